# Optimizing an MI355X kernel written in HIP

```python
import jax, jax.numpy as jnp
from jax import lax
import numpy as np

D_MODEL = 2048
BATCH = 2
SEQ = 4096
DEPTH = 1
DEC_BATCH = 8
DEC_SEQ = 16
PAST_LEN = 4096

CHUNK = 64
QBLOCK = 128
HEAD_DIM = 128
SB_HEADS = 6
BAND_HEADS = 6
MEM_HEADS = 4
SB_WIDTH = SB_HEADS * HEAD_DIM
BAND_WIDTH = BAND_HEADS * HEAD_DIM
MEM_WIDTH = MEM_HEADS * HEAD_DIM
N_MEM = 256
BAND_LEFT_CHUNKS = 8
BAND_ROWS = BAND_LEFT_CHUNKS * CHUNK
MAX_REL = 256
IN_WIDTH = 4 * SB_WIDTH + 4 * BAND_WIDTH + 2 * MEM_WIDTH + 3 * D_MODEL
RMS_EPS = 1e-6
NEG_INF = -1e30

kernel_name = "sandwich_gated_stickbreak_chunkband_stream_step"


def rms_norm(x, g):
    xf = x.astype(jnp.float32)
    xf = xf * lax.rsqrt(jnp.mean(xf * xf, axis=-1, keepdims=True) + RMS_EPS)
    return (xf * g.astype(jnp.float32)).astype(x.dtype)


def in_projection(x, g_pre, w_in):
    b, t, _ = x.shape
    widths = [SB_WIDTH] * 4 + [BAND_WIDTH] * 4 + [MEM_WIDTH] * 2 + [D_MODEL] * 3
    points = np.cumsum(widths)[:-1].tolist()
    parts = jnp.split(rms_norm(x, g_pre) @ w_in, points, axis=-1)
    sb_q, sb_k, sb_v, sb_g, bd_q, bd_k, bd_v, bd_g, mm_q, mm_g, mg_sb, mg_bd, mg_mm = parts
    hs = lambda a, n: a.reshape(b, t, n, HEAD_DIM)
    return (hs(sb_q, SB_HEADS), hs(sb_k, SB_HEADS), hs(sb_v, SB_HEADS), sb_g,
            hs(bd_q, BAND_HEADS), hs(bd_k, BAND_HEADS), hs(bd_v, BAND_HEADS), bd_g,
            hs(mm_q, MEM_HEADS), mm_g, mg_sb, mg_bd, mg_mm)


def memory_kv(mem, g_mem, w_mem_kv):
    b, m, _ = mem.shape
    mk, mv = jnp.split(rms_norm(mem, g_mem) @ w_mem_kv, 2, axis=-1)
    return (mk.reshape(b, m, MEM_HEADS, HEAD_DIM), mv.reshape(b, m, MEM_HEADS, HEAD_DIM))


def stick_breaking(q, k, v, q_pos, k_pos):
    z = jnp.einsum('bqhd,bkhd->bhqk', q, k).astype(jnp.float32) * (HEAD_DIM ** -0.5)
    mask = k_pos[None, :] < q_pos[:, None]
    log_1m = jnp.where(mask, jax.nn.log_sigmoid(-z), 0.0)
    suffix = lax.cumsum(log_1m, axis=3, reverse=True) - log_1m
    w = jnp.where(mask, jnp.exp(jax.nn.log_sigmoid(z) + suffix), 0.0)
    return jnp.einsum('bhqk,bkhd->bqhd', w.astype(v.dtype), v)


def stick_breaking_prompt(q, k, v):
    t = q.shape[1]
    pos = jnp.arange(t)
    outs = []
    for i in range(t // QBLOCK):
        lo, hi = i * QBLOCK, (i + 1) * QBLOCK
        outs.append(stick_breaking(q[:, lo:hi], k[:, :hi], v[:, :hi], pos[lo:hi], pos[:hi]))
    return jnp.concatenate(outs, axis=1)


def band_attention(q, k, v, q_pos, k_pos, rel_bias):
    s = jnp.einsum('bnqhd,bnkhd->bnhqk', q, k).astype(jnp.float32) * (HEAD_DIM ** -0.5)
    rel = jnp.clip(q_pos[:, :, None] - k_pos[:, None, :], -MAX_REL, MAX_REL) + MAX_REL
    bias = jnp.moveaxis(rel_bias.astype(jnp.float32)[:, rel], 0, 1)
    s = jnp.where((k_pos >= 0)[None, :, None, None, :], s + bias[None], NEG_INF)
    p = jax.nn.softmax(s, axis=-1)
    return jnp.einsum('bnhqk,bnkhd->bnqhd', p.astype(v.dtype), v)


def band_prompt(q, k, v, rel_bias):
    b, t, h, d = q.shape
    nc = t // CHUNK
    lc = BAND_LEFT_CHUNKS

    def gather_band(a):
        ac = jnp.pad(a.reshape(b, nc, CHUNK, h, d), ((0, 0), (lc, 0), (0, 0), (0, 0), (0, 0)))
        return jnp.concatenate([ac[:, j:j + nc] for j in range(lc + 1)], axis=2)

    c0 = jnp.arange(nc)[:, None] * CHUNK
    q_pos = c0 + jnp.arange(CHUNK)[None, :]
    k_pos = c0 - lc * CHUNK + jnp.arange((lc + 1) * CHUNK)[None, :]
    out = band_attention(q.reshape(b, nc, CHUNK, h, d), gather_band(k), gather_band(v),
                         q_pos, k_pos, rel_bias)
    return out.reshape(b, t, h, d)


def memory_attention(q, mk, mv):
    s = jnp.einsum('bthd,bmhd->bhtm', q, mk).astype(jnp.float32) * (HEAD_DIM ** -0.5)
    p = jax.nn.softmax(s, axis=-1)
    return jnp.einsum('bhtm,bmhd->bthd', p.astype(mv.dtype), mv)


def merge_output(x, o_sb, g_sb, o_bd, g_bd, o_mm, g_mm, mg_sb, mg_bd, mg_mm,
                 w_up_sb, w_up_band, w_up_mem, w_out, g_post):
    b, t, _ = x.shape

    def branch(o, g, w):
        return (o.reshape(b, t, -1) * jax.nn.silu(g)) @ w

    merged = (jax.nn.sigmoid(mg_sb) * branch(o_sb, g_sb, w_up_sb)
              + jax.nn.sigmoid(mg_bd) * branch(o_bd, g_bd, w_up_band)
              + jax.nn.sigmoid(mg_mm) * branch(o_mm, g_mm, w_up_mem))
    return x + rms_norm(merged @ w_out, g_post)


def setup_inputs(seed: int = 0) -> dict:
    key = jax.random.key(seed)
    ks = jax.random.split(key, 24)
    nrm = lambda k, shape, scale: jax.random.normal(k, shape, jnp.float32) * scale
    band_rows = min(BAND_ROWS, PAST_LEN)
    return {
        'x_prompt': nrm(ks[0], (BATCH, SEQ, D_MODEL), 1.0),
        'x_sample': nrm(ks[1], (DEC_BATCH, DEC_SEQ, D_MODEL), 1.0),
        'cache_sb_k': nrm(ks[2], (DEPTH, DEC_BATCH, PAST_LEN, SB_HEADS, HEAD_DIM), 1.0),
        'cache_sb_v': nrm(ks[3], (DEPTH, DEC_BATCH, PAST_LEN, SB_HEADS, HEAD_DIM), 1.0),
        'cache_band_k': nrm(ks[4], (DEPTH, DEC_BATCH, band_rows, BAND_HEADS, HEAD_DIM), 1.0),
        'cache_band_v': nrm(ks[5], (DEPTH, DEC_BATCH, band_rows, BAND_HEADS, HEAD_DIM), 1.0),
        'cache_mem_k': nrm(ks[6], (DEPTH, DEC_BATCH, N_MEM, MEM_HEADS, HEAD_DIM), 1.0),
        'cache_mem_v': nrm(ks[7], (DEPTH, DEC_BATCH, N_MEM, MEM_HEADS, HEAD_DIM), 1.0),
        'mem_prompt': nrm(ks[8], (BATCH, N_MEM, D_MODEL), 1.0),
        'g_pre': 1.0 + nrm(ks[9], (DEPTH, D_MODEL), 0.02),
        'w_in': nrm(ks[10], (DEPTH, D_MODEL, IN_WIDTH), D_MODEL ** -0.5),
        'rel_bias': nrm(ks[11], (DEPTH, BAND_HEADS, 2 * MAX_REL + 1), 0.1),
        'g_mem': 1.0 + nrm(ks[12], (DEPTH, D_MODEL), 0.02),
        'w_mem_kv': nrm(ks[13], (DEPTH, D_MODEL, 2 * MEM_WIDTH), D_MODEL ** -0.5),
        'w_up_sb': nrm(ks[14], (DEPTH, SB_WIDTH, D_MODEL), SB_WIDTH ** -0.5),
        'w_up_band': nrm(ks[15], (DEPTH, BAND_WIDTH, D_MODEL), BAND_WIDTH ** -0.5),
        'w_up_mem': nrm(ks[16], (DEPTH, MEM_WIDTH, D_MODEL), MEM_WIDTH ** -0.5),
        'w_out': nrm(ks[17], (DEPTH, D_MODEL, D_MODEL), D_MODEL ** -0.5),
        'g_post': 1.0 + nrm(ks[18], (DEPTH, D_MODEL), 0.02),
    }


def reference(x_prompt, x_sample, cache_sb_k, cache_sb_v, cache_band_k, cache_band_v,
              cache_mem_k, cache_mem_v, mem_prompt, g_pre, w_in, rel_bias, g_mem, w_mem_kv,
              w_up_sb, w_up_band, w_up_mem, w_out, g_post):
    past = cache_sb_k.shape[2]
    r_band = cache_band_k.shape[2]
    n_new = x_sample.shape[1]
    q_pos_s = past + jnp.arange(n_new)
    k_pos_sb = jnp.arange(past + n_new)
    k_pos_bd = past - r_band + jnp.arange(r_band + n_new)

    xp, xs = x_prompt, x_sample
    sbk_p, sbv_p, bdk_p, bdv_p, mk_p, mv_p = [], [], [], [], [], []
    sbk_s, sbv_s, bdk_s, bdv_s = [], [], [], []
    for l in range(DEPTH):
        (sq, sk, sv, sg, bq, bk, bv, bg, mq, mg, gsb, gbd, gmm) = in_projection(xp, g_pre[l], w_in[l])
        mk, mv = memory_kv(mem_prompt, g_mem[l], w_mem_kv[l])
        o_sb = stick_breaking_prompt(sq, sk, sv)
        o_bd = band_prompt(bq, bk, bv, rel_bias[l])
        o_mm = memory_attention(mq, mk, mv)
        xp = merge_output(xp, o_sb, sg, o_bd, bg, o_mm, mg, gsb, gbd, gmm,
                          w_up_sb[l], w_up_band[l], w_up_mem[l], w_out[l], g_post[l])
        sbk_p.append(sk); sbv_p.append(sv)
        bdk_p.append(bk[:, -BAND_ROWS:]); bdv_p.append(bv[:, -BAND_ROWS:])
        mk_p.append(mk); mv_p.append(mv)

        (sq2, sk2, sv2, sg2, bq2, bk2, bv2, bg2, mq2, mg2, gsb2, gbd2, gmm2) = in_projection(xs, g_pre[l], w_in[l])
        k_all = jnp.concatenate([cache_sb_k[l], sk2], axis=1)
        v_all = jnp.concatenate([cache_sb_v[l], sv2], axis=1)
        o_sb2 = stick_breaking(sq2, k_all, v_all, q_pos_s, k_pos_sb)
        kb = jnp.concatenate([cache_band_k[l], bk2], axis=1)[:, None]
        vb = jnp.concatenate([cache_band_v[l], bv2], axis=1)[:, None]
        o_bd2 = band_attention(bq2[:, None], kb, vb, q_pos_s[None], k_pos_bd[None], rel_bias[l])[:, 0]
        o_mm2 = memory_attention(mq2, cache_mem_k[l], cache_mem_v[l])
        xs = merge_output(xs, o_sb2, sg2, o_bd2, bg2, o_mm2, mg2, gsb2, gbd2, gmm2,
                          w_up_sb[l], w_up_band[l], w_up_mem[l], w_out[l], g_post[l])
        sbk_s.append(sk2); sbv_s.append(sv2)
        bdk_s.append(bk2); bdv_s.append(bv2)

    return (xp, xs,
            jnp.stack(sbk_p), jnp.stack(sbv_p), jnp.stack(bdk_p), jnp.stack(bdv_p),
            jnp.stack(mk_p), jnp.stack(mv_p),
            jnp.stack(sbk_s), jnp.stack(sbv_s), jnp.stack(bdk_s), jnp.stack(bdv_s))
```

```cpp
#include <hip/hip_runtime.h>
#include <hip/hip_bf16.h>
#include <cstdio>
#include <cstdint>

#ifndef MK_N_LAUNCHES
#define MK_N_LAUNCHES 6
#endif
#ifndef SB_EARLY_EXIT
#define SB_EARLY_EXIT 1
#endif

constexpr int DM = 2048, SEQ = 4096, NB = 2, DB = 8, DS = 16, PAST = 4096, HD = 128;
constexpr int MP = NB * SEQ;
constexpr int MS = DB * DS;
constexpr int MIN_ = 8448;
constexpr int MREAL = MP + MS;
constexpr int MMEM0 = 8448;
constexpr int MA = 8960;
constexpr int INW = 13312, NCAT = 14336;
constexpr int NMEM = 256;
constexpr float RMS_EPS = 1e-6f;
constexpr float LOG2E = 1.4426950408889634f;
constexpr float QSCALE = 0.08838834764831845f * 1.4426950408889634f;

namespace pg8 {
#define PG8_LAS __attribute__((address_space(3)))
typedef unsigned short bf16_t;
typedef short bf16x8 __attribute__((ext_vector_type(8)));
typedef float f32x4 __attribute__((ext_vector_type(4)));
typedef unsigned u32x4 __attribute__((ext_vector_type(4)));
constexpr int BM = 256, BK = 64, HALF = 128, HTB = HALF * BK * 2  , STAGE_BYTES = 8 * HTB, NXCD = 8, WGM = 8;

__host__ __device__ __forceinline__ int lds_byte(int r, int c) { const int st = (r >> 4) * 2 + (c >> 5), rr = r & 15, cc = c & 31, ob = rr * 64 + cc * 2; return st * 1024 + (ob ^ (((ob >> 9) & 1) << 5)); }
__host__ __device__ __forceinline__ void stage_rc(int b, int& R, int& C) { const int st = b / 1024, sb = b % 1024, swz = sb ^ (((sb >> 9) & 1) << 5); R = (st >> 1) * 16 + swz / 64; C = (st & 1) * 32 + (swz % 64) / 2; }
__host__ __device__ __forceinline__ int perm32(int rho) { const int n = rho >> 4, i = rho & 15; return 8 * (i >> 2) + 4 * n + (i & 3); }

struct Unit { int pm, pn, k0, nt; };
struct Gemm { const bf16_t* A; const bf16_t* Bt; int M, N, K; };

struct StaticOrder {
    int nM, nN, nwg, G, c;
    __host__ __device__ void init(int M, int N, int G_, int c_) { nM = M / BM; nN = N / BM; nwg = nM * nN; G = G_; c = c_; }
    __host__ __device__ bool next(int i, Unit& u) const {
        const long L = (long)i * G + c; if (L >= nwg) return false;
        int wgid = (int)L; { const int q = nwg / NXCD, r = nwg % NXCD, xcd = wgid % NXCD, off = wgid / NXCD; wgid = (xcd < r ? xcd * (q + 1) : r * (q + 1) + (xcd - r) * q) + off; }
        const int nig = WGM * nN, gid = wgid / nig, fm = gid * WGM, gsz = (nM - fm) < WGM ? (nM - fm) : WGM;
        u.pm = fm + ((wgid % nig) % gsz); u.pn = (wgid % nig) / gsz; u.k0 = 0; u.nt = 0; return true;
    }
    __device__ __forceinline__ void a_ready(const Unit&) const {}
    __device__ __forceinline__ void done(const Unit&) const {}
};

typedef float f32x2_t __attribute__((ext_vector_type(2))); typedef __bf16 bf16x2_t __attribute__((ext_vector_type(2)));
__device__ __forceinline__ unsigned cvt_pk_bf16(float lo, float hi) { f32x2_t v = {lo, hi}; bf16x2_t b = __builtin_convertvector(v, bf16x2_t); return __builtin_bit_cast(unsigned, b); }

template <class Epi, class Sched, bool ALIGN_EPI = false, bool SP2 = false>
__device__ __forceinline__ void gemm_phase(PG8_LAS unsigned char* lds, const Gemm g, const Sched& S, const Epi& E) {
    const int tid = threadIdx.x, wid = __builtin_amdgcn_readfirstlane(tid >> 6), lane = tid & 63, wr = wid >> 2, wc = wid & 3, fr = lane & 15, fq = lane >> 4;
    const int K = g.K, nt = K / BK;
    unsigned voffA[2], voffB[2];
#pragma unroll
    for (int i = 0; i < 2; ++i) { int R, C; stage_rc(tid * 16 + i * 8192, R, C); const int Rb = Epi::PERM ? ((R & ~31) + perm32(R & 31)) : R;
        voffA[i] = (unsigned)(R * K + C) * 2u; voffB[i] = (unsigned)(Rb * K + C) * 2u; }
    const size_t kstep = (size_t)(BK * 2);
    const size_t hstep = (size_t)HALF * K * 2;
    const size_t tstep = 2 * hstep;
    const unsigned ldsw = (unsigned)wid * 1024u;
    const int aoff = lds_byte(wr * 64 + fr, fq * 8), boff = lds_byte(wc * 32 + fr, fq * 8);
#define PG8_SA(b, h) (((b) * 2 + (h)) * HTB)
#define PG8_SB(b, h) ((4 + (b) * 2 + (h)) * HTB)
#define PG8_STAGE(bufoff, gbase, voff) do { _Pragma("unroll") for (int _i = 0; _i < 2; ++_i) \
        __builtin_amdgcn_global_load_lds((const unsigned*)((const char*)(gbase) + (voff)[_i]), (PG8_LAS unsigned*)(lds + (bufoff) + ldsw + _i * 8192), 16, 0, 0); } while (0)
#define PG8_LDA(dst, b, h) do { _Pragma("unroll") for (int m = 0; m < 4; ++m) _Pragma("unroll") for (int k = 0; k < 2; ++k) dst[m][k] = *(const PG8_LAS bf16x8*)(lds + PG8_SA(b, h) + aoff + m * 2048 + k * 1024); } while (0)
#define PG8_LDB(dst, b, h) do { _Pragma("unroll") for (int n = 0; n < 2; ++n) _Pragma("unroll") for (int k = 0; k < 2; ++k) dst[n][k] = *(const PG8_LAS bf16x8*)(lds + PG8_SB(b, h) + boff + n * 2048 + k * 1024); } while (0)
#define PG8_MMA(ai, bj, At, Bt) do { __builtin_amdgcn_s_setprio(1); _Pragma("unroll") for (int m = 0; m < 4; ++m) _Pragma("unroll") for (int n = 0; n < 2; ++n) _Pragma("unroll") for (int k = 0; k < 2; ++k) \
        acc[ai][bj][m][n] = __builtin_amdgcn_mfma_f32_16x16x32_bf16(Bt[n][k], At[m][k], acc[ai][bj][m][n], 0, 0, 0); __builtin_amdgcn_s_setprio(0); } while (0)
#define PG8_WAIT_V(n) asm volatile("s_waitcnt vmcnt(" #n ")" ::: "memory")
#define PG8_WAIT_L(n) asm volatile("s_waitcnt lgkmcnt(" #n ")" ::: "memory")
#define PG8_BAR __builtin_amdgcn_s_barrier()
#define PG8_SCHED __builtin_amdgcn_sched_barrier(0)
    Unit cur, nxt; int ui = 0;
    if (!S.next(0, cur)) return;
    f32x4 acc[2][2][4][2];
#pragma unroll
    for (int a = 0; a < 2; ++a)
#pragma unroll
        for (int b = 0; b < 2; ++b)
#pragma unroll
            for (int m = 0; m < 4; ++m)
#pragma unroll
                for (int n = 0; n < 2; ++n) acc[a][b][m][n] = (f32x4){0.f, 0.f, 0.f, 0.f};
    bf16x8 At[4][2], B0[2][2], B1[2][2];
    const char* cA = (const char*)g.A + (size_t)cur.pm * tstep + (size_t)cur.k0 * 2; const char* cB = (const char*)g.Bt + (size_t)cur.pn * tstep + (size_t)cur.k0 * 2;
    S.a_ready(cur);
    if constexpr (SP2) {
        PG8_STAGE(PG8_SB(0, 0), cB, voffB); PG8_STAGE(PG8_SB(0, 1), cB + hstep, voffB); PG8_STAGE(PG8_SA(0, 0), cA, voffA); PG8_STAGE(PG8_SA(0, 1), cA + hstep, voffA);
        if (wr == 1) PG8_BAR;
        PG8_WAIT_V(2); PG8_BAR;
        PG8_STAGE(PG8_SB(1, 0), cB + kstep, voffB); PG8_STAGE(PG8_SA(1, 0), cA + kstep, voffA); PG8_STAGE(PG8_SB(1, 1), cB + hstep + kstep, voffB);
        PG8_WAIT_V(6); PG8_BAR;
    } else {
        PG8_STAGE(PG8_SB(0, 0), cB, voffB); PG8_STAGE(PG8_SA(0, 0), cA, voffA); PG8_STAGE(PG8_SB(0, 1), cB + hstep, voffB); PG8_STAGE(PG8_SA(0, 1), cA + hstep, voffA);
        if (wr == 1) PG8_BAR;
        PG8_WAIT_V(4); PG8_BAR;
        PG8_STAGE(PG8_SB(1, 0), cB + kstep, voffB); PG8_STAGE(PG8_SA(1, 0), cA + kstep, voffA); PG8_STAGE(PG8_SB(1, 1), cB + hstep + kstep, voffB);
        PG8_WAIT_V(6); PG8_BAR;
    }
    for (;;) {
        const bool has_next = S.next(ui + 1, nxt);
        const char* nA = has_next ? (const char*)g.A + (size_t)nxt.pm * tstep + (size_t)nxt.k0 * 2 : cA; const char* nB = has_next ? (const char*)g.Bt + (size_t)nxt.pn * tstep + (size_t)nxt.k0 * 2 : cB;
        const int ntu = cur.nt ? cur.nt : nt;
        for (int t = 0; t < ntu; t += 2) {
            const bool last = (t == ntu - 2);
            const char* a1 = cA + (size_t)(t + 1) * kstep;
            const char* a2 = last ? nA : cA + (size_t)(t + 2) * kstep; const char* b2 = last ? nB : cB + (size_t)(t + 2) * kstep;
            const char* a3 = a2 + kstep; const char* b3 = b2 + kstep;
            if (last && has_next) S.a_ready(nxt);
            if constexpr (SP2) {
            PG8_LDB(B0, 0, 0); PG8_LDB(B1, 0, 1); PG8_SCHED; PG8_LDA(At, 0, 0); PG8_STAGE(PG8_SA(1, 1), a1 + hstep, voffA);
            PG8_WAIT_V(8); PG8_WAIT_L(0); PG8_BAR; PG8_MMA(0, 0, At, B0); PG8_MMA(0, 1, At, B1); PG8_BAR; PG8_SCHED;
            PG8_LDA(At, 0, 1); PG8_STAGE(PG8_SB(0, 0), b2, voffB); PG8_STAGE(PG8_SB(0, 1), b2 + hstep, voffB); PG8_STAGE(PG8_SA(0, 0), a2, voffA);
            PG8_WAIT_V(8); PG8_WAIT_L(0); PG8_BAR; PG8_MMA(1, 0, At, B0); PG8_MMA(1, 1, At, B1); PG8_BAR; PG8_SCHED;
            PG8_LDB(B0, 1, 0); PG8_LDB(B1, 1, 1); PG8_SCHED; PG8_LDA(At, 1, 0); PG8_STAGE(PG8_SA(0, 1), a2 + hstep, voffA);
            PG8_WAIT_V(8); PG8_WAIT_L(0); PG8_BAR; PG8_MMA(0, 0, At, B0); PG8_MMA(0, 1, At, B1); PG8_BAR; PG8_SCHED;
            PG8_LDA(At, 1, 1); PG8_STAGE(PG8_SB(1, 0), b3, voffB); PG8_STAGE(PG8_SB(1, 1), b3 + hstep, voffB); PG8_STAGE(PG8_SA(1, 0), a3, voffA);
            PG8_WAIT_V(8); PG8_WAIT_L(0); PG8_BAR; PG8_MMA(1, 0, At, B0); PG8_MMA(1, 1, At, B1); PG8_BAR; PG8_SCHED;
            } else {
            PG8_LDB(B0, 0, 0); PG8_SCHED; PG8_LDA(At, 0, 0); PG8_STAGE(PG8_SA(1, 1), a1 + hstep, voffA);
            PG8_WAIT_L(8); PG8_BAR; PG8_WAIT_L(0); PG8_MMA(0, 0, At, B0); PG8_BAR; PG8_SCHED;
            PG8_LDB(B1, 0, 1); PG8_STAGE(PG8_SB(0, 0), b2, voffB);
            PG8_BAR; PG8_WAIT_L(0); PG8_MMA(0, 1, At, B1); PG8_BAR;
            PG8_LDA(At, 0, 1); PG8_STAGE(PG8_SA(0, 0), a2, voffA);
            PG8_BAR; PG8_WAIT_L(0); PG8_MMA(1, 0, At, B0); PG8_BAR; PG8_SCHED;
            PG8_STAGE(PG8_SB(0, 1), b2 + hstep, voffB);
            PG8_WAIT_V(6); PG8_BAR; PG8_MMA(1, 1, At, B1); PG8_BAR;
            PG8_LDB(B0, 1, 0); PG8_SCHED; PG8_LDA(At, 1, 0); PG8_STAGE(PG8_SA(0, 1), a2 + hstep, voffA);
            PG8_WAIT_L(8); PG8_BAR; PG8_WAIT_L(0); PG8_MMA(0, 0, At, B0); PG8_BAR; PG8_SCHED;
            PG8_LDB(B1, 1, 1); PG8_STAGE(PG8_SB(1, 0), b3, voffB);
            PG8_BAR; PG8_WAIT_L(0); PG8_MMA(0, 1, At, B1); PG8_BAR;
            PG8_LDA(At, 1, 1); PG8_STAGE(PG8_SA(1, 0), a3, voffA);
            PG8_BAR; PG8_WAIT_L(0); PG8_MMA(1, 0, At, B0); PG8_BAR; PG8_SCHED;
            PG8_STAGE(PG8_SB(1, 1), b3 + hstep, voffB);
            PG8_WAIT_V(6); PG8_BAR; PG8_MMA(1, 1, At, B1); PG8_BAR;
            }
        }
        if constexpr (ALIGN_EPI) { if (wr == 0) PG8_BAR; }
        if constexpr (!Epi::AFTER_DRAIN) { E(acc, cur, wr, wc, fr, fq); S.done(cur); }
        if (!has_next) break;
        if (E.reset_after(cur))
#pragma unroll
        for (int a = 0; a < 2; ++a)
#pragma unroll
            for (int b = 0; b < 2; ++b)
#pragma unroll
                for (int m = 0; m < 4; ++m)
#pragma unroll
                    for (int n = 0; n < 2; ++n) acc[a][b][m][n] = (f32x4){0.f, 0.f, 0.f, 0.f};
        cur = nxt; cA = nA; cB = nB; ++ui;
        if constexpr (ALIGN_EPI) { if (wr == 1) PG8_BAR; }
    }
    PG8_WAIT_V(0);
    if constexpr (!ALIGN_EPI) { if (wr == 0) PG8_BAR; }
    PG8_BAR;
    if constexpr (Epi::AFTER_DRAIN) { E.fused(acc, cur, wr, wc, fr, fq, lds, wid, lane); S.done(cur); }
#undef PG8_SA
#undef PG8_SB
#undef PG8_STAGE
#undef PG8_LDA
#undef PG8_LDB
#undef PG8_MMA
#undef PG8_WAIT_V
#undef PG8_WAIT_L
#undef PG8_BAR
#undef PG8_SCHED
}
}

namespace ep {
using pg8::f32x4; using pg8::u32x4; using pg8::Unit; using pg8::bf16_t; using pg8::HALF; using pg8::BM; using pg8::cvt_pk_bf16;
typedef unsigned u32x2 __attribute__((ext_vector_type(2)));

struct InOrder {
    pg8::StaticOrder so; int G, c;
    __device__ void init(int G_, int c_) { so.init(MIN_, INW, G_, c_); G = G_; c = c_; }
    __device__ bool next(int i, Unit& u) const {
        const long L = (long)i * G + c;
        if (L < so.nwg) return so.next(i, u);
        const int j = (int)(L - so.nwg); if (j >= 8) return false;
        u.pm = 33 + (j & 1); u.pn = 52 + (j >> 1); u.k0 = 0; u.nt = 0; return true;
    }
    __device__ __forceinline__ void a_ready(const Unit&) const {}
    __device__ __forceinline__ void done(const Unit&) const {}
};

__device__ __forceinline__ float sigmoidf_fast(float x) { return __builtin_amdgcn_rcpf(1.0f + __builtin_amdgcn_exp2f(-x * LOG2E)); }
__device__ __forceinline__ float bf2f(unsigned short h) { return __uint_as_float((unsigned)h << 16); }

struct EpiIn {
    static constexpr bool PERM = true, AFTER_DRAIN = false;
    bf16_t *QSB, *KSB, *VSB, *GSB, *QBD, *KBD, *VBD, *GBD, *QMM, *GMM, *MG, *MK, *MV;
    float* out;
    __device__ __forceinline__ bool reset_after(const Unit&) const { return true; }
    template <int ACT, int F32>
    __device__ __forceinline__ void store(const f32x4 (&acc)[2][2][4][2], bf16_t* dst, int ldc, int colt, int rowoff, int pm, float* f0, float* f1, int wr, int wc, int fr, int fq) const {
        const int col0 = colt + wc * 32 + 8 * fq;
#pragma unroll
        for (int ai = 0; ai < 2; ++ai)
#pragma unroll
            for (int m = 0; m < 4; ++m) {
                const int r = pm * BM + ai * HALF + wr * 64 + m * 16 + fr;
                bf16_t* rowp = dst + (size_t)(r - rowoff) * ldc + col0;
                float* frow = nullptr;
                if (F32 == 1) { if (r < MP) frow = f0 + (size_t)r * 768; else if (r < MREAL) frow = f1 + (size_t)(r - MP) * 768; }
                if (F32 == 2) { if (r < MP) { const int t = r & (SEQ - 1); if (t >= SEQ - 512) frow = f0 + ((size_t)(r >> 12) * 512 + (t - (SEQ - 512))) * 768; } else if (r < MREAL) frow = f1 + (size_t)(r - MP) * 768; }
                if (F32 == 3) frow = f0 + (size_t)(r - MMEM0) * 512;
#pragma unroll
                for (int bj = 0; bj < 2; ++bj) {
                    f32x4 v0 = acc[ai][bj][m][0], v1 = acc[ai][bj][m][1];
                    if (F32 != 0) { if (frow) { *(f32x4*)(frow + col0 + bj * HALF) = v0; *(f32x4*)(frow + col0 + bj * HALF + 4) = v1; } }
                    if (ACT == 1) { v0 = v0 * QSCALE; v1 = v1 * QSCALE; }
                    if (ACT == 2) {
#pragma unroll
                        for (int e = 0; e < 4; ++e) { v0[e] = v0[e] * sigmoidf_fast(v0[e]); v1[e] = v1[e] * sigmoidf_fast(v1[e]); } }
                    if (ACT == 3) {
#pragma unroll
                        for (int e = 0; e < 4; ++e) { v0[e] = sigmoidf_fast(v0[e]); v1[e] = sigmoidf_fast(v1[e]); } }
                    u32x4 w; w.x = cvt_pk_bf16(v0[0], v0[1]); w.y = cvt_pk_bf16(v0[2], v0[3]); w.z = cvt_pk_bf16(v1[0], v1[1]); w.w = cvt_pk_bf16(v1[2], v1[3]);
                    *(u32x4*)(rowp + bj * HALF) = w; }
            }
    }
    __device__ __forceinline__ void operator()(const f32x4 (&acc)[2][2][4][2], const Unit& u, int wr, int wc, int fr, int fq) const {
        const int pn = u.pn, pm = u.pm;
        float* const o_sbk = out + 17039360, * const o_sbv = out + 23330816, * const o_bdk = out + 29622272, * const o_bdv = out + 30408704;
        float* const o_mk = out + 31195136, * const o_mv = out + 31457280;
        float* const s_sbk = out + 31719424, * const s_sbv = out + 31817728, * const s_bdk = out + 31916032, * const s_bdv = out + 32014336;
        if (pn < 3)        store<1, 0>(acc, QSB, 768, 256 * pn, 0, pm, nullptr, nullptr, wr, wc, fr, fq);
        else if (pn < 6)   store<0, 1>(acc, KSB, 768, 256 * (pn - 3), 0, pm, o_sbk, s_sbk, wr, wc, fr, fq);
        else if (pn < 9)   store<0, 1>(acc, VSB, 768, 256 * (pn - 6), 0, pm, o_sbv, s_sbv, wr, wc, fr, fq);
        else if (pn < 12)  store<2, 0>(acc, GSB, 768, 256 * (pn - 9), 0, pm, nullptr, nullptr, wr, wc, fr, fq);
        else if (pn < 15)  store<1, 0>(acc, QBD, 768, 256 * (pn - 12), 0, pm, nullptr, nullptr, wr, wc, fr, fq);
        else if (pn < 18)  store<0, 2>(acc, KBD, 768, 256 * (pn - 15), 0, pm, o_bdk, s_bdk, wr, wc, fr, fq);
        else if (pn < 21)  store<0, 2>(acc, VBD, 768, 256 * (pn - 18), 0, pm, o_bdv, s_bdv, wr, wc, fr, fq);
        else if (pn < 24)  store<2, 0>(acc, GBD, 768, 256 * (pn - 21), 0, pm, nullptr, nullptr, wr, wc, fr, fq);
        else if (pn < 26)  store<1, 0>(acc, QMM, 512, 256 * (pn - 24), 0, pm, nullptr, nullptr, wr, wc, fr, fq);
        else if (pn < 28)  store<2, 0>(acc, GMM, 512, 256 * (pn - 26), 0, pm, nullptr, nullptr, wr, wc, fr, fq);
        else if (pn < 52)  store<3, 0>(acc, MG, 6144, 256 * (pn - 28), 0, pm, nullptr, nullptr, wr, wc, fr, fq);
        else if (pn < 54)  store<0, 3>(acc, MK, 512, 256 * (pn - 52), MMEM0, pm, o_mk, nullptr, wr, wc, fr, fq);
        else               store<0, 3>(acc, MV, 512, 256 * (pn - 54), MMEM0, pm, o_mv, nullptr, wr, wc, fr, fq);
    }
};

struct MergeOrder {
    pg8::StaticOrder so;
    __device__ void init(int G_, int c_) { so.init(MIN_, DM, G_, c_); }
    __device__ bool next(int i, Unit& u) const {
        const int ti = i / 3, seg = i - 3 * ti;
        if (!so.next(ti, u)) return false;
        u.k0 = 768 * seg; u.nt = (seg == 2) ? 8 : 12; return true;
    }
    __device__ __forceinline__ void a_ready(const Unit&) const {}
    __device__ __forceinline__ void done(const Unit&) const {}
};
struct EpiMerge {
    static constexpr bool PERM = true, AFTER_DRAIN = false;
    const bf16_t* MG; bf16_t* OUT;
    __device__ __forceinline__ bool reset_after(const Unit& u) const { return u.k0 == 1536; }
    __device__ __forceinline__ void operator()(f32x4 (&acc)[2][2][4][2], const Unit& u, int wr, int wc, int fr, int fq) const {
        const int col0 = u.pn * BM + wc * 32 + 8 * fq;
        const int seg = (u.k0 == 0) ? 0 : (u.k0 == 768 ? 1 : 2);
#pragma unroll
        for (int ai = 0; ai < 2; ++ai)
#pragma unroll
            for (int m = 0; m < 4; ++m) {
                const int r = u.pm * BM + ai * HALF + wr * 64 + m * 16 + fr;
                const bf16_t* g = MG + (size_t)r * 6144 + seg * 2048 + col0; bf16_t* rowp = OUT + (size_t)r * DM + col0;
#pragma unroll
                for (int bj = 0; bj < 2; ++bj) {
                    const u32x4 a = *(const u32x4*)(g + bj * HALF);
                    float f[8];
#pragma unroll
                    for (int e = 0; e < 4; ++e) { f[2 * e] = fmaxf(__uint_as_float(a[e] << 16), 1e-30f); f[2 * e + 1] = fmaxf(__uint_as_float(a[e] & 0xffff0000u), 1e-30f); }
                    if (seg < 2) {
                        const u32x4 b = *(const u32x4*)(g + 2048 + bj * HALF);
#pragma unroll
                        for (int e = 0; e < 4; ++e) { f[2 * e] *= __builtin_amdgcn_rcpf(fmaxf(__uint_as_float(b[e] << 16), 1e-30f)); f[2 * e + 1] *= __builtin_amdgcn_rcpf(fmaxf(__uint_as_float(b[e] & 0xffff0000u), 1e-30f)); }
                    }
#pragma unroll
                    for (int k = 0; k < 8; ++k) acc[ai][bj][m][k >> 2][k & 3] *= f[k];
                    if (seg == 2) {
                        u32x4 w; w.x = cvt_pk_bf16(acc[ai][bj][m][0][0], acc[ai][bj][m][0][1]); w.y = cvt_pk_bf16(acc[ai][bj][m][0][2], acc[ai][bj][m][0][3]);
                        w.z = cvt_pk_bf16(acc[ai][bj][m][1][0], acc[ai][bj][m][1][1]); w.w = cvt_pk_bf16(acc[ai][bj][m][1][2], acc[ai][bj][m][1][3]);
                        *(u32x4*)(rowp + bj * HALF) = w; }
                }
                if (m & 1) asm volatile("" ::: "memory");
            }
    }
};

struct EpiOut {
    static constexpr bool PERM = false, AFTER_DRAIN = false;
    float* out; float* ssq;
    __device__ __forceinline__ bool reset_after(const Unit&) const { return true; }
    __device__ __forceinline__ void operator()(const f32x4 (&acc)[2][2][4][2], const Unit& u, int wr, int wc, int fr, int fq) const {
        const int col0 = u.pn * BM + wc * 32 + 4 * fq;
#pragma unroll
        for (int ai = 0; ai < 2; ++ai)
#pragma unroll
            for (int m = 0; m < 4; ++m) {
                const int r = u.pm * BM + ai * HALF + wr * 64 + m * 16 + fr;
                float* yrow = (r < MP) ? out + (size_t)r * DM : out + (size_t)16777216 + (size_t)(r - MP) * DM;
                float s = 0.f;
#pragma unroll
                for (int bj = 0; bj < 2; ++bj)
#pragma unroll
                    for (int n = 0; n < 2; ++n) { const f32x4 v = acc[ai][bj][m][n]; s += (v[0] * v[0] + v[1] * v[1]) + (v[2] * v[2] + v[3] * v[3]);
                        if (r < MREAL) *(f32x4*)(yrow + col0 + bj * HALF + n * 16) = v; }
                s += __shfl_xor(s, 16); s += __shfl_xor(s, 32);
                if (fq == 0) ssq[(size_t)r * 32 + u.pn * 4 + wc] = s;
            }
    }
};
}

namespace att {
typedef unsigned short u16;
using bf16x8 = __attribute__((ext_vector_type(8))) short;
using s16x4  = __attribute__((ext_vector_type(4))) short;
using f32x16 = __attribute__((ext_vector_type(16))) float;
using f32x4  = __attribute__((ext_vector_type(4))) float;
using u32x4  = __attribute__((ext_vector_type(4))) unsigned;
using u32x2  = __attribute__((ext_vector_type(2))) unsigned;
constexpr int SHM_V = 16384, SHM_K = 16384;
constexpr int OFF_V = 0, OFF_K = 2 * SHM_V, OFF_BIAS = 65536, OFF_FLAGS = 65536 + 2304, OFF_ITEM = OFF_FLAGS + 128, ATT_LDS = OFF_ITEM + 64;
constexpr float SB_DONE_LOG2 = -200.0f;
#define KSWZ(row, colB) ((row) * 256 + ((colB) ^ (((row) & 7) << 4)))
#define ATT_SBAR() __builtin_amdgcn_sched_barrier(0)
__device__ __forceinline__ int crow(int r, int hi) { return (r & 3) + 8 * (r >> 2) + 4 * hi; }
__device__ __forceinline__ unsigned cvtpk(float lo, float hi) { return pg8::cvt_pk_bf16(lo, hi); }
__device__ __forceinline__ int v_st(int k, int c) { const int kk = (k & ~0xC) | ((k & 4) << 1) | ((k & 8) >> 1); return ((kk >> 3) * 4 + (c >> 5)) * 512 + ((kk & 7) * 32 + (c & 31)) * 2; }
__device__ __forceinline__ int v_rd_base(int lane) { return ((lane & 3) << 3) | (((lane >> 2) & 3) << 6) | (((lane >> 4) & 1) << 5) | (((lane >> 5) & 1) << 8); }
constexpr int v_rd_off(int d0, int ks, int half) { return d0 * 512 + ks * 4096 + half * 2048; }
template <int OFF> __device__ __forceinline__ s16x4 tr_read(int vb) { s16x4 r; asm volatile("ds_read_b64_tr_b16 %0, %1 offset:%2" : "=&v"(r) : "v"(vb), "i"(OFF) : "memory"); return r; }

struct Item {
    int mode;
    int rule;
    const u16* Q; int ldq; int nq; int qpos0;
    const u16 *kb, *vb; int ldb; int pb_lo, pb_hi;
    const float *kf, *vf; int ldf; int pf_lo, pf_hi;
    int pv_lo, pv_hi;
    int kp_first, kp_step, ntiles;
    const float* bias;
    u16* O; int ldo; const u16* G; int ldg;
};

__device__ __forceinline__ void qkt(f32x16& p0, f32x16& p1, const char* Ks, const bf16x8* qr, int r32, int hi) {
    p0 = f32x16{}; p1 = f32x16{};
#pragma unroll
    for (int d0 = 0; d0 < 8; ++d0) { const int cb = (d0 * 16 + hi * 8) * 2;
        const bf16x8 b0 = *reinterpret_cast<const bf16x8*>(Ks + KSWZ(r32, cb));
        const bf16x8 b1 = *reinterpret_cast<const bf16x8*>(Ks + KSWZ(32 + r32, cb));
        p0 = __builtin_amdgcn_mfma_f32_32x32x16_bf16(b0, qr[d0], p0, 0, 0, 0);
        p1 = __builtin_amdgcn_mfma_f32_32x32x16_bf16(b1, qr[d0], p1, 0, 0, 0); }
}
template <int D0> __device__ __forceinline__ void pv_one(f32x16& od, int vb, bf16x8 pa0, bf16x8 pa1, bf16x8 pa2, bf16x8 pa3) {
    const s16x4 l0 = tr_read<v_rd_off(D0, 0, 0)>(vb), h0 = tr_read<v_rd_off(D0, 0, 1)>(vb), l1 = tr_read<v_rd_off(D0, 1, 0)>(vb), h1 = tr_read<v_rd_off(D0, 1, 1)>(vb);
    const s16x4 l2 = tr_read<v_rd_off(D0, 2, 0)>(vb), h2 = tr_read<v_rd_off(D0, 2, 1)>(vb), l3 = tr_read<v_rd_off(D0, 3, 0)>(vb), h3 = tr_read<v_rd_off(D0, 3, 1)>(vb);
    asm volatile("s_waitcnt lgkmcnt(0)" ::: "memory"); ATT_SBAR();
#define ATT_PK(L, H) (bf16x8){L[0], L[1], L[2], L[3], H[0], H[1], H[2], H[3]}
    od = __builtin_amdgcn_mfma_f32_32x32x16_bf16(ATT_PK(l0, h0), pa0, od, 0, 0, 0);
    od = __builtin_amdgcn_mfma_f32_32x32x16_bf16(ATT_PK(l1, h1), pa1, od, 0, 0, 0);
    od = __builtin_amdgcn_mfma_f32_32x32x16_bf16(ATT_PK(l2, h2), pa2, od, 0, 0, 0);
    od = __builtin_amdgcn_mfma_f32_32x32x16_bf16(ATT_PK(l3, h3), pa3, od, 0, 0, 0);
#undef ATT_PK
}
#define ATT_PK4(P, BASE, OUT) do { const unsigned a0_ = cvtpk(P[BASE + 0], P[BASE + 1]), a1_ = cvtpk(P[BASE + 2], P[BASE + 3]);   \
    const unsigned b0_ = cvtpk(P[BASE + 4], P[BASE + 5]), b1_ = cvtpk(P[BASE + 6], P[BASE + 7]);                              \
    auto r0_ = __builtin_amdgcn_permlane32_swap(a0_, b0_, false, false); auto r1_ = __builtin_amdgcn_permlane32_swap(a1_, b1_, false, false); \
    u32x4 w_ = {r0_[0], r1_[0], r0_[1], r1_[1]}; OUT = *reinterpret_cast<bf16x8*>(&w_); } while (0)

__device__ __forceinline__ void sb_half(f32x16& p, float& carry, bool need_mask, int kbase, int qpos, int pv_lo, int pv_hi, int hi) {
    float T[16];
#pragma unroll
    for (int r = 0; r < 16; ++r) {
        const float z = p[r];
        const float t = __builtin_amdgcn_exp2f(-__builtin_fabsf(z));
        const float l = __builtin_amdgcn_logf(1.0f + t);
        float lm = -(fmaxf(z, 0.f) + l);
        float lp = fminf(z, 0.f) - l;
        if (need_mask) { const int kp = kbase + crow(r, hi); const bool ok = (kp < qpos) && (kp >= pv_lo) && (kp < pv_hi); lm = ok ? lm : 0.f; lp = ok ? lp : -1e30f; }
        T[r] = lm; p[r] = lp;
    }
    float E[16], glo[4], ghi[4];
#pragma unroll
    for (int g = 0; g < 4; ++g) {
        E[4 * g + 3] = 0.f; E[4 * g + 2] = T[4 * g + 3]; E[4 * g + 1] = E[4 * g + 2] + T[4 * g + 2]; E[4 * g] = E[4 * g + 1] + T[4 * g + 1];
        const float gt = E[4 * g] + T[4 * g];
        auto rr = __builtin_amdgcn_permlane32_swap(__float_as_uint(gt), __float_as_uint(gt), false, false);
        glo[g] = __uint_as_float(rr[0]); ghi[g] = __uint_as_float(rr[1]);
    }
    float SG[4];
    SG[3] = 0.f; SG[2] = glo[3] + ghi[3]; SG[1] = SG[2] + (glo[2] + ghi[2]); SG[0] = SG[1] + (glo[1] + ghi[1]);
    const float tot = SG[0] + (glo[0] + ghi[0]);
#pragma unroll
    for (int g = 0; g < 4; ++g) SG[g] += carry + (hi == 0 ? ghi[g] : 0.f);
#pragma unroll
    for (int r = 0; r < 16; ++r) p[r] = __builtin_amdgcn_exp2f(p[r] + (SG[r >> 2] + E[r]));
    carry += tot;
}

template <int MODE>
__device__ __forceinline__ void run_item(const Item& it, char* lds, __attribute__((address_space(3))) unsigned char* ldsl) {
    const int tid = threadIdx.x, lane = tid & 63, r32 = lane & 31, hi = lane >> 5;
    const int wid = __builtin_amdgcn_readfirstlane(tid >> 6);
    char* V_lds = lds + OFF_V; char* K_lds = lds + OFF_K;
    float* biasT = (float*)(lds + OFF_BIAS);
    volatile __attribute__((address_space(3))) int* flags = (volatile __attribute__((address_space(3))) int*)(ldsl + OFF_FLAGS);
    const bool has_bias = (MODE == 1) && (it.bias != nullptr);
    if (has_bias) for (int i = tid; i < 513; i += 512) biasT[i] = it.bias[i] * LOG2E;
    const bool wave_rows = (32 * wid < it.nq);
    int qrow = 32 * wid + r32; if (qrow >= it.nq) qrow = it.nq - 1;
    const int qpos = it.qpos0 + 32 * wid + r32;
    bf16x8 qr[8];
    { const u16* Qw = it.Q + (size_t)qrow * it.ldq + hi * 8;
#pragma unroll
      for (int d0 = 0; d0 < 8; ++d0) qr[d0] = *reinterpret_cast<const bf16x8*>(Qw + d0 * 16); }
    f32x16 o[4]; o[0] = f32x16{}; o[1] = f32x16{}; o[2] = f32x16{}; o[3] = f32x16{};
    float carry = 0.f, m_reg = -1e30f, l_reg = 0.f;
    const int sr = tid >> 4, sc = (tid & 15) * 8;
    const int vst0 = v_st(sr, sc), vst1 = v_st(32 + sr, sc), kst0 = KSWZ(sr, sc * 2), kst1 = KSWZ(32 + sr, sc * 2);
    const int vb0 = (int)(uintptr_t)V_lds + v_rd_base(lane);
    f32x4 sK0a, sK0b, sK1a, sK1b, sV0a, sV0b, sV1a, sV1b;
#define ATT_LD(p, A, B, kbp, kfp) do { const int p_ = (p); \
        if (p_ >= it.pb_lo && p_ < it.pb_hi) { A = *reinterpret_cast<const f32x4*>(kbp + (size_t)(p_ - it.pb_lo) * it.ldb + sc); } \
        else if (p_ >= it.pf_lo && p_ < it.pf_hi) { const float* s_ = kfp + (size_t)(p_ - it.pf_lo) * it.ldf + sc; A = *reinterpret_cast<const f32x4*>(s_); B = *reinterpret_cast<const f32x4*>(s_ + 4); } \
        else { A = (f32x4){0.f, 0.f, 0.f, 0.f}; } } while (0)
#define ATT_CV(p, A, B, OUT) do { const int p_ = (p); \
        if (p_ >= it.pf_lo && p_ < it.pf_hi) { u32x4 w_ = {cvtpk(A[0], A[1]), cvtpk(A[2], A[3]), cvtpk(B[0], B[1]), cvtpk(B[2], B[3])}; OUT = *reinterpret_cast<bf16x8*>(&w_); } \
        else { f32x4 a_ = A; OUT = *reinterpret_cast<bf16x8*>(&a_); } } while (0)
#define ATT_SLOAD(kp0) do { ATT_LD((kp0) + sr, sK0a, sK0b, it.kb, it.kf); ATT_LD((kp0) + 32 + sr, sK1a, sK1b, it.kb, it.kf); \
        ATT_LD((kp0) + sr, sV0a, sV0b, it.vb, it.vf); ATT_LD((kp0) + 32 + sr, sV1a, sV1b, it.vb, it.vf); } while (0)
#define ATT_SWRITE(b, kp0) do { bf16x8 t_; \
        ATT_CV((kp0) + sr, sK0a, sK0b, t_); *reinterpret_cast<bf16x8*>(K_lds + (b) * SHM_K + kst0) = t_; \
        ATT_CV((kp0) + 32 + sr, sK1a, sK1b, t_); *reinterpret_cast<bf16x8*>(K_lds + (b) * SHM_K + kst1) = t_; \
        ATT_CV((kp0) + sr, sV0a, sV0b, t_); *reinterpret_cast<bf16x8*>(V_lds + (b) * SHM_V + vst0) = t_; \
        ATT_CV((kp0) + 32 + sr, sV1a, sV1b, t_); *reinterpret_cast<bf16x8*>(V_lds + (b) * SHM_V + vst1) = t_; } while (0)
    sK0b = sK1b = sV0b = sV1b = (f32x4){0.f, 0.f, 0.f, 0.f};
    const int nt = it.ntiles;
    ATT_SLOAD(it.kp_first); ATT_SWRITE(0, it.kp_first);
    __syncthreads();
    bool wdone = !wave_rows;
    for (int j = 0; j < nt; ++j) {
        const int kp0 = it.kp_first + j * it.kp_step, kpn = kp0 + it.kp_step, cur = j & 1;
        const bool more = (j + 1 < nt);
        if (more) ATT_SLOAD(kpn);
        bool active = wave_rows;
        if (it.rule == 1) active = active && (kp0 <= it.qpos0 + 32 * wid + 30) && !wdone;
        if (it.rule == 2) { const int ct = kp0 >> 6, cw = (it.qpos0 + 32 * wid) >> 6; active = active && (ct >= cw - 8) && (ct <= cw); }
        if (active) {
            f32x16 p0, p1;
            qkt(p0, p1, K_lds + cur * SHM_K, qr, r32, hi);
            bool need_mask = (kp0 < it.pv_lo) || (kp0 + 64 > it.pv_hi);
            if (MODE == 0) {
                need_mask = need_mask || (kp0 + 63 >= it.qpos0 + 32 * wid);
                sb_half(p1, carry, need_mask, kp0 + 32, qpos, it.pv_lo, it.pv_hi, hi);
                sb_half(p0, carry, need_mask, kp0, qpos, it.pv_lo, it.pv_hi, hi);
            } else {
                if (has_bias) {
#pragma unroll
                    for (int r = 0; r < 16; ++r) { const int kp = kp0 + crow(r, hi);
                        int d0_ = qpos - kp; d0_ = d0_ < -256 ? -256 : (d0_ > 256 ? 256 : d0_);
                        int d1_ = qpos - kp - 32; d1_ = d1_ < -256 ? -256 : (d1_ > 256 ? 256 : d1_);
                        p0[r] += biasT[d0_ + 256]; p1[r] += biasT[d1_ + 256]; }
                }
                if (need_mask) {
#pragma unroll
                    for (int r = 0; r < 16; ++r) { const int kp = kp0 + crow(r, hi);
                        if (!(kp >= it.pv_lo && kp < it.pv_hi)) p0[r] = -1e30f;
                        if (!(kp + 32 >= it.pv_lo && kp + 32 < it.pv_hi)) p1[r] = -1e30f; }
                }
                float pmax = p0[0];
#pragma unroll
                for (int r = 1; r < 16; ++r) pmax = fmaxf(pmax, p0[r]);
#pragma unroll
                for (int r = 0; r < 16; ++r) pmax = fmaxf(pmax, p1[r]);
                { auto rr = __builtin_amdgcn_permlane32_swap(__float_as_uint(pmax), __float_as_uint(pmax), false, false); pmax = fmaxf(__uint_as_float(rr[0]), __uint_as_float(rr[1])); }
                const float mn = fmaxf(m_reg, pmax);
                const float alpha = __builtin_amdgcn_exp2f(m_reg - mn); m_reg = mn;
                float ps = 0.f;
#pragma unroll
                for (int r = 0; r < 16; ++r) { p0[r] = __builtin_amdgcn_exp2f(p0[r] - mn); ps += p0[r]; }
#pragma unroll
                for (int r = 0; r < 16; ++r) { p1[r] = __builtin_amdgcn_exp2f(p1[r] - mn); ps += p1[r]; }
                { auto rr = __builtin_amdgcn_permlane32_swap(__float_as_uint(ps), __float_as_uint(ps), false, false); ps = __uint_as_float(rr[0]) + __uint_as_float(rr[1]); }
                l_reg = l_reg * alpha + ps;
                if (__any(alpha < 1.f)) {
#pragma unroll
                    for (int d = 0; d < 4; ++d)
#pragma unroll
                        for (int r = 0; r < 16; ++r) o[d][r] *= alpha; }
            }
            bf16x8 pa0, pa1, pa2, pa3;
            ATT_PK4(p0, 0, pa0); ATT_PK4(p0, 8, pa1); ATT_PK4(p1, 0, pa2); ATT_PK4(p1, 8, pa3);
            const int vb = vb0 + cur * SHM_V;
            pv_one<0>(o[0], vb, pa0, pa1, pa2, pa3); pv_one<1>(o[1], vb, pa0, pa1, pa2, pa3); pv_one<2>(o[2], vb, pa0, pa1, pa2, pa3); pv_one<3>(o[3], vb, pa0, pa1, pa2, pa3);
        }
        if (MODE == 0 && SB_EARLY_EXIT) {
            if (wave_rows && !wdone) { const bool rowdone = (carry < SB_DONE_LOG2) || (32 * wid + r32 >= it.nq); wdone = __all(rowdone); }
            if (lane == 0) flags[cur * 8 + wid] = wdone ? 1 : 0;
        }
        if (more) ATT_SWRITE(cur ^ 1, kpn);
        __syncthreads();
        if (MODE == 0 && SB_EARLY_EXIT) {
            int alld = 1;
#pragma unroll
            for (int w = 0; w < 8; ++w) alld &= flags[cur * 8 + w];
            if (alld) break;
        }
    }
    if (wave_rows && (32 * wid + r32) < it.nq) {
        const float inv = (MODE == 1) ? __builtin_amdgcn_rcpf(l_reg) : 1.0f;
        const size_t row = (size_t)(32 * wid + r32);
        u16* orow = it.O + row * it.ldo + 4 * hi; const u16* grow = it.G + row * it.ldg + 4 * hi;
#pragma unroll
        for (int d0 = 0; d0 < 4; ++d0)
#pragma unroll
            for (int g = 0; g < 4; ++g) {
                const u32x2 gv = *reinterpret_cast<const u32x2*>(grow + 32 * d0 + 8 * g);
                const float g0 = __uint_as_float(gv.x << 16), g1 = __uint_as_float(gv.x & 0xffff0000u), g2 = __uint_as_float(gv.y << 16), g3 = __uint_as_float(gv.y & 0xffff0000u);
                u32x2 w; w.x = cvtpk(o[d0][4 * g] * inv * g0, o[d0][4 * g + 1] * inv * g1); w.y = cvtpk(o[d0][4 * g + 2] * inv * g2, o[d0][4 * g + 3] * inv * g3);
                *reinterpret_cast<u32x2*>(orow + 32 * d0 + 8 * g) = w; }
    }
    __syncthreads();
#undef ATT_LD
#undef ATT_CV
#undef ATT_SLOAD
#undef ATT_SWRITE
}
}

constexpr int NWAVES = 8;
constexpr int N_LAUNCHES = MK_N_LAUNCHES;
constexpr int PER_PHASE = 6;

constexpr size_t al256(size_t x) { return (x + 255) & ~(size_t)255; }
constexpr size_t WS_CTL = 0, CTL_ZERO_BYTES = 1u << 20;
constexpr size_t WS_WCAT = CTL_ZERO_BYTES;
constexpr size_t WS_WUP  = WS_WCAT + (size_t)NCAT * DM * 2;
constexpr size_t WS_WOUT = WS_WUP + (size_t)DM * DM * 2;
constexpr size_t WS_ACAT = WS_WOUT + (size_t)DM * DM * 2;
constexpr size_t SZ768 = (size_t)MIN_ * 768 * 2, SZ512 = (size_t)MIN_ * 512 * 2;
constexpr size_t WS_QSB = WS_ACAT + (size_t)MA * DM * 2, WS_KSB = WS_QSB + SZ768, WS_VSB = WS_KSB + SZ768, WS_GSB = WS_VSB + SZ768;
constexpr size_t WS_QBD = WS_GSB + SZ768, WS_KBD = WS_QBD + SZ768, WS_VBD = WS_KBD + SZ768, WS_GBD = WS_VBD + SZ768;
constexpr size_t WS_QMM = WS_GBD + SZ768, WS_GMM = WS_QMM + SZ512;
constexpr size_t WS_MG  = WS_GMM + SZ512;
constexpr size_t WS_MK  = WS_MG + (size_t)MIN_ * 6144 * 2, WS_MV = WS_MK + (size_t)512 * 512 * 2;
constexpr size_t WS_AUP = WS_MV + (size_t)512 * 512 * 2;
constexpr size_t WS_SSQ = WS_AUP + (size_t)MIN_ * DM * 2;
constexpr size_t WS_END = WS_SSQ + (size_t)MIN_ * 32 * 4;
static_assert(WS_WCAT % 256 == 0 && WS_QSB % 256 == 0 && WS_MG % 256 == 0 && WS_AUP % 256 == 0 && WS_SSQ % 256 == 0, "alignment");
constexpr int CW_TMO = 0, CW_WORK = 64, CW_BAR = 4096;
constexpr int OUT_ELEMS = 32112640;

constexpr int RING_BYTES = 131072, LDSCTL_OFF = RING_BYTES, MISC_OFF = LDSCTL_OFF + 320, LDS_BYTES = 147456;
static_assert(att::ATT_LDS <= RING_BYTES, "attention scratch inside the ring region");

#define GAS __attribute__((address_space(1)))
#define LAS __attribute__((address_space(3)))
typedef unsigned short bf16;
typedef unsigned v4u __attribute__((ext_vector_type(4)));
typedef float f32x4 __attribute__((ext_vector_type(4)));
typedef GAS unsigned gu32;
#define RLX_AGENT __ATOMIC_RELAXED, __HIP_MEMORY_SCOPE_AGENT
#define LDS_WAIT() asm volatile("s_waitcnt lgkmcnt(0)" ::: "memory")
__device__ __forceinline__ unsigned pk2(float lo, float hi) { return pg8::cvt_pk_bf16(lo, hi); }

#define XB_TMO      128
#define XB_XCNT(j)  (256  + 64 * (j))
#define XB_XSUB(j)  (1280 + 64 * (j))
#define XB_XGEN(j)  (2304 + 64 * (j))
#define XB_TOP      3328
#define XB_TOPGEN   3392
#define XCD_BAR_WORDS 3456
#define XB_SPIN_CAP (1u << 18)
__device__ __forceinline__ unsigned xb_ld(unsigned* p)              { return __hip_atomic_load(p, __ATOMIC_RELAXED, __HIP_MEMORY_SCOPE_AGENT); }
__device__ __forceinline__ unsigned xb_add(unsigned* p, unsigned v) { return __hip_atomic_fetch_add(p, v, __ATOMIC_RELAXED, __HIP_MEMORY_SCOPE_AGENT); }
__device__ __forceinline__ unsigned xb_xcc_id() { return (unsigned)__builtin_amdgcn_s_getreg((3 << 11) | 20) & 0xFu; }
#define XB_SPIN(cond, bar) do { unsigned _sp = 0; while (cond) { __builtin_amdgcn_s_sleep(1); \
    if ((++_sp & 255u) == 0u) { if (xb_ld(&(bar)[XB_TMO])) break; if (_sp > XB_SPIN_CAP) { atomicAdd(&(bar)[XB_TMO], 1u); break; } } } } while (0)
struct XcdBarrier { unsigned* bar; unsigned x; volatile LAS unsigned* st; };
__device__ __forceinline__ XcdBarrier xcd_barrier_post(unsigned* bar, volatile LAS unsigned* st) {
    XcdBarrier b; b.bar = bar; b.x = xb_xcc_id(); b.st = st;
    if (threadIdx.x == 0) (void)xb_add(&bar[XB_XCNT(b.x)], 1u);
    return b;
}
__device__ __forceinline__ void xcd_barrier_complete(unsigned* bar, unsigned x, unsigned& nloc, unsigned& nx) {
    const unsigned G = gridDim.x * gridDim.y * gridDim.z;
    unsigned sum, cnt, mine, sp = 0u;
    for (;;) {
        sum = 0u; cnt = 0u; mine = 0u;
#pragma unroll
        for (unsigned j = 0; j < 16; ++j) { const unsigned c = xb_ld(&bar[XB_XCNT(j)]); sum += c; cnt += (c > 0u) ? 1u : 0u; mine = (j == x) ? c : mine; }
        if (sum == G) break;
        __builtin_amdgcn_s_sleep(1);
        if ((++sp & 255u) == 0u) { if (xb_ld(&bar[XB_TMO])) break; if (sp > XB_SPIN_CAP) { atomicAdd(&bar[XB_TMO], 1u); break; } }
    }
    nloc = mine > 0u ? mine : 1u; nx = cnt > 0u ? cnt : 1u;
}
__device__ __forceinline__ void xcd_barrier(const XcdBarrier& b) {
    asm volatile("s_waitcnt vmcnt(0)" ::: "memory");
    __syncthreads();
    if (threadIdx.x == 0) {
        unsigned* bar = b.bar;
        __builtin_amdgcn_s_waitcnt(0);
        unsigned nloc = b.st[0], nx = b.st[1];
        if (nloc == 0u) { xcd_barrier_complete(bar, b.x, nloc, nx); b.st[0] = nloc; b.st[1] = nx; }
        const unsigned old = xb_add(&bar[XB_XSUB(b.x)], 1u);
        const unsigned gen = old / nloc;
        if (old + 1u == (gen + 1u) * nloc) {
            __builtin_amdgcn_fence(__ATOMIC_RELEASE, "agent");
            asm volatile("s_waitcnt vmcnt(0)" ::: "memory");
            const unsigned og = xb_add(&bar[XB_TOP], 1u);
            const unsigned tg = og / nx;
            if (og + 1u == (tg + 1u) * nx) xb_add(&bar[XB_TOPGEN], 1u);
            else XB_SPIN(xb_ld(&bar[XB_TOPGEN]) == tg, bar);
            __builtin_amdgcn_fence(__ATOMIC_ACQUIRE, "agent");
            xb_add(&bar[XB_XGEN(b.x)], 1u);
            asm volatile("s_waitcnt vmcnt(0)" ::: "memory");
        } else {
            XB_SPIN(xb_ld(&bar[XB_XGEN(b.x)]) == gen, bar);
            __builtin_amdgcn_fence(__ATOMIC_ACQUIRE, "agent");
            asm volatile("s_waitcnt vmcnt(0)" ::: "memory");
        }
    }
    __syncthreads();
}

struct Frame {
    LAS unsigned char* lds;
    volatile LAS unsigned* MISC;
    gu32* ctl;
    int vcu, G;
    const float *x_prompt, *x_sample, *c_sbk, *c_sbv, *c_bdk, *c_bdv, *c_mk, *c_mv, *mem_prompt, *g_pre, *w_in, *rel_bias, *g_mem, *w_mem_kv, *w_up_sb, *w_up_band, *w_up_mem, *w_out, *g_post;
    float* out;
    bf16 *WCAT, *WUP, *WOUT, *ACAT, *QSB, *KSB, *VSB, *GSB, *QBD, *KBD, *VBD, *GBD, *QMM, *GMM, *MG, *MK, *MV, *AUP, *MERGED;
    float* SSQ;
};

__device__ __forceinline__ int fresh_tid() { int t = threadIdx.x; asm volatile("" : "+v"(t)); return t; }
__device__ __forceinline__ float wave_sum(float v) {
#pragma unroll
    for (int o = 1; o < 64; o <<= 1) v += __shfl_xor(v, o);
    return v;
}
__device__ __forceinline__ void p0_transpose_item(const float* W, int N, bf16* WT, int ldt, int row_off, int col_off, LAS float* scr, int item, int lane) {
    const int nblk = N / 32, kb = item / nblk, nb = item % nblk, k0 = 64 * kb, n0 = 32 * nb;
#pragma unroll 8
    for (int i = 0; i < 32; ++i) { const int kk = 2 * i + (lane >> 5); scr[kk * 33 + (lane & 31)] = W[(size_t)(k0 + kk) * N + n0 + (lane & 31)]; }
    LDS_WAIT(); asm volatile("" ::: "memory");
    const int c = lane & 7;
#pragma unroll
    for (int j = 0; j < 4; ++j) { const int n = (lane >> 3) + 8 * j; const LAS float* s = scr + (8 * c) * 33 + n;
        v4u o; o.x = pk2(s[0 * 33], s[1 * 33]); o.y = pk2(s[2 * 33], s[3 * 33]); o.z = pk2(s[4 * 33], s[5 * 33]); o.w = pk2(s[6 * 33], s[7 * 33]);
        *(GAS v4u*)(WT + (size_t)(row_off + n0 + n) * ldt + col_off + k0 + 8 * c) = o; }
    LDS_WAIT(); asm volatile("" ::: "memory");
}
__device__ __forceinline__ void rms_row_to_bf16(const float* xrow, const float* g, bf16* orow, int lane) {
    const GAS f32x4* xr = (const GAS f32x4*)xrow + lane; const GAS f32x4* gr = (const GAS f32x4*)g + lane;
    f32x4 v[8]; float s = 0.f;
#pragma unroll
    for (int j = 0; j < 8; ++j) { v[j] = xr[64 * j]; s += (v[j].x * v[j].x + v[j].y * v[j].y) + (v[j].z * v[j].z + v[j].w * v[j].w); }
    const float r = 1.0f / sqrtf(wave_sum(s) * (1.0f / DM) + RMS_EPS);
    GAS unsigned long long* o8 = (GAS unsigned long long*)orow + lane;
#pragma unroll
    for (int j = 0; j < 8; ++j) { const f32x4 gv = gr[64 * j];
        o8[64 * j] = (unsigned long long)pk2(v[j].x * r * gv.x, v[j].y * r * gv.y) | ((unsigned long long)pk2(v[j].z * r * gv.z, v[j].w * r * gv.w) << 32); }
}
__device__ __forceinline__ void p0_prologue(Frame& F) {
    const int tid_ = fresh_tid(), lane_ = tid_ & 63, wave_ = __builtin_amdgcn_readfirstlane(tid_ >> 6);
    LAS float* scr = (LAS float*)(F.lds + wave_ * 16384);
    const int gw = F.vcu * NWAVES + wave_, NGW = F.G * NWAVES;
    constexpr int I_IN = 32 * (INW / 32), I_MEM = 32 * (1024 / 32), I_USB = 12 * 64, I_UBD = 12 * 64, I_UMM = 8 * 64, I_OUT = 32 * 64;
    constexpr int NITEMS = I_IN + I_MEM + I_USB + I_UBD + I_UMM + I_OUT;
    for (int it = gw; it < NITEMS; it += NGW) {
        int r = it;
        if (r < I_IN)  { p0_transpose_item(F.w_in, INW, F.WCAT, DM, 0, 0, scr, r, lane_); continue; } r -= I_IN;
        if (r < I_MEM) { p0_transpose_item(F.w_mem_kv, 1024, F.WCAT, DM, INW, 0, scr, r, lane_); continue; } r -= I_MEM;
        if (r < I_USB) { p0_transpose_item(F.w_up_sb, DM, F.WUP, DM, 0, 0, scr, r, lane_); continue; } r -= I_USB;
        if (r < I_UBD) { p0_transpose_item(F.w_up_band, DM, F.WUP, DM, 0, 768, scr, r, lane_); continue; } r -= I_UBD;
        if (r < I_UMM) { p0_transpose_item(F.w_up_mem, DM, F.WUP, DM, 0, 1536, scr, r, lane_); continue; } r -= I_UMM;
        p0_transpose_item(F.w_out, DM, F.WOUT, DM, 0, 0, scr, r, lane_);
    }
    for (int m = gw; m < MA; m += NGW) {
        bf16* orow = F.ACAT + (size_t)m * DM;
        if (m < MP) rms_row_to_bf16(F.x_prompt + (size_t)m * DM, F.g_pre, orow, lane_);
        else if (m < MREAL) rms_row_to_bf16(F.x_sample + (size_t)(m - MP) * DM, F.g_pre, orow, lane_);
        else if (m < MIN_) {
            GAS v4u* o = (GAS v4u*)orow + lane_; GAS v4u* o2 = (GAS v4u*)(F.AUP + (size_t)m * DM) + lane_;
#pragma unroll
            for (int j = 0; j < 4; ++j) { o[64 * j] = (v4u){0u, 0u, 0u, 0u}; o2[64 * j] = (v4u){0u, 0u, 0u, 0u}; }
        }
        else rms_row_to_bf16(F.mem_prompt + (size_t)(m - MMEM0) * DM, F.g_mem, orow, lane_);
    }
}
__device__ __forceinline__ void p5_final(Frame& F) {
    const int tid_ = fresh_tid(), lane_ = tid_ & 63, wave_ = __builtin_amdgcn_readfirstlane(tid_ >> 6);
    const int gw = F.vcu * NWAVES + wave_, NGW = F.G * NWAVES;
    for (int m = gw; m < MREAL; m += NGW) {
        float s = (lane_ < 32) ? F.SSQ[(size_t)m * 32 + lane_] : 0.f;
        s = wave_sum(s);
        const float r = 1.0f / sqrtf(s * (1.0f / DM) + RMS_EPS);
        float* yrow = (m < MP) ? F.out + (size_t)m * DM : F.out + (size_t)16777216 + (size_t)(m - MP) * DM;
        const float* xrow = (m < MP) ? F.x_prompt + (size_t)m * DM : F.x_sample + (size_t)(m - MP) * DM;
        GAS f32x4* y4 = (GAS f32x4*)yrow + lane_; const GAS f32x4* x4 = (const GAS f32x4*)xrow + lane_; const GAS f32x4* g4 = (const GAS f32x4*)F.g_post + lane_;
#pragma unroll
        for (int j = 0; j < 8; ++j) { const f32x4 yv = y4[64 * j], xv = x4[64 * j], gv = g4[64 * j]; y4[64 * j] = xv + yv * r * gv; }
    }
}

constexpr int IT_BDP = 192, IT_BDS = 48, IT_SBP = 192, IT_SBS = 48, IT_MMP = 128, IT_MMS = 32;
constexpr int IT_TOTAL = IT_BDP + IT_BDS + IT_SBP + IT_SBS + IT_MMP + IT_MMS;
__device__ __forceinline__ att::Item make_item(const Frame& F, int idx) {
    att::Item it; it.bias = nullptr; it.kf = nullptr; it.vf = nullptr; it.ldf = 0; it.pf_lo = 0; it.pf_hi = 0; it.kb = nullptr; it.vb = nullptr; it.ldb = 0; it.pb_lo = 0; it.pb_hi = 0;
    if (idx < IT_BDP) {
        const int b = idx / 96, h = (idx / 16) % 6, cg = idx % 16; const size_t row0 = (size_t)b * SEQ + 256 * cg;
        it.mode = 1; it.rule = 2; it.Q = F.QBD + row0 * 768 + h * HD; it.ldq = 768; it.nq = 256; it.qpos0 = 256 * cg;
        it.kb = F.KBD + (size_t)b * SEQ * 768 + h * HD; it.vb = F.VBD + (size_t)b * SEQ * 768 + h * HD; it.ldb = 768; it.pb_lo = 0; it.pb_hi = SEQ;
        it.pv_lo = 0; it.pv_hi = SEQ; const int c_lo = (4 * cg - 8) > 0 ? (4 * cg - 8) : 0;
        it.kp_first = 64 * c_lo; it.kp_step = 64; it.ntiles = 4 * cg + 4 - c_lo; it.bias = F.rel_bias + h * 513;
        it.O = F.AUP + row0 * DM + 768 + h * HD; it.ldo = DM; it.G = F.GBD + row0 * 768 + h * HD; it.ldg = 768; return it; }
    idx -= IT_BDP;
    if (idx < IT_BDS) {
        const int b = idx / 6, h = idx % 6; const size_t row0 = (size_t)MP + b * DS;
        it.mode = 1; it.rule = 0; it.Q = F.QBD + row0 * 768 + h * HD; it.ldq = 768; it.nq = DS; it.qpos0 = PAST;
        it.kb = F.KBD + row0 * 768 + h * HD; it.vb = F.VBD + row0 * 768 + h * HD; it.ldb = 768; it.pb_lo = PAST; it.pb_hi = PAST + DS;
        it.kf = F.c_bdk + (size_t)b * 512 * 768 + h * HD; it.vf = F.c_bdv + (size_t)b * 512 * 768 + h * HD; it.ldf = 768; it.pf_lo = PAST - 512; it.pf_hi = PAST;
        it.pv_lo = PAST - 512; it.pv_hi = PAST + DS; it.kp_first = PAST - 512; it.kp_step = 64; it.ntiles = 9; it.bias = F.rel_bias + h * 513;
        it.O = F.AUP + row0 * DM + 768 + h * HD; it.ldo = DM; it.G = F.GBD + row0 * 768 + h * HD; it.ldg = 768; return it; }
    idx -= IT_BDS;
    if (idx < IT_SBP) {
        const int b = idx % 2, h = (idx / 2) % 6, qb = 15 - idx / 12; const size_t row0 = (size_t)b * SEQ + 256 * qb;
        it.mode = 0; it.rule = 1; it.Q = F.QSB + row0 * 768 + h * HD; it.ldq = 768; it.nq = 256; it.qpos0 = 256 * qb;
        it.kb = F.KSB + (size_t)b * SEQ * 768 + h * HD; it.vb = F.VSB + (size_t)b * SEQ * 768 + h * HD; it.ldb = 768; it.pb_lo = 0; it.pb_hi = SEQ;
        it.pv_lo = 0; it.pv_hi = SEQ; it.kp_first = 64 * (4 * qb + 3); it.kp_step = -64; it.ntiles = 4 * qb + 4;
        it.O = F.AUP + row0 * DM + h * HD; it.ldo = DM; it.G = F.GSB + row0 * 768 + h * HD; it.ldg = 768; return it; }
    idx -= IT_SBP;
    if (idx < IT_SBS) {
        const int b = idx / 6, h = idx % 6; const size_t row0 = (size_t)MP + b * DS;
        it.mode = 0; it.rule = 1; it.Q = F.QSB + row0 * 768 + h * HD; it.ldq = 768; it.nq = DS; it.qpos0 = PAST;
        it.kb = F.KSB + row0 * 768 + h * HD; it.vb = F.VSB + row0 * 768 + h * HD; it.ldb = 768; it.pb_lo = PAST; it.pb_hi = PAST + DS;
        it.kf = F.c_sbk + (size_t)b * PAST * 768 + h * HD; it.vf = F.c_sbv + (size_t)b * PAST * 768 + h * HD; it.ldf = 768; it.pf_lo = 0; it.pf_hi = PAST;
        it.pv_lo = 0; it.pv_hi = PAST + DS; it.kp_first = PAST + DS - 64; it.kp_step = -64; it.ntiles = (PAST + DS + 63) / 64;
        it.O = F.AUP + row0 * DM + h * HD; it.ldo = DM; it.G = F.GSB + row0 * 768 + h * HD; it.ldg = 768; return it; }
    idx -= IT_SBS;
    if (idx < IT_MMP) {
        const int b = idx / 64, h = (idx / 16) % 4, qb = idx % 16; const size_t row0 = (size_t)b * SEQ + 256 * qb;
        it.mode = 1; it.rule = 0; it.Q = F.QMM + row0 * 512 + h * HD; it.ldq = 512; it.nq = 256; it.qpos0 = 0;
        it.kb = F.MK + (size_t)b * NMEM * 512 + h * HD; it.vb = F.MV + (size_t)b * NMEM * 512 + h * HD; it.ldb = 512; it.pb_lo = 0; it.pb_hi = NMEM;
        it.pv_lo = 0; it.pv_hi = NMEM; it.kp_first = 0; it.kp_step = 64; it.ntiles = 4;
        it.O = F.AUP + row0 * DM + 1536 + h * HD; it.ldo = DM; it.G = F.GMM + row0 * 512 + h * HD; it.ldg = 512; return it; }
    idx -= IT_MMP;
    {
        const int b = idx / 4, h = idx % 4; const size_t row0 = (size_t)MP + b * DS;
        it.mode = 1; it.rule = 0; it.Q = F.QMM + row0 * 512 + h * HD; it.ldq = 512; it.nq = DS; it.qpos0 = 0;
        it.kf = F.c_mk + (size_t)b * NMEM * 512 + h * HD; it.vf = F.c_mv + (size_t)b * NMEM * 512 + h * HD; it.ldf = 512; it.pf_lo = 0; it.pf_hi = NMEM;
        it.pv_lo = 0; it.pv_hi = NMEM; it.kp_first = 0; it.kp_step = 64; it.ntiles = 4;
        it.O = F.AUP + row0 * DM + 1536 + h * HD; it.ldo = DM; it.G = F.GMM + row0 * 512 + h * HD; it.ldg = 512; return it; }
}

struct Args { const void* in[19]; float* out; unsigned char* ws; int ph_lo, ph_hi; };
__global__ void __launch_bounds__(NWAVES * 64, 2) fwd_megakernel(Args args) {
    extern __shared__ __attribute__((aligned(16))) unsigned char lds[];
    Frame F;
    F.lds = (LAS unsigned char*)lds;
    F.MISC = (volatile LAS unsigned*)(F.lds + MISC_OFF);
    F.G = gridDim.x; { const int bx = blockIdx.x; F.vcu = (F.G % 8 == 0) ? (bx % 8) * (F.G / 8) + bx / 8 : bx; }
    unsigned char* ws = args.ws;
    F.ctl = (gu32*)(ws + WS_CTL);
    F.x_prompt = (const float*)args.in[0]; F.x_sample = (const float*)args.in[1]; F.c_sbk = (const float*)args.in[2]; F.c_sbv = (const float*)args.in[3];
    F.c_bdk = (const float*)args.in[4]; F.c_bdv = (const float*)args.in[5]; F.c_mk = (const float*)args.in[6]; F.c_mv = (const float*)args.in[7];
    F.mem_prompt = (const float*)args.in[8]; F.g_pre = (const float*)args.in[9]; F.w_in = (const float*)args.in[10]; F.rel_bias = (const float*)args.in[11];
    F.g_mem = (const float*)args.in[12]; F.w_mem_kv = (const float*)args.in[13]; F.w_up_sb = (const float*)args.in[14]; F.w_up_band = (const float*)args.in[15];
    F.w_up_mem = (const float*)args.in[16]; F.w_out = (const float*)args.in[17]; F.g_post = (const float*)args.in[18];
    F.out = args.out;
    F.WCAT = (bf16*)(ws + WS_WCAT); F.WUP = (bf16*)(ws + WS_WUP); F.WOUT = (bf16*)(ws + WS_WOUT); F.ACAT = (bf16*)(ws + WS_ACAT); F.MERGED = (bf16*)(ws + WS_ACAT);
    F.QSB = (bf16*)(ws + WS_QSB); F.KSB = (bf16*)(ws + WS_KSB); F.VSB = (bf16*)(ws + WS_VSB); F.GSB = (bf16*)(ws + WS_GSB);
    F.QBD = (bf16*)(ws + WS_QBD); F.KBD = (bf16*)(ws + WS_KBD); F.VBD = (bf16*)(ws + WS_VBD); F.GBD = (bf16*)(ws + WS_GBD);
    F.QMM = (bf16*)(ws + WS_QMM); F.GMM = (bf16*)(ws + WS_GMM); F.MG = (bf16*)(ws + WS_MG); F.MK = (bf16*)(ws + WS_MK); F.MV = (bf16*)(ws + WS_MV);
    F.AUP = (bf16*)(ws + WS_AUP); F.SSQ = (float*)(ws + WS_SSQ);
    for (int u = threadIdx.x; u < (LDS_BYTES - LDSCTL_OFF) / 4; u += NWAVES * 64) ((LAS unsigned*)(F.lds + LDSCTL_OFF))[u] = 0u;
    __syncthreads();
    XcdBarrier bar; bar.bar = (unsigned*)(F.ctl + CW_BAR); bar.x = 0; bar.st = nullptr;
    if (N_LAUNCHES != PER_PHASE) bar = xcd_barrier_post((unsigned*)(F.ctl + CW_BAR), F.MISC + 8);
#define GRID_BAR() do { if (N_LAUNCHES != PER_PHASE) xcd_barrier(bar); } while (0)
    const int lo = args.ph_lo, hi = args.ph_hi;
#ifdef ONLY_PHASE
#define IN(k) ((k) == ONLY_PHASE && lo <= (k) && (k) < hi)
#else
#define IN(k) (lo <= (k) && (k) < hi)
#endif
#define BOTH(k) (IN(k) && IN((k) + 1))

    if (IN(0)) { p0_prologue(F); if (BOTH(0)) GRID_BAR(); }

    if (IN(1)) {
        pg8::Gemm g{F.ACAT, F.WCAT, MA, NCAT, DM}; ep::InOrder S; S.init(F.G, (int)blockIdx.x);
        ep::EpiIn E{F.QSB, F.KSB, F.VSB, F.GSB, F.QBD, F.KBD, F.VBD, F.GBD, F.QMM, F.GMM, F.MG, F.MK, F.MV, F.out};
        pg8::gemm_phase<ep::EpiIn, ep::InOrder, true, true>(F.lds, g, S, E);
        if (BOTH(1)) GRID_BAR();
    }

    if (IN(2)) {
        volatile LAS int* slot = (volatile LAS int*)(F.lds + att::OFF_ITEM);
        for (;;) {
            if (threadIdx.x == 0) *slot = (int)__hip_atomic_fetch_add((unsigned*)(F.ctl + CW_WORK), 1u, RLX_AGENT);
            __syncthreads();
            const int idx = __builtin_amdgcn_readfirstlane(*slot);
            __syncthreads();
            if (idx >= IT_TOTAL) break;
            const att::Item it = make_item(F, idx);
            if (it.mode == 0) att::run_item<0>(it, (char*)lds, F.lds); else att::run_item<1>(it, (char*)lds, F.lds);
        }
        if (BOTH(2)) GRID_BAR();
    }

    if (IN(3)) {
        pg8::Gemm g{F.AUP, F.WUP, MIN_, DM, DM}; ep::MergeOrder S; S.init(F.G, (int)blockIdx.x);
        ep::EpiMerge E{F.MG, F.MERGED};
        pg8::gemm_phase<ep::EpiMerge, ep::MergeOrder, true, true>(F.lds, g, S, E);
        if (BOTH(3)) GRID_BAR();
    }

    if (IN(4)) {
        pg8::Gemm g{F.MERGED, F.WOUT, MIN_, DM, DM}; pg8::StaticOrder S; S.init(MIN_, DM, F.G, (int)blockIdx.x);
        ep::EpiOut E{F.out, F.SSQ};
        pg8::gemm_phase<ep::EpiOut, pg8::StaticOrder, true, true>(F.lds, g, S, E);
        if (BOTH(4)) GRID_BAR();
    }

    if (IN(5)) p5_final(F);
#undef IN
#undef BOTH
#undef GRID_BAR
}

extern "C" void kernel_launch(void* const* d_in, const int* in_sizes, int n_in, void* d_out, int out_size, void* d_ws, size_t ws_size, hipStream_t stream) {
    static int grid = 0;
    if (grid == 0) {
        if (n_in != 19 || in_sizes[0] != MP * DM || in_sizes[10] != DM * INW || out_size != OUT_ELEMS || ws_size < WS_END) {
            fprintf(stderr, "kernel_launch: built for 19 inputs, x_prompt %d, w_in %d, out %d floats, >= %zu bytes of workspace; got n_in %d, in0 %d, in10 %d, out %d, ws %zu; nothing launched\n",
                    MP * DM, DM * INW, OUT_ELEMS, (size_t)WS_END, n_in, n_in > 0 ? in_sizes[0] : -1, n_in > 10 ? in_sizes[10] : -1, out_size, ws_size);
            grid = -1; return; }
        int dev = 0, cus = 0, per_cu = 0;
        if (hipGetDevice(&dev) != hipSuccess || hipDeviceGetAttribute(&cus, hipDeviceAttributeMultiprocessorCount, dev) != hipSuccess) { fprintf(stderr, "kernel_launch: device query failed\n"); grid = -1; return; }
        if (hipFuncSetAttribute((const void*)fwd_megakernel, hipFuncAttributeMaxDynamicSharedMemorySize, LDS_BYTES) != hipSuccess) { fprintf(stderr, "kernel_launch: hipFuncSetAttribute(%d B LDS) failed\n", LDS_BYTES); grid = -1; return; }
        if (hipOccupancyMaxActiveBlocksPerMultiprocessor(&per_cu, (const void*)fwd_megakernel, NWAVES * 64, LDS_BYTES) != hipSuccess || per_cu < 1) {
            fprintf(stderr, "kernel_launch: occupancy query reports %d workgroups per CU; nothing launched\n", per_cu); (void)hipGetLastError(); grid = -1; return; }
        grid = cus;
    }
    if (grid < 0) return;
    if (hipMemsetAsync((char*)d_ws + WS_CTL, 0, CTL_ZERO_BYTES, stream) != hipSuccess) { fprintf(stderr, "kernel_launch: hipMemsetAsync failed\n"); return; }
    Args a{};
    for (int i = 0; i < 19; ++i) a.in[i] = d_in[i];
    a.out = (float*)d_out; a.ws = (unsigned char*)d_ws;
    if (N_LAUNCHES == 1) {
        a.ph_lo = 0; a.ph_hi = PER_PHASE;
        hipLaunchKernelGGL(fwd_megakernel, dim3(grid), dim3(NWAVES * 64), LDS_BYTES, stream, a);
    } else {
        for (int li = 0; li < PER_PHASE; ++li) { a.ph_lo = li; a.ph_hi = li + 1; hipLaunchKernelGGL(fwd_megakernel, dim3(grid), dim3(NWAVES * 64), LDS_BYTES, stream, a); }
    }
    const hipError_t le = hipPeekAtLastError();
    if (le != hipSuccess) fprintf(stderr, "kernel_launch: launch failed: %s (grid %d)\n", hipGetErrorName(le), grid);
}
```

```cpp
#include <hip/hip_runtime.h>
#include <hip/hip_bf16.h>
#include <cstdio>
#include <cstdint>

#ifndef MK_N_LAUNCHES
#define MK_N_LAUNCHES 1
#endif
#ifndef SB_EARLY_EXIT
#define SB_EARLY_EXIT 1
#endif

constexpr int DM = 2048, SEQ = 4096, NB = 2, DB = 8, DS = 16, PAST = 4096, HD = 128;
constexpr int MP = NB * SEQ;
constexpr int MS = DB * DS;
constexpr int MIN_ = 8448;
constexpr int MREAL = MP + MS;
constexpr int MMEM0 = 8448;
constexpr int MA = 8960;
constexpr int INW = 13312, NCAT = 14336;
constexpr int NMEM = 256;
constexpr float RMS_EPS = 1e-6f;
constexpr float LOG2E = 1.4426950408889634f;
constexpr float QSCALE = 0.08838834764831845f * 1.4426950408889634f;

namespace pg8 {
#define PG8_LAS __attribute__((address_space(3)))
typedef unsigned short bf16_t;
typedef short bf16x8 __attribute__((ext_vector_type(8)));
typedef float f32x4 __attribute__((ext_vector_type(4)));
typedef unsigned u32x4 __attribute__((ext_vector_type(4)));
constexpr int BM = 256, BK = 64, HALF = 128, HTB = HALF * BK * 2  , STAGE_BYTES = 8 * HTB, NXCD = 8, WGM = 8;

__host__ __device__ __forceinline__ int lds_byte(int r, int c) { const int st = (r >> 4) * 2 + (c >> 5), rr = r & 15, cc = c & 31, ob = rr * 64 + cc * 2; return st * 1024 + (ob ^ (((ob >> 9) & 1) << 5)); }
__host__ __device__ __forceinline__ void stage_rc(int b, int& R, int& C) { const int st = b / 1024, sb = b % 1024, swz = sb ^ (((sb >> 9) & 1) << 5); R = (st >> 1) * 16 + swz / 64; C = (st & 1) * 32 + (swz % 64) / 2; }
__host__ __device__ __forceinline__ int perm32(int rho) { const int n = rho >> 4, i = rho & 15; return 8 * (i >> 2) + 4 * n + (i & 3); }

struct Unit { int pm, pn, k0, nt; };
struct Gemm { const bf16_t* A; const bf16_t* Bt; int M, N, K; };

struct StaticOrder {
    int nM, nN, nwg, G, c;
    __host__ __device__ void init(int M, int N, int G_, int c_) { nM = M / BM; nN = N / BM; nwg = nM * nN; G = G_; c = c_; }
    __host__ __device__ bool next(int i, Unit& u) const {
        const long L = (long)i * G + c; if (L >= nwg) return false;
        int wgid = (int)L; { const int q = nwg / NXCD, r = nwg % NXCD, xcd = wgid % NXCD, off = wgid / NXCD; wgid = (xcd < r ? xcd * (q + 1) : r * (q + 1) + (xcd - r) * q) + off; }
        const int nig = WGM * nN, gid = wgid / nig, fm = gid * WGM, gsz = (nM - fm) < WGM ? (nM - fm) : WGM;
        u.pm = fm + ((wgid % nig) % gsz); u.pn = (wgid % nig) / gsz; u.k0 = 0; u.nt = 0; return true;
    }
    __device__ __forceinline__ void a_ready(const Unit&) const {}
    __device__ __forceinline__ void done(const Unit&) const {}
};

typedef float f32x2_t __attribute__((ext_vector_type(2))); typedef __bf16 bf16x2_t __attribute__((ext_vector_type(2)));
__device__ __forceinline__ unsigned cvt_pk_bf16(float lo, float hi) { f32x2_t v = {lo, hi}; bf16x2_t b = __builtin_convertvector(v, bf16x2_t); return __builtin_bit_cast(unsigned, b); }

template <class Epi, class Sched, bool ALIGN_EPI = false, bool SP2 = false>
__device__ __forceinline__ void gemm_phase(PG8_LAS unsigned char* lds, const Gemm g, const Sched& S, const Epi& E) {
    const int tid = threadIdx.x, wid = __builtin_amdgcn_readfirstlane(tid >> 6), lane = tid & 63, wr = wid >> 2, wc = wid & 3, fr = lane & 15, fq = lane >> 4;
    const int K = g.K, nt = K / BK;
    unsigned voffA[2], voffB[2];
#pragma unroll
    for (int i = 0; i < 2; ++i) { int R, C; stage_rc(tid * 16 + i * 8192, R, C); const int Rb = Epi::PERM ? ((R & ~31) + perm32(R & 31)) : R;
        voffA[i] = (unsigned)(R * K + C) * 2u; voffB[i] = (unsigned)(Rb * K + C) * 2u; }
    const size_t kstep = (size_t)(BK * 2);
    const size_t hstep = (size_t)HALF * K * 2;
    const size_t tstep = 2 * hstep;
    const unsigned ldsw = (unsigned)wid * 1024u;
    const int aoff = lds_byte(wr * 64 + fr, fq * 8), boff = lds_byte(wc * 32 + fr, fq * 8);
#define PG8_SA(b, h) (((b) * 2 + (h)) * HTB)
#define PG8_SB(b, h) ((4 + (b) * 2 + (h)) * HTB)
#define PG8_STAGE(bufoff, gbase, voff) do { _Pragma("unroll") for (int _i = 0; _i < 2; ++_i) \
        __builtin_amdgcn_global_load_lds((const unsigned*)((const char*)(gbase) + (voff)[_i]), (PG8_LAS unsigned*)(lds + (bufoff) + ldsw + _i * 8192), 16, 0, 0); } while (0)
#define PG8_LDA(dst, b, h) do { _Pragma("unroll") for (int m = 0; m < 4; ++m) _Pragma("unroll") for (int k = 0; k < 2; ++k) dst[m][k] = *(const PG8_LAS bf16x8*)(lds + PG8_SA(b, h) + aoff + m * 2048 + k * 1024); } while (0)
#define PG8_LDB(dst, b, h) do { _Pragma("unroll") for (int n = 0; n < 2; ++n) _Pragma("unroll") for (int k = 0; k < 2; ++k) dst[n][k] = *(const PG8_LAS bf16x8*)(lds + PG8_SB(b, h) + boff + n * 2048 + k * 1024); } while (0)
#define PG8_MMA(ai, bj, At, Bt) do { __builtin_amdgcn_s_setprio(1); _Pragma("unroll") for (int m = 0; m < 4; ++m) _Pragma("unroll") for (int n = 0; n < 2; ++n) _Pragma("unroll") for (int k = 0; k < 2; ++k) \
        acc[ai][bj][m][n] = __builtin_amdgcn_mfma_f32_16x16x32_bf16(Bt[n][k], At[m][k], acc[ai][bj][m][n], 0, 0, 0); __builtin_amdgcn_s_setprio(0); } while (0)
#define PG8_WAIT_V(n) asm volatile("s_waitcnt vmcnt(" #n ")" ::: "memory")
#define PG8_WAIT_L(n) asm volatile("s_waitcnt lgkmcnt(" #n ")" ::: "memory")
#define PG8_BAR __builtin_amdgcn_s_barrier()
#define PG8_SCHED __builtin_amdgcn_sched_barrier(0)
    Unit cur, nxt; int ui = 0;
    if (!S.next(0, cur)) return;
    f32x4 acc[2][2][4][2];
#pragma unroll
    for (int a = 0; a < 2; ++a)
#pragma unroll
        for (int b = 0; b < 2; ++b)
#pragma unroll
            for (int m = 0; m < 4; ++m)
#pragma unroll
                for (int n = 0; n < 2; ++n) acc[a][b][m][n] = (f32x4){0.f, 0.f, 0.f, 0.f};
    bf16x8 At[4][2], B0[2][2], B1[2][2];
    const char* cA = (const char*)g.A + (size_t)cur.pm * tstep + (size_t)cur.k0 * 2; const char* cB = (const char*)g.Bt + (size_t)cur.pn * tstep + (size_t)cur.k0 * 2;
    S.a_ready(cur);
    if constexpr (SP2) {
        PG8_STAGE(PG8_SB(0, 0), cB, voffB); PG8_STAGE(PG8_SB(0, 1), cB + hstep, voffB); PG8_STAGE(PG8_SA(0, 0), cA, voffA); PG8_STAGE(PG8_SA(0, 1), cA + hstep, voffA);
        if (wr == 1) PG8_BAR;
        PG8_WAIT_V(2); PG8_BAR;
        PG8_STAGE(PG8_SB(1, 0), cB + kstep, voffB); PG8_STAGE(PG8_SA(1, 0), cA + kstep, voffA); PG8_STAGE(PG8_SB(1, 1), cB + hstep + kstep, voffB);
        PG8_WAIT_V(6); PG8_BAR;
    } else {
        PG8_STAGE(PG8_SB(0, 0), cB, voffB); PG8_STAGE(PG8_SA(0, 0), cA, voffA); PG8_STAGE(PG8_SB(0, 1), cB + hstep, voffB); PG8_STAGE(PG8_SA(0, 1), cA + hstep, voffA);
        if (wr == 1) PG8_BAR;
        PG8_WAIT_V(4); PG8_BAR;
        PG8_STAGE(PG8_SB(1, 0), cB + kstep, voffB); PG8_STAGE(PG8_SA(1, 0), cA + kstep, voffA); PG8_STAGE(PG8_SB(1, 1), cB + hstep + kstep, voffB);
        PG8_WAIT_V(6); PG8_BAR;
    }
    for (;;) {
        const bool has_next = S.next(ui + 1, nxt);
        const char* nA = has_next ? (const char*)g.A + (size_t)nxt.pm * tstep + (size_t)nxt.k0 * 2 : cA; const char* nB = has_next ? (const char*)g.Bt + (size_t)nxt.pn * tstep + (size_t)nxt.k0 * 2 : cB;
        const int ntu = cur.nt ? cur.nt : nt;
        for (int t = 0; t < ntu; t += 2) {
            const bool last = (t == ntu - 2);
            const char* a1 = cA + (size_t)(t + 1) * kstep;
            const char* a2 = last ? nA : cA + (size_t)(t + 2) * kstep; const char* b2 = last ? nB : cB + (size_t)(t + 2) * kstep;
            const char* a3 = a2 + kstep; const char* b3 = b2 + kstep;
            if (last && has_next) S.a_ready(nxt);
            if constexpr (SP2) {
            PG8_LDB(B0, 0, 0); PG8_LDB(B1, 0, 1); PG8_SCHED; PG8_LDA(At, 0, 0); PG8_STAGE(PG8_SA(1, 1), a1 + hstep, voffA);
            PG8_WAIT_V(8); PG8_WAIT_L(0); PG8_BAR; PG8_MMA(0, 0, At, B0); PG8_MMA(0, 1, At, B1); PG8_BAR; PG8_SCHED;
            PG8_LDA(At, 0, 1); PG8_STAGE(PG8_SB(0, 0), b2, voffB); PG8_STAGE(PG8_SB(0, 1), b2 + hstep, voffB); PG8_STAGE(PG8_SA(0, 0), a2, voffA);
            PG8_WAIT_V(8); PG8_WAIT_L(0); PG8_BAR; PG8_MMA(1, 0, At, B0); PG8_MMA(1, 1, At, B1); PG8_BAR; PG8_SCHED;
            PG8_LDB(B0, 1, 0); PG8_LDB(B1, 1, 1); PG8_SCHED; PG8_LDA(At, 1, 0); PG8_STAGE(PG8_SA(0, 1), a2 + hstep, voffA);
            PG8_WAIT_V(8); PG8_WAIT_L(0); PG8_BAR; PG8_MMA(0, 0, At, B0); PG8_MMA(0, 1, At, B1); PG8_BAR; PG8_SCHED;
            PG8_LDA(At, 1, 1); PG8_STAGE(PG8_SB(1, 0), b3, voffB); PG8_STAGE(PG8_SB(1, 1), b3 + hstep, voffB); PG8_STAGE(PG8_SA(1, 0), a3, voffA);
            PG8_WAIT_V(8); PG8_WAIT_L(0); PG8_BAR; PG8_MMA(1, 0, At, B0); PG8_MMA(1, 1, At, B1); PG8_BAR; PG8_SCHED;
            } else {
            PG8_LDB(B0, 0, 0); PG8_SCHED; PG8_LDA(At, 0, 0); PG8_STAGE(PG8_SA(1, 1), a1 + hstep, voffA);
            PG8_WAIT_L(8); PG8_BAR; PG8_WAIT_L(0); PG8_MMA(0, 0, At, B0); PG8_BAR; PG8_SCHED;
            PG8_LDB(B1, 0, 1); PG8_STAGE(PG8_SB(0, 0), b2, voffB);
            PG8_BAR; PG8_WAIT_L(0); PG8_MMA(0, 1, At, B1); PG8_BAR;
            PG8_LDA(At, 0, 1); PG8_STAGE(PG8_SA(0, 0), a2, voffA);
            PG8_BAR; PG8_WAIT_L(0); PG8_MMA(1, 0, At, B0); PG8_BAR; PG8_SCHED;
            PG8_STAGE(PG8_SB(0, 1), b2 + hstep, voffB);
            PG8_WAIT_V(6); PG8_BAR; PG8_MMA(1, 1, At, B1); PG8_BAR;
            PG8_LDB(B0, 1, 0); PG8_SCHED; PG8_LDA(At, 1, 0); PG8_STAGE(PG8_SA(0, 1), a2 + hstep, voffA);
            PG8_WAIT_L(8); PG8_BAR; PG8_WAIT_L(0); PG8_MMA(0, 0, At, B0); PG8_BAR; PG8_SCHED;
            PG8_LDB(B1, 1, 1); PG8_STAGE(PG8_SB(1, 0), b3, voffB);
            PG8_BAR; PG8_WAIT_L(0); PG8_MMA(0, 1, At, B1); PG8_BAR;
            PG8_LDA(At, 1, 1); PG8_STAGE(PG8_SA(1, 0), a3, voffA);
            PG8_BAR; PG8_WAIT_L(0); PG8_MMA(1, 0, At, B0); PG8_BAR; PG8_SCHED;
            PG8_STAGE(PG8_SB(1, 1), b3 + hstep, voffB);
            PG8_WAIT_V(6); PG8_BAR; PG8_MMA(1, 1, At, B1); PG8_BAR;
            }
        }
        if constexpr (ALIGN_EPI) { if (wr == 0) PG8_BAR; }
        if constexpr (!Epi::AFTER_DRAIN) { E(acc, cur, wr, wc, fr, fq); S.done(cur); }
        if (!has_next) break;
        if (E.reset_after(cur))
#pragma unroll
        for (int a = 0; a < 2; ++a)
#pragma unroll
            for (int b = 0; b < 2; ++b)
#pragma unroll
                for (int m = 0; m < 4; ++m)
#pragma unroll
                    for (int n = 0; n < 2; ++n) acc[a][b][m][n] = (f32x4){0.f, 0.f, 0.f, 0.f};
        cur = nxt; cA = nA; cB = nB; ++ui;
        if constexpr (ALIGN_EPI) { if (wr == 1) PG8_BAR; }
    }
    PG8_WAIT_V(0);
    if constexpr (!ALIGN_EPI) { if (wr == 0) PG8_BAR; }
    PG8_BAR;
    if constexpr (Epi::AFTER_DRAIN) { E.fused(acc, cur, wr, wc, fr, fq, lds, wid, lane); S.done(cur); }
#undef PG8_SA
#undef PG8_SB
#undef PG8_STAGE
#undef PG8_LDA
#undef PG8_LDB
#undef PG8_MMA
#undef PG8_WAIT_V
#undef PG8_WAIT_L
#undef PG8_BAR
#undef PG8_SCHED
}
}

namespace ep {
using pg8::f32x4; using pg8::u32x4; using pg8::Unit; using pg8::bf16_t; using pg8::HALF; using pg8::BM; using pg8::cvt_pk_bf16;
typedef unsigned u32x2 __attribute__((ext_vector_type(2)));

struct InOrder {
    pg8::StaticOrder so; int G, c;
    __device__ void init(int G_, int c_) { so.init(MIN_, INW, G_, c_); G = G_; c = c_; }
    __device__ bool next(int i, Unit& u) const {
        const long L = (long)i * G + c;
        if (L < so.nwg) return so.next(i, u);
        const int j = (int)(L - so.nwg); if (j >= 8) return false;
        u.pm = 33 + (j & 1); u.pn = 52 + (j >> 1); u.k0 = 0; u.nt = 0; return true;
    }
    __device__ __forceinline__ void a_ready(const Unit&) const {}
    __device__ __forceinline__ void done(const Unit&) const {}
};

__device__ __forceinline__ float sigmoidf_fast(float x) { return __builtin_amdgcn_rcpf(1.0f + __builtin_amdgcn_exp2f(-x * LOG2E)); }
__device__ __forceinline__ float bf2f(unsigned short h) { return __uint_as_float((unsigned)h << 16); }

struct EpiIn {
    static constexpr bool PERM = true, AFTER_DRAIN = false;
    bf16_t *QSB, *KSB, *VSB, *GSB, *QBD, *KBD, *VBD, *GBD, *QMM, *GMM, *MG, *MK, *MV;
    float* out;
    __device__ __forceinline__ bool reset_after(const Unit&) const { return true; }
    template <int ACT, int F32>
    __device__ __forceinline__ void store(const f32x4 (&acc)[2][2][4][2], bf16_t* dst, int ldc, int colt, int rowoff, int pm, float* f0, float* f1, int wr, int wc, int fr, int fq) const {
        const int col0 = colt + wc * 32 + 8 * fq;
#pragma unroll
        for (int ai = 0; ai < 2; ++ai)
#pragma unroll
            for (int m = 0; m < 4; ++m) {
                const int r = pm * BM + ai * HALF + wr * 64 + m * 16 + fr;
                bf16_t* rowp = dst + (size_t)(r - rowoff) * ldc + col0;
                float* frow = nullptr;
                if (F32 == 1) { if (r < MP) frow = f0 + (size_t)r * 768; else if (r < MREAL) frow = f1 + (size_t)(r - MP) * 768; }
                if (F32 == 2) { if (r < MP) { const int t = r & (SEQ - 1); if (t >= SEQ - 512) frow = f0 + ((size_t)(r >> 12) * 512 + (t - (SEQ - 512))) * 768; } else if (r < MREAL) frow = f1 + (size_t)(r - MP) * 768; }
                if (F32 == 3) frow = f0 + (size_t)(r - MMEM0) * 512;
#pragma unroll
                for (int bj = 0; bj < 2; ++bj) {
                    f32x4 v0 = acc[ai][bj][m][0], v1 = acc[ai][bj][m][1];
                    if (F32 != 0) { if (frow) { *(f32x4*)(frow + col0 + bj * HALF) = v0; *(f32x4*)(frow + col0 + bj * HALF + 4) = v1; } }
                    if (ACT == 1) { v0 = v0 * QSCALE; v1 = v1 * QSCALE; }
                    if (ACT == 2) {
#pragma unroll
                        for (int e = 0; e < 4; ++e) { v0[e] = v0[e] * sigmoidf_fast(v0[e]); v1[e] = v1[e] * sigmoidf_fast(v1[e]); } }
                    if (ACT == 3) {
#pragma unroll
                        for (int e = 0; e < 4; ++e) { v0[e] = sigmoidf_fast(v0[e]); v1[e] = sigmoidf_fast(v1[e]); } }
                    u32x4 w; w.x = cvt_pk_bf16(v0[0], v0[1]); w.y = cvt_pk_bf16(v0[2], v0[3]); w.z = cvt_pk_bf16(v1[0], v1[1]); w.w = cvt_pk_bf16(v1[2], v1[3]);
                    *(u32x4*)(rowp + bj * HALF) = w; }
            }
    }
    __device__ __forceinline__ void operator()(const f32x4 (&acc)[2][2][4][2], const Unit& u, int wr, int wc, int fr, int fq) const {
        const int pn = u.pn, pm = u.pm;
        float* const o_sbk = out + 17039360, * const o_sbv = out + 23330816, * const o_bdk = out + 29622272, * const o_bdv = out + 30408704;
        float* const o_mk = out + 31195136, * const o_mv = out + 31457280;
        float* const s_sbk = out + 31719424, * const s_sbv = out + 31817728, * const s_bdk = out + 31916032, * const s_bdv = out + 32014336;
        if (pn < 3)        store<1, 0>(acc, QSB, 768, 256 * pn, 0, pm, nullptr, nullptr, wr, wc, fr, fq);
        else if (pn < 6)   store<0, 1>(acc, KSB, 768, 256 * (pn - 3), 0, pm, o_sbk, s_sbk, wr, wc, fr, fq);
        else if (pn < 9)   store<0, 1>(acc, VSB, 768, 256 * (pn - 6), 0, pm, o_sbv, s_sbv, wr, wc, fr, fq);
        else if (pn < 12)  store<2, 0>(acc, GSB, 768, 256 * (pn - 9), 0, pm, nullptr, nullptr, wr, wc, fr, fq);
        else if (pn < 15)  store<1, 0>(acc, QBD, 768, 256 * (pn - 12), 0, pm, nullptr, nullptr, wr, wc, fr, fq);
        else if (pn < 18)  store<0, 2>(acc, KBD, 768, 256 * (pn - 15), 0, pm, o_bdk, s_bdk, wr, wc, fr, fq);
        else if (pn < 21)  store<0, 2>(acc, VBD, 768, 256 * (pn - 18), 0, pm, o_bdv, s_bdv, wr, wc, fr, fq);
        else if (pn < 24)  store<2, 0>(acc, GBD, 768, 256 * (pn - 21), 0, pm, nullptr, nullptr, wr, wc, fr, fq);
        else if (pn < 26)  store<1, 0>(acc, QMM, 512, 256 * (pn - 24), 0, pm, nullptr, nullptr, wr, wc, fr, fq);
        else if (pn < 28)  store<2, 0>(acc, GMM, 512, 256 * (pn - 26), 0, pm, nullptr, nullptr, wr, wc, fr, fq);
        else if (pn < 52)  store<3, 0>(acc, MG, 6144, 256 * (pn - 28), 0, pm, nullptr, nullptr, wr, wc, fr, fq);
        else if (pn < 54)  store<0, 3>(acc, MK, 512, 256 * (pn - 52), MMEM0, pm, o_mk, nullptr, wr, wc, fr, fq);
        else               store<0, 3>(acc, MV, 512, 256 * (pn - 54), MMEM0, pm, o_mv, nullptr, wr, wc, fr, fq);
    }
};

struct MergeOrder {
    pg8::StaticOrder so;
    __device__ void init(int G_, int c_) { so.init(MIN_, DM, G_, c_); }
    __device__ bool next(int i, Unit& u) const {
        const int ti = i / 3, seg = i - 3 * ti;
        if (!so.next(ti, u)) return false;
        u.k0 = 768 * seg; u.nt = (seg == 2) ? 8 : 12; return true;
    }
    __device__ __forceinline__ void a_ready(const Unit&) const {}
    __device__ __forceinline__ void done(const Unit&) const {}
};
struct EpiMerge {
    static constexpr bool PERM = true, AFTER_DRAIN = false;
    const bf16_t* MG; bf16_t* OUT;
    __device__ __forceinline__ bool reset_after(const Unit& u) const { return u.k0 == 1536; }
    __device__ __forceinline__ void operator()(f32x4 (&acc)[2][2][4][2], const Unit& u, int wr, int wc, int fr, int fq) const {
        const int col0 = u.pn * BM + wc * 32 + 8 * fq;
        const int seg = (u.k0 == 0) ? 0 : (u.k0 == 768 ? 1 : 2);
#pragma unroll
        for (int ai = 0; ai < 2; ++ai)
#pragma unroll
            for (int m = 0; m < 4; ++m) {
                const int r = u.pm * BM + ai * HALF + wr * 64 + m * 16 + fr;
                const bf16_t* g = MG + (size_t)r * 6144 + seg * 2048 + col0; bf16_t* rowp = OUT + (size_t)r * DM + col0;
#pragma unroll
                for (int bj = 0; bj < 2; ++bj) {
                    const u32x4 a = *(const u32x4*)(g + bj * HALF);
                    float f[8];
#pragma unroll
                    for (int e = 0; e < 4; ++e) { f[2 * e] = fmaxf(__uint_as_float(a[e] << 16), 1e-30f); f[2 * e + 1] = fmaxf(__uint_as_float(a[e] & 0xffff0000u), 1e-30f); }
                    if (seg < 2) {
                        const u32x4 b = *(const u32x4*)(g + 2048 + bj * HALF);
#pragma unroll
                        for (int e = 0; e < 4; ++e) { f[2 * e] *= __builtin_amdgcn_rcpf(fmaxf(__uint_as_float(b[e] << 16), 1e-30f)); f[2 * e + 1] *= __builtin_amdgcn_rcpf(fmaxf(__uint_as_float(b[e] & 0xffff0000u), 1e-30f)); }
                    }
#pragma unroll
                    for (int k = 0; k < 8; ++k) acc[ai][bj][m][k >> 2][k & 3] *= f[k];
                    if (seg == 2) {
                        u32x4 w; w.x = cvt_pk_bf16(acc[ai][bj][m][0][0], acc[ai][bj][m][0][1]); w.y = cvt_pk_bf16(acc[ai][bj][m][0][2], acc[ai][bj][m][0][3]);
                        w.z = cvt_pk_bf16(acc[ai][bj][m][1][0], acc[ai][bj][m][1][1]); w.w = cvt_pk_bf16(acc[ai][bj][m][1][2], acc[ai][bj][m][1][3]);
                        *(u32x4*)(rowp + bj * HALF) = w; }
                }
                if (m & 1) asm volatile("" ::: "memory");
            }
    }
};

struct EpiOut {
    static constexpr bool PERM = false, AFTER_DRAIN = false;
    float* out; float* ssq;
    __device__ __forceinline__ bool reset_after(const Unit&) const { return true; }
    __device__ __forceinline__ void operator()(const f32x4 (&acc)[2][2][4][2], const Unit& u, int wr, int wc, int fr, int fq) const {
        const int col0 = u.pn * BM + wc * 32 + 4 * fq;
#pragma unroll
        for (int ai = 0; ai < 2; ++ai)
#pragma unroll
            for (int m = 0; m < 4; ++m) {
                const int r = u.pm * BM + ai * HALF + wr * 64 + m * 16 + fr;
                float* yrow = (r < MP) ? out + (size_t)r * DM : out + (size_t)16777216 + (size_t)(r - MP) * DM;
                float s = 0.f;
#pragma unroll
                for (int bj = 0; bj < 2; ++bj)
#pragma unroll
                    for (int n = 0; n < 2; ++n) { const f32x4 v = acc[ai][bj][m][n]; s += (v[0] * v[0] + v[1] * v[1]) + (v[2] * v[2] + v[3] * v[3]);
                        if (r < MREAL) *(f32x4*)(yrow + col0 + bj * HALF + n * 16) = v; }
                s += __shfl_xor(s, 16); s += __shfl_xor(s, 32);
                if (fq == 0) ssq[(size_t)r * 32 + u.pn * 4 + wc] = s;
            }
    }
};
}

namespace att {
typedef unsigned short u16;
using bf16x8 = __attribute__((ext_vector_type(8))) short;
using s16x4  = __attribute__((ext_vector_type(4))) short;
using f32x16 = __attribute__((ext_vector_type(16))) float;
using f32x4  = __attribute__((ext_vector_type(4))) float;
using u32x4  = __attribute__((ext_vector_type(4))) unsigned;
using u32x2  = __attribute__((ext_vector_type(2))) unsigned;
constexpr int SHM_V = 16384, SHM_K = 16384;
constexpr int OFF_V = 0, OFF_K = 2 * SHM_V, OFF_BIAS = 65536, OFF_FLAGS = 65536 + 2304, OFF_ITEM = OFF_FLAGS + 128, ATT_LDS = OFF_ITEM + 64;
constexpr float SB_DONE_LOG2 = -200.0f;
#define KSWZ(row, colB) ((row) * 256 + ((colB) ^ (((row) & 7) << 4)))
#define ATT_SBAR() __builtin_amdgcn_sched_barrier(0)
__device__ __forceinline__ int crow(int r, int hi) { return (r & 3) + 8 * (r >> 2) + 4 * hi; }
__device__ __forceinline__ unsigned cvtpk(float lo, float hi) { return pg8::cvt_pk_bf16(lo, hi); }
__device__ __forceinline__ int v_st(int k, int c) { const int kk = (k & ~0xC) | ((k & 4) << 1) | ((k & 8) >> 1); return ((kk >> 3) * 4 + (c >> 5)) * 512 + ((kk & 7) * 32 + (c & 31)) * 2; }
__device__ __forceinline__ int v_rd_base(int lane) { return ((lane & 3) << 3) | (((lane >> 2) & 3) << 6) | (((lane >> 4) & 1) << 5) | (((lane >> 5) & 1) << 8); }
constexpr int v_rd_off(int d0, int ks, int half) { return d0 * 512 + ks * 4096 + half * 2048; }
template <int OFF> __device__ __forceinline__ s16x4 tr_read(int vb) { s16x4 r; asm volatile("ds_read_b64_tr_b16 %0, %1 offset:%2" : "=&v"(r) : "v"(vb), "i"(OFF) : "memory"); return r; }

struct Item {
    int mode;
    int rule;
    const u16* Q; int ldq; int nq; int qpos0;
    const u16 *kb, *vb; int ldb; int pb_lo, pb_hi;
    const float *kf, *vf; int ldf; int pf_lo, pf_hi;
    int pv_lo, pv_hi;
    int kp_first, kp_step, ntiles;
    const float* bias;
    u16* O; int ldo; const u16* G; int ldg;
};

__device__ __forceinline__ void qkt(f32x16& p0, f32x16& p1, const char* Ks, const bf16x8* qr, int r32, int hi) {
    p0 = f32x16{}; p1 = f32x16{};
#pragma unroll
    for (int d0 = 0; d0 < 8; ++d0) { const int cb = (d0 * 16 + hi * 8) * 2;
        const bf16x8 b0 = *reinterpret_cast<const bf16x8*>(Ks + KSWZ(r32, cb));
        const bf16x8 b1 = *reinterpret_cast<const bf16x8*>(Ks + KSWZ(32 + r32, cb));
        p0 = __builtin_amdgcn_mfma_f32_32x32x16_bf16(b0, qr[d0], p0, 0, 0, 0);
        p1 = __builtin_amdgcn_mfma_f32_32x32x16_bf16(b1, qr[d0], p1, 0, 0, 0); }
}
template <int D0> __device__ __forceinline__ void pv_one(f32x16& od, int vb, bf16x8 pa0, bf16x8 pa1, bf16x8 pa2, bf16x8 pa3) {
    const s16x4 l0 = tr_read<v_rd_off(D0, 0, 0)>(vb), h0 = tr_read<v_rd_off(D0, 0, 1)>(vb), l1 = tr_read<v_rd_off(D0, 1, 0)>(vb), h1 = tr_read<v_rd_off(D0, 1, 1)>(vb);
    const s16x4 l2 = tr_read<v_rd_off(D0, 2, 0)>(vb), h2 = tr_read<v_rd_off(D0, 2, 1)>(vb), l3 = tr_read<v_rd_off(D0, 3, 0)>(vb), h3 = tr_read<v_rd_off(D0, 3, 1)>(vb);
    asm volatile("s_waitcnt lgkmcnt(0)" ::: "memory"); ATT_SBAR();
#define ATT_PK(L, H) (bf16x8){L[0], L[1], L[2], L[3], H[0], H[1], H[2], H[3]}
    od = __builtin_amdgcn_mfma_f32_32x32x16_bf16(ATT_PK(l0, h0), pa0, od, 0, 0, 0);
    od = __builtin_amdgcn_mfma_f32_32x32x16_bf16(ATT_PK(l1, h1), pa1, od, 0, 0, 0);
    od = __builtin_amdgcn_mfma_f32_32x32x16_bf16(ATT_PK(l2, h2), pa2, od, 0, 0, 0);
    od = __builtin_amdgcn_mfma_f32_32x32x16_bf16(ATT_PK(l3, h3), pa3, od, 0, 0, 0);
#undef ATT_PK
}
#define ATT_PK4(P, BASE, OUT) do { const unsigned a0_ = cvtpk(P[BASE + 0], P[BASE + 1]), a1_ = cvtpk(P[BASE + 2], P[BASE + 3]);   \
    const unsigned b0_ = cvtpk(P[BASE + 4], P[BASE + 5]), b1_ = cvtpk(P[BASE + 6], P[BASE + 7]);                              \
    auto r0_ = __builtin_amdgcn_permlane32_swap(a0_, b0_, false, false); auto r1_ = __builtin_amdgcn_permlane32_swap(a1_, b1_, false, false); \
    u32x4 w_ = {r0_[0], r1_[0], r0_[1], r1_[1]}; OUT = *reinterpret_cast<bf16x8*>(&w_); } while (0)

__device__ __forceinline__ void sb_half(f32x16& p, float& carry, bool need_mask, int kbase, int qpos, int pv_lo, int pv_hi, int hi) {
    float T[16];
#pragma unroll
    for (int r = 0; r < 16; ++r) {
        const float z = p[r];
        const float t = __builtin_amdgcn_exp2f(-__builtin_fabsf(z));
        const float l = __builtin_amdgcn_logf(1.0f + t);
        float lm = -(fmaxf(z, 0.f) + l);
        float lp = fminf(z, 0.f) - l;
        if (need_mask) { const int kp = kbase + crow(r, hi); const bool ok = (kp < qpos) && (kp >= pv_lo) && (kp < pv_hi); lm = ok ? lm : 0.f; lp = ok ? lp : -1e30f; }
        T[r] = lm; p[r] = lp;
    }
    float E[16], glo[4], ghi[4];
#pragma unroll
    for (int g = 0; g < 4; ++g) {
        E[4 * g + 3] = 0.f; E[4 * g + 2] = T[4 * g + 3]; E[4 * g + 1] = E[4 * g + 2] + T[4 * g + 2]; E[4 * g] = E[4 * g + 1] + T[4 * g + 1];
        const float gt = E[4 * g] + T[4 * g];
        auto rr = __builtin_amdgcn_permlane32_swap(__float_as_uint(gt), __float_as_uint(gt), false, false);
        glo[g] = __uint_as_float(rr[0]); ghi[g] = __uint_as_float(rr[1]);
    }
    float SG[4];
    SG[3] = 0.f; SG[2] = glo[3] + ghi[3]; SG[1] = SG[2] + (glo[2] + ghi[2]); SG[0] = SG[1] + (glo[1] + ghi[1]);
    const float tot = SG[0] + (glo[0] + ghi[0]);
#pragma unroll
    for (int g = 0; g < 4; ++g) SG[g] += carry + (hi == 0 ? ghi[g] : 0.f);
#pragma unroll
    for (int r = 0; r < 16; ++r) p[r] = __builtin_amdgcn_exp2f(p[r] + (SG[r >> 2] + E[r]));
    carry += tot;
}

template <int MODE>
__device__ __forceinline__ void run_item(const Item& it, char* lds, __attribute__((address_space(3))) unsigned char* ldsl) {
    const int tid = threadIdx.x, lane = tid & 63, r32 = lane & 31, hi = lane >> 5;
    const int wid = __builtin_amdgcn_readfirstlane(tid >> 6);
    char* V_lds = lds + OFF_V; char* K_lds = lds + OFF_K;
    float* biasT = (float*)(lds + OFF_BIAS);
    volatile __attribute__((address_space(3))) int* flags = (volatile __attribute__((address_space(3))) int*)(ldsl + OFF_FLAGS);
    const bool has_bias = (MODE == 1) && (it.bias != nullptr);
    if (has_bias) for (int i = tid; i < 513; i += 512) biasT[i] = it.bias[i] * LOG2E;
    const bool wave_rows = (32 * wid < it.nq);
    int qrow = 32 * wid + r32; if (qrow >= it.nq) qrow = it.nq - 1;
    const int qpos = it.qpos0 + 32 * wid + r32;
    bf16x8 qr[8];
    { const u16* Qw = it.Q + (size_t)qrow * it.ldq + hi * 8;
#pragma unroll
      for (int d0 = 0; d0 < 8; ++d0) qr[d0] = *reinterpret_cast<const bf16x8*>(Qw + d0 * 16); }
    f32x16 o[4]; o[0] = f32x16{}; o[1] = f32x16{}; o[2] = f32x16{}; o[3] = f32x16{};
    float carry = 0.f, m_reg = -1e30f, l_reg = 0.f;
    const int sr = tid >> 4, sc = (tid & 15) * 8;
    const int vst0 = v_st(sr, sc), vst1 = v_st(32 + sr, sc), kst0 = KSWZ(sr, sc * 2), kst1 = KSWZ(32 + sr, sc * 2);
    const int vb0 = (int)(uintptr_t)V_lds + v_rd_base(lane);
    f32x4 sK0a, sK0b, sK1a, sK1b, sV0a, sV0b, sV1a, sV1b;
#define ATT_LD(p, A, B, kbp, kfp) do { const int p_ = (p); \
        if (p_ >= it.pb_lo && p_ < it.pb_hi) { A = *reinterpret_cast<const f32x4*>(kbp + (size_t)(p_ - it.pb_lo) * it.ldb + sc); } \
        else if (p_ >= it.pf_lo && p_ < it.pf_hi) { const float* s_ = kfp + (size_t)(p_ - it.pf_lo) * it.ldf + sc; A = *reinterpret_cast<const f32x4*>(s_); B = *reinterpret_cast<const f32x4*>(s_ + 4); } \
        else { A = (f32x4){0.f, 0.f, 0.f, 0.f}; } } while (0)
#define ATT_CV(p, A, B, OUT) do { const int p_ = (p); \
        if (p_ >= it.pf_lo && p_ < it.pf_hi) { u32x4 w_ = {cvtpk(A[0], A[1]), cvtpk(A[2], A[3]), cvtpk(B[0], B[1]), cvtpk(B[2], B[3])}; OUT = *reinterpret_cast<bf16x8*>(&w_); } \
        else { f32x4 a_ = A; OUT = *reinterpret_cast<bf16x8*>(&a_); } } while (0)
#define ATT_SLOAD(kp0) do { ATT_LD((kp0) + sr, sK0a, sK0b, it.kb, it.kf); ATT_LD((kp0) + 32 + sr, sK1a, sK1b, it.kb, it.kf); \
        ATT_LD((kp0) + sr, sV0a, sV0b, it.vb, it.vf); ATT_LD((kp0) + 32 + sr, sV1a, sV1b, it.vb, it.vf); } while (0)
#define ATT_SWRITE(b, kp0) do { bf16x8 t_; \
        ATT_CV((kp0) + sr, sK0a, sK0b, t_); *reinterpret_cast<bf16x8*>(K_lds + (b) * SHM_K + kst0) = t_; \
        ATT_CV((kp0) + 32 + sr, sK1a, sK1b, t_); *reinterpret_cast<bf16x8*>(K_lds + (b) * SHM_K + kst1) = t_; \
        ATT_CV((kp0) + sr, sV0a, sV0b, t_); *reinterpret_cast<bf16x8*>(V_lds + (b) * SHM_V + vst0) = t_; \
        ATT_CV((kp0) + 32 + sr, sV1a, sV1b, t_); *reinterpret_cast<bf16x8*>(V_lds + (b) * SHM_V + vst1) = t_; } while (0)
    sK0b = sK1b = sV0b = sV1b = (f32x4){0.f, 0.f, 0.f, 0.f};
    const int nt = it.ntiles;
    ATT_SLOAD(it.kp_first); ATT_SWRITE(0, it.kp_first);
    __syncthreads();
    bool wdone = !wave_rows;
    for (int j = 0; j < nt; ++j) {
        const int kp0 = it.kp_first + j * it.kp_step, kpn = kp0 + it.kp_step, cur = j & 1;
        const bool more = (j + 1 < nt);
        if (more) ATT_SLOAD(kpn);
        bool active = wave_rows;
        if (it.rule == 1) active = active && (kp0 <= it.qpos0 + 32 * wid + 30) && !wdone;
        if (it.rule == 2) { const int ct = kp0 >> 6, cw = (it.qpos0 + 32 * wid) >> 6; active = active && (ct >= cw - 8) && (ct <= cw); }
        if (active) {
            f32x16 p0, p1;
            qkt(p0, p1, K_lds + cur * SHM_K, qr, r32, hi);
            bool need_mask = (kp0 < it.pv_lo) || (kp0 + 64 > it.pv_hi);
            if (MODE == 0) {
                need_mask = need_mask || (kp0 + 63 >= it.qpos0 + 32 * wid);
                sb_half(p1, carry, need_mask, kp0 + 32, qpos, it.pv_lo, it.pv_hi, hi);
                sb_half(p0, carry, need_mask, kp0, qpos, it.pv_lo, it.pv_hi, hi);
            } else {
                if (has_bias) {
#pragma unroll
                    for (int r = 0; r < 16; ++r) { const int kp = kp0 + crow(r, hi);
                        int d0_ = qpos - kp; d0_ = d0_ < -256 ? -256 : (d0_ > 256 ? 256 : d0_);
                        int d1_ = qpos - kp - 32; d1_ = d1_ < -256 ? -256 : (d1_ > 256 ? 256 : d1_);
                        p0[r] += biasT[d0_ + 256]; p1[r] += biasT[d1_ + 256]; }
                }
                if (need_mask) {
#pragma unroll
                    for (int r = 0; r < 16; ++r) { const int kp = kp0 + crow(r, hi);
                        if (!(kp >= it.pv_lo && kp < it.pv_hi)) p0[r] = -1e30f;
                        if (!(kp + 32 >= it.pv_lo && kp + 32 < it.pv_hi)) p1[r] = -1e30f; }
                }
                float pmax = p0[0];
#pragma unroll
                for (int r = 1; r < 16; ++r) pmax = fmaxf(pmax, p0[r]);
#pragma unroll
                for (int r = 0; r < 16; ++r) pmax = fmaxf(pmax, p1[r]);
                { auto rr = __builtin_amdgcn_permlane32_swap(__float_as_uint(pmax), __float_as_uint(pmax), false, false); pmax = fmaxf(__uint_as_float(rr[0]), __uint_as_float(rr[1])); }
                const float mn = fmaxf(m_reg, pmax);
                const float alpha = __builtin_amdgcn_exp2f(m_reg - mn); m_reg = mn;
                float ps = 0.f;
#pragma unroll
                for (int r = 0; r < 16; ++r) { p0[r] = __builtin_amdgcn_exp2f(p0[r] - mn); ps += p0[r]; }
#pragma unroll
                for (int r = 0; r < 16; ++r) { p1[r] = __builtin_amdgcn_exp2f(p1[r] - mn); ps += p1[r]; }
                { auto rr = __builtin_amdgcn_permlane32_swap(__float_as_uint(ps), __float_as_uint(ps), false, false); ps = __uint_as_float(rr[0]) + __uint_as_float(rr[1]); }
                l_reg = l_reg * alpha + ps;
                if (__any(alpha < 1.f)) {
#pragma unroll
                    for (int d = 0; d < 4; ++d)
#pragma unroll
                        for (int r = 0; r < 16; ++r) o[d][r] *= alpha; }
            }
            bf16x8 pa0, pa1, pa2, pa3;
            ATT_PK4(p0, 0, pa0); ATT_PK4(p0, 8, pa1); ATT_PK4(p1, 0, pa2); ATT_PK4(p1, 8, pa3);
            const int vb = vb0 + cur * SHM_V;
            pv_one<0>(o[0], vb, pa0, pa1, pa2, pa3); pv_one<1>(o[1], vb, pa0, pa1, pa2, pa3); pv_one<2>(o[2], vb, pa0, pa1, pa2, pa3); pv_one<3>(o[3], vb, pa0, pa1, pa2, pa3);
        }
        if (MODE == 0 && SB_EARLY_EXIT) {
            if (wave_rows && !wdone) { const bool rowdone = (carry < SB_DONE_LOG2) || (32 * wid + r32 >= it.nq); wdone = __all(rowdone); }
            if (lane == 0) flags[cur * 8 + wid] = wdone ? 1 : 0;
        }
        if (more) ATT_SWRITE(cur ^ 1, kpn);
        __syncthreads();
        if (MODE == 0 && SB_EARLY_EXIT) {
            int alld = 1;
#pragma unroll
            for (int w = 0; w < 8; ++w) alld &= flags[cur * 8 + w];
            if (alld) break;
        }
    }
    if (wave_rows && (32 * wid + r32) < it.nq) {
        const float inv = (MODE == 1) ? __builtin_amdgcn_rcpf(l_reg) : 1.0f;
        const size_t row = (size_t)(32 * wid + r32);
        u16* orow = it.O + row * it.ldo + 4 * hi; const u16* grow = it.G + row * it.ldg + 4 * hi;
#pragma unroll
        for (int d0 = 0; d0 < 4; ++d0)
#pragma unroll
            for (int g = 0; g < 4; ++g) {
                const u32x2 gv = *reinterpret_cast<const u32x2*>(grow + 32 * d0 + 8 * g);
                const float g0 = __uint_as_float(gv.x << 16), g1 = __uint_as_float(gv.x & 0xffff0000u), g2 = __uint_as_float(gv.y << 16), g3 = __uint_as_float(gv.y & 0xffff0000u);
                u32x2 w; w.x = cvtpk(o[d0][4 * g] * inv * g0, o[d0][4 * g + 1] * inv * g1); w.y = cvtpk(o[d0][4 * g + 2] * inv * g2, o[d0][4 * g + 3] * inv * g3);
                *reinterpret_cast<u32x2*>(orow + 32 * d0 + 8 * g) = w; }
    }
    __syncthreads();
#undef ATT_LD
#undef ATT_CV
#undef ATT_SLOAD
#undef ATT_SWRITE
}
}

constexpr int NWAVES = 8;
constexpr int N_LAUNCHES = MK_N_LAUNCHES;
constexpr int PER_PHASE = 6;

constexpr size_t al256(size_t x) { return (x + 255) & ~(size_t)255; }
constexpr size_t WS_CTL = 0, CTL_ZERO_BYTES = 1u << 20;
constexpr size_t WS_WCAT = CTL_ZERO_BYTES;
constexpr size_t WS_WUP  = WS_WCAT + (size_t)NCAT * DM * 2;
constexpr size_t WS_WOUT = WS_WUP + (size_t)DM * DM * 2;
constexpr size_t WS_ACAT = WS_WOUT + (size_t)DM * DM * 2;
constexpr size_t SZ768 = (size_t)MIN_ * 768 * 2, SZ512 = (size_t)MIN_ * 512 * 2;
constexpr size_t WS_QSB = WS_ACAT + (size_t)MA * DM * 2, WS_KSB = WS_QSB + SZ768, WS_VSB = WS_KSB + SZ768, WS_GSB = WS_VSB + SZ768;
constexpr size_t WS_QBD = WS_GSB + SZ768, WS_KBD = WS_QBD + SZ768, WS_VBD = WS_KBD + SZ768, WS_GBD = WS_VBD + SZ768;
constexpr size_t WS_QMM = WS_GBD + SZ768, WS_GMM = WS_QMM + SZ512;
constexpr size_t WS_MG  = WS_GMM + SZ512;
constexpr size_t WS_MK  = WS_MG + (size_t)MIN_ * 6144 * 2, WS_MV = WS_MK + (size_t)512 * 512 * 2;
constexpr size_t WS_AUP = WS_MV + (size_t)512 * 512 * 2;
constexpr size_t WS_SSQ = WS_AUP + (size_t)MIN_ * DM * 2;
constexpr size_t WS_END = WS_SSQ + (size_t)MIN_ * 32 * 4;
static_assert(WS_WCAT % 256 == 0 && WS_QSB % 256 == 0 && WS_MG % 256 == 0 && WS_AUP % 256 == 0 && WS_SSQ % 256 == 0, "alignment");
constexpr int CW_TMO = 0, CW_WORK = 64, CW_BAR = 4096;
constexpr int OUT_ELEMS = 32112640;

constexpr int RING_BYTES = 131072, LDSCTL_OFF = RING_BYTES, MISC_OFF = LDSCTL_OFF + 320, LDS_BYTES = 147456;
static_assert(att::ATT_LDS <= RING_BYTES, "attention scratch inside the ring region");

#define GAS __attribute__((address_space(1)))
#define LAS __attribute__((address_space(3)))
typedef unsigned short bf16;
typedef unsigned v4u __attribute__((ext_vector_type(4)));
typedef float f32x4 __attribute__((ext_vector_type(4)));
typedef GAS unsigned gu32;
#define RLX_AGENT __ATOMIC_RELAXED, __HIP_MEMORY_SCOPE_AGENT
#define LDS_WAIT() asm volatile("s_waitcnt lgkmcnt(0)" ::: "memory")
__device__ __forceinline__ unsigned pk2(float lo, float hi) { return pg8::cvt_pk_bf16(lo, hi); }

#define XB_TMO      128
#define XB_XCNT(j)  (256  + 64 * (j))
#define XB_XSUB(j)  (1280 + 64 * (j))
#define XB_XGEN(j)  (2304 + 64 * (j))
#define XB_TOP      3328
#define XB_TOPGEN   3392
#define XCD_BAR_WORDS 3456
#define XB_SPIN_CAP (1u << 18)
__device__ __forceinline__ unsigned xb_ld(unsigned* p)              { return __hip_atomic_load(p, __ATOMIC_RELAXED, __HIP_MEMORY_SCOPE_AGENT); }
__device__ __forceinline__ unsigned xb_add(unsigned* p, unsigned v) { return __hip_atomic_fetch_add(p, v, __ATOMIC_RELAXED, __HIP_MEMORY_SCOPE_AGENT); }
__device__ __forceinline__ unsigned xb_xcc_id() { return (unsigned)__builtin_amdgcn_s_getreg((3 << 11) | 20) & 0xFu; }
#define XB_SPIN(cond, bar) do { unsigned _sp = 0; while (cond) { __builtin_amdgcn_s_sleep(1); \
    if ((++_sp & 255u) == 0u) { if (xb_ld(&(bar)[XB_TMO])) break; if (_sp > XB_SPIN_CAP) { atomicAdd(&(bar)[XB_TMO], 1u); break; } } } } while (0)
struct XcdBarrier { unsigned* bar; unsigned x; volatile LAS unsigned* st; };
__device__ __forceinline__ XcdBarrier xcd_barrier_post(unsigned* bar, volatile LAS unsigned* st) {
    XcdBarrier b; b.bar = bar; b.x = xb_xcc_id(); b.st = st;
    if (threadIdx.x == 0) (void)xb_add(&bar[XB_XCNT(b.x)], 1u);
    return b;
}
__device__ __forceinline__ void xcd_barrier_complete(unsigned* bar, unsigned x, unsigned& nloc, unsigned& nx) {
    const unsigned G = gridDim.x * gridDim.y * gridDim.z;
    unsigned sum, cnt, mine, sp = 0u;
    for (;;) {
        sum = 0u; cnt = 0u; mine = 0u;
#pragma unroll
        for (unsigned j = 0; j < 16; ++j) { const unsigned c = xb_ld(&bar[XB_XCNT(j)]); sum += c; cnt += (c > 0u) ? 1u : 0u; mine = (j == x) ? c : mine; }
        if (sum == G) break;
        __builtin_amdgcn_s_sleep(1);
        if ((++sp & 255u) == 0u) { if (xb_ld(&bar[XB_TMO])) break; if (sp > XB_SPIN_CAP) { atomicAdd(&bar[XB_TMO], 1u); break; } }
    }
    nloc = mine > 0u ? mine : 1u; nx = cnt > 0u ? cnt : 1u;
}
__device__ __forceinline__ void xcd_barrier(const XcdBarrier& b) {
    asm volatile("s_waitcnt vmcnt(0)" ::: "memory");
    __syncthreads();
    if (threadIdx.x == 0) {
        unsigned* bar = b.bar;
        __builtin_amdgcn_s_waitcnt(0);
        unsigned nloc = b.st[0], nx = b.st[1];
        if (nloc == 0u) { xcd_barrier_complete(bar, b.x, nloc, nx); b.st[0] = nloc; b.st[1] = nx; }
        const unsigned old = xb_add(&bar[XB_XSUB(b.x)], 1u);
        const unsigned gen = old / nloc;
        if (old + 1u == (gen + 1u) * nloc) {
            __builtin_amdgcn_fence(__ATOMIC_RELEASE, "agent");
            asm volatile("s_waitcnt vmcnt(0)" ::: "memory");
            const unsigned og = xb_add(&bar[XB_TOP], 1u);
            const unsigned tg = og / nx;
            if (og + 1u == (tg + 1u) * nx) xb_add(&bar[XB_TOPGEN], 1u);
            else XB_SPIN(xb_ld(&bar[XB_TOPGEN]) == tg, bar);
            __builtin_amdgcn_fence(__ATOMIC_ACQUIRE, "agent");
            xb_add(&bar[XB_XGEN(b.x)], 1u);
            asm volatile("s_waitcnt vmcnt(0)" ::: "memory");
        } else {
            XB_SPIN(xb_ld(&bar[XB_XGEN(b.x)]) == gen, bar);
            __builtin_amdgcn_fence(__ATOMIC_ACQUIRE, "agent");
            asm volatile("s_waitcnt vmcnt(0)" ::: "memory");
        }
    }
    __syncthreads();
}

struct Frame {
    LAS unsigned char* lds;
    volatile LAS unsigned* MISC;
    gu32* ctl;
    int vcu, G;
    const float *x_prompt, *x_sample, *c_sbk, *c_sbv, *c_bdk, *c_bdv, *c_mk, *c_mv, *mem_prompt, *g_pre, *w_in, *rel_bias, *g_mem, *w_mem_kv, *w_up_sb, *w_up_band, *w_up_mem, *w_out, *g_post;
    float* out;
    bf16 *WCAT, *WUP, *WOUT, *ACAT, *QSB, *KSB, *VSB, *GSB, *QBD, *KBD, *VBD, *GBD, *QMM, *GMM, *MG, *MK, *MV, *AUP, *MERGED;
    float* SSQ;
};

__device__ __forceinline__ int fresh_tid() { int t = threadIdx.x; asm volatile("" : "+v"(t)); return t; }
__device__ __forceinline__ float wave_sum(float v) {
#pragma unroll
    for (int o = 1; o < 64; o <<= 1) v += __shfl_xor(v, o);
    return v;
}
__device__ __forceinline__ void p0_transpose_item(const float* W, int N, bf16* WT, int ldt, int row_off, int col_off, LAS float* scr, int item, int lane) {
    const int nblk = N / 32, kb = item / nblk, nb = item % nblk, k0 = 64 * kb, n0 = 32 * nb;
#pragma unroll 8
    for (int i = 0; i < 32; ++i) { const int kk = 2 * i + (lane >> 5); scr[kk * 33 + (lane & 31)] = W[(size_t)(k0 + kk) * N + n0 + (lane & 31)]; }
    LDS_WAIT(); asm volatile("" ::: "memory");
    const int c = lane & 7;
#pragma unroll
    for (int j = 0; j < 4; ++j) { const int n = (lane >> 3) + 8 * j; const LAS float* s = scr + (8 * c) * 33 + n;
        v4u o; o.x = pk2(s[0 * 33], s[1 * 33]); o.y = pk2(s[2 * 33], s[3 * 33]); o.z = pk2(s[4 * 33], s[5 * 33]); o.w = pk2(s[6 * 33], s[7 * 33]);
        *(GAS v4u*)(WT + (size_t)(row_off + n0 + n) * ldt + col_off + k0 + 8 * c) = o; }
    LDS_WAIT(); asm volatile("" ::: "memory");
}
__device__ __forceinline__ void rms_row_to_bf16(const float* xrow, const float* g, bf16* orow, int lane) {
    const GAS f32x4* xr = (const GAS f32x4*)xrow + lane; const GAS f32x4* gr = (const GAS f32x4*)g + lane;
    f32x4 v[8]; float s = 0.f;
#pragma unroll
    for (int j = 0; j < 8; ++j) { v[j] = xr[64 * j]; s += (v[j].x * v[j].x + v[j].y * v[j].y) + (v[j].z * v[j].z + v[j].w * v[j].w); }
    const float r = 1.0f / sqrtf(wave_sum(s) * (1.0f / DM) + RMS_EPS);
    GAS unsigned long long* o8 = (GAS unsigned long long*)orow + lane;
#pragma unroll
    for (int j = 0; j < 8; ++j) { const f32x4 gv = gr[64 * j];
        o8[64 * j] = (unsigned long long)pk2(v[j].x * r * gv.x, v[j].y * r * gv.y) | ((unsigned long long)pk2(v[j].z * r * gv.z, v[j].w * r * gv.w) << 32); }
}
__device__ __forceinline__ void p0_prologue(Frame& F) {
    const int tid_ = fresh_tid(), lane_ = tid_ & 63, wave_ = __builtin_amdgcn_readfirstlane(tid_ >> 6);
    LAS float* scr = (LAS float*)(F.lds + wave_ * 16384);
    const int gw = F.vcu * NWAVES + wave_, NGW = F.G * NWAVES;
    constexpr int I_IN = 32 * (INW / 32), I_MEM = 32 * (1024 / 32), I_USB = 12 * 64, I_UBD = 12 * 64, I_UMM = 8 * 64, I_OUT = 32 * 64;
    constexpr int NITEMS = I_IN + I_MEM + I_USB + I_UBD + I_UMM + I_OUT;
    for (int it = gw; it < NITEMS; it += NGW) {
        int r = it;
        if (r < I_IN)  { p0_transpose_item(F.w_in, INW, F.WCAT, DM, 0, 0, scr, r, lane_); continue; } r -= I_IN;
        if (r < I_MEM) { p0_transpose_item(F.w_mem_kv, 1024, F.WCAT, DM, INW, 0, scr, r, lane_); continue; } r -= I_MEM;
        if (r < I_USB) { p0_transpose_item(F.w_up_sb, DM, F.WUP, DM, 0, 0, scr, r, lane_); continue; } r -= I_USB;
        if (r < I_UBD) { p0_transpose_item(F.w_up_band, DM, F.WUP, DM, 0, 768, scr, r, lane_); continue; } r -= I_UBD;
        if (r < I_UMM) { p0_transpose_item(F.w_up_mem, DM, F.WUP, DM, 0, 1536, scr, r, lane_); continue; } r -= I_UMM;
        p0_transpose_item(F.w_out, DM, F.WOUT, DM, 0, 0, scr, r, lane_);
    }
    for (int m = gw; m < MA; m += NGW) {
        bf16* orow = F.ACAT + (size_t)m * DM;
        if (m < MP) rms_row_to_bf16(F.x_prompt + (size_t)m * DM, F.g_pre, orow, lane_);
        else if (m < MREAL) rms_row_to_bf16(F.x_sample + (size_t)(m - MP) * DM, F.g_pre, orow, lane_);
        else if (m < MIN_) {
            GAS v4u* o = (GAS v4u*)orow + lane_; GAS v4u* o2 = (GAS v4u*)(F.AUP + (size_t)m * DM) + lane_;
#pragma unroll
            for (int j = 0; j < 4; ++j) { o[64 * j] = (v4u){0u, 0u, 0u, 0u}; o2[64 * j] = (v4u){0u, 0u, 0u, 0u}; }
        }
        else rms_row_to_bf16(F.mem_prompt + (size_t)(m - MMEM0) * DM, F.g_mem, orow, lane_);
    }
}
__device__ __forceinline__ void p5_final(Frame& F) {
    const int tid_ = fresh_tid(), lane_ = tid_ & 63, wave_ = __builtin_amdgcn_readfirstlane(tid_ >> 6);
    const int gw = F.vcu * NWAVES + wave_, NGW = F.G * NWAVES;
    for (int m = gw; m < MREAL; m += NGW) {
        float s = (lane_ < 32) ? F.SSQ[(size_t)m * 32 + lane_] : 0.f;
        s = wave_sum(s);
        const float r = 1.0f / sqrtf(s * (1.0f / DM) + RMS_EPS);
        float* yrow = (m < MP) ? F.out + (size_t)m * DM : F.out + (size_t)16777216 + (size_t)(m - MP) * DM;
        const float* xrow = (m < MP) ? F.x_prompt + (size_t)m * DM : F.x_sample + (size_t)(m - MP) * DM;
        GAS f32x4* y4 = (GAS f32x4*)yrow + lane_; const GAS f32x4* x4 = (const GAS f32x4*)xrow + lane_; const GAS f32x4* g4 = (const GAS f32x4*)F.g_post + lane_;
#pragma unroll
        for (int j = 0; j < 8; ++j) { const f32x4 yv = y4[64 * j], xv = x4[64 * j], gv = g4[64 * j]; y4[64 * j] = xv + yv * r * gv; }
    }
}

constexpr int IT_BDP = 192, IT_BDS = 48, IT_SBP = 192, IT_SBS = 48, IT_MMP = 128, IT_MMS = 32;
constexpr int IT_TOTAL = IT_BDP + IT_BDS + IT_SBP + IT_SBS + IT_MMP + IT_MMS;
__device__ __forceinline__ att::Item make_item(const Frame& F, int idx) {
    att::Item it; it.bias = nullptr; it.kf = nullptr; it.vf = nullptr; it.ldf = 0; it.pf_lo = 0; it.pf_hi = 0; it.kb = nullptr; it.vb = nullptr; it.ldb = 0; it.pb_lo = 0; it.pb_hi = 0;
    if (idx < IT_BDP) {
        const int b = idx / 96, h = (idx / 16) % 6, cg = idx % 16; const size_t row0 = (size_t)b * SEQ + 256 * cg;
        it.mode = 1; it.rule = 2; it.Q = F.QBD + row0 * 768 + h * HD; it.ldq = 768; it.nq = 256; it.qpos0 = 256 * cg;
        it.kb = F.KBD + (size_t)b * SEQ * 768 + h * HD; it.vb = F.VBD + (size_t)b * SEQ * 768 + h * HD; it.ldb = 768; it.pb_lo = 0; it.pb_hi = SEQ;
        it.pv_lo = 0; it.pv_hi = SEQ; const int c_lo = (4 * cg - 8) > 0 ? (4 * cg - 8) : 0;
        it.kp_first = 64 * c_lo; it.kp_step = 64; it.ntiles = 4 * cg + 4 - c_lo; it.bias = F.rel_bias + h * 513;
        it.O = F.AUP + row0 * DM + 768 + h * HD; it.ldo = DM; it.G = F.GBD + row0 * 768 + h * HD; it.ldg = 768; return it; }
    idx -= IT_BDP;
    if (idx < IT_BDS) {
        const int b = idx / 6, h = idx % 6; const size_t row0 = (size_t)MP + b * DS;
        it.mode = 1; it.rule = 0; it.Q = F.QBD + row0 * 768 + h * HD; it.ldq = 768; it.nq = DS; it.qpos0 = PAST;
        it.kb = F.KBD + row0 * 768 + h * HD; it.vb = F.VBD + row0 * 768 + h * HD; it.ldb = 768; it.pb_lo = PAST; it.pb_hi = PAST + DS;
        it.kf = F.c_bdk + (size_t)b * 512 * 768 + h * HD; it.vf = F.c_bdv + (size_t)b * 512 * 768 + h * HD; it.ldf = 768; it.pf_lo = PAST - 512; it.pf_hi = PAST;
        it.pv_lo = PAST - 512; it.pv_hi = PAST + DS; it.kp_first = PAST - 512; it.kp_step = 64; it.ntiles = 9; it.bias = F.rel_bias + h * 513;
        it.O = F.AUP + row0 * DM + 768 + h * HD; it.ldo = DM; it.G = F.GBD + row0 * 768 + h * HD; it.ldg = 768; return it; }
    idx -= IT_BDS;
    if (idx < IT_SBP) {
        const int b = idx % 2, h = (idx / 2) % 6, qb = 15 - idx / 12; const size_t row0 = (size_t)b * SEQ + 256 * qb;
        it.mode = 0; it.rule = 1; it.Q = F.QSB + row0 * 768 + h * HD; it.ldq = 768; it.nq = 256; it.qpos0 = 256 * qb;
        it.kb = F.KSB + (size_t)b * SEQ * 768 + h * HD; it.vb = F.VSB + (size_t)b * SEQ * 768 + h * HD; it.ldb = 768; it.pb_lo = 0; it.pb_hi = SEQ;
        it.pv_lo = 0; it.pv_hi = SEQ; it.kp_first = 64 * (4 * qb + 3); it.kp_step = -64; it.ntiles = 4 * qb + 4;
        it.O = F.AUP + row0 * DM + h * HD; it.ldo = DM; it.G = F.GSB + row0 * 768 + h * HD; it.ldg = 768; return it; }
    idx -= IT_SBP;
    if (idx < IT_SBS) {
        const int b = idx / 6, h = idx % 6; const size_t row0 = (size_t)MP + b * DS;
        it.mode = 0; it.rule = 1; it.Q = F.QSB + row0 * 768 + h * HD; it.ldq = 768; it.nq = DS; it.qpos0 = PAST;
        it.kb = F.KSB + row0 * 768 + h * HD; it.vb = F.VSB + row0 * 768 + h * HD; it.ldb = 768; it.pb_lo = PAST; it.pb_hi = PAST + DS;
        it.kf = F.c_sbk + (size_t)b * PAST * 768 + h * HD; it.vf = F.c_sbv + (size_t)b * PAST * 768 + h * HD; it.ldf = 768; it.pf_lo = 0; it.pf_hi = PAST;
        it.pv_lo = 0; it.pv_hi = PAST + DS; it.kp_first = PAST + DS - 64; it.kp_step = -64; it.ntiles = (PAST + DS + 63) / 64;
        it.O = F.AUP + row0 * DM + h * HD; it.ldo = DM; it.G = F.GSB + row0 * 768 + h * HD; it.ldg = 768; return it; }
    idx -= IT_SBS;
    if (idx < IT_MMP) {
        const int b = idx / 64, h = (idx / 16) % 4, qb = idx % 16; const size_t row0 = (size_t)b * SEQ + 256 * qb;
        it.mode = 1; it.rule = 0; it.Q = F.QMM + row0 * 512 + h * HD; it.ldq = 512; it.nq = 256; it.qpos0 = 0;
        it.kb = F.MK + (size_t)b * NMEM * 512 + h * HD; it.vb = F.MV + (size_t)b * NMEM * 512 + h * HD; it.ldb = 512; it.pb_lo = 0; it.pb_hi = NMEM;
        it.pv_lo = 0; it.pv_hi = NMEM; it.kp_first = 0; it.kp_step = 64; it.ntiles = 4;
        it.O = F.AUP + row0 * DM + 1536 + h * HD; it.ldo = DM; it.G = F.GMM + row0 * 512 + h * HD; it.ldg = 512; return it; }
    idx -= IT_MMP;
    {
        const int b = idx / 4, h = idx % 4; const size_t row0 = (size_t)MP + b * DS;
        it.mode = 1; it.rule = 0; it.Q = F.QMM + row0 * 512 + h * HD; it.ldq = 512; it.nq = DS; it.qpos0 = 0;
        it.kf = F.c_mk + (size_t)b * NMEM * 512 + h * HD; it.vf = F.c_mv + (size_t)b * NMEM * 512 + h * HD; it.ldf = 512; it.pf_lo = 0; it.pf_hi = NMEM;
        it.pv_lo = 0; it.pv_hi = NMEM; it.kp_first = 0; it.kp_step = 64; it.ntiles = 4;
        it.O = F.AUP + row0 * DM + 1536 + h * HD; it.ldo = DM; it.G = F.GMM + row0 * 512 + h * HD; it.ldg = 512; return it; }
}

struct Args { const void* in[19]; float* out; unsigned char* ws; int ph_lo, ph_hi; };
__global__ void __launch_bounds__(NWAVES * 64, 2) fwd_megakernel(Args args) {
    extern __shared__ __attribute__((aligned(16))) unsigned char lds[];
    Frame F;
    F.lds = (LAS unsigned char*)lds;
    F.MISC = (volatile LAS unsigned*)(F.lds + MISC_OFF);
    F.G = gridDim.x; { const int bx = blockIdx.x; F.vcu = (F.G % 8 == 0) ? (bx % 8) * (F.G / 8) + bx / 8 : bx; }
    unsigned char* ws = args.ws;
    F.ctl = (gu32*)(ws + WS_CTL);
    F.x_prompt = (const float*)args.in[0]; F.x_sample = (const float*)args.in[1]; F.c_sbk = (const float*)args.in[2]; F.c_sbv = (const float*)args.in[3];
    F.c_bdk = (const float*)args.in[4]; F.c_bdv = (const float*)args.in[5]; F.c_mk = (const float*)args.in[6]; F.c_mv = (const float*)args.in[7];
    F.mem_prompt = (const float*)args.in[8]; F.g_pre = (const float*)args.in[9]; F.w_in = (const float*)args.in[10]; F.rel_bias = (const float*)args.in[11];
    F.g_mem = (const float*)args.in[12]; F.w_mem_kv = (const float*)args.in[13]; F.w_up_sb = (const float*)args.in[14]; F.w_up_band = (const float*)args.in[15];
    F.w_up_mem = (const float*)args.in[16]; F.w_out = (const float*)args.in[17]; F.g_post = (const float*)args.in[18];
    F.out = args.out;
    F.WCAT = (bf16*)(ws + WS_WCAT); F.WUP = (bf16*)(ws + WS_WUP); F.WOUT = (bf16*)(ws + WS_WOUT); F.ACAT = (bf16*)(ws + WS_ACAT); F.MERGED = (bf16*)(ws + WS_ACAT);
    F.QSB = (bf16*)(ws + WS_QSB); F.KSB = (bf16*)(ws + WS_KSB); F.VSB = (bf16*)(ws + WS_VSB); F.GSB = (bf16*)(ws + WS_GSB);
    F.QBD = (bf16*)(ws + WS_QBD); F.KBD = (bf16*)(ws + WS_KBD); F.VBD = (bf16*)(ws + WS_VBD); F.GBD = (bf16*)(ws + WS_GBD);
    F.QMM = (bf16*)(ws + WS_QMM); F.GMM = (bf16*)(ws + WS_GMM); F.MG = (bf16*)(ws + WS_MG); F.MK = (bf16*)(ws + WS_MK); F.MV = (bf16*)(ws + WS_MV);
    F.AUP = (bf16*)(ws + WS_AUP); F.SSQ = (float*)(ws + WS_SSQ);
    for (int u = threadIdx.x; u < (LDS_BYTES - LDSCTL_OFF) / 4; u += NWAVES * 64) ((LAS unsigned*)(F.lds + LDSCTL_OFF))[u] = 0u;
    __syncthreads();
    XcdBarrier bar; bar.bar = (unsigned*)(F.ctl + CW_BAR); bar.x = 0; bar.st = nullptr;
    if (N_LAUNCHES != PER_PHASE) bar = xcd_barrier_post((unsigned*)(F.ctl + CW_BAR), F.MISC + 8);
#define GRID_BAR() do { if (N_LAUNCHES != PER_PHASE) xcd_barrier(bar); } while (0)
    const int lo = args.ph_lo, hi = args.ph_hi;
#ifdef ONLY_PHASE
#define IN(k) ((k) == ONLY_PHASE && lo <= (k) && (k) < hi)
#else
#define IN(k) (lo <= (k) && (k) < hi)
#endif
#define BOTH(k) (IN(k) && IN((k) + 1))

    if (IN(0)) { p0_prologue(F); if (BOTH(0)) GRID_BAR(); }

    if (IN(1)) {
        pg8::Gemm g{F.ACAT, F.WCAT, MA, NCAT, DM}; ep::InOrder S; S.init(F.G, (int)blockIdx.x);
        ep::EpiIn E{F.QSB, F.KSB, F.VSB, F.GSB, F.QBD, F.KBD, F.VBD, F.GBD, F.QMM, F.GMM, F.MG, F.MK, F.MV, F.out};
        pg8::gemm_phase<ep::EpiIn, ep::InOrder, true, true>(F.lds, g, S, E);
        if (BOTH(1)) GRID_BAR();
    }

    if (IN(2)) {
        volatile LAS int* slot = (volatile LAS int*)(F.lds + att::OFF_ITEM);
        for (;;) {
            if (threadIdx.x == 0) *slot = (int)__hip_atomic_fetch_add((unsigned*)(F.ctl + CW_WORK), 1u, RLX_AGENT);
            __syncthreads();
            const int idx = __builtin_amdgcn_readfirstlane(*slot);
            __syncthreads();
            if (idx >= IT_TOTAL) break;
            const att::Item it = make_item(F, idx);
            if (it.mode == 0) att::run_item<0>(it, (char*)lds, F.lds); else att::run_item<1>(it, (char*)lds, F.lds);
        }
        if (BOTH(2)) GRID_BAR();
    }

    if (IN(3)) {
        pg8::Gemm g{F.AUP, F.WUP, MIN_, DM, DM}; ep::MergeOrder S; S.init(F.G, (int)blockIdx.x);
        ep::EpiMerge E{F.MG, F.MERGED};
        pg8::gemm_phase<ep::EpiMerge, ep::MergeOrder, true, true>(F.lds, g, S, E);
        if (BOTH(3)) GRID_BAR();
    }

    if (IN(4)) {
        pg8::Gemm g{F.MERGED, F.WOUT, MIN_, DM, DM}; pg8::StaticOrder S; S.init(MIN_, DM, F.G, (int)blockIdx.x);
        ep::EpiOut E{F.out, F.SSQ};
        pg8::gemm_phase<ep::EpiOut, pg8::StaticOrder, true, true>(F.lds, g, S, E);
        if (BOTH(4)) GRID_BAR();
    }

    if (IN(5)) p5_final(F);
#undef IN
#undef BOTH
#undef GRID_BAR
}

extern "C" void kernel_launch(void* const* d_in, const int* in_sizes, int n_in, void* d_out, int out_size, void* d_ws, size_t ws_size, hipStream_t stream) {
    static int grid = 0;
    if (grid == 0) {
        if (n_in != 19 || in_sizes[0] != MP * DM || in_sizes[10] != DM * INW || out_size != OUT_ELEMS || ws_size < WS_END) {
            fprintf(stderr, "kernel_launch: built for 19 inputs, x_prompt %d, w_in %d, out %d floats, >= %zu bytes of workspace; got n_in %d, in0 %d, in10 %d, out %d, ws %zu; nothing launched\n",
                    MP * DM, DM * INW, OUT_ELEMS, (size_t)WS_END, n_in, n_in > 0 ? in_sizes[0] : -1, n_in > 10 ? in_sizes[10] : -1, out_size, ws_size);
            grid = -1; return; }
        int dev = 0, cus = 0, per_cu = 0;
        if (hipGetDevice(&dev) != hipSuccess || hipDeviceGetAttribute(&cus, hipDeviceAttributeMultiprocessorCount, dev) != hipSuccess) { fprintf(stderr, "kernel_launch: device query failed\n"); grid = -1; return; }
        if (hipFuncSetAttribute((const void*)fwd_megakernel, hipFuncAttributeMaxDynamicSharedMemorySize, LDS_BYTES) != hipSuccess) { fprintf(stderr, "kernel_launch: hipFuncSetAttribute(%d B LDS) failed\n", LDS_BYTES); grid = -1; return; }
        if (hipOccupancyMaxActiveBlocksPerMultiprocessor(&per_cu, (const void*)fwd_megakernel, NWAVES * 64, LDS_BYTES) != hipSuccess || per_cu < 1) {
            fprintf(stderr, "kernel_launch: occupancy query reports %d workgroups per CU; nothing launched\n", per_cu); (void)hipGetLastError(); grid = -1; return; }
        grid = cus;
    }
    if (grid < 0) return;
    if (hipMemsetAsync((char*)d_ws + WS_CTL, 0, CTL_ZERO_BYTES, stream) != hipSuccess) { fprintf(stderr, "kernel_launch: hipMemsetAsync failed\n"); return; }
    Args a{};
    for (int i = 0; i < 19; ++i) a.in[i] = d_in[i];
    a.out = (float*)d_out; a.ws = (unsigned char*)d_ws;
    if (N_LAUNCHES == 1) {
        a.ph_lo = 0; a.ph_hi = PER_PHASE;
        hipLaunchKernelGGL(fwd_megakernel, dim3(grid), dim3(NWAVES * 64), LDS_BYTES, stream, a);
    } else {
        for (int li = 0; li < PER_PHASE; ++li) { a.ph_lo = li; a.ph_hi = li + 1; hipLaunchKernelGGL(fwd_megakernel, dim3(grid), dim3(NWAVES * 64), LDS_BYTES, stream, a); }
    }
    const hipError_t le = hipPeekAtLastError();
    if (le != hipSuccess) fprintf(stderr, "kernel_launch: launch failed: %s (grid %d)\n", hipGetErrorName(le), grid);
}
```

```cpp
#include <hip/hip_runtime.h>
#include <hip/hip_bf16.h>
#include <cstdio>
#include <cstdint>

#ifndef MK_N_LAUNCHES
#define MK_N_LAUNCHES 1
#endif
#ifndef DBG_REPEAT
#define DBG_REPEAT -1
#endif
#ifndef SB_EARLY_EXIT
#define SB_EARLY_EXIT 1
#endif

constexpr int DM = 2048, SEQ = 4096, NB = 2, DB = 8, DS = 16, PAST = 4096, HD = 128;
constexpr int MP = NB * SEQ;
constexpr int MS = DB * DS;
constexpr int MIN_ = 8448;
constexpr int MREAL = MP + MS;
constexpr int MMEM0 = 8448;
constexpr int MA = 8960;
constexpr int INW = 13312, NCAT = 14336;
constexpr int NMEM = 256;
constexpr float RMS_EPS = 1e-6f;
constexpr float LOG2E = 1.4426950408889634f;
constexpr float QSCALE = 0.08838834764831845f * 1.4426950408889634f;

namespace pg8 {
#define PG8_LAS __attribute__((address_space(3)))
typedef unsigned short bf16_t;
typedef short bf16x8 __attribute__((ext_vector_type(8)));
typedef float f32x4 __attribute__((ext_vector_type(4)));
typedef unsigned u32x4 __attribute__((ext_vector_type(4)));
constexpr int BM = 256, BK = 64, HALF = 128, HTB = HALF * BK * 2  , STAGE_BYTES = 8 * HTB, NXCD = 8, WGM = 8;

__host__ __device__ __forceinline__ int lds_byte(int r, int c) { const int st = (r >> 4) * 2 + (c >> 5), rr = r & 15, cc = c & 31, ob = rr * 64 + cc * 2; return st * 1024 + (ob ^ (((ob >> 9) & 1) << 5)); }
__host__ __device__ __forceinline__ void stage_rc(int b, int& R, int& C) { const int st = b / 1024, sb = b % 1024, swz = sb ^ (((sb >> 9) & 1) << 5); R = (st >> 1) * 16 + swz / 64; C = (st & 1) * 32 + (swz % 64) / 2; }
__host__ __device__ __forceinline__ int perm32(int rho) { const int n = rho >> 4, i = rho & 15; return 8 * (i >> 2) + 4 * n + (i & 3); }

struct Unit { int pm, pn, k0, nt; };
struct Gemm { const bf16_t* A; const bf16_t* Bt; int M, N, K; };

struct StaticOrder {
    int nM, nN, nwg, G, c;
    __host__ __device__ void init(int M, int N, int G_, int c_) { nM = M / BM; nN = N / BM; nwg = nM * nN; G = G_; c = c_; }
    __host__ __device__ bool next(int i, Unit& u) const {
        const long L = (long)i * G + c; if (L >= nwg) return false;
        int wgid = (int)L; { const int q = nwg / NXCD, r = nwg % NXCD, xcd = wgid % NXCD, off = wgid / NXCD; wgid = (xcd < r ? xcd * (q + 1) : r * (q + 1) + (xcd - r) * q) + off; }
        const int nig = WGM * nN, gid = wgid / nig, fm = gid * WGM, gsz = (nM - fm) < WGM ? (nM - fm) : WGM;
        u.pm = fm + ((wgid % nig) % gsz); u.pn = (wgid % nig) / gsz; u.k0 = 0; u.nt = 0; return true;
    }
    __device__ __forceinline__ void a_ready(const Unit&) const {}
    __device__ __forceinline__ void done(const Unit&) const {}
};

typedef float f32x2_t __attribute__((ext_vector_type(2))); typedef __bf16 bf16x2_t __attribute__((ext_vector_type(2)));
__device__ __forceinline__ unsigned cvt_pk_bf16(float lo, float hi) { f32x2_t v = {lo, hi}; bf16x2_t b = __builtin_convertvector(v, bf16x2_t); return __builtin_bit_cast(unsigned, b); }

template <class Epi, class Sched, bool ALIGN_EPI = false, bool SP2 = false>
__device__ __forceinline__ void gemm_phase(PG8_LAS unsigned char* lds, const Gemm g, const Sched& S, const Epi& E) {
    const int tid = threadIdx.x, wid = __builtin_amdgcn_readfirstlane(tid >> 6), lane = tid & 63, wr = wid >> 2, wc = wid & 3, fr = lane & 15, fq = lane >> 4;
    const int K = g.K, nt = K / BK;
    unsigned voffA[2], voffB[2];
#pragma unroll
    for (int i = 0; i < 2; ++i) { int R, C; stage_rc(tid * 16 + i * 8192, R, C); const int Rb = Epi::PERM ? ((R & ~31) + perm32(R & 31)) : R;
        voffA[i] = (unsigned)(R * K + C) * 2u; voffB[i] = (unsigned)(Rb * K + C) * 2u; }
    const size_t kstep = (size_t)(BK * 2);
    const size_t hstep = (size_t)HALF * K * 2;
    const size_t tstep = 2 * hstep;
    const unsigned ldsw = (unsigned)wid * 1024u;
    const int aoff = lds_byte(wr * 64 + fr, fq * 8), boff = lds_byte(wc * 32 + fr, fq * 8);
#define PG8_SA(b, h) (((b) * 2 + (h)) * HTB)
#define PG8_SB(b, h) ((4 + (b) * 2 + (h)) * HTB)
#define PG8_STAGE(bufoff, gbase, voff) do { _Pragma("unroll") for (int _i = 0; _i < 2; ++_i) \
        __builtin_amdgcn_global_load_lds((const unsigned*)((const char*)(gbase) + (voff)[_i]), (PG8_LAS unsigned*)(lds + (bufoff) + ldsw + _i * 8192), 16, 0, 0); } while (0)
#define PG8_LDA(dst, b, h) do { _Pragma("unroll") for (int m = 0; m < 4; ++m) _Pragma("unroll") for (int k = 0; k < 2; ++k) dst[m][k] = *(const PG8_LAS bf16x8*)(lds + PG8_SA(b, h) + aoff + m * 2048 + k * 1024); } while (0)
#define PG8_LDB(dst, b, h) do { _Pragma("unroll") for (int n = 0; n < 2; ++n) _Pragma("unroll") for (int k = 0; k < 2; ++k) dst[n][k] = *(const PG8_LAS bf16x8*)(lds + PG8_SB(b, h) + boff + n * 2048 + k * 1024); } while (0)
#define PG8_MMA(ai, bj, At, Bt) do { __builtin_amdgcn_s_setprio(1); _Pragma("unroll") for (int m = 0; m < 4; ++m) _Pragma("unroll") for (int n = 0; n < 2; ++n) _Pragma("unroll") for (int k = 0; k < 2; ++k) \
        acc[ai][bj][m][n] = __builtin_amdgcn_mfma_f32_16x16x32_bf16(Bt[n][k], At[m][k], acc[ai][bj][m][n], 0, 0, 0); __builtin_amdgcn_s_setprio(0); } while (0)
#define PG8_WAIT_V(n) asm volatile("s_waitcnt vmcnt(" #n ")" ::: "memory")
#define PG8_WAIT_L(n) asm volatile("s_waitcnt lgkmcnt(" #n ")" ::: "memory")
#define PG8_BAR __builtin_amdgcn_s_barrier()
#define PG8_SCHED __builtin_amdgcn_sched_barrier(0)
    Unit cur, nxt; int ui = 0;
    if (!S.next(0, cur)) return;
    f32x4 acc[2][2][4][2];
#pragma unroll
    for (int a = 0; a < 2; ++a)
#pragma unroll
        for (int b = 0; b < 2; ++b)
#pragma unroll
            for (int m = 0; m < 4; ++m)
#pragma unroll
                for (int n = 0; n < 2; ++n) acc[a][b][m][n] = (f32x4){0.f, 0.f, 0.f, 0.f};
    bf16x8 At[4][2], B0[2][2], B1[2][2];
    const char* cA = (const char*)g.A + (size_t)cur.pm * tstep + (size_t)cur.k0 * 2; const char* cB = (const char*)g.Bt + (size_t)cur.pn * tstep + (size_t)cur.k0 * 2;
    S.a_ready(cur);
    if constexpr (SP2) {
        PG8_STAGE(PG8_SB(0, 0), cB, voffB); PG8_STAGE(PG8_SB(0, 1), cB + hstep, voffB); PG8_STAGE(PG8_SA(0, 0), cA, voffA); PG8_STAGE(PG8_SA(0, 1), cA + hstep, voffA);
        if (wr == 1) PG8_BAR;
        PG8_WAIT_V(2); PG8_BAR;
        PG8_STAGE(PG8_SB(1, 0), cB + kstep, voffB); PG8_STAGE(PG8_SA(1, 0), cA + kstep, voffA); PG8_STAGE(PG8_SB(1, 1), cB + hstep + kstep, voffB);
        PG8_WAIT_V(6); PG8_BAR;
    } else {
        PG8_STAGE(PG8_SB(0, 0), cB, voffB); PG8_STAGE(PG8_SA(0, 0), cA, voffA); PG8_STAGE(PG8_SB(0, 1), cB + hstep, voffB); PG8_STAGE(PG8_SA(0, 1), cA + hstep, voffA);
        if (wr == 1) PG8_BAR;
        PG8_WAIT_V(4); PG8_BAR;
        PG8_STAGE(PG8_SB(1, 0), cB + kstep, voffB); PG8_STAGE(PG8_SA(1, 0), cA + kstep, voffA); PG8_STAGE(PG8_SB(1, 1), cB + hstep + kstep, voffB);
        PG8_WAIT_V(6); PG8_BAR;
    }
    for (;;) {
        const bool has_next = S.next(ui + 1, nxt);
        const char* nA = has_next ? (const char*)g.A + (size_t)nxt.pm * tstep + (size_t)nxt.k0 * 2 : cA; const char* nB = has_next ? (const char*)g.Bt + (size_t)nxt.pn * tstep + (size_t)nxt.k0 * 2 : cB;
        const int ntu = cur.nt ? cur.nt : nt;
        for (int t = 0; t < ntu; t += 2) {
            const bool last = (t == ntu - 2);
            const char* a1 = cA + (size_t)(t + 1) * kstep;
            const char* a2 = last ? nA : cA + (size_t)(t + 2) * kstep; const char* b2 = last ? nB : cB + (size_t)(t + 2) * kstep;
            const char* a3 = a2 + kstep; const char* b3 = b2 + kstep;
            if (last && has_next) S.a_ready(nxt);
            if constexpr (SP2) {
            PG8_LDB(B0, 0, 0); PG8_LDB(B1, 0, 1); PG8_SCHED; PG8_LDA(At, 0, 0); PG8_STAGE(PG8_SA(1, 1), a1 + hstep, voffA);
            PG8_WAIT_V(8); PG8_WAIT_L(0); PG8_BAR; PG8_MMA(0, 0, At, B0); PG8_MMA(0, 1, At, B1); PG8_BAR; PG8_SCHED;
            PG8_LDA(At, 0, 1); PG8_STAGE(PG8_SB(0, 0), b2, voffB); PG8_STAGE(PG8_SB(0, 1), b2 + hstep, voffB); PG8_STAGE(PG8_SA(0, 0), a2, voffA);
            PG8_WAIT_V(8); PG8_WAIT_L(0); PG8_BAR; PG8_MMA(1, 0, At, B0); PG8_MMA(1, 1, At, B1); PG8_BAR; PG8_SCHED;
            PG8_LDB(B0, 1, 0); PG8_LDB(B1, 1, 1); PG8_SCHED; PG8_LDA(At, 1, 0); PG8_STAGE(PG8_SA(0, 1), a2 + hstep, voffA);
            PG8_WAIT_V(8); PG8_WAIT_L(0); PG8_BAR; PG8_MMA(0, 0, At, B0); PG8_MMA(0, 1, At, B1); PG8_BAR; PG8_SCHED;
            PG8_LDA(At, 1, 1); PG8_STAGE(PG8_SB(1, 0), b3, voffB); PG8_STAGE(PG8_SB(1, 1), b3 + hstep, voffB); PG8_STAGE(PG8_SA(1, 0), a3, voffA);
            PG8_WAIT_V(8); PG8_WAIT_L(0); PG8_BAR; PG8_MMA(1, 0, At, B0); PG8_MMA(1, 1, At, B1); PG8_BAR; PG8_SCHED;
            } else {
            PG8_LDB(B0, 0, 0); PG8_SCHED; PG8_LDA(At, 0, 0); PG8_STAGE(PG8_SA(1, 1), a1 + hstep, voffA);
            PG8_WAIT_L(8); PG8_BAR; PG8_WAIT_L(0); PG8_MMA(0, 0, At, B0); PG8_BAR; PG8_SCHED;
            PG8_LDB(B1, 0, 1); PG8_STAGE(PG8_SB(0, 0), b2, voffB);
            PG8_BAR; PG8_WAIT_L(0); PG8_MMA(0, 1, At, B1); PG8_BAR;
            PG8_LDA(At, 0, 1); PG8_STAGE(PG8_SA(0, 0), a2, voffA);
            PG8_BAR; PG8_WAIT_L(0); PG8_MMA(1, 0, At, B0); PG8_BAR; PG8_SCHED;
            PG8_STAGE(PG8_SB(0, 1), b2 + hstep, voffB);
            PG8_WAIT_V(6); PG8_BAR; PG8_MMA(1, 1, At, B1); PG8_BAR;
            PG8_LDB(B0, 1, 0); PG8_SCHED; PG8_LDA(At, 1, 0); PG8_STAGE(PG8_SA(0, 1), a2 + hstep, voffA);
            PG8_WAIT_L(8); PG8_BAR; PG8_WAIT_L(0); PG8_MMA(0, 0, At, B0); PG8_BAR; PG8_SCHED;
            PG8_LDB(B1, 1, 1); PG8_STAGE(PG8_SB(1, 0), b3, voffB);
            PG8_BAR; PG8_WAIT_L(0); PG8_MMA(0, 1, At, B1); PG8_BAR;
            PG8_LDA(At, 1, 1); PG8_STAGE(PG8_SA(1, 0), a3, voffA);
            PG8_BAR; PG8_WAIT_L(0); PG8_MMA(1, 0, At, B0); PG8_BAR; PG8_SCHED;
            PG8_STAGE(PG8_SB(1, 1), b3 + hstep, voffB);
            PG8_WAIT_V(6); PG8_BAR; PG8_MMA(1, 1, At, B1); PG8_BAR;
            }
        }
        if constexpr (ALIGN_EPI) { if (wr == 0) PG8_BAR; }
        if constexpr (!Epi::AFTER_DRAIN) { E(acc, cur, wr, wc, fr, fq); S.done(cur); }
        if (!has_next) break;
        if (E.reset_after(cur))
#pragma unroll
        for (int a = 0; a < 2; ++a)
#pragma unroll
            for (int b = 0; b < 2; ++b)
#pragma unroll
                for (int m = 0; m < 4; ++m)
#pragma unroll
                    for (int n = 0; n < 2; ++n) acc[a][b][m][n] = (f32x4){0.f, 0.f, 0.f, 0.f};
        cur = nxt; cA = nA; cB = nB; ++ui;
        if constexpr (ALIGN_EPI) { if (wr == 1) PG8_BAR; }
    }
    PG8_WAIT_V(0);
    if constexpr (!ALIGN_EPI) { if (wr == 0) PG8_BAR; }
    PG8_BAR;
    if constexpr (Epi::AFTER_DRAIN) { E.fused(acc, cur, wr, wc, fr, fq, lds, wid, lane); S.done(cur); }
#undef PG8_SA
#undef PG8_SB
#undef PG8_STAGE
#undef PG8_LDA
#undef PG8_LDB
#undef PG8_MMA
#undef PG8_WAIT_V
#undef PG8_WAIT_L
#undef PG8_BAR
#undef PG8_SCHED
}
}

namespace ep {
using pg8::f32x4; using pg8::u32x4; using pg8::Unit; using pg8::bf16_t; using pg8::HALF; using pg8::BM; using pg8::cvt_pk_bf16;
typedef unsigned u32x2 __attribute__((ext_vector_type(2)));

struct InOrder {
    pg8::StaticOrder so; int G, c;
    __device__ void init(int G_, int c_) { so.init(MIN_, INW, G_, c_); G = G_; c = c_; }
    __device__ bool next(int i, Unit& u) const {
        const long L = (long)i * G + c;
        if (L < so.nwg) return so.next(i, u);
        const int j = (int)(L - so.nwg); if (j >= 8) return false;
        u.pm = 33 + (j & 1); u.pn = 52 + (j >> 1); u.k0 = 0; u.nt = 0; return true;
    }
    __device__ __forceinline__ void a_ready(const Unit&) const {}
    __device__ __forceinline__ void done(const Unit&) const {}
};

__device__ __forceinline__ float sigmoidf_fast(float x) { return __builtin_amdgcn_rcpf(1.0f + __builtin_amdgcn_exp2f(-x * LOG2E)); }
__device__ __forceinline__ float bf2f(unsigned short h) { return __uint_as_float((unsigned)h << 16); }

struct EpiIn {
    static constexpr bool PERM = true, AFTER_DRAIN = false;
    bf16_t *QSB, *KSB, *VSB, *GSB, *QBD, *KBD, *VBD, *GBD, *QMM, *GMM, *MG, *MK, *MV;
    float* out;
    __device__ __forceinline__ bool reset_after(const Unit&) const { return true; }
    template <int ACT, int F32>
    __device__ __forceinline__ void store(const f32x4 (&acc)[2][2][4][2], bf16_t* dst, int ldc, int colt, int rowoff, int pm, float* f0, float* f1, int wr, int wc, int fr, int fq) const {
        const int col0 = colt + wc * 32 + 8 * fq;
#pragma unroll
        for (int ai = 0; ai < 2; ++ai)
#pragma unroll
            for (int m = 0; m < 4; ++m) {
                const int r = pm * BM + ai * HALF + wr * 64 + m * 16 + fr;
                bf16_t* rowp = dst + (size_t)(r - rowoff) * ldc + col0;
                float* frow = nullptr;
                if (F32 == 1) { if (r < MP) frow = f0 + (size_t)r * 768; else if (r < MREAL) frow = f1 + (size_t)(r - MP) * 768; }
                if (F32 == 2) { if (r < MP) { const int t = r & (SEQ - 1); if (t >= SEQ - 512) frow = f0 + ((size_t)(r >> 12) * 512 + (t - (SEQ - 512))) * 768; } else if (r < MREAL) frow = f1 + (size_t)(r - MP) * 768; }
                if (F32 == 3) frow = f0 + (size_t)(r - MMEM0) * 512;
#pragma unroll
                for (int bj = 0; bj < 2; ++bj) {
                    f32x4 v0 = acc[ai][bj][m][0], v1 = acc[ai][bj][m][1];
                    if (F32 != 0) { if (frow) { *(f32x4*)(frow + col0 + bj * HALF) = v0; *(f32x4*)(frow + col0 + bj * HALF + 4) = v1; } }
                    if (ACT == 1) { v0 = v0 * QSCALE; v1 = v1 * QSCALE; }
                    if (ACT == 2) {
#pragma unroll
                        for (int e = 0; e < 4; ++e) { v0[e] = v0[e] * sigmoidf_fast(v0[e]); v1[e] = v1[e] * sigmoidf_fast(v1[e]); } }
                    if (ACT == 3) {
#pragma unroll
                        for (int e = 0; e < 4; ++e) { v0[e] = sigmoidf_fast(v0[e]); v1[e] = sigmoidf_fast(v1[e]); } }
                    u32x4 w; w.x = cvt_pk_bf16(v0[0], v0[1]); w.y = cvt_pk_bf16(v0[2], v0[3]); w.z = cvt_pk_bf16(v1[0], v1[1]); w.w = cvt_pk_bf16(v1[2], v1[3]);
                    *(u32x4*)(rowp + bj * HALF) = w; }
            }
    }
    __device__ __forceinline__ void operator()(const f32x4 (&acc)[2][2][4][2], const Unit& u, int wr, int wc, int fr, int fq) const {
        const int pn = u.pn, pm = u.pm;
        float* const o_sbk = out + 17039360, * const o_sbv = out + 23330816, * const o_bdk = out + 29622272, * const o_bdv = out + 30408704;
        float* const o_mk = out + 31195136, * const o_mv = out + 31457280;
        float* const s_sbk = out + 31719424, * const s_sbv = out + 31817728, * const s_bdk = out + 31916032, * const s_bdv = out + 32014336;
        if (pn < 3)        store<1, 0>(acc, QSB, 768, 256 * pn, 0, pm, nullptr, nullptr, wr, wc, fr, fq);
        else if (pn < 6)   store<0, 1>(acc, KSB, 768, 256 * (pn - 3), 0, pm, o_sbk, s_sbk, wr, wc, fr, fq);
        else if (pn < 9)   store<0, 1>(acc, VSB, 768, 256 * (pn - 6), 0, pm, o_sbv, s_sbv, wr, wc, fr, fq);
        else if (pn < 12)  store<2, 0>(acc, GSB, 768, 256 * (pn - 9), 0, pm, nullptr, nullptr, wr, wc, fr, fq);
        else if (pn < 15)  store<1, 0>(acc, QBD, 768, 256 * (pn - 12), 0, pm, nullptr, nullptr, wr, wc, fr, fq);
        else if (pn < 18)  store<0, 2>(acc, KBD, 768, 256 * (pn - 15), 0, pm, o_bdk, s_bdk, wr, wc, fr, fq);
        else if (pn < 21)  store<0, 2>(acc, VBD, 768, 256 * (pn - 18), 0, pm, o_bdv, s_bdv, wr, wc, fr, fq);
        else if (pn < 24)  store<2, 0>(acc, GBD, 768, 256 * (pn - 21), 0, pm, nullptr, nullptr, wr, wc, fr, fq);
        else if (pn < 26)  store<1, 0>(acc, QMM, 512, 256 * (pn - 24), 0, pm, nullptr, nullptr, wr, wc, fr, fq);
        else if (pn < 28)  store<2, 0>(acc, GMM, 512, 256 * (pn - 26), 0, pm, nullptr, nullptr, wr, wc, fr, fq);
        else if (pn < 52)  store<3, 0>(acc, MG, 6144, 256 * (pn - 28), 0, pm, nullptr, nullptr, wr, wc, fr, fq);
        else if (pn < 54)  store<0, 3>(acc, MK, 512, 256 * (pn - 52), MMEM0, pm, o_mk, nullptr, wr, wc, fr, fq);
        else               store<0, 3>(acc, MV, 512, 256 * (pn - 54), MMEM0, pm, o_mv, nullptr, wr, wc, fr, fq);
    }
};

struct MergeOrder {
    pg8::StaticOrder so;
    __device__ void init(int G_, int c_) { so.init(MP, DM, G_, c_); }
    __device__ bool next(int i, Unit& u) const {
        const int ti = i / 3, seg = i - 3 * ti;
        if (!so.next(ti, u)) return false;
        u.k0 = 768 * seg; u.nt = (seg == 2) ? 8 : 12; return true;
    }
    __device__ __forceinline__ void a_ready(const Unit&) const {}
    __device__ __forceinline__ void done(const Unit&) const {}
};
struct EpiMerge {
    static constexpr bool PERM = true, AFTER_DRAIN = false;
    const bf16_t* MG; bf16_t* OUT;
    __device__ __forceinline__ bool reset_after(const Unit& u) const { return u.k0 == 1536; }
    __device__ __forceinline__ void operator()(f32x4 (&acc)[2][2][4][2], const Unit& u, int wr, int wc, int fr, int fq) const {
        const int col0 = u.pn * BM + wc * 32 + 8 * fq;
        const int seg = (u.k0 == 0) ? 0 : (u.k0 == 768 ? 1 : 2);
#pragma unroll
        for (int ai = 0; ai < 2; ++ai)
#pragma unroll
            for (int m = 0; m < 4; ++m) {
                const int r = u.pm * BM + ai * HALF + wr * 64 + m * 16 + fr;
                const bf16_t* g = MG + (size_t)r * 6144 + seg * 2048 + col0; bf16_t* rowp = OUT + (size_t)r * DM + col0;
#pragma unroll
                for (int bj = 0; bj < 2; ++bj) {
                    const u32x4 a = *(const u32x4*)(g + bj * HALF);
                    float f[8];
#pragma unroll
                    for (int e = 0; e < 4; ++e) { f[2 * e] = fmaxf(__uint_as_float(a[e] << 16), 1e-30f); f[2 * e + 1] = fmaxf(__uint_as_float(a[e] & 0xffff0000u), 1e-30f); }
                    if (seg < 2) {
                        const u32x4 b = *(const u32x4*)(g + 2048 + bj * HALF);
#pragma unroll
                        for (int e = 0; e < 4; ++e) { f[2 * e] *= __builtin_amdgcn_rcpf(fmaxf(__uint_as_float(b[e] << 16), 1e-30f)); f[2 * e + 1] *= __builtin_amdgcn_rcpf(fmaxf(__uint_as_float(b[e] & 0xffff0000u), 1e-30f)); }
                    }
#pragma unroll
                    for (int k = 0; k < 8; ++k) acc[ai][bj][m][k >> 2][k & 3] *= f[k];
                    if (seg == 2) {
                        u32x4 w; w.x = cvt_pk_bf16(acc[ai][bj][m][0][0], acc[ai][bj][m][0][1]); w.y = cvt_pk_bf16(acc[ai][bj][m][0][2], acc[ai][bj][m][0][3]);
                        w.z = cvt_pk_bf16(acc[ai][bj][m][1][0], acc[ai][bj][m][1][1]); w.w = cvt_pk_bf16(acc[ai][bj][m][1][2], acc[ai][bj][m][1][3]);
                        *(u32x4*)(rowp + bj * HALF) = w; }
                }
                if (m == 3) asm volatile("" ::: "memory");
            }
    }
};

struct EpiOut {
    static constexpr bool PERM = false, AFTER_DRAIN = false;
    float* out; float* ssq;
    __device__ __forceinline__ bool reset_after(const Unit&) const { return true; }
    __device__ __forceinline__ void operator()(const f32x4 (&acc)[2][2][4][2], const Unit& u, int wr, int wc, int fr, int fq) const {
        const int col0 = u.pn * BM + wc * 32 + 4 * fq;
#pragma unroll
        for (int ai = 0; ai < 2; ++ai)
#pragma unroll
            for (int m = 0; m < 4; ++m) {
                const int r = u.pm * BM + ai * HALF + wr * 64 + m * 16 + fr;
                float* yrow = out + (size_t)r * DM;
                float s = 0.f;
#pragma unroll
                for (int bj = 0; bj < 2; ++bj)
#pragma unroll
                    for (int n = 0; n < 2; ++n) { const f32x4 v = acc[ai][bj][m][n]; s += (v[0] * v[0] + v[1] * v[1]) + (v[2] * v[2] + v[3] * v[3]);
                        *(f32x4*)(yrow + col0 + bj * HALF + n * 16) = v; }
                s += __shfl_xor(s, 16); s += __shfl_xor(s, 32);
                if (fq == 0) ssq[(size_t)r * 32 + u.pn * 4 + wc] = s;
            }
    }
};

template <int MODE>
__device__ __forceinline__ void skinny_phase(const bf16_t* A, const bf16_t* Bt, const bf16_t* MG, bf16_t* OUTB, float* OUTF, float* SSQS, int slice, __attribute__((address_space(3))) unsigned char* ldsl) {
    typedef short bf16x8 __attribute__((ext_vector_type(8)));
    const int tid = threadIdx.x, lane = tid & 63, fr = lane & 15, fq = lane >> 4;
    const int w = __builtin_amdgcn_readfirstlane(tid >> 6), rb = w & 3, kh = w >> 2;
    const int cb = slice >> 1, rh = slice & 1;
    const int row = MP + 64 * rh + 16 * rb + fr;
    const bf16_t* ap = A + (size_t)row * DM + 8 * fq + 1024 * kh;
    const bf16_t* bp = Bt + (size_t)(16 * cb + fr) * DM + 8 * fq + 1024 * kh;
    const bf16_t* gp = MG + (size_t)row * 6144 + 16 * cb + 4 * fq;
    f32x4 acc = {0.f, 0.f, 0.f, 0.f};
#pragma unroll 1
    for (int kb = 0; kb < 4; ++kb) {
        if (MODE == 0) { const int k0 = 1024 * kh + 256 * kb;
            if (k0 == 768 || k0 == 1536) { const int s = (k0 == 768) ? 0 : 1;
                const u32x2 ga = *(const u32x2*)(gp + s * 2048), gb = *(const u32x2*)(gp + (s + 1) * 2048);
                acc[0] *= fmaxf(__uint_as_float(ga.x << 16), 1e-30f) * __builtin_amdgcn_rcpf(fmaxf(__uint_as_float(gb.x << 16), 1e-30f));
                acc[1] *= fmaxf(__uint_as_float(ga.x & 0xffff0000u), 1e-30f) * __builtin_amdgcn_rcpf(fmaxf(__uint_as_float(gb.x & 0xffff0000u), 1e-30f));
                acc[2] *= fmaxf(__uint_as_float(ga.y << 16), 1e-30f) * __builtin_amdgcn_rcpf(fmaxf(__uint_as_float(gb.y << 16), 1e-30f));
                acc[3] *= fmaxf(__uint_as_float(ga.y & 0xffff0000u), 1e-30f) * __builtin_amdgcn_rcpf(fmaxf(__uint_as_float(gb.y & 0xffff0000u), 1e-30f)); } }
        bf16x8 af[8], bf[8];
#pragma unroll
        for (int j = 0; j < 8; ++j) { af[j] = *(const bf16x8*)(ap + 256 * kb + 32 * j); bf[j] = *(const bf16x8*)(bp + 256 * kb + 32 * j); }
#pragma unroll
        for (int j = 0; j < 8; ++j) acc = __builtin_amdgcn_mfma_f32_16x16x32_bf16(bf[j], af[j], acc, 0, 0, 0);
    }
    if (MODE == 0) { const int s = kh + 1;
        const u32x2 ga = *(const u32x2*)(gp + s * 2048);
        acc[0] *= fmaxf(__uint_as_float(ga.x << 16), 1e-30f); acc[1] *= fmaxf(__uint_as_float(ga.x & 0xffff0000u), 1e-30f);
        acc[2] *= fmaxf(__uint_as_float(ga.y << 16), 1e-30f); acc[3] *= fmaxf(__uint_as_float(ga.y & 0xffff0000u), 1e-30f); }
    __attribute__((address_space(3))) f32x4* red = (__attribute__((address_space(3))) f32x4*)ldsl;
    if (kh == 1) red[rb * 64 + lane] = acc;
    __syncthreads();
    if (kh == 0) {
        acc = acc + red[rb * 64 + lane];
        if (MODE == 0) { u32x2 o; o.x = cvt_pk_bf16(acc[0], acc[1]); o.y = cvt_pk_bf16(acc[2], acc[3]); *(u32x2*)(OUTB + (size_t)row * DM + 16 * cb + 4 * fq) = o; }
        else { *(f32x4*)(OUTF + (size_t)(row - MP) * DM + 16 * cb + 4 * fq) = acc;
            float s = (acc[0] * acc[0] + acc[1] * acc[1]) + (acc[2] * acc[2] + acc[3] * acc[3]);
            s += __shfl_xor(s, 16); s += __shfl_xor(s, 32);
            if (fq == 0) SSQS[(size_t)(row - MP) * 128 + cb] = s; }
    }
    __syncthreads();
}
}

namespace att {
typedef unsigned short u16;
using bf16x8 = __attribute__((ext_vector_type(8))) short;
using s16x4  = __attribute__((ext_vector_type(4))) short;
using f32x16 = __attribute__((ext_vector_type(16))) float;
using f32x4  = __attribute__((ext_vector_type(4))) float;
using u32x4  = __attribute__((ext_vector_type(4))) unsigned;
using u32x2  = __attribute__((ext_vector_type(2))) unsigned;
constexpr int SHM_V = 16384, SHM_K = 16384;
constexpr int OFF_V = 0, OFF_K = 2 * SHM_V, OFF_BIAS = 65536, OFF_FLAGS = 65536 + 2304, OFF_ITEM = OFF_FLAGS + 128, ATT_LDS = OFF_ITEM + 64;
constexpr float SB_DONE_LOG2 = -200.0f;
#define KSWZ(row, colB) ((row) * 256 + ((colB) ^ (((row) & 7) << 4)))
#define ATT_SBAR() __builtin_amdgcn_sched_barrier(0)
__device__ __forceinline__ int crow(int r, int hi) { return (r & 3) + 8 * (r >> 2) + 4 * hi; }
__device__ __forceinline__ unsigned cvtpk(float lo, float hi) { return pg8::cvt_pk_bf16(lo, hi); }
__device__ __forceinline__ int v_st(int k, int c) { const int kk = (k & ~0xC) | ((k & 4) << 1) | ((k & 8) >> 1); return ((kk >> 3) * 4 + (c >> 5)) * 512 + ((kk & 7) * 32 + (c & 31)) * 2; }
__device__ __forceinline__ int v_rd_base(int lane) { return ((lane & 3) << 3) | (((lane >> 2) & 3) << 6) | (((lane >> 4) & 1) << 5) | (((lane >> 5) & 1) << 8); }
constexpr int v_rd_off(int d0, int ks, int half) { return d0 * 512 + ks * 4096 + half * 2048; }
template <int OFF> __device__ __forceinline__ s16x4 tr_read(int vb) { s16x4 r; asm volatile("ds_read_b64_tr_b16 %0, %1 offset:%2" : "=&v"(r) : "v"(vb), "i"(OFF) : "memory"); return r; }

struct Item {
    int mode;
    int rule;
    const u16* Q; int ldq; int nq; int qpos0;
    const u16 *kb, *vb; int ldb; int pb_lo, pb_hi;
    const float *kf, *vf; int ldf; int pf_lo, pf_hi;
    int pv_lo, pv_hi;
    int kp_first, kp_step, ntiles;
    const float* bias;
    u16* O; int ldo; const u16* G; int ldg;
};

__device__ __forceinline__ void qkt(f32x16& p0, f32x16& p1, const char* Ks, const bf16x8* qr, int r32, int hi) {
    p0 = f32x16{}; p1 = f32x16{};
#pragma unroll
    for (int d0 = 0; d0 < 8; ++d0) { const int cb = (d0 * 16 + hi * 8) * 2;
        const bf16x8 b0 = *reinterpret_cast<const bf16x8*>(Ks + KSWZ(r32, cb));
        const bf16x8 b1 = *reinterpret_cast<const bf16x8*>(Ks + KSWZ(32 + r32, cb));
        p0 = __builtin_amdgcn_mfma_f32_32x32x16_bf16(b0, qr[d0], p0, 0, 0, 0);
        p1 = __builtin_amdgcn_mfma_f32_32x32x16_bf16(b1, qr[d0], p1, 0, 0, 0); }
}
template <int D0> __device__ __forceinline__ void pv_one(f32x16& od, int vb, bf16x8 pa0, bf16x8 pa1, bf16x8 pa2, bf16x8 pa3) {
    const s16x4 l0 = tr_read<v_rd_off(D0, 0, 0)>(vb), h0 = tr_read<v_rd_off(D0, 0, 1)>(vb), l1 = tr_read<v_rd_off(D0, 1, 0)>(vb), h1 = tr_read<v_rd_off(D0, 1, 1)>(vb);
    const s16x4 l2 = tr_read<v_rd_off(D0, 2, 0)>(vb), h2 = tr_read<v_rd_off(D0, 2, 1)>(vb), l3 = tr_read<v_rd_off(D0, 3, 0)>(vb), h3 = tr_read<v_rd_off(D0, 3, 1)>(vb);
    asm volatile("s_waitcnt lgkmcnt(0)" ::: "memory"); ATT_SBAR();
#define ATT_PK(L, H) (bf16x8){L[0], L[1], L[2], L[3], H[0], H[1], H[2], H[3]}
    od = __builtin_amdgcn_mfma_f32_32x32x16_bf16(ATT_PK(l0, h0), pa0, od, 0, 0, 0);
    od = __builtin_amdgcn_mfma_f32_32x32x16_bf16(ATT_PK(l1, h1), pa1, od, 0, 0, 0);
    od = __builtin_amdgcn_mfma_f32_32x32x16_bf16(ATT_PK(l2, h2), pa2, od, 0, 0, 0);
    od = __builtin_amdgcn_mfma_f32_32x32x16_bf16(ATT_PK(l3, h3), pa3, od, 0, 0, 0);
#undef ATT_PK
}
#define ATT_PK4(P, BASE, OUT) do { const unsigned a0_ = cvtpk(P[BASE + 0], P[BASE + 1]), a1_ = cvtpk(P[BASE + 2], P[BASE + 3]);   \
    const unsigned b0_ = cvtpk(P[BASE + 4], P[BASE + 5]), b1_ = cvtpk(P[BASE + 6], P[BASE + 7]);                              \
    auto r0_ = __builtin_amdgcn_permlane32_swap(a0_, b0_, false, false); auto r1_ = __builtin_amdgcn_permlane32_swap(a1_, b1_, false, false); \
    u32x4 w_ = {r0_[0], r1_[0], r0_[1], r1_[1]}; OUT = *reinterpret_cast<bf16x8*>(&w_); } while (0)

__device__ __forceinline__ void sb_half(f32x16& p, float& carry, bool need_mask, int kbase, int qpos, int pv_lo, int pv_hi, int hi) {
    float T[16];
#pragma unroll
    for (int r = 0; r < 16; ++r) {
        const float z = p[r];
        const float t = __builtin_amdgcn_exp2f(-__builtin_fabsf(z));
        const float l = __builtin_amdgcn_logf(1.0f + t);
        float lm = -(fmaxf(z, 0.f) + l);
        float lp = fminf(z, 0.f) - l;
        if (need_mask) { const int kp = kbase + crow(r, hi); const bool ok = (kp < qpos) && (kp >= pv_lo) && (kp < pv_hi); lm = ok ? lm : 0.f; lp = ok ? lp : -1e30f; }
        T[r] = lm; p[r] = lp;
    }
    float E[16], glo[4], ghi[4];
#pragma unroll
    for (int g = 0; g < 4; ++g) {
        E[4 * g + 3] = 0.f; E[4 * g + 2] = T[4 * g + 3]; E[4 * g + 1] = E[4 * g + 2] + T[4 * g + 2]; E[4 * g] = E[4 * g + 1] + T[4 * g + 1];
        const float gt = E[4 * g] + T[4 * g];
        auto rr = __builtin_amdgcn_permlane32_swap(__float_as_uint(gt), __float_as_uint(gt), false, false);
        glo[g] = __uint_as_float(rr[0]); ghi[g] = __uint_as_float(rr[1]);
    }
    float SG[4];
    SG[3] = 0.f; SG[2] = glo[3] + ghi[3]; SG[1] = SG[2] + (glo[2] + ghi[2]); SG[0] = SG[1] + (glo[1] + ghi[1]);
    const float tot = SG[0] + (glo[0] + ghi[0]);
#pragma unroll
    for (int g = 0; g < 4; ++g) SG[g] += carry + (hi == 0 ? ghi[g] : 0.f);
#pragma unroll
    for (int r = 0; r < 16; ++r) p[r] = __builtin_amdgcn_exp2f(p[r] + (SG[r >> 2] + E[r]));
    carry += tot;
}

template <int MODE>
__device__ __forceinline__ void run_item(const Item& it, char* lds, __attribute__((address_space(3))) unsigned char* ldsl) {
    const int tid = threadIdx.x, lane = tid & 63, r32 = lane & 31, hi = lane >> 5;
    const int wid = __builtin_amdgcn_readfirstlane(tid >> 6);
    char* V_lds = lds + OFF_V; char* K_lds = lds + OFF_K;
    float* biasT = (float*)(lds + OFF_BIAS);
    volatile __attribute__((address_space(3))) int* flags = (volatile __attribute__((address_space(3))) int*)(ldsl + OFF_FLAGS);
    const bool has_bias = (MODE == 1) && (it.bias != nullptr);
    if (has_bias) for (int i = tid; i < 513; i += 512) biasT[i] = it.bias[i] * LOG2E;
    const bool wave_rows = (32 * wid < it.nq);
    int qrow = 32 * wid + r32; if (qrow >= it.nq) qrow = it.nq - 1;
    const int qpos = it.qpos0 + 32 * wid + r32;
    bf16x8 qr[8];
    { const u16* Qw = it.Q + (size_t)qrow * it.ldq + hi * 8;
#pragma unroll
      for (int d0 = 0; d0 < 8; ++d0) qr[d0] = *reinterpret_cast<const bf16x8*>(Qw + d0 * 16); }
    f32x16 o[4]; o[0] = f32x16{}; o[1] = f32x16{}; o[2] = f32x16{}; o[3] = f32x16{};
    float carry = 0.f, m_reg = -1e30f, l_reg = 0.f;
    const int sr = tid >> 4, sc = (tid & 15) * 8;
    const int vst0 = v_st(sr, sc), vst1 = v_st(32 + sr, sc), kst0 = KSWZ(sr, sc * 2), kst1 = KSWZ(32 + sr, sc * 2);
    const int vb0 = (int)(uintptr_t)V_lds + v_rd_base(lane);
    f32x4 sK0a, sK0b, sK1a, sK1b, sV0a, sV0b, sV1a, sV1b;
#define ATT_LD(p, A, B, kbp, kfp) do { const int p_ = (p); \
        if (p_ >= it.pb_lo && p_ < it.pb_hi) { A = *reinterpret_cast<const f32x4*>(kbp + (size_t)(p_ - it.pb_lo) * it.ldb + sc); } \
        else if (p_ >= it.pf_lo && p_ < it.pf_hi) { const float* s_ = kfp + (size_t)(p_ - it.pf_lo) * it.ldf + sc; A = *reinterpret_cast<const f32x4*>(s_); B = *reinterpret_cast<const f32x4*>(s_ + 4); } \
        else { A = (f32x4){0.f, 0.f, 0.f, 0.f}; } } while (0)
#define ATT_CV(p, A, B, OUT) do { const int p_ = (p); \
        if (p_ >= it.pf_lo && p_ < it.pf_hi) { u32x4 w_ = {cvtpk(A[0], A[1]), cvtpk(A[2], A[3]), cvtpk(B[0], B[1]), cvtpk(B[2], B[3])}; OUT = *reinterpret_cast<bf16x8*>(&w_); } \
        else { f32x4 a_ = A; OUT = *reinterpret_cast<bf16x8*>(&a_); } } while (0)
#define ATT_SLOAD(kp0) do { ATT_LD((kp0) + sr, sK0a, sK0b, it.kb, it.kf); ATT_LD((kp0) + 32 + sr, sK1a, sK1b, it.kb, it.kf); \
        ATT_LD((kp0) + sr, sV0a, sV0b, it.vb, it.vf); ATT_LD((kp0) + 32 + sr, sV1a, sV1b, it.vb, it.vf); } while (0)
#define ATT_SWRITE(b, kp0) do { bf16x8 t_; \
        ATT_CV((kp0) + sr, sK0a, sK0b, t_); *reinterpret_cast<bf16x8*>(K_lds + (b) * SHM_K + kst0) = t_; \
        ATT_CV((kp0) + 32 + sr, sK1a, sK1b, t_); *reinterpret_cast<bf16x8*>(K_lds + (b) * SHM_K + kst1) = t_; \
        ATT_CV((kp0) + sr, sV0a, sV0b, t_); *reinterpret_cast<bf16x8*>(V_lds + (b) * SHM_V + vst0) = t_; \
        ATT_CV((kp0) + 32 + sr, sV1a, sV1b, t_); *reinterpret_cast<bf16x8*>(V_lds + (b) * SHM_V + vst1) = t_; } while (0)
    sK0b = sK1b = sV0b = sV1b = (f32x4){0.f, 0.f, 0.f, 0.f};
    const int nt = it.ntiles;
    ATT_SLOAD(it.kp_first); ATT_SWRITE(0, it.kp_first);
    __syncthreads();
    bool wdone = !wave_rows;
    for (int j = 0; j < nt; ++j) {
        const int kp0 = it.kp_first + j * it.kp_step, kpn = kp0 + it.kp_step, cur = j & 1;
        const bool more = (j + 1 < nt);
        if (more) ATT_SLOAD(kpn);
        bool active = wave_rows;
        if (it.rule == 1) active = active && (kp0 <= it.qpos0 + 32 * wid + 30) && !wdone;
        if (it.rule == 2) { const int ct = kp0 >> 6, cw = (it.qpos0 + 32 * wid) >> 6; active = active && (ct >= cw - 8) && (ct <= cw); }
        if (active) {
            f32x16 p0, p1;
            qkt(p0, p1, K_lds + cur * SHM_K, qr, r32, hi);
            bool need_mask = (kp0 < it.pv_lo) || (kp0 + 64 > it.pv_hi);
            if (MODE == 0) {
                need_mask = need_mask || (kp0 + 63 >= it.qpos0 + 32 * wid);
                sb_half(p1, carry, need_mask, kp0 + 32, qpos, it.pv_lo, it.pv_hi, hi);
                sb_half(p0, carry, need_mask, kp0, qpos, it.pv_lo, it.pv_hi, hi);
            } else {
                if (has_bias) {
#pragma unroll
                    for (int r = 0; r < 16; ++r) { const int kp = kp0 + crow(r, hi);
                        int d0_ = qpos - kp; d0_ = d0_ < -256 ? -256 : (d0_ > 256 ? 256 : d0_);
                        int d1_ = qpos - kp - 32; d1_ = d1_ < -256 ? -256 : (d1_ > 256 ? 256 : d1_);
                        p0[r] += biasT[d0_ + 256]; p1[r] += biasT[d1_ + 256]; }
                }
                if (need_mask) {
#pragma unroll
                    for (int r = 0; r < 16; ++r) { const int kp = kp0 + crow(r, hi);
                        if (!(kp >= it.pv_lo && kp < it.pv_hi)) p0[r] = -1e30f;
                        if (!(kp + 32 >= it.pv_lo && kp + 32 < it.pv_hi)) p1[r] = -1e30f; }
                }
                float pmax = p0[0];
#pragma unroll
                for (int r = 1; r < 16; ++r) pmax = fmaxf(pmax, p0[r]);
#pragma unroll
                for (int r = 0; r < 16; ++r) pmax = fmaxf(pmax, p1[r]);
                { auto rr = __builtin_amdgcn_permlane32_swap(__float_as_uint(pmax), __float_as_uint(pmax), false, false); pmax = fmaxf(__uint_as_float(rr[0]), __uint_as_float(rr[1])); }
                const float mn = fmaxf(m_reg, pmax);
                const float alpha = __builtin_amdgcn_exp2f(m_reg - mn); m_reg = mn;
                float ps = 0.f;
#pragma unroll
                for (int r = 0; r < 16; ++r) { p0[r] = __builtin_amdgcn_exp2f(p0[r] - mn); ps += p0[r]; }
#pragma unroll
                for (int r = 0; r < 16; ++r) { p1[r] = __builtin_amdgcn_exp2f(p1[r] - mn); ps += p1[r]; }
                { auto rr = __builtin_amdgcn_permlane32_swap(__float_as_uint(ps), __float_as_uint(ps), false, false); ps = __uint_as_float(rr[0]) + __uint_as_float(rr[1]); }
                l_reg = l_reg * alpha + ps;
                if (__any(alpha < 1.f)) {
#pragma unroll
                    for (int d = 0; d < 4; ++d)
#pragma unroll
                        for (int r = 0; r < 16; ++r) o[d][r] *= alpha; }
            }
            bf16x8 pa0, pa1, pa2, pa3;
            ATT_PK4(p0, 0, pa0); ATT_PK4(p0, 8, pa1); ATT_PK4(p1, 0, pa2); ATT_PK4(p1, 8, pa3);
            const int vb = vb0 + cur * SHM_V;
            pv_one<0>(o[0], vb, pa0, pa1, pa2, pa3); pv_one<1>(o[1], vb, pa0, pa1, pa2, pa3); pv_one<2>(o[2], vb, pa0, pa1, pa2, pa3); pv_one<3>(o[3], vb, pa0, pa1, pa2, pa3);
        }
        if (MODE == 0 && SB_EARLY_EXIT) {
            if (wave_rows && !wdone) { const bool rowdone = (carry < SB_DONE_LOG2) || (32 * wid + r32 >= it.nq); wdone = __all(rowdone); }
            if (lane == 0) flags[cur * 8 + wid] = wdone ? 1 : 0;
        }
        if (more) ATT_SWRITE(cur ^ 1, kpn);
        __syncthreads();
        if (MODE == 0 && SB_EARLY_EXIT) {
            int alld = 1;
#pragma unroll
            for (int w = 0; w < 8; ++w) alld &= flags[cur * 8 + w];
            if (alld) break;
        }
    }
    if (wave_rows && (32 * wid + r32) < it.nq) {
        const float inv = (MODE == 1) ? __builtin_amdgcn_rcpf(l_reg) : 1.0f;
        const size_t row = (size_t)(32 * wid + r32);
        u16* orow = it.O + row * it.ldo + 4 * hi; const u16* grow = it.G + row * it.ldg + 4 * hi;
#pragma unroll
        for (int d0 = 0; d0 < 4; ++d0)
#pragma unroll
            for (int g = 0; g < 4; ++g) {
                const u32x2 gv = *reinterpret_cast<const u32x2*>(grow + 32 * d0 + 8 * g);
                const float g0 = __uint_as_float(gv.x << 16), g1 = __uint_as_float(gv.x & 0xffff0000u), g2 = __uint_as_float(gv.y << 16), g3 = __uint_as_float(gv.y & 0xffff0000u);
                u32x2 w; w.x = cvtpk(o[d0][4 * g] * inv * g0, o[d0][4 * g + 1] * inv * g1); w.y = cvtpk(o[d0][4 * g + 2] * inv * g2, o[d0][4 * g + 3] * inv * g3);
                *reinterpret_cast<u32x2*>(orow + 32 * d0 + 8 * g) = w; }
    }
    __syncthreads();
#undef ATT_LD
#undef ATT_CV
#undef ATT_SLOAD
#undef ATT_SWRITE
}
}

constexpr int NWAVES = 8;
constexpr int N_LAUNCHES = MK_N_LAUNCHES;
constexpr int PER_PHASE = 6;

constexpr size_t al256(size_t x) { return (x + 255) & ~(size_t)255; }
constexpr size_t WS_CTL = 0, CTL_ZERO_BYTES = 1u << 20;
constexpr size_t WS_WCAT = CTL_ZERO_BYTES;
constexpr size_t WS_WUP  = WS_WCAT + (size_t)NCAT * DM * 2;
constexpr size_t WS_WOUT = WS_WUP + (size_t)DM * DM * 2;
constexpr size_t WS_ACAT = WS_WOUT + (size_t)DM * DM * 2;
constexpr size_t SZ768 = (size_t)MIN_ * 768 * 2, SZ512 = (size_t)MIN_ * 512 * 2;
constexpr size_t WS_QSB = WS_ACAT + (size_t)MA * DM * 2, WS_KSB = WS_QSB + SZ768, WS_VSB = WS_KSB + SZ768, WS_GSB = WS_VSB + SZ768;
constexpr size_t WS_QBD = WS_GSB + SZ768, WS_KBD = WS_QBD + SZ768, WS_VBD = WS_KBD + SZ768, WS_GBD = WS_VBD + SZ768;
constexpr size_t WS_QMM = WS_GBD + SZ768, WS_GMM = WS_QMM + SZ512;
constexpr size_t WS_MG  = WS_GMM + SZ512;
constexpr size_t WS_MK  = WS_MG + (size_t)MIN_ * 6144 * 2, WS_MV = WS_MK + (size_t)512 * 512 * 2;
constexpr size_t WS_AUP = WS_MV + (size_t)512 * 512 * 2;
constexpr size_t WS_SSQ = WS_AUP + (size_t)MIN_ * DM * 2;
constexpr size_t WS_SSQS = WS_SSQ + (size_t)MIN_ * 32 * 4;
constexpr size_t WS_END = WS_SSQS + (size_t)MS * 128 * 4;
static_assert(WS_WCAT % 256 == 0 && WS_QSB % 256 == 0 && WS_MG % 256 == 0 && WS_AUP % 256 == 0 && WS_SSQ % 256 == 0, "alignment");
constexpr int CW_TMO = 0, CW_WORK = 64, CW_BAR = 4096;
constexpr int OUT_ELEMS = 32112640;

constexpr int RING_BYTES = 131072, LDSCTL_OFF = RING_BYTES, MISC_OFF = LDSCTL_OFF + 320, LDS_BYTES = 147456;
static_assert(att::ATT_LDS <= RING_BYTES, "attention scratch inside the ring region");

#define GAS __attribute__((address_space(1)))
#define LAS __attribute__((address_space(3)))
typedef unsigned short bf16;
typedef unsigned v4u __attribute__((ext_vector_type(4)));
typedef float f32x4 __attribute__((ext_vector_type(4)));
typedef GAS unsigned gu32;
#define RLX_AGENT __ATOMIC_RELAXED, __HIP_MEMORY_SCOPE_AGENT
#define LDS_WAIT() asm volatile("s_waitcnt lgkmcnt(0)" ::: "memory")
__device__ __forceinline__ unsigned pk2(float lo, float hi) { return pg8::cvt_pk_bf16(lo, hi); }

#define XB_TMO      128
#define XB_XCNT(j)  (256  + 64 * (j))
#define XB_XSUB(j)  (1280 + 64 * (j))
#define XB_XGEN(j)  (2304 + 64 * (j))
#define XB_TOP      3328
#define XB_TOPGEN   3392
#define XCD_BAR_WORDS 3456
#define XB_SPIN_CAP (1u << 18)
__device__ __forceinline__ unsigned xb_ld(unsigned* p)              { return __hip_atomic_load(p, __ATOMIC_RELAXED, __HIP_MEMORY_SCOPE_AGENT); }
__device__ __forceinline__ unsigned xb_add(unsigned* p, unsigned v) { return __hip_atomic_fetch_add(p, v, __ATOMIC_RELAXED, __HIP_MEMORY_SCOPE_AGENT); }
__device__ __forceinline__ unsigned xb_xcc_id() { return (unsigned)__builtin_amdgcn_s_getreg((3 << 11) | 20) & 0xFu; }
#define XB_SPIN(cond, bar) do { unsigned _sp = 0; while (cond) { __builtin_amdgcn_s_sleep(1); \
    if ((++_sp & 255u) == 0u) { if (xb_ld(&(bar)[XB_TMO])) break; if (_sp > XB_SPIN_CAP) { atomicAdd(&(bar)[XB_TMO], 1u); break; } } } } while (0)
struct XcdBarrier { unsigned* bar; unsigned x; volatile LAS unsigned* st; };
__device__ __forceinline__ XcdBarrier xcd_barrier_post(unsigned* bar, volatile LAS unsigned* st) {
    XcdBarrier b; b.bar = bar; b.x = xb_xcc_id(); b.st = st;
    if (threadIdx.x == 0) (void)xb_add(&bar[XB_XCNT(b.x)], 1u);
    return b;
}
__device__ __forceinline__ void xcd_barrier_complete(unsigned* bar, unsigned x, unsigned& nloc, unsigned& nx) {
    const unsigned G = gridDim.x * gridDim.y * gridDim.z;
    unsigned sum, cnt, mine, sp = 0u;
    for (;;) {
        sum = 0u; cnt = 0u; mine = 0u;
#pragma unroll
        for (unsigned j = 0; j < 16; ++j) { const unsigned c = xb_ld(&bar[XB_XCNT(j)]); sum += c; cnt += (c > 0u) ? 1u : 0u; mine = (j == x) ? c : mine; }
        if (sum == G) break;
        __builtin_amdgcn_s_sleep(1);
        if ((++sp & 255u) == 0u) { if (xb_ld(&bar[XB_TMO])) break; if (sp > XB_SPIN_CAP) { atomicAdd(&bar[XB_TMO], 1u); break; } }
    }
    nloc = mine > 0u ? mine : 1u; nx = cnt > 0u ? cnt : 1u;
}
__device__ __forceinline__ void xcd_barrier(const XcdBarrier& b) {
    asm volatile("s_waitcnt vmcnt(0)" ::: "memory");
    __syncthreads();
    if (threadIdx.x == 0) {
        unsigned* bar = b.bar;
        __builtin_amdgcn_s_waitcnt(0);
        unsigned nloc = b.st[0], nx = b.st[1];
        if (nloc == 0u) { xcd_barrier_complete(bar, b.x, nloc, nx); b.st[0] = nloc; b.st[1] = nx; }
        const unsigned old = xb_add(&bar[XB_XSUB(b.x)], 1u);
        const unsigned gen = old / nloc;
        if (old + 1u == (gen + 1u) * nloc) {
            __builtin_amdgcn_fence(__ATOMIC_RELEASE, "agent");
            asm volatile("s_waitcnt vmcnt(0)" ::: "memory");
            const unsigned og = xb_add(&bar[XB_TOP], 1u);
            const unsigned tg = og / nx;
            if (og + 1u == (tg + 1u) * nx) xb_add(&bar[XB_TOPGEN], 1u);
            else XB_SPIN(xb_ld(&bar[XB_TOPGEN]) == tg, bar);
            __builtin_amdgcn_fence(__ATOMIC_ACQUIRE, "agent");
            xb_add(&bar[XB_XGEN(b.x)], 1u);
            asm volatile("s_waitcnt vmcnt(0)" ::: "memory");
        } else {
            XB_SPIN(xb_ld(&bar[XB_XGEN(b.x)]) == gen, bar);
            __builtin_amdgcn_fence(__ATOMIC_ACQUIRE, "agent");
            asm volatile("s_waitcnt vmcnt(0)" ::: "memory");
        }
    }
    __syncthreads();
}

struct Frame {
    LAS unsigned char* lds;
    volatile LAS unsigned* MISC;
    gu32* ctl;
    int vcu, G;
    const float *x_prompt, *x_sample, *c_sbk, *c_sbv, *c_bdk, *c_bdv, *c_mk, *c_mv, *mem_prompt, *g_pre, *w_in, *rel_bias, *g_mem, *w_mem_kv, *w_up_sb, *w_up_band, *w_up_mem, *w_out, *g_post;
    float* out;
    bf16 *WCAT, *WUP, *WOUT, *ACAT, *QSB, *KSB, *VSB, *GSB, *QBD, *KBD, *VBD, *GBD, *QMM, *GMM, *MG, *MK, *MV, *AUP, *MERGED;
    float* SSQ; float* SSQS;
};

__device__ __forceinline__ int fresh_tid() { int t = threadIdx.x; asm volatile("" : "+v"(t)); return t; }
__device__ __forceinline__ float wave_sum(float v) {
#pragma unroll
    for (int o = 1; o < 64; o <<= 1) v += __shfl_xor(v, o);
    return v;
}
__device__ __forceinline__ void p0_transpose_item(const float* W, int N, bf16* WT, int ldt, int row_off, int col_off, LAS float* scr, int item, int lane) {
    const int nblk = N / 32, kb = item / nblk, nb = item % nblk, k0 = 64 * kb, n0 = 32 * nb;
#pragma unroll 8
    for (int i = 0; i < 32; ++i) { const int kk = 2 * i + (lane >> 5); scr[kk * 33 + (lane & 31)] = W[(size_t)(k0 + kk) * N + n0 + (lane & 31)]; }
    LDS_WAIT(); asm volatile("" ::: "memory");
    const int c = lane & 7;
#pragma unroll
    for (int j = 0; j < 4; ++j) { const int n = (lane >> 3) + 8 * j; const LAS float* s = scr + (8 * c) * 33 + n;
        v4u o; o.x = pk2(s[0 * 33], s[1 * 33]); o.y = pk2(s[2 * 33], s[3 * 33]); o.z = pk2(s[4 * 33], s[5 * 33]); o.w = pk2(s[6 * 33], s[7 * 33]);
        *(GAS v4u*)(WT + (size_t)(row_off + n0 + n) * ldt + col_off + k0 + 8 * c) = o; }
    LDS_WAIT(); asm volatile("" ::: "memory");
}
__device__ __forceinline__ void rms_row_to_bf16(const float* xrow, const float* g, bf16* orow, int lane) {
    const GAS f32x4* xr = (const GAS f32x4*)xrow + lane; const GAS f32x4* gr = (const GAS f32x4*)g + lane;
    f32x4 v[8]; float s = 0.f;
#pragma unroll
    for (int j = 0; j < 8; ++j) { v[j] = xr[64 * j]; s += (v[j].x * v[j].x + v[j].y * v[j].y) + (v[j].z * v[j].z + v[j].w * v[j].w); }
    const float r = 1.0f / sqrtf(wave_sum(s) * (1.0f / DM) + RMS_EPS);
    GAS unsigned long long* o8 = (GAS unsigned long long*)orow + lane;
#pragma unroll
    for (int j = 0; j < 8; ++j) { const f32x4 gv = gr[64 * j];
        o8[64 * j] = (unsigned long long)pk2(v[j].x * r * gv.x, v[j].y * r * gv.y) | ((unsigned long long)pk2(v[j].z * r * gv.z, v[j].w * r * gv.w) << 32); }
}
__device__ __forceinline__ void p0_prologue(Frame& F) {
    const int tid_ = fresh_tid(), lane_ = tid_ & 63, wave_ = __builtin_amdgcn_readfirstlane(tid_ >> 6);
    LAS float* scr = (LAS float*)(F.lds + wave_ * 16384);
    const int gw = F.vcu * NWAVES + wave_, NGW = F.G * NWAVES;
    constexpr int I_IN = 32 * (INW / 32), I_MEM = 32 * (1024 / 32), I_USB = 12 * 64, I_UBD = 12 * 64, I_UMM = 8 * 64, I_OUT = 32 * 64;
    constexpr int NITEMS = I_IN + I_MEM + I_USB + I_UBD + I_UMM + I_OUT;
    for (int it = gw; it < NITEMS; it += NGW) {
        int r = it;
        if (r < I_IN)  { p0_transpose_item(F.w_in, INW, F.WCAT, DM, 0, 0, scr, r, lane_); continue; } r -= I_IN;
        if (r < I_MEM) { p0_transpose_item(F.w_mem_kv, 1024, F.WCAT, DM, INW, 0, scr, r, lane_); continue; } r -= I_MEM;
        if (r < I_USB) { p0_transpose_item(F.w_up_sb, DM, F.WUP, DM, 0, 0, scr, r, lane_); continue; } r -= I_USB;
        if (r < I_UBD) { p0_transpose_item(F.w_up_band, DM, F.WUP, DM, 0, 768, scr, r, lane_); continue; } r -= I_UBD;
        if (r < I_UMM) { p0_transpose_item(F.w_up_mem, DM, F.WUP, DM, 0, 1536, scr, r, lane_); continue; } r -= I_UMM;
        p0_transpose_item(F.w_out, DM, F.WOUT, DM, 0, 0, scr, r, lane_);
    }
    for (int m = gw; m < MA; m += NGW) {
        bf16* orow = F.ACAT + (size_t)m * DM;
        if (m < MP) rms_row_to_bf16(F.x_prompt + (size_t)m * DM, F.g_pre, orow, lane_);
        else if (m < MREAL) rms_row_to_bf16(F.x_sample + (size_t)(m - MP) * DM, F.g_pre, orow, lane_);
        else if (m < MIN_) {
            GAS v4u* o = (GAS v4u*)orow + lane_; GAS v4u* o2 = (GAS v4u*)(F.AUP + (size_t)m * DM) + lane_;
#pragma unroll
            for (int j = 0; j < 4; ++j) { o[64 * j] = (v4u){0u, 0u, 0u, 0u}; o2[64 * j] = (v4u){0u, 0u, 0u, 0u}; }
        }
        else rms_row_to_bf16(F.mem_prompt + (size_t)(m - MMEM0) * DM, F.g_mem, orow, lane_);
    }
}
__device__ __forceinline__ void p5_final(Frame& F) {
    const int tid_ = fresh_tid(), lane_ = tid_ & 63, wave_ = __builtin_amdgcn_readfirstlane(tid_ >> 6);
    const int gw = F.vcu * NWAVES + wave_, NGW = F.G * NWAVES;
    for (int m = gw; m < MREAL; m += NGW) {
        float s = (m < MP) ? ((lane_ < 32) ? F.SSQ[(size_t)m * 32 + lane_] : 0.f) : (F.SSQS[(size_t)(m - MP) * 128 + lane_] + F.SSQS[(size_t)(m - MP) * 128 + 64 + lane_]);
        s = wave_sum(s);
        const float r = 1.0f / sqrtf(s * (1.0f / DM) + RMS_EPS);
        float* yrow = (m < MP) ? F.out + (size_t)m * DM : F.out + (size_t)16777216 + (size_t)(m - MP) * DM;
        const float* xrow = (m < MP) ? F.x_prompt + (size_t)m * DM : F.x_sample + (size_t)(m - MP) * DM;
        GAS f32x4* y4 = (GAS f32x4*)yrow + lane_; const GAS f32x4* x4 = (const GAS f32x4*)xrow + lane_; const GAS f32x4* g4 = (const GAS f32x4*)F.g_post + lane_;
#pragma unroll
        for (int j = 0; j < 8; ++j) { const f32x4 yv = y4[64 * j], xv = x4[64 * j], gv = g4[64 * j]; y4[64 * j] = xv + yv * r * gv; }
    }
}

constexpr int IT_BDP = 192, IT_BDS = 48, IT_SBP = 192, IT_SBS = 48, IT_MMP = 128, IT_MMS = 32;
constexpr int IT_TOTAL = IT_BDP + IT_BDS + IT_SBP + IT_SBS + IT_MMP + IT_MMS;
__device__ __forceinline__ att::Item make_item(const Frame& F, int idx) {
    att::Item it; it.bias = nullptr; it.kf = nullptr; it.vf = nullptr; it.ldf = 0; it.pf_lo = 0; it.pf_hi = 0; it.kb = nullptr; it.vb = nullptr; it.ldb = 0; it.pb_lo = 0; it.pb_hi = 0;
    if (idx < IT_BDP) {
        const int b = idx / 96, h = (idx / 16) % 6, cg = idx % 16; const size_t row0 = (size_t)b * SEQ + 256 * cg;
        it.mode = 1; it.rule = 2; it.Q = F.QBD + row0 * 768 + h * HD; it.ldq = 768; it.nq = 256; it.qpos0 = 256 * cg;
        it.kb = F.KBD + (size_t)b * SEQ * 768 + h * HD; it.vb = F.VBD + (size_t)b * SEQ * 768 + h * HD; it.ldb = 768; it.pb_lo = 0; it.pb_hi = SEQ;
        it.pv_lo = 0; it.pv_hi = SEQ; const int c_lo = (4 * cg - 8) > 0 ? (4 * cg - 8) : 0;
        it.kp_first = 64 * c_lo; it.kp_step = 64; it.ntiles = 4 * cg + 4 - c_lo; it.bias = F.rel_bias + h * 513;
        it.O = F.AUP + row0 * DM + 768 + h * HD; it.ldo = DM; it.G = F.GBD + row0 * 768 + h * HD; it.ldg = 768; return it; }
    idx -= IT_BDP;
    if (idx < IT_BDS) {
        const int b = idx / 6, h = idx % 6; const size_t row0 = (size_t)MP + b * DS;
        it.mode = 1; it.rule = 0; it.Q = F.QBD + row0 * 768 + h * HD; it.ldq = 768; it.nq = DS; it.qpos0 = PAST;
        it.kb = F.KBD + row0 * 768 + h * HD; it.vb = F.VBD + row0 * 768 + h * HD; it.ldb = 768; it.pb_lo = PAST; it.pb_hi = PAST + DS;
        it.kf = F.c_bdk + (size_t)b * 512 * 768 + h * HD; it.vf = F.c_bdv + (size_t)b * 512 * 768 + h * HD; it.ldf = 768; it.pf_lo = PAST - 512; it.pf_hi = PAST;
        it.pv_lo = PAST - 512; it.pv_hi = PAST + DS; it.kp_first = PAST - 512; it.kp_step = 64; it.ntiles = 9; it.bias = F.rel_bias + h * 513;
        it.O = F.AUP + row0 * DM + 768 + h * HD; it.ldo = DM; it.G = F.GBD + row0 * 768 + h * HD; it.ldg = 768; return it; }
    idx -= IT_BDS;
    if (idx < IT_SBP) {
        const int b = idx % 2, h = (idx / 2) % 6, qb = 15 - idx / 12; const size_t row0 = (size_t)b * SEQ + 256 * qb;
        it.mode = 0; it.rule = 1; it.Q = F.QSB + row0 * 768 + h * HD; it.ldq = 768; it.nq = 256; it.qpos0 = 256 * qb;
        it.kb = F.KSB + (size_t)b * SEQ * 768 + h * HD; it.vb = F.VSB + (size_t)b * SEQ * 768 + h * HD; it.ldb = 768; it.pb_lo = 0; it.pb_hi = SEQ;
        it.pv_lo = 0; it.pv_hi = SEQ; it.kp_first = 64 * (4 * qb + 3); it.kp_step = -64; it.ntiles = 4 * qb + 4;
        it.O = F.AUP + row0 * DM + h * HD; it.ldo = DM; it.G = F.GSB + row0 * 768 + h * HD; it.ldg = 768; return it; }
    idx -= IT_SBP;
    if (idx < IT_SBS) {
        const int b = idx / 6, h = idx % 6; const size_t row0 = (size_t)MP + b * DS;
        it.mode = 0; it.rule = 1; it.Q = F.QSB + row0 * 768 + h * HD; it.ldq = 768; it.nq = DS; it.qpos0 = PAST;
        it.kb = F.KSB + row0 * 768 + h * HD; it.vb = F.VSB + row0 * 768 + h * HD; it.ldb = 768; it.pb_lo = PAST; it.pb_hi = PAST + DS;
        it.kf = F.c_sbk + (size_t)b * PAST * 768 + h * HD; it.vf = F.c_sbv + (size_t)b * PAST * 768 + h * HD; it.ldf = 768; it.pf_lo = 0; it.pf_hi = PAST;
        it.pv_lo = 0; it.pv_hi = PAST + DS; it.kp_first = PAST + DS - 64; it.kp_step = -64; it.ntiles = (PAST + DS + 63) / 64;
        it.O = F.AUP + row0 * DM + h * HD; it.ldo = DM; it.G = F.GSB + row0 * 768 + h * HD; it.ldg = 768; return it; }
    idx -= IT_SBS;
    if (idx < IT_MMP) {
        const int b = idx / 64, h = (idx / 16) % 4, qb = idx % 16; const size_t row0 = (size_t)b * SEQ + 256 * qb;
        it.mode = 1; it.rule = 0; it.Q = F.QMM + row0 * 512 + h * HD; it.ldq = 512; it.nq = 256; it.qpos0 = 0;
        it.kb = F.MK + (size_t)b * NMEM * 512 + h * HD; it.vb = F.MV + (size_t)b * NMEM * 512 + h * HD; it.ldb = 512; it.pb_lo = 0; it.pb_hi = NMEM;
        it.pv_lo = 0; it.pv_hi = NMEM; it.kp_first = 0; it.kp_step = 64; it.ntiles = 4;
        it.O = F.AUP + row0 * DM + 1536 + h * HD; it.ldo = DM; it.G = F.GMM + row0 * 512 + h * HD; it.ldg = 512; return it; }
    idx -= IT_MMP;
    {
        const int b = idx / 4, h = idx % 4; const size_t row0 = (size_t)MP + b * DS;
        it.mode = 1; it.rule = 0; it.Q = F.QMM + row0 * 512 + h * HD; it.ldq = 512; it.nq = DS; it.qpos0 = 0;
        it.kf = F.c_mk + (size_t)b * NMEM * 512 + h * HD; it.vf = F.c_mv + (size_t)b * NMEM * 512 + h * HD; it.ldf = 512; it.pf_lo = 0; it.pf_hi = NMEM;
        it.pv_lo = 0; it.pv_hi = NMEM; it.kp_first = 0; it.kp_step = 64; it.ntiles = 4;
        it.O = F.AUP + row0 * DM + 1536 + h * HD; it.ldo = DM; it.G = F.GMM + row0 * 512 + h * HD; it.ldg = 512; return it; }
}

struct Args { const void* in[19]; float* out; unsigned char* ws; int ph_lo, ph_hi; };
__global__ void __launch_bounds__(NWAVES * 64, 2) fwd_megakernel(Args args) {
    extern __shared__ __attribute__((aligned(16))) unsigned char lds[];
    Frame F;
    F.lds = (LAS unsigned char*)lds;
    F.MISC = (volatile LAS unsigned*)(F.lds + MISC_OFF);
    F.G = gridDim.x; { const int bx = blockIdx.x; F.vcu = (F.G % 8 == 0) ? (bx % 8) * (F.G / 8) + bx / 8 : bx; }
    unsigned char* ws = args.ws;
    F.ctl = (gu32*)(ws + WS_CTL);
    F.x_prompt = (const float*)args.in[0]; F.x_sample = (const float*)args.in[1]; F.c_sbk = (const float*)args.in[2]; F.c_sbv = (const float*)args.in[3];
    F.c_bdk = (const float*)args.in[4]; F.c_bdv = (const float*)args.in[5]; F.c_mk = (const float*)args.in[6]; F.c_mv = (const float*)args.in[7];
    F.mem_prompt = (const float*)args.in[8]; F.g_pre = (const float*)args.in[9]; F.w_in = (const float*)args.in[10]; F.rel_bias = (const float*)args.in[11];
    F.g_mem = (const float*)args.in[12]; F.w_mem_kv = (const float*)args.in[13]; F.w_up_sb = (const float*)args.in[14]; F.w_up_band = (const float*)args.in[15];
    F.w_up_mem = (const float*)args.in[16]; F.w_out = (const float*)args.in[17]; F.g_post = (const float*)args.in[18];
    F.out = args.out;
    F.WCAT = (bf16*)(ws + WS_WCAT); F.WUP = (bf16*)(ws + WS_WUP); F.WOUT = (bf16*)(ws + WS_WOUT); F.ACAT = (bf16*)(ws + WS_ACAT); F.MERGED = (bf16*)(ws + WS_ACAT);
    F.QSB = (bf16*)(ws + WS_QSB); F.KSB = (bf16*)(ws + WS_KSB); F.VSB = (bf16*)(ws + WS_VSB); F.GSB = (bf16*)(ws + WS_GSB);
    F.QBD = (bf16*)(ws + WS_QBD); F.KBD = (bf16*)(ws + WS_KBD); F.VBD = (bf16*)(ws + WS_VBD); F.GBD = (bf16*)(ws + WS_GBD);
    F.QMM = (bf16*)(ws + WS_QMM); F.GMM = (bf16*)(ws + WS_GMM); F.MG = (bf16*)(ws + WS_MG); F.MK = (bf16*)(ws + WS_MK); F.MV = (bf16*)(ws + WS_MV);
    F.AUP = (bf16*)(ws + WS_AUP); F.SSQ = (float*)(ws + WS_SSQ); F.SSQS = (float*)(ws + WS_SSQS);
    for (int u = threadIdx.x; u < (LDS_BYTES - LDSCTL_OFF) / 4; u += NWAVES * 64) ((LAS unsigned*)(F.lds + LDSCTL_OFF))[u] = 0u;
    __syncthreads();
    XcdBarrier bar; bar.bar = (unsigned*)(F.ctl + CW_BAR); bar.x = 0; bar.st = nullptr;
    if (N_LAUNCHES != PER_PHASE) bar = xcd_barrier_post((unsigned*)(F.ctl + CW_BAR), F.MISC + 8);
#define GRID_BAR() do { if (N_LAUNCHES != PER_PHASE) xcd_barrier(bar); } while (0)
    const int lo = args.ph_lo, hi = args.ph_hi;
#ifdef ONLY_PHASE
#define IN(k) ((k) == ONLY_PHASE && lo <= (k) && (k) < hi)
#else
#define IN(k) (lo <= (k) && (k) < hi)
#endif
#define BOTH(k) (IN(k) && IN((k) + 1))

    if (IN(0)) { for (int rep = 0; rep < (DBG_REPEAT == 0 ? 2 : 1); ++rep) { p0_prologue(F); if (BOTH(0)) GRID_BAR(); } }

    if (IN(1)) {
        pg8::Gemm g{F.ACAT, F.WCAT, MA, NCAT, DM}; ep::InOrder S; S.init(F.G, (int)blockIdx.x);
        ep::EpiIn E{F.QSB, F.KSB, F.VSB, F.GSB, F.QBD, F.KBD, F.VBD, F.GBD, F.QMM, F.GMM, F.MG, F.MK, F.MV, F.out};
        for (int rep = 0; rep < (DBG_REPEAT == 1 ? 2 : 1); ++rep) {
        pg8::gemm_phase<ep::EpiIn, ep::InOrder, true, true>(F.lds, g, S, E);
        if (BOTH(1)) GRID_BAR(); }
    }

    if (IN(2)) {
        volatile LAS int* slot = (volatile LAS int*)(F.lds + att::OFF_ITEM);
        for (;;) {
            if (threadIdx.x == 0) *slot = (int)__hip_atomic_fetch_add((unsigned*)(F.ctl + CW_WORK), 1u, RLX_AGENT);
            __syncthreads();
            const int idx = __builtin_amdgcn_readfirstlane(*slot);
            __syncthreads();
            if (idx >= (DBG_REPEAT == 2 ? 2 : 1) * IT_TOTAL) break;
            const att::Item it = make_item(F, idx % IT_TOTAL);
            if (it.mode == 0) att::run_item<0>(it, (char*)lds, F.lds); else att::run_item<1>(it, (char*)lds, F.lds);
        }
        if (BOTH(2)) GRID_BAR();
    }

    if (IN(3)) {
        pg8::Gemm g{F.AUP, F.WUP, MIN_, DM, DM}; ep::MergeOrder S; S.init(F.G, (int)blockIdx.x);
        ep::EpiMerge E{F.MG, F.MERGED};
        for (int rep = 0; rep < (DBG_REPEAT == 3 ? 2 : 1); ++rep) {
        pg8::gemm_phase<ep::EpiMerge, ep::MergeOrder, true, true>(F.lds, g, S, E);
        for (int sl = F.vcu; sl < 256; sl += F.G) ep::skinny_phase<0>(F.AUP, F.WUP, F.MG, F.MERGED, nullptr, nullptr, sl, F.lds);
        if (BOTH(3)) GRID_BAR(); }
    }

    if (IN(4)) {
        pg8::Gemm g{F.MERGED, F.WOUT, MP, DM, DM}; pg8::StaticOrder S; S.init(MP, DM, F.G, (int)blockIdx.x);
        ep::EpiOut E{F.out, F.SSQ};
        for (int rep = 0; rep < (DBG_REPEAT == 4 ? 2 : 1); ++rep) {
        pg8::gemm_phase<ep::EpiOut, pg8::StaticOrder, true, true>(F.lds, g, S, E);
        for (int sl = F.vcu; sl < 256; sl += F.G) ep::skinny_phase<1>(F.MERGED, F.WOUT, nullptr, nullptr, F.out + 16777216, F.SSQS, sl, F.lds);
        if (BOTH(4)) GRID_BAR(); }
    }

    if (IN(5)) p5_final(F);
#undef IN
#undef BOTH
#undef GRID_BAR
}

extern "C" void kernel_launch(void* const* d_in, const int* in_sizes, int n_in, void* d_out, int out_size, void* d_ws, size_t ws_size, hipStream_t stream) {
    static int grid = 0;
    if (grid == 0) {
        if (n_in != 19 || in_sizes[0] != MP * DM || in_sizes[10] != DM * INW || out_size != OUT_ELEMS || ws_size < WS_END) {
            fprintf(stderr, "kernel_launch: built for 19 inputs, x_prompt %d, w_in %d, out %d floats, >= %zu bytes of workspace; got n_in %d, in0 %d, in10 %d, out %d, ws %zu; nothing launched\n",
                    MP * DM, DM * INW, OUT_ELEMS, (size_t)WS_END, n_in, n_in > 0 ? in_sizes[0] : -1, n_in > 10 ? in_sizes[10] : -1, out_size, ws_size);
            grid = -1; return; }
        int dev = 0, cus = 0, per_cu = 0;
        if (hipGetDevice(&dev) != hipSuccess || hipDeviceGetAttribute(&cus, hipDeviceAttributeMultiprocessorCount, dev) != hipSuccess) { fprintf(stderr, "kernel_launch: device query failed\n"); grid = -1; return; }
        if (hipFuncSetAttribute((const void*)fwd_megakernel, hipFuncAttributeMaxDynamicSharedMemorySize, LDS_BYTES) != hipSuccess) { fprintf(stderr, "kernel_launch: hipFuncSetAttribute(%d B LDS) failed\n", LDS_BYTES); grid = -1; return; }
        if (hipOccupancyMaxActiveBlocksPerMultiprocessor(&per_cu, (const void*)fwd_megakernel, NWAVES * 64, LDS_BYTES) != hipSuccess || per_cu < 1) {
            fprintf(stderr, "kernel_launch: occupancy query reports %d workgroups per CU; nothing launched\n", per_cu); (void)hipGetLastError(); grid = -1; return; }
        grid = cus;
    }
    if (grid < 0) return;
    if (hipMemsetAsync((char*)d_ws + WS_CTL, 0, CTL_ZERO_BYTES, stream) != hipSuccess) { fprintf(stderr, "kernel_launch: hipMemsetAsync failed\n"); return; }
    Args a{};
    for (int i = 0; i < 19; ++i) a.in[i] = d_in[i];
    a.out = (float*)d_out; a.ws = (unsigned char*)d_ws;
    if (N_LAUNCHES == 1) {
        a.ph_lo = 0; a.ph_hi = PER_PHASE;
        hipLaunchKernelGGL(fwd_megakernel, dim3(grid), dim3(NWAVES * 64), LDS_BYTES, stream, a);
    } else {
        for (int li = 0; li < PER_PHASE; ++li) { a.ph_lo = li; a.ph_hi = li + 1; hipLaunchKernelGGL(fwd_megakernel, dim3(grid), dim3(NWAVES * 64), LDS_BYTES, stream, a); }
    }
    const hipError_t le = hipPeekAtLastError();
    if (le != hipSuccess) fprintf(stderr, "kernel_launch: launch failed: %s (grid %d)\n", hipGetErrorName(le), grid);
}
```

```cpp
#include <hip/hip_runtime.h>
#include <hip/hip_bf16.h>
#include <cstdio>
#include <cstdint>

#ifndef MK_N_LAUNCHES
#define MK_N_LAUNCHES 1
#endif
#ifndef FUSE_RMS
#define FUSE_RMS 0
#endif
#ifndef LATE_WT
#define LATE_WT 1
#endif
#ifndef SLACK_P1
#define SLACK_P1 1
#endif
#ifndef SB_EARLY_EXIT
#define SB_EARLY_EXIT 1
#endif

constexpr int DM = 2048, SEQ = 4096, NB = 2, DB = 8, DS = 16, PAST = 4096, HD = 128;
constexpr int MP = NB * SEQ;
constexpr int MS = DB * DS;
constexpr int MIN_ = 8448;
constexpr int MREAL = MP + MS;
constexpr int MMEM0 = 8448;
constexpr int MA = 8960;
constexpr int INW = 13312, NCAT = 14336;
constexpr int NMEM = 256;
constexpr float RMS_EPS = 1e-6f;
constexpr float LOG2E = 1.4426950408889634f;
constexpr float QSCALE = 0.08838834764831845f * 1.4426950408889634f;

namespace pg8 {
#define PG8_LAS __attribute__((address_space(3)))
typedef unsigned short bf16_t;
typedef short bf16x8 __attribute__((ext_vector_type(8)));
typedef float f32x4 __attribute__((ext_vector_type(4)));
typedef unsigned u32x4 __attribute__((ext_vector_type(4)));
constexpr int BM = 256, BK = 64, HALF = 128, HTB = HALF * BK * 2  , STAGE_BYTES = 8 * HTB, NXCD = 8, WGM = 8;

__host__ __device__ __forceinline__ int lds_byte(int r, int c) { const int st = (r >> 4) * 2 + (c >> 5), rr = r & 15, cc = c & 31, ob = rr * 64 + cc * 2; return st * 1024 + (ob ^ (((ob >> 9) & 1) << 5)); }
__host__ __device__ __forceinline__ void stage_rc(int b, int& R, int& C) { const int st = b / 1024, sb = b % 1024, swz = sb ^ (((sb >> 9) & 1) << 5); R = (st >> 1) * 16 + swz / 64; C = (st & 1) * 32 + (swz % 64) / 2; }
__host__ __device__ __forceinline__ int perm32(int rho) { const int n = rho >> 4, i = rho & 15; return 8 * (i >> 2) + 4 * n + (i & 3); }

struct Unit { int pm, pn, k0, nt; };
struct Gemm { const bf16_t* A; const bf16_t* Bt; int M, N, K; };

struct StaticOrder {
    int nM, nN, nwg, G, c;
    __host__ __device__ void init(int M, int N, int G_, int c_) { nM = M / BM; nN = N / BM; nwg = nM * nN; G = G_; c = c_; }
    __host__ __device__ bool next(int i, Unit& u) const {
        const long L = (long)i * G + c; if (L >= nwg) return false;
        int wgid = (int)L; { const int q = nwg / NXCD, r = nwg % NXCD, xcd = wgid % NXCD, off = wgid / NXCD; wgid = (xcd < r ? xcd * (q + 1) : r * (q + 1) + (xcd - r) * q) + off; }
        const int nig = WGM * nN, gid = wgid / nig, fm = gid * WGM, gsz = (nM - fm) < WGM ? (nM - fm) : WGM;
        u.pm = fm + ((wgid % nig) % gsz); u.pn = (wgid % nig) / gsz; u.k0 = 0; u.nt = 0; return true;
    }
    __device__ __forceinline__ void a_ready(const Unit&) const {}
    __device__ __forceinline__ void done(const Unit&) const {}
};

typedef float f32x2_t __attribute__((ext_vector_type(2))); typedef __bf16 bf16x2_t __attribute__((ext_vector_type(2)));
__device__ __forceinline__ unsigned cvt_pk_bf16(float lo, float hi) { f32x2_t v = {lo, hi}; bf16x2_t b = __builtin_convertvector(v, bf16x2_t); return __builtin_bit_cast(unsigned, b); }

template <class Epi, class Sched, bool ALIGN_EPI = false, bool SP2 = false>
__device__ __forceinline__ void gemm_phase(PG8_LAS unsigned char* lds, const Gemm g, const Sched& S, const Epi& E) {
    const int tid = threadIdx.x, wid = __builtin_amdgcn_readfirstlane(tid >> 6), lane = tid & 63, wr = wid >> 2, wc = wid & 3, fr = lane & 15, fq = lane >> 4;
    const int K = g.K, nt = K / BK;
    unsigned voffA[2], voffB[2];
#pragma unroll
    for (int i = 0; i < 2; ++i) { int R, C; stage_rc(tid * 16 + i * 8192, R, C); const int Rb = Epi::PERM ? ((R & ~31) + perm32(R & 31)) : R;
        voffA[i] = (unsigned)(R * K + C) * 2u; voffB[i] = (unsigned)(Rb * K + C) * 2u; }
    const size_t kstep = (size_t)(BK * 2);
    const size_t hstep = (size_t)HALF * K * 2;
    const size_t tstep = 2 * hstep;
    const unsigned ldsw = (unsigned)wid * 1024u;
    const int aoff = lds_byte(wr * 64 + fr, fq * 8), boff = lds_byte(wc * 32 + fr, fq * 8);
#define PG8_SA(b, h) (((b) * 2 + (h)) * HTB)
#define PG8_SB(b, h) ((4 + (b) * 2 + (h)) * HTB)
#define PG8_STAGE(bufoff, gbase, voff) do { _Pragma("unroll") for (int _i = 0; _i < 2; ++_i) \
        __builtin_amdgcn_global_load_lds((const unsigned*)((const char*)(gbase) + (voff)[_i]), (PG8_LAS unsigned*)(lds + (bufoff) + ldsw + _i * 8192), 16, 0, 0); } while (0)
#define PG8_LDA(dst, b, h) do { _Pragma("unroll") for (int m = 0; m < 4; ++m) _Pragma("unroll") for (int k = 0; k < 2; ++k) dst[m][k] = *(const PG8_LAS bf16x8*)(lds + PG8_SA(b, h) + aoff + m * 2048 + k * 1024); } while (0)
#define PG8_LDB(dst, b, h) do { _Pragma("unroll") for (int n = 0; n < 2; ++n) _Pragma("unroll") for (int k = 0; k < 2; ++k) dst[n][k] = *(const PG8_LAS bf16x8*)(lds + PG8_SB(b, h) + boff + n * 2048 + k * 1024); } while (0)
#define PG8_MMA(ai, bj, At, Bt) do { __builtin_amdgcn_s_setprio(1); _Pragma("unroll") for (int m = 0; m < 4; ++m) _Pragma("unroll") for (int n = 0; n < 2; ++n) _Pragma("unroll") for (int k = 0; k < 2; ++k) \
        acc[ai][bj][m][n] = __builtin_amdgcn_mfma_f32_16x16x32_bf16(Bt[n][k], At[m][k], acc[ai][bj][m][n], 0, 0, 0); __builtin_amdgcn_s_setprio(0); } while (0)
#define PG8_WAIT_V(n) asm volatile("s_waitcnt vmcnt(" #n ")" ::: "memory")
#define PG8_WAIT_L(n) asm volatile("s_waitcnt lgkmcnt(" #n ")" ::: "memory")
#define PG8_BAR __builtin_amdgcn_s_barrier()
#define PG8_SCHED __builtin_amdgcn_sched_barrier(0)
    Unit cur, nxt; int ui = 0;
    if (!S.next(0, cur)) return;
    f32x4 acc[2][2][4][2];
#pragma unroll
    for (int a = 0; a < 2; ++a)
#pragma unroll
        for (int b = 0; b < 2; ++b)
#pragma unroll
            for (int m = 0; m < 4; ++m)
#pragma unroll
                for (int n = 0; n < 2; ++n) acc[a][b][m][n] = (f32x4){0.f, 0.f, 0.f, 0.f};
    bf16x8 At[4][2], B0[2][2], B1[2][2];
    const char* cA = (const char*)g.A + (size_t)cur.pm * tstep + (size_t)cur.k0 * 2; const char* cB = (const char*)g.Bt + (size_t)cur.pn * tstep + (size_t)cur.k0 * 2;
    S.a_ready(cur);
    if constexpr (SP2) {
        PG8_STAGE(PG8_SB(0, 0), cB, voffB); PG8_STAGE(PG8_SB(0, 1), cB + hstep, voffB); PG8_STAGE(PG8_SA(0, 0), cA, voffA); PG8_STAGE(PG8_SA(0, 1), cA + hstep, voffA);
        if (wr == 1) PG8_BAR;
        PG8_WAIT_V(2); PG8_BAR;
        PG8_STAGE(PG8_SB(1, 0), cB + kstep, voffB); PG8_STAGE(PG8_SA(1, 0), cA + kstep, voffA); PG8_STAGE(PG8_SB(1, 1), cB + hstep + kstep, voffB);
        PG8_WAIT_V(6); PG8_BAR;
    } else {
        PG8_STAGE(PG8_SB(0, 0), cB, voffB); PG8_STAGE(PG8_SA(0, 0), cA, voffA); PG8_STAGE(PG8_SB(0, 1), cB + hstep, voffB); PG8_STAGE(PG8_SA(0, 1), cA + hstep, voffA);
        if (wr == 1) PG8_BAR;
        PG8_WAIT_V(4); PG8_BAR;
        PG8_STAGE(PG8_SB(1, 0), cB + kstep, voffB); PG8_STAGE(PG8_SA(1, 0), cA + kstep, voffA); PG8_STAGE(PG8_SB(1, 1), cB + hstep + kstep, voffB);
        PG8_WAIT_V(6); PG8_BAR;
    }
    for (;;) {
        const bool has_next = S.next(ui + 1, nxt);
        const char* nA = has_next ? (const char*)g.A + (size_t)nxt.pm * tstep + (size_t)nxt.k0 * 2 : cA; const char* nB = has_next ? (const char*)g.Bt + (size_t)nxt.pn * tstep + (size_t)nxt.k0 * 2 : cB;
        const int ntu = cur.nt ? cur.nt : nt;
        for (int t = 0; t < ntu; t += 2) {
            const bool last = (t == ntu - 2);
            const char* a1 = cA + (size_t)(t + 1) * kstep;
            const char* a2 = last ? nA : cA + (size_t)(t + 2) * kstep; const char* b2 = last ? nB : cB + (size_t)(t + 2) * kstep;
            const char* a3 = a2 + kstep; const char* b3 = b2 + kstep;
            if (last && has_next) S.a_ready(nxt);
            if constexpr (SP2) {
            PG8_LDB(B0, 0, 0); PG8_LDB(B1, 0, 1); PG8_SCHED; PG8_LDA(At, 0, 0); PG8_STAGE(PG8_SA(1, 1), a1 + hstep, voffA);
            PG8_WAIT_V(8); PG8_WAIT_L(0); PG8_BAR; PG8_MMA(0, 0, At, B0); PG8_MMA(0, 1, At, B1); PG8_BAR; PG8_SCHED;
            PG8_LDA(At, 0, 1); PG8_STAGE(PG8_SB(0, 0), b2, voffB); PG8_STAGE(PG8_SB(0, 1), b2 + hstep, voffB); PG8_STAGE(PG8_SA(0, 0), a2, voffA);
            PG8_WAIT_V(8); PG8_WAIT_L(0); PG8_BAR; PG8_MMA(1, 0, At, B0); PG8_MMA(1, 1, At, B1); PG8_BAR; PG8_SCHED;
            PG8_LDB(B0, 1, 0); PG8_LDB(B1, 1, 1); PG8_SCHED; PG8_LDA(At, 1, 0); PG8_STAGE(PG8_SA(0, 1), a2 + hstep, voffA);
            PG8_WAIT_V(8); PG8_WAIT_L(0); PG8_BAR; PG8_MMA(0, 0, At, B0); PG8_MMA(0, 1, At, B1); PG8_BAR; PG8_SCHED;
            PG8_LDA(At, 1, 1); PG8_STAGE(PG8_SB(1, 0), b3, voffB); PG8_STAGE(PG8_SB(1, 1), b3 + hstep, voffB); PG8_STAGE(PG8_SA(1, 0), a3, voffA);
            PG8_WAIT_V(8); PG8_WAIT_L(0); PG8_BAR; PG8_MMA(1, 0, At, B0); PG8_MMA(1, 1, At, B1); PG8_BAR; PG8_SCHED;
            } else {
            PG8_LDB(B0, 0, 0); PG8_SCHED; PG8_LDA(At, 0, 0); PG8_STAGE(PG8_SA(1, 1), a1 + hstep, voffA);
            PG8_WAIT_L(8); PG8_BAR; PG8_WAIT_L(0); PG8_MMA(0, 0, At, B0); PG8_BAR; PG8_SCHED;
            PG8_LDB(B1, 0, 1); PG8_STAGE(PG8_SB(0, 0), b2, voffB);
            PG8_BAR; PG8_WAIT_L(0); PG8_MMA(0, 1, At, B1); PG8_BAR;
            PG8_LDA(At, 0, 1); PG8_STAGE(PG8_SA(0, 0), a2, voffA);
            PG8_BAR; PG8_WAIT_L(0); PG8_MMA(1, 0, At, B0); PG8_BAR; PG8_SCHED;
            PG8_STAGE(PG8_SB(0, 1), b2 + hstep, voffB);
            PG8_WAIT_V(6); PG8_BAR; PG8_MMA(1, 1, At, B1); PG8_BAR;
            PG8_LDB(B0, 1, 0); PG8_SCHED; PG8_LDA(At, 1, 0); PG8_STAGE(PG8_SA(0, 1), a2 + hstep, voffA);
            PG8_WAIT_L(8); PG8_BAR; PG8_WAIT_L(0); PG8_MMA(0, 0, At, B0); PG8_BAR; PG8_SCHED;
            PG8_LDB(B1, 1, 1); PG8_STAGE(PG8_SB(1, 0), b3, voffB);
            PG8_BAR; PG8_WAIT_L(0); PG8_MMA(0, 1, At, B1); PG8_BAR;
            PG8_LDA(At, 1, 1); PG8_STAGE(PG8_SA(1, 0), a3, voffA);
            PG8_BAR; PG8_WAIT_L(0); PG8_MMA(1, 0, At, B0); PG8_BAR; PG8_SCHED;
            PG8_STAGE(PG8_SB(1, 1), b3 + hstep, voffB);
            PG8_WAIT_V(6); PG8_BAR; PG8_MMA(1, 1, At, B1); PG8_BAR;
            }
        }
        if constexpr (ALIGN_EPI) { if (wr == 0) PG8_BAR; }
        if constexpr (!Epi::AFTER_DRAIN) { E(acc, cur, wr, wc, fr, fq); S.done(cur); }
        if (!has_next) break;
        if (E.reset_after(cur))
#pragma unroll
        for (int a = 0; a < 2; ++a)
#pragma unroll
            for (int b = 0; b < 2; ++b)
#pragma unroll
                for (int m = 0; m < 4; ++m)
#pragma unroll
                    for (int n = 0; n < 2; ++n) acc[a][b][m][n] = (f32x4){0.f, 0.f, 0.f, 0.f};
        cur = nxt; cA = nA; cB = nB; ++ui;
        if constexpr (ALIGN_EPI) { if (wr == 1) PG8_BAR; }
    }
    PG8_WAIT_V(0);
    if constexpr (!ALIGN_EPI) { if (wr == 0) PG8_BAR; }
    PG8_BAR;
    if constexpr (Epi::AFTER_DRAIN) { E.fused(acc, cur, wr, wc, fr, fq, lds, wid, lane); S.done(cur); }
#undef PG8_SA
#undef PG8_SB
#undef PG8_STAGE
#undef PG8_LDA
#undef PG8_LDB
#undef PG8_MMA
#undef PG8_WAIT_V
#undef PG8_WAIT_L
#undef PG8_BAR
#undef PG8_SCHED
}
}

namespace ep {
using pg8::f32x4; using pg8::u32x4; using pg8::Unit; using pg8::bf16_t; using pg8::HALF; using pg8::BM; using pg8::cvt_pk_bf16;
typedef unsigned u32x2 __attribute__((ext_vector_type(2)));

struct InOrder {
    pg8::StaticOrder so; int G, c;
    __device__ void init(int G_, int c_) { so.init(MIN_, INW, G_, c_); G = G_; c = c_; }
    __device__ bool next(int i, Unit& u) const {
        const long L = (long)i * G + c;
        if (L < so.nwg) return so.next(i, u);
        const int j = (int)(L - so.nwg); if (j >= 8) return false;
        u.pm = 33 + (j & 1); u.pn = 52 + (j >> 1); u.k0 = 0; u.nt = 0; return true;
    }
    __device__ __forceinline__ void a_ready(const Unit&) const {}
    __device__ __forceinline__ void done(const Unit&) const {}
};

__device__ __forceinline__ float sigmoidf_fast(float x) { return __builtin_amdgcn_rcpf(1.0f + __builtin_amdgcn_exp2f(-x * LOG2E)); }
__device__ __forceinline__ float bf2f(unsigned short h) { return __uint_as_float((unsigned)h << 16); }

struct EpiIn {
    static constexpr bool PERM = true, AFTER_DRAIN = false;
    bf16_t *QSB, *KSB, *VSB, *GSB, *QBD, *KBD, *VBD, *GBD, *QMM, *GMM, *MG, *MK, *MV;
    float* out;
    bf16_t *KBC, *VBC;
    __device__ __forceinline__ bool reset_after(const Unit&) const { return true; }
    template <int ACT, int F32>
    __device__ __forceinline__ void store(const f32x4 (&acc)[2][2][4][2], bf16_t* dst, int ldc, int colt, int rowoff, int pm, float* f0, float* f1, int wr, int wc, int fr, int fq, bf16_t* bdc = nullptr) const {
        const int col0 = colt + wc * 32 + 8 * fq;
#pragma unroll
        for (int ai = 0; ai < 2; ++ai)
#pragma unroll
            for (int m = 0; m < 4; ++m) {
                const int r = pm * BM + ai * HALF + wr * 64 + m * 16 + fr;
                bf16_t* rowp = dst + (size_t)(r - rowoff) * ldc + col0;
                float* frow = nullptr;
                if (F32 == 1) { if (r < MP) frow = f0 + (size_t)r * 768; else if (r < MREAL) frow = f1 + (size_t)(r - MP) * 768; }
                if (F32 == 2) { if (r < MP) { const int t = r & (SEQ - 1); if (t >= SEQ - 512) frow = f0 + ((size_t)(r >> 12) * 512 + (t - (SEQ - 512))) * 768; } else if (r < MREAL) frow = f1 + (size_t)(r - MP) * 768; }
                if (F32 == 3) frow = f0 + (size_t)(r - MMEM0) * 512;
#pragma unroll
                for (int bj = 0; bj < 2; ++bj) {
                    f32x4 v0 = acc[ai][bj][m][0], v1 = acc[ai][bj][m][1];
                    if (F32 != 0) { if (frow) { __builtin_nontemporal_store(v0, (f32x4*)(frow + col0 + bj * HALF)); __builtin_nontemporal_store(v1, (f32x4*)(frow + col0 + bj * HALF + 4)); } }
                    if (ACT == 1) { v0 = v0 * QSCALE; v1 = v1 * QSCALE; }
                    if (ACT == 2) {
#pragma unroll
                        for (int e = 0; e < 4; ++e) { v0[e] = v0[e] * sigmoidf_fast(v0[e]); v1[e] = v1[e] * sigmoidf_fast(v1[e]); } }
                    if (ACT == 3) {
#pragma unroll
                        for (int e = 0; e < 4; ++e) { v0[e] = sigmoidf_fast(v0[e]); v1[e] = sigmoidf_fast(v1[e]); } }
                    u32x4 w; w.x = cvt_pk_bf16(v0[0], v0[1]); w.y = cvt_pk_bf16(v0[2], v0[3]); w.z = cvt_pk_bf16(v1[0], v1[1]); w.w = cvt_pk_bf16(v1[2], v1[3]);
                    *(u32x4*)(rowp + bj * HALF) = w;
                    if (F32 == 2 && SLACK_P1) { if (r >= MP && r < MREAL) *(u32x4*)(bdc + ((size_t)((r - MP) >> 4) * 576 + 512 + ((r - MP) & 15)) * 768 + col0 + bj * HALF) = w; } }
            }
    }
    __device__ __forceinline__ void store_gates(const f32x4 (&acc)[2][2][4][2], int t, int pm, int wr, int wc, int fr, int fq) const {
        const int idx0 = 64 * t + 16 * wc + 4 * fq;
        bf16_t* sdst; int sld, scol;
        if (t < 12) { sdst = GSB; sld = 768; scol = idx0; } else if (t < 24) { sdst = GBD; sld = 768; scol = idx0 - 768; } else { sdst = GMM; sld = 512; scol = idx0 - 1536; }
#pragma unroll
        for (int ai = 0; ai < 2; ++ai)
#pragma unroll
            for (int m = 0; m < 4; ++m) {
                const int r = pm * BM + ai * HALF + wr * 64 + m * 16 + fr;
                const f32x4 z1 = acc[ai][0][m][0], z2 = acc[ai][0][m][1], z3 = acc[ai][1][m][0], zs = acc[ai][1][m][1];
                f32x4 r1, r2, g3, sg;
#pragma unroll
                for (int e = 0; e < 4; ++e) {
                    const float d1 = fminf(1.0f + __builtin_amdgcn_exp2f(-z1[e] * LOG2E), 1e30f), d2 = fminf(1.0f + __builtin_amdgcn_exp2f(-z2[e] * LOG2E), 1e30f), d3 = fminf(1.0f + __builtin_amdgcn_exp2f(-z3[e] * LOG2E), 1e30f);
                    const float i1 = __builtin_amdgcn_rcpf(d1), i2 = __builtin_amdgcn_rcpf(d2), i3 = __builtin_amdgcn_rcpf(d3);
                    r1[e] = d2 * i1; r2[e] = d3 * i2; g3[e] = i3; sg[e] = zs[e] * sigmoidf_fast(zs[e]); }
                bf16_t* mrow = MG + (size_t)r * 6144 + idx0;
                u32x2 w;
                w.x = cvt_pk_bf16(r1[0], r1[1]); w.y = cvt_pk_bf16(r1[2], r1[3]); *(u32x2*)(mrow) = w;
                w.x = cvt_pk_bf16(r2[0], r2[1]); w.y = cvt_pk_bf16(r2[2], r2[3]); *(u32x2*)(mrow + 2048) = w;
                w.x = cvt_pk_bf16(g3[0], g3[1]); w.y = cvt_pk_bf16(g3[2], g3[3]); *(u32x2*)(mrow + 4096) = w;
                w.x = cvt_pk_bf16(sg[0], sg[1]); w.y = cvt_pk_bf16(sg[2], sg[3]); *(u32x2*)(sdst + (size_t)r * sld + scol) = w;
            }
    }
    __device__ __forceinline__ void operator()(const f32x4 (&acc)[2][2][4][2], const Unit& u, int wr, int wc, int fr, int fq) const {
        const int pn = u.pn, pm = u.pm;
        float* const o_sbk = out + 17039360, * const o_sbv = out + 23330816, * const o_bdk = out + 29622272, * const o_bdv = out + 30408704;
        float* const o_mk = out + 31195136, * const o_mv = out + 31457280;
        float* const s_sbk = out + 31719424, * const s_sbv = out + 31817728, * const s_bdk = out + 31916032, * const s_bdv = out + 32014336;
        if (pn < 3)        store<1, 0>(acc, QSB, 768, 256 * pn, 0, pm, nullptr, nullptr, wr, wc, fr, fq);
        else if (pn < 6)   store<0, 1>(acc, KSB, 768, 256 * (pn - 3), 0, pm, o_sbk, s_sbk, wr, wc, fr, fq);
        else if (pn < 9)   store<0, 1>(acc, VSB, 768, 256 * (pn - 6), 0, pm, o_sbv, s_sbv, wr, wc, fr, fq);
        else if (pn < 12)  store<1, 0>(acc, QBD, 768, 256 * (pn - 9), 0, pm, nullptr, nullptr, wr, wc, fr, fq);
        else if (pn < 15)  store<0, 2>(acc, KBD, 768, 256 * (pn - 12), 0, pm, o_bdk, s_bdk, wr, wc, fr, fq, KBC);
        else if (pn < 18)  store<0, 2>(acc, VBD, 768, 256 * (pn - 15), 0, pm, o_bdv, s_bdv, wr, wc, fr, fq, VBC);
        else if (pn < 20)  store<1, 0>(acc, QMM, 512, 256 * (pn - 18), 0, pm, nullptr, nullptr, wr, wc, fr, fq);
        else if (pn < 52)  store_gates(acc, pn - 20, pm, wr, wc, fr, fq);
        else if (pn < 54)  store<0, 3>(acc, MK, 512, 256 * (pn - 52), MMEM0, pm, o_mk, nullptr, wr, wc, fr, fq);
        else               store<0, 3>(acc, MV, 512, 256 * (pn - 54), MMEM0, pm, o_mv, nullptr, wr, wc, fr, fq);
    }
};

struct MergeOrder {
    pg8::StaticOrder so;
    __device__ void init(int G_, int c_) { so.init(MP, DM, G_, c_); }
    __device__ bool next(int i, Unit& u) const {
        const int ti = i / 3, seg = i - 3 * ti;
        if (!so.next(ti, u)) return false;
        u.k0 = 768 * seg; u.nt = (seg == 2) ? 8 : 12; return true;
    }
    __device__ __forceinline__ void a_ready(const Unit&) const {}
    __device__ __forceinline__ void done(const Unit&) const {}
};
struct EpiMerge {
    static constexpr bool PERM = true, AFTER_DRAIN = false;
    const bf16_t* MG; bf16_t* OUT;
    __device__ __forceinline__ bool reset_after(const Unit& u) const { return u.k0 == 1536; }
    __device__ __forceinline__ void operator()(f32x4 (&acc)[2][2][4][2], const Unit& u, int wr, int wc, int fr, int fq) const {
        const int col0 = u.pn * BM + wc * 32 + 8 * fq;
        const int seg = (u.k0 == 0) ? 0 : (u.k0 == 768 ? 1 : 2);
        const bool last = (seg == 2);
        u32x4 g[2][4][2];
#pragma unroll
        for (int ai = 0; ai < 2; ++ai)
#pragma unroll
            for (int m = 0; m < 4; ++m) { const bf16_t* g_ = MG + (size_t)(u.pm * BM + ai * HALF + wr * 64 + m * 16 + fr) * 6144 + seg * 2048 + col0;
#pragma unroll
                for (int bj = 0; bj < 2; ++bj) g[ai][m][bj] = *(const u32x4*)(g_ + bj * HALF); }
#pragma unroll
        for (int ai = 0; ai < 2; ++ai)
#pragma unroll
            for (int m = 0; m < 4; ++m) { bf16_t* rowp = OUT + (size_t)(u.pm * BM + ai * HALF + wr * 64 + m * 16 + fr) * DM + col0;
#pragma unroll
                for (int bj = 0; bj < 2; ++bj) {
#pragma unroll
                    for (int e = 0; e < 4; ++e) { acc[ai][bj][m][e >> 1][2 * (e & 1)] *= __uint_as_float(g[ai][m][bj][e] << 16); acc[ai][bj][m][e >> 1][2 * (e & 1) + 1] *= __uint_as_float(g[ai][m][bj][e] & 0xffff0000u); }
                    if (last) { u32x4 w; w.x = cvt_pk_bf16(acc[ai][bj][m][0][0], acc[ai][bj][m][0][1]); w.y = cvt_pk_bf16(acc[ai][bj][m][0][2], acc[ai][bj][m][0][3]);
                        w.z = cvt_pk_bf16(acc[ai][bj][m][1][0], acc[ai][bj][m][1][1]); w.w = cvt_pk_bf16(acc[ai][bj][m][1][2], acc[ai][bj][m][1][3]);
                        *(u32x4*)(rowp + bj * HALF) = w; } } }
    }
};

struct EpiOut {
    static constexpr bool PERM = true, AFTER_DRAIN = false;
    bf16_t* yb; float* ssq;
    __device__ __forceinline__ bool reset_after(const Unit&) const { return true; }
    __device__ __forceinline__ void operator()(const f32x4 (&acc)[2][2][4][2], const Unit& u, int wr, int wc, int fr, int fq) const {
        const int col0 = u.pn * BM + wc * 32 + 8 * fq;
#pragma unroll
        for (int ai = 0; ai < 2; ++ai)
#pragma unroll
            for (int m = 0; m < 4; ++m) {
                const int r = u.pm * BM + ai * HALF + wr * 64 + m * 16 + fr;
                bf16_t* yrow = yb + (size_t)r * DM + col0;
                float s = 0.f;
#pragma unroll
                for (int bj = 0; bj < 2; ++bj) { const f32x4 v0 = acc[ai][bj][m][0], v1 = acc[ai][bj][m][1];
                    s += ((v0[0] * v0[0] + v0[1] * v0[1]) + (v0[2] * v0[2] + v0[3] * v0[3])) + ((v1[0] * v1[0] + v1[1] * v1[1]) + (v1[2] * v1[2] + v1[3] * v1[3]));
                    u32x4 w; w.x = cvt_pk_bf16(v0[0], v0[1]); w.y = cvt_pk_bf16(v0[2], v0[3]); w.z = cvt_pk_bf16(v1[0], v1[1]); w.w = cvt_pk_bf16(v1[2], v1[3]);
                    *(u32x4*)(yrow + bj * HALF) = w; }
                s += __shfl_xor(s, 16); s += __shfl_xor(s, 32);
                if (fq == 0) ssq[(size_t)r * 32 + u.pn * 4 + wc] = s;
            }
    }
};

struct EpiOutFused {
    static constexpr bool PERM = false, AFTER_DRAIN = true;
    const float* x; float* out; const float* gpost; float* xbuf; unsigned* cnt; unsigned* tmo;
    __device__ __forceinline__ bool reset_after(const Unit&) const { return true; }
    __device__ __forceinline__ void operator()(const f32x4 (&)[2][2][4][2], const Unit&, int, int, int, int) const {}
    __device__ __forceinline__ void fused(f32x4 (&acc)[2][2][4][2], const Unit& u, int wr, int wc, int fr, int fq, __attribute__((address_space(3))) unsigned char* lds, int wid, int lane) const {
        typedef __attribute__((address_space(3))) float lfloat;
        lfloat* P = (lfloat*)lds;
        lfloat* S = (lfloat*)(lds + 4096);
        __attribute__((address_space(3))) unsigned* flag = (__attribute__((address_space(3))) unsigned*)(lds + 4096 + 1024);
        const int col0 = u.pn * BM + wc * 32 + 4 * fq;
        f32x4 pre[4][2][2];
#pragma unroll
        for (int m = 0; m < 4; ++m) { const size_t off = (size_t)(u.pm * BM + wr * 64 + m * 16 + fr) * DM + col0;
#pragma unroll
            for (int bj = 0; bj < 2; ++bj)
#pragma unroll
                for (int n = 0; n < 2; ++n) pre[m][bj][n] = *(const f32x4*)(x + off + bj * HALF + n * 16); }
#pragma unroll
        for (int ai = 0; ai < 2; ++ai)
#pragma unroll
            for (int m = 0; m < 4; ++m) { float s = 0.f;
#pragma unroll
                for (int bj = 0; bj < 2; ++bj)
#pragma unroll
                    for (int n = 0; n < 2; ++n) { const f32x4 v = acc[ai][bj][m][n]; s += (v[0] * v[0] + v[1] * v[1]) + (v[2] * v[2] + v[3] * v[3]); }
                s += __shfl_xor(s, 16); s += __shfl_xor(s, 32);
                if (fq == 0) P[(ai * HALF + wr * 64 + m * 16 + fr) * 4 + wc] = s; }
        asm volatile("s_waitcnt lgkmcnt(0)" ::: "memory"); __builtin_amdgcn_s_barrier(); asm volatile("" ::: "memory");
        const int row = wid * 32 + (lane & 31);
        if (lane < 32) { const float t = (P[row * 4 + 0] + P[row * 4 + 1]) + (P[row * 4 + 2] + P[row * 4 + 3]);
            __hip_atomic_store(xbuf + ((size_t)(u.pm * BM + row) * 8 + u.pn), t, __ATOMIC_RELAXED, __HIP_MEMORY_SCOPE_AGENT); }
        asm volatile("s_waitcnt vmcnt(0)" ::: "memory");
        if (lane == 0) __hip_atomic_fetch_add(cnt + 64 * u.pm, 1u, __ATOMIC_RELAXED, __HIP_MEMORY_SCOPE_AGENT);
        if (wid == 0) { bool dead = false; const unsigned long long t0 = __builtin_amdgcn_s_memrealtime();
            for (;;) {
                if ((unsigned)__builtin_amdgcn_readfirstlane(__hip_atomic_load(cnt + 64 * u.pm, __ATOMIC_RELAXED, __HIP_MEMORY_SCOPE_AGENT)) >= 64u) break;
                if (__builtin_amdgcn_s_memrealtime() - t0 > 2000000ull) { if (lane == 0) __hip_atomic_store(tmo, 1u, __ATOMIC_RELAXED, __HIP_MEMORY_SCOPE_AGENT); dead = true; break; }
                __builtin_amdgcn_s_sleep(2); }
            __builtin_amdgcn_fence(__ATOMIC_ACQUIRE, "agent");
            if (lane == 0) flag[0] = dead ? 1u : 0u; }
        asm volatile("s_waitcnt vmcnt(0) lgkmcnt(0)" ::: "memory"); __builtin_amdgcn_s_barrier(); asm volatile("" ::: "memory");
        const bool bad = flag[0] != 0u;
        if (lane < 32) { const float* slot = xbuf + (size_t)(u.pm * BM + row) * 8; float q = 0.f;
#pragma unroll
            for (int t = 0; t < 8; ++t) q += __hip_atomic_load(slot + t, __ATOMIC_RELAXED, __HIP_MEMORY_SCOPE_AGENT);
            S[row] = 1.0f / sqrtf(q * (1.0f / DM) + RMS_EPS); }
        asm volatile("s_waitcnt lgkmcnt(0)" ::: "memory"); __builtin_amdgcn_s_barrier(); asm volatile("" ::: "memory");
        f32x4 gv[2][2];
#pragma unroll
        for (int bj = 0; bj < 2; ++bj)
#pragma unroll
            for (int n = 0; n < 2; ++n) gv[bj][n] = *(const f32x4*)(gpost + col0 + bj * HALF + n * 16);
        const float qnan = __builtin_nanf("");
#pragma unroll
        for (int ai = 0; ai < 2; ++ai)
#pragma unroll
            for (int m = 0; m < 4; ++m) { const int r = ai * HALF + wr * 64 + m * 16 + fr; const float rs = S[r]; const size_t off = (size_t)(u.pm * BM + r) * DM + col0;
#pragma unroll
                for (int bj = 0; bj < 2; ++bj)
#pragma unroll
                    for (int n = 0; n < 2; ++n) { const f32x4 bs = ai == 0 ? pre[m][bj][n] : *(const f32x4*)(x + off + bj * HALF + n * 16);
                        f32x4 o = bs + acc[ai][bj][m][n] * rs * gv[bj][n];
                        if (bad) o = (f32x4){qnan, qnan, qnan, qnan};
                        *(f32x4*)(out + off + bj * HALF + n * 16) = o; }
                if (m & 1) asm volatile("" ::: "memory"); }
    }
};

template <int MODE>
__device__ __forceinline__ void skinny_phase(const bf16_t* A, const bf16_t* Bt, const bf16_t* MG, bf16_t* OUTB, float* OUTF, float* SSQS, int slice, __attribute__((address_space(3))) unsigned char* ldsl) {
    typedef short bf16x8 __attribute__((ext_vector_type(8)));
    const int tid = threadIdx.x, lane = tid & 63, fr = lane & 15, fq = lane >> 4;
    const int w = __builtin_amdgcn_readfirstlane(tid >> 6);
    const int cb = slice >> 1, rh = slice & 1;
    const int row0 = MP + 64 * rh + fr;
    const bf16_t* ap = A + (size_t)row0 * DM + 256 * w + 8 * fq;
    const bf16_t* bp = Bt + (size_t)(16 * cb + fr) * DM + 256 * w + 8 * fq;
    bf16x8 bf[8], af[4][8];
#pragma unroll
    for (int j = 0; j < 8; ++j) bf[j] = *(const bf16x8*)(bp + 32 * j);
#pragma unroll
    for (int rb = 0; rb < 4; ++rb)
#pragma unroll
        for (int j = 0; j < 8; ++j) af[rb][j] = *(const bf16x8*)(ap + (size_t)rb * 16 * DM + 32 * j);
    f32x4 acc[4];
#pragma unroll
    for (int rb = 0; rb < 4; ++rb) { acc[rb] = (f32x4){0.f, 0.f, 0.f, 0.f};
#pragma unroll
        for (int j = 0; j < 8; ++j) acc[rb] = __builtin_amdgcn_mfma_f32_16x16x32_bf16(bf[j], af[rb][j], acc[rb], 0, 0, 0); }
    if (MODE == 0) { const int s = (w < 3) ? 0 : (w < 6 ? 1 : 2);
#pragma unroll
        for (int rb = 0; rb < 4; ++rb) { const bf16_t* gp = MG + (size_t)(row0 + 16 * rb) * 6144 + 16 * cb + 4 * fq;
            const u32x2 ra = *(const u32x2*)gp, rb2 = *(const u32x2*)(gp + 2048), gc = *(const u32x2*)(gp + 4096);
#pragma unroll
            for (int e = 0; e < 4; ++e) { const unsigned a_ = e < 2 ? ra.x : ra.y, b_ = e < 2 ? rb2.x : rb2.y, c_ = e < 2 ? gc.x : gc.y;
                const float f1 = (e & 1) ? __uint_as_float(a_ & 0xffff0000u) : __uint_as_float(a_ << 16), f2 = (e & 1) ? __uint_as_float(b_ & 0xffff0000u) : __uint_as_float(b_ << 16), f3 = (e & 1) ? __uint_as_float(c_ & 0xffff0000u) : __uint_as_float(c_ << 16);
                acc[rb][e] *= f3 * (s < 2 ? f2 : 1.0f) * (s < 1 ? f1 : 1.0f); } } }
    __attribute__((address_space(3))) f32x4* red = (__attribute__((address_space(3))) f32x4*)ldsl;
#pragma unroll
    for (int rb = 0; rb < 4; ++rb) red[(w * 4 + rb) * 64 + lane] = acc[rb];
    __syncthreads();
    if (w < 4) { const int rb = w; f32x4 s = red[rb * 64 + lane];
#pragma unroll
        for (int k = 1; k < 8; ++k) s = s + red[(k * 4 + rb) * 64 + lane];
        const int row = row0 + 16 * rb;
        if (MODE == 0) { u32x2 o; o.x = cvt_pk_bf16(s[0], s[1]); o.y = cvt_pk_bf16(s[2], s[3]); *(u32x2*)(OUTB + (size_t)row * DM + 16 * cb + 4 * fq) = o; }
        else { *(f32x4*)(OUTF + (size_t)(row - MP) * DM + 16 * cb + 4 * fq) = s;
            float q = (s[0] * s[0] + s[1] * s[1]) + (s[2] * s[2] + s[3] * s[3]);
            q += __shfl_xor(q, 16); q += __shfl_xor(q, 32);
            if (fq == 0) SSQS[(size_t)(row - MP) * 128 + cb] = q; }
    }
    __syncthreads();
}
}

namespace att {
typedef unsigned short u16;
#define GA __attribute__((address_space(1)))
using bf16x8 = __attribute__((ext_vector_type(8))) short;
using s16x4  = __attribute__((ext_vector_type(4))) short;
using f32x16 = __attribute__((ext_vector_type(16))) float;
using f32x4  = __attribute__((ext_vector_type(4))) float;
using u32x4  = __attribute__((ext_vector_type(4))) unsigned;
using u32x2  = __attribute__((ext_vector_type(2))) unsigned;
constexpr int SHM_V = 16384, SHM_K = 16384;
constexpr int NBUF = 3;
constexpr int OFF_V = 0, OFF_K = NBUF * SHM_V, OFF_BIAS = 2 * NBUF * SHM_V, OFF_FLAGS = OFF_BIAS + 2304, OFF_ITEM = OFF_FLAGS + 128, ATT_LDS = OFF_ITEM + 64;
constexpr float SB_DONE_LOG2 = -200.0f;
#define KSWZ(row, colB) ((row) * 256 + ((colB) ^ (((row) & 7) << 4)))
#define ATT_SBAR() __builtin_amdgcn_sched_barrier(0)
__device__ __forceinline__ int crow(int r, int hi) { return (r & 3) + 8 * (r >> 2) + 4 * hi; }
__device__ __forceinline__ unsigned cvtpk(float lo, float hi) { return pg8::cvt_pk_bf16(lo, hi); }
__device__ __forceinline__ int v_st(int k, int c) { const int kk = (k & ~0xC) | ((k & 4) << 1) | ((k & 8) >> 1); return ((kk >> 3) * 4 + (c >> 5)) * 512 + ((kk & 7) * 32 + (c & 31)) * 2; }
__device__ __forceinline__ int v_rd_base(int lane) { return ((lane & 3) << 3) | (((lane >> 2) & 3) << 6) | (((lane >> 4) & 1) << 5) | (((lane >> 5) & 1) << 8); }
constexpr int v_rd_off(int d0, int ks, int half) { return d0 * 512 + ks * 4096 + half * 2048; }
template <int OFF> __device__ __forceinline__ s16x4 tr_read(int vb) { s16x4 r; asm volatile("ds_read_b64_tr_b16 %0, %1 offset:%2" : "=&v"(r) : "v"(vb), "i"(OFF) : "memory"); return r; }

struct Item {
    int mode;
    int rule;
    const GA u16* Q; int ldq; int nq; int qpos0;
    const GA u16 *kb, *vb; int ldb; int pb_lo, pb_hi;
    const GA float *kf, *vf; int ldf; int pf_lo, pf_hi;
    int pv_lo, pv_hi;
    int kp_first, kp_step, ntiles;
    const GA float* bias;
    GA u16* O; int ldo; const GA u16* G; int ldg;
    int dma;
};

template <bool QPARK>
__device__ __forceinline__ void qkt(f32x16& p0, f32x16& p1, const char* Ks, const bf16x8* qr, const char* qpark, int r32, int hi) {
    p0 = f32x16{}; p1 = f32x16{};
#pragma unroll
    for (int d0 = 0; d0 < 8; ++d0) { const int cb = (d0 * 16 + hi * 8) * 2;
        const bf16x8 b0 = *reinterpret_cast<const bf16x8*>(Ks + KSWZ(r32, cb));
        const bf16x8 b1 = *reinterpret_cast<const bf16x8*>(Ks + KSWZ(32 + r32, cb));
        const bf16x8 q = QPARK ? *reinterpret_cast<const bf16x8*>(qpark + d0 * 1024) : qr[d0];
        p0 = __builtin_amdgcn_mfma_f32_32x32x16_bf16(b0, q, p0, 0, 0, 0);
        p1 = __builtin_amdgcn_mfma_f32_32x32x16_bf16(b1, q, p1, 0, 0, 0); }
}
template <int D0> __device__ __forceinline__ void pv_one(f32x16& od, int vb, bf16x8 pa0, bf16x8 pa1, bf16x8 pa2, bf16x8 pa3) {
    const s16x4 l0 = tr_read<v_rd_off(D0, 0, 0)>(vb), h0 = tr_read<v_rd_off(D0, 0, 1)>(vb), l1 = tr_read<v_rd_off(D0, 1, 0)>(vb), h1 = tr_read<v_rd_off(D0, 1, 1)>(vb);
    const s16x4 l2 = tr_read<v_rd_off(D0, 2, 0)>(vb), h2 = tr_read<v_rd_off(D0, 2, 1)>(vb), l3 = tr_read<v_rd_off(D0, 3, 0)>(vb), h3 = tr_read<v_rd_off(D0, 3, 1)>(vb);
    asm volatile("s_waitcnt lgkmcnt(0)" ::: "memory"); ATT_SBAR();
#define ATT_PK(L, H) (bf16x8){L[0], L[1], L[2], L[3], H[0], H[1], H[2], H[3]}
    od = __builtin_amdgcn_mfma_f32_32x32x16_bf16(ATT_PK(l0, h0), pa0, od, 0, 0, 0);
    od = __builtin_amdgcn_mfma_f32_32x32x16_bf16(ATT_PK(l1, h1), pa1, od, 0, 0, 0);
    od = __builtin_amdgcn_mfma_f32_32x32x16_bf16(ATT_PK(l2, h2), pa2, od, 0, 0, 0);
    od = __builtin_amdgcn_mfma_f32_32x32x16_bf16(ATT_PK(l3, h3), pa3, od, 0, 0, 0);
#undef ATT_PK
}
#define ATT_PK4(P, BASE, OUT) do { const unsigned a0_ = cvtpk(P[BASE + 0], P[BASE + 1]), a1_ = cvtpk(P[BASE + 2], P[BASE + 3]);   \
    const unsigned b0_ = cvtpk(P[BASE + 4], P[BASE + 5]), b1_ = cvtpk(P[BASE + 6], P[BASE + 7]);                              \
    auto r0_ = __builtin_amdgcn_permlane32_swap(a0_, b0_, false, false); auto r1_ = __builtin_amdgcn_permlane32_swap(a1_, b1_, false, false); \
    u32x4 w_ = {r0_[0], r1_[0], r0_[1], r1_[1]}; OUT = *reinterpret_cast<bf16x8*>(&w_); } while (0)

__device__ __forceinline__ void sb_half(f32x16& p, float& carry, bool need_mask, int kbase, int qpos, int pv_lo, int pv_hi, int hi) {
    float T[16];
#pragma unroll
    for (int r = 0; r < 16; ++r) {
        const float z = p[r];
        const float t = __builtin_amdgcn_exp2f(-__builtin_fabsf(z));
        const float l = __builtin_amdgcn_logf(1.0f + t);
        float lm = -(fmaxf(z, 0.f) + l);
        float lp = fminf(z, 0.f) - l;
        if (need_mask) { const int kp = kbase + crow(r, hi); const bool ok = (kp < qpos) && (kp >= pv_lo) && (kp < pv_hi); lm = ok ? lm : 0.f; lp = ok ? lp : -1e30f; }
        T[r] = lm; p[r] = lp;
    }
    float glo[4], ghi[4];
#pragma unroll
    for (int g = 0; g < 4; ++g) {
        T[4 * g + 2] += T[4 * g + 3]; T[4 * g + 1] += T[4 * g + 2]; T[4 * g] += T[4 * g + 1];
        const float gt = T[4 * g];
        auto rr = __builtin_amdgcn_permlane32_swap(__float_as_uint(gt), __float_as_uint(gt), false, false);
        glo[g] = __uint_as_float(rr[0]); ghi[g] = __uint_as_float(rr[1]);
    }
    float SG[4];
    SG[3] = 0.f; SG[2] = glo[3] + ghi[3]; SG[1] = SG[2] + (glo[2] + ghi[2]); SG[0] = SG[1] + (glo[1] + ghi[1]);
    const float tot = SG[0] + (glo[0] + ghi[0]);
#pragma unroll
    for (int g = 0; g < 4; ++g) SG[g] += carry + (hi == 0 ? ghi[g] : 0.f);
#pragma unroll
    for (int r = 0; r < 16; ++r) p[r] = __builtin_amdgcn_exp2f(p[r] + ((r & 3) == 3 ? SG[r >> 2] : SG[r >> 2] + T[r + 1]));
    carry += tot;
}

#define ATT_TILE(Kt, vb_) do { \
            f32x16 p0, p1; \
            qkt<!DMA>(p0, p1, (Kt), qr, qpark, r32, hi); \
            bool need_mask = (kp0 < it.pv_lo) || (kp0 + 64 > it.pv_hi); \
            if (MODE == 0) { \
                need_mask = need_mask || (kp0 + 63 >= it.qpos0 + 32 * wid); \
                sb_half(p1, carry, need_mask, kp0 + 32, qpos, it.pv_lo, it.pv_hi, hi); \
                sb_half(p0, carry, need_mask, kp0, qpos, it.pv_lo, it.pv_hi, hi); \
            } else { \
                if (has_bias) {       \
                    const int dlo_ = it.qpos0 + 32 * wid - kp0 - 63, dhi_ = it.qpos0 + 32 * wid + 31 - kp0;       \
                    if (dlo_ >= 256) { const float c_ = biasT[0]; \
                        _Pragma("unroll") for (int r = 0; r < 16; ++r) { p0[r] += c_; p1[r] += c_; } } \
                    else if (dlo_ > -256 && dhi_ < 256) { const float* rb_ = biasT + (256 - qpos + kp0 + 4 * hi);              \
                        _Pragma("unroll") for (int r = 0; r < 16; ++r) { p0[r] += rb_[(r & 3) + 8 * (r >> 2)]; p1[r] += rb_[32 + (r & 3) + 8 * (r >> 2)]; } } \
                    else { \
                        _Pragma("unroll") for (int r = 0; r < 16; ++r) { const int kp = kp0 + crow(r, hi); \
                            int i0_ = 256 - qpos + kp; i0_ = i0_ < 0 ? 0 : (i0_ > 512 ? 512 : i0_); \
                            int i1_ = 288 - qpos + kp; i1_ = i1_ < 0 ? 0 : (i1_ > 512 ? 512 : i1_); \
                            p0[r] += biasT[i0_]; p1[r] += biasT[i1_]; } } \
                } \
                if (need_mask) { \
                    _Pragma("unroll") for (int r = 0; r < 16; ++r) { const int kp = kp0 + crow(r, hi); \
                        if (!(kp >= it.pv_lo && kp < it.pv_hi)) p0[r] = -1e30f; \
                        if (!(kp + 32 >= it.pv_lo && kp + 32 < it.pv_hi)) p1[r] = -1e30f; } \
                } \
                float pmax = p0[0]; \
                _Pragma("unroll") for (int r = 1; r < 16; ++r) pmax = fmaxf(pmax, p0[r]); \
                _Pragma("unroll") for (int r = 0; r < 16; ++r) pmax = fmaxf(pmax, p1[r]); \
                { auto rr = __builtin_amdgcn_permlane32_swap(__float_as_uint(pmax), __float_as_uint(pmax), false, false); pmax = fmaxf(__uint_as_float(rr[0]), __uint_as_float(rr[1])); } \
                float mn = m_reg, alpha = 1.f;                  \
                if (!__all(pmax - m_reg <= 8.0f)) { mn = fmaxf(m_reg, pmax); alpha = __builtin_amdgcn_exp2f(m_reg - mn); m_reg = mn; } \
                float ps = 0.f; \
                _Pragma("unroll") for (int r = 0; r < 16; ++r) { p0[r] = __builtin_amdgcn_exp2f(p0[r] - mn); ps += p0[r]; } \
                _Pragma("unroll") for (int r = 0; r < 16; ++r) { p1[r] = __builtin_amdgcn_exp2f(p1[r] - mn); ps += p1[r]; } \
                { auto rr = __builtin_amdgcn_permlane32_swap(__float_as_uint(ps), __float_as_uint(ps), false, false); ps = __uint_as_float(rr[0]) + __uint_as_float(rr[1]); } \
                l_reg = l_reg * alpha + ps; \
                if (__any(alpha < 1.f)) { \
                    _Pragma("unroll") for (int d = 0; d < 4; ++d) \
                        _Pragma("unroll") for (int r = 0; r < 16; ++r) o[d][r] *= alpha; } \
            } \
            bf16x8 pa0, pa1, pa2, pa3; \
            ATT_PK4(p0, 0, pa0); ATT_PK4(p0, 8, pa1); ATT_PK4(p1, 0, pa2); ATT_PK4(p1, 8, pa3); \
            const int vbt_ = (vb_); \
            pv_one<0>(o[0], vbt_, pa0, pa1, pa2, pa3); pv_one<1>(o[1], vbt_, pa0, pa1, pa2, pa3); pv_one<2>(o[2], vbt_, pa0, pa1, pa2, pa3); pv_one<3>(o[3], vbt_, pa0, pa1, pa2, pa3); \
        } while (0)

template <int MODE, bool DMA>
__device__ __forceinline__ void run_item(const Item& it, char* lds, __attribute__((address_space(3))) unsigned char* ldsl) {
    typedef __attribute__((address_space(3))) unsigned las_u32;
    const int tid = threadIdx.x, lane = tid & 63, r32 = lane & 31, hi = lane >> 5;
    const int wid = __builtin_amdgcn_readfirstlane(tid >> 6);
    char* V_lds = lds + OFF_V; char* K_lds = lds + OFF_K;
    float* biasT = (float*)(lds + OFF_BIAS);
    volatile __attribute__((address_space(3))) int* flags = (volatile __attribute__((address_space(3))) int*)(ldsl + OFF_FLAGS);
    const bool has_bias = (MODE == 1) && (it.bias != nullptr);
    const bool wave_rows = (32 * wid < it.nq);
    int qrow = 32 * wid + r32; if (qrow >= it.nq) qrow = it.nq - 1;
    const int qpos = it.qpos0 + 32 * wid + r32;
    bf16x8 qr[8];
    char* const qpark = K_lds + 2 * SHM_K + (wid & 1) * 8192 + lane * 16;
#define ATT_ITEM_LOADS() do { \
    if (has_bias) for (int i = tid; i < 513; i += 512) biasT[i] = it.bias[512 - i] * LOG2E; \
    { const GA u16* Qw = it.Q + (size_t)qrow * it.ldq + hi * 8; \
      _Pragma("unroll") for (int d0 = 0; d0 < 8; ++d0) { const bf16x8 q = *reinterpret_cast<const GA bf16x8*>(Qw + d0 * 16); \
          if constexpr (DMA) qr[d0] = q; else { if (wid < 2) *reinterpret_cast<bf16x8*>(qpark + d0 * 1024) = q; } } } \
    } while (0)
    f32x16 o[4]; o[0] = f32x16{}; o[1] = f32x16{}; o[2] = f32x16{}; o[3] = f32x16{};
    float carry = 0.f, m_reg = -1e30f, l_reg = 0.f;
    const int vb0 = (int)(uintptr_t)V_lds + v_rd_base(lane);
    const int nt = it.ntiles;
    bool wdone = !wave_rows;
    if constexpr (!DMA) ATT_ITEM_LOADS();
    if constexpr (DMA) {
        unsigned koff[2], voff[2];
#pragma unroll
        for (int i = 0; i < 2; ++i) { const int p = wid + 8 * i;
            const int krow = 4 * p + (lane >> 4), kch = (lane & 15) ^ (krow & 7);
            koff[i] = (unsigned)(krow * it.ldb * 2 + kch * 16);
            const int s = 2 * p + (lane >> 5), kk = 8 * (s >> 2) + ((lane & 31) >> 2), k = (kk & ~0xC) | ((kk & 4) << 1) | ((kk & 8) >> 1), c = 32 * (s & 3) + 8 * (lane & 3);
            voff[i] = (unsigned)(k * it.ldb * 2 + c * 2); }
        const GA char* kbase = (const GA char*)it.kb; const GA char* vbase = (const GA char*)it.vb;
#define ATT_DMA(b, kp0_) do { const size_t to_ = (size_t)((kp0_) - it.pb_lo) * (size_t)it.ldb * 2; \
        _Pragma("unroll") for (int i_ = 0; i_ < 2; ++i_) { \
            __builtin_amdgcn_global_load_lds((const GA unsigned*)(kbase + to_ + koff[i_]), (las_u32*)(ldsl + OFF_K + (b) * SHM_K + (wid + 8 * i_) * 1024), 16, 0, 0); \
            __builtin_amdgcn_global_load_lds((const GA unsigned*)(vbase + to_ + voff[i_]), (las_u32*)(ldsl + OFF_V + (b) * SHM_V + (wid + 8 * i_) * 1024), 16, 0, 0); } } while (0)
        ATT_DMA(0, it.kp_first);
        if (nt > 1) ATT_DMA(1, it.kp_first + it.kp_step);
        ATT_ITEM_LOADS();
        int cur = 0;
        for (int j = 0; j < nt; ++j) {
            const int kp0 = it.kp_first + j * it.kp_step;
            if (j + 1 < nt) asm volatile("s_waitcnt vmcnt(4) lgkmcnt(0)\n\ts_barrier" ::: "memory");
            else            asm volatile("s_waitcnt vmcnt(0) lgkmcnt(0)\n\ts_barrier" ::: "memory");
            if (MODE == 0 && SB_EARLY_EXIT && j > 0) {
                int alld = 1;
#pragma unroll
                for (int w = 0; w < 8; ++w) alld &= flags[((j - 1) & 1) * 8 + w];
                if (alld) break;
            }
            if (j + 2 < nt) { const int b2 = (cur >= 1) ? cur - 1 : cur + 2; ATT_DMA(b2, kp0 + 2 * it.kp_step); }
            bool active = wave_rows;
            if (it.rule == 1) active = active && (kp0 <= it.qpos0 + 32 * wid + 30) && !wdone;
            if (it.rule == 2) { const int ct = kp0 >> 6, cw = (it.qpos0 + 32 * wid) >> 6; active = active && (ct >= cw - 8) && (ct <= cw); }
            if (active) ATT_TILE(K_lds + cur * SHM_K, vb0 + cur * SHM_V);
            if (MODE == 0 && SB_EARLY_EXIT) {
                if (wave_rows && !wdone) { const bool rowdone = (carry < SB_DONE_LOG2) || (32 * wid + r32 >= it.nq); wdone = __all(rowdone); }
                if (lane == 0) flags[(j & 1) * 8 + wid] = wdone ? 1 : 0;
            }
            cur = (cur == NBUF - 1) ? 0 : cur + 1;
        }
        asm volatile("s_waitcnt vmcnt(0)" ::: "memory");
#undef ATT_DMA
    } else {
    const int sr = tid >> 4, sc = (tid & 15) * 8;
    const int vst0 = v_st(sr, sc), vst1 = v_st(32 + sr, sc), kst0 = KSWZ(sr, sc * 2), kst1 = KSWZ(32 + sr, sc * 2);
    f32x4 sK0a, sK0b, sK1a, sK1b, sV0a, sV0b, sV1a, sV1b;
#define ATT_LD(p, A, B, kbp, kfp) do { const int p_ = (p); const bool isb_ = (p_ >= it.pb_lo && p_ < it.pb_hi), isf_ = (p_ >= it.pf_lo && p_ < it.pf_hi); \
        const GA char* a0_ = isf_ ? (const GA char*)(kfp + (size_t)(p_ - it.pf_lo) * it.ldf + sc) : (const GA char*)(kbp + (size_t)(isb_ ? p_ - it.pb_lo : 0) * it.ldb + sc); \
        const f32x4 la_ = *reinterpret_cast<const GA f32x4*>(a0_); const f32x4 lb_ = *reinterpret_cast<const GA f32x4*>(a0_ + (isf_ ? 16 : 0)); \
        A = la_; B = lb_; } while (0)
#define ATT_CV(p, A, B, OUT) do { const int p_ = (p); const bool isb_ = (p_ >= it.pb_lo && p_ < it.pb_hi), isf_ = (p_ >= it.pf_lo && p_ < it.pf_hi); \
        u32x4 w_ = {cvtpk(A[0], A[1]), cvtpk(A[2], A[3]), cvtpk(B[0], B[1]), cvtpk(B[2], B[3])}; const u32x4 r_ = __builtin_bit_cast(u32x4, A); \
        w_.x = isf_ ? w_.x : (isb_ ? r_.x : 0u); w_.y = isf_ ? w_.y : (isb_ ? r_.y : 0u); w_.z = isf_ ? w_.z : (isb_ ? r_.z : 0u); w_.w = isf_ ? w_.w : (isb_ ? r_.w : 0u); \
        OUT = *reinterpret_cast<bf16x8*>(&w_); } while (0)
#define ATT_SLOAD(kp0) do { ATT_LD((kp0) + sr, sK0a, sK0b, it.kb, it.kf); ATT_LD((kp0) + 32 + sr, sK1a, sK1b, it.kb, it.kf); \
        ATT_LD((kp0) + sr, sV0a, sV0b, it.vb, it.vf); ATT_LD((kp0) + 32 + sr, sV1a, sV1b, it.vb, it.vf); } while (0)
#define ATT_SWRITE(b, kp0) do { bf16x8 t_; \
        ATT_CV((kp0) + sr, sK0a, sK0b, t_); *reinterpret_cast<bf16x8*>(K_lds + (b) * SHM_K + kst0) = t_; \
        ATT_CV((kp0) + 32 + sr, sK1a, sK1b, t_); *reinterpret_cast<bf16x8*>(K_lds + (b) * SHM_K + kst1) = t_; \
        ATT_CV((kp0) + sr, sV0a, sV0b, t_); *reinterpret_cast<bf16x8*>(V_lds + (b) * SHM_V + vst0) = t_; \
        ATT_CV((kp0) + 32 + sr, sV1a, sV1b, t_); *reinterpret_cast<bf16x8*>(V_lds + (b) * SHM_V + vst1) = t_; } while (0)
    sK0b = sK1b = sV0b = sV1b = (f32x4){0.f, 0.f, 0.f, 0.f};
    ATT_SLOAD(it.kp_first); ATT_SWRITE(0, it.kp_first);
    __syncthreads();
    for (int j = 0; j < nt; ++j) {
        const int kp0 = it.kp_first + j * it.kp_step, kpn = kp0 + it.kp_step, cur = j & 1;
        const bool more = (j + 1 < nt);
        if (more) ATT_SLOAD(kpn);
        bool active = wave_rows;
        if (it.rule == 1) active = active && (kp0 <= it.qpos0 + 32 * wid + 30) && !wdone;
        if (it.rule == 2) { const int ct = kp0 >> 6, cw = (it.qpos0 + 32 * wid) >> 6; active = active && (ct >= cw - 8) && (ct <= cw); }
        if (active) ATT_TILE(K_lds + cur * SHM_K, vb0 + cur * SHM_V);
        if (MODE == 0 && SB_EARLY_EXIT) {
            if (wave_rows && !wdone) { const bool rowdone = (carry < SB_DONE_LOG2) || (32 * wid + r32 >= it.nq); wdone = __all(rowdone); }
            if (lane == 0) flags[cur * 8 + wid] = wdone ? 1 : 0;
        }
        if (more) ATT_SWRITE(cur ^ 1, kpn);
        __syncthreads();
        if (MODE == 0 && SB_EARLY_EXIT) {
            int alld = 1;
#pragma unroll
            for (int w = 0; w < 8; ++w) alld &= flags[cur * 8 + w];
            if (alld) break;
        }
    }
#undef ATT_LD
#undef ATT_CV
#undef ATT_SLOAD
#undef ATT_SWRITE
    }
    if (wave_rows && (32 * wid + r32) < it.nq) {
        const float inv = (MODE == 1) ? __builtin_amdgcn_rcpf(l_reg) : 1.0f;
        const size_t row = (size_t)(32 * wid + r32);
        GA u16* orow = it.O + row * it.ldo + 4 * hi; const GA u16* grow = it.G + row * it.ldg + 4 * hi;
        u32x2 gv[16];
#pragma unroll
        for (int i = 0; i < 16; ++i) gv[i] = *reinterpret_cast<const GA u32x2*>(grow + 32 * (i >> 2) + 8 * (i & 3));
#pragma unroll
        for (int d0 = 0; d0 < 4; ++d0)
#pragma unroll
            for (int g = 0; g < 4; ++g) { const u32x2 gq = gv[4 * d0 + g];
                const float g0 = __uint_as_float(gq.x << 16), g1 = __uint_as_float(gq.x & 0xffff0000u), g2 = __uint_as_float(gq.y << 16), g3 = __uint_as_float(gq.y & 0xffff0000u);
                u32x2 w; w.x = cvtpk(o[d0][4 * g] * inv * g0, o[d0][4 * g + 1] * inv * g1); w.y = cvtpk(o[d0][4 * g + 2] * inv * g2, o[d0][4 * g + 3] * inv * g3);
                *reinterpret_cast<GA u32x2*>(orow + 32 * d0 + 8 * g) = w; }
    }
    __syncthreads();
}
#undef ATT_TILE
#undef ATT_ITEM_LOADS
#undef GA
}

constexpr int NWAVES = 8;
constexpr int N_LAUNCHES = MK_N_LAUNCHES;
constexpr int PER_PHASE = 6;

constexpr size_t al256(size_t x) { return (x + 255) & ~(size_t)255; }
constexpr size_t WS_CTL = 0, CTL_ZERO_BYTES = 65536, CTL_BYTES = 1u << 20;
constexpr size_t WS_WCAT = CTL_BYTES;
constexpr size_t WS_WUP  = WS_WCAT + (size_t)NCAT * DM * 2;
constexpr size_t WS_WOUT = WS_WUP + (size_t)DM * DM * 2;
constexpr size_t WS_ACAT = WS_WOUT + (size_t)DM * DM * 2;
constexpr size_t SZ768 = (size_t)MIN_ * 768 * 2, SZ512 = (size_t)MIN_ * 512 * 2;
constexpr size_t WS_QSB = WS_ACAT + (size_t)MA * DM * 2, WS_KSB = WS_QSB + SZ768, WS_VSB = WS_KSB + SZ768, WS_GSB = WS_VSB + SZ768;
constexpr size_t WS_QBD = WS_GSB + SZ768, WS_KBD = WS_QBD + SZ768, WS_VBD = WS_KBD + SZ768, WS_GBD = WS_VBD + SZ768;
constexpr size_t WS_QMM = WS_GBD + SZ768, WS_GMM = WS_QMM + SZ512;
constexpr size_t WS_MG  = WS_GMM + SZ512;
constexpr size_t WS_MK  = WS_MG + (size_t)MIN_ * 6144 * 2, WS_MV = WS_MK + (size_t)512 * 512 * 2;
constexpr size_t WS_AUP = WS_MV + (size_t)512 * 512 * 2;
constexpr size_t WS_SSQ = WS_AUP + (size_t)MIN_ * DM * 2;
constexpr size_t WS_SSQS = WS_SSQ + (size_t)MIN_ * 32 * 4;
constexpr size_t WS_XBUF = WS_SSQS + (size_t)MS * 128 * 4;
constexpr size_t WS_YB = WS_XBUF + (size_t)MP * 8 * 4;
constexpr size_t WS_KBC = WS_YB, WS_VBC = WS_KBC + (size_t)DB * 576 * 768 * 2, WS_MKC = WS_VBC + (size_t)DB * 576 * 768 * 2, WS_MVC = WS_MKC + (size_t)DB * NMEM * 512 * 2;
static_assert(WS_MVC + (size_t)DB * NMEM * 512 * 2 <= WS_YB + (size_t)MP * DM * 2, "decode caches inside the YB region");
constexpr size_t WS_END = WS_YB + (size_t)MP * DM * 2;
static_assert(WS_WCAT % 256 == 0 && WS_QSB % 256 == 0 && WS_MG % 256 == 0 && WS_AUP % 256 == 0 && WS_SSQ % 256 == 0, "alignment");
constexpr int CW_TMO = 0, CW_WORK = 64, CW_BAR = 4096, CW_PANEL = 8192;
constexpr int OUT_ELEMS = 32112640;

constexpr int RING_BYTES = 131072, LDSCTL_OFF = RING_BYTES, MISC_OFF = LDSCTL_OFF + 320, LDS_BYTES = 147456;
static_assert(att::ATT_LDS <= RING_BYTES, "attention scratch inside the ring region");

#define GAS __attribute__((address_space(1)))
#define LAS __attribute__((address_space(3)))
typedef unsigned short bf16;
typedef unsigned v4u __attribute__((ext_vector_type(4)));
typedef float f32x4 __attribute__((ext_vector_type(4)));
typedef GAS unsigned gu32;
#define RLX_AGENT __ATOMIC_RELAXED, __HIP_MEMORY_SCOPE_AGENT
#define LDS_WAIT() asm volatile("s_waitcnt lgkmcnt(0)" ::: "memory")
__device__ __forceinline__ unsigned pk2(float lo, float hi) { return pg8::cvt_pk_bf16(lo, hi); }

#define XB_TMO      128
#define XB_XCNT(j)  (256  + 64 * (j))
#define XB_XSUB(j)  (1280 + 64 * (j))
#define XB_XGEN(j)  (2304 + 64 * (j))
#define XB_TOP      3328
#define XB_TOPGEN   3392
#define XCD_BAR_WORDS 3456
#define XB_SPIN_CAP (1u << 18)
__device__ __forceinline__ unsigned xb_ld(unsigned* p)              { return __hip_atomic_load(p, __ATOMIC_RELAXED, __HIP_MEMORY_SCOPE_AGENT); }
__device__ __forceinline__ unsigned xb_add(unsigned* p, unsigned v) { return __hip_atomic_fetch_add(p, v, __ATOMIC_RELAXED, __HIP_MEMORY_SCOPE_AGENT); }
__device__ __forceinline__ unsigned xb_xcc_id() { return (unsigned)__builtin_amdgcn_s_getreg((3 << 11) | 20) & 0xFu; }
#define XB_SPIN(cond, bar) do { unsigned _sp = 0; while (cond) { __builtin_amdgcn_s_sleep(1); \
    if ((++_sp & 255u) == 0u) { if (xb_ld(&(bar)[XB_TMO])) break; if (_sp > XB_SPIN_CAP) { atomicAdd(&(bar)[XB_TMO], 1u); break; } } } } while (0)
struct XcdBarrier { unsigned* bar; unsigned x; volatile LAS unsigned* st; };
__device__ __forceinline__ XcdBarrier xcd_barrier_post(unsigned* bar, volatile LAS unsigned* st) {
    XcdBarrier b; b.bar = bar; b.x = xb_xcc_id(); b.st = st;
    if (threadIdx.x == 0) (void)xb_add(&bar[XB_XCNT(b.x)], 1u);
    return b;
}
__device__ __forceinline__ void xcd_barrier_complete(unsigned* bar, unsigned x, unsigned& nloc, unsigned& nx) {
    const unsigned G = gridDim.x * gridDim.y * gridDim.z;
    unsigned sum, cnt, mine, sp = 0u;
    for (;;) {
        sum = 0u; cnt = 0u; mine = 0u;
#pragma unroll
        for (unsigned j = 0; j < 16; ++j) { const unsigned c = xb_ld(&bar[XB_XCNT(j)]); sum += c; cnt += (c > 0u) ? 1u : 0u; mine = (j == x) ? c : mine; }
        if (sum == G) break;
        __builtin_amdgcn_s_sleep(1);
        if ((++sp & 255u) == 0u) { if (xb_ld(&bar[XB_TMO])) break; if (sp > XB_SPIN_CAP) { atomicAdd(&bar[XB_TMO], 1u); break; } }
    }
    nloc = mine > 0u ? mine : 1u; nx = cnt > 0u ? cnt : 1u;
}
__device__ __forceinline__ void xcd_barrier(const XcdBarrier& b) {
    asm volatile("s_waitcnt vmcnt(0)" ::: "memory");
    __syncthreads();
    if (threadIdx.x == 0) {
        unsigned* bar = b.bar;
        __builtin_amdgcn_s_waitcnt(0);
        unsigned nloc = b.st[0], nx = b.st[1];
        if (nloc == 0u) { xcd_barrier_complete(bar, b.x, nloc, nx); b.st[0] = nloc; b.st[1] = nx; }
        const unsigned old = xb_add(&bar[XB_XSUB(b.x)], 1u);
        const unsigned gen = old / nloc;
        if (old + 1u == (gen + 1u) * nloc) {
            __builtin_amdgcn_fence(__ATOMIC_RELEASE, "agent");
            asm volatile("s_waitcnt vmcnt(0)" ::: "memory");
            const unsigned og = xb_add(&bar[XB_TOP], 1u);
            const unsigned tg = og / nx;
            if (og + 1u == (tg + 1u) * nx) xb_add(&bar[XB_TOPGEN], 1u);
            else XB_SPIN(xb_ld(&bar[XB_TOPGEN]) == tg, bar);
            __builtin_amdgcn_fence(__ATOMIC_ACQUIRE, "agent");
            xb_add(&bar[XB_XGEN(b.x)], 1u);
            asm volatile("s_waitcnt vmcnt(0)" ::: "memory");
        } else {
            XB_SPIN(xb_ld(&bar[XB_XGEN(b.x)]) == gen, bar);
            __builtin_amdgcn_fence(__ATOMIC_ACQUIRE, "agent");
            asm volatile("s_waitcnt vmcnt(0)" ::: "memory");
        }
    }
    __syncthreads();
}

struct Frame {
    LAS unsigned char* lds;
    volatile LAS unsigned* MISC;
    gu32* ctl;
    int vcu, G;
    const float *x_prompt, *x_sample, *c_sbk, *c_sbv, *c_bdk, *c_bdv, *c_mk, *c_mv, *mem_prompt, *g_pre, *w_in, *rel_bias, *g_mem, *w_mem_kv, *w_up_sb, *w_up_band, *w_up_mem, *w_out, *g_post;
    float* out;
    bf16 *WCAT, *WUP, *WOUT, *ACAT, *QSB, *KSB, *VSB, *GSB, *QBD, *KBD, *VBD, *GBD, *QMM, *GMM, *MG, *MK, *MV, *AUP, *MERGED;
    float* SSQ; float* SSQS; bf16* YB; bf16 *KBC, *VBC, *MKC, *MVC;
};

__device__ __forceinline__ int fresh_tid() { int t = threadIdx.x; asm volatile("" : "+v"(t)); return t; }
__device__ __forceinline__ float wave_sum(float v) {
#pragma unroll
    for (int o = 1; o < 64; o <<= 1) v += __shfl_xor(v, o);
    return v;
}
__device__ __forceinline__ void p0_transpose_item(const float* W, int N, bf16* WT, int ldt, int row_off, int col_off, LAS float* scr, int item, int lane) {
    const int nblk = N / 32, kb = item / nblk, nb = item % nblk, k0 = 64 * kb, n0 = 32 * nb;
    f32x4 wv[8];
#pragma unroll
    for (int i = 0; i < 8; ++i) wv[i] = *(const GAS f32x4*)(W + (size_t)(k0 + (lane >> 3) + 8 * i) * N + n0 + 4 * (lane & 7));
#pragma unroll
    for (int i = 0; i < 8; ++i) { LAS float* d = scr + ((lane >> 3) + 8 * i) * 33 + 4 * (lane & 7); d[0] = wv[i].x; d[1] = wv[i].y; d[2] = wv[i].z; d[3] = wv[i].w; }
    LDS_WAIT(); asm volatile("" ::: "memory");
    const int c = lane & 7;
#pragma unroll
    for (int j = 0; j < 4; ++j) { const int n = (lane >> 3) + 8 * j; const LAS float* s = scr + (8 * c) * 33 + n;
        v4u o; o.x = pk2(s[0 * 33], s[1 * 33]); o.y = pk2(s[2 * 33], s[3 * 33]); o.z = pk2(s[4 * 33], s[5 * 33]); o.w = pk2(s[6 * 33], s[7 * 33]);
        *(GAS v4u*)(WT + (size_t)(row_off + n0 + n) * ldt + col_off + k0 + 8 * c) = o; }
    LDS_WAIT(); asm volatile("" ::: "memory");
}
__device__ __forceinline__ void rms_row_to_bf16(const float* xrow, const float* g, bf16* orow, int lane) {
    const GAS f32x4* xr = (const GAS f32x4*)xrow + lane; const GAS f32x4* gr = (const GAS f32x4*)g + lane;
    f32x4 v[8]; float s = 0.f;
#pragma unroll
    for (int j = 0; j < 8; ++j) { v[j] = xr[64 * j]; s += (v[j].x * v[j].x + v[j].y * v[j].y) + (v[j].z * v[j].z + v[j].w * v[j].w); }
    const float r = 1.0f / sqrtf(wave_sum(s) * (1.0f / DM) + RMS_EPS);
    GAS unsigned long long* o8 = (GAS unsigned long long*)orow + lane;
#pragma unroll
    for (int j = 0; j < 8; ++j) { const f32x4 gv = gr[64 * j];
        o8[64 * j] = (unsigned long long)pk2(v[j].x * r * gv.x, v[j].y * r * gv.y) | ((unsigned long long)pk2(v[j].z * r * gv.z, v[j].w * r * gv.w) << 32); }
}
__device__ __forceinline__ void p0_t_load(const float* W, int N, int item, int lane, f32x4 (&wv)[8]) {
    const int nblk = N / 32, kb = item / nblk, nb = item % nblk, k0 = 64 * kb, n0 = 32 * nb;
#pragma unroll
    for (int i = 0; i < 8; ++i) wv[i] = *(const GAS f32x4*)(W + (size_t)(k0 + (lane >> 3) + 8 * i) * N + n0 + 4 * (lane & 7));
}
__device__ __forceinline__ int wcat_row(int c) {
    int kind, idx;
    if (c >= 7168) { const int d = c - 7168; kind = d >> 11; idx = d & 2047; }
    else { const int p = c >> 8;
        if (p < 9) return c;
        if (p < 12) { kind = 3; idx = c - 2304; }
        else if (p < 21) return c - 768;
        else if (p < 24) { kind = 3; idx = 768 + (c - 5376); }
        else if (p < 26) return c - 1536;
        else { kind = 3; idx = 1536 + (c - 6656); } }
    const int t = idx >> 6, q = idx & 63;
    return (20 + t) * 256 + 128 * (kind >> 1) + 4 * (kind & 1) + 32 * (q >> 4) + 8 * ((q >> 2) & 3) + (q & 3);
}
template <bool MAP>
__device__ __forceinline__ void p0_t_finish(const f32x4 (&wv)[8], int N, bf16* WT, int ldt, int row_off, int col_off, LAS float* scr, int item, int lane) {
    const int nblk = N / 32, kb = item / nblk, nb = item % nblk, k0 = 64 * kb, n0 = 32 * nb;
#pragma unroll
    for (int i = 0; i < 8; ++i) { LAS float* d = scr + ((lane >> 3) + 8 * i) * 33 + 4 * (lane & 7); d[0] = wv[i].x; d[1] = wv[i].y; d[2] = wv[i].z; d[3] = wv[i].w; }
    LDS_WAIT(); asm volatile("" ::: "memory");
    const int c = lane & 7;
#pragma unroll
    for (int j = 0; j < 4; ++j) { const int n = (lane >> 3) + 8 * j; const LAS float* s = scr + (8 * c) * 33 + n;
        v4u o; o.x = pk2(s[0 * 33], s[1 * 33]); o.y = pk2(s[2 * 33], s[3 * 33]); o.z = pk2(s[4 * 33], s[5 * 33]); o.w = pk2(s[6 * 33], s[7 * 33]);
        *(GAS v4u*)(WT + (size_t)(MAP ? wcat_row(n0 + n) : row_off + n0 + n) * ldt + col_off + k0 + 8 * c) = o; }
    LDS_WAIT(); asm volatile("" ::: "memory");
}
__device__ __forceinline__ void rms_load(const float* xrow, int lane, f32x4 (&v)[8]) {
    const GAS f32x4* xr = (const GAS f32x4*)xrow + lane;
#pragma unroll
    for (int j = 0; j < 8; ++j) v[j] = xr[64 * j];
}
__device__ __forceinline__ void rms_finish(const f32x4 (&v)[8], const f32x4 (&gv)[8], bf16* orow, int lane) {
    float s = 0.f;
#pragma unroll
    for (int j = 0; j < 8; ++j) s += (v[j].x * v[j].x + v[j].y * v[j].y) + (v[j].z * v[j].z + v[j].w * v[j].w);
    const float r = 1.0f / sqrtf(wave_sum(s) * (1.0f / DM) + RMS_EPS);
    GAS unsigned long long* o8 = (GAS unsigned long long*)orow + lane;
#pragma unroll
    for (int j = 0; j < 8; ++j) o8[64 * j] = (unsigned long long)pk2(v[j].x * r * gv[j].x, v[j].y * r * gv[j].y) | ((unsigned long long)pk2(v[j].z * r * gv[j].z, v[j].w * r * gv[j].w) << 32);
}
__device__ __forceinline__ void p0_prologue(Frame& F) {
    const int tid_ = fresh_tid(), lane_ = tid_ & 63, wave_ = __builtin_amdgcn_readfirstlane(tid_ >> 6);
    LAS float* scr = (LAS float*)(F.lds + wave_ * 16384);
    const int gw = F.vcu * NWAVES + wave_, NGW = F.G * NWAVES;
    constexpr int I_IN = 32 * (INW / 32), I_MEM = 32 * (1024 / 32), I_USB = 12 * 64, I_UBD = 12 * 64, I_UMM = 8 * 64, I_OUT = 32 * 64;
    constexpr int NI = I_IN + I_MEM;
#define P0_TLOAD(buf, it_) do { if ((it_) < I_IN) p0_t_load(F.w_in, INW, (it_), lane_, buf); else p0_t_load(F.w_mem_kv, 1024, (it_) - I_IN, lane_, buf); } while (0)
#define P0_TFIN(buf, it_) do { if ((it_) < I_IN) p0_t_finish<true>(buf, INW, F.WCAT, DM, 0, 0, scr, (it_), lane_); else p0_t_finish<false>(buf, 1024, F.WCAT, DM, INW, 0, scr, (it_) - I_IN, lane_); } while (0)
    { f32x4 wa[8], wb[8]; int it = gw;
      if (it < NI) P0_TLOAD(wa, it);
      while (it < NI) {
          int it2 = it + NGW; if (it2 < NI) P0_TLOAD(wb, it2);
          P0_TFIN(wa, it); it = it2; if (it >= NI) break;
          it2 = it + NGW; if (it2 < NI) P0_TLOAD(wa, it2);
          P0_TFIN(wb, it); it = it2; } }
#undef P0_TLOAD
#undef P0_TFIN
    if (!LATE_WT) for (int it = gw; it < I_USB + I_UBD + I_UMM + I_OUT; it += NGW) {
        int r = it;
        if (r < I_USB) { p0_transpose_item(F.w_up_sb, DM, F.WUP, DM, 0, 0, scr, r, lane_); continue; } r -= I_USB;
        if (r < I_UBD) { p0_transpose_item(F.w_up_band, DM, F.WUP, DM, 0, 768, scr, r, lane_); continue; } r -= I_UBD;
        if (r < I_UMM) { p0_transpose_item(F.w_up_mem, DM, F.WUP, DM, 0, 1536, scr, r, lane_); continue; } r -= I_UMM;
        p0_transpose_item(F.w_out, DM, F.WOUT, DM, 0, 0, scr, r, lane_);
    }
    { f32x4 gv[8], va[8], vb[8]; const GAS f32x4* gr = (const GAS f32x4*)F.g_pre + lane_;
#pragma unroll
      for (int j = 0; j < 8; ++j) gv[j] = gr[64 * j];
      int m = gw;
      if (m < MP) rms_load(F.x_prompt + (size_t)m * DM, lane_, va);
      while (m < MP) {
          int m2 = m + NGW; if (m2 < MP) rms_load(F.x_prompt + (size_t)m2 * DM, lane_, vb);
          rms_finish(va, gv, F.ACAT + (size_t)m * DM, lane_); m = m2; if (m >= MP) break;
          m2 = m + NGW; if (m2 < MP) rms_load(F.x_prompt + (size_t)m2 * DM, lane_, va);
          rms_finish(vb, gv, F.ACAT + (size_t)m * DM, lane_); m = m2; } }
    for (int m = MP + gw; m < MA; m += NGW) {
        bf16* orow = F.ACAT + (size_t)m * DM;
        if (m < MREAL) rms_row_to_bf16(F.x_sample + (size_t)(m - MP) * DM, F.g_pre, orow, lane_);
        else if (m < MIN_) {
            GAS v4u* o = (GAS v4u*)orow + lane_; GAS v4u* o2 = (GAS v4u*)(F.AUP + (size_t)m * DM) + lane_;
#pragma unroll
            for (int j = 0; j < 4; ++j) { o[64 * j] = (v4u){0u, 0u, 0u, 0u}; o2[64 * j] = (v4u){0u, 0u, 0u, 0u}; }
        }
        else rms_row_to_bf16(F.mem_prompt + (size_t)(m - MMEM0) * DM, F.g_mem, orow, lane_);
    }
}
constexpr int LATE_ITEMS = 128;
__device__ __forceinline__ void late_transpose_item(Frame& F, int j) {
    const int tid_ = fresh_tid(), lane_ = tid_ & 63, wave_ = __builtin_amdgcn_readfirstlane(tid_ >> 6);
    LAS float* scr = (LAS float*)(F.lds + wave_ * 16384);
    constexpr int I_USB = 12 * 64, I_UBD = 12 * 64, I_UMM = 8 * 64;
#pragma unroll 1
    for (int q = 0; q < 4; ++q) {
        int r = (j * 8 + wave_) * 4 + q;
        if (r < I_USB) { p0_transpose_item(F.w_up_sb, DM, F.WUP, DM, 0, 0, scr, r, lane_); continue; } r -= I_USB;
        if (r < I_UBD) { p0_transpose_item(F.w_up_band, DM, F.WUP, DM, 0, 768, scr, r, lane_); continue; } r -= I_UBD;
        if (r < I_UMM) { p0_transpose_item(F.w_up_mem, DM, F.WUP, DM, 0, 1536, scr, r, lane_); continue; } r -= I_UMM;
        p0_transpose_item(F.w_out, DM, F.WOUT, DM, 0, 0, scr, r, lane_);
    }
}
constexpr int CV_BD = DB * 576 * 768 / 32768, CV_MM = DB * NMEM * 512 / 32768, SLACK_ITEMS = LATE_ITEMS + 2 * CV_BD + 2 * CV_MM;
static_assert(DB * 576 * 768 % 32768 == 0 && DB * NMEM * 512 % 32768 == 0, "conversion item size");
template <bool BAND>
__device__ __forceinline__ void slack_convert(const float* src, bf16* dst, int jj, int tid_) {
    constexpr int ld = BAND ? 768 : 512, rows_d = BAND ? 576 : NMEM, rows_s = BAND ? 512 : NMEM;
    f32x4 va[8], vb[8];
#pragma unroll
    for (int it = 0; it < 8; ++it) { const int e = (jj * 4096 + it * 512 + tid_) * 8;
        const int col = e % ld, rowd = e / ld, b = rowd / rows_d, row = rowd % rows_d;
        const float* s = src + ((size_t)(b * rows_s + (row < rows_s ? row : 0)) * ld + col);
        va[it] = *(const GAS f32x4*)s; vb[it] = *(const GAS f32x4*)(s + 4); }
#pragma unroll
    for (int it = 0; it < 8; ++it) { const int e = (jj * 4096 + it * 512 + tid_) * 8; const int row = (e / ld) % rows_d;
        v4u w; w.x = pk2(va[it].x, va[it].y); w.y = pk2(va[it].z, va[it].w); w.z = pk2(vb[it].x, vb[it].y); w.w = pk2(vb[it].z, vb[it].w);
        if (row >= rows_s + DS) w = (v4u){0u, 0u, 0u, 0u};
        if (row < rows_s || row >= rows_s + DS) *(GAS v4u*)(dst + e) = w; }
}
__device__ __forceinline__ void slack_item(Frame& F, int j) {
    if (j < LATE_ITEMS) { late_transpose_item(F, j); return; }
    j -= LATE_ITEMS;
    const int tid_ = fresh_tid();
    if (j < CV_BD) slack_convert<true>(F.c_bdk, F.KBC, j, tid_);
    else if (j < 2 * CV_BD) slack_convert<true>(F.c_bdv, F.VBC, j - CV_BD, tid_);
    else if (j < 2 * CV_BD + CV_MM) slack_convert<false>(F.c_mk, F.MKC, j - 2 * CV_BD, tid_);
    else slack_convert<false>(F.c_mv, F.MVC, j - 2 * CV_BD - CV_MM, tid_);
}
struct P5Row { float sq; unsigned long long yb[8]; f32x4 xv[8]; };
__device__ __forceinline__ void p5_load(Frame& F, int m, int lane, float& sq, unsigned long long (&yb)[8], f32x4 (&xv)[8]) {
    sq = (lane < 32) ? F.SSQ[(size_t)m * 32 + lane] : 0.f;
    const GAS unsigned long long* yb8 = (const GAS unsigned long long*)(F.YB + (size_t)m * DM) + lane; const GAS f32x4* x4 = (const GAS f32x4*)(F.x_prompt + (size_t)m * DM) + lane;
#pragma unroll
    for (int j = 0; j < 8; ++j) { yb[j] = yb8[64 * j]; xv[j] = x4[64 * j]; }
}
__device__ __forceinline__ void p5_finish(Frame& F, int m, int lane, float sq, const unsigned long long (&yb)[8], const f32x4 (&xv)[8], const f32x4 (&gv)[8]) {
    const float r = 1.0f / sqrtf(wave_sum(sq) * (1.0f / DM) + RMS_EPS);
    GAS f32x4* y4 = (GAS f32x4*)(F.out + (size_t)m * DM) + lane;
#pragma unroll
    for (int j = 0; j < 8; ++j) { const unsigned long long yq = yb[j];
        const f32x4 yv = {__uint_as_float((unsigned)yq << 16), __uint_as_float((unsigned)yq & 0xffff0000u), __uint_as_float((unsigned)(yq >> 32) << 16), __uint_as_float((unsigned)(yq >> 32) & 0xffff0000u)};
        __builtin_nontemporal_store(xv[j] + yv * r * gv[j], &y4[64 * j]); }
}
__device__ __forceinline__ void p5_final(Frame& F) {
    const int tid_ = fresh_tid(), lane_ = tid_ & 63, wave_ = __builtin_amdgcn_readfirstlane(tid_ >> 6);
    const int gw = F.vcu * NWAVES + wave_, NGW = F.G * NWAVES;
    f32x4 gv[8]; { const GAS f32x4* g4 = (const GAS f32x4*)F.g_post + lane_;
#pragma unroll
        for (int j = 0; j < 8; ++j) gv[j] = g4[64 * j]; }
    if (!FUSE_RMS) {
        float sa, sb; unsigned long long ya[8], yb[8]; f32x4 xa[8], xb[8]; int m = gw;
        if (m < MP) p5_load(F, m, lane_, sa, ya, xa);
        while (m < MP) {
            int m2 = m + NGW; if (m2 < MP) p5_load(F, m2, lane_, sb, yb, xb);
            p5_finish(F, m, lane_, sa, ya, xa, gv); m = m2; if (m >= MP) break;
            m2 = m + NGW; if (m2 < MP) p5_load(F, m2, lane_, sa, ya, xa);
            p5_finish(F, m, lane_, sb, yb, xb, gv); m = m2; }
    }
    for (int m = MP + gw; m < MREAL; m += NGW) {
        float s = F.SSQS[(size_t)(m - MP) * 128 + lane_] + F.SSQS[(size_t)(m - MP) * 128 + 64 + lane_];
        s = wave_sum(s);
        const float r = 1.0f / sqrtf(s * (1.0f / DM) + RMS_EPS);
        GAS f32x4* y4 = (GAS f32x4*)(F.out + (size_t)16777216 + (size_t)(m - MP) * DM) + lane_; const GAS f32x4* x4 = (const GAS f32x4*)(F.x_sample + (size_t)(m - MP) * DM) + lane_;
#pragma unroll
        for (int j = 0; j < 8; ++j) { const f32x4 yv = y4[64 * j], xv = x4[64 * j]; y4[64 * j] = xv + yv * r * gv[j]; }
    }
}

constexpr int IT_BDP = 192, IT_BDS = 48, IT_SBP = 192, IT_SBS = 48, IT_MMP = 128, IT_MMS = 32;
constexpr int IT_TOTAL = IT_BDP + IT_BDS + IT_SBP + IT_SBS + IT_MMP + IT_MMS;
struct ArgsK { const void* in[19]; float* out; unsigned char* ws; int ph_lo, ph_hi; };
struct ItemSrc {
    const ArgsK* ka; unsigned char* ws;
    __device__ __forceinline__ GAS bf16* W(size_t off) const { return (GAS bf16*)(ws + off); }
    __device__ __forceinline__ const GAS float* I(int k) const { return (const GAS float*)ka->in[k]; }
};
__device__ __forceinline__ att::Item make_item(const ItemSrc& S, int idx) {
    GAS bf16* const QSB = S.W(WS_QSB); GAS bf16* const KSB = S.W(WS_KSB); GAS bf16* const VSB = S.W(WS_VSB); GAS bf16* const GSB = S.W(WS_GSB);
    GAS bf16* const QBD = S.W(WS_QBD); GAS bf16* const KBD = S.W(WS_KBD); GAS bf16* const VBD = S.W(WS_VBD); GAS bf16* const GBD = S.W(WS_GBD);
    GAS bf16* const QMM = S.W(WS_QMM); GAS bf16* const GMM = S.W(WS_GMM); GAS bf16* const MK = S.W(WS_MK); GAS bf16* const MV = S.W(WS_MV); GAS bf16* const AUP = S.W(WS_AUP);
    att::Item it; it.dma = 0; it.bias = nullptr; it.kf = nullptr; it.vf = nullptr; it.ldf = 0; it.pf_lo = 0; it.pf_hi = 0; it.kb = nullptr; it.vb = nullptr; it.ldb = 0; it.pb_lo = 0; it.pb_hi = 0;
    if (idx < 48) idx += 192; else if (idx < 96) idx += 432 - 48; else if (idx < 128) idx += 608 - 96; else if (idx < 320) idx -= 128; else if (idx < 512) idx += 240 - 320; else idx += 480 - 512;
    if (idx < IT_BDP) {
        const int b = idx / 96, h = (idx / 16) % 6, cg = idx % 16; const size_t row0 = (size_t)b * SEQ + 256 * cg;
        it.mode = 1; it.rule = 2; it.Q = QBD + row0 * 768 + h * HD; it.ldq = 768; it.nq = 256; it.qpos0 = 256 * cg;
        it.kb = KBD + (size_t)b * SEQ * 768 + h * HD; it.vb = VBD + (size_t)b * SEQ * 768 + h * HD; it.ldb = 768; it.pb_lo = 0; it.pb_hi = SEQ;
        it.pv_lo = 0; it.pv_hi = SEQ; const int c_lo = (4 * cg - 8) > 0 ? (4 * cg - 8) : 0;
        it.kp_first = 64 * c_lo; it.kp_step = 64; it.ntiles = 4 * cg + 4 - c_lo; it.bias = S.I(11) + h * 513; it.dma = 1;
        it.O = AUP + row0 * DM + 768 + h * HD; it.ldo = DM; it.G = GBD + row0 * 768 + h * HD; it.ldg = 768; return it; }
    idx -= IT_BDP;
    if (idx < IT_BDS) {
        const int b = idx / 6, h = idx % 6; const size_t row0 = (size_t)MP + b * DS;
        it.mode = 1; it.rule = 0; it.Q = QBD + row0 * 768 + h * HD; it.ldq = 768; it.nq = DS; it.qpos0 = PAST;
        if (SLACK_P1) {
            it.kb = S.W(WS_KBC) + (size_t)b * 576 * 768 + h * HD; it.vb = S.W(WS_VBC) + (size_t)b * 576 * 768 + h * HD; it.ldb = 768; it.pb_lo = PAST - 512; it.pb_hi = PAST - 512 + 576; it.dma = 1;
        } else {
            it.kb = KBD + row0 * 768 + h * HD; it.vb = VBD + row0 * 768 + h * HD; it.ldb = 768; it.pb_lo = PAST; it.pb_hi = PAST + DS;
            it.kf = S.I(4) + (size_t)b * 512 * 768 + h * HD; it.vf = S.I(5) + (size_t)b * 512 * 768 + h * HD; it.ldf = 768; it.pf_lo = PAST - 512; it.pf_hi = PAST; }
        it.pv_lo = PAST - 512; it.pv_hi = PAST + DS; it.kp_first = PAST - 512; it.kp_step = 64; it.ntiles = 9; it.bias = S.I(11) + h * 513;
        it.O = AUP + row0 * DM + 768 + h * HD; it.ldo = DM; it.G = GBD + row0 * 768 + h * HD; it.ldg = 768; return it; }
    idx -= IT_BDS;
    if (idx < IT_SBP) {
        const int b = idx % 2, h = (idx / 2) % 6, qb = 15 - idx / 12; const size_t row0 = (size_t)b * SEQ + 256 * qb;
        it.mode = 0; it.rule = 1; it.Q = QSB + row0 * 768 + h * HD; it.ldq = 768; it.nq = 256; it.qpos0 = 256 * qb;
        it.kb = KSB + (size_t)b * SEQ * 768 + h * HD; it.vb = VSB + (size_t)b * SEQ * 768 + h * HD; it.ldb = 768; it.pb_lo = 0; it.pb_hi = SEQ;
        it.pv_lo = 0; it.pv_hi = SEQ; it.kp_first = 64 * (4 * qb + 3); it.kp_step = -64; it.ntiles = 4 * qb + 4; it.dma = 1;
        it.O = AUP + row0 * DM + h * HD; it.ldo = DM; it.G = GSB + row0 * 768 + h * HD; it.ldg = 768; return it; }
    idx -= IT_SBP;
    if (idx < IT_SBS) {
        const int b = idx / 6, h = idx % 6; const size_t row0 = (size_t)MP + b * DS;
        it.mode = 0; it.rule = 1; it.Q = QSB + row0 * 768 + h * HD; it.ldq = 768; it.nq = DS; it.qpos0 = PAST;
        it.kb = KSB + row0 * 768 + h * HD; it.vb = VSB + row0 * 768 + h * HD; it.ldb = 768; it.pb_lo = PAST; it.pb_hi = PAST + DS;
        it.kf = S.I(2) + (size_t)b * PAST * 768 + h * HD; it.vf = S.I(3) + (size_t)b * PAST * 768 + h * HD; it.ldf = 768; it.pf_lo = 0; it.pf_hi = PAST;
        it.pv_lo = 0; it.pv_hi = PAST + DS; it.kp_first = PAST + DS - 64; it.kp_step = -64; it.ntiles = (PAST + DS + 63) / 64;
        it.O = AUP + row0 * DM + h * HD; it.ldo = DM; it.G = GSB + row0 * 768 + h * HD; it.ldg = 768; return it; }
    idx -= IT_SBS;
    if (idx < IT_MMP) {
        const int b = idx / 64, h = (idx / 16) % 4, qb = idx % 16; const size_t row0 = (size_t)b * SEQ + 256 * qb;
        it.mode = 1; it.rule = 0; it.Q = QMM + row0 * 512 + h * HD; it.ldq = 512; it.nq = 256; it.qpos0 = 0;
        it.kb = MK + (size_t)b * NMEM * 512 + h * HD; it.vb = MV + (size_t)b * NMEM * 512 + h * HD; it.ldb = 512; it.pb_lo = 0; it.pb_hi = NMEM;
        it.pv_lo = 0; it.pv_hi = NMEM; it.kp_first = 0; it.kp_step = 64; it.ntiles = 4; it.dma = 1;
        it.O = AUP + row0 * DM + 1536 + h * HD; it.ldo = DM; it.G = GMM + row0 * 512 + h * HD; it.ldg = 512; return it; }
    idx -= IT_MMP;
    {
        const int b = idx / 4, h = idx % 4; const size_t row0 = (size_t)MP + b * DS;
        it.mode = 1; it.rule = 0; it.Q = QMM + row0 * 512 + h * HD; it.ldq = 512; it.nq = DS; it.qpos0 = 0;
        if (SLACK_P1) { it.kb = S.W(WS_MKC) + (size_t)b * NMEM * 512 + h * HD; it.vb = S.W(WS_MVC) + (size_t)b * NMEM * 512 + h * HD; it.ldb = 512; it.pb_lo = 0; it.pb_hi = NMEM; it.dma = 1; }
        else { it.kf = S.I(6) + (size_t)b * NMEM * 512 + h * HD; it.vf = S.I(7) + (size_t)b * NMEM * 512 + h * HD; it.ldf = 512; it.pf_lo = 0; it.pf_hi = NMEM; }
        it.pv_lo = 0; it.pv_hi = NMEM; it.kp_first = 0; it.kp_step = 64; it.ntiles = 4;
        it.O = AUP + row0 * DM + 1536 + h * HD; it.ldo = DM; it.G = GMM + row0 * 512 + h * HD; it.ldg = 512; return it; }
}

struct Args { const void* in[19]; float* out; unsigned char* ws; int ph_lo, ph_hi; };
__global__ void __launch_bounds__(NWAVES * 64, 2) fwd_megakernel(Args args) {
    extern __shared__ __attribute__((aligned(16))) unsigned char lds[];
    Frame F;
    F.lds = (LAS unsigned char*)lds;
    F.MISC = (volatile LAS unsigned*)(F.lds + MISC_OFF);
    F.G = gridDim.x; { const int bx = blockIdx.x; F.vcu = (F.G % 8 == 0) ? (bx % 8) * (F.G / 8) + bx / 8 : bx; }
    unsigned char* ws = args.ws;
    F.ctl = (gu32*)(ws + WS_CTL);
    F.x_prompt = (const float*)args.in[0]; F.x_sample = (const float*)args.in[1]; F.c_sbk = (const float*)args.in[2]; F.c_sbv = (const float*)args.in[3];
    F.c_bdk = (const float*)args.in[4]; F.c_bdv = (const float*)args.in[5]; F.c_mk = (const float*)args.in[6]; F.c_mv = (const float*)args.in[7];
    F.mem_prompt = (const float*)args.in[8]; F.g_pre = (const float*)args.in[9]; F.w_in = (const float*)args.in[10]; F.rel_bias = (const float*)args.in[11];
    F.g_mem = (const float*)args.in[12]; F.w_mem_kv = (const float*)args.in[13]; F.w_up_sb = (const float*)args.in[14]; F.w_up_band = (const float*)args.in[15];
    F.w_up_mem = (const float*)args.in[16]; F.w_out = (const float*)args.in[17]; F.g_post = (const float*)args.in[18];
    F.out = args.out;
    F.WCAT = (bf16*)(ws + WS_WCAT); F.WUP = (bf16*)(ws + WS_WUP); F.WOUT = (bf16*)(ws + WS_WOUT); F.ACAT = (bf16*)(ws + WS_ACAT); F.MERGED = (bf16*)(ws + WS_ACAT);
    F.QSB = (bf16*)(ws + WS_QSB); F.KSB = (bf16*)(ws + WS_KSB); F.VSB = (bf16*)(ws + WS_VSB); F.GSB = (bf16*)(ws + WS_GSB);
    F.QBD = (bf16*)(ws + WS_QBD); F.KBD = (bf16*)(ws + WS_KBD); F.VBD = (bf16*)(ws + WS_VBD); F.GBD = (bf16*)(ws + WS_GBD);
    F.QMM = (bf16*)(ws + WS_QMM); F.GMM = (bf16*)(ws + WS_GMM); F.MG = (bf16*)(ws + WS_MG); F.MK = (bf16*)(ws + WS_MK); F.MV = (bf16*)(ws + WS_MV);
    F.AUP = (bf16*)(ws + WS_AUP); F.SSQ = (float*)(ws + WS_SSQ); F.SSQS = (float*)(ws + WS_SSQS); F.YB = (bf16*)(ws + WS_YB); F.KBC = (bf16*)(ws + WS_KBC); F.VBC = (bf16*)(ws + WS_VBC); F.MKC = (bf16*)(ws + WS_MKC); F.MVC = (bf16*)(ws + WS_MVC);
    for (int u = threadIdx.x; u < (LDS_BYTES - LDSCTL_OFF) / 4; u += NWAVES * 64) ((LAS unsigned*)(F.lds + LDSCTL_OFF))[u] = 0u;
    __syncthreads();
    XcdBarrier bar; bar.bar = (unsigned*)(F.ctl + CW_BAR); bar.x = 0; bar.st = nullptr;
    if (N_LAUNCHES != PER_PHASE) bar = xcd_barrier_post((unsigned*)(F.ctl + CW_BAR), F.MISC + 8);
#define GRID_BAR() do { if (N_LAUNCHES != PER_PHASE) xcd_barrier(bar); } while (0)
    const int lo = args.ph_lo, hi = args.ph_hi;
#ifdef ONLY_PHASE
#define IN(k) ((k) == ONLY_PHASE && lo <= (k) && (k) < hi)
#else
#define IN(k) (lo <= (k) && (k) < hi)
#endif
#define BOTH(k) (IN(k) && IN((k) + 1))
    if (IN(0)) { p0_prologue(F); if (BOTH(0)) GRID_BAR(); }
    if (IN(1)) {
        pg8::Gemm g{F.ACAT, F.WCAT, MA, NCAT, DM}; ep::InOrder S; S.init(F.G, (int)blockIdx.x);
        ep::EpiIn E{F.QSB, F.KSB, F.VSB, F.GSB, F.QBD, F.KBD, F.VBD, F.GBD, F.QMM, F.GMM, F.MG, F.MK, F.MV, F.out, F.KBC, F.VBC};
        {
        pg8::gemm_phase<ep::EpiIn, ep::InOrder, true, true>(F.lds, g, S, E);
        if (SLACK_P1) {
            volatile LAS int* sl = (volatile LAS int*)(F.MISC + 12);
            for (;;) {
                if (threadIdx.x == 0) *sl = (int)__hip_atomic_fetch_add((unsigned*)(F.ctl + CW_WORK + 64), 1u, RLX_AGENT);
                __syncthreads();
                const int j = __builtin_amdgcn_readfirstlane(*sl);
                __syncthreads();
                if (j >= SLACK_ITEMS) break;
                slack_item(F, j);
            }
        }
        if (BOTH(1)) GRID_BAR(); }
    }
    if (IN(2)) {
        volatile LAS int* slot = (volatile LAS int*)(F.lds + att::OFF_ITEM);
        for (;;) {
            if (threadIdx.x == 0) *slot = (int)__hip_atomic_fetch_add((unsigned*)(F.ctl + CW_WORK), 1u, RLX_AGENT);
            __syncthreads();
            const int idx = __builtin_amdgcn_readfirstlane(*slot);
            __syncthreads();
            if (idx >= IT_TOTAL + ((LATE_WT && !SLACK_P1) ? LATE_ITEMS : 0)) break;
            if (idx >= IT_TOTAL) { late_transpose_item(F, idx - IT_TOTAL); __syncthreads(); continue; }
            const ArgsK* ka = (const ArgsK*)__builtin_amdgcn_kernarg_segment_ptr(); unsigned char* wsl = args.ws;
            asm volatile("" : "+s"(ka), "+s"(wsl));
            const ItemSrc isrc{ka, wsl};
            const att::Item it = make_item(isrc, idx);
            if (it.dma) { if (it.mode == 0) att::run_item<0, true>(it, (char*)lds, F.lds); else att::run_item<1, true>(it, (char*)lds, F.lds); }
            else { if (it.mode == 0) att::run_item<0, false>(it, (char*)lds, F.lds); else att::run_item<1, false>(it, (char*)lds, F.lds); }
        }
        if (BOTH(2)) GRID_BAR();
    }
    if (IN(3)) {
        pg8::Gemm g{F.AUP, F.WUP, MIN_, DM, DM}; ep::MergeOrder S; S.init(F.G, (int)blockIdx.x);
        ep::EpiMerge E{F.MG, F.MERGED};
        {
        pg8::gemm_phase<ep::EpiMerge, ep::MergeOrder, true, true>(F.lds, g, S, E);
        for (int sl = F.vcu; sl < 256; sl += F.G) ep::skinny_phase<0>(F.AUP, F.WUP, F.MG, F.MERGED, nullptr, nullptr, sl, F.lds);
        if (BOTH(3)) GRID_BAR(); }
    }
    if (IN(4)) {
        pg8::Gemm g{F.MERGED, F.WOUT, MP, DM, DM}; pg8::StaticOrder S; S.init(MP, DM, F.G, (int)blockIdx.x);
#if FUSE_RMS
        ep::EpiOutFused E{F.x_prompt, F.out, F.g_post, (float*)(ws + WS_XBUF), (unsigned*)(F.ctl + CW_PANEL), (unsigned*)(F.ctl + CW_TMO)};
        {
        pg8::gemm_phase<ep::EpiOutFused, pg8::StaticOrder, false, true>(F.lds, g, S, E);
#else
        ep::EpiOut E{F.YB, F.SSQ};
        {
        pg8::gemm_phase<ep::EpiOut, pg8::StaticOrder, true, true>(F.lds, g, S, E);
#endif
        for (int sl = F.vcu; sl < 256; sl += F.G) ep::skinny_phase<1>(F.MERGED, F.WOUT, nullptr, nullptr, F.out + 16777216, F.SSQS, sl, F.lds);
        if (BOTH(4)) GRID_BAR(); }
    }
    if (IN(5)) p5_final(F);
#undef IN
#undef BOTH
#undef GRID_BAR
}

extern "C" void kernel_launch(void* const* d_in, const int* in_sizes, int n_in, void* d_out, int out_size, void* d_ws, size_t ws_size, hipStream_t stream) {
    static int grid = 0;
    if (grid == 0) {
        if (n_in != 19 || in_sizes[0] != MP * DM || in_sizes[10] != DM * INW || out_size != OUT_ELEMS || ws_size < WS_END) {
            fprintf(stderr, "kernel_launch: built for 19 inputs, x_prompt %d, w_in %d, out %d floats, >= %zu bytes of workspace; got n_in %d, in0 %d, in10 %d, out %d, ws %zu; nothing launched\n",
                    MP * DM, DM * INW, OUT_ELEMS, (size_t)WS_END, n_in, n_in > 0 ? in_sizes[0] : -1, n_in > 10 ? in_sizes[10] : -1, out_size, ws_size);
            grid = -1; return; }
        int dev = 0, cus = 0, per_cu = 0;
        if (hipGetDevice(&dev) != hipSuccess || hipDeviceGetAttribute(&cus, hipDeviceAttributeMultiprocessorCount, dev) != hipSuccess) { fprintf(stderr, "kernel_launch: device query failed\n"); grid = -1; return; }
        if (hipFuncSetAttribute((const void*)fwd_megakernel, hipFuncAttributeMaxDynamicSharedMemorySize, LDS_BYTES) != hipSuccess) { fprintf(stderr, "kernel_launch: hipFuncSetAttribute(%d B LDS) failed\n", LDS_BYTES); grid = -1; return; }
        if (hipOccupancyMaxActiveBlocksPerMultiprocessor(&per_cu, (const void*)fwd_megakernel, NWAVES * 64, LDS_BYTES) != hipSuccess || per_cu < 1) {
            fprintf(stderr, "kernel_launch: occupancy query reports %d workgroups per CU; nothing launched\n", per_cu); (void)hipGetLastError(); grid = -1; return; }
        grid = cus;
    }
    if (grid < 0) return;
    if (hipMemsetAsync((char*)d_ws + WS_CTL, 0, CTL_ZERO_BYTES, stream) != hipSuccess) { fprintf(stderr, "kernel_launch: hipMemsetAsync failed\n"); return; }
    Args a{};
    for (int i = 0; i < 19; ++i) a.in[i] = d_in[i];
    a.out = (float*)d_out; a.ws = (unsigned char*)d_ws;
    if (N_LAUNCHES == 1) {
        a.ph_lo = 0; a.ph_hi = PER_PHASE;
        hipLaunchKernelGGL(fwd_megakernel, dim3(grid), dim3(NWAVES * 64), LDS_BYTES, stream, a);
    } else {
        for (int li = 0; li < PER_PHASE; ++li) { a.ph_lo = li; a.ph_hi = li + 1; hipLaunchKernelGGL(fwd_megakernel, dim3(grid), dim3(NWAVES * 64), LDS_BYTES, stream, a); }
    }
    const hipError_t le = hipPeekAtLastError();
    if (le != hipSuccess) fprintf(stderr, "kernel_launch: launch failed: %s (grid %d)\n", hipGetErrorName(le), grid);
}
```

```cpp
#include <hip/hip_runtime.h>
#include <hip/hip_bf16.h>
#include <cstdio>
#include <cstdint>

#ifndef MK_N_LAUNCHES
#define MK_N_LAUNCHES 1
#endif
#ifndef FUSE_RMS
#define FUSE_RMS 0
#endif
#ifndef LATE_WT
#define LATE_WT 1
#endif
#ifndef SLACK_P1
#define SLACK_P1 1
#endif
#ifndef SB_EARLY_EXIT
#define SB_EARLY_EXIT 1
#endif

constexpr int DM = 2048, SEQ = 4096, NB = 2, DB = 8, DS = 16, PAST = 4096, HD = 128;
constexpr int MP = NB * SEQ;
constexpr int MS = DB * DS;
constexpr int MIN_ = 8448;
constexpr int MREAL = MP + MS;
constexpr int MMEM0 = 8448;
constexpr int MA = 8960;
constexpr int INW = 13312, NCAT = 14336;
constexpr int NMEM = 256;
constexpr float RMS_EPS = 1e-6f;
constexpr float LOG2E = 1.4426950408889634f;
constexpr float QSCALE = 0.08838834764831845f * 1.4426950408889634f;

namespace pg8 {
#define PG8_LAS __attribute__((address_space(3)))
typedef unsigned short bf16_t;
typedef short bf16x8 __attribute__((ext_vector_type(8)));
typedef float f32x4 __attribute__((ext_vector_type(4)));
typedef unsigned u32x4 __attribute__((ext_vector_type(4)));
constexpr int BM = 256, BK = 64, HALF = 128, HTB = HALF * BK * 2  , STAGE_BYTES = 8 * HTB, NXCD = 8, WGM = 8;

__host__ __device__ __forceinline__ int lds_byte(int r, int c) { const int st = (r >> 4) * 2 + (c >> 5), rr = r & 15, cc = c & 31, ob = rr * 64 + cc * 2; return st * 1024 + (ob ^ (((ob >> 9) & 1) << 5)); }
__host__ __device__ __forceinline__ void stage_rc(int b, int& R, int& C) { const int st = b / 1024, sb = b % 1024, swz = sb ^ (((sb >> 9) & 1) << 5); R = (st >> 1) * 16 + swz / 64; C = (st & 1) * 32 + (swz % 64) / 2; }
__host__ __device__ __forceinline__ int perm32(int rho) { const int n = rho >> 4, i = rho & 15; return 8 * (i >> 2) + 4 * n + (i & 3); }

struct Unit { int pm, pn, k0, nt; };
struct Gemm { const bf16_t* A; const bf16_t* Bt; int M, N, K; };

struct StaticOrder {
    int nM, nN, nwg, G, c;
    __host__ __device__ void init(int M, int N, int G_, int c_) { nM = M / BM; nN = N / BM; nwg = nM * nN; G = G_; c = c_; }
    __host__ __device__ bool next(int i, Unit& u) const {
        const long L = (long)i * G + c; if (L >= nwg) return false;
        int wgid = (int)L; { const int q = nwg / NXCD, r = nwg % NXCD, xcd = wgid % NXCD, off = wgid / NXCD; wgid = (xcd < r ? xcd * (q + 1) : r * (q + 1) + (xcd - r) * q) + off; }
        const int nig = WGM * nN, gid = wgid / nig, fm = gid * WGM, gsz = (nM - fm) < WGM ? (nM - fm) : WGM;
        u.pm = fm + ((wgid % nig) % gsz); u.pn = (wgid % nig) / gsz; u.k0 = 0; u.nt = 0; return true;
    }
    __device__ __forceinline__ void a_ready(const Unit&) const {}
    __device__ __forceinline__ void done(const Unit&) const {}
};

typedef float f32x2_t __attribute__((ext_vector_type(2))); typedef __bf16 bf16x2_t __attribute__((ext_vector_type(2)));
__device__ __forceinline__ unsigned cvt_pk_bf16(float lo, float hi) { f32x2_t v = {lo, hi}; bf16x2_t b = __builtin_convertvector(v, bf16x2_t); return __builtin_bit_cast(unsigned, b); }

template <class Epi, class Sched, bool ALIGN_EPI = false, bool SP2 = false>
__device__ __forceinline__ void gemm_phase(PG8_LAS unsigned char* lds, const Gemm g, const Sched& S, const Epi& E) {
    const int tid = threadIdx.x, wid = __builtin_amdgcn_readfirstlane(tid >> 6), lane = tid & 63, wr = wid >> 2, wc = wid & 3, fr = lane & 15, fq = lane >> 4;
    const int K = g.K, nt = K / BK;
    unsigned voffA[2], voffB[2];
#pragma unroll
    for (int i = 0; i < 2; ++i) { int R, C; stage_rc(tid * 16 + i * 8192, R, C); const int Rb = Epi::PERM ? ((R & ~31) + perm32(R & 31)) : R;
        voffA[i] = (unsigned)(R * K + C) * 2u; voffB[i] = (unsigned)(Rb * K + C) * 2u; }
    const size_t kstep = (size_t)(BK * 2);
    const size_t hstep = (size_t)HALF * K * 2;
    const size_t tstep = 2 * hstep;
    const unsigned ldsw = (unsigned)wid * 1024u;
    const int aoff = lds_byte(wr * 64 + fr, fq * 8), boff = lds_byte(wc * 32 + fr, fq * 8);
#define PG8_SA(b, h) (((b) * 2 + (h)) * HTB)
#define PG8_SB(b, h) ((4 + (b) * 2 + (h)) * HTB)
#define PG8_STAGE(bufoff, gbase, voff) do { _Pragma("unroll") for (int _i = 0; _i < 2; ++_i) \
        __builtin_amdgcn_global_load_lds((const unsigned*)((const char*)(gbase) + (voff)[_i]), (PG8_LAS unsigned*)(lds + (bufoff) + ldsw + _i * 8192), 16, 0, 0); } while (0)
#define PG8_LDA(dst, b, h) do { _Pragma("unroll") for (int m = 0; m < 4; ++m) _Pragma("unroll") for (int k = 0; k < 2; ++k) dst[m][k] = *(const PG8_LAS bf16x8*)(lds + PG8_SA(b, h) + aoff + m * 2048 + k * 1024); } while (0)
#define PG8_LDB(dst, b, h) do { _Pragma("unroll") for (int n = 0; n < 2; ++n) _Pragma("unroll") for (int k = 0; k < 2; ++k) dst[n][k] = *(const PG8_LAS bf16x8*)(lds + PG8_SB(b, h) + boff + n * 2048 + k * 1024); } while (0)
#define PG8_MMA(ai, bj, At, Bt) do { __builtin_amdgcn_s_setprio(1); _Pragma("unroll") for (int m = 0; m < 4; ++m) _Pragma("unroll") for (int n = 0; n < 2; ++n) _Pragma("unroll") for (int k = 0; k < 2; ++k) \
        acc[ai][bj][m][n] = __builtin_amdgcn_mfma_f32_16x16x32_bf16(Bt[n][k], At[m][k], acc[ai][bj][m][n], 0, 0, 0); __builtin_amdgcn_s_setprio(0); } while (0)
#define PG8_WAIT_V(n) asm volatile("s_waitcnt vmcnt(" #n ")" ::: "memory")
#define PG8_WAIT_L(n) asm volatile("s_waitcnt lgkmcnt(" #n ")" ::: "memory")
#define PG8_BAR __builtin_amdgcn_s_barrier()
#define PG8_SCHED __builtin_amdgcn_sched_barrier(0)
    Unit cur, nxt; int ui = 0;
    if (!S.next(0, cur)) return;
    f32x4 acc[2][2][4][2];
#pragma unroll
    for (int a = 0; a < 2; ++a)
#pragma unroll
        for (int b = 0; b < 2; ++b)
#pragma unroll
            for (int m = 0; m < 4; ++m)
#pragma unroll
                for (int n = 0; n < 2; ++n) acc[a][b][m][n] = (f32x4){0.f, 0.f, 0.f, 0.f};
    bf16x8 At[4][2], B0[2][2], B1[2][2];
    const char* cA = (const char*)g.A + (size_t)cur.pm * tstep + (size_t)cur.k0 * 2; const char* cB = (const char*)g.Bt + (size_t)cur.pn * tstep + (size_t)cur.k0 * 2;
    S.a_ready(cur);
    if constexpr (SP2) {
        PG8_STAGE(PG8_SB(0, 0), cB, voffB); PG8_STAGE(PG8_SB(0, 1), cB + hstep, voffB); PG8_STAGE(PG8_SA(0, 0), cA, voffA); PG8_STAGE(PG8_SA(0, 1), cA + hstep, voffA);
        if (wr == 1) PG8_BAR;
        PG8_WAIT_V(2); PG8_BAR;
        PG8_STAGE(PG8_SB(1, 0), cB + kstep, voffB); PG8_STAGE(PG8_SA(1, 0), cA + kstep, voffA); PG8_STAGE(PG8_SB(1, 1), cB + hstep + kstep, voffB);
        PG8_WAIT_V(6); PG8_BAR;
    } else {
        PG8_STAGE(PG8_SB(0, 0), cB, voffB); PG8_STAGE(PG8_SA(0, 0), cA, voffA); PG8_STAGE(PG8_SB(0, 1), cB + hstep, voffB); PG8_STAGE(PG8_SA(0, 1), cA + hstep, voffA);
        if (wr == 1) PG8_BAR;
        PG8_WAIT_V(4); PG8_BAR;
        PG8_STAGE(PG8_SB(1, 0), cB + kstep, voffB); PG8_STAGE(PG8_SA(1, 0), cA + kstep, voffA); PG8_STAGE(PG8_SB(1, 1), cB + hstep + kstep, voffB);
        PG8_WAIT_V(6); PG8_BAR;
    }
    for (;;) {
        const bool has_next = S.next(ui + 1, nxt);
        const char* nA = has_next ? (const char*)g.A + (size_t)nxt.pm * tstep + (size_t)nxt.k0 * 2 : cA; const char* nB = has_next ? (const char*)g.Bt + (size_t)nxt.pn * tstep + (size_t)nxt.k0 * 2 : cB;
        const int ntu = cur.nt ? cur.nt : nt;
        for (int t = 0; t < ntu; t += 2) {
            const bool last = (t == ntu - 2);
            const char* a1 = cA + (size_t)(t + 1) * kstep;
            const char* a2 = last ? nA : cA + (size_t)(t + 2) * kstep; const char* b2 = last ? nB : cB + (size_t)(t + 2) * kstep;
            const char* a3 = a2 + kstep; const char* b3 = b2 + kstep;
            if (last && has_next) S.a_ready(nxt);
            if constexpr (SP2) {
            PG8_LDB(B0, 0, 0); PG8_LDB(B1, 0, 1); PG8_SCHED; PG8_LDA(At, 0, 0); PG8_STAGE(PG8_SA(1, 1), a1 + hstep, voffA);
            PG8_WAIT_V(8); PG8_WAIT_L(0); PG8_BAR; PG8_MMA(0, 0, At, B0); PG8_MMA(0, 1, At, B1); PG8_BAR; PG8_SCHED;
            PG8_LDA(At, 0, 1); PG8_STAGE(PG8_SB(0, 0), b2, voffB); PG8_STAGE(PG8_SB(0, 1), b2 + hstep, voffB); PG8_STAGE(PG8_SA(0, 0), a2, voffA);
            PG8_WAIT_V(8); PG8_WAIT_L(0); PG8_BAR; PG8_MMA(1, 0, At, B0); PG8_MMA(1, 1, At, B1); PG8_BAR; PG8_SCHED;
            PG8_LDB(B0, 1, 0); PG8_LDB(B1, 1, 1); PG8_SCHED; PG8_LDA(At, 1, 0); PG8_STAGE(PG8_SA(0, 1), a2 + hstep, voffA);
            PG8_WAIT_V(8); PG8_WAIT_L(0); PG8_BAR; PG8_MMA(0, 0, At, B0); PG8_MMA(0, 1, At, B1); PG8_BAR; PG8_SCHED;
            PG8_LDA(At, 1, 1); PG8_STAGE(PG8_SB(1, 0), b3, voffB); PG8_STAGE(PG8_SB(1, 1), b3 + hstep, voffB); PG8_STAGE(PG8_SA(1, 0), a3, voffA);
            PG8_WAIT_V(8); PG8_WAIT_L(0); PG8_BAR; PG8_MMA(1, 0, At, B0); PG8_MMA(1, 1, At, B1); PG8_BAR; PG8_SCHED;
            } else {
            PG8_LDB(B0, 0, 0); PG8_SCHED; PG8_LDA(At, 0, 0); PG8_STAGE(PG8_SA(1, 1), a1 + hstep, voffA);
            PG8_WAIT_L(8); PG8_BAR; PG8_WAIT_L(0); PG8_MMA(0, 0, At, B0); PG8_BAR; PG8_SCHED;
            PG8_LDB(B1, 0, 1); PG8_STAGE(PG8_SB(0, 0), b2, voffB);
            PG8_BAR; PG8_WAIT_L(0); PG8_MMA(0, 1, At, B1); PG8_BAR;
            PG8_LDA(At, 0, 1); PG8_STAGE(PG8_SA(0, 0), a2, voffA);
            PG8_BAR; PG8_WAIT_L(0); PG8_MMA(1, 0, At, B0); PG8_BAR; PG8_SCHED;
            PG8_STAGE(PG8_SB(0, 1), b2 + hstep, voffB);
            PG8_WAIT_V(6); PG8_BAR; PG8_MMA(1, 1, At, B1); PG8_BAR;
            PG8_LDB(B0, 1, 0); PG8_SCHED; PG8_LDA(At, 1, 0); PG8_STAGE(PG8_SA(0, 1), a2 + hstep, voffA);
            PG8_WAIT_L(8); PG8_BAR; PG8_WAIT_L(0); PG8_MMA(0, 0, At, B0); PG8_BAR; PG8_SCHED;
            PG8_LDB(B1, 1, 1); PG8_STAGE(PG8_SB(1, 0), b3, voffB);
            PG8_BAR; PG8_WAIT_L(0); PG8_MMA(0, 1, At, B1); PG8_BAR;
            PG8_LDA(At, 1, 1); PG8_STAGE(PG8_SA(1, 0), a3, voffA);
            PG8_BAR; PG8_WAIT_L(0); PG8_MMA(1, 0, At, B0); PG8_BAR; PG8_SCHED;
            PG8_STAGE(PG8_SB(1, 1), b3 + hstep, voffB);
            PG8_WAIT_V(6); PG8_BAR; PG8_MMA(1, 1, At, B1); PG8_BAR;
            }
        }
        if constexpr (ALIGN_EPI) { if (wr == 0) PG8_BAR; }
        if constexpr (!Epi::AFTER_DRAIN) { E(acc, cur, wr, wc, fr, fq); S.done(cur); }
        if (!has_next) break;
        if (E.reset_after(cur))
#pragma unroll
        for (int a = 0; a < 2; ++a)
#pragma unroll
            for (int b = 0; b < 2; ++b)
#pragma unroll
                for (int m = 0; m < 4; ++m)
#pragma unroll
                    for (int n = 0; n < 2; ++n) acc[a][b][m][n] = (f32x4){0.f, 0.f, 0.f, 0.f};
        cur = nxt; cA = nA; cB = nB; ++ui;
        if constexpr (ALIGN_EPI) { if (wr == 1) PG8_BAR; }
    }
    PG8_WAIT_V(0);
    if constexpr (!ALIGN_EPI) { if (wr == 0) PG8_BAR; }
    PG8_BAR;
    if constexpr (Epi::AFTER_DRAIN) { E.fused(acc, cur, wr, wc, fr, fq, lds, wid, lane); S.done(cur); }
#undef PG8_SA
#undef PG8_SB
#undef PG8_STAGE
#undef PG8_LDA
#undef PG8_LDB
#undef PG8_MMA
#undef PG8_WAIT_V
#undef PG8_WAIT_L
#undef PG8_BAR
#undef PG8_SCHED
}
}

namespace ep {
using pg8::f32x4; using pg8::u32x4; using pg8::Unit; using pg8::bf16_t; using pg8::HALF; using pg8::BM; using pg8::cvt_pk_bf16;
typedef unsigned u32x2 __attribute__((ext_vector_type(2)));

struct InOrder {
    pg8::StaticOrder so; int G, c;
    __device__ void init(int G_, int c_) { so.init(MIN_, INW, G_, c_); G = G_; c = c_; }
    __device__ bool next(int i, Unit& u) const {
        const long L = (long)i * G + c;
        if (L < so.nwg) return so.next(i, u);
        const int j = (int)(L - so.nwg); if (j >= 8) return false;
        u.pm = 33 + (j & 1); u.pn = 52 + (j >> 1); u.k0 = 0; u.nt = 0; return true;
    }
    __device__ __forceinline__ void a_ready(const Unit&) const {}
    __device__ __forceinline__ void done(const Unit&) const {}
};

__device__ __forceinline__ float sigmoidf_fast(float x) { return __builtin_amdgcn_rcpf(1.0f + __builtin_amdgcn_exp2f(-x * LOG2E)); }
__device__ __forceinline__ float bf2f(unsigned short h) { return __uint_as_float((unsigned)h << 16); }

struct EpiIn {
    static constexpr bool PERM = true, AFTER_DRAIN = false;
    bf16_t *QSB, *KSB, *VSB, *GSB, *QBD, *KBD, *VBD, *GBD, *QMM, *GMM, *MG, *MK, *MV;
    float* out;
    __attribute__((address_space(3))) unsigned char* stg;
    bf16_t *KBC, *VBC;
    __device__ __forceinline__ bool reset_after(const Unit&) const { return true; }
    template <int ACT, int F32>
    __device__ __forceinline__ void store(const f32x4 (&acc)[2][2][4][2], bf16_t* dst, int ldc, int colt, int rowoff, int pm, float* f0, float* f1, int wr, int wc, int fr, int fq, bf16_t* bdc = nullptr) const {
        const int col0 = colt + wc * 32 + 8 * fq;
#pragma unroll
        for (int ai = 0; ai < 2; ++ai)
#pragma unroll
            for (int m = 0; m < 4; ++m) {
                const int r = pm * BM + ai * HALF + wr * 64 + m * 16 + fr;
                bf16_t* rowp = dst + (size_t)(r - rowoff) * ldc + col0;
                float* frow = nullptr;
                if (F32 == 1) { if (r < MP) frow = f0 + (size_t)r * 768; else if (r < MREAL) frow = f1 + (size_t)(r - MP) * 768; }
                if (F32 == 2) { if (r < MP) { const int t = r & (SEQ - 1); if (t >= SEQ - 512) frow = f0 + ((size_t)(r >> 12) * 512 + (t - (SEQ - 512))) * 768; } else if (r < MREAL) frow = f1 + (size_t)(r - MP) * 768; }
                if (F32 == 3) frow = f0 + (size_t)(r - MMEM0) * 512;
#pragma unroll
                for (int bj = 0; bj < 2; ++bj) {
                    f32x4 v0 = acc[ai][bj][m][0], v1 = acc[ai][bj][m][1];
                    if (F32 != 0) { if (frow) { __builtin_nontemporal_store(v0, (f32x4*)(frow + col0 + bj * HALF)); __builtin_nontemporal_store(v1, (f32x4*)(frow + col0 + bj * HALF + 4)); } }
                    if (ACT == 1) { v0 = v0 * QSCALE; v1 = v1 * QSCALE; }
                    if (ACT == 2) {
#pragma unroll
                        for (int e = 0; e < 4; ++e) { v0[e] = v0[e] * sigmoidf_fast(v0[e]); v1[e] = v1[e] * sigmoidf_fast(v1[e]); } }
                    if (ACT == 3) {
#pragma unroll
                        for (int e = 0; e < 4; ++e) { v0[e] = sigmoidf_fast(v0[e]); v1[e] = sigmoidf_fast(v1[e]); } }
                    u32x4 w; w.x = cvt_pk_bf16(v0[0], v0[1]); w.y = cvt_pk_bf16(v0[2], v0[3]); w.z = cvt_pk_bf16(v1[0], v1[1]); w.w = cvt_pk_bf16(v1[2], v1[3]);
                    *(u32x4*)(rowp + bj * HALF) = w;
                    if (F32 == 2 && SLACK_P1) { if (r >= MP && r < MREAL) *(u32x4*)(bdc + ((size_t)((r - MP) >> 4) * 576 + 512 + ((r - MP) & 15)) * 768 + col0 + bj * HALF) = w; } }
            }
    }
    __device__ __forceinline__ void store_gates(const f32x4 (&acc)[2][2][4][2], int t, int pm, int wr, int wc, int fr, int fq) const {
        typedef float f32x2 __attribute__((ext_vector_type(2)));
        typedef __attribute__((address_space(3))) u32x2 lu32x2; typedef __attribute__((address_space(3))) u32x4 lu32x4;
        const int sld = (t < 24) ? 768 : 512;
        bf16_t* const sdst = (t < 12) ? GSB + 64 * t : (t < 24 ? GBD + 64 * (t - 12) : GMM + 64 * (t - 24));
        constexpr float CAP = 1073741824.0f, NLN2 = -0.6931471805599453f;
        const int row32 = wr * 16 + fr;
        const int woff = row32 * 128 + ((wc ^ ((row32 >> 1) & 3)) << 5) + fq * 8;
        const int tid = threadIdx.x, rrow = (tid & 255) >> 3, part = tid & 7, kq = tid >> 8;
        const int roff = kq * 4096 + rrow * 128 + ((((part >> 1) ^ ((rrow >> 1) & 3)) << 5) | ((part & 1) << 4));
        const int grow = pm * BM + (rrow >> 4) * 64 + (rrow & 15);
#pragma unroll
        for (int ai = 0; ai < 2; ++ai)
#pragma unroll
            for (int m = 0; m < 4; ++m) {
                u32x2 w1, w2, w3, ws;
#pragma unroll
                for (int h = 0; h < 2; ++h) {
                    const f32x2 x1 = {acc[ai][0][m][0][2 * h], acc[ai][0][m][0][2 * h + 1]}, x2 = {acc[ai][0][m][1][2 * h], acc[ai][0][m][1][2 * h + 1]};
                    const f32x2 x3 = {acc[ai][1][m][0][2 * h], acc[ai][1][m][0][2 * h + 1]}, xs = {acc[ai][1][m][1][2 * h], acc[ai][1][m][1][2 * h + 1]};
                    const f32x2 one = {1.0f, 1.0f};
                    const f32x2 d1 = (f32x2){fminf(__builtin_amdgcn_exp2f(x1.x), CAP), fminf(__builtin_amdgcn_exp2f(x1.y), CAP)} + one, d2 = (f32x2){fminf(__builtin_amdgcn_exp2f(x2.x), CAP), fminf(__builtin_amdgcn_exp2f(x2.y), CAP)} + one;
                    const f32x2 d3 = (f32x2){fminf(__builtin_amdgcn_exp2f(x3.x), CAP), fminf(__builtin_amdgcn_exp2f(x3.y), CAP)} + one, ds = (f32x2){fminf(__builtin_amdgcn_exp2f(xs.x), CAP), fminf(__builtin_amdgcn_exp2f(xs.y), CAP)} + one;
                    const f32x2 p12 = d1 * d2, p3s = d3 * ds, q = p12 * p3s;
                    const f32x2 rq = {__builtin_amdgcn_rcpf(q.x), __builtin_amdgcn_rcpf(q.y)};
                    const f32x2 i12 = rq * p3s, i3s = rq * p12;
                    const f32x2 g3 = i3s * ds, sg = (xs * NLN2) * (i3s * d3);
                    const f32x2 r1 = (d2 * d2) * i12, r2 = (d3 * d1) * i12;
                    w1[h] = cvt_pk_bf16(r1.x, r1.y); w2[h] = cvt_pk_bf16(r2.x, r2.y); w3[h] = cvt_pk_bf16(g3.x, g3.y); ws[h] = cvt_pk_bf16(sg.x, sg.y);
                }
                if (ai + m > 0) { asm volatile("s_waitcnt lgkmcnt(0)" ::: "memory"); __builtin_amdgcn_s_barrier(); }
                *(lu32x2*)(stg + woff) = w1; *(lu32x2*)(stg + 4096 + woff) = w2; *(lu32x2*)(stg + 8192 + woff) = w3; *(lu32x2*)(stg + 12288 + woff) = ws;
                asm volatile("s_waitcnt lgkmcnt(0)" ::: "memory"); __builtin_amdgcn_s_barrier(); asm volatile("" ::: "memory");
                const u32x4 va = *(const lu32x4*)(stg + roff), vb = *(const lu32x4*)(stg + 8192 + roff);
                const int r = grow + ai * HALF + m * 16;
                *(u32x4*)(MG + (size_t)r * 6144 + kq * 2048 + 64 * t + part * 8) = va;
                if (kq == 0) *(u32x4*)(MG + (size_t)r * 6144 + 4096 + 64 * t + part * 8) = vb;
                else *(u32x4*)(sdst + (size_t)r * sld + part * 8) = vb;
            }
        asm volatile("s_waitcnt lgkmcnt(0)" ::: "memory");
    }
    __device__ __forceinline__ void operator()(const f32x4 (&acc)[2][2][4][2], const Unit& u, int wr, int wc, int fr, int fq) const {
        const int pn = u.pn, pm = u.pm;
        float* const o_sbk = out + 17039360, * const o_sbv = out + 23330816, * const o_bdk = out + 29622272, * const o_bdv = out + 30408704;
        float* const o_mk = out + 31195136, * const o_mv = out + 31457280;
        float* const s_sbk = out + 31719424, * const s_sbv = out + 31817728, * const s_bdk = out + 31916032, * const s_bdv = out + 32014336;
        if (pn < 3)        store<0, 0>(acc, QSB, 768, 256 * pn, 0, pm, nullptr, nullptr, wr, wc, fr, fq);
        else if (pn < 6)   store<0, 1>(acc, KSB, 768, 256 * (pn - 3), 0, pm, o_sbk, s_sbk, wr, wc, fr, fq);
        else if (pn < 9)   store<0, 1>(acc, VSB, 768, 256 * (pn - 6), 0, pm, o_sbv, s_sbv, wr, wc, fr, fq);
        else if (pn < 12)  store<0, 0>(acc, QBD, 768, 256 * (pn - 9), 0, pm, nullptr, nullptr, wr, wc, fr, fq);
        else if (pn < 15)  store<0, 2>(acc, KBD, 768, 256 * (pn - 12), 0, pm, o_bdk, s_bdk, wr, wc, fr, fq, KBC);
        else if (pn < 18)  store<0, 2>(acc, VBD, 768, 256 * (pn - 15), 0, pm, o_bdv, s_bdv, wr, wc, fr, fq, VBC);
        else if (pn < 20)  store<0, 0>(acc, QMM, 512, 256 * (pn - 18), 0, pm, nullptr, nullptr, wr, wc, fr, fq);
        else if (pn < 52)  store_gates(acc, pn - 20, pm, wr, wc, fr, fq);
        else if (pn < 54)  store<0, 3>(acc, MK, 512, 256 * (pn - 52), MMEM0, pm, o_mk, nullptr, wr, wc, fr, fq);
        else               store<0, 3>(acc, MV, 512, 256 * (pn - 54), MMEM0, pm, o_mv, nullptr, wr, wc, fr, fq);
    }
};

struct MergeOrder {
    pg8::StaticOrder so;
    __device__ void init(int G_, int c_) { so.init(MP, DM, G_, c_); }
    __device__ bool next(int i, Unit& u) const {
        const int ti = i / 3, seg = i - 3 * ti;
        if (!so.next(ti, u)) return false;
        u.k0 = 768 * seg; u.nt = (seg == 2) ? 8 : 12; return true;
    }
    __device__ __forceinline__ void a_ready(const Unit&) const {}
    __device__ __forceinline__ void done(const Unit&) const {}
};
struct EpiMerge {
    static constexpr bool PERM = true, AFTER_DRAIN = false;
    const bf16_t* MG; bf16_t* OUT;
    __device__ __forceinline__ bool reset_after(const Unit& u) const { return u.k0 == 1536; }
    __device__ __forceinline__ void operator()(f32x4 (&acc)[2][2][4][2], const Unit& u, int wr, int wc, int fr, int fq) const {
        const int col0 = u.pn * BM + wc * 32 + 8 * fq;
        const int seg = (u.k0 == 0) ? 0 : (u.k0 == 768 ? 1 : 2);
        const bool last = (seg == 2);
        u32x4 g[2][4][2];
#pragma unroll
        for (int ai = 0; ai < 2; ++ai)
#pragma unroll
            for (int m = 0; m < 4; ++m) { const bf16_t* g_ = MG + (size_t)(u.pm * BM + ai * HALF + wr * 64 + m * 16 + fr) * 6144 + seg * 2048 + col0;
#pragma unroll
                for (int bj = 0; bj < 2; ++bj) g[ai][m][bj] = *(const u32x4*)(g_ + bj * HALF); }
#pragma unroll
        for (int ai = 0; ai < 2; ++ai)
#pragma unroll
            for (int m = 0; m < 4; ++m) { bf16_t* rowp = OUT + (size_t)(u.pm * BM + ai * HALF + wr * 64 + m * 16 + fr) * DM + col0;
#pragma unroll
                for (int bj = 0; bj < 2; ++bj) {
#pragma unroll
                    for (int e = 0; e < 4; ++e) { acc[ai][bj][m][e >> 1][2 * (e & 1)] *= __uint_as_float(g[ai][m][bj][e] << 16); acc[ai][bj][m][e >> 1][2 * (e & 1) + 1] *= __uint_as_float(g[ai][m][bj][e] & 0xffff0000u); }
                    if (last) { u32x4 w; w.x = cvt_pk_bf16(acc[ai][bj][m][0][0], acc[ai][bj][m][0][1]); w.y = cvt_pk_bf16(acc[ai][bj][m][0][2], acc[ai][bj][m][0][3]);
                        w.z = cvt_pk_bf16(acc[ai][bj][m][1][0], acc[ai][bj][m][1][1]); w.w = cvt_pk_bf16(acc[ai][bj][m][1][2], acc[ai][bj][m][1][3]);
                        *(u32x4*)(rowp + bj * HALF) = w; } } }
    }
};

struct EpiOut {
    static constexpr bool PERM = true, AFTER_DRAIN = false;
    bf16_t* yb; float* ssq;
    __device__ __forceinline__ bool reset_after(const Unit&) const { return true; }
    __device__ __forceinline__ void operator()(const f32x4 (&acc)[2][2][4][2], const Unit& u, int wr, int wc, int fr, int fq) const {
        const int col0 = u.pn * BM + wc * 32 + 8 * fq;
#pragma unroll
        for (int ai = 0; ai < 2; ++ai)
#pragma unroll
            for (int m = 0; m < 4; ++m) {
                const int r = u.pm * BM + ai * HALF + wr * 64 + m * 16 + fr;
                bf16_t* yrow = yb + (size_t)r * DM + col0;
                float s = 0.f;
#pragma unroll
                for (int bj = 0; bj < 2; ++bj) { const f32x4 v0 = acc[ai][bj][m][0], v1 = acc[ai][bj][m][1];
                    s += ((v0[0] * v0[0] + v0[1] * v0[1]) + (v0[2] * v0[2] + v0[3] * v0[3])) + ((v1[0] * v1[0] + v1[1] * v1[1]) + (v1[2] * v1[2] + v1[3] * v1[3]));
                    u32x4 w; w.x = cvt_pk_bf16(v0[0], v0[1]); w.y = cvt_pk_bf16(v0[2], v0[3]); w.z = cvt_pk_bf16(v1[0], v1[1]); w.w = cvt_pk_bf16(v1[2], v1[3]);
                    *(u32x4*)(yrow + bj * HALF) = w; }
                s += __shfl_xor(s, 16); s += __shfl_xor(s, 32);
                if (fq == 0) ssq[(size_t)r * 32 + u.pn * 4 + wc] = s;
            }
    }
};

struct EpiOutFused {
    static constexpr bool PERM = false, AFTER_DRAIN = true;
    const float* x; float* out; const float* gpost; float* xbuf; unsigned* cnt; unsigned* tmo;
    __device__ __forceinline__ bool reset_after(const Unit&) const { return true; }
    __device__ __forceinline__ void operator()(const f32x4 (&)[2][2][4][2], const Unit&, int, int, int, int) const {}
    __device__ __forceinline__ void fused(f32x4 (&acc)[2][2][4][2], const Unit& u, int wr, int wc, int fr, int fq, __attribute__((address_space(3))) unsigned char* lds, int wid, int lane) const {
        typedef __attribute__((address_space(3))) float lfloat;
        lfloat* P = (lfloat*)lds;
        lfloat* S = (lfloat*)(lds + 4096);
        __attribute__((address_space(3))) unsigned* flag = (__attribute__((address_space(3))) unsigned*)(lds + 4096 + 1024);
        const int col0 = u.pn * BM + wc * 32 + 4 * fq;
        f32x4 pre[4][2][2];
#pragma unroll
        for (int m = 0; m < 4; ++m) { const size_t off = (size_t)(u.pm * BM + wr * 64 + m * 16 + fr) * DM + col0;
#pragma unroll
            for (int bj = 0; bj < 2; ++bj)
#pragma unroll
                for (int n = 0; n < 2; ++n) pre[m][bj][n] = *(const f32x4*)(x + off + bj * HALF + n * 16); }
#pragma unroll
        for (int ai = 0; ai < 2; ++ai)
#pragma unroll
            for (int m = 0; m < 4; ++m) { float s = 0.f;
#pragma unroll
                for (int bj = 0; bj < 2; ++bj)
#pragma unroll
                    for (int n = 0; n < 2; ++n) { const f32x4 v = acc[ai][bj][m][n]; s += (v[0] * v[0] + v[1] * v[1]) + (v[2] * v[2] + v[3] * v[3]); }
                s += __shfl_xor(s, 16); s += __shfl_xor(s, 32);
                if (fq == 0) P[(ai * HALF + wr * 64 + m * 16 + fr) * 4 + wc] = s; }
        asm volatile("s_waitcnt lgkmcnt(0)" ::: "memory"); __builtin_amdgcn_s_barrier(); asm volatile("" ::: "memory");
        const int row = wid * 32 + (lane & 31);
        if (lane < 32) { const float t = (P[row * 4 + 0] + P[row * 4 + 1]) + (P[row * 4 + 2] + P[row * 4 + 3]);
            __hip_atomic_store(xbuf + ((size_t)(u.pm * BM + row) * 8 + u.pn), t, __ATOMIC_RELAXED, __HIP_MEMORY_SCOPE_AGENT); }
        asm volatile("s_waitcnt vmcnt(0)" ::: "memory");
        if (lane == 0) __hip_atomic_fetch_add(cnt + 64 * u.pm, 1u, __ATOMIC_RELAXED, __HIP_MEMORY_SCOPE_AGENT);
        if (wid == 0) { bool dead = false; const unsigned long long t0 = __builtin_amdgcn_s_memrealtime();
            for (;;) {
                if ((unsigned)__builtin_amdgcn_readfirstlane(__hip_atomic_load(cnt + 64 * u.pm, __ATOMIC_RELAXED, __HIP_MEMORY_SCOPE_AGENT)) >= 64u) break;
                if (__builtin_amdgcn_s_memrealtime() - t0 > 2000000ull) { if (lane == 0) __hip_atomic_store(tmo, 1u, __ATOMIC_RELAXED, __HIP_MEMORY_SCOPE_AGENT); dead = true; break; }
                __builtin_amdgcn_s_sleep(2); }
            __builtin_amdgcn_fence(__ATOMIC_ACQUIRE, "agent");
            if (lane == 0) flag[0] = dead ? 1u : 0u; }
        asm volatile("s_waitcnt vmcnt(0) lgkmcnt(0)" ::: "memory"); __builtin_amdgcn_s_barrier(); asm volatile("" ::: "memory");
        const bool bad = flag[0] != 0u;
        if (lane < 32) { const float* slot = xbuf + (size_t)(u.pm * BM + row) * 8; float q = 0.f;
#pragma unroll
            for (int t = 0; t < 8; ++t) q += __hip_atomic_load(slot + t, __ATOMIC_RELAXED, __HIP_MEMORY_SCOPE_AGENT);
            S[row] = 1.0f / sqrtf(q * (1.0f / DM) + RMS_EPS); }
        asm volatile("s_waitcnt lgkmcnt(0)" ::: "memory"); __builtin_amdgcn_s_barrier(); asm volatile("" ::: "memory");
        f32x4 gv[2][2];
#pragma unroll
        for (int bj = 0; bj < 2; ++bj)
#pragma unroll
            for (int n = 0; n < 2; ++n) gv[bj][n] = *(const f32x4*)(gpost + col0 + bj * HALF + n * 16);
        const float qnan = __builtin_nanf("");
#pragma unroll
        for (int ai = 0; ai < 2; ++ai)
#pragma unroll
            for (int m = 0; m < 4; ++m) { const int r = ai * HALF + wr * 64 + m * 16 + fr; const float rs = S[r]; const size_t off = (size_t)(u.pm * BM + r) * DM + col0;
#pragma unroll
                for (int bj = 0; bj < 2; ++bj)
#pragma unroll
                    for (int n = 0; n < 2; ++n) { const f32x4 bs = ai == 0 ? pre[m][bj][n] : *(const f32x4*)(x + off + bj * HALF + n * 16);
                        f32x4 o = bs + acc[ai][bj][m][n] * rs * gv[bj][n];
                        if (bad) o = (f32x4){qnan, qnan, qnan, qnan};
                        *(f32x4*)(out + off + bj * HALF + n * 16) = o; }
                if (m & 1) asm volatile("" ::: "memory"); }
    }
};

template <int MODE>
__device__ __forceinline__ void skinny_phase(const bf16_t* A, const bf16_t* Bt, const bf16_t* MG, bf16_t* OUTB, float* OUTF, float* SSQS, int slice, __attribute__((address_space(3))) unsigned char* ldsl) {
    typedef short bf16x8 __attribute__((ext_vector_type(8)));
    const int tid = threadIdx.x, lane = tid & 63, fr = lane & 15, fq = lane >> 4;
    const int w = __builtin_amdgcn_readfirstlane(tid >> 6);
    const int cb = slice >> 1, rh = slice & 1;
    const int row0 = MP + 64 * rh + fr;
    const bf16_t* ap = A + (size_t)row0 * DM + 256 * w + 8 * fq;
    const bf16_t* bp = Bt + (size_t)(16 * cb + fr) * DM + 256 * w + 8 * fq;
    bf16x8 bf[8], af[4][8];
#pragma unroll
    for (int j = 0; j < 8; ++j) bf[j] = *(const bf16x8*)(bp + 32 * j);
#pragma unroll
    for (int rb = 0; rb < 4; ++rb)
#pragma unroll
        for (int j = 0; j < 8; ++j) af[rb][j] = *(const bf16x8*)(ap + (size_t)rb * 16 * DM + 32 * j);
    f32x4 acc[4];
#pragma unroll
    for (int rb = 0; rb < 4; ++rb) { acc[rb] = (f32x4){0.f, 0.f, 0.f, 0.f};
#pragma unroll
        for (int j = 0; j < 8; ++j) acc[rb] = __builtin_amdgcn_mfma_f32_16x16x32_bf16(bf[j], af[rb][j], acc[rb], 0, 0, 0); }
    if (MODE == 0) { const int s = (w < 3) ? 0 : (w < 6 ? 1 : 2);
#pragma unroll
        for (int rb = 0; rb < 4; ++rb) { const bf16_t* gp = MG + (size_t)(row0 + 16 * rb) * 6144 + 16 * cb + 4 * fq;
            const u32x2 ra = *(const u32x2*)gp, rb2 = *(const u32x2*)(gp + 2048), gc = *(const u32x2*)(gp + 4096);
#pragma unroll
            for (int e = 0; e < 4; ++e) { const unsigned a_ = e < 2 ? ra.x : ra.y, b_ = e < 2 ? rb2.x : rb2.y, c_ = e < 2 ? gc.x : gc.y;
                const float f1 = (e & 1) ? __uint_as_float(a_ & 0xffff0000u) : __uint_as_float(a_ << 16), f2 = (e & 1) ? __uint_as_float(b_ & 0xffff0000u) : __uint_as_float(b_ << 16), f3 = (e & 1) ? __uint_as_float(c_ & 0xffff0000u) : __uint_as_float(c_ << 16);
                acc[rb][e] *= f3 * (s < 2 ? f2 : 1.0f) * (s < 1 ? f1 : 1.0f); } } }
    __attribute__((address_space(3))) f32x4* red = (__attribute__((address_space(3))) f32x4*)ldsl;
#pragma unroll
    for (int rb = 0; rb < 4; ++rb) red[(w * 4 + rb) * 64 + lane] = acc[rb];
    __syncthreads();
    if (w < 4) { const int rb = w; f32x4 s = red[rb * 64 + lane];
#pragma unroll
        for (int k = 1; k < 8; ++k) s = s + red[(k * 4 + rb) * 64 + lane];
        const int row = row0 + 16 * rb;
        if (MODE == 0) { u32x2 o; o.x = cvt_pk_bf16(s[0], s[1]); o.y = cvt_pk_bf16(s[2], s[3]); *(u32x2*)(OUTB + (size_t)row * DM + 16 * cb + 4 * fq) = o; }
        else { *(f32x4*)(OUTF + (size_t)(row - MP) * DM + 16 * cb + 4 * fq) = s;
            float q = (s[0] * s[0] + s[1] * s[1]) + (s[2] * s[2] + s[3] * s[3]);
            q += __shfl_xor(q, 16); q += __shfl_xor(q, 32);
            if (fq == 0) SSQS[(size_t)(row - MP) * 128 + cb] = q; }
    }
    __syncthreads();
}
}

namespace att {
typedef unsigned short u16;
#define GA __attribute__((address_space(1)))
using bf16x8 = __attribute__((ext_vector_type(8))) short;
using s16x4  = __attribute__((ext_vector_type(4))) short;
using f32x16 = __attribute__((ext_vector_type(16))) float;
using f32x4  = __attribute__((ext_vector_type(4))) float;
using u32x4  = __attribute__((ext_vector_type(4))) unsigned;
using u32x2  = __attribute__((ext_vector_type(2))) unsigned;
constexpr int SHM_V = 16384, SHM_K = 16384;
constexpr int NBUF = 3;
constexpr int OFF_V = 0, OFF_K = NBUF * SHM_V, OFF_BIAS = 2 * NBUF * SHM_V, OFF_FLAGS = OFF_BIAS + 2304, OFF_ITEM = OFF_FLAGS + 128, ATT_LDS = OFF_ITEM + 64;
constexpr float SB_DONE_LOG2 = -200.0f;
#define KSWZ(row, colB) ((row) * 256 + ((colB) ^ (((row) & 7) << 4)))
#define ATT_SBAR() __builtin_amdgcn_sched_barrier(0)
__device__ __forceinline__ int crow(int r, int hi) { return (r & 3) + 8 * (r >> 2) + 4 * hi; }
__device__ __forceinline__ unsigned cvtpk(float lo, float hi) { return pg8::cvt_pk_bf16(lo, hi); }
__device__ __forceinline__ int v_st(int k, int c) { const int kk = (k & ~0xC) | ((k & 4) << 1) | ((k & 8) >> 1); return ((kk >> 3) * 4 + (c >> 5)) * 512 + ((kk & 7) * 32 + (c & 31)) * 2; }
__device__ __forceinline__ int v_rd_base(int lane) { return ((lane & 3) << 3) | (((lane >> 2) & 3) << 6) | (((lane >> 4) & 1) << 5) | (((lane >> 5) & 1) << 8); }
constexpr int v_rd_off(int d0, int ks, int half) { return d0 * 512 + ks * 4096 + half * 2048; }
template <int OFF> __device__ __forceinline__ s16x4 tr_read(int vb) { s16x4 r; asm volatile("ds_read_b64_tr_b16 %0, %1 offset:%2" : "=&v"(r) : "v"(vb), "i"(OFF) : "memory"); return r; }

struct Item {
    int mode;
    int rule;
    const GA u16* Q; int ldq; int nq; int qpos0;
    const GA u16 *kb, *vb; int ldb; int pb_lo, pb_hi;
    const GA float *kf, *vf; int ldf; int pf_lo, pf_hi;
    int pv_lo, pv_hi;
    int kp_first, kp_step, ntiles;
    const GA float* bias;
    GA u16* O; int ldo; const GA u16* G; int ldg;
    int dma;
};

template <bool QPARK>
__device__ __forceinline__ void qkt(f32x16& p0, f32x16& p1, const char* Ks, const bf16x8* qr, const char* qpark, int r32, int hi) {
    p0 = f32x16{}; p1 = f32x16{};
#pragma unroll
    for (int d0 = 0; d0 < 8; ++d0) { const int cb = (d0 * 16 + hi * 8) * 2;
        const bf16x8 b0 = *reinterpret_cast<const bf16x8*>(Ks + KSWZ(r32, cb));
        const bf16x8 b1 = *reinterpret_cast<const bf16x8*>(Ks + KSWZ(32 + r32, cb));
        const bf16x8 q = QPARK ? *reinterpret_cast<const bf16x8*>(qpark + d0 * 1024) : qr[d0];
        p0 = __builtin_amdgcn_mfma_f32_32x32x16_bf16(b0, q, p0, 0, 0, 0);
        p1 = __builtin_amdgcn_mfma_f32_32x32x16_bf16(b1, q, p1, 0, 0, 0); }
}
template <int D0> __device__ __forceinline__ void pv_one(f32x16& od, int vb, bf16x8 pa0, bf16x8 pa1, bf16x8 pa2, bf16x8 pa3) {
    const s16x4 l0 = tr_read<v_rd_off(D0, 0, 0)>(vb), h0 = tr_read<v_rd_off(D0, 0, 1)>(vb), l1 = tr_read<v_rd_off(D0, 1, 0)>(vb), h1 = tr_read<v_rd_off(D0, 1, 1)>(vb);
    const s16x4 l2 = tr_read<v_rd_off(D0, 2, 0)>(vb), h2 = tr_read<v_rd_off(D0, 2, 1)>(vb), l3 = tr_read<v_rd_off(D0, 3, 0)>(vb), h3 = tr_read<v_rd_off(D0, 3, 1)>(vb);
    asm volatile("s_waitcnt lgkmcnt(0)" ::: "memory"); ATT_SBAR();
#define ATT_PK(L, H) (bf16x8){L[0], L[1], L[2], L[3], H[0], H[1], H[2], H[3]}
    od = __builtin_amdgcn_mfma_f32_32x32x16_bf16(ATT_PK(l0, h0), pa0, od, 0, 0, 0);
    od = __builtin_amdgcn_mfma_f32_32x32x16_bf16(ATT_PK(l1, h1), pa1, od, 0, 0, 0);
    od = __builtin_amdgcn_mfma_f32_32x32x16_bf16(ATT_PK(l2, h2), pa2, od, 0, 0, 0);
    od = __builtin_amdgcn_mfma_f32_32x32x16_bf16(ATT_PK(l3, h3), pa3, od, 0, 0, 0);
#undef ATT_PK
}
#define ATT_PK4(P, BASE, OUT) do { const unsigned a0_ = cvtpk(P[BASE + 0], P[BASE + 1]), a1_ = cvtpk(P[BASE + 2], P[BASE + 3]);   \
    const unsigned b0_ = cvtpk(P[BASE + 4], P[BASE + 5]), b1_ = cvtpk(P[BASE + 6], P[BASE + 7]);                              \
    auto r0_ = __builtin_amdgcn_permlane32_swap(a0_, b0_, false, false); auto r1_ = __builtin_amdgcn_permlane32_swap(a1_, b1_, false, false); \
    u32x4 w_ = {r0_[0], r1_[0], r0_[1], r1_[1]}; OUT = *reinterpret_cast<bf16x8*>(&w_); } while (0)

__device__ __forceinline__ void sb_half(f32x16& p, float& carry, bool need_mask, int kbase, int qpos, int pv_lo, int pv_hi, int hi) {
    float T[16];
#pragma unroll
    for (int r = 0; r < 16; ++r) {
        const float z = p[r];
        const float t = __builtin_amdgcn_exp2f(-__builtin_fabsf(z));
        const float l = __builtin_amdgcn_logf(1.0f + t);
        float lm = -(fmaxf(z, 0.f) + l);
        float lp = fminf(z, 0.f) - l;
        if (need_mask) { const int kp = kbase + crow(r, hi); const bool ok = (kp < qpos) && (kp >= pv_lo) && (kp < pv_hi); lm = ok ? lm : 0.f; lp = ok ? lp : -1e30f; }
        T[r] = lm; p[r] = lp;
    }
    float glo[4], ghi[4];
#pragma unroll
    for (int g = 0; g < 4; ++g) {
        T[4 * g + 2] += T[4 * g + 3]; T[4 * g + 1] += T[4 * g + 2]; T[4 * g] += T[4 * g + 1];
        const float gt = T[4 * g];
        auto rr = __builtin_amdgcn_permlane32_swap(__float_as_uint(gt), __float_as_uint(gt), false, false);
        glo[g] = __uint_as_float(rr[0]); ghi[g] = __uint_as_float(rr[1]);
    }
    float SG[4];
    SG[3] = 0.f; SG[2] = glo[3] + ghi[3]; SG[1] = SG[2] + (glo[2] + ghi[2]); SG[0] = SG[1] + (glo[1] + ghi[1]);
    const float tot = SG[0] + (glo[0] + ghi[0]);
#pragma unroll
    for (int g = 0; g < 4; ++g) SG[g] += carry + (hi == 0 ? ghi[g] : 0.f);
#pragma unroll
    for (int r = 0; r < 16; ++r) p[r] = __builtin_amdgcn_exp2f(p[r] + ((r & 3) == 3 ? SG[r >> 2] : SG[r >> 2] + T[r + 1]));
    carry += tot;
}

#define ATT_TILE(Kt, vb_) do { \
            f32x16 p0, p1; \
            qkt<!DMA>(p0, p1, (Kt), qr, qpark, r32, hi); \
            bool need_mask = (kp0 < it.pv_lo) || (kp0 + 64 > it.pv_hi); \
            if (MODE == 0) { \
                need_mask = need_mask || (kp0 + 63 >= it.qpos0 + 32 * wid); \
                sb_half(p1, carry, need_mask, kp0 + 32, qpos, it.pv_lo, it.pv_hi, hi); \
                sb_half(p0, carry, need_mask, kp0, qpos, it.pv_lo, it.pv_hi, hi); \
            } else { \
                if (has_bias) {       \
                    const int dlo_ = it.qpos0 + 32 * wid - kp0 - 63, dhi_ = it.qpos0 + 32 * wid + 31 - kp0;       \
                    if (dlo_ >= 256) { const float c_ = biasT[0]; \
                        _Pragma("unroll") for (int r = 0; r < 16; ++r) { p0[r] += c_; p1[r] += c_; } } \
                    else if (dlo_ > -256 && dhi_ < 256) { const float* rb_ = biasT + (256 - qpos + kp0 + 4 * hi);              \
                        _Pragma("unroll") for (int r = 0; r < 16; ++r) { p0[r] += rb_[(r & 3) + 8 * (r >> 2)]; p1[r] += rb_[32 + (r & 3) + 8 * (r >> 2)]; } } \
                    else { \
                        _Pragma("unroll") for (int r = 0; r < 16; ++r) { const int kp = kp0 + crow(r, hi); \
                            int i0_ = 256 - qpos + kp; i0_ = i0_ < 0 ? 0 : (i0_ > 512 ? 512 : i0_); \
                            int i1_ = 288 - qpos + kp; i1_ = i1_ < 0 ? 0 : (i1_ > 512 ? 512 : i1_); \
                            p0[r] += biasT[i0_]; p1[r] += biasT[i1_]; } } \
                } \
                if (need_mask) { \
                    _Pragma("unroll") for (int r = 0; r < 16; ++r) { const int kp = kp0 + crow(r, hi); \
                        if (!(kp >= it.pv_lo && kp < it.pv_hi)) p0[r] = -1e30f; \
                        if (!(kp + 32 >= it.pv_lo && kp + 32 < it.pv_hi)) p1[r] = -1e30f; } \
                } \
                float pmax = p0[0]; \
                _Pragma("unroll") for (int r = 1; r < 16; ++r) pmax = fmaxf(pmax, p0[r]); \
                _Pragma("unroll") for (int r = 0; r < 16; ++r) pmax = fmaxf(pmax, p1[r]); \
                { auto rr = __builtin_amdgcn_permlane32_swap(__float_as_uint(pmax), __float_as_uint(pmax), false, false); pmax = fmaxf(__uint_as_float(rr[0]), __uint_as_float(rr[1])); } \
                float mn = m_reg, alpha = 1.f;                  \
                if (!__all(pmax - m_reg <= 8.0f)) { mn = fmaxf(m_reg, pmax); alpha = __builtin_amdgcn_exp2f(m_reg - mn); m_reg = mn; } \
                float ps = 0.f; \
                _Pragma("unroll") for (int r = 0; r < 16; ++r) { p0[r] = __builtin_amdgcn_exp2f(p0[r] - mn); ps += p0[r]; } \
                _Pragma("unroll") for (int r = 0; r < 16; ++r) { p1[r] = __builtin_amdgcn_exp2f(p1[r] - mn); ps += p1[r]; } \
                { auto rr = __builtin_amdgcn_permlane32_swap(__float_as_uint(ps), __float_as_uint(ps), false, false); ps = __uint_as_float(rr[0]) + __uint_as_float(rr[1]); } \
                l_reg = l_reg * alpha + ps; \
                if (__any(alpha < 1.f)) { \
                    _Pragma("unroll") for (int d = 0; d < 4; ++d) \
                        _Pragma("unroll") for (int r = 0; r < 16; ++r) o[d][r] *= alpha; } \
            } \
            bf16x8 pa0, pa1, pa2, pa3; \
            ATT_PK4(p0, 0, pa0); ATT_PK4(p0, 8, pa1); ATT_PK4(p1, 0, pa2); ATT_PK4(p1, 8, pa3); \
            const int vbt_ = (vb_); \
            pv_one<0>(o[0], vbt_, pa0, pa1, pa2, pa3); pv_one<1>(o[1], vbt_, pa0, pa1, pa2, pa3); pv_one<2>(o[2], vbt_, pa0, pa1, pa2, pa3); pv_one<3>(o[3], vbt_, pa0, pa1, pa2, pa3); \
        } while (0)

template <int MODE, bool DMA>
__device__ __forceinline__ void run_item(const Item& it, char* lds, __attribute__((address_space(3))) unsigned char* ldsl) {
    typedef __attribute__((address_space(3))) unsigned las_u32;
    const int tid = threadIdx.x, lane = tid & 63, r32 = lane & 31, hi = lane >> 5;
    const int wid = __builtin_amdgcn_readfirstlane(tid >> 6);
    char* V_lds = lds + OFF_V; char* K_lds = lds + OFF_K;
    float* biasT = (float*)(lds + OFF_BIAS);
    volatile __attribute__((address_space(3))) int* flags = (volatile __attribute__((address_space(3))) int*)(ldsl + OFF_FLAGS);
    const bool has_bias = (MODE == 1) && (it.bias != nullptr);
    const bool wave_rows = (32 * wid < it.nq);
    int qrow = 32 * wid + r32; if (qrow >= it.nq) qrow = it.nq - 1;
    const int qpos = it.qpos0 + 32 * wid + r32;
    bf16x8 qr[8];
    char* const qpark = K_lds + 2 * SHM_K + (wid & 1) * 8192 + lane * 16;
#define ATT_ITEM_LOADS() do { \
    if (has_bias) for (int i = tid; i < 513; i += 512) biasT[i] = it.bias[512 - i] * LOG2E; \
    { const GA u16* Qw = it.Q + (size_t)qrow * it.ldq + hi * 8; \
      _Pragma("unroll") for (int d0 = 0; d0 < 8; ++d0) { const bf16x8 q = *reinterpret_cast<const GA bf16x8*>(Qw + d0 * 16); \
          if constexpr (DMA) qr[d0] = q; else { if (wid < 2) *reinterpret_cast<bf16x8*>(qpark + d0 * 1024) = q; } } } \
    } while (0)
    f32x16 o[4]; o[0] = f32x16{}; o[1] = f32x16{}; o[2] = f32x16{}; o[3] = f32x16{};
    float carry = 0.f, m_reg = -1e30f, l_reg = 0.f;
    const int vb0 = (int)(uintptr_t)V_lds + v_rd_base(lane);
    const int nt = it.ntiles;
    bool wdone = !wave_rows;
    if constexpr (!DMA) ATT_ITEM_LOADS();
    if constexpr (DMA) {
        unsigned koff[2], voff[2];
#pragma unroll
        for (int i = 0; i < 2; ++i) { const int p = wid + 8 * i;
            const int krow = 4 * p + (lane >> 4), kch = (lane & 15) ^ (krow & 7);
            koff[i] = (unsigned)(krow * it.ldb * 2 + kch * 16);
            const int s = 2 * p + (lane >> 5), kk = 8 * (s >> 2) + ((lane & 31) >> 2), k = (kk & ~0xC) | ((kk & 4) << 1) | ((kk & 8) >> 1), c = 32 * (s & 3) + 8 * (lane & 3);
            voff[i] = (unsigned)(k * it.ldb * 2 + c * 2); }
        const GA char* kbase = (const GA char*)it.kb; const GA char* vbase = (const GA char*)it.vb;
#define ATT_DMA(b, kp0_) do { const size_t to_ = (size_t)((kp0_) - it.pb_lo) * (size_t)it.ldb * 2; \
        _Pragma("unroll") for (int i_ = 0; i_ < 2; ++i_) { \
            __builtin_amdgcn_global_load_lds((const GA unsigned*)(kbase + to_ + koff[i_]), (las_u32*)(ldsl + OFF_K + (b) * SHM_K + (wid + 8 * i_) * 1024), 16, 0, 0); \
            __builtin_amdgcn_global_load_lds((const GA unsigned*)(vbase + to_ + voff[i_]), (las_u32*)(ldsl + OFF_V + (b) * SHM_V + (wid + 8 * i_) * 1024), 16, 0, 0); } } while (0)
        ATT_DMA(0, it.kp_first);
        if (nt > 1) ATT_DMA(1, it.kp_first + it.kp_step);
        ATT_ITEM_LOADS();
        int cur = 0;
        for (int j = 0; j < nt; ++j) {
            const int kp0 = it.kp_first + j * it.kp_step;
            if (j + 1 < nt) asm volatile("s_waitcnt vmcnt(4) lgkmcnt(0)\n\ts_barrier" ::: "memory");
            else            asm volatile("s_waitcnt vmcnt(0) lgkmcnt(0)\n\ts_barrier" ::: "memory");
            if (MODE == 0 && SB_EARLY_EXIT && j > 0) {
                int alld = 1;
#pragma unroll
                for (int w = 0; w < 8; ++w) alld &= flags[((j - 1) & 1) * 8 + w];
                if (alld) break;
            }
            if (j + 2 < nt) { const int b2 = (cur >= 1) ? cur - 1 : cur + 2; ATT_DMA(b2, kp0 + 2 * it.kp_step); }
            bool active = wave_rows;
            if (it.rule == 1) active = active && (kp0 <= it.qpos0 + 32 * wid + 30) && !wdone;
            if (it.rule == 2) { const int ct = kp0 >> 6, cw = (it.qpos0 + 32 * wid) >> 6; active = active && (ct >= cw - 8) && (ct <= cw); }
            if (active) ATT_TILE(K_lds + cur * SHM_K, vb0 + cur * SHM_V);
            if (MODE == 0 && SB_EARLY_EXIT) {
                if (wave_rows && !wdone) { const bool rowdone = (carry < SB_DONE_LOG2) || (32 * wid + r32 >= it.nq); wdone = __all(rowdone); }
                if (lane == 0) flags[(j & 1) * 8 + wid] = wdone ? 1 : 0;
            }
            cur = (cur == NBUF - 1) ? 0 : cur + 1;
        }
        asm volatile("s_waitcnt vmcnt(0)" ::: "memory");
#undef ATT_DMA
    } else {
    const int sr = tid >> 4, sc = (tid & 15) * 8;
    const int vst0 = v_st(sr, sc), vst1 = v_st(32 + sr, sc), kst0 = KSWZ(sr, sc * 2), kst1 = KSWZ(32 + sr, sc * 2);
    f32x4 sK0a, sK0b, sK1a, sK1b, sV0a, sV0b, sV1a, sV1b;
#define ATT_LD(p, A, B, kbp, kfp) do { const int p_ = (p); const bool isb_ = (p_ >= it.pb_lo && p_ < it.pb_hi), isf_ = (p_ >= it.pf_lo && p_ < it.pf_hi); \
        const GA char* a0_ = isf_ ? (const GA char*)(kfp + (size_t)(p_ - it.pf_lo) * it.ldf + sc) : (const GA char*)(kbp + (size_t)(isb_ ? p_ - it.pb_lo : 0) * it.ldb + sc); \
        const f32x4 la_ = *reinterpret_cast<const GA f32x4*>(a0_); const f32x4 lb_ = *reinterpret_cast<const GA f32x4*>(a0_ + (isf_ ? 16 : 0)); \
        A = la_; B = lb_; } while (0)
#define ATT_CV(p, A, B, OUT) do { const int p_ = (p); const bool isb_ = (p_ >= it.pb_lo && p_ < it.pb_hi), isf_ = (p_ >= it.pf_lo && p_ < it.pf_hi); \
        u32x4 w_ = {cvtpk(A[0], A[1]), cvtpk(A[2], A[3]), cvtpk(B[0], B[1]), cvtpk(B[2], B[3])}; const u32x4 r_ = __builtin_bit_cast(u32x4, A); \
        w_.x = isf_ ? w_.x : (isb_ ? r_.x : 0u); w_.y = isf_ ? w_.y : (isb_ ? r_.y : 0u); w_.z = isf_ ? w_.z : (isb_ ? r_.z : 0u); w_.w = isf_ ? w_.w : (isb_ ? r_.w : 0u); \
        OUT = *reinterpret_cast<bf16x8*>(&w_); } while (0)
#define ATT_SLOAD(kp0) do { ATT_LD((kp0) + sr, sK0a, sK0b, it.kb, it.kf); ATT_LD((kp0) + 32 + sr, sK1a, sK1b, it.kb, it.kf); \
        ATT_LD((kp0) + sr, sV0a, sV0b, it.vb, it.vf); ATT_LD((kp0) + 32 + sr, sV1a, sV1b, it.vb, it.vf); } while (0)
#define ATT_SWRITE(b, kp0) do { bf16x8 t_; \
        ATT_CV((kp0) + sr, sK0a, sK0b, t_); *reinterpret_cast<bf16x8*>(K_lds + (b) * SHM_K + kst0) = t_; \
        ATT_CV((kp0) + 32 + sr, sK1a, sK1b, t_); *reinterpret_cast<bf16x8*>(K_lds + (b) * SHM_K + kst1) = t_; \
        ATT_CV((kp0) + sr, sV0a, sV0b, t_); *reinterpret_cast<bf16x8*>(V_lds + (b) * SHM_V + vst0) = t_; \
        ATT_CV((kp0) + 32 + sr, sV1a, sV1b, t_); *reinterpret_cast<bf16x8*>(V_lds + (b) * SHM_V + vst1) = t_; } while (0)
    sK0b = sK1b = sV0b = sV1b = (f32x4){0.f, 0.f, 0.f, 0.f};
    ATT_SLOAD(it.kp_first); ATT_SWRITE(0, it.kp_first);
    __syncthreads();
    for (int j = 0; j < nt; ++j) {
        const int kp0 = it.kp_first + j * it.kp_step, kpn = kp0 + it.kp_step, cur = j & 1;
        const bool more = (j + 1 < nt);
        if (more) ATT_SLOAD(kpn);
        bool active = wave_rows;
        if (it.rule == 1) active = active && (kp0 <= it.qpos0 + 32 * wid + 30) && !wdone;
        if (it.rule == 2) { const int ct = kp0 >> 6, cw = (it.qpos0 + 32 * wid) >> 6; active = active && (ct >= cw - 8) && (ct <= cw); }
        if (active) ATT_TILE(K_lds + cur * SHM_K, vb0 + cur * SHM_V);
        if (MODE == 0 && SB_EARLY_EXIT) {
            if (wave_rows && !wdone) { const bool rowdone = (carry < SB_DONE_LOG2) || (32 * wid + r32 >= it.nq); wdone = __all(rowdone); }
            if (lane == 0) flags[cur * 8 + wid] = wdone ? 1 : 0;
        }
        if (more) ATT_SWRITE(cur ^ 1, kpn);
        __syncthreads();
        if (MODE == 0 && SB_EARLY_EXIT) {
            int alld = 1;
#pragma unroll
            for (int w = 0; w < 8; ++w) alld &= flags[cur * 8 + w];
            if (alld) break;
        }
    }
#undef ATT_LD
#undef ATT_CV
#undef ATT_SLOAD
#undef ATT_SWRITE
    }
    if (wave_rows && (32 * wid + r32) < it.nq) {
        const float inv = (MODE == 1) ? __builtin_amdgcn_rcpf(l_reg) : 1.0f;
        const size_t row = (size_t)(32 * wid + r32);
        GA u16* orow = it.O + row * it.ldo + 4 * hi; const GA u16* grow = it.G + row * it.ldg + 4 * hi;
        u32x2 gv[16];
#pragma unroll
        for (int i = 0; i < 16; ++i) gv[i] = *reinterpret_cast<const GA u32x2*>(grow + 32 * (i >> 2) + 8 * (i & 3));
#pragma unroll
        for (int d0 = 0; d0 < 4; ++d0)
#pragma unroll
            for (int g = 0; g < 4; ++g) { const u32x2 gq = gv[4 * d0 + g];
                const float g0 = __uint_as_float(gq.x << 16), g1 = __uint_as_float(gq.x & 0xffff0000u), g2 = __uint_as_float(gq.y << 16), g3 = __uint_as_float(gq.y & 0xffff0000u);
                u32x2 w; w.x = cvtpk(o[d0][4 * g] * inv * g0, o[d0][4 * g + 1] * inv * g1); w.y = cvtpk(o[d0][4 * g + 2] * inv * g2, o[d0][4 * g + 3] * inv * g3);
                *reinterpret_cast<GA u32x2*>(orow + 32 * d0 + 8 * g) = w; }
    }
    __syncthreads();
}
#undef ATT_TILE
#undef ATT_ITEM_LOADS
#undef GA
}

constexpr int NWAVES = 8;
constexpr int N_LAUNCHES = MK_N_LAUNCHES;
constexpr int PER_PHASE = 6;

constexpr size_t al256(size_t x) { return (x + 255) & ~(size_t)255; }
constexpr size_t WS_CTL = 0, CTL_ZERO_BYTES = 65536, CTL_BYTES = 1u << 20;
constexpr size_t WS_WCAT = CTL_BYTES;
constexpr size_t WS_WUP  = WS_WCAT + (size_t)NCAT * DM * 2;
constexpr size_t WS_WOUT = WS_WUP + (size_t)DM * DM * 2;
constexpr size_t WS_ACAT = WS_WOUT + (size_t)DM * DM * 2;
constexpr size_t SZ768 = (size_t)MIN_ * 768 * 2, SZ512 = (size_t)MIN_ * 512 * 2;
constexpr size_t WS_QSB = WS_ACAT + (size_t)MA * DM * 2, WS_KSB = WS_QSB + SZ768, WS_VSB = WS_KSB + SZ768, WS_GSB = WS_VSB + SZ768;
constexpr size_t WS_QBD = WS_GSB + SZ768, WS_KBD = WS_QBD + SZ768, WS_VBD = WS_KBD + SZ768, WS_GBD = WS_VBD + SZ768;
constexpr size_t WS_QMM = WS_GBD + SZ768, WS_GMM = WS_QMM + SZ512;
constexpr size_t WS_MG  = WS_GMM + SZ512;
constexpr size_t WS_MK  = WS_MG + (size_t)MIN_ * 6144 * 2, WS_MV = WS_MK + (size_t)512 * 512 * 2;
constexpr size_t WS_AUP = WS_MV + (size_t)512 * 512 * 2;
constexpr size_t WS_SSQ = WS_AUP + (size_t)MIN_ * DM * 2;
constexpr size_t WS_SSQS = WS_SSQ + (size_t)MIN_ * 32 * 4;
constexpr size_t WS_XBUF = WS_SSQS + (size_t)MS * 128 * 4;
constexpr size_t WS_YB = WS_XBUF + (size_t)MP * 8 * 4;
constexpr size_t WS_KBC = WS_YB, WS_VBC = WS_KBC + (size_t)DB * 576 * 768 * 2, WS_MKC = WS_VBC + (size_t)DB * 576 * 768 * 2, WS_MVC = WS_MKC + (size_t)DB * NMEM * 512 * 2;
static_assert(WS_MVC + (size_t)DB * NMEM * 512 * 2 <= WS_YB + (size_t)MP * DM * 2, "decode caches inside the YB region");
constexpr size_t WS_END = WS_YB + (size_t)MP * DM * 2;
static_assert(WS_WCAT % 256 == 0 && WS_QSB % 256 == 0 && WS_MG % 256 == 0 && WS_AUP % 256 == 0 && WS_SSQ % 256 == 0, "alignment");
constexpr int CW_TMO = 0, CW_WORK = 64, CW_BAR = 4096, CW_PANEL = 8192;
constexpr int OUT_ELEMS = 32112640;

constexpr int RING_BYTES = 131072, LDSCTL_OFF = RING_BYTES, MISC_OFF = LDSCTL_OFF + 320, STG_OFF = 147456, LDS_BYTES = 163840;
static_assert(att::ATT_LDS <= RING_BYTES, "attention scratch inside the ring region");

#define GAS __attribute__((address_space(1)))
#define LAS __attribute__((address_space(3)))
typedef unsigned short bf16;
typedef unsigned v4u __attribute__((ext_vector_type(4)));
typedef float f32x4 __attribute__((ext_vector_type(4)));
typedef GAS unsigned gu32;
#define RLX_AGENT __ATOMIC_RELAXED, __HIP_MEMORY_SCOPE_AGENT
#define LDS_WAIT() asm volatile("s_waitcnt lgkmcnt(0)" ::: "memory")
__device__ __forceinline__ unsigned pk2(float lo, float hi) { return pg8::cvt_pk_bf16(lo, hi); }

#define XB_TMO      128
#define XB_XCNT(j)  (256  + 64 * (j))
#define XB_XSUB(j)  (1280 + 64 * (j))
#define XB_XGEN(j)  (2304 + 64 * (j))
#define XB_TOP      3328
#define XB_TOPGEN   3392
#define XCD_BAR_WORDS 3456
#define XB_SPIN_CAP (1u << 18)
__device__ __forceinline__ unsigned xb_ld(unsigned* p)              { return __hip_atomic_load(p, __ATOMIC_RELAXED, __HIP_MEMORY_SCOPE_AGENT); }
__device__ __forceinline__ unsigned xb_add(unsigned* p, unsigned v) { return __hip_atomic_fetch_add(p, v, __ATOMIC_RELAXED, __HIP_MEMORY_SCOPE_AGENT); }
__device__ __forceinline__ unsigned xb_xcc_id() { return (unsigned)__builtin_amdgcn_s_getreg((3 << 11) | 20) & 0xFu; }
#define XB_SPIN(cond, bar) do { unsigned _sp = 0; while (cond) { __builtin_amdgcn_s_sleep(1); \
    if ((++_sp & 255u) == 0u) { if (xb_ld(&(bar)[XB_TMO])) break; if (_sp > XB_SPIN_CAP) { atomicAdd(&(bar)[XB_TMO], 1u); break; } } } } while (0)
struct XcdBarrier { unsigned* bar; unsigned x; volatile LAS unsigned* st; };
__device__ __forceinline__ XcdBarrier xcd_barrier_post(unsigned* bar, volatile LAS unsigned* st) {
    XcdBarrier b; b.bar = bar; b.x = xb_xcc_id(); b.st = st;
    if (threadIdx.x == 0) (void)xb_add(&bar[XB_XCNT(b.x)], 1u);
    return b;
}
__device__ __forceinline__ void xcd_barrier_complete(unsigned* bar, unsigned x, unsigned& nloc, unsigned& nx) {
    const unsigned G = gridDim.x * gridDim.y * gridDim.z;
    unsigned sum, cnt, mine, sp = 0u;
    for (;;) {
        sum = 0u; cnt = 0u; mine = 0u;
#pragma unroll
        for (unsigned j = 0; j < 16; ++j) { const unsigned c = xb_ld(&bar[XB_XCNT(j)]); sum += c; cnt += (c > 0u) ? 1u : 0u; mine = (j == x) ? c : mine; }
        if (sum == G) break;
        __builtin_amdgcn_s_sleep(1);
        if ((++sp & 255u) == 0u) { if (xb_ld(&bar[XB_TMO])) break; if (sp > XB_SPIN_CAP) { atomicAdd(&bar[XB_TMO], 1u); break; } }
    }
    nloc = mine > 0u ? mine : 1u; nx = cnt > 0u ? cnt : 1u;
}
__device__ __forceinline__ void xcd_barrier(const XcdBarrier& b) {
    asm volatile("s_waitcnt vmcnt(0)" ::: "memory");
    __syncthreads();
    if (threadIdx.x == 0) {
        unsigned* bar = b.bar;
        __builtin_amdgcn_s_waitcnt(0);
        unsigned nloc = b.st[0], nx = b.st[1];
        if (nloc == 0u) { xcd_barrier_complete(bar, b.x, nloc, nx); b.st[0] = nloc; b.st[1] = nx; }
        const unsigned old = xb_add(&bar[XB_XSUB(b.x)], 1u);
        const unsigned gen = old / nloc;
        if (old + 1u == (gen + 1u) * nloc) {
            __builtin_amdgcn_fence(__ATOMIC_RELEASE, "agent");
            asm volatile("s_waitcnt vmcnt(0)" ::: "memory");
            const unsigned og = xb_add(&bar[XB_TOP], 1u);
            const unsigned tg = og / nx;
            if (og + 1u == (tg + 1u) * nx) xb_add(&bar[XB_TOPGEN], 1u);
            else XB_SPIN(xb_ld(&bar[XB_TOPGEN]) == tg, bar);
            __builtin_amdgcn_fence(__ATOMIC_ACQUIRE, "agent");
            xb_add(&bar[XB_XGEN(b.x)], 1u);
            asm volatile("s_waitcnt vmcnt(0)" ::: "memory");
        } else {
            XB_SPIN(xb_ld(&bar[XB_XGEN(b.x)]) == gen, bar);
            __builtin_amdgcn_fence(__ATOMIC_ACQUIRE, "agent");
            asm volatile("s_waitcnt vmcnt(0)" ::: "memory");
        }
    }
    __syncthreads();
}

struct Frame {
    LAS unsigned char* lds;
    volatile LAS unsigned* MISC;
    gu32* ctl;
    int vcu, G;
    const float *x_prompt, *x_sample, *c_sbk, *c_sbv, *c_bdk, *c_bdv, *c_mk, *c_mv, *mem_prompt, *g_pre, *w_in, *rel_bias, *g_mem, *w_mem_kv, *w_up_sb, *w_up_band, *w_up_mem, *w_out, *g_post;
    float* out;
    bf16 *WCAT, *WUP, *WOUT, *ACAT, *QSB, *KSB, *VSB, *GSB, *QBD, *KBD, *VBD, *GBD, *QMM, *GMM, *MG, *MK, *MV, *AUP, *MERGED;
    float* SSQ; float* SSQS; bf16* YB; bf16 *KBC, *VBC, *MKC, *MVC;
};

__device__ __forceinline__ int fresh_tid() { int t = threadIdx.x; asm volatile("" : "+v"(t)); return t; }
__device__ __forceinline__ float wave_sum(float v) {
#pragma unroll
    for (int o = 1; o < 64; o <<= 1) v += __shfl_xor(v, o);
    return v;
}
__device__ __forceinline__ void p0_transpose_item(const float* W, int N, bf16* WT, int ldt, int row_off, int col_off, LAS float* scr, int item, int lane) {
    const int nblk = N / 32, kb = item / nblk, nb = item % nblk, k0 = 64 * kb, n0 = 32 * nb;
    f32x4 wv[8];
#pragma unroll
    for (int i = 0; i < 8; ++i) wv[i] = *(const GAS f32x4*)(W + (size_t)(k0 + (lane >> 3) + 8 * i) * N + n0 + 4 * (lane & 7));
#pragma unroll
    for (int i = 0; i < 8; ++i) { LAS float* d = scr + ((lane >> 3) + 8 * i) * 33 + 4 * (lane & 7); d[0] = wv[i].x; d[1] = wv[i].y; d[2] = wv[i].z; d[3] = wv[i].w; }
    LDS_WAIT(); asm volatile("" ::: "memory");
    const int c = lane & 7;
#pragma unroll
    for (int j = 0; j < 4; ++j) { const int n = (lane >> 3) + 8 * j; const LAS float* s = scr + (8 * c) * 33 + n;
        v4u o; o.x = pk2(s[0 * 33], s[1 * 33]); o.y = pk2(s[2 * 33], s[3 * 33]); o.z = pk2(s[4 * 33], s[5 * 33]); o.w = pk2(s[6 * 33], s[7 * 33]);
        *(GAS v4u*)(WT + (size_t)(row_off + n0 + n) * ldt + col_off + k0 + 8 * c) = o; }
    LDS_WAIT(); asm volatile("" ::: "memory");
}
__device__ __forceinline__ void rms_row_to_bf16(const float* xrow, const float* g, bf16* orow, int lane) {
    const GAS f32x4* xr = (const GAS f32x4*)xrow + lane; const GAS f32x4* gr = (const GAS f32x4*)g + lane;
    f32x4 v[8]; float s = 0.f;
#pragma unroll
    for (int j = 0; j < 8; ++j) { v[j] = xr[64 * j]; s += (v[j].x * v[j].x + v[j].y * v[j].y) + (v[j].z * v[j].z + v[j].w * v[j].w); }
    const float r = 1.0f / sqrtf(wave_sum(s) * (1.0f / DM) + RMS_EPS);
    GAS unsigned long long* o8 = (GAS unsigned long long*)orow + lane;
#pragma unroll
    for (int j = 0; j < 8; ++j) { const f32x4 gv = gr[64 * j];
        o8[64 * j] = (unsigned long long)pk2(v[j].x * r * gv.x, v[j].y * r * gv.y) | ((unsigned long long)pk2(v[j].z * r * gv.z, v[j].w * r * gv.w) << 32); }
}
__device__ __forceinline__ void p0_t_load(const float* W, int N, int item, int lane, f32x4 (&wv)[8]) {
    const int nblk = N / 32, kb = item / nblk, nb = item % nblk, k0 = 64 * kb, n0 = 32 * nb;
#pragma unroll
    for (int i = 0; i < 8; ++i) wv[i] = *(const GAS f32x4*)(W + (size_t)(k0 + (lane >> 3) + 8 * i) * N + n0 + 4 * (lane & 7));
}
__device__ __forceinline__ int wcat_row(int c) {
    int kind, idx;
    if (c >= 7168) { const int d = c - 7168; kind = d >> 11; idx = d & 2047; }
    else { const int p = c >> 8;
        if (p < 9) return c;
        if (p < 12) { kind = 3; idx = c - 2304; }
        else if (p < 21) return c - 768;
        else if (p < 24) { kind = 3; idx = 768 + (c - 5376); }
        else if (p < 26) return c - 1536;
        else { kind = 3; idx = 1536 + (c - 6656); } }
    const int t = idx >> 6, q = idx & 63;
    return (20 + t) * 256 + 128 * (kind >> 1) + 4 * (kind & 1) + 32 * (q >> 4) + 8 * ((q >> 2) & 3) + (q & 3);
}
__device__ __forceinline__ float wcat_scale(int c) { const int p = c >> 8; return (p < 3 || (p >= 12 && p < 15) || p == 24 || p == 25) ? QSCALE : ((p >= 9 && p < 12) || p >= 21) ? -LOG2E : 1.0f; }
template <bool MAP>
__device__ __forceinline__ void p0_t_finish(const f32x4 (&wv)[8], int N, bf16* WT, int ldt, int row_off, int col_off, LAS float* scr, int item, int lane) {
    const int nblk = N / 32, kb = item / nblk, nb = item % nblk, k0 = 64 * kb, n0 = 32 * nb;
#pragma unroll
    for (int i = 0; i < 8; ++i) { LAS float* d = scr + ((lane >> 3) + 8 * i) * 33 + 4 * (lane & 7); d[0] = wv[i].x; d[1] = wv[i].y; d[2] = wv[i].z; d[3] = wv[i].w; }
    LDS_WAIT(); asm volatile("" ::: "memory");
    const int c = lane & 7;
#pragma unroll
    for (int j = 0; j < 4; ++j) { const int n = (lane >> 3) + 8 * j; const LAS float* s = scr + (8 * c) * 33 + n;
        const float sc = MAP ? wcat_scale(n0 + n) : 1.0f;
        v4u o; o.x = pk2(s[0 * 33] * sc, s[1 * 33] * sc); o.y = pk2(s[2 * 33] * sc, s[3 * 33] * sc); o.z = pk2(s[4 * 33] * sc, s[5 * 33] * sc); o.w = pk2(s[6 * 33] * sc, s[7 * 33] * sc);
        *(GAS v4u*)(WT + (size_t)(MAP ? wcat_row(n0 + n) : row_off + n0 + n) * ldt + col_off + k0 + 8 * c) = o; }
    LDS_WAIT(); asm volatile("" ::: "memory");
}
__device__ __forceinline__ void rms_load(const float* xrow, int lane, f32x4 (&v)[8]) {
    const GAS f32x4* xr = (const GAS f32x4*)xrow + lane;
#pragma unroll
    for (int j = 0; j < 8; ++j) v[j] = xr[64 * j];
}
__device__ __forceinline__ void rms_finish(const f32x4 (&v)[8], const f32x4 (&gv)[8], bf16* orow, int lane) {
    float s = 0.f;
#pragma unroll
    for (int j = 0; j < 8; ++j) s += (v[j].x * v[j].x + v[j].y * v[j].y) + (v[j].z * v[j].z + v[j].w * v[j].w);
    const float r = 1.0f / sqrtf(wave_sum(s) * (1.0f / DM) + RMS_EPS);
    GAS unsigned long long* o8 = (GAS unsigned long long*)orow + lane;
#pragma unroll
    for (int j = 0; j < 8; ++j) o8[64 * j] = (unsigned long long)pk2(v[j].x * r * gv[j].x, v[j].y * r * gv[j].y) | ((unsigned long long)pk2(v[j].z * r * gv[j].z, v[j].w * r * gv[j].w) << 32);
}
__device__ __forceinline__ void p0_prologue(Frame& F) {
    const int tid_ = fresh_tid(), lane_ = tid_ & 63, wave_ = __builtin_amdgcn_readfirstlane(tid_ >> 6);
    LAS float* scr = (LAS float*)(F.lds + wave_ * 16384);
    const int gw = F.vcu * NWAVES + wave_, NGW = F.G * NWAVES;
    constexpr int I_IN = 32 * (INW / 32), I_MEM = 32 * (1024 / 32), I_USB = 12 * 64, I_UBD = 12 * 64, I_UMM = 8 * 64, I_OUT = 32 * 64;
    constexpr int NI = I_IN + I_MEM;
#define P0_TLOAD(buf, it_) do { if ((it_) < I_IN) p0_t_load(F.w_in, INW, (it_), lane_, buf); else p0_t_load(F.w_mem_kv, 1024, (it_) - I_IN, lane_, buf); } while (0)
#define P0_TFIN(buf, it_) do { if ((it_) < I_IN) p0_t_finish<true>(buf, INW, F.WCAT, DM, 0, 0, scr, (it_), lane_); else p0_t_finish<false>(buf, 1024, F.WCAT, DM, INW, 0, scr, (it_) - I_IN, lane_); } while (0)
    { f32x4 wa[8], wb[8]; int it = gw;
      if (it < NI) P0_TLOAD(wa, it);
      while (it < NI) {
          int it2 = it + NGW; if (it2 < NI) P0_TLOAD(wb, it2);
          P0_TFIN(wa, it); it = it2; if (it >= NI) break;
          it2 = it + NGW; if (it2 < NI) P0_TLOAD(wa, it2);
          P0_TFIN(wb, it); it = it2; } }
#undef P0_TLOAD
#undef P0_TFIN
    if (!LATE_WT) for (int it = gw; it < I_USB + I_UBD + I_UMM + I_OUT; it += NGW) {
        int r = it;
        if (r < I_USB) { p0_transpose_item(F.w_up_sb, DM, F.WUP, DM, 0, 0, scr, r, lane_); continue; } r -= I_USB;
        if (r < I_UBD) { p0_transpose_item(F.w_up_band, DM, F.WUP, DM, 0, 768, scr, r, lane_); continue; } r -= I_UBD;
        if (r < I_UMM) { p0_transpose_item(F.w_up_mem, DM, F.WUP, DM, 0, 1536, scr, r, lane_); continue; } r -= I_UMM;
        p0_transpose_item(F.w_out, DM, F.WOUT, DM, 0, 0, scr, r, lane_);
    }
    { f32x4 gv[8], va[8], vb[8]; const GAS f32x4* gr = (const GAS f32x4*)F.g_pre + lane_;
#pragma unroll
      for (int j = 0; j < 8; ++j) gv[j] = gr[64 * j];
      int m = gw;
      if (m < MP) rms_load(F.x_prompt + (size_t)m * DM, lane_, va);
      while (m < MP) {
          int m2 = m + NGW; if (m2 < MP) rms_load(F.x_prompt + (size_t)m2 * DM, lane_, vb);
          rms_finish(va, gv, F.ACAT + (size_t)m * DM, lane_); m = m2; if (m >= MP) break;
          m2 = m + NGW; if (m2 < MP) rms_load(F.x_prompt + (size_t)m2 * DM, lane_, va);
          rms_finish(vb, gv, F.ACAT + (size_t)m * DM, lane_); m = m2; } }
    for (int m = MP + gw; m < MA; m += NGW) {
        bf16* orow = F.ACAT + (size_t)m * DM;
        if (m < MREAL) rms_row_to_bf16(F.x_sample + (size_t)(m - MP) * DM, F.g_pre, orow, lane_);
        else if (m < MIN_) {
            GAS v4u* o = (GAS v4u*)orow + lane_; GAS v4u* o2 = (GAS v4u*)(F.AUP + (size_t)m * DM) + lane_;
#pragma unroll
            for (int j = 0; j < 4; ++j) { o[64 * j] = (v4u){0u, 0u, 0u, 0u}; o2[64 * j] = (v4u){0u, 0u, 0u, 0u}; }
        }
        else rms_row_to_bf16(F.mem_prompt + (size_t)(m - MMEM0) * DM, F.g_mem, orow, lane_);
    }
}
constexpr int LATE_ITEMS = 128;
__device__ __forceinline__ void late_transpose_item(Frame& F, int j) {
    const int tid_ = fresh_tid(), lane_ = tid_ & 63, wave_ = __builtin_amdgcn_readfirstlane(tid_ >> 6);
    LAS float* scr = (LAS float*)(F.lds + wave_ * 16384);
    constexpr int I_USB = 12 * 64, I_UBD = 12 * 64, I_UMM = 8 * 64;
#pragma unroll 1
    for (int q = 0; q < 4; ++q) {
        int r = (j * 8 + wave_) * 4 + q;
        if (r < I_USB) { p0_transpose_item(F.w_up_sb, DM, F.WUP, DM, 0, 0, scr, r, lane_); continue; } r -= I_USB;
        if (r < I_UBD) { p0_transpose_item(F.w_up_band, DM, F.WUP, DM, 0, 768, scr, r, lane_); continue; } r -= I_UBD;
        if (r < I_UMM) { p0_transpose_item(F.w_up_mem, DM, F.WUP, DM, 0, 1536, scr, r, lane_); continue; } r -= I_UMM;
        p0_transpose_item(F.w_out, DM, F.WOUT, DM, 0, 0, scr, r, lane_);
    }
}
constexpr int CV_BD = DB * 576 * 768 / 32768, CV_MM = DB * NMEM * 512 / 32768, SLACK_ITEMS = LATE_ITEMS + 2 * CV_BD + 2 * CV_MM;
static_assert(DB * 576 * 768 % 32768 == 0 && DB * NMEM * 512 % 32768 == 0, "conversion item size");
template <bool BAND>
__device__ __forceinline__ void slack_convert(const float* src, bf16* dst, int jj, int tid_) {
    constexpr int ld = BAND ? 768 : 512, rows_d = BAND ? 576 : NMEM, rows_s = BAND ? 512 : NMEM;
    f32x4 va[8], vb[8];
#pragma unroll
    for (int it = 0; it < 8; ++it) { const int e = (jj * 4096 + it * 512 + tid_) * 8;
        const int col = e % ld, rowd = e / ld, b = rowd / rows_d, row = rowd % rows_d;
        const float* s = src + ((size_t)(b * rows_s + (row < rows_s ? row : 0)) * ld + col);
        va[it] = *(const GAS f32x4*)s; vb[it] = *(const GAS f32x4*)(s + 4); }
#pragma unroll
    for (int it = 0; it < 8; ++it) { const int e = (jj * 4096 + it * 512 + tid_) * 8; const int row = (e / ld) % rows_d;
        v4u w; w.x = pk2(va[it].x, va[it].y); w.y = pk2(va[it].z, va[it].w); w.z = pk2(vb[it].x, vb[it].y); w.w = pk2(vb[it].z, vb[it].w);
        if (row >= rows_s + DS) w = (v4u){0u, 0u, 0u, 0u};
        if (row < rows_s || row >= rows_s + DS) *(GAS v4u*)(dst + e) = w; }
}
__device__ __forceinline__ void slack_item(Frame& F, int j) {
    if (j < LATE_ITEMS) { late_transpose_item(F, j); return; }
    j -= LATE_ITEMS;
    const int tid_ = fresh_tid();
    if (j < CV_BD) slack_convert<true>(F.c_bdk, F.KBC, j, tid_);
    else if (j < 2 * CV_BD) slack_convert<true>(F.c_bdv, F.VBC, j - CV_BD, tid_);
    else if (j < 2 * CV_BD + CV_MM) slack_convert<false>(F.c_mk, F.MKC, j - 2 * CV_BD, tid_);
    else slack_convert<false>(F.c_mv, F.MVC, j - 2 * CV_BD - CV_MM, tid_);
}
struct P5Row { float sq; unsigned long long yb[8]; f32x4 xv[8]; };
__device__ __forceinline__ void p5_load(Frame& F, int m, int lane, float& sq, unsigned long long (&yb)[8], f32x4 (&xv)[8]) {
    sq = (lane < 32) ? F.SSQ[(size_t)m * 32 + lane] : 0.f;
    const GAS unsigned long long* yb8 = (const GAS unsigned long long*)(F.YB + (size_t)m * DM) + lane; const GAS f32x4* x4 = (const GAS f32x4*)(F.x_prompt + (size_t)m * DM) + lane;
#pragma unroll
    for (int j = 0; j < 8; ++j) { yb[j] = yb8[64 * j]; xv[j] = x4[64 * j]; }
}
__device__ __forceinline__ void p5_finish(Frame& F, int m, int lane, float sq, const unsigned long long (&yb)[8], const f32x4 (&xv)[8], const f32x4 (&gv)[8]) {
    const float r = 1.0f / sqrtf(wave_sum(sq) * (1.0f / DM) + RMS_EPS);
    GAS f32x4* y4 = (GAS f32x4*)(F.out + (size_t)m * DM) + lane;
#pragma unroll
    for (int j = 0; j < 8; ++j) { const unsigned long long yq = yb[j];
        const f32x4 yv = {__uint_as_float((unsigned)yq << 16), __uint_as_float((unsigned)yq & 0xffff0000u), __uint_as_float((unsigned)(yq >> 32) << 16), __uint_as_float((unsigned)(yq >> 32) & 0xffff0000u)};
        __builtin_nontemporal_store(xv[j] + yv * r * gv[j], &y4[64 * j]); }
}
__device__ __forceinline__ void p5_final(Frame& F) {
    const int tid_ = fresh_tid(), lane_ = tid_ & 63, wave_ = __builtin_amdgcn_readfirstlane(tid_ >> 6);
    const int gw = F.vcu * NWAVES + wave_, NGW = F.G * NWAVES;
    f32x4 gv[8]; { const GAS f32x4* g4 = (const GAS f32x4*)F.g_post + lane_;
#pragma unroll
        for (int j = 0; j < 8; ++j) gv[j] = g4[64 * j]; }
    if (!FUSE_RMS) {
        float sa, sb; unsigned long long ya[8], yb[8]; f32x4 xa[8], xb[8]; int m = gw;
        if (m < MP) p5_load(F, m, lane_, sa, ya, xa);
        while (m < MP) {
            int m2 = m + NGW; if (m2 < MP) p5_load(F, m2, lane_, sb, yb, xb);
            p5_finish(F, m, lane_, sa, ya, xa, gv); m = m2; if (m >= MP) break;
            m2 = m + NGW; if (m2 < MP) p5_load(F, m2, lane_, sa, ya, xa);
            p5_finish(F, m, lane_, sb, yb, xb, gv); m = m2; }
    }
    for (int m = MP + gw; m < MREAL; m += NGW) {
        float s = F.SSQS[(size_t)(m - MP) * 128 + lane_] + F.SSQS[(size_t)(m - MP) * 128 + 64 + lane_];
        s = wave_sum(s);
        const float r = 1.0f / sqrtf(s * (1.0f / DM) + RMS_EPS);
        GAS f32x4* y4 = (GAS f32x4*)(F.out + (size_t)16777216 + (size_t)(m - MP) * DM) + lane_; const GAS f32x4* x4 = (const GAS f32x4*)(F.x_sample + (size_t)(m - MP) * DM) + lane_;
#pragma unroll
        for (int j = 0; j < 8; ++j) { const f32x4 yv = y4[64 * j], xv = x4[64 * j]; y4[64 * j] = xv + yv * r * gv[j]; }
    }
}

constexpr int IT_BDP = 192, IT_BDS = 48, IT_SBP = 192, IT_SBS = 48, IT_MMP = 128, IT_MMS = 32;
constexpr int IT_TOTAL = IT_BDP + IT_BDS + IT_SBP + IT_SBS + IT_MMP + IT_MMS;
struct ArgsK { const void* in[19]; float* out; unsigned char* ws; int ph_lo, ph_hi; };
struct ItemSrc {
    const ArgsK* ka; unsigned char* ws;
    __device__ __forceinline__ GAS bf16* W(size_t off) const { return (GAS bf16*)(ws + off); }
    __device__ __forceinline__ const GAS float* I(int k) const { return (const GAS float*)ka->in[k]; }
};
__device__ __forceinline__ att::Item make_item(const ItemSrc& S, int idx) {
    GAS bf16* const QSB = S.W(WS_QSB); GAS bf16* const KSB = S.W(WS_KSB); GAS bf16* const VSB = S.W(WS_VSB); GAS bf16* const GSB = S.W(WS_GSB);
    GAS bf16* const QBD = S.W(WS_QBD); GAS bf16* const KBD = S.W(WS_KBD); GAS bf16* const VBD = S.W(WS_VBD); GAS bf16* const GBD = S.W(WS_GBD);
    GAS bf16* const QMM = S.W(WS_QMM); GAS bf16* const GMM = S.W(WS_GMM); GAS bf16* const MK = S.W(WS_MK); GAS bf16* const MV = S.W(WS_MV); GAS bf16* const AUP = S.W(WS_AUP);
    att::Item it; it.dma = 0; it.bias = nullptr; it.kf = nullptr; it.vf = nullptr; it.ldf = 0; it.pf_lo = 0; it.pf_hi = 0; it.kb = nullptr; it.vb = nullptr; it.ldb = 0; it.pb_lo = 0; it.pb_hi = 0;
    if (idx < 48) idx += 192; else if (idx < 96) idx += 432 - 48; else if (idx < 128) idx += 608 - 96; else if (idx < 320) idx -= 128; else if (idx < 512) idx += 240 - 320; else idx += 480 - 512;
    if (idx < IT_BDP) {
        const int b = idx / 96, h = (idx / 16) % 6, cg = idx % 16; const size_t row0 = (size_t)b * SEQ + 256 * cg;
        it.mode = 1; it.rule = 2; it.Q = QBD + row0 * 768 + h * HD; it.ldq = 768; it.nq = 256; it.qpos0 = 256 * cg;
        it.kb = KBD + (size_t)b * SEQ * 768 + h * HD; it.vb = VBD + (size_t)b * SEQ * 768 + h * HD; it.ldb = 768; it.pb_lo = 0; it.pb_hi = SEQ;
        it.pv_lo = 0; it.pv_hi = SEQ; const int c_lo = (4 * cg - 8) > 0 ? (4 * cg - 8) : 0;
        it.kp_first = 64 * c_lo; it.kp_step = 64; it.ntiles = 4 * cg + 4 - c_lo; it.bias = S.I(11) + h * 513; it.dma = 1;
        it.O = AUP + row0 * DM + 768 + h * HD; it.ldo = DM; it.G = GBD + row0 * 768 + h * HD; it.ldg = 768; return it; }
    idx -= IT_BDP;
    if (idx < IT_BDS) {
        const int b = idx / 6, h = idx % 6; const size_t row0 = (size_t)MP + b * DS;
        it.mode = 1; it.rule = 0; it.Q = QBD + row0 * 768 + h * HD; it.ldq = 768; it.nq = DS; it.qpos0 = PAST;
        if (SLACK_P1) {
            it.kb = S.W(WS_KBC) + (size_t)b * 576 * 768 + h * HD; it.vb = S.W(WS_VBC) + (size_t)b * 576 * 768 + h * HD; it.ldb = 768; it.pb_lo = PAST - 512; it.pb_hi = PAST - 512 + 576; it.dma = 1;
        } else {
            it.kb = KBD + row0 * 768 + h * HD; it.vb = VBD + row0 * 768 + h * HD; it.ldb = 768; it.pb_lo = PAST; it.pb_hi = PAST + DS;
            it.kf = S.I(4) + (size_t)b * 512 * 768 + h * HD; it.vf = S.I(5) + (size_t)b * 512 * 768 + h * HD; it.ldf = 768; it.pf_lo = PAST - 512; it.pf_hi = PAST; }
        it.pv_lo = PAST - 512; it.pv_hi = PAST + DS; it.kp_first = PAST - 512; it.kp_step = 64; it.ntiles = 9; it.bias = S.I(11) + h * 513;
        it.O = AUP + row0 * DM + 768 + h * HD; it.ldo = DM; it.G = GBD + row0 * 768 + h * HD; it.ldg = 768; return it; }
    idx -= IT_BDS;
    if (idx < IT_SBP) {
        const int b = idx % 2, h = (idx / 2) % 6, qb = 15 - idx / 12; const size_t row0 = (size_t)b * SEQ + 256 * qb;
        it.mode = 0; it.rule = 1; it.Q = QSB + row0 * 768 + h * HD; it.ldq = 768; it.nq = 256; it.qpos0 = 256 * qb;
        it.kb = KSB + (size_t)b * SEQ * 768 + h * HD; it.vb = VSB + (size_t)b * SEQ * 768 + h * HD; it.ldb = 768; it.pb_lo = 0; it.pb_hi = SEQ;
        it.pv_lo = 0; it.pv_hi = SEQ; it.kp_first = 64 * (4 * qb + 3); it.kp_step = -64; it.ntiles = 4 * qb + 4; it.dma = 1;
        it.O = AUP + row0 * DM + h * HD; it.ldo = DM; it.G = GSB + row0 * 768 + h * HD; it.ldg = 768; return it; }
    idx -= IT_SBP;
    if (idx < IT_SBS) {
        const int b = idx / 6, h = idx % 6; const size_t row0 = (size_t)MP + b * DS;
        it.mode = 0; it.rule = 1; it.Q = QSB + row0 * 768 + h * HD; it.ldq = 768; it.nq = DS; it.qpos0 = PAST;
        it.kb = KSB + row0 * 768 + h * HD; it.vb = VSB + row0 * 768 + h * HD; it.ldb = 768; it.pb_lo = PAST; it.pb_hi = PAST + DS;
        it.kf = S.I(2) + (size_t)b * PAST * 768 + h * HD; it.vf = S.I(3) + (size_t)b * PAST * 768 + h * HD; it.ldf = 768; it.pf_lo = 0; it.pf_hi = PAST;
        it.pv_lo = 0; it.pv_hi = PAST + DS; it.kp_first = PAST + DS - 64; it.kp_step = -64; it.ntiles = (PAST + DS + 63) / 64;
        it.O = AUP + row0 * DM + h * HD; it.ldo = DM; it.G = GSB + row0 * 768 + h * HD; it.ldg = 768; return it; }
    idx -= IT_SBS;
    if (idx < IT_MMP) {
        const int b = idx / 64, h = (idx / 16) % 4, qb = idx % 16; const size_t row0 = (size_t)b * SEQ + 256 * qb;
        it.mode = 1; it.rule = 0; it.Q = QMM + row0 * 512 + h * HD; it.ldq = 512; it.nq = 256; it.qpos0 = 0;
        it.kb = MK + (size_t)b * NMEM * 512 + h * HD; it.vb = MV + (size_t)b * NMEM * 512 + h * HD; it.ldb = 512; it.pb_lo = 0; it.pb_hi = NMEM;
        it.pv_lo = 0; it.pv_hi = NMEM; it.kp_first = 0; it.kp_step = 64; it.ntiles = 4; it.dma = 1;
        it.O = AUP + row0 * DM + 1536 + h * HD; it.ldo = DM; it.G = GMM + row0 * 512 + h * HD; it.ldg = 512; return it; }
    idx -= IT_MMP;
    {
        const int b = idx / 4, h = idx % 4; const size_t row0 = (size_t)MP + b * DS;
        it.mode = 1; it.rule = 0; it.Q = QMM + row0 * 512 + h * HD; it.ldq = 512; it.nq = DS; it.qpos0 = 0;
        if (SLACK_P1) { it.kb = S.W(WS_MKC) + (size_t)b * NMEM * 512 + h * HD; it.vb = S.W(WS_MVC) + (size_t)b * NMEM * 512 + h * HD; it.ldb = 512; it.pb_lo = 0; it.pb_hi = NMEM; it.dma = 1; }
        else { it.kf = S.I(6) + (size_t)b * NMEM * 512 + h * HD; it.vf = S.I(7) + (size_t)b * NMEM * 512 + h * HD; it.ldf = 512; it.pf_lo = 0; it.pf_hi = NMEM; }
        it.pv_lo = 0; it.pv_hi = NMEM; it.kp_first = 0; it.kp_step = 64; it.ntiles = 4;
        it.O = AUP + row0 * DM + 1536 + h * HD; it.ldo = DM; it.G = GMM + row0 * 512 + h * HD; it.ldg = 512; return it; }
}

struct Args { const void* in[19]; float* out; unsigned char* ws; int ph_lo, ph_hi; };
__global__ void __launch_bounds__(NWAVES * 64, 2) fwd_megakernel(Args args) {
    extern __shared__ __attribute__((aligned(16))) unsigned char lds[];
    Frame F;
    F.lds = (LAS unsigned char*)lds;
    F.MISC = (volatile LAS unsigned*)(F.lds + MISC_OFF);
    F.G = gridDim.x; { const int bx = blockIdx.x; F.vcu = (F.G % 8 == 0) ? (bx % 8) * (F.G / 8) + bx / 8 : bx; }
    unsigned char* ws = args.ws;
    F.ctl = (gu32*)(ws + WS_CTL);
    F.x_prompt = (const float*)args.in[0]; F.x_sample = (const float*)args.in[1]; F.c_sbk = (const float*)args.in[2]; F.c_sbv = (const float*)args.in[3];
    F.c_bdk = (const float*)args.in[4]; F.c_bdv = (const float*)args.in[5]; F.c_mk = (const float*)args.in[6]; F.c_mv = (const float*)args.in[7];
    F.mem_prompt = (const float*)args.in[8]; F.g_pre = (const float*)args.in[9]; F.w_in = (const float*)args.in[10]; F.rel_bias = (const float*)args.in[11];
    F.g_mem = (const float*)args.in[12]; F.w_mem_kv = (const float*)args.in[13]; F.w_up_sb = (const float*)args.in[14]; F.w_up_band = (const float*)args.in[15];
    F.w_up_mem = (const float*)args.in[16]; F.w_out = (const float*)args.in[17]; F.g_post = (const float*)args.in[18];
    F.out = args.out;
    F.WCAT = (bf16*)(ws + WS_WCAT); F.WUP = (bf16*)(ws + WS_WUP); F.WOUT = (bf16*)(ws + WS_WOUT); F.ACAT = (bf16*)(ws + WS_ACAT); F.MERGED = (bf16*)(ws + WS_ACAT);
    F.QSB = (bf16*)(ws + WS_QSB); F.KSB = (bf16*)(ws + WS_KSB); F.VSB = (bf16*)(ws + WS_VSB); F.GSB = (bf16*)(ws + WS_GSB);
    F.QBD = (bf16*)(ws + WS_QBD); F.KBD = (bf16*)(ws + WS_KBD); F.VBD = (bf16*)(ws + WS_VBD); F.GBD = (bf16*)(ws + WS_GBD);
    F.QMM = (bf16*)(ws + WS_QMM); F.GMM = (bf16*)(ws + WS_GMM); F.MG = (bf16*)(ws + WS_MG); F.MK = (bf16*)(ws + WS_MK); F.MV = (bf16*)(ws + WS_MV);
    F.AUP = (bf16*)(ws + WS_AUP); F.SSQ = (float*)(ws + WS_SSQ); F.SSQS = (float*)(ws + WS_SSQS); F.YB = (bf16*)(ws + WS_YB); F.KBC = (bf16*)(ws + WS_KBC); F.VBC = (bf16*)(ws + WS_VBC); F.MKC = (bf16*)(ws + WS_MKC); F.MVC = (bf16*)(ws + WS_MVC);
    for (int u = threadIdx.x; u < (STG_OFF - LDSCTL_OFF) / 4; u += NWAVES * 64) ((LAS unsigned*)(F.lds + LDSCTL_OFF))[u] = 0u;
    __syncthreads();
    XcdBarrier bar; bar.bar = (unsigned*)(F.ctl + CW_BAR); bar.x = 0; bar.st = nullptr;
    if (N_LAUNCHES != PER_PHASE) bar = xcd_barrier_post((unsigned*)(F.ctl + CW_BAR), F.MISC + 8);
#define GRID_BAR() do { if (N_LAUNCHES != PER_PHASE) xcd_barrier(bar); } while (0)
    const int lo = args.ph_lo, hi = args.ph_hi;
#ifdef ONLY_PHASE
#define IN(k) ((k) == ONLY_PHASE && lo <= (k) && (k) < hi)
#else
#define IN(k) (lo <= (k) && (k) < hi)
#endif
#define BOTH(k) (IN(k) && IN((k) + 1))
#ifdef PROBE_PHASE
#define PROBE_T0(k) do { if ((k) == PROBE_PHASE && blockIdx.x == 0 && threadIdx.x == 0) { const unsigned long long t_ = __builtin_amdgcn_s_memrealtime(); F.MISC[20] = (unsigned)t_; F.MISC[21] = (unsigned)(t_ >> 32); } } while (0)
#define PROBE_T1(k) do { if ((k) == PROBE_PHASE) { if (blockIdx.x == 0 && threadIdx.x == 0) { const unsigned long long t1_ = __builtin_amdgcn_s_memrealtime(), t0_ = (unsigned long long)F.MISC[20] | ((unsigned long long)F.MISC[21] << 32); \
        const unsigned long long te_ = t1_ + (unsigned long long)(PROBE_K) * (t1_ - t0_); unsigned n_ = 0; while (__builtin_amdgcn_s_memrealtime() < te_ && ++n_ < (1u << 22)) __builtin_amdgcn_s_sleep(4); } \
        __syncthreads(); GRID_BAR(); } } while (0)
#else
#define PROBE_T0(k) do { } while (0)
#define PROBE_T1(k) do { } while (0)
#endif
    if (IN(0)) { PROBE_T0(0); p0_prologue(F); if (BOTH(0)) GRID_BAR(); PROBE_T1(0); }
    if (IN(1)) {
        PROBE_T0(1);
        pg8::Gemm g{F.ACAT, F.WCAT, MA, NCAT, DM}; ep::InOrder S; S.init(F.G, (int)blockIdx.x);
        ep::EpiIn E{F.QSB, F.KSB, F.VSB, F.GSB, F.QBD, F.KBD, F.VBD, F.GBD, F.QMM, F.GMM, F.MG, F.MK, F.MV, F.out, F.lds + STG_OFF, F.KBC, F.VBC};
        {
        pg8::gemm_phase<ep::EpiIn, ep::InOrder, true, true>(F.lds, g, S, E);
        if (SLACK_P1) {
            volatile LAS int* sl = (volatile LAS int*)(F.MISC + 12);
            for (;;) {
                if (threadIdx.x == 0) *sl = (int)__hip_atomic_fetch_add((unsigned*)(F.ctl + CW_WORK + 64), 1u, RLX_AGENT);
                __syncthreads();
                const int j = __builtin_amdgcn_readfirstlane(*sl);
                __syncthreads();
                if (j >= SLACK_ITEMS) break;
                slack_item(F, j);
            }
        }
        if (BOTH(1)) GRID_BAR(); }
        PROBE_T1(1);
    }
    if (IN(2)) {
        PROBE_T0(2);
        volatile LAS int* slot = (volatile LAS int*)(F.lds + att::OFF_ITEM);
        for (;;) {
            if (threadIdx.x == 0) *slot = (int)__hip_atomic_fetch_add((unsigned*)(F.ctl + CW_WORK), 1u, RLX_AGENT);
            __syncthreads();
            const int idx = __builtin_amdgcn_readfirstlane(*slot);
            __syncthreads();
            if (idx >= IT_TOTAL + ((LATE_WT && !SLACK_P1) ? LATE_ITEMS : 0)) break;
            if (idx >= IT_TOTAL) { late_transpose_item(F, idx - IT_TOTAL); __syncthreads(); continue; }
            const ArgsK* ka = (const ArgsK*)__builtin_amdgcn_kernarg_segment_ptr(); unsigned char* wsl = args.ws;
            asm volatile("" : "+s"(ka), "+s"(wsl));
            const ItemSrc isrc{ka, wsl};
            const att::Item it = make_item(isrc, idx);
            if (it.dma) { if (it.mode == 0) att::run_item<0, true>(it, (char*)lds, F.lds); else att::run_item<1, true>(it, (char*)lds, F.lds); }
            else { if (it.mode == 0) att::run_item<0, false>(it, (char*)lds, F.lds); else att::run_item<1, false>(it, (char*)lds, F.lds); }
        }
        if (BOTH(2)) GRID_BAR();
        PROBE_T1(2);
    }
    if (IN(3)) {
        PROBE_T0(3);
        pg8::Gemm g{F.AUP, F.WUP, MIN_, DM, DM}; ep::MergeOrder S; S.init(F.G, (int)blockIdx.x);
        ep::EpiMerge E{F.MG, F.MERGED};
        {
        pg8::gemm_phase<ep::EpiMerge, ep::MergeOrder, true, true>(F.lds, g, S, E);
        for (int sl = F.vcu; sl < 256; sl += F.G) ep::skinny_phase<0>(F.AUP, F.WUP, F.MG, F.MERGED, nullptr, nullptr, sl, F.lds);
        if (BOTH(3)) GRID_BAR(); }
        PROBE_T1(3);
    }
    if (IN(4)) {
        PROBE_T0(4);
        pg8::Gemm g{F.MERGED, F.WOUT, MP, DM, DM}; pg8::StaticOrder S; S.init(MP, DM, F.G, (int)blockIdx.x);
#if FUSE_RMS
        ep::EpiOutFused E{F.x_prompt, F.out, F.g_post, (float*)(ws + WS_XBUF), (unsigned*)(F.ctl + CW_PANEL), (unsigned*)(F.ctl + CW_TMO)};
        {
        pg8::gemm_phase<ep::EpiOutFused, pg8::StaticOrder, false, true>(F.lds, g, S, E);
#else
        ep::EpiOut E{F.YB, F.SSQ};
        {
        pg8::gemm_phase<ep::EpiOut, pg8::StaticOrder, true, true>(F.lds, g, S, E);
#endif
        for (int sl = F.vcu; sl < 256; sl += F.G) ep::skinny_phase<1>(F.MERGED, F.WOUT, nullptr, nullptr, F.out + 16777216, F.SSQS, sl, F.lds);
        if (BOTH(4)) GRID_BAR(); }
        PROBE_T1(4);
    }
    if (IN(5)) p5_final(F);
#undef IN
#undef BOTH
#undef GRID_BAR
#undef PROBE_T0
#undef PROBE_T1
}

extern "C" void kernel_launch(void* const* d_in, const int* in_sizes, int n_in, void* d_out, int out_size, void* d_ws, size_t ws_size, hipStream_t stream) {
    static int grid = 0;
    if (grid == 0) {
        if (n_in != 19 || in_sizes[0] != MP * DM || in_sizes[10] != DM * INW || out_size != OUT_ELEMS || ws_size < WS_END) {
            fprintf(stderr, "kernel_launch: built for 19 inputs, x_prompt %d, w_in %d, out %d floats, >= %zu bytes of workspace; got n_in %d, in0 %d, in10 %d, out %d, ws %zu; nothing launched\n",
                    MP * DM, DM * INW, OUT_ELEMS, (size_t)WS_END, n_in, n_in > 0 ? in_sizes[0] : -1, n_in > 10 ? in_sizes[10] : -1, out_size, ws_size);
            grid = -1; return; }
        int dev = 0, cus = 0, per_cu = 0;
        if (hipGetDevice(&dev) != hipSuccess || hipDeviceGetAttribute(&cus, hipDeviceAttributeMultiprocessorCount, dev) != hipSuccess) { fprintf(stderr, "kernel_launch: device query failed\n"); grid = -1; return; }
        if (hipFuncSetAttribute((const void*)fwd_megakernel, hipFuncAttributeMaxDynamicSharedMemorySize, LDS_BYTES) != hipSuccess) { fprintf(stderr, "kernel_launch: hipFuncSetAttribute(%d B LDS) failed\n", LDS_BYTES); grid = -1; return; }
        if (hipOccupancyMaxActiveBlocksPerMultiprocessor(&per_cu, (const void*)fwd_megakernel, NWAVES * 64, LDS_BYTES) != hipSuccess || per_cu < 1) {
            fprintf(stderr, "kernel_launch: occupancy query reports %d workgroups per CU; nothing launched\n", per_cu); (void)hipGetLastError(); grid = -1; return; }
        grid = cus;
    }
    if (grid < 0) return;
    if (hipMemsetAsync((char*)d_ws + WS_CTL, 0, CTL_ZERO_BYTES, stream) != hipSuccess) { fprintf(stderr, "kernel_launch: hipMemsetAsync failed\n"); return; }
    Args a{};
    for (int i = 0; i < 19; ++i) a.in[i] = d_in[i];
    a.out = (float*)d_out; a.ws = (unsigned char*)d_ws;
    if (N_LAUNCHES == 1) {
        a.ph_lo = 0; a.ph_hi = PER_PHASE;
        hipLaunchKernelGGL(fwd_megakernel, dim3(grid), dim3(NWAVES * 64), LDS_BYTES, stream, a);
    } else {
        for (int li = 0; li < PER_PHASE; ++li) { a.ph_lo = li; a.ph_hi = li + 1; hipLaunchKernelGGL(fwd_megakernel, dim3(grid), dim3(NWAVES * 64), LDS_BYTES, stream, a); }
    }
    const hipError_t le = hipPeekAtLastError();
    if (le != hipSuccess) fprintf(stderr, "kernel_launch: launch failed: %s (grid %d)\n", hipGetErrorName(le), grid);
}
```

```cpp
#include <hip/hip_runtime.h>
#include <hip/hip_bf16.h>
#include <cstdio>
#include <cstdint>

#ifndef MK_N_LAUNCHES
#define MK_N_LAUNCHES 1
#endif
#ifndef FUSE_RMS
#define FUSE_RMS 0
#endif
#ifndef LATE_WT
#define LATE_WT 1
#endif
#ifndef SLACK_P1
#define SLACK_P1 1
#endif
#ifndef SB_EARLY_EXIT
#define SB_EARLY_EXIT 1
#endif

constexpr int DM = 2048, SEQ = 4096, NB = 2, DB = 8, DS = 16, PAST = 4096, HD = 128;
constexpr int MP = NB * SEQ;
constexpr int MS = DB * DS;
constexpr int MIN_ = 8448;
constexpr int MREAL = MP + MS;
constexpr int MMEM0 = 8448;
constexpr int MA = 8960;
constexpr int INW = 13312, NCAT = 14336;
constexpr int NMEM = 256;
constexpr float RMS_EPS = 1e-6f;
constexpr float LOG2E = 1.4426950408889634f;
constexpr float QSCALE = 0.08838834764831845f * 1.4426950408889634f;

namespace pg8 {
#define PG8_LAS __attribute__((address_space(3)))
typedef unsigned short bf16_t;
typedef short bf16x8 __attribute__((ext_vector_type(8)));
typedef float f32x4 __attribute__((ext_vector_type(4)));
typedef unsigned u32x4 __attribute__((ext_vector_type(4)));
constexpr int BM = 256, BK = 64, HALF = 128, HTB = HALF * BK * 2  , STAGE_BYTES = 8 * HTB, NXCD = 8, WGM = 8;

__host__ __device__ __forceinline__ int lds_byte(int r, int c) { const int st = (r >> 4) * 2 + (c >> 5), rr = r & 15, cc = c & 31, ob = rr * 64 + cc * 2; return st * 1024 + (ob ^ (((ob >> 9) & 1) << 5)); }
__host__ __device__ __forceinline__ void stage_rc(int b, int& R, int& C) { const int st = b / 1024, sb = b % 1024, swz = sb ^ (((sb >> 9) & 1) << 5); R = (st >> 1) * 16 + swz / 64; C = (st & 1) * 32 + (swz % 64) / 2; }
__host__ __device__ __forceinline__ int perm32(int rho) { const int n = rho >> 4, i = rho & 15; return 8 * (i >> 2) + 4 * n + (i & 3); }

struct Unit { int pm, pn, k0, nt; };
struct Gemm { const bf16_t* A; const bf16_t* Bt; int M, N, K; };

struct StaticOrder {
    int nM, nN, nwg, G, c;
    __host__ __device__ void init(int M, int N, int G_, int c_) { nM = M / BM; nN = N / BM; nwg = nM * nN; G = G_; c = c_; }
    __host__ __device__ bool next(int i, Unit& u) const {
        const long L = (long)i * G + c; if (L >= nwg) return false;
        int wgid = (int)L; { const int q = nwg / NXCD, r = nwg % NXCD, xcd = wgid % NXCD, off = wgid / NXCD; wgid = (xcd < r ? xcd * (q + 1) : r * (q + 1) + (xcd - r) * q) + off; }
        const int nig = WGM * nN, gid = wgid / nig, fm = gid * WGM, gsz = (nM - fm) < WGM ? (nM - fm) : WGM;
        u.pm = fm + ((wgid % nig) % gsz); u.pn = (wgid % nig) / gsz; u.k0 = 0; u.nt = 0; return true;
    }
    __device__ __forceinline__ void a_ready(const Unit&) const {}
    __device__ __forceinline__ void done(const Unit&) const {}
};

typedef float f32x2_t __attribute__((ext_vector_type(2))); typedef __bf16 bf16x2_t __attribute__((ext_vector_type(2)));
__device__ __forceinline__ unsigned cvt_pk_bf16(float lo, float hi) { f32x2_t v = {lo, hi}; bf16x2_t b = __builtin_convertvector(v, bf16x2_t); return __builtin_bit_cast(unsigned, b); }

template <class Epi, class Sched, bool ALIGN_EPI = false, bool SP2 = false>
__device__ __forceinline__ void gemm_phase(PG8_LAS unsigned char* lds, const Gemm g, const Sched& S, const Epi& E) {
    const int tid = threadIdx.x, wid = __builtin_amdgcn_readfirstlane(tid >> 6), lane = tid & 63, wr = wid >> 2, wc = wid & 3, fr = lane & 15, fq = lane >> 4;
    const int K = g.K, nt = K / BK;
    unsigned voffA[2], voffB[2];
#pragma unroll
    for (int i = 0; i < 2; ++i) { int R, C; stage_rc(tid * 16 + i * 8192, R, C); const int Rb = Epi::PERM ? ((R & ~31) + perm32(R & 31)) : R;
        voffA[i] = (unsigned)(R * K + C) * 2u; voffB[i] = (unsigned)(Rb * K + C) * 2u; }
    const size_t kstep = (size_t)(BK * 2);
    const size_t hstep = (size_t)HALF * K * 2;
    const size_t tstep = 2 * hstep;
    const unsigned ldsw = (unsigned)wid * 1024u;
    const int aoff = lds_byte(wr * 64 + fr, fq * 8), boff = lds_byte(wc * 32 + fr, fq * 8);
#define PG8_SA(b, h) (((b) * 2 + (h)) * HTB)
#define PG8_SB(b, h) ((4 + (b) * 2 + (h)) * HTB)
#define PG8_STAGE(bufoff, gbase, voff) do { _Pragma("unroll") for (int _i = 0; _i < 2; ++_i) \
        __builtin_amdgcn_global_load_lds((const unsigned*)((const char*)(gbase) + (voff)[_i]), (PG8_LAS unsigned*)(lds + (bufoff) + ldsw + _i * 8192), 16, 0, 0); } while (0)
#define PG8_LDA(dst, b, h) do { _Pragma("unroll") for (int m = 0; m < 4; ++m) _Pragma("unroll") for (int k = 0; k < 2; ++k) dst[m][k] = *(const PG8_LAS bf16x8*)(lds + PG8_SA(b, h) + aoff + m * 2048 + k * 1024); } while (0)
#define PG8_LDB(dst, b, h) do { _Pragma("unroll") for (int n = 0; n < 2; ++n) _Pragma("unroll") for (int k = 0; k < 2; ++k) dst[n][k] = *(const PG8_LAS bf16x8*)(lds + PG8_SB(b, h) + boff + n * 2048 + k * 1024); } while (0)
#define PG8_MMA(ai, bj, At, Bt) do { __builtin_amdgcn_s_setprio(1); _Pragma("unroll") for (int m = 0; m < 4; ++m) _Pragma("unroll") for (int n = 0; n < 2; ++n) _Pragma("unroll") for (int k = 0; k < 2; ++k) \
        acc[ai][bj][m][n] = __builtin_amdgcn_mfma_f32_16x16x32_bf16(Bt[n][k], At[m][k], acc[ai][bj][m][n], 0, 0, 0); __builtin_amdgcn_s_setprio(0); } while (0)
#define PG8_WAIT_V(n) asm volatile("s_waitcnt vmcnt(" #n ")" ::: "memory")
#define PG8_WAIT_L(n) asm volatile("s_waitcnt lgkmcnt(" #n ")" ::: "memory")
#define PG8_BAR __builtin_amdgcn_s_barrier()
#define PG8_SCHED __builtin_amdgcn_sched_barrier(0)
    Unit cur, nxt; int ui = 0;
    if (!S.next(0, cur)) return;
    f32x4 acc[2][2][4][2];
#pragma unroll
    for (int a = 0; a < 2; ++a)
#pragma unroll
        for (int b = 0; b < 2; ++b)
#pragma unroll
            for (int m = 0; m < 4; ++m)
#pragma unroll
                for (int n = 0; n < 2; ++n) acc[a][b][m][n] = (f32x4){0.f, 0.f, 0.f, 0.f};
    bf16x8 At[4][2], B0[2][2], B1[2][2];
    const char* cA = (const char*)g.A + (size_t)cur.pm * tstep + (size_t)cur.k0 * 2; const char* cB = (const char*)g.Bt + (size_t)cur.pn * tstep + (size_t)cur.k0 * 2;
    S.a_ready(cur);
    if constexpr (SP2) {
        PG8_STAGE(PG8_SB(0, 0), cB, voffB); PG8_STAGE(PG8_SB(0, 1), cB + hstep, voffB); PG8_STAGE(PG8_SA(0, 0), cA, voffA); PG8_STAGE(PG8_SA(0, 1), cA + hstep, voffA);
        if (wr == 1) PG8_BAR;
        PG8_WAIT_V(2); PG8_BAR;
        PG8_STAGE(PG8_SB(1, 0), cB + kstep, voffB); PG8_STAGE(PG8_SA(1, 0), cA + kstep, voffA); PG8_STAGE(PG8_SB(1, 1), cB + hstep + kstep, voffB);
        PG8_WAIT_V(6); PG8_BAR;
    } else {
        PG8_STAGE(PG8_SB(0, 0), cB, voffB); PG8_STAGE(PG8_SA(0, 0), cA, voffA); PG8_STAGE(PG8_SB(0, 1), cB + hstep, voffB); PG8_STAGE(PG8_SA(0, 1), cA + hstep, voffA);
        if (wr == 1) PG8_BAR;
        PG8_WAIT_V(4); PG8_BAR;
        PG8_STAGE(PG8_SB(1, 0), cB + kstep, voffB); PG8_STAGE(PG8_SA(1, 0), cA + kstep, voffA); PG8_STAGE(PG8_SB(1, 1), cB + hstep + kstep, voffB);
        PG8_WAIT_V(6); PG8_BAR;
    }
    for (;;) {
        const bool has_next = S.next(ui + 1, nxt);
        const char* nA = has_next ? (const char*)g.A + (size_t)nxt.pm * tstep + (size_t)nxt.k0 * 2 : cA; const char* nB = has_next ? (const char*)g.Bt + (size_t)nxt.pn * tstep + (size_t)nxt.k0 * 2 : cB;
        const int ntu = cur.nt ? cur.nt : nt;
        for (int t = 0; t < ntu; t += 2) {
            const bool last = (t == ntu - 2);
            const char* a1 = cA + (size_t)(t + 1) * kstep;
            const char* a2 = last ? nA : cA + (size_t)(t + 2) * kstep; const char* b2 = last ? nB : cB + (size_t)(t + 2) * kstep;
            const char* a3 = a2 + kstep; const char* b3 = b2 + kstep;
            if (last && has_next) S.a_ready(nxt);
            if constexpr (SP2) {
            PG8_LDB(B0, 0, 0); PG8_LDB(B1, 0, 1); PG8_SCHED; PG8_LDA(At, 0, 0); PG8_STAGE(PG8_SA(1, 1), a1 + hstep, voffA);
            PG8_WAIT_V(8); PG8_WAIT_L(0); PG8_BAR; PG8_MMA(0, 0, At, B0); PG8_MMA(0, 1, At, B1); PG8_BAR; PG8_SCHED;
            PG8_LDA(At, 0, 1); PG8_STAGE(PG8_SB(0, 0), b2, voffB); PG8_STAGE(PG8_SB(0, 1), b2 + hstep, voffB); PG8_STAGE(PG8_SA(0, 0), a2, voffA);
            PG8_WAIT_V(8); PG8_WAIT_L(0); PG8_BAR; PG8_MMA(1, 0, At, B0); PG8_MMA(1, 1, At, B1); PG8_BAR; PG8_SCHED;
            PG8_LDB(B0, 1, 0); PG8_LDB(B1, 1, 1); PG8_SCHED; PG8_LDA(At, 1, 0); PG8_STAGE(PG8_SA(0, 1), a2 + hstep, voffA);
            PG8_WAIT_V(8); PG8_WAIT_L(0); PG8_BAR; PG8_MMA(0, 0, At, B0); PG8_MMA(0, 1, At, B1); PG8_BAR; PG8_SCHED;
            PG8_LDA(At, 1, 1); PG8_STAGE(PG8_SB(1, 0), b3, voffB); PG8_STAGE(PG8_SB(1, 1), b3 + hstep, voffB); PG8_STAGE(PG8_SA(1, 0), a3, voffA);
            PG8_WAIT_V(8); PG8_WAIT_L(0); PG8_BAR; PG8_MMA(1, 0, At, B0); PG8_MMA(1, 1, At, B1); PG8_BAR; PG8_SCHED;
            } else {
            PG8_LDB(B0, 0, 0); PG8_SCHED; PG8_LDA(At, 0, 0); PG8_STAGE(PG8_SA(1, 1), a1 + hstep, voffA);
            PG8_WAIT_L(8); PG8_BAR; PG8_WAIT_L(0); PG8_MMA(0, 0, At, B0); PG8_BAR; PG8_SCHED;
            PG8_LDB(B1, 0, 1); PG8_STAGE(PG8_SB(0, 0), b2, voffB);
            PG8_BAR; PG8_WAIT_L(0); PG8_MMA(0, 1, At, B1); PG8_BAR;
            PG8_LDA(At, 0, 1); PG8_STAGE(PG8_SA(0, 0), a2, voffA);
            PG8_BAR; PG8_WAIT_L(0); PG8_MMA(1, 0, At, B0); PG8_BAR; PG8_SCHED;
            PG8_STAGE(PG8_SB(0, 1), b2 + hstep, voffB);
            PG8_WAIT_V(6); PG8_BAR; PG8_MMA(1, 1, At, B1); PG8_BAR;
            PG8_LDB(B0, 1, 0); PG8_SCHED; PG8_LDA(At, 1, 0); PG8_STAGE(PG8_SA(0, 1), a2 + hstep, voffA);
            PG8_WAIT_L(8); PG8_BAR; PG8_WAIT_L(0); PG8_MMA(0, 0, At, B0); PG8_BAR; PG8_SCHED;
            PG8_LDB(B1, 1, 1); PG8_STAGE(PG8_SB(1, 0), b3, voffB);
            PG8_BAR; PG8_WAIT_L(0); PG8_MMA(0, 1, At, B1); PG8_BAR;
            PG8_LDA(At, 1, 1); PG8_STAGE(PG8_SA(1, 0), a3, voffA);
            PG8_BAR; PG8_WAIT_L(0); PG8_MMA(1, 0, At, B0); PG8_BAR; PG8_SCHED;
            PG8_STAGE(PG8_SB(1, 1), b3 + hstep, voffB);
            PG8_WAIT_V(6); PG8_BAR; PG8_MMA(1, 1, At, B1); PG8_BAR;
            }
        }
        if constexpr (ALIGN_EPI) { if (wr == 0) PG8_BAR; }
        if constexpr (!Epi::AFTER_DRAIN) { E(acc, cur, wr, wc, fr, fq); S.done(cur); }
        if (!has_next) break;
        if (E.reset_after(cur))
#pragma unroll
        for (int a = 0; a < 2; ++a)
#pragma unroll
            for (int b = 0; b < 2; ++b)
#pragma unroll
                for (int m = 0; m < 4; ++m)
#pragma unroll
                    for (int n = 0; n < 2; ++n) acc[a][b][m][n] = (f32x4){0.f, 0.f, 0.f, 0.f};
        cur = nxt; cA = nA; cB = nB; ++ui;
        if constexpr (ALIGN_EPI) { if (wr == 1) PG8_BAR; }
    }
    PG8_WAIT_V(0);
    if constexpr (!ALIGN_EPI) { if (wr == 0) PG8_BAR; }
    PG8_BAR;
    if constexpr (Epi::AFTER_DRAIN) { E.fused(acc, cur, wr, wc, fr, fq, lds, wid, lane); S.done(cur); }
#undef PG8_SA
#undef PG8_SB
#undef PG8_STAGE
#undef PG8_LDA
#undef PG8_LDB
#undef PG8_MMA
#undef PG8_WAIT_V
#undef PG8_WAIT_L
#undef PG8_BAR
#undef PG8_SCHED
}
}

namespace ep {
using pg8::f32x4; using pg8::u32x4; using pg8::Unit; using pg8::bf16_t; using pg8::HALF; using pg8::BM; using pg8::cvt_pk_bf16;
typedef unsigned u32x2 __attribute__((ext_vector_type(2)));

struct InOrder {
    pg8::StaticOrder so; int G, c;
    __device__ void init(int G_, int c_) { so.init(MIN_, INW, G_, c_); G = G_; c = c_; }
    __device__ bool next(int i, Unit& u) const {
        const long L = (long)i * G + c;
        if (L < so.nwg) return so.next(i, u);
        const int j = (int)(L - so.nwg); if (j >= 8) return false;
        u.pm = 33 + (j & 1); u.pn = 52 + (j >> 1); u.k0 = 0; u.nt = 0; return true;
    }
    __device__ __forceinline__ void a_ready(const Unit&) const {}
    __device__ __forceinline__ void done(const Unit&) const {}
};

__device__ __forceinline__ float sigmoidf_fast(float x) { return __builtin_amdgcn_rcpf(1.0f + __builtin_amdgcn_exp2f(-x * LOG2E)); }
__device__ __forceinline__ float bf2f(unsigned short h) { return __uint_as_float((unsigned)h << 16); }

struct EpiIn {
    static constexpr bool PERM = true, AFTER_DRAIN = false;
    bf16_t *QSB, *KSB, *VSB, *GSB, *QBD, *KBD, *VBD, *GBD, *QMM, *GMM, *MG, *MK, *MV;
    float* out;
    __attribute__((address_space(3))) unsigned char* stg;
    bf16_t *KBC, *VBC;
    __device__ __forceinline__ bool reset_after(const Unit&) const { return true; }
    template <int ACT, int F32>
    __device__ __forceinline__ void store(const f32x4 (&acc)[2][2][4][2], bf16_t* dst, int ldc, int colt, int rowoff, int pm, float* f0, float* f1, int wr, int wc, int fr, int fq, bf16_t* bdc = nullptr) const {
        const int col0 = colt + wc * 32 + 8 * fq;
#pragma unroll
        for (int ai = 0; ai < 2; ++ai)
#pragma unroll
            for (int m = 0; m < 4; ++m) {
                const int r = pm * BM + ai * HALF + wr * 64 + m * 16 + fr;
                bf16_t* rowp = dst + (size_t)(r - rowoff) * ldc + col0;
                float* frow = nullptr;
                if (F32 == 1) { if (r < MP) frow = f0 + (size_t)r * 768; else if (r < MREAL) frow = f1 + (size_t)(r - MP) * 768; }
                if (F32 == 2) { if (r < MP) { const int t = r & (SEQ - 1); if (t >= SEQ - 512) frow = f0 + ((size_t)(r >> 12) * 512 + (t - (SEQ - 512))) * 768; } else if (r < MREAL) frow = f1 + (size_t)(r - MP) * 768; }
                if (F32 == 3) frow = f0 + (size_t)(r - MMEM0) * 512;
#pragma unroll
                for (int bj = 0; bj < 2; ++bj) {
                    f32x4 v0 = acc[ai][bj][m][0], v1 = acc[ai][bj][m][1];
                    if (F32 != 0) { if (frow) { __builtin_nontemporal_store(v0, (f32x4*)(frow + col0 + bj * HALF)); __builtin_nontemporal_store(v1, (f32x4*)(frow + col0 + bj * HALF + 4)); } }
                    if (ACT == 1) { v0 = v0 * QSCALE; v1 = v1 * QSCALE; }
                    if (ACT == 2) {
#pragma unroll
                        for (int e = 0; e < 4; ++e) { v0[e] = v0[e] * sigmoidf_fast(v0[e]); v1[e] = v1[e] * sigmoidf_fast(v1[e]); } }
                    if (ACT == 3) {
#pragma unroll
                        for (int e = 0; e < 4; ++e) { v0[e] = sigmoidf_fast(v0[e]); v1[e] = sigmoidf_fast(v1[e]); } }
                    u32x4 w; w.x = cvt_pk_bf16(v0[0], v0[1]); w.y = cvt_pk_bf16(v0[2], v0[3]); w.z = cvt_pk_bf16(v1[0], v1[1]); w.w = cvt_pk_bf16(v1[2], v1[3]);
                    *(u32x4*)(rowp + bj * HALF) = w;
                    if (F32 == 2 && SLACK_P1) { if (r >= MP && r < MREAL) *(u32x4*)(bdc + ((size_t)((r - MP) >> 4) * 576 + 512 + ((r - MP) & 15)) * 768 + col0 + bj * HALF) = w; } }
            }
    }
    __device__ __forceinline__ void store_gates(const f32x4 (&acc)[2][2][4][2], int t, int pm, int wr, int wc, int fr, int fq) const {
        typedef float f32x2 __attribute__((ext_vector_type(2)));
        typedef __attribute__((address_space(3))) u32x2 lu32x2; typedef __attribute__((address_space(3))) u32x4 lu32x4;
        const int sld = (t < 24) ? 768 : 512;
        bf16_t* const sdst = (t < 12) ? GSB + 64 * t : (t < 24 ? GBD + 64 * (t - 12) : GMM + 64 * (t - 24));
        constexpr float CAP = 1073741824.0f, NLN2 = -0.6931471805599453f;
        const int row32 = wr * 16 + fr;
        const int woff = row32 * 128 + ((wc ^ ((row32 >> 1) & 3)) << 5) + fq * 8;
        const int tid = threadIdx.x, rrow = (tid & 255) >> 3, part = tid & 7, kq = tid >> 8;
        const int roff = kq * 4096 + rrow * 128 + ((((part >> 1) ^ ((rrow >> 1) & 3)) << 5) | ((part & 1) << 4));
        const int grow = pm * BM + (rrow >> 4) * 64 + (rrow & 15);
#pragma unroll
        for (int ai = 0; ai < 2; ++ai)
#pragma unroll
            for (int m = 0; m < 4; ++m) {
                u32x2 w1, w2, w3, ws;
#pragma unroll
                for (int h = 0; h < 2; ++h) {
                    const f32x2 x1 = {acc[ai][0][m][0][2 * h], acc[ai][0][m][0][2 * h + 1]}, x2 = {acc[ai][0][m][1][2 * h], acc[ai][0][m][1][2 * h + 1]};
                    const f32x2 x3 = {acc[ai][1][m][0][2 * h], acc[ai][1][m][0][2 * h + 1]}, xs = {acc[ai][1][m][1][2 * h], acc[ai][1][m][1][2 * h + 1]};
                    const f32x2 one = {1.0f, 1.0f};
                    const f32x2 d1 = (f32x2){fminf(__builtin_amdgcn_exp2f(x1.x), CAP), fminf(__builtin_amdgcn_exp2f(x1.y), CAP)} + one, d2 = (f32x2){fminf(__builtin_amdgcn_exp2f(x2.x), CAP), fminf(__builtin_amdgcn_exp2f(x2.y), CAP)} + one;
                    const f32x2 d3 = (f32x2){fminf(__builtin_amdgcn_exp2f(x3.x), CAP), fminf(__builtin_amdgcn_exp2f(x3.y), CAP)} + one, ds = (f32x2){fminf(__builtin_amdgcn_exp2f(xs.x), CAP), fminf(__builtin_amdgcn_exp2f(xs.y), CAP)} + one;
                    const f32x2 p12 = d1 * d2, p3s = d3 * ds, q = p12 * p3s;
                    const f32x2 rq = {__builtin_amdgcn_rcpf(q.x), __builtin_amdgcn_rcpf(q.y)};
                    const f32x2 i12 = rq * p3s, i3s = rq * p12;
                    const f32x2 g3 = i3s * ds, sg = (xs * NLN2) * (i3s * d3);
                    const f32x2 r1 = (d2 * d2) * i12, r2 = (d3 * d1) * i12;
                    w1[h] = cvt_pk_bf16(r1.x, r1.y); w2[h] = cvt_pk_bf16(r2.x, r2.y); w3[h] = cvt_pk_bf16(g3.x, g3.y); ws[h] = cvt_pk_bf16(sg.x, sg.y);
                }
                if (ai + m > 0) { asm volatile("s_waitcnt lgkmcnt(0)" ::: "memory"); __builtin_amdgcn_s_barrier(); }
                *(lu32x2*)(stg + woff) = w1; *(lu32x2*)(stg + 4096 + woff) = w2; *(lu32x2*)(stg + 8192 + woff) = w3; *(lu32x2*)(stg + 12288 + woff) = ws;
                asm volatile("s_waitcnt lgkmcnt(0)" ::: "memory"); __builtin_amdgcn_s_barrier(); asm volatile("" ::: "memory");
                const u32x4 va = *(const lu32x4*)(stg + roff), vb = *(const lu32x4*)(stg + 8192 + roff);
                const int r = grow + ai * HALF + m * 16;
                *(u32x4*)(MG + (size_t)r * 6144 + kq * 2048 + 64 * t + part * 8) = va;
                if (kq == 0) *(u32x4*)(MG + (size_t)r * 6144 + 4096 + 64 * t + part * 8) = vb;
                else *(u32x4*)(sdst + (size_t)r * sld + part * 8) = vb;
            }
        asm volatile("s_waitcnt lgkmcnt(0)" ::: "memory");
    }
    __device__ __forceinline__ void operator()(const f32x4 (&acc)[2][2][4][2], const Unit& u, int wr, int wc, int fr, int fq) const {
        const int pn = u.pn, pm = u.pm;
        float* const o_sbk = out + 17039360, * const o_sbv = out + 23330816, * const o_bdk = out + 29622272, * const o_bdv = out + 30408704;
        float* const o_mk = out + 31195136, * const o_mv = out + 31457280;
        float* const s_sbk = out + 31719424, * const s_sbv = out + 31817728, * const s_bdk = out + 31916032, * const s_bdv = out + 32014336;
        if (pn < 3)        store<0, 0>(acc, QSB, 768, 256 * pn, 0, pm, nullptr, nullptr, wr, wc, fr, fq);
        else if (pn < 6)   store<0, 1>(acc, KSB, 768, 256 * (pn - 3), 0, pm, o_sbk, s_sbk, wr, wc, fr, fq);
        else if (pn < 9)   store<0, 1>(acc, VSB, 768, 256 * (pn - 6), 0, pm, o_sbv, s_sbv, wr, wc, fr, fq);
        else if (pn < 12)  store<0, 0>(acc, QBD, 768, 256 * (pn - 9), 0, pm, nullptr, nullptr, wr, wc, fr, fq);
        else if (pn < 15)  store<0, 2>(acc, KBD, 768, 256 * (pn - 12), 0, pm, o_bdk, s_bdk, wr, wc, fr, fq, KBC);
        else if (pn < 18)  store<0, 2>(acc, VBD, 768, 256 * (pn - 15), 0, pm, o_bdv, s_bdv, wr, wc, fr, fq, VBC);
        else if (pn < 20)  store<0, 0>(acc, QMM, 512, 256 * (pn - 18), 0, pm, nullptr, nullptr, wr, wc, fr, fq);
        else if (pn < 52)  store_gates(acc, pn - 20, pm, wr, wc, fr, fq);
        else if (pn < 54)  store<0, 3>(acc, MK, 512, 256 * (pn - 52), MMEM0, pm, o_mk, nullptr, wr, wc, fr, fq);
        else               store<0, 3>(acc, MV, 512, 256 * (pn - 54), MMEM0, pm, o_mv, nullptr, wr, wc, fr, fq);
    }
};

struct MergeOrder {
    pg8::StaticOrder so;
    __device__ void init(int G_, int c_) { so.init(MP, DM, G_, c_); }
    __device__ bool next(int i, Unit& u) const {
        const int ti = i / 3, seg = i - 3 * ti;
        if (!so.next(ti, u)) return false;
        u.k0 = 768 * seg; u.nt = (seg == 2) ? 8 : 12; return true;
    }
    __device__ __forceinline__ void a_ready(const Unit&) const {}
    __device__ __forceinline__ void done(const Unit&) const {}
};
struct EpiMerge {
    static constexpr bool PERM = true, AFTER_DRAIN = false;
    const bf16_t* MG; bf16_t* OUT;
    __device__ __forceinline__ bool reset_after(const Unit& u) const { return u.k0 == 1536; }
    __device__ __forceinline__ void operator()(f32x4 (&acc)[2][2][4][2], const Unit& u, int wr, int wc, int fr, int fq) const {
        const int col0 = u.pn * BM + wc * 32 + 8 * fq;
        const int seg = (u.k0 == 0) ? 0 : (u.k0 == 768 ? 1 : 2);
        const bool last = (seg == 2);
        u32x4 g[2][4][2];
#pragma unroll
        for (int ai = 0; ai < 2; ++ai)
#pragma unroll
            for (int m = 0; m < 4; ++m) { const bf16_t* g_ = MG + (size_t)(u.pm * BM + ai * HALF + wr * 64 + m * 16 + fr) * 6144 + seg * 2048 + col0;
#pragma unroll
                for (int bj = 0; bj < 2; ++bj) g[ai][m][bj] = *(const u32x4*)(g_ + bj * HALF); }
#pragma unroll
        for (int ai = 0; ai < 2; ++ai)
#pragma unroll
            for (int m = 0; m < 4; ++m) { bf16_t* rowp = OUT + (size_t)(u.pm * BM + ai * HALF + wr * 64 + m * 16 + fr) * DM + col0;
#pragma unroll
                for (int bj = 0; bj < 2; ++bj) {
#pragma unroll
                    for (int e = 0; e < 4; ++e) { acc[ai][bj][m][e >> 1][2 * (e & 1)] *= __uint_as_float(g[ai][m][bj][e] << 16); acc[ai][bj][m][e >> 1][2 * (e & 1) + 1] *= __uint_as_float(g[ai][m][bj][e] & 0xffff0000u); }
                    if (last) { u32x4 w; w.x = cvt_pk_bf16(acc[ai][bj][m][0][0], acc[ai][bj][m][0][1]); w.y = cvt_pk_bf16(acc[ai][bj][m][0][2], acc[ai][bj][m][0][3]);
                        w.z = cvt_pk_bf16(acc[ai][bj][m][1][0], acc[ai][bj][m][1][1]); w.w = cvt_pk_bf16(acc[ai][bj][m][1][2], acc[ai][bj][m][1][3]);
                        *(u32x4*)(rowp + bj * HALF) = w; } } }
    }
};

struct EpiOut {
    static constexpr bool PERM = true, AFTER_DRAIN = false;
    bf16_t* yb; float* ssq;
    __device__ __forceinline__ bool reset_after(const Unit&) const { return true; }
    __device__ __forceinline__ void operator()(const f32x4 (&acc)[2][2][4][2], const Unit& u, int wr, int wc, int fr, int fq) const {
        const int col0 = u.pn * BM + wc * 32 + 8 * fq;
#pragma unroll
        for (int ai = 0; ai < 2; ++ai)
#pragma unroll
            for (int m = 0; m < 4; ++m) {
                const int r = u.pm * BM + ai * HALF + wr * 64 + m * 16 + fr;
                bf16_t* yrow = yb + (size_t)r * DM + col0;
                float s = 0.f;
#pragma unroll
                for (int bj = 0; bj < 2; ++bj) { const f32x4 v0 = acc[ai][bj][m][0], v1 = acc[ai][bj][m][1];
                    s += ((v0[0] * v0[0] + v0[1] * v0[1]) + (v0[2] * v0[2] + v0[3] * v0[3])) + ((v1[0] * v1[0] + v1[1] * v1[1]) + (v1[2] * v1[2] + v1[3] * v1[3]));
                    u32x4 w; w.x = cvt_pk_bf16(v0[0], v0[1]); w.y = cvt_pk_bf16(v0[2], v0[3]); w.z = cvt_pk_bf16(v1[0], v1[1]); w.w = cvt_pk_bf16(v1[2], v1[3]);
                    *(u32x4*)(yrow + bj * HALF) = w; }
                s += __shfl_xor(s, 16); s += __shfl_xor(s, 32);
                if (fq == 0) ssq[(size_t)r * 32 + u.pn * 4 + wc] = s;
            }
    }
};

struct EpiOutFused {
    static constexpr bool PERM = false, AFTER_DRAIN = true;
    const float* x; float* out; const float* gpost; float* xbuf; unsigned* cnt; unsigned* tmo;
    __device__ __forceinline__ bool reset_after(const Unit&) const { return true; }
    __device__ __forceinline__ void operator()(const f32x4 (&)[2][2][4][2], const Unit&, int, int, int, int) const {}
    __device__ __forceinline__ void fused(f32x4 (&acc)[2][2][4][2], const Unit& u, int wr, int wc, int fr, int fq, __attribute__((address_space(3))) unsigned char* lds, int wid, int lane) const {
        typedef __attribute__((address_space(3))) float lfloat;
        lfloat* P = (lfloat*)lds;
        lfloat* S = (lfloat*)(lds + 4096);
        __attribute__((address_space(3))) unsigned* flag = (__attribute__((address_space(3))) unsigned*)(lds + 4096 + 1024);
        const int col0 = u.pn * BM + wc * 32 + 4 * fq;
        f32x4 pre[4][2][2];
#pragma unroll
        for (int m = 0; m < 4; ++m) { const size_t off = (size_t)(u.pm * BM + wr * 64 + m * 16 + fr) * DM + col0;
#pragma unroll
            for (int bj = 0; bj < 2; ++bj)
#pragma unroll
                for (int n = 0; n < 2; ++n) pre[m][bj][n] = *(const f32x4*)(x + off + bj * HALF + n * 16); }
#pragma unroll
        for (int ai = 0; ai < 2; ++ai)
#pragma unroll
            for (int m = 0; m < 4; ++m) { float s = 0.f;
#pragma unroll
                for (int bj = 0; bj < 2; ++bj)
#pragma unroll
                    for (int n = 0; n < 2; ++n) { const f32x4 v = acc[ai][bj][m][n]; s += (v[0] * v[0] + v[1] * v[1]) + (v[2] * v[2] + v[3] * v[3]); }
                s += __shfl_xor(s, 16); s += __shfl_xor(s, 32);
                if (fq == 0) P[(ai * HALF + wr * 64 + m * 16 + fr) * 4 + wc] = s; }
        asm volatile("s_waitcnt lgkmcnt(0)" ::: "memory"); __builtin_amdgcn_s_barrier(); asm volatile("" ::: "memory");
        const int row = wid * 32 + (lane & 31);
        if (lane < 32) { const float t = (P[row * 4 + 0] + P[row * 4 + 1]) + (P[row * 4 + 2] + P[row * 4 + 3]);
            __hip_atomic_store(xbuf + ((size_t)(u.pm * BM + row) * 8 + u.pn), t, __ATOMIC_RELAXED, __HIP_MEMORY_SCOPE_AGENT); }
        asm volatile("s_waitcnt vmcnt(0)" ::: "memory");
        if (lane == 0) __hip_atomic_fetch_add(cnt + 64 * u.pm, 1u, __ATOMIC_RELAXED, __HIP_MEMORY_SCOPE_AGENT);
        if (wid == 0) { bool dead = false; const unsigned long long t0 = __builtin_amdgcn_s_memrealtime();
            for (;;) {
                if ((unsigned)__builtin_amdgcn_readfirstlane(__hip_atomic_load(cnt + 64 * u.pm, __ATOMIC_RELAXED, __HIP_MEMORY_SCOPE_AGENT)) >= 64u) break;
                if (__builtin_amdgcn_s_memrealtime() - t0 > 2000000ull) { if (lane == 0) __hip_atomic_store(tmo, 1u, __ATOMIC_RELAXED, __HIP_MEMORY_SCOPE_AGENT); dead = true; break; }
                __builtin_amdgcn_s_sleep(2); }
            __builtin_amdgcn_fence(__ATOMIC_ACQUIRE, "agent");
            if (lane == 0) flag[0] = dead ? 1u : 0u; }
        asm volatile("s_waitcnt vmcnt(0) lgkmcnt(0)" ::: "memory"); __builtin_amdgcn_s_barrier(); asm volatile("" ::: "memory");
        const bool bad = flag[0] != 0u;
        if (lane < 32) { const float* slot = xbuf + (size_t)(u.pm * BM + row) * 8; float q = 0.f;
#pragma unroll
            for (int t = 0; t < 8; ++t) q += __hip_atomic_load(slot + t, __ATOMIC_RELAXED, __HIP_MEMORY_SCOPE_AGENT);
            S[row] = 1.0f / sqrtf(q * (1.0f / DM) + RMS_EPS); }
        asm volatile("s_waitcnt lgkmcnt(0)" ::: "memory"); __builtin_amdgcn_s_barrier(); asm volatile("" ::: "memory");
        f32x4 gv[2][2];
#pragma unroll
        for (int bj = 0; bj < 2; ++bj)
#pragma unroll
            for (int n = 0; n < 2; ++n) gv[bj][n] = *(const f32x4*)(gpost + col0 + bj * HALF + n * 16);
        const float qnan = __builtin_nanf("");
#pragma unroll
        for (int ai = 0; ai < 2; ++ai)
#pragma unroll
            for (int m = 0; m < 4; ++m) { const int r = ai * HALF + wr * 64 + m * 16 + fr; const float rs = S[r]; const size_t off = (size_t)(u.pm * BM + r) * DM + col0;
#pragma unroll
                for (int bj = 0; bj < 2; ++bj)
#pragma unroll
                    for (int n = 0; n < 2; ++n) { const f32x4 bs = ai == 0 ? pre[m][bj][n] : *(const f32x4*)(x + off + bj * HALF + n * 16);
                        f32x4 o = bs + acc[ai][bj][m][n] * rs * gv[bj][n];
                        if (bad) o = (f32x4){qnan, qnan, qnan, qnan};
                        *(f32x4*)(out + off + bj * HALF + n * 16) = o; }
                if (m & 1) asm volatile("" ::: "memory"); }
    }
};

template <int MODE>
__device__ __forceinline__ void skinny_phase(const bf16_t* A, const bf16_t* Bt, const bf16_t* MG, bf16_t* OUTB, float* OUTF, float* SSQS, int slice, __attribute__((address_space(3))) unsigned char* ldsl) {
    typedef short bf16x8 __attribute__((ext_vector_type(8)));
    const int tid = threadIdx.x, lane = tid & 63, fr = lane & 15, fq = lane >> 4;
    const int w = __builtin_amdgcn_readfirstlane(tid >> 6);
    const int cb = slice >> 1, rh = slice & 1;
    const int row0 = MP + 64 * rh + fr;
    const bf16_t* ap = A + (size_t)row0 * DM + 256 * w + 8 * fq;
    const bf16_t* bp = Bt + (size_t)(16 * cb + fr) * DM + 256 * w + 8 * fq;
    bf16x8 bf[8], af[4][8];
#pragma unroll
    for (int j = 0; j < 8; ++j) bf[j] = *(const bf16x8*)(bp + 32 * j);
#pragma unroll
    for (int rb = 0; rb < 4; ++rb)
#pragma unroll
        for (int j = 0; j < 8; ++j) af[rb][j] = *(const bf16x8*)(ap + (size_t)rb * 16 * DM + 32 * j);
    f32x4 acc[4];
#pragma unroll
    for (int rb = 0; rb < 4; ++rb) { acc[rb] = (f32x4){0.f, 0.f, 0.f, 0.f};
#pragma unroll
        for (int j = 0; j < 8; ++j) acc[rb] = __builtin_amdgcn_mfma_f32_16x16x32_bf16(bf[j], af[rb][j], acc[rb], 0, 0, 0); }
    if (MODE == 0) { const int s = (w < 3) ? 0 : (w < 6 ? 1 : 2);
#pragma unroll
        for (int rb = 0; rb < 4; ++rb) { const bf16_t* gp = MG + (size_t)(row0 + 16 * rb) * 6144 + 16 * cb + 4 * fq;
            const u32x2 ra = *(const u32x2*)gp, rb2 = *(const u32x2*)(gp + 2048), gc = *(const u32x2*)(gp + 4096);
#pragma unroll
            for (int e = 0; e < 4; ++e) { const unsigned a_ = e < 2 ? ra.x : ra.y, b_ = e < 2 ? rb2.x : rb2.y, c_ = e < 2 ? gc.x : gc.y;
                const float f1 = (e & 1) ? __uint_as_float(a_ & 0xffff0000u) : __uint_as_float(a_ << 16), f2 = (e & 1) ? __uint_as_float(b_ & 0xffff0000u) : __uint_as_float(b_ << 16), f3 = (e & 1) ? __uint_as_float(c_ & 0xffff0000u) : __uint_as_float(c_ << 16);
                acc[rb][e] *= f3 * (s < 2 ? f2 : 1.0f) * (s < 1 ? f1 : 1.0f); } } }
    __attribute__((address_space(3))) f32x4* red = (__attribute__((address_space(3))) f32x4*)ldsl;
#pragma unroll
    for (int rb = 0; rb < 4; ++rb) red[(w * 4 + rb) * 64 + lane] = acc[rb];
    __syncthreads();
    if (w < 4) { const int rb = w; f32x4 s = red[rb * 64 + lane];
#pragma unroll
        for (int k = 1; k < 8; ++k) s = s + red[(k * 4 + rb) * 64 + lane];
        const int row = row0 + 16 * rb;
        if (MODE == 0) { u32x2 o; o.x = cvt_pk_bf16(s[0], s[1]); o.y = cvt_pk_bf16(s[2], s[3]); *(u32x2*)(OUTB + (size_t)row * DM + 16 * cb + 4 * fq) = o; }
        else { *(f32x4*)(OUTF + (size_t)(row - MP) * DM + 16 * cb + 4 * fq) = s;
            float q = (s[0] * s[0] + s[1] * s[1]) + (s[2] * s[2] + s[3] * s[3]);
            q += __shfl_xor(q, 16); q += __shfl_xor(q, 32);
            if (fq == 0) SSQS[(size_t)(row - MP) * 128 + cb] = q; }
    }
    __syncthreads();
}
}

namespace att {
typedef unsigned short u16;
#define GA __attribute__((address_space(1)))
using bf16x8 = __attribute__((ext_vector_type(8))) short;
using s16x4  = __attribute__((ext_vector_type(4))) short;
using f32x16 = __attribute__((ext_vector_type(16))) float;
using f32x4  = __attribute__((ext_vector_type(4))) float;
using u32x4  = __attribute__((ext_vector_type(4))) unsigned;
using u32x2  = __attribute__((ext_vector_type(2))) unsigned;
constexpr int SHM_V = 16384, SHM_K = 16384;
constexpr int NBUF = 3;
constexpr int OFF_V = 0, OFF_K = NBUF * SHM_V, OFF_BIAS = 2 * NBUF * SHM_V, OFF_FLAGS = OFF_BIAS + 2304, OFF_ITEM = OFF_FLAGS + 128, ATT_LDS = OFF_ITEM + 64;
constexpr float SB_DONE_LOG2 = -200.0f;
#define KSWZ(row, colB) ((row) * 256 + ((colB) ^ (((row) & 7) << 4)))
#define ATT_SBAR() __builtin_amdgcn_sched_barrier(0)
__device__ __forceinline__ int crow(int r, int hi) { return (r & 3) + 8 * (r >> 2) + 4 * hi; }
__device__ __forceinline__ unsigned cvtpk(float lo, float hi) { return pg8::cvt_pk_bf16(lo, hi); }
__device__ __forceinline__ int v_st(int k, int c) { const int kk = (k & ~0xC) | ((k & 4) << 1) | ((k & 8) >> 1); return ((kk >> 3) * 4 + (c >> 5)) * 512 + ((kk & 7) * 32 + (c & 31)) * 2; }
__device__ __forceinline__ int v_rd_base(int lane) { return ((lane & 3) << 3) | (((lane >> 2) & 3) << 6) | (((lane >> 4) & 1) << 5) | (((lane >> 5) & 1) << 8); }
constexpr int v_rd_off(int d0, int ks, int half) { return d0 * 512 + ks * 4096 + half * 2048; }
template <int OFF> __device__ __forceinline__ s16x4 tr_read(int vb) { s16x4 r; asm volatile("ds_read_b64_tr_b16 %0, %1 offset:%2" : "=&v"(r) : "v"(vb), "i"(OFF) : "memory"); return r; }

struct Item {
    int mode;
    int rule;
    const GA u16* Q; int ldq; int nq; int qpos0;
    const GA u16 *kb, *vb; int ldb; int pb_lo, pb_hi;
    const GA float *kf, *vf; int ldf; int pf_lo, pf_hi;
    int pv_lo, pv_hi;
    int kp_first, kp_step, ntiles;
    const GA float* bias;
    GA u16* O; int ldo; const GA u16* G; int ldg;
    int dma;
};

template <bool QPARK>
__device__ __forceinline__ void qkt(f32x16& p0, f32x16& p1, const char* Ks, const bf16x8* qr, const char* qpark, int r32, int hi) {
    p0 = f32x16{}; p1 = f32x16{};
#pragma unroll
    for (int d0 = 0; d0 < 8; ++d0) { const int cb = (d0 * 16 + hi * 8) * 2;
        const bf16x8 b0 = *reinterpret_cast<const bf16x8*>(Ks + KSWZ(r32, cb));
        const bf16x8 b1 = *reinterpret_cast<const bf16x8*>(Ks + KSWZ(32 + r32, cb));
        const bf16x8 q = QPARK ? *reinterpret_cast<const bf16x8*>(qpark + d0 * 1024) : qr[d0];
        p0 = __builtin_amdgcn_mfma_f32_32x32x16_bf16(b0, q, p0, 0, 0, 0);
        p1 = __builtin_amdgcn_mfma_f32_32x32x16_bf16(b1, q, p1, 0, 0, 0); }
}
template <int D0> __device__ __forceinline__ void pv_one(f32x16& od, int vb, bf16x8 pa0, bf16x8 pa1, bf16x8 pa2, bf16x8 pa3) {
    const s16x4 l0 = tr_read<v_rd_off(D0, 0, 0)>(vb), h0 = tr_read<v_rd_off(D0, 0, 1)>(vb), l1 = tr_read<v_rd_off(D0, 1, 0)>(vb), h1 = tr_read<v_rd_off(D0, 1, 1)>(vb);
    const s16x4 l2 = tr_read<v_rd_off(D0, 2, 0)>(vb), h2 = tr_read<v_rd_off(D0, 2, 1)>(vb), l3 = tr_read<v_rd_off(D0, 3, 0)>(vb), h3 = tr_read<v_rd_off(D0, 3, 1)>(vb);
    asm volatile("s_waitcnt lgkmcnt(0)" ::: "memory"); ATT_SBAR();
#define ATT_PK(L, H) (bf16x8){L[0], L[1], L[2], L[3], H[0], H[1], H[2], H[3]}
    od = __builtin_amdgcn_mfma_f32_32x32x16_bf16(ATT_PK(l0, h0), pa0, od, 0, 0, 0);
    od = __builtin_amdgcn_mfma_f32_32x32x16_bf16(ATT_PK(l1, h1), pa1, od, 0, 0, 0);
    od = __builtin_amdgcn_mfma_f32_32x32x16_bf16(ATT_PK(l2, h2), pa2, od, 0, 0, 0);
    od = __builtin_amdgcn_mfma_f32_32x32x16_bf16(ATT_PK(l3, h3), pa3, od, 0, 0, 0);
#undef ATT_PK
}
#define ATT_PK4(P, BASE, OUT) do { const unsigned a0_ = cvtpk(P[BASE + 0], P[BASE + 1]), a1_ = cvtpk(P[BASE + 2], P[BASE + 3]);   \
    const unsigned b0_ = cvtpk(P[BASE + 4], P[BASE + 5]), b1_ = cvtpk(P[BASE + 6], P[BASE + 7]);                              \
    auto r0_ = __builtin_amdgcn_permlane32_swap(a0_, b0_, false, false); auto r1_ = __builtin_amdgcn_permlane32_swap(a1_, b1_, false, false); \
    u32x4 w_ = {r0_[0], r1_[0], r0_[1], r1_[1]}; OUT = *reinterpret_cast<bf16x8*>(&w_); } while (0)

__device__ __forceinline__ void sb_half(f32x16& p, float& carry, bool need_mask, int kbase, int qpos, int pv_lo, int pv_hi, int hi) {
    float T[16];
#pragma unroll
    for (int r = 0; r < 16; ++r) {
        const float z = p[r];
        const float t = __builtin_amdgcn_exp2f(-__builtin_fabsf(z));
        const float l = __builtin_amdgcn_logf(1.0f + t);
        float lm = -(fmaxf(z, 0.f) + l);
        float lp = fminf(z, 0.f) - l;
        if (need_mask) { const int kp = kbase + crow(r, hi); const bool ok = (kp < qpos) && (kp >= pv_lo) && (kp < pv_hi); lm = ok ? lm : 0.f; lp = ok ? lp : -1e30f; }
        T[r] = lm; p[r] = lp;
    }
    float glo[4], ghi[4];
#pragma unroll
    for (int g = 0; g < 4; ++g) {
        T[4 * g + 2] += T[4 * g + 3]; T[4 * g + 1] += T[4 * g + 2]; T[4 * g] += T[4 * g + 1];
        const float gt = T[4 * g];
        auto rr = __builtin_amdgcn_permlane32_swap(__float_as_uint(gt), __float_as_uint(gt), false, false);
        glo[g] = __uint_as_float(rr[0]); ghi[g] = __uint_as_float(rr[1]);
    }
    float SG[4];
    SG[3] = 0.f; SG[2] = glo[3] + ghi[3]; SG[1] = SG[2] + (glo[2] + ghi[2]); SG[0] = SG[1] + (glo[1] + ghi[1]);
    const float tot = SG[0] + (glo[0] + ghi[0]);
#pragma unroll
    for (int g = 0; g < 4; ++g) SG[g] += carry + (hi == 0 ? ghi[g] : 0.f);
#pragma unroll
    for (int r = 0; r < 16; ++r) p[r] = __builtin_amdgcn_exp2f(p[r] + ((r & 3) == 3 ? SG[r >> 2] : SG[r >> 2] + T[r + 1]));
    carry += tot;
}

#define ATT_TILE(Kt, vb_) do { \
            f32x16 p0, p1; \
            qkt<!DMA>(p0, p1, (Kt), qr, qpark, r32, hi); \
            bool need_mask = (kp0 < it.pv_lo) || (kp0 + 64 > it.pv_hi); \
            if (MODE == 0) { \
                need_mask = need_mask || (kp0 + 63 >= it.qpos0 + 32 * wid); \
                sb_half(p1, carry, need_mask, kp0 + 32, qpos, it.pv_lo, it.pv_hi, hi); \
                sb_half(p0, carry, need_mask, kp0, qpos, it.pv_lo, it.pv_hi, hi); \
            } else { \
                if (has_bias) {       \
                    const int dlo_ = it.qpos0 + 32 * wid - kp0 - 63, dhi_ = it.qpos0 + 32 * wid + 31 - kp0;       \
                    if (dlo_ >= 256) { const float c_ = biasT[0]; \
                        _Pragma("unroll") for (int r = 0; r < 16; ++r) { p0[r] += c_; p1[r] += c_; } } \
                    else if (dlo_ > -256 && dhi_ < 256) { const float* rb_ = biasT + (256 - qpos + kp0 + 4 * hi);              \
                        _Pragma("unroll") for (int r = 0; r < 16; ++r) { p0[r] += rb_[(r & 3) + 8 * (r >> 2)]; p1[r] += rb_[32 + (r & 3) + 8 * (r >> 2)]; } } \
                    else { \
                        _Pragma("unroll") for (int r = 0; r < 16; ++r) { const int kp = kp0 + crow(r, hi); \
                            int i0_ = 256 - qpos + kp; i0_ = i0_ < 0 ? 0 : (i0_ > 512 ? 512 : i0_); \
                            int i1_ = 288 - qpos + kp; i1_ = i1_ < 0 ? 0 : (i1_ > 512 ? 512 : i1_); \
                            p0[r] += biasT[i0_]; p1[r] += biasT[i1_]; } } \
                } \
                if (need_mask) { \
                    _Pragma("unroll") for (int r = 0; r < 16; ++r) { const int kp = kp0 + crow(r, hi); \
                        if (!(kp >= it.pv_lo && kp < it.pv_hi)) p0[r] = -1e30f; \
                        if (!(kp + 32 >= it.pv_lo && kp + 32 < it.pv_hi)) p1[r] = -1e30f; } \
                } \
                float pmax = p0[0]; \
                _Pragma("unroll") for (int r = 1; r < 16; ++r) pmax = fmaxf(pmax, p0[r]); \
                _Pragma("unroll") for (int r = 0; r < 16; ++r) pmax = fmaxf(pmax, p1[r]); \
                { auto rr = __builtin_amdgcn_permlane32_swap(__float_as_uint(pmax), __float_as_uint(pmax), false, false); pmax = fmaxf(__uint_as_float(rr[0]), __uint_as_float(rr[1])); } \
                float mn = m_reg, alpha = 1.f;                  \
                if (!__all(pmax - m_reg <= 8.0f)) { mn = fmaxf(m_reg, pmax); alpha = __builtin_amdgcn_exp2f(m_reg - mn); m_reg = mn; } \
                float ps = 0.f; \
                _Pragma("unroll") for (int r = 0; r < 16; ++r) { p0[r] = __builtin_amdgcn_exp2f(p0[r] - mn); ps += p0[r]; } \
                _Pragma("unroll") for (int r = 0; r < 16; ++r) { p1[r] = __builtin_amdgcn_exp2f(p1[r] - mn); ps += p1[r]; } \
                { auto rr = __builtin_amdgcn_permlane32_swap(__float_as_uint(ps), __float_as_uint(ps), false, false); ps = __uint_as_float(rr[0]) + __uint_as_float(rr[1]); } \
                l_reg = l_reg * alpha + ps; \
                if (__any(alpha < 1.f)) { \
                    _Pragma("unroll") for (int d = 0; d < 4; ++d) \
                        _Pragma("unroll") for (int r = 0; r < 16; ++r) o[d][r] *= alpha; } \
            } \
            bf16x8 pa0, pa1, pa2, pa3; \
            ATT_PK4(p0, 0, pa0); ATT_PK4(p0, 8, pa1); ATT_PK4(p1, 0, pa2); ATT_PK4(p1, 8, pa3); \
            const int vbt_ = (vb_); \
            pv_one<0>(o[0], vbt_, pa0, pa1, pa2, pa3); pv_one<1>(o[1], vbt_, pa0, pa1, pa2, pa3); pv_one<2>(o[2], vbt_, pa0, pa1, pa2, pa3); pv_one<3>(o[3], vbt_, pa0, pa1, pa2, pa3); \
        } while (0)

template <int MODE, bool DMA>
__device__ __forceinline__ void run_item(const Item& it, char* lds, __attribute__((address_space(3))) unsigned char* ldsl) {
    typedef __attribute__((address_space(3))) unsigned las_u32;
    const int tid = threadIdx.x, lane = tid & 63, r32 = lane & 31, hi = lane >> 5;
    const int wid = __builtin_amdgcn_readfirstlane(tid >> 6);
    char* V_lds = lds + OFF_V; char* K_lds = lds + OFF_K;
    float* biasT = (float*)(lds + OFF_BIAS);
    volatile __attribute__((address_space(3))) int* flags = (volatile __attribute__((address_space(3))) int*)(ldsl + OFF_FLAGS);
    const bool has_bias = (MODE == 1) && (it.bias != nullptr);
    const bool wave_rows = (32 * wid < it.nq);
    int qrow = 32 * wid + r32; if (qrow >= it.nq) qrow = it.nq - 1;
    const int qpos = it.qpos0 + 32 * wid + r32;
    bf16x8 qr[8];
    char* const qpark = K_lds + 2 * SHM_K + (wid & 1) * 8192 + lane * 16;
#define ATT_ITEM_LOADS() do { \
    if (has_bias) for (int i = tid; i < 513; i += 512) biasT[i] = it.bias[512 - i] * LOG2E; \
    { const GA u16* Qw = it.Q + (size_t)qrow * it.ldq + hi * 8; \
      _Pragma("unroll") for (int d0 = 0; d0 < 8; ++d0) { const bf16x8 q = *reinterpret_cast<const GA bf16x8*>(Qw + d0 * 16); \
          if constexpr (DMA) qr[d0] = q; else { if (wid < 2) *reinterpret_cast<bf16x8*>(qpark + d0 * 1024) = q; } } } \
    } while (0)
    f32x16 o[4]; o[0] = f32x16{}; o[1] = f32x16{}; o[2] = f32x16{}; o[3] = f32x16{};
    float carry = 0.f, m_reg = -1e30f, l_reg = 0.f;
    const int vb0 = (int)(uintptr_t)V_lds + v_rd_base(lane);
    const int nt = it.ntiles;
    bool wdone = !wave_rows;
    if constexpr (!DMA) ATT_ITEM_LOADS();
    if constexpr (DMA) {
        unsigned koff[2], voff[2];
#pragma unroll
        for (int i = 0; i < 2; ++i) { const int p = wid + 8 * i;
            const int krow = 4 * p + (lane >> 4), kch = (lane & 15) ^ (krow & 7);
            koff[i] = (unsigned)(krow * it.ldb * 2 + kch * 16);
            const int s = 2 * p + (lane >> 5), kk = 8 * (s >> 2) + ((lane & 31) >> 2), k = (kk & ~0xC) | ((kk & 4) << 1) | ((kk & 8) >> 1), c = 32 * (s & 3) + 8 * (lane & 3);
            voff[i] = (unsigned)(k * it.ldb * 2 + c * 2); }
        const GA char* kbase = (const GA char*)it.kb; const GA char* vbase = (const GA char*)it.vb;
#define ATT_DMA(b, kp0_) do { const size_t to_ = (size_t)((kp0_) - it.pb_lo) * (size_t)it.ldb * 2; \
        _Pragma("unroll") for (int i_ = 0; i_ < 2; ++i_) { \
            __builtin_amdgcn_global_load_lds((const GA unsigned*)(kbase + to_ + koff[i_]), (las_u32*)(ldsl + OFF_K + (b) * SHM_K + (wid + 8 * i_) * 1024), 16, 0, 0); \
            __builtin_amdgcn_global_load_lds((const GA unsigned*)(vbase + to_ + voff[i_]), (las_u32*)(ldsl + OFF_V + (b) * SHM_V + (wid + 8 * i_) * 1024), 16, 0, 0); } } while (0)
        ATT_DMA(0, it.kp_first);
        if (nt > 1) ATT_DMA(1, it.kp_first + it.kp_step);
        ATT_ITEM_LOADS();
        int cur = 0;
        for (int j = 0; j < nt; ++j) {
            const int kp0 = it.kp_first + j * it.kp_step;
            if (j + 1 < nt) asm volatile("s_waitcnt vmcnt(4) lgkmcnt(0)\n\ts_barrier" ::: "memory");
            else            asm volatile("s_waitcnt vmcnt(0) lgkmcnt(0)\n\ts_barrier" ::: "memory");
            if (MODE == 0 && SB_EARLY_EXIT && j > 0) {
                int alld = 1;
#pragma unroll
                for (int w = 0; w < 8; ++w) alld &= flags[((j - 1) & 1) * 8 + w];
                if (alld) break;
            }
            if (j + 2 < nt) { const int b2 = (cur >= 1) ? cur - 1 : cur + 2; ATT_DMA(b2, kp0 + 2 * it.kp_step); }
            bool active = wave_rows;
            if (it.rule == 1) active = active && (kp0 <= it.qpos0 + 32 * wid + 30) && !wdone;
            if (it.rule == 2) { const int ct = kp0 >> 6, cw = (it.qpos0 + 32 * wid) >> 6; active = active && (ct >= cw - 8) && (ct <= cw); }
            if (active) ATT_TILE(K_lds + cur * SHM_K, vb0 + cur * SHM_V);
            if (MODE == 0 && SB_EARLY_EXIT) {
                if (wave_rows && !wdone) { const bool rowdone = (carry < SB_DONE_LOG2) || (32 * wid + r32 >= it.nq); wdone = __all(rowdone); }
                if (lane == 0) flags[(j & 1) * 8 + wid] = wdone ? 1 : 0;
            }
            cur = (cur == NBUF - 1) ? 0 : cur + 1;
        }
        asm volatile("s_waitcnt vmcnt(0) lgkmcnt(0)\n\ts_barrier" ::: "memory");
#undef ATT_DMA
    } else {
    const int sr = tid >> 4, sc = (tid & 15) * 8;
    const int vst0 = v_st(sr, sc), vst1 = v_st(32 + sr, sc), kst0 = KSWZ(sr, sc * 2), kst1 = KSWZ(32 + sr, sc * 2);
    f32x4 sK0a, sK0b, sK1a, sK1b, sV0a, sV0b, sV1a, sV1b;
#define ATT_LD(p, A, B, kbp, kfp) do { const int p_ = (p); const bool isb_ = (p_ >= it.pb_lo && p_ < it.pb_hi), isf_ = (p_ >= it.pf_lo && p_ < it.pf_hi); \
        const GA char* a0_ = isf_ ? (const GA char*)(kfp + (size_t)(p_ - it.pf_lo) * it.ldf + sc) : (const GA char*)(kbp + (size_t)(isb_ ? p_ - it.pb_lo : 0) * it.ldb + sc); \
        const f32x4 la_ = *reinterpret_cast<const GA f32x4*>(a0_); const f32x4 lb_ = *reinterpret_cast<const GA f32x4*>(a0_ + (isf_ ? 16 : 0)); \
        A = la_; B = lb_; } while (0)
#define ATT_CV(p, A, B, OUT) do { const int p_ = (p); const bool isb_ = (p_ >= it.pb_lo && p_ < it.pb_hi), isf_ = (p_ >= it.pf_lo && p_ < it.pf_hi); \
        u32x4 w_ = {cvtpk(A[0], A[1]), cvtpk(A[2], A[3]), cvtpk(B[0], B[1]), cvtpk(B[2], B[3])}; const u32x4 r_ = __builtin_bit_cast(u32x4, A); \
        w_.x = isf_ ? w_.x : (isb_ ? r_.x : 0u); w_.y = isf_ ? w_.y : (isb_ ? r_.y : 0u); w_.z = isf_ ? w_.z : (isb_ ? r_.z : 0u); w_.w = isf_ ? w_.w : (isb_ ? r_.w : 0u); \
        OUT = *reinterpret_cast<bf16x8*>(&w_); } while (0)
#define ATT_SLOAD(kp0) do { ATT_LD((kp0) + sr, sK0a, sK0b, it.kb, it.kf); ATT_LD((kp0) + 32 + sr, sK1a, sK1b, it.kb, it.kf); \
        ATT_LD((kp0) + sr, sV0a, sV0b, it.vb, it.vf); ATT_LD((kp0) + 32 + sr, sV1a, sV1b, it.vb, it.vf); } while (0)
#define ATT_SWRITE(b, kp0) do { bf16x8 t_; \
        ATT_CV((kp0) + sr, sK0a, sK0b, t_); *reinterpret_cast<bf16x8*>(K_lds + (b) * SHM_K + kst0) = t_; \
        ATT_CV((kp0) + 32 + sr, sK1a, sK1b, t_); *reinterpret_cast<bf16x8*>(K_lds + (b) * SHM_K + kst1) = t_; \
        ATT_CV((kp0) + sr, sV0a, sV0b, t_); *reinterpret_cast<bf16x8*>(V_lds + (b) * SHM_V + vst0) = t_; \
        ATT_CV((kp0) + 32 + sr, sV1a, sV1b, t_); *reinterpret_cast<bf16x8*>(V_lds + (b) * SHM_V + vst1) = t_; } while (0)
    sK0b = sK1b = sV0b = sV1b = (f32x4){0.f, 0.f, 0.f, 0.f};
    ATT_SLOAD(it.kp_first); ATT_SWRITE(0, it.kp_first);
    __syncthreads();
    for (int j = 0; j < nt; ++j) {
        const int kp0 = it.kp_first + j * it.kp_step, kpn = kp0 + it.kp_step, cur = j & 1;
        const bool more = (j + 1 < nt);
        if (more) ATT_SLOAD(kpn);
        bool active = wave_rows;
        if (it.rule == 1) active = active && (kp0 <= it.qpos0 + 32 * wid + 30) && !wdone;
        if (it.rule == 2) { const int ct = kp0 >> 6, cw = (it.qpos0 + 32 * wid) >> 6; active = active && (ct >= cw - 8) && (ct <= cw); }
        if (active) ATT_TILE(K_lds + cur * SHM_K, vb0 + cur * SHM_V);
        if (MODE == 0 && SB_EARLY_EXIT) {
            if (wave_rows && !wdone) { const bool rowdone = (carry < SB_DONE_LOG2) || (32 * wid + r32 >= it.nq); wdone = __all(rowdone); }
            if (lane == 0) flags[cur * 8 + wid] = wdone ? 1 : 0;
        }
        if (more) ATT_SWRITE(cur ^ 1, kpn);
        __syncthreads();
        if (MODE == 0 && SB_EARLY_EXIT) {
            int alld = 1;
#pragma unroll
            for (int w = 0; w < 8; ++w) alld &= flags[cur * 8 + w];
            if (alld) break;
        }
    }
#undef ATT_LD
#undef ATT_CV
#undef ATT_SLOAD
#undef ATT_SWRITE
    }
    if (wave_rows) {
        const int nrow = it.nq - 32 * wid;
        const int prow = lane >> 4, piece = lane & 15;
        u32x4 gq[8];
#pragma unroll
        for (int j = 0; j < 8; ++j) { int rl = 4 * j + prow; rl = rl < nrow ? rl : nrow - 1;
            gq[j] = *reinterpret_cast<const GA u32x4*>(it.G + (size_t)(32 * wid + rl) * it.ldg + 8 * piece); }
        const float inv = (MODE == 1) ? __builtin_amdgcn_rcpf(l_reg) : 1.0f;
        char* const stg = lds + wid * 8704 + r32 * 272 + hi * 8;
#pragma unroll
        for (int d0 = 0; d0 < 4; ++d0)
#pragma unroll
            for (int g = 0; g < 4; ++g) { u32x2 w; w.x = cvtpk(o[d0][4 * g] * inv, o[d0][4 * g + 1] * inv); w.y = cvtpk(o[d0][4 * g + 2] * inv, o[d0][4 * g + 3] * inv);
                *reinterpret_cast<u32x2*>(stg + d0 * 64 + g * 16) = w; }
        asm volatile("s_waitcnt lgkmcnt(0)" ::: "memory");
        const char* const rd = lds + wid * 8704 + prow * 272 + piece * 16;
#pragma unroll
        for (int j = 0; j < 8; ++j) { const int rl = 4 * j + prow;
            const u32x4 ov = *reinterpret_cast<const u32x4*>(rd + j * 4 * 272); const u32x4 gg = gq[j]; u32x4 w;
#pragma unroll
            for (int e = 0; e < 4; ++e) w[e] = cvtpk(__uint_as_float(ov[e] << 16) * __uint_as_float(gg[e] << 16), __uint_as_float(ov[e] & 0xffff0000u) * __uint_as_float(gg[e] & 0xffff0000u));
            if (rl < nrow) *reinterpret_cast<GA u32x4*>(it.O + (size_t)(32 * wid + rl) * it.ldo + 8 * piece) = w; }
    }
    __syncthreads();
}
#undef ATT_TILE
#undef ATT_ITEM_LOADS
#undef GA
}

constexpr int NWAVES = 8;
constexpr int N_LAUNCHES = MK_N_LAUNCHES;
constexpr int PER_PHASE = 6;

constexpr size_t al256(size_t x) { return (x + 255) & ~(size_t)255; }
constexpr size_t WS_CTL = 0, CTL_ZERO_BYTES = 65536, CTL_BYTES = 1u << 20;
constexpr size_t WS_WCAT = CTL_BYTES;
constexpr size_t WS_WUP  = WS_WCAT + (size_t)NCAT * DM * 2;
constexpr size_t WS_WOUT = WS_WUP + (size_t)DM * DM * 2;
constexpr size_t WS_ACAT = WS_WOUT + (size_t)DM * DM * 2;
constexpr size_t SZ768 = (size_t)MIN_ * 768 * 2, SZ512 = (size_t)MIN_ * 512 * 2;
constexpr size_t WS_QSB = WS_ACAT + (size_t)MA * DM * 2, WS_KSB = WS_QSB + SZ768, WS_VSB = WS_KSB + SZ768, WS_GSB = WS_VSB + SZ768;
constexpr size_t WS_QBD = WS_GSB + SZ768, WS_KBD = WS_QBD + SZ768, WS_VBD = WS_KBD + SZ768, WS_GBD = WS_VBD + SZ768;
constexpr size_t WS_QMM = WS_GBD + SZ768, WS_GMM = WS_QMM + SZ512;
constexpr size_t WS_MG  = WS_GMM + SZ512;
constexpr size_t WS_MK  = WS_MG + (size_t)MIN_ * 6144 * 2, WS_MV = WS_MK + (size_t)512 * 512 * 2;
constexpr size_t WS_AUP = WS_MV + (size_t)512 * 512 * 2;
constexpr size_t WS_SSQ = WS_AUP + (size_t)MIN_ * DM * 2;
constexpr size_t WS_SSQS = WS_SSQ + (size_t)MIN_ * 32 * 4;
constexpr size_t WS_XBUF = WS_SSQS + (size_t)MS * 128 * 4;
constexpr size_t WS_YB = WS_XBUF + (size_t)MP * 8 * 4;
constexpr size_t WS_KBC = WS_YB, WS_VBC = WS_KBC + (size_t)DB * 576 * 768 * 2, WS_MKC = WS_VBC + (size_t)DB * 576 * 768 * 2, WS_MVC = WS_MKC + (size_t)DB * NMEM * 512 * 2;
static_assert(WS_MVC + (size_t)DB * NMEM * 512 * 2 <= WS_YB + (size_t)MP * DM * 2, "decode caches inside the YB region");
constexpr size_t WS_END = WS_YB + (size_t)MP * DM * 2;
static_assert(WS_WCAT % 256 == 0 && WS_QSB % 256 == 0 && WS_MG % 256 == 0 && WS_AUP % 256 == 0 && WS_SSQ % 256 == 0, "alignment");
constexpr int CW_TMO = 0, CW_WORK = 64, CW_BAR = 4096, CW_PANEL = 8192;
constexpr int OUT_ELEMS = 32112640;

constexpr int RING_BYTES = 131072, LDSCTL_OFF = RING_BYTES, MISC_OFF = LDSCTL_OFF + 320, STG_OFF = 147456, LDS_BYTES = 163840;
static_assert(att::ATT_LDS <= RING_BYTES, "attention scratch inside the ring region");

#define GAS __attribute__((address_space(1)))
#define LAS __attribute__((address_space(3)))
typedef unsigned short bf16;
typedef unsigned v4u __attribute__((ext_vector_type(4)));
typedef float f32x4 __attribute__((ext_vector_type(4)));
typedef GAS unsigned gu32;
#define RLX_AGENT __ATOMIC_RELAXED, __HIP_MEMORY_SCOPE_AGENT
#define LDS_WAIT() asm volatile("s_waitcnt lgkmcnt(0)" ::: "memory")
__device__ __forceinline__ unsigned pk2(float lo, float hi) { return pg8::cvt_pk_bf16(lo, hi); }

#define XB_TMO      128
#define XB_XCNT(j)  (256  + 64 * (j))
#define XB_XSUB(j)  (1280 + 64 * (j))
#define XB_XGEN(j)  (2304 + 64 * (j))
#define XB_TOP      3328
#define XB_TOPGEN   3392
#define XCD_BAR_WORDS 3456
#define XB_SPIN_CAP (1u << 18)
__device__ __forceinline__ unsigned xb_ld(unsigned* p)              { return __hip_atomic_load(p, __ATOMIC_RELAXED, __HIP_MEMORY_SCOPE_AGENT); }
__device__ __forceinline__ unsigned xb_add(unsigned* p, unsigned v) { return __hip_atomic_fetch_add(p, v, __ATOMIC_RELAXED, __HIP_MEMORY_SCOPE_AGENT); }
__device__ __forceinline__ unsigned xb_xcc_id() { return (unsigned)__builtin_amdgcn_s_getreg((3 << 11) | 20) & 0xFu; }
#define XB_SPIN(cond, bar) do { unsigned _sp = 0; while (cond) { __builtin_amdgcn_s_sleep(1); \
    if ((++_sp & 255u) == 0u) { if (xb_ld(&(bar)[XB_TMO])) break; if (_sp > XB_SPIN_CAP) { atomicAdd(&(bar)[XB_TMO], 1u); break; } } } } while (0)
struct XcdBarrier { unsigned* bar; unsigned x; volatile LAS unsigned* st; };
__device__ __forceinline__ XcdBarrier xcd_barrier_post(unsigned* bar, volatile LAS unsigned* st) {
    XcdBarrier b; b.bar = bar; b.x = xb_xcc_id(); b.st = st;
    if (threadIdx.x == 0) (void)xb_add(&bar[XB_XCNT(b.x)], 1u);
    return b;
}
__device__ __forceinline__ void xcd_barrier_complete(unsigned* bar, unsigned x, unsigned& nloc, unsigned& nx) {
    const unsigned G = gridDim.x * gridDim.y * gridDim.z;
    unsigned sum, cnt, mine, sp = 0u;
    for (;;) {
        sum = 0u; cnt = 0u; mine = 0u;
#pragma unroll
        for (unsigned j = 0; j < 16; ++j) { const unsigned c = xb_ld(&bar[XB_XCNT(j)]); sum += c; cnt += (c > 0u) ? 1u : 0u; mine = (j == x) ? c : mine; }
        if (sum == G) break;
        __builtin_amdgcn_s_sleep(1);
        if ((++sp & 255u) == 0u) { if (xb_ld(&bar[XB_TMO])) break; if (sp > XB_SPIN_CAP) { atomicAdd(&bar[XB_TMO], 1u); break; } }
    }
    nloc = mine > 0u ? mine : 1u; nx = cnt > 0u ? cnt : 1u;
}
__device__ __forceinline__ void xcd_barrier(const XcdBarrier& b) {
    asm volatile("s_waitcnt vmcnt(0)" ::: "memory");
    __syncthreads();
    if (threadIdx.x == 0) {
        unsigned* bar = b.bar;
        __builtin_amdgcn_s_waitcnt(0);
        unsigned nloc = b.st[0], nx = b.st[1];
        if (nloc == 0u) { xcd_barrier_complete(bar, b.x, nloc, nx); b.st[0] = nloc; b.st[1] = nx; }
        const unsigned old = xb_add(&bar[XB_XSUB(b.x)], 1u);
        const unsigned gen = old / nloc;
        if (old + 1u == (gen + 1u) * nloc) {
            __builtin_amdgcn_fence(__ATOMIC_RELEASE, "agent");
            asm volatile("s_waitcnt vmcnt(0)" ::: "memory");
            const unsigned og = xb_add(&bar[XB_TOP], 1u);
            const unsigned tg = og / nx;
            if (og + 1u == (tg + 1u) * nx) xb_add(&bar[XB_TOPGEN], 1u);
            else XB_SPIN(xb_ld(&bar[XB_TOPGEN]) == tg, bar);
            __builtin_amdgcn_fence(__ATOMIC_ACQUIRE, "agent");
            xb_add(&bar[XB_XGEN(b.x)], 1u);
            asm volatile("s_waitcnt vmcnt(0)" ::: "memory");
        } else {
            XB_SPIN(xb_ld(&bar[XB_XGEN(b.x)]) == gen, bar);
            __builtin_amdgcn_fence(__ATOMIC_ACQUIRE, "agent");
            asm volatile("s_waitcnt vmcnt(0)" ::: "memory");
        }
    }
    __syncthreads();
}

struct Frame {
    LAS unsigned char* lds;
    volatile LAS unsigned* MISC;
    gu32* ctl;
    int vcu, G;
    const float *x_prompt, *x_sample, *c_sbk, *c_sbv, *c_bdk, *c_bdv, *c_mk, *c_mv, *mem_prompt, *g_pre, *w_in, *rel_bias, *g_mem, *w_mem_kv, *w_up_sb, *w_up_band, *w_up_mem, *w_out, *g_post;
    float* out;
    bf16 *WCAT, *WUP, *WOUT, *ACAT, *QSB, *KSB, *VSB, *GSB, *QBD, *KBD, *VBD, *GBD, *QMM, *GMM, *MG, *MK, *MV, *AUP, *MERGED;
    float* SSQ; float* SSQS; bf16* YB; bf16 *KBC, *VBC, *MKC, *MVC;
};

__device__ __forceinline__ int fresh_tid() { int t = threadIdx.x; asm volatile("" : "+v"(t)); return t; }
__device__ __forceinline__ float wave_sum(float v) {
#pragma unroll
    for (int o = 1; o < 64; o <<= 1) v += __shfl_xor(v, o);
    return v;
}
__device__ __forceinline__ void p0_transpose_item(const float* W, int N, bf16* WT, int ldt, int row_off, int col_off, LAS float* scr, int item, int lane) {
    const int nblk = N / 32, kb = item / nblk, nb = item % nblk, k0 = 64 * kb, n0 = 32 * nb;
    f32x4 wv[8];
#pragma unroll
    for (int i = 0; i < 8; ++i) wv[i] = *(const GAS f32x4*)(W + (size_t)(k0 + (lane >> 3) + 8 * i) * N + n0 + 4 * (lane & 7));
#pragma unroll
    for (int i = 0; i < 8; ++i) { LAS float* d = scr + ((lane >> 3) + 8 * i) * 33 + 4 * (lane & 7); d[0] = wv[i].x; d[1] = wv[i].y; d[2] = wv[i].z; d[3] = wv[i].w; }
    LDS_WAIT(); asm volatile("" ::: "memory");
    const int c = lane & 7;
#pragma unroll
    for (int j = 0; j < 4; ++j) { const int n = (lane >> 3) + 8 * j; const LAS float* s = scr + (8 * c) * 33 + n;
        v4u o; o.x = pk2(s[0 * 33], s[1 * 33]); o.y = pk2(s[2 * 33], s[3 * 33]); o.z = pk2(s[4 * 33], s[5 * 33]); o.w = pk2(s[6 * 33], s[7 * 33]);
        *(GAS v4u*)(WT + (size_t)(row_off + n0 + n) * ldt + col_off + k0 + 8 * c) = o; }
    LDS_WAIT(); asm volatile("" ::: "memory");
}
__device__ __forceinline__ void rms_row_to_bf16(const float* xrow, const float* g, bf16* orow, int lane) {
    const GAS f32x4* xr = (const GAS f32x4*)xrow + lane; const GAS f32x4* gr = (const GAS f32x4*)g + lane;
    f32x4 v[8]; float s = 0.f;
#pragma unroll
    for (int j = 0; j < 8; ++j) { v[j] = xr[64 * j]; s += (v[j].x * v[j].x + v[j].y * v[j].y) + (v[j].z * v[j].z + v[j].w * v[j].w); }
    const float r = 1.0f / sqrtf(wave_sum(s) * (1.0f / DM) + RMS_EPS);
    GAS unsigned long long* o8 = (GAS unsigned long long*)orow + lane;
#pragma unroll
    for (int j = 0; j < 8; ++j) { const f32x4 gv = gr[64 * j];
        o8[64 * j] = (unsigned long long)pk2(v[j].x * r * gv.x, v[j].y * r * gv.y) | ((unsigned long long)pk2(v[j].z * r * gv.z, v[j].w * r * gv.w) << 32); }
}
__device__ __forceinline__ void p0_t_load(const float* W, int N, int item, int lane, f32x4 (&wv)[8]) {
    const int nblk = N / 32, kb = item / nblk, nb = item % nblk, k0 = 64 * kb, n0 = 32 * nb;
#pragma unroll
    for (int i = 0; i < 8; ++i) wv[i] = *(const GAS f32x4*)(W + (size_t)(k0 + (lane >> 3) + 8 * i) * N + n0 + 4 * (lane & 7));
}
__device__ __forceinline__ int wcat_row(int c) {
    int kind, idx;
    if (c >= 7168) { const int d = c - 7168; kind = d >> 11; idx = d & 2047; }
    else { const int p = c >> 8;
        if (p < 9) return c;
        if (p < 12) { kind = 3; idx = c - 2304; }
        else if (p < 21) return c - 768;
        else if (p < 24) { kind = 3; idx = 768 + (c - 5376); }
        else if (p < 26) return c - 1536;
        else { kind = 3; idx = 1536 + (c - 6656); } }
    const int t = idx >> 6, q = idx & 63;
    return (20 + t) * 256 + 128 * (kind >> 1) + 4 * (kind & 1) + 32 * (q >> 4) + 8 * ((q >> 2) & 3) + (q & 3);
}
__device__ __forceinline__ float wcat_scale(int c) { const int p = c >> 8; return (p < 3 || (p >= 12 && p < 15) || p == 24 || p == 25) ? QSCALE : ((p >= 9 && p < 12) || p >= 21) ? -LOG2E : 1.0f; }
template <bool MAP>
__device__ __forceinline__ void p0_t_finish(const f32x4 (&wv)[8], int N, bf16* WT, int ldt, int row_off, int col_off, LAS float* scr, int item, int lane) {
    const int nblk = N / 32, kb = item / nblk, nb = item % nblk, k0 = 64 * kb, n0 = 32 * nb;
#pragma unroll
    for (int i = 0; i < 8; ++i) { LAS float* d = scr + ((lane >> 3) + 8 * i) * 33 + 4 * (lane & 7); d[0] = wv[i].x; d[1] = wv[i].y; d[2] = wv[i].z; d[3] = wv[i].w; }
    LDS_WAIT(); asm volatile("" ::: "memory");
    const int c = lane & 7;
#pragma unroll
    for (int j = 0; j < 4; ++j) { const int n = (lane >> 3) + 8 * j; const LAS float* s = scr + (8 * c) * 33 + n;
        const float sc = MAP ? wcat_scale(n0 + n) : 1.0f;
        v4u o; o.x = pk2(s[0 * 33] * sc, s[1 * 33] * sc); o.y = pk2(s[2 * 33] * sc, s[3 * 33] * sc); o.z = pk2(s[4 * 33] * sc, s[5 * 33] * sc); o.w = pk2(s[6 * 33] * sc, s[7 * 33] * sc);
        *(GAS v4u*)(WT + (size_t)(MAP ? wcat_row(n0 + n) : row_off + n0 + n) * ldt + col_off + k0 + 8 * c) = o; }
    LDS_WAIT(); asm volatile("" ::: "memory");
}
__device__ __forceinline__ void rms_load(const float* xrow, int lane, f32x4 (&v)[8]) {
    const GAS f32x4* xr = (const GAS f32x4*)xrow + lane;
#pragma unroll
    for (int j = 0; j < 8; ++j) v[j] = xr[64 * j];
}
__device__ __forceinline__ void rms_finish(const f32x4 (&v)[8], const f32x4 (&gv)[8], bf16* orow, int lane) {
    float s = 0.f;
#pragma unroll
    for (int j = 0; j < 8; ++j) s += (v[j].x * v[j].x + v[j].y * v[j].y) + (v[j].z * v[j].z + v[j].w * v[j].w);
    const float r = 1.0f / sqrtf(wave_sum(s) * (1.0f / DM) + RMS_EPS);
    GAS unsigned long long* o8 = (GAS unsigned long long*)orow + lane;
#pragma unroll
    for (int j = 0; j < 8; ++j) o8[64 * j] = (unsigned long long)pk2(v[j].x * r * gv[j].x, v[j].y * r * gv[j].y) | ((unsigned long long)pk2(v[j].z * r * gv[j].z, v[j].w * r * gv[j].w) << 32);
}
__device__ __forceinline__ void p0_prologue(Frame& F) {
    const int tid_ = fresh_tid(), lane_ = tid_ & 63, wave_ = __builtin_amdgcn_readfirstlane(tid_ >> 6);
    LAS float* scr = (LAS float*)(F.lds + wave_ * 16384);
    const int gw = F.vcu * NWAVES + wave_, NGW = F.G * NWAVES;
    constexpr int I_IN = 32 * (INW / 32), I_MEM = 32 * (1024 / 32), I_USB = 12 * 64, I_UBD = 12 * 64, I_UMM = 8 * 64, I_OUT = 32 * 64;
    constexpr int NI = I_IN + I_MEM;
#define P0_TLOAD(buf, it_) do { if ((it_) < I_IN) p0_t_load(F.w_in, INW, (it_), lane_, buf); else p0_t_load(F.w_mem_kv, 1024, (it_) - I_IN, lane_, buf); } while (0)
#define P0_TFIN(buf, it_) do { if ((it_) < I_IN) p0_t_finish<true>(buf, INW, F.WCAT, DM, 0, 0, scr, (it_), lane_); else p0_t_finish<false>(buf, 1024, F.WCAT, DM, INW, 0, scr, (it_) - I_IN, lane_); } while (0)
    { f32x4 wa[8], wb[8]; int it = gw;
      if (it < NI) P0_TLOAD(wa, it);
      while (it < NI) {
          int it2 = it + NGW; if (it2 < NI) P0_TLOAD(wb, it2);
          P0_TFIN(wa, it); it = it2; if (it >= NI) break;
          it2 = it + NGW; if (it2 < NI) P0_TLOAD(wa, it2);
          P0_TFIN(wb, it); it = it2; } }
#undef P0_TLOAD
#undef P0_TFIN
    if (!LATE_WT) for (int it = gw; it < I_USB + I_UBD + I_UMM + I_OUT; it += NGW) {
        int r = it;
        if (r < I_USB) { p0_transpose_item(F.w_up_sb, DM, F.WUP, DM, 0, 0, scr, r, lane_); continue; } r -= I_USB;
        if (r < I_UBD) { p0_transpose_item(F.w_up_band, DM, F.WUP, DM, 0, 768, scr, r, lane_); continue; } r -= I_UBD;
        if (r < I_UMM) { p0_transpose_item(F.w_up_mem, DM, F.WUP, DM, 0, 1536, scr, r, lane_); continue; } r -= I_UMM;
        p0_transpose_item(F.w_out, DM, F.WOUT, DM, 0, 0, scr, r, lane_);
    }
    { f32x4 gv[8], va[8], vb[8]; const GAS f32x4* gr = (const GAS f32x4*)F.g_pre + lane_;
#pragma unroll
      for (int j = 0; j < 8; ++j) gv[j] = gr[64 * j];
      int m = gw;
      if (m < MP) rms_load(F.x_prompt + (size_t)m * DM, lane_, va);
      while (m < MP) {
          int m2 = m + NGW; if (m2 < MP) rms_load(F.x_prompt + (size_t)m2 * DM, lane_, vb);
          rms_finish(va, gv, F.ACAT + (size_t)m * DM, lane_); m = m2; if (m >= MP) break;
          m2 = m + NGW; if (m2 < MP) rms_load(F.x_prompt + (size_t)m2 * DM, lane_, va);
          rms_finish(vb, gv, F.ACAT + (size_t)m * DM, lane_); m = m2; } }
    for (int m = MP + gw; m < MA; m += NGW) {
        bf16* orow = F.ACAT + (size_t)m * DM;
        if (m < MREAL) rms_row_to_bf16(F.x_sample + (size_t)(m - MP) * DM, F.g_pre, orow, lane_);
        else if (m < MIN_) {
            GAS v4u* o = (GAS v4u*)orow + lane_; GAS v4u* o2 = (GAS v4u*)(F.AUP + (size_t)m * DM) + lane_;
#pragma unroll
            for (int j = 0; j < 4; ++j) { o[64 * j] = (v4u){0u, 0u, 0u, 0u}; o2[64 * j] = (v4u){0u, 0u, 0u, 0u}; }
        }
        else rms_row_to_bf16(F.mem_prompt + (size_t)(m - MMEM0) * DM, F.g_mem, orow, lane_);
    }
}
constexpr int LATE_ITEMS = 128;
__device__ __forceinline__ void late_transpose_item(Frame& F, int j) {
    const int tid_ = fresh_tid(), lane_ = tid_ & 63, wave_ = __builtin_amdgcn_readfirstlane(tid_ >> 6);
    LAS float* scr = (LAS float*)(F.lds + wave_ * 16384);
    constexpr int I_USB = 12 * 64, I_UBD = 12 * 64, I_UMM = 8 * 64;
#pragma unroll 1
    for (int q = 0; q < 4; ++q) {
        int r = (j * 8 + wave_) * 4 + q;
        if (r < I_USB) { p0_transpose_item(F.w_up_sb, DM, F.WUP, DM, 0, 0, scr, r, lane_); continue; } r -= I_USB;
        if (r < I_UBD) { p0_transpose_item(F.w_up_band, DM, F.WUP, DM, 0, 768, scr, r, lane_); continue; } r -= I_UBD;
        if (r < I_UMM) { p0_transpose_item(F.w_up_mem, DM, F.WUP, DM, 0, 1536, scr, r, lane_); continue; } r -= I_UMM;
        p0_transpose_item(F.w_out, DM, F.WOUT, DM, 0, 0, scr, r, lane_);
    }
}
constexpr int CV_BD = DB * 576 * 768 / 32768, CV_MM = DB * NMEM * 512 / 32768, SLACK_ITEMS = LATE_ITEMS + 2 * CV_BD + 2 * CV_MM;
static_assert(DB * 576 * 768 % 32768 == 0 && DB * NMEM * 512 % 32768 == 0, "conversion item size");
template <bool BAND>
__device__ __forceinline__ void slack_convert(const float* src, bf16* dst, int jj, int tid_) {
    constexpr int ld = BAND ? 768 : 512, rows_d = BAND ? 576 : NMEM, rows_s = BAND ? 512 : NMEM;
    f32x4 va[8], vb[8];
#pragma unroll
    for (int it = 0; it < 8; ++it) { const int e = (jj * 4096 + it * 512 + tid_) * 8;
        const int col = e % ld, rowd = e / ld, b = rowd / rows_d, row = rowd % rows_d;
        const float* s = src + ((size_t)(b * rows_s + (row < rows_s ? row : 0)) * ld + col);
        va[it] = *(const GAS f32x4*)s; vb[it] = *(const GAS f32x4*)(s + 4); }
#pragma unroll
    for (int it = 0; it < 8; ++it) { const int e = (jj * 4096 + it * 512 + tid_) * 8; const int row = (e / ld) % rows_d;
        v4u w; w.x = pk2(va[it].x, va[it].y); w.y = pk2(va[it].z, va[it].w); w.z = pk2(vb[it].x, vb[it].y); w.w = pk2(vb[it].z, vb[it].w);
        if (row >= rows_s + DS) w = (v4u){0u, 0u, 0u, 0u};
        if (row < rows_s || row >= rows_s + DS) *(GAS v4u*)(dst + e) = w; }
}
__device__ __forceinline__ void slack_item(Frame& F, int j) {
    if (j < LATE_ITEMS) { late_transpose_item(F, j); return; }
    j -= LATE_ITEMS;
    const int tid_ = fresh_tid();
    if (j < CV_BD) slack_convert<true>(F.c_bdk, F.KBC, j, tid_);
    else if (j < 2 * CV_BD) slack_convert<true>(F.c_bdv, F.VBC, j - CV_BD, tid_);
    else if (j < 2 * CV_BD + CV_MM) slack_convert<false>(F.c_mk, F.MKC, j - 2 * CV_BD, tid_);
    else slack_convert<false>(F.c_mv, F.MVC, j - 2 * CV_BD - CV_MM, tid_);
}
struct P5Row { float sq; unsigned long long yb[8]; f32x4 xv[8]; };
__device__ __forceinline__ void p5_load(Frame& F, int m, int lane, float& sq, unsigned long long (&yb)[8], f32x4 (&xv)[8]) {
    sq = (lane < 32) ? F.SSQ[(size_t)m * 32 + lane] : 0.f;
    const GAS unsigned long long* yb8 = (const GAS unsigned long long*)(F.YB + (size_t)m * DM) + lane; const GAS f32x4* x4 = (const GAS f32x4*)(F.x_prompt + (size_t)m * DM) + lane;
#pragma unroll
    for (int j = 0; j < 8; ++j) { yb[j] = yb8[64 * j]; xv[j] = x4[64 * j]; }
}
__device__ __forceinline__ void p5_finish(Frame& F, int m, int lane, float sq, const unsigned long long (&yb)[8], const f32x4 (&xv)[8], const f32x4 (&gv)[8]) {
    const float r = 1.0f / sqrtf(wave_sum(sq) * (1.0f / DM) + RMS_EPS);
    GAS f32x4* y4 = (GAS f32x4*)(F.out + (size_t)m * DM) + lane;
#pragma unroll
    for (int j = 0; j < 8; ++j) { const unsigned long long yq = yb[j];
        const f32x4 yv = {__uint_as_float((unsigned)yq << 16), __uint_as_float((unsigned)yq & 0xffff0000u), __uint_as_float((unsigned)(yq >> 32) << 16), __uint_as_float((unsigned)(yq >> 32) & 0xffff0000u)};
        __builtin_nontemporal_store(xv[j] + yv * r * gv[j], &y4[64 * j]); }
}
__device__ __forceinline__ void p5_final(Frame& F) {
    const int tid_ = fresh_tid(), lane_ = tid_ & 63, wave_ = __builtin_amdgcn_readfirstlane(tid_ >> 6);
    const int gw = F.vcu * NWAVES + wave_, NGW = F.G * NWAVES;
    f32x4 gv[8]; { const GAS f32x4* g4 = (const GAS f32x4*)F.g_post + lane_;
#pragma unroll
        for (int j = 0; j < 8; ++j) gv[j] = g4[64 * j]; }
    if (!FUSE_RMS) {
        float sa, sb; unsigned long long ya[8], yb[8]; f32x4 xa[8], xb[8]; int m = gw;
        if (m < MP) p5_load(F, m, lane_, sa, ya, xa);
        while (m < MP) {
            int m2 = m + NGW; if (m2 < MP) p5_load(F, m2, lane_, sb, yb, xb);
            p5_finish(F, m, lane_, sa, ya, xa, gv); m = m2; if (m >= MP) break;
            m2 = m + NGW; if (m2 < MP) p5_load(F, m2, lane_, sa, ya, xa);
            p5_finish(F, m, lane_, sb, yb, xb, gv); m = m2; }
    }
    for (int m = MP + gw; m < MREAL; m += NGW) {
        float s = F.SSQS[(size_t)(m - MP) * 128 + lane_] + F.SSQS[(size_t)(m - MP) * 128 + 64 + lane_];
        s = wave_sum(s);
        const float r = 1.0f / sqrtf(s * (1.0f / DM) + RMS_EPS);
        GAS f32x4* y4 = (GAS f32x4*)(F.out + (size_t)16777216 + (size_t)(m - MP) * DM) + lane_; const GAS f32x4* x4 = (const GAS f32x4*)(F.x_sample + (size_t)(m - MP) * DM) + lane_;
#pragma unroll
        for (int j = 0; j < 8; ++j) { const f32x4 yv = y4[64 * j], xv = x4[64 * j]; y4[64 * j] = xv + yv * r * gv[j]; }
    }
}

constexpr int IT_BDP = 192, IT_BDS = 48, IT_SBP = 192, IT_SBS = 48, IT_MMP = 128, IT_MMS = 32;
constexpr int IT_TOTAL = IT_BDP + IT_BDS + IT_SBP + IT_SBS + IT_MMP + IT_MMS;
struct ArgsK { const void* in[19]; float* out; unsigned char* ws; int ph_lo, ph_hi; };
struct ItemSrc {
    const ArgsK* ka; unsigned char* ws;
    __device__ __forceinline__ GAS bf16* W(size_t off) const { return (GAS bf16*)(ws + off); }
    __device__ __forceinline__ const GAS float* I(int k) const { return (const GAS float*)ka->in[k]; }
};
__device__ __forceinline__ att::Item make_item(const ItemSrc& S, int idx) {
    GAS bf16* const QSB = S.W(WS_QSB); GAS bf16* const KSB = S.W(WS_KSB); GAS bf16* const VSB = S.W(WS_VSB); GAS bf16* const GSB = S.W(WS_GSB);
    GAS bf16* const QBD = S.W(WS_QBD); GAS bf16* const KBD = S.W(WS_KBD); GAS bf16* const VBD = S.W(WS_VBD); GAS bf16* const GBD = S.W(WS_GBD);
    GAS bf16* const QMM = S.W(WS_QMM); GAS bf16* const GMM = S.W(WS_GMM); GAS bf16* const MK = S.W(WS_MK); GAS bf16* const MV = S.W(WS_MV); GAS bf16* const AUP = S.W(WS_AUP);
    att::Item it; it.dma = 0; it.bias = nullptr; it.kf = nullptr; it.vf = nullptr; it.ldf = 0; it.pf_lo = 0; it.pf_hi = 0; it.kb = nullptr; it.vb = nullptr; it.ldb = 0; it.pb_lo = 0; it.pb_hi = 0;
    if (idx < 48) idx += 192; else if (idx < 96) idx += 432 - 48; else if (idx < 128) idx += 608 - 96; else if (idx < 320) idx -= 128; else if (idx < 512) idx += 240 - 320; else idx += 480 - 512;
    if (idx < IT_BDP) {
        const int b = idx / 96, h = (idx / 16) % 6, cg = idx % 16; const size_t row0 = (size_t)b * SEQ + 256 * cg;
        it.mode = 1; it.rule = 2; it.Q = QBD + row0 * 768 + h * HD; it.ldq = 768; it.nq = 256; it.qpos0 = 256 * cg;
        it.kb = KBD + (size_t)b * SEQ * 768 + h * HD; it.vb = VBD + (size_t)b * SEQ * 768 + h * HD; it.ldb = 768; it.pb_lo = 0; it.pb_hi = SEQ;
        it.pv_lo = 0; it.pv_hi = SEQ; const int c_lo = (4 * cg - 8) > 0 ? (4 * cg - 8) : 0;
        it.kp_first = 64 * c_lo; it.kp_step = 64; it.ntiles = 4 * cg + 4 - c_lo; it.bias = S.I(11) + h * 513; it.dma = 1;
        it.O = AUP + row0 * DM + 768 + h * HD; it.ldo = DM; it.G = GBD + row0 * 768 + h * HD; it.ldg = 768; return it; }
    idx -= IT_BDP;
    if (idx < IT_BDS) {
        const int b = idx / 6, h = idx % 6; const size_t row0 = (size_t)MP + b * DS;
        it.mode = 1; it.rule = 0; it.Q = QBD + row0 * 768 + h * HD; it.ldq = 768; it.nq = DS; it.qpos0 = PAST;
        if (SLACK_P1) {
            it.kb = S.W(WS_KBC) + (size_t)b * 576 * 768 + h * HD; it.vb = S.W(WS_VBC) + (size_t)b * 576 * 768 + h * HD; it.ldb = 768; it.pb_lo = PAST - 512; it.pb_hi = PAST - 512 + 576; it.dma = 1;
        } else {
            it.kb = KBD + row0 * 768 + h * HD; it.vb = VBD + row0 * 768 + h * HD; it.ldb = 768; it.pb_lo = PAST; it.pb_hi = PAST + DS;
            it.kf = S.I(4) + (size_t)b * 512 * 768 + h * HD; it.vf = S.I(5) + (size_t)b * 512 * 768 + h * HD; it.ldf = 768; it.pf_lo = PAST - 512; it.pf_hi = PAST; }
        it.pv_lo = PAST - 512; it.pv_hi = PAST + DS; it.kp_first = PAST - 512; it.kp_step = 64; it.ntiles = 9; it.bias = S.I(11) + h * 513;
        it.O = AUP + row0 * DM + 768 + h * HD; it.ldo = DM; it.G = GBD + row0 * 768 + h * HD; it.ldg = 768; return it; }
    idx -= IT_BDS;
    if (idx < IT_SBP) {
        const int b = idx % 2, h = (idx / 2) % 6, qb = 15 - idx / 12; const size_t row0 = (size_t)b * SEQ + 256 * qb;
        it.mode = 0; it.rule = 1; it.Q = QSB + row0 * 768 + h * HD; it.ldq = 768; it.nq = 256; it.qpos0 = 256 * qb;
        it.kb = KSB + (size_t)b * SEQ * 768 + h * HD; it.vb = VSB + (size_t)b * SEQ * 768 + h * HD; it.ldb = 768; it.pb_lo = 0; it.pb_hi = SEQ;
        it.pv_lo = 0; it.pv_hi = SEQ; it.kp_first = 64 * (4 * qb + 3); it.kp_step = -64; it.ntiles = 4 * qb + 4; it.dma = 1;
        it.O = AUP + row0 * DM + h * HD; it.ldo = DM; it.G = GSB + row0 * 768 + h * HD; it.ldg = 768; return it; }
    idx -= IT_SBP;
    if (idx < IT_SBS) {
        const int b = idx / 6, h = idx % 6; const size_t row0 = (size_t)MP + b * DS;
        it.mode = 0; it.rule = 1; it.Q = QSB + row0 * 768 + h * HD; it.ldq = 768; it.nq = DS; it.qpos0 = PAST;
        it.kb = KSB + row0 * 768 + h * HD; it.vb = VSB + row0 * 768 + h * HD; it.ldb = 768; it.pb_lo = PAST; it.pb_hi = PAST + DS;
        it.kf = S.I(2) + (size_t)b * PAST * 768 + h * HD; it.vf = S.I(3) + (size_t)b * PAST * 768 + h * HD; it.ldf = 768; it.pf_lo = 0; it.pf_hi = PAST;
        it.pv_lo = 0; it.pv_hi = PAST + DS; it.kp_first = PAST + DS - 64; it.kp_step = -64; it.ntiles = (PAST + DS + 63) / 64;
        it.O = AUP + row0 * DM + h * HD; it.ldo = DM; it.G = GSB + row0 * 768 + h * HD; it.ldg = 768; return it; }
    idx -= IT_SBS;
    if (idx < IT_MMP) {
        const int b = idx / 64, h = (idx / 16) % 4, qb = idx % 16; const size_t row0 = (size_t)b * SEQ + 256 * qb;
        it.mode = 1; it.rule = 0; it.Q = QMM + row0 * 512 + h * HD; it.ldq = 512; it.nq = 256; it.qpos0 = 0;
        it.kb = MK + (size_t)b * NMEM * 512 + h * HD; it.vb = MV + (size_t)b * NMEM * 512 + h * HD; it.ldb = 512; it.pb_lo = 0; it.pb_hi = NMEM;
        it.pv_lo = 0; it.pv_hi = NMEM; it.kp_first = 0; it.kp_step = 64; it.ntiles = 4; it.dma = 1;
        it.O = AUP + row0 * DM + 1536 + h * HD; it.ldo = DM; it.G = GMM + row0 * 512 + h * HD; it.ldg = 512; return it; }
    idx -= IT_MMP;
    {
        const int b = idx / 4, h = idx % 4; const size_t row0 = (size_t)MP + b * DS;
        it.mode = 1; it.rule = 0; it.Q = QMM + row0 * 512 + h * HD; it.ldq = 512; it.nq = DS; it.qpos0 = 0;
        if (SLACK_P1) { it.kb = S.W(WS_MKC) + (size_t)b * NMEM * 512 + h * HD; it.vb = S.W(WS_MVC) + (size_t)b * NMEM * 512 + h * HD; it.ldb = 512; it.pb_lo = 0; it.pb_hi = NMEM; it.dma = 1; }
        else { it.kf = S.I(6) + (size_t)b * NMEM * 512 + h * HD; it.vf = S.I(7) + (size_t)b * NMEM * 512 + h * HD; it.ldf = 512; it.pf_lo = 0; it.pf_hi = NMEM; }
        it.pv_lo = 0; it.pv_hi = NMEM; it.kp_first = 0; it.kp_step = 64; it.ntiles = 4;
        it.O = AUP + row0 * DM + 1536 + h * HD; it.ldo = DM; it.G = GMM + row0 * 512 + h * HD; it.ldg = 512; return it; }
}

struct Args { const void* in[19]; float* out; unsigned char* ws; int ph_lo, ph_hi; };
__global__ void __launch_bounds__(NWAVES * 64, 2) fwd_megakernel(Args args) {
    extern __shared__ __attribute__((aligned(16))) unsigned char lds[];
    Frame F;
    F.lds = (LAS unsigned char*)lds;
    F.MISC = (volatile LAS unsigned*)(F.lds + MISC_OFF);
    F.G = gridDim.x; { const int bx = blockIdx.x; F.vcu = (F.G % 8 == 0) ? (bx % 8) * (F.G / 8) + bx / 8 : bx; }
    unsigned char* ws = args.ws;
    F.ctl = (gu32*)(ws + WS_CTL);
    F.x_prompt = (const float*)args.in[0]; F.x_sample = (const float*)args.in[1]; F.c_sbk = (const float*)args.in[2]; F.c_sbv = (const float*)args.in[3];
    F.c_bdk = (const float*)args.in[4]; F.c_bdv = (const float*)args.in[5]; F.c_mk = (const float*)args.in[6]; F.c_mv = (const float*)args.in[7];
    F.mem_prompt = (const float*)args.in[8]; F.g_pre = (const float*)args.in[9]; F.w_in = (const float*)args.in[10]; F.rel_bias = (const float*)args.in[11];
    F.g_mem = (const float*)args.in[12]; F.w_mem_kv = (const float*)args.in[13]; F.w_up_sb = (const float*)args.in[14]; F.w_up_band = (const float*)args.in[15];
    F.w_up_mem = (const float*)args.in[16]; F.w_out = (const float*)args.in[17]; F.g_post = (const float*)args.in[18];
    F.out = args.out;
    F.WCAT = (bf16*)(ws + WS_WCAT); F.WUP = (bf16*)(ws + WS_WUP); F.WOUT = (bf16*)(ws + WS_WOUT); F.ACAT = (bf16*)(ws + WS_ACAT); F.MERGED = (bf16*)(ws + WS_ACAT);
    F.QSB = (bf16*)(ws + WS_QSB); F.KSB = (bf16*)(ws + WS_KSB); F.VSB = (bf16*)(ws + WS_VSB); F.GSB = (bf16*)(ws + WS_GSB);
    F.QBD = (bf16*)(ws + WS_QBD); F.KBD = (bf16*)(ws + WS_KBD); F.VBD = (bf16*)(ws + WS_VBD); F.GBD = (bf16*)(ws + WS_GBD);
    F.QMM = (bf16*)(ws + WS_QMM); F.GMM = (bf16*)(ws + WS_GMM); F.MG = (bf16*)(ws + WS_MG); F.MK = (bf16*)(ws + WS_MK); F.MV = (bf16*)(ws + WS_MV);
    F.AUP = (bf16*)(ws + WS_AUP); F.SSQ = (float*)(ws + WS_SSQ); F.SSQS = (float*)(ws + WS_SSQS); F.YB = (bf16*)(ws + WS_YB); F.KBC = (bf16*)(ws + WS_KBC); F.VBC = (bf16*)(ws + WS_VBC); F.MKC = (bf16*)(ws + WS_MKC); F.MVC = (bf16*)(ws + WS_MVC);
    for (int u = threadIdx.x; u < (STG_OFF - LDSCTL_OFF) / 4; u += NWAVES * 64) ((LAS unsigned*)(F.lds + LDSCTL_OFF))[u] = 0u;
    __syncthreads();
    XcdBarrier bar; bar.bar = (unsigned*)(F.ctl + CW_BAR); bar.x = 0; bar.st = nullptr;
    if (N_LAUNCHES != PER_PHASE) bar = xcd_barrier_post((unsigned*)(F.ctl + CW_BAR), F.MISC + 8);
#define GRID_BAR() do { if (N_LAUNCHES != PER_PHASE) xcd_barrier(bar); } while (0)
    const int lo = args.ph_lo, hi = args.ph_hi;
#ifdef ONLY_PHASE
#define IN(k) ((k) == ONLY_PHASE && lo <= (k) && (k) < hi)
#else
#define IN(k) (lo <= (k) && (k) < hi)
#endif
#define BOTH(k) (IN(k) && IN((k) + 1))
#ifdef PROBE_PHASE
#define PROBE_T0(k) do { if ((k) == PROBE_PHASE && blockIdx.x == 0 && threadIdx.x == 0) { const unsigned long long t_ = __builtin_amdgcn_s_memrealtime(); F.MISC[20] = (unsigned)t_; F.MISC[21] = (unsigned)(t_ >> 32); } } while (0)
#define PROBE_T1(k) do { if ((k) == PROBE_PHASE) { if (blockIdx.x == 0 && threadIdx.x == 0) { const unsigned long long t1_ = __builtin_amdgcn_s_memrealtime(), t0_ = (unsigned long long)F.MISC[20] | ((unsigned long long)F.MISC[21] << 32); \
        const unsigned long long te_ = t1_ + (unsigned long long)(PROBE_K) * (t1_ - t0_); unsigned n_ = 0; while (__builtin_amdgcn_s_memrealtime() < te_ && ++n_ < (1u << 22)) __builtin_amdgcn_s_sleep(4); } \
        __syncthreads(); GRID_BAR(); } } while (0)
#else
#define PROBE_T0(k) do { } while (0)
#define PROBE_T1(k) do { } while (0)
#endif
    if (IN(0)) { PROBE_T0(0); p0_prologue(F); if (BOTH(0)) GRID_BAR(); PROBE_T1(0); }
    if (IN(1)) {
        PROBE_T0(1);
        pg8::Gemm g{F.ACAT, F.WCAT, MA, NCAT, DM}; ep::InOrder S; S.init(F.G, (int)blockIdx.x);
        ep::EpiIn E{F.QSB, F.KSB, F.VSB, F.GSB, F.QBD, F.KBD, F.VBD, F.GBD, F.QMM, F.GMM, F.MG, F.MK, F.MV, F.out, F.lds + STG_OFF, F.KBC, F.VBC};
        {
        pg8::gemm_phase<ep::EpiIn, ep::InOrder, true, true>(F.lds, g, S, E);
        if (SLACK_P1) {
            volatile LAS int* sl = (volatile LAS int*)(F.MISC + 12);
            for (;;) {
                if (threadIdx.x == 0) *sl = (int)__hip_atomic_fetch_add((unsigned*)(F.ctl + CW_WORK + 64), 1u, RLX_AGENT);
                __syncthreads();
                const int j = __builtin_amdgcn_readfirstlane(*sl);
                __syncthreads();
                if (j >= SLACK_ITEMS) break;
                slack_item(F, j);
            }
        }
        if (BOTH(1)) GRID_BAR(); }
        PROBE_T1(1);
    }
    if (IN(2)) {
        PROBE_T0(2);
        volatile LAS int* slot = (volatile LAS int*)(F.lds + att::OFF_ITEM);
        for (;;) {
            if (threadIdx.x == 0) *slot = (int)__hip_atomic_fetch_add((unsigned*)(F.ctl + CW_WORK), 1u, RLX_AGENT);
            __syncthreads();
            const int idx = __builtin_amdgcn_readfirstlane(*slot);
            __syncthreads();
            if (idx >= IT_TOTAL + ((LATE_WT && !SLACK_P1) ? LATE_ITEMS : 0)) break;
            if (idx >= IT_TOTAL) { late_transpose_item(F, idx - IT_TOTAL); __syncthreads(); continue; }
            const ArgsK* ka = (const ArgsK*)__builtin_amdgcn_kernarg_segment_ptr(); unsigned char* wsl = args.ws;
            asm volatile("" : "+s"(ka), "+s"(wsl));
            const ItemSrc isrc{ka, wsl};
            const att::Item it = make_item(isrc, idx);
            if (it.dma) { if (it.mode == 0) att::run_item<0, true>(it, (char*)lds, F.lds); else att::run_item<1, true>(it, (char*)lds, F.lds); }
            else { if (it.mode == 0) att::run_item<0, false>(it, (char*)lds, F.lds); else att::run_item<1, false>(it, (char*)lds, F.lds); }
        }
        if (BOTH(2)) GRID_BAR();
        PROBE_T1(2);
    }
    if (IN(3)) {
        PROBE_T0(3);
        pg8::Gemm g{F.AUP, F.WUP, MIN_, DM, DM}; ep::MergeOrder S; S.init(F.G, (int)blockIdx.x);
        ep::EpiMerge E{F.MG, F.MERGED};
        {
        pg8::gemm_phase<ep::EpiMerge, ep::MergeOrder, true, true>(F.lds, g, S, E);
        for (int sl = F.vcu; sl < 256; sl += F.G) ep::skinny_phase<0>(F.AUP, F.WUP, F.MG, F.MERGED, nullptr, nullptr, sl, F.lds);
        if (BOTH(3)) GRID_BAR(); }
        PROBE_T1(3);
    }
    if (IN(4)) {
        PROBE_T0(4);
        pg8::Gemm g{F.MERGED, F.WOUT, MP, DM, DM}; pg8::StaticOrder S; S.init(MP, DM, F.G, (int)blockIdx.x);
#if FUSE_RMS
        ep::EpiOutFused E{F.x_prompt, F.out, F.g_post, (float*)(ws + WS_XBUF), (unsigned*)(F.ctl + CW_PANEL), (unsigned*)(F.ctl + CW_TMO)};
        {
        pg8::gemm_phase<ep::EpiOutFused, pg8::StaticOrder, false, true>(F.lds, g, S, E);
#else
        ep::EpiOut E{F.YB, F.SSQ};
        {
        pg8::gemm_phase<ep::EpiOut, pg8::StaticOrder, true, true>(F.lds, g, S, E);
#endif
        for (int sl = F.vcu; sl < 256; sl += F.G) ep::skinny_phase<1>(F.MERGED, F.WOUT, nullptr, nullptr, F.out + 16777216, F.SSQS, sl, F.lds);
        if (BOTH(4)) GRID_BAR(); }
        PROBE_T1(4);
    }
    if (IN(5)) p5_final(F);
#undef IN
#undef BOTH
#undef GRID_BAR
#undef PROBE_T0
#undef PROBE_T1
}

extern "C" void kernel_launch(void* const* d_in, const int* in_sizes, int n_in, void* d_out, int out_size, void* d_ws, size_t ws_size, hipStream_t stream) {
    static int grid = 0;
    if (grid == 0) {
        if (n_in != 19 || in_sizes[0] != MP * DM || in_sizes[10] != DM * INW || out_size != OUT_ELEMS || ws_size < WS_END) {
            fprintf(stderr, "kernel_launch: built for 19 inputs, x_prompt %d, w_in %d, out %d floats, >= %zu bytes of workspace; got n_in %d, in0 %d, in10 %d, out %d, ws %zu; nothing launched\n",
                    MP * DM, DM * INW, OUT_ELEMS, (size_t)WS_END, n_in, n_in > 0 ? in_sizes[0] : -1, n_in > 10 ? in_sizes[10] : -1, out_size, ws_size);
            grid = -1; return; }
        int dev = 0, cus = 0, per_cu = 0;
        if (hipGetDevice(&dev) != hipSuccess || hipDeviceGetAttribute(&cus, hipDeviceAttributeMultiprocessorCount, dev) != hipSuccess) { fprintf(stderr, "kernel_launch: device query failed\n"); grid = -1; return; }
        if (hipFuncSetAttribute((const void*)fwd_megakernel, hipFuncAttributeMaxDynamicSharedMemorySize, LDS_BYTES) != hipSuccess) { fprintf(stderr, "kernel_launch: hipFuncSetAttribute(%d B LDS) failed\n", LDS_BYTES); grid = -1; return; }
        if (hipOccupancyMaxActiveBlocksPerMultiprocessor(&per_cu, (const void*)fwd_megakernel, NWAVES * 64, LDS_BYTES) != hipSuccess || per_cu < 1) {
            fprintf(stderr, "kernel_launch: occupancy query reports %d workgroups per CU; nothing launched\n", per_cu); (void)hipGetLastError(); grid = -1; return; }
        grid = cus;
    }
    if (grid < 0) return;
    if (hipMemsetAsync((char*)d_ws + WS_CTL, 0, CTL_ZERO_BYTES, stream) != hipSuccess) { fprintf(stderr, "kernel_launch: hipMemsetAsync failed\n"); return; }
    Args a{};
    for (int i = 0; i < 19; ++i) a.in[i] = d_in[i];
    a.out = (float*)d_out; a.ws = (unsigned char*)d_ws;
    if (N_LAUNCHES == 1) {
        a.ph_lo = 0; a.ph_hi = PER_PHASE;
        hipLaunchKernelGGL(fwd_megakernel, dim3(grid), dim3(NWAVES * 64), LDS_BYTES, stream, a);
    } else {
        for (int li = 0; li < PER_PHASE; ++li) { a.ph_lo = li; a.ph_hi = li + 1; hipLaunchKernelGGL(fwd_megakernel, dim3(grid), dim3(NWAVES * 64), LDS_BYTES, stream, a); }
    }
    const hipError_t le = hipPeekAtLastError();
    if (le != hipSuccess) fprintf(stderr, "kernel_launch: launch failed: %s (grid %d)\n", hipGetErrorName(le), grid);
}
```

```cpp
#include <hip/hip_runtime.h>
#include <hip/hip_bf16.h>
#include <cstdio>
#include <cstdint>

#ifndef MK_N_LAUNCHES
#define MK_N_LAUNCHES 1
#endif
#ifndef FUSE_RMS
#define FUSE_RMS 0
#endif
#ifndef LATE_WT
#define LATE_WT 1
#endif
#ifndef SLACK_P1
#define SLACK_P1 1
#endif
#ifndef SB_EARLY_EXIT
#define SB_EARLY_EXIT 1
#endif

constexpr int DM = 2048, SEQ = 4096, NB = 2, DB = 8, DS = 16, PAST = 4096, HD = 128;
constexpr int MP = NB * SEQ;
constexpr int MS = DB * DS;
constexpr int MIN_ = 8448;
constexpr int MREAL = MP + MS;
constexpr int MMEM0 = 8448;
constexpr int MA = 8960;
constexpr int INW = 13312, NCAT = 14336;
constexpr int NMEM = 256;
constexpr float RMS_EPS = 1e-6f;
constexpr float LOG2E = 1.4426950408889634f;
constexpr float QSCALE = 0.08838834764831845f * 1.4426950408889634f;

namespace pg8 {
#define PG8_LAS __attribute__((address_space(3)))
typedef unsigned short bf16_t;
typedef short bf16x8 __attribute__((ext_vector_type(8)));
typedef float f32x4 __attribute__((ext_vector_type(4)));
typedef unsigned u32x4 __attribute__((ext_vector_type(4)));
constexpr int BM = 256, BK = 64, HALF = 128, HTB = HALF * BK * 2  , STAGE_BYTES = 8 * HTB, NXCD = 8, WGM = 8;

__host__ __device__ __forceinline__ int lds_byte(int r, int c) { const int st = (r >> 4) * 2 + (c >> 5), rr = r & 15, cc = c & 31, ob = rr * 64 + cc * 2; return st * 1024 + (ob ^ (((ob >> 9) & 1) << 5)); }
__host__ __device__ __forceinline__ void stage_rc(int b, int& R, int& C) { const int st = b / 1024, sb = b % 1024, swz = sb ^ (((sb >> 9) & 1) << 5); R = (st >> 1) * 16 + swz / 64; C = (st & 1) * 32 + (swz % 64) / 2; }
__host__ __device__ __forceinline__ int perm32(int rho) { const int n = rho >> 4, i = rho & 15; return 8 * (i >> 2) + 4 * n + (i & 3); }

struct Unit { int pm, pn, k0, nt; };
struct Gemm { const bf16_t* A; const bf16_t* Bt; int M, N, K; };

struct StaticOrder {
    int nM, nN, nwg, G, c;
    __host__ __device__ void init(int M, int N, int G_, int c_) { nM = M / BM; nN = N / BM; nwg = nM * nN; G = G_; c = c_; }
    __host__ __device__ bool next(int i, Unit& u) const {
        const long L = (long)i * G + c; if (L >= nwg) return false;
        int wgid = (int)L; { const int q = nwg / NXCD, r = nwg % NXCD, xcd = wgid % NXCD, off = wgid / NXCD; wgid = (xcd < r ? xcd * (q + 1) : r * (q + 1) + (xcd - r) * q) + off; }
        const int nig = WGM * nN, gid = wgid / nig, fm = gid * WGM, gsz = (nM - fm) < WGM ? (nM - fm) : WGM;
        u.pm = fm + ((wgid % nig) % gsz); u.pn = (wgid % nig) / gsz; u.k0 = 0; u.nt = 0; return true;
    }
    __device__ __forceinline__ void a_ready(const Unit&) const {}
    __device__ __forceinline__ void done(const Unit&) const {}
};

typedef float f32x2_t __attribute__((ext_vector_type(2))); typedef __bf16 bf16x2_t __attribute__((ext_vector_type(2)));
__device__ __forceinline__ unsigned cvt_pk_bf16(float lo, float hi) { f32x2_t v = {lo, hi}; bf16x2_t b = __builtin_convertvector(v, bf16x2_t); return __builtin_bit_cast(unsigned, b); }

template <class Epi, class Sched, bool ALIGN_EPI = false, bool SP2 = false>
__device__ __forceinline__ void gemm_phase(PG8_LAS unsigned char* lds, const Gemm g, const Sched& S, const Epi& E) {
    const int tid = threadIdx.x, wid = __builtin_amdgcn_readfirstlane(tid >> 6), lane = tid & 63, wr = wid >> 2, wc = wid & 3, fr = lane & 15, fq = lane >> 4;
    const int K = g.K, nt = K / BK;
    unsigned voffA[2], voffB[2];
#pragma unroll
    for (int i = 0; i < 2; ++i) { int R, C; stage_rc(tid * 16 + i * 8192, R, C); const int Rb = Epi::PERM ? ((R & ~31) + perm32(R & 31)) : R;
        voffA[i] = (unsigned)(R * K + C) * 2u; voffB[i] = (unsigned)(Rb * K + C) * 2u; }
    const size_t kstep = (size_t)(BK * 2);
    const size_t hstep = (size_t)HALF * K * 2;
    const size_t tstep = 2 * hstep;
    const unsigned ldsw = (unsigned)wid * 1024u;
    const int aoff = lds_byte(wr * 64 + fr, fq * 8), boff = lds_byte(wc * 32 + fr, fq * 8);
#define PG8_SA(b, h) (((b) * 2 + (h)) * HTB)
#define PG8_SB(b, h) ((4 + (b) * 2 + (h)) * HTB)
#define PG8_STAGE(bufoff, gbase, voff) do { _Pragma("unroll") for (int _i = 0; _i < 2; ++_i) \
        __builtin_amdgcn_global_load_lds((const unsigned*)((const char*)(gbase) + (voff)[_i]), (PG8_LAS unsigned*)(lds + (bufoff) + ldsw + _i * 8192), 16, 0, 0); } while (0)
#define PG8_LDA(dst, b, h) do { _Pragma("unroll") for (int m = 0; m < 4; ++m) _Pragma("unroll") for (int k = 0; k < 2; ++k) dst[m][k] = *(const PG8_LAS bf16x8*)(lds + PG8_SA(b, h) + aoff + m * 2048 + k * 1024); } while (0)
#define PG8_LDB(dst, b, h) do { _Pragma("unroll") for (int n = 0; n < 2; ++n) _Pragma("unroll") for (int k = 0; k < 2; ++k) dst[n][k] = *(const PG8_LAS bf16x8*)(lds + PG8_SB(b, h) + boff + n * 2048 + k * 1024); } while (0)
#define PG8_MMA(ai, bj, At, Bt) do { __builtin_amdgcn_s_setprio(1); _Pragma("unroll") for (int m = 0; m < 4; ++m) _Pragma("unroll") for (int n = 0; n < 2; ++n) _Pragma("unroll") for (int k = 0; k < 2; ++k) \
        acc[ai][bj][m][n] = __builtin_amdgcn_mfma_f32_16x16x32_bf16(Bt[n][k], At[m][k], acc[ai][bj][m][n], 0, 0, 0); __builtin_amdgcn_s_setprio(0); } while (0)
#define PG8_WAIT_V(n) asm volatile("s_waitcnt vmcnt(" #n ")" ::: "memory")
#define PG8_WAIT_L(n) asm volatile("s_waitcnt lgkmcnt(" #n ")" ::: "memory")
#define PG8_BAR __builtin_amdgcn_s_barrier()
#define PG8_SCHED __builtin_amdgcn_sched_barrier(0)
    Unit cur, nxt; int ui = 0;
    if (!S.next(0, cur)) return;
    f32x4 acc[2][2][4][2];
#pragma unroll
    for (int a = 0; a < 2; ++a)
#pragma unroll
        for (int b = 0; b < 2; ++b)
#pragma unroll
            for (int m = 0; m < 4; ++m)
#pragma unroll
                for (int n = 0; n < 2; ++n) acc[a][b][m][n] = (f32x4){0.f, 0.f, 0.f, 0.f};
    bf16x8 At[4][2], B0[2][2], B1[2][2];
    const char* cA = (const char*)g.A + (size_t)cur.pm * tstep + (size_t)cur.k0 * 2; const char* cB = (const char*)g.Bt + (size_t)cur.pn * tstep + (size_t)cur.k0 * 2;
    S.a_ready(cur);
    if constexpr (SP2) {
        PG8_STAGE(PG8_SB(0, 0), cB, voffB); PG8_STAGE(PG8_SB(0, 1), cB + hstep, voffB); PG8_STAGE(PG8_SA(0, 0), cA, voffA); PG8_STAGE(PG8_SA(0, 1), cA + hstep, voffA);
        if (wr == 1) PG8_BAR;
        PG8_WAIT_V(2); PG8_BAR;
        PG8_STAGE(PG8_SB(1, 0), cB + kstep, voffB); PG8_STAGE(PG8_SA(1, 0), cA + kstep, voffA); PG8_STAGE(PG8_SB(1, 1), cB + hstep + kstep, voffB);
        PG8_WAIT_V(6); PG8_BAR;
    } else {
        PG8_STAGE(PG8_SB(0, 0), cB, voffB); PG8_STAGE(PG8_SA(0, 0), cA, voffA); PG8_STAGE(PG8_SB(0, 1), cB + hstep, voffB); PG8_STAGE(PG8_SA(0, 1), cA + hstep, voffA);
        if (wr == 1) PG8_BAR;
        PG8_WAIT_V(4); PG8_BAR;
        PG8_STAGE(PG8_SB(1, 0), cB + kstep, voffB); PG8_STAGE(PG8_SA(1, 0), cA + kstep, voffA); PG8_STAGE(PG8_SB(1, 1), cB + hstep + kstep, voffB);
        PG8_WAIT_V(6); PG8_BAR;
    }
    for (;;) {
        const bool has_next = S.next(ui + 1, nxt);
        const char* nA = has_next ? (const char*)g.A + (size_t)nxt.pm * tstep + (size_t)nxt.k0 * 2 : cA; const char* nB = has_next ? (const char*)g.Bt + (size_t)nxt.pn * tstep + (size_t)nxt.k0 * 2 : cB;
        const int ntu = cur.nt ? cur.nt : nt;
        for (int t = 0; t < ntu; t += 2) {
            const bool last = (t == ntu - 2);
            const char* a1 = cA + (size_t)(t + 1) * kstep;
            const char* a2 = last ? nA : cA + (size_t)(t + 2) * kstep; const char* b2 = last ? nB : cB + (size_t)(t + 2) * kstep;
            const char* a3 = a2 + kstep; const char* b3 = b2 + kstep;
            if (last && has_next) S.a_ready(nxt);
            if constexpr (SP2) {
            PG8_LDB(B0, 0, 0); PG8_LDB(B1, 0, 1); PG8_SCHED; PG8_LDA(At, 0, 0); PG8_STAGE(PG8_SA(1, 1), a1 + hstep, voffA);
            PG8_WAIT_V(8); PG8_WAIT_L(0); PG8_BAR; PG8_MMA(0, 0, At, B0); PG8_MMA(0, 1, At, B1); PG8_BAR; PG8_SCHED;
            PG8_LDA(At, 0, 1); PG8_STAGE(PG8_SB(0, 0), b2, voffB); PG8_STAGE(PG8_SB(0, 1), b2 + hstep, voffB); PG8_STAGE(PG8_SA(0, 0), a2, voffA);
            PG8_WAIT_V(8); PG8_WAIT_L(0); PG8_BAR; PG8_MMA(1, 0, At, B0); PG8_MMA(1, 1, At, B1); PG8_BAR; PG8_SCHED;
            PG8_LDB(B0, 1, 0); PG8_LDB(B1, 1, 1); PG8_SCHED; PG8_LDA(At, 1, 0); PG8_STAGE(PG8_SA(0, 1), a2 + hstep, voffA);
            PG8_WAIT_V(8); PG8_WAIT_L(0); PG8_BAR; PG8_MMA(0, 0, At, B0); PG8_MMA(0, 1, At, B1); PG8_BAR; PG8_SCHED;
            PG8_LDA(At, 1, 1); PG8_STAGE(PG8_SB(1, 0), b3, voffB); PG8_STAGE(PG8_SB(1, 1), b3 + hstep, voffB); PG8_STAGE(PG8_SA(1, 0), a3, voffA);
            PG8_WAIT_V(8); PG8_WAIT_L(0); PG8_BAR; PG8_MMA(1, 0, At, B0); PG8_MMA(1, 1, At, B1); PG8_BAR; PG8_SCHED;
            } else {
            PG8_LDB(B0, 0, 0); PG8_SCHED; PG8_LDA(At, 0, 0); PG8_STAGE(PG8_SA(1, 1), a1 + hstep, voffA);
            PG8_WAIT_L(8); PG8_BAR; PG8_WAIT_L(0); PG8_MMA(0, 0, At, B0); PG8_BAR; PG8_SCHED;
            PG8_LDB(B1, 0, 1); PG8_STAGE(PG8_SB(0, 0), b2, voffB);
            PG8_BAR; PG8_WAIT_L(0); PG8_MMA(0, 1, At, B1); PG8_BAR;
            PG8_LDA(At, 0, 1); PG8_STAGE(PG8_SA(0, 0), a2, voffA);
            PG8_BAR; PG8_WAIT_L(0); PG8_MMA(1, 0, At, B0); PG8_BAR; PG8_SCHED;
            PG8_STAGE(PG8_SB(0, 1), b2 + hstep, voffB);
            PG8_WAIT_V(6); PG8_BAR; PG8_MMA(1, 1, At, B1); PG8_BAR;
            PG8_LDB(B0, 1, 0); PG8_SCHED; PG8_LDA(At, 1, 0); PG8_STAGE(PG8_SA(0, 1), a2 + hstep, voffA);
            PG8_WAIT_L(8); PG8_BAR; PG8_WAIT_L(0); PG8_MMA(0, 0, At, B0); PG8_BAR; PG8_SCHED;
            PG8_LDB(B1, 1, 1); PG8_STAGE(PG8_SB(1, 0), b3, voffB);
            PG8_BAR; PG8_WAIT_L(0); PG8_MMA(0, 1, At, B1); PG8_BAR;
            PG8_LDA(At, 1, 1); PG8_STAGE(PG8_SA(1, 0), a3, voffA);
            PG8_BAR; PG8_WAIT_L(0); PG8_MMA(1, 0, At, B0); PG8_BAR; PG8_SCHED;
            PG8_STAGE(PG8_SB(1, 1), b3 + hstep, voffB);
            PG8_WAIT_V(6); PG8_BAR; PG8_MMA(1, 1, At, B1); PG8_BAR;
            }
        }
        if constexpr (ALIGN_EPI) { if (wr == 0) PG8_BAR; }
        if constexpr (!Epi::AFTER_DRAIN) { E(acc, cur, wr, wc, fr, fq); S.done(cur); }
        if (!has_next) break;
        if (E.reset_after(cur))
#pragma unroll
        for (int a = 0; a < 2; ++a)
#pragma unroll
            for (int b = 0; b < 2; ++b)
#pragma unroll
                for (int m = 0; m < 4; ++m)
#pragma unroll
                    for (int n = 0; n < 2; ++n) acc[a][b][m][n] = (f32x4){0.f, 0.f, 0.f, 0.f};
        cur = nxt; cA = nA; cB = nB; ++ui;
        if constexpr (ALIGN_EPI) { if (wr == 1) PG8_BAR; }
    }
    PG8_WAIT_V(0);
    if constexpr (!ALIGN_EPI) { if (wr == 0) PG8_BAR; }
    PG8_BAR;
    if constexpr (Epi::AFTER_DRAIN) { E.fused(acc, cur, wr, wc, fr, fq, lds, wid, lane); S.done(cur); }
#undef PG8_SA
#undef PG8_SB
#undef PG8_STAGE
#undef PG8_LDA
#undef PG8_LDB
#undef PG8_MMA
#undef PG8_WAIT_V
#undef PG8_WAIT_L
#undef PG8_BAR
#undef PG8_SCHED
}
}

namespace ep {
using pg8::f32x4; using pg8::u32x4; using pg8::Unit; using pg8::bf16_t; using pg8::HALF; using pg8::BM; using pg8::cvt_pk_bf16;
typedef unsigned u32x2 __attribute__((ext_vector_type(2)));

struct InOrder {
    pg8::StaticOrder so; int G, c;
    __device__ void init(int G_, int c_) { so.init(MIN_, INW, G_, c_); G = G_; c = c_; }
    __device__ bool next(int i, Unit& u) const {
        const long L = (long)i * G + c;
        if (L < so.nwg) return so.next(i, u);
        const int j = (int)(L - so.nwg); if (j >= 8) return false;
        u.pm = 33 + (j & 1); u.pn = 52 + (j >> 1); u.k0 = 0; u.nt = 0; return true;
    }
    __device__ __forceinline__ void a_ready(const Unit&) const {}
    __device__ __forceinline__ void done(const Unit&) const {}
};

__device__ __forceinline__ float sigmoidf_fast(float x) { return __builtin_amdgcn_rcpf(1.0f + __builtin_amdgcn_exp2f(-x * LOG2E)); }
__device__ __forceinline__ float bf2f(unsigned short h) { return __uint_as_float((unsigned)h << 16); }

struct EpiIn {
    static constexpr bool PERM = true, AFTER_DRAIN = false;
    bf16_t *QSB, *KSB, *VSB, *GSB, *QBD, *KBD, *VBD, *GBD, *QMM, *GMM, *MG, *MK, *MV;
    float* out;
    __attribute__((address_space(3))) unsigned char* stg;
    bf16_t *KBC, *VBC;
    __device__ __forceinline__ bool reset_after(const Unit&) const { return true; }
    template <int ACT, int F32>
    __device__ __forceinline__ void store(const f32x4 (&acc)[2][2][4][2], bf16_t* dst, int ldc, int colt, int rowoff, int pm, float* f0, float* f1, int wr, int wc, int fr, int fq, bf16_t* bdc = nullptr) const {
        const int col0 = colt + wc * 32 + 8 * fq;
#pragma unroll
        for (int ai = 0; ai < 2; ++ai)
#pragma unroll
            for (int m = 0; m < 4; ++m) {
                const int r = pm * BM + ai * HALF + wr * 64 + m * 16 + fr;
                bf16_t* rowp = dst + (size_t)(r - rowoff) * ldc + col0;
                float* frow = nullptr;
                if (F32 == 1) { if (r < MP) frow = f0 + (size_t)r * 768; else if (r < MREAL) frow = f1 + (size_t)(r - MP) * 768; }
                if (F32 == 2) { if (r < MP) { const int t = r & (SEQ - 1); if (t >= SEQ - 512) frow = f0 + ((size_t)(r >> 12) * 512 + (t - (SEQ - 512))) * 768; } else if (r < MREAL) frow = f1 + (size_t)(r - MP) * 768; }
                if (F32 == 3) frow = f0 + (size_t)(r - MMEM0) * 512;
#pragma unroll
                for (int bj = 0; bj < 2; ++bj) {
                    f32x4 v0 = acc[ai][bj][m][0], v1 = acc[ai][bj][m][1];
                    if (F32 != 0) { if (frow) { __builtin_nontemporal_store(v0, (f32x4*)(frow + col0 + bj * HALF)); __builtin_nontemporal_store(v1, (f32x4*)(frow + col0 + bj * HALF + 4)); } }
                    if (ACT == 1) { v0 = v0 * QSCALE; v1 = v1 * QSCALE; }
                    if (ACT == 2) {
#pragma unroll
                        for (int e = 0; e < 4; ++e) { v0[e] = v0[e] * sigmoidf_fast(v0[e]); v1[e] = v1[e] * sigmoidf_fast(v1[e]); } }
                    if (ACT == 3) {
#pragma unroll
                        for (int e = 0; e < 4; ++e) { v0[e] = sigmoidf_fast(v0[e]); v1[e] = sigmoidf_fast(v1[e]); } }
                    u32x4 w; w.x = cvt_pk_bf16(v0[0], v0[1]); w.y = cvt_pk_bf16(v0[2], v0[3]); w.z = cvt_pk_bf16(v1[0], v1[1]); w.w = cvt_pk_bf16(v1[2], v1[3]);
                    *(u32x4*)(rowp + bj * HALF) = w;
                    if (F32 == 2 && SLACK_P1) { if (r >= MP && r < MREAL) *(u32x4*)(bdc + ((size_t)((r - MP) >> 4) * 576 + 512 + ((r - MP) & 15)) * 768 + col0 + bj * HALF) = w; } }
            }
    }
    __device__ __forceinline__ void store_gates(const f32x4 (&acc)[2][2][4][2], int t, int pm, int wr, int wc, int fr, int fq) const {
        typedef float f32x2 __attribute__((ext_vector_type(2)));
        typedef __attribute__((address_space(3))) u32x2 lu32x2; typedef __attribute__((address_space(3))) u32x4 lu32x4;
        const int sld = (t < 24) ? 768 : 512;
        bf16_t* const sdst = (t < 12) ? GSB + 64 * t : (t < 24 ? GBD + 64 * (t - 12) : GMM + 64 * (t - 24));
        constexpr float CAP = 1073741824.0f, NLN2 = -0.6931471805599453f;
        const int row32 = wr * 16 + fr;
        const int woff = row32 * 128 + ((wc ^ ((row32 >> 1) & 3)) << 5) + fq * 8;
        const int tid = threadIdx.x, rrow = (tid & 255) >> 3, part = tid & 7, kq = tid >> 8;
        const int roff = kq * 4096 + rrow * 128 + ((((part >> 1) ^ ((rrow >> 1) & 3)) << 5) | ((part & 1) << 4));
        const int grow = pm * BM + (rrow >> 4) * 64 + (rrow & 15);
#pragma unroll
        for (int ai = 0; ai < 2; ++ai)
#pragma unroll
            for (int m = 0; m < 4; ++m) {
                u32x2 w1, w2, w3, ws;
#pragma unroll
                for (int h = 0; h < 2; ++h) {
                    const f32x2 x1 = {acc[ai][0][m][0][2 * h], acc[ai][0][m][0][2 * h + 1]}, x2 = {acc[ai][0][m][1][2 * h], acc[ai][0][m][1][2 * h + 1]};
                    const f32x2 x3 = {acc[ai][1][m][0][2 * h], acc[ai][1][m][0][2 * h + 1]}, xs = {acc[ai][1][m][1][2 * h], acc[ai][1][m][1][2 * h + 1]};
                    const f32x2 one = {1.0f, 1.0f};
                    const f32x2 d1 = (f32x2){fminf(__builtin_amdgcn_exp2f(x1.x), CAP), fminf(__builtin_amdgcn_exp2f(x1.y), CAP)} + one, d2 = (f32x2){fminf(__builtin_amdgcn_exp2f(x2.x), CAP), fminf(__builtin_amdgcn_exp2f(x2.y), CAP)} + one;
                    const f32x2 d3 = (f32x2){fminf(__builtin_amdgcn_exp2f(x3.x), CAP), fminf(__builtin_amdgcn_exp2f(x3.y), CAP)} + one, ds = (f32x2){fminf(__builtin_amdgcn_exp2f(xs.x), CAP), fminf(__builtin_amdgcn_exp2f(xs.y), CAP)} + one;
                    const f32x2 p12 = d1 * d2, p3s = d3 * ds, q = p12 * p3s;
                    const f32x2 rq = {__builtin_amdgcn_rcpf(q.x), __builtin_amdgcn_rcpf(q.y)};
                    const f32x2 i12 = rq * p3s, i3s = rq * p12;
                    const f32x2 g3 = i3s * ds, sg = (xs * NLN2) * (i3s * d3);
                    const f32x2 r1 = (d2 * d2) * i12, r2 = (d3 * d1) * i12;
                    w1[h] = cvt_pk_bf16(r1.x, r1.y); w2[h] = cvt_pk_bf16(r2.x, r2.y); w3[h] = cvt_pk_bf16(g3.x, g3.y); ws[h] = cvt_pk_bf16(sg.x, sg.y);
                }
                if (ai + m > 0) { asm volatile("s_waitcnt lgkmcnt(0)" ::: "memory"); __builtin_amdgcn_s_barrier(); }
                *(lu32x2*)(stg + woff) = w1; *(lu32x2*)(stg + 4096 + woff) = w2; *(lu32x2*)(stg + 8192 + woff) = w3; *(lu32x2*)(stg + 12288 + woff) = ws;
                asm volatile("s_waitcnt lgkmcnt(0)" ::: "memory"); __builtin_amdgcn_s_barrier(); asm volatile("" ::: "memory");
                const u32x4 va = *(const lu32x4*)(stg + roff), vb = *(const lu32x4*)(stg + 8192 + roff);
                const int r = grow + ai * HALF + m * 16;
                *(u32x4*)(MG + (size_t)r * 6144 + kq * 2048 + 64 * t + part * 8) = va;
                if (kq == 0) *(u32x4*)(MG + (size_t)r * 6144 + 4096 + 64 * t + part * 8) = vb;
                else *(u32x4*)(sdst + (size_t)r * sld + part * 8) = vb;
            }
        asm volatile("s_waitcnt lgkmcnt(0)" ::: "memory");
    }
    __device__ __forceinline__ void operator()(const f32x4 (&acc)[2][2][4][2], const Unit& u, int wr, int wc, int fr, int fq) const {
        const int pn = u.pn, pm = u.pm;
        float* const o_sbk = out + 17039360, * const o_sbv = out + 23330816, * const o_bdk = out + 29622272, * const o_bdv = out + 30408704;
        float* const o_mk = out + 31195136, * const o_mv = out + 31457280;
        float* const s_sbk = out + 31719424, * const s_sbv = out + 31817728, * const s_bdk = out + 31916032, * const s_bdv = out + 32014336;
        if (pn < 3)        store<0, 0>(acc, QSB, 768, 256 * pn, 0, pm, nullptr, nullptr, wr, wc, fr, fq);
        else if (pn < 6)   store<0, 1>(acc, KSB, 768, 256 * (pn - 3), 0, pm, o_sbk, s_sbk, wr, wc, fr, fq);
        else if (pn < 9)   store<0, 1>(acc, VSB, 768, 256 * (pn - 6), 0, pm, o_sbv, s_sbv, wr, wc, fr, fq);
        else if (pn < 12)  store<0, 0>(acc, QBD, 768, 256 * (pn - 9), 0, pm, nullptr, nullptr, wr, wc, fr, fq);
        else if (pn < 15)  store<0, 2>(acc, KBD, 768, 256 * (pn - 12), 0, pm, o_bdk, s_bdk, wr, wc, fr, fq, KBC);
        else if (pn < 18)  store<0, 2>(acc, VBD, 768, 256 * (pn - 15), 0, pm, o_bdv, s_bdv, wr, wc, fr, fq, VBC);
        else if (pn < 20)  store<0, 0>(acc, QMM, 512, 256 * (pn - 18), 0, pm, nullptr, nullptr, wr, wc, fr, fq);
        else if (pn < 52)  store_gates(acc, pn - 20, pm, wr, wc, fr, fq);
        else if (pn < 54)  store<0, 3>(acc, MK, 512, 256 * (pn - 52), MMEM0, pm, o_mk, nullptr, wr, wc, fr, fq);
        else               store<0, 3>(acc, MV, 512, 256 * (pn - 54), MMEM0, pm, o_mv, nullptr, wr, wc, fr, fq);
    }
};

struct MergeOrder {
    pg8::StaticOrder so;
    __device__ void init(int G_, int c_) { so.init(MP, DM, G_, c_); }
    __device__ bool next(int i, Unit& u) const {
        const int ti = i / 3, seg = i - 3 * ti;
        if (!so.next(ti, u)) return false;
        u.k0 = 768 * seg; u.nt = (seg == 2) ? 8 : 12; return true;
    }
    __device__ __forceinline__ void a_ready(const Unit&) const {}
    __device__ __forceinline__ void done(const Unit&) const {}
};
struct EpiMerge {
    static constexpr bool PERM = true, AFTER_DRAIN = false;
    const bf16_t* MG; bf16_t* OUT;
    __device__ __forceinline__ bool reset_after(const Unit& u) const { return u.k0 == 1536; }
    __device__ __forceinline__ void operator()(f32x4 (&acc)[2][2][4][2], const Unit& u, int wr, int wc, int fr, int fq) const {
        const int col0 = u.pn * BM + wc * 32 + 8 * fq;
        const int seg = (u.k0 == 0) ? 0 : (u.k0 == 768 ? 1 : 2);
        const bool last = (seg == 2);
        u32x4 g[2][4][2];
#pragma unroll
        for (int ai = 0; ai < 2; ++ai)
#pragma unroll
            for (int m = 0; m < 4; ++m) { const bf16_t* g_ = MG + (size_t)(u.pm * BM + ai * HALF + wr * 64 + m * 16 + fr) * 6144 + seg * 2048 + col0;
#pragma unroll
                for (int bj = 0; bj < 2; ++bj) g[ai][m][bj] = *(const u32x4*)(g_ + bj * HALF); }
#pragma unroll
        for (int ai = 0; ai < 2; ++ai)
#pragma unroll
            for (int m = 0; m < 4; ++m) { bf16_t* rowp = OUT + (size_t)(u.pm * BM + ai * HALF + wr * 64 + m * 16 + fr) * DM + col0;
#pragma unroll
                for (int bj = 0; bj < 2; ++bj) {
#pragma unroll
                    for (int e = 0; e < 4; ++e) { acc[ai][bj][m][e >> 1][2 * (e & 1)] *= __uint_as_float(g[ai][m][bj][e] << 16); acc[ai][bj][m][e >> 1][2 * (e & 1) + 1] *= __uint_as_float(g[ai][m][bj][e] & 0xffff0000u); }
                    if (last) { u32x4 w; w.x = cvt_pk_bf16(acc[ai][bj][m][0][0], acc[ai][bj][m][0][1]); w.y = cvt_pk_bf16(acc[ai][bj][m][0][2], acc[ai][bj][m][0][3]);
                        w.z = cvt_pk_bf16(acc[ai][bj][m][1][0], acc[ai][bj][m][1][1]); w.w = cvt_pk_bf16(acc[ai][bj][m][1][2], acc[ai][bj][m][1][3]);
                        *(u32x4*)(rowp + bj * HALF) = w; } } }
    }
};

struct EpiOut {
    static constexpr bool PERM = true, AFTER_DRAIN = false;
    bf16_t* yb; float* ssq;
    __device__ __forceinline__ bool reset_after(const Unit&) const { return true; }
    __device__ __forceinline__ void operator()(const f32x4 (&acc)[2][2][4][2], const Unit& u, int wr, int wc, int fr, int fq) const {
        const int col0 = u.pn * BM + wc * 32 + 8 * fq;
#pragma unroll
        for (int ai = 0; ai < 2; ++ai)
#pragma unroll
            for (int m = 0; m < 4; ++m) {
                const int r = u.pm * BM + ai * HALF + wr * 64 + m * 16 + fr;
                bf16_t* yrow = yb + (size_t)r * DM + col0;
                float s = 0.f;
#pragma unroll
                for (int bj = 0; bj < 2; ++bj) { const f32x4 v0 = acc[ai][bj][m][0], v1 = acc[ai][bj][m][1];
                    s += ((v0[0] * v0[0] + v0[1] * v0[1]) + (v0[2] * v0[2] + v0[3] * v0[3])) + ((v1[0] * v1[0] + v1[1] * v1[1]) + (v1[2] * v1[2] + v1[3] * v1[3]));
                    u32x4 w; w.x = cvt_pk_bf16(v0[0], v0[1]); w.y = cvt_pk_bf16(v0[2], v0[3]); w.z = cvt_pk_bf16(v1[0], v1[1]); w.w = cvt_pk_bf16(v1[2], v1[3]);
                    *(u32x4*)(yrow + bj * HALF) = w; }
                s += __shfl_xor(s, 16); s += __shfl_xor(s, 32);
                if (fq == 0) ssq[(size_t)r * 32 + u.pn * 4 + wc] = s;
            }
    }
};

struct EpiOutFused {
    static constexpr bool PERM = false, AFTER_DRAIN = true;
    const float* x; float* out; const float* gpost; float* xbuf; unsigned* cnt; unsigned* tmo;
    __device__ __forceinline__ bool reset_after(const Unit&) const { return true; }
    __device__ __forceinline__ void operator()(const f32x4 (&)[2][2][4][2], const Unit&, int, int, int, int) const {}
    __device__ __forceinline__ void fused(f32x4 (&acc)[2][2][4][2], const Unit& u, int wr, int wc, int fr, int fq, __attribute__((address_space(3))) unsigned char* lds, int wid, int lane) const {
        typedef __attribute__((address_space(3))) float lfloat;
        lfloat* P = (lfloat*)lds;
        lfloat* S = (lfloat*)(lds + 4096);
        __attribute__((address_space(3))) unsigned* flag = (__attribute__((address_space(3))) unsigned*)(lds + 4096 + 1024);
        const int col0 = u.pn * BM + wc * 32 + 4 * fq;
        f32x4 pre[4][2][2];
#pragma unroll
        for (int m = 0; m < 4; ++m) { const size_t off = (size_t)(u.pm * BM + wr * 64 + m * 16 + fr) * DM + col0;
#pragma unroll
            for (int bj = 0; bj < 2; ++bj)
#pragma unroll
                for (int n = 0; n < 2; ++n) pre[m][bj][n] = *(const f32x4*)(x + off + bj * HALF + n * 16); }
#pragma unroll
        for (int ai = 0; ai < 2; ++ai)
#pragma unroll
            for (int m = 0; m < 4; ++m) { float s = 0.f;
#pragma unroll
                for (int bj = 0; bj < 2; ++bj)
#pragma unroll
                    for (int n = 0; n < 2; ++n) { const f32x4 v = acc[ai][bj][m][n]; s += (v[0] * v[0] + v[1] * v[1]) + (v[2] * v[2] + v[3] * v[3]); }
                s += __shfl_xor(s, 16); s += __shfl_xor(s, 32);
                if (fq == 0) P[(ai * HALF + wr * 64 + m * 16 + fr) * 4 + wc] = s; }
        asm volatile("s_waitcnt lgkmcnt(0)" ::: "memory"); __builtin_amdgcn_s_barrier(); asm volatile("" ::: "memory");
        const int row = wid * 32 + (lane & 31);
        if (lane < 32) { const float t = (P[row * 4 + 0] + P[row * 4 + 1]) + (P[row * 4 + 2] + P[row * 4 + 3]);
            __hip_atomic_store(xbuf + ((size_t)(u.pm * BM + row) * 8 + u.pn), t, __ATOMIC_RELAXED, __HIP_MEMORY_SCOPE_AGENT); }
        asm volatile("s_waitcnt vmcnt(0)" ::: "memory");
        if (lane == 0) __hip_atomic_fetch_add(cnt + 64 * u.pm, 1u, __ATOMIC_RELAXED, __HIP_MEMORY_SCOPE_AGENT);
        if (wid == 0) { bool dead = false; const unsigned long long t0 = __builtin_amdgcn_s_memrealtime();
            for (;;) {
                if ((unsigned)__builtin_amdgcn_readfirstlane(__hip_atomic_load(cnt + 64 * u.pm, __ATOMIC_RELAXED, __HIP_MEMORY_SCOPE_AGENT)) >= 64u) break;
                if (__builtin_amdgcn_s_memrealtime() - t0 > 2000000ull) { if (lane == 0) __hip_atomic_store(tmo, 1u, __ATOMIC_RELAXED, __HIP_MEMORY_SCOPE_AGENT); dead = true; break; }
                __builtin_amdgcn_s_sleep(2); }
            __builtin_amdgcn_fence(__ATOMIC_ACQUIRE, "agent");
            if (lane == 0) flag[0] = dead ? 1u : 0u; }
        asm volatile("s_waitcnt vmcnt(0) lgkmcnt(0)" ::: "memory"); __builtin_amdgcn_s_barrier(); asm volatile("" ::: "memory");
        const bool bad = flag[0] != 0u;
        if (lane < 32) { const float* slot = xbuf + (size_t)(u.pm * BM + row) * 8; float q = 0.f;
#pragma unroll
            for (int t = 0; t < 8; ++t) q += __hip_atomic_load(slot + t, __ATOMIC_RELAXED, __HIP_MEMORY_SCOPE_AGENT);
            S[row] = 1.0f / sqrtf(q * (1.0f / DM) + RMS_EPS); }
        asm volatile("s_waitcnt lgkmcnt(0)" ::: "memory"); __builtin_amdgcn_s_barrier(); asm volatile("" ::: "memory");
        f32x4 gv[2][2];
#pragma unroll
        for (int bj = 0; bj < 2; ++bj)
#pragma unroll
            for (int n = 0; n < 2; ++n) gv[bj][n] = *(const f32x4*)(gpost + col0 + bj * HALF + n * 16);
        const float qnan = __builtin_nanf("");
#pragma unroll
        for (int ai = 0; ai < 2; ++ai)
#pragma unroll
            for (int m = 0; m < 4; ++m) { const int r = ai * HALF + wr * 64 + m * 16 + fr; const float rs = S[r]; const size_t off = (size_t)(u.pm * BM + r) * DM + col0;
#pragma unroll
                for (int bj = 0; bj < 2; ++bj)
#pragma unroll
                    for (int n = 0; n < 2; ++n) { const f32x4 bs = ai == 0 ? pre[m][bj][n] : *(const f32x4*)(x + off + bj * HALF + n * 16);
                        f32x4 o = bs + acc[ai][bj][m][n] * rs * gv[bj][n];
                        if (bad) o = (f32x4){qnan, qnan, qnan, qnan};
                        *(f32x4*)(out + off + bj * HALF + n * 16) = o; }
                if (m & 1) asm volatile("" ::: "memory"); }
    }
};

template <int MODE>
__device__ __forceinline__ void skinny_phase(const bf16_t* A, const bf16_t* Bt, const bf16_t* MG, bf16_t* OUTB, float* OUTF, float* SSQS, int slice, __attribute__((address_space(3))) unsigned char* ldsl) {
    typedef short bf16x8 __attribute__((ext_vector_type(8)));
    const int tid = threadIdx.x, lane = tid & 63, fr = lane & 15, fq = lane >> 4;
    const int w = __builtin_amdgcn_readfirstlane(tid >> 6);
    const int cb = slice >> 1, rh = slice & 1;
    const int row0 = MP + 64 * rh + fr;
    const bf16_t* ap = A + (size_t)row0 * DM + 256 * w + 8 * fq;
    const bf16_t* bp = Bt + (size_t)(16 * cb + fr) * DM + 256 * w + 8 * fq;
    bf16x8 bf[8], af[4][8];
#pragma unroll
    for (int j = 0; j < 8; ++j) bf[j] = *(const bf16x8*)(bp + 32 * j);
#pragma unroll
    for (int rb = 0; rb < 4; ++rb)
#pragma unroll
        for (int j = 0; j < 8; ++j) af[rb][j] = *(const bf16x8*)(ap + (size_t)rb * 16 * DM + 32 * j);
    f32x4 acc[4];
#pragma unroll
    for (int rb = 0; rb < 4; ++rb) { acc[rb] = (f32x4){0.f, 0.f, 0.f, 0.f};
#pragma unroll
        for (int j = 0; j < 8; ++j) acc[rb] = __builtin_amdgcn_mfma_f32_16x16x32_bf16(bf[j], af[rb][j], acc[rb], 0, 0, 0); }
    if (MODE == 0) { const int s = (w < 3) ? 0 : (w < 6 ? 1 : 2);
#pragma unroll
        for (int rb = 0; rb < 4; ++rb) { const bf16_t* gp = MG + (size_t)(row0 + 16 * rb) * 6144 + 16 * cb + 4 * fq;
            const u32x2 ra = *(const u32x2*)gp, rb2 = *(const u32x2*)(gp + 2048), gc = *(const u32x2*)(gp + 4096);
#pragma unroll
            for (int e = 0; e < 4; ++e) { const unsigned a_ = e < 2 ? ra.x : ra.y, b_ = e < 2 ? rb2.x : rb2.y, c_ = e < 2 ? gc.x : gc.y;
                const float f1 = (e & 1) ? __uint_as_float(a_ & 0xffff0000u) : __uint_as_float(a_ << 16), f2 = (e & 1) ? __uint_as_float(b_ & 0xffff0000u) : __uint_as_float(b_ << 16), f3 = (e & 1) ? __uint_as_float(c_ & 0xffff0000u) : __uint_as_float(c_ << 16);
                acc[rb][e] *= f3 * (s < 2 ? f2 : 1.0f) * (s < 1 ? f1 : 1.0f); } } }
    __attribute__((address_space(3))) f32x4* red = (__attribute__((address_space(3))) f32x4*)ldsl;
#pragma unroll
    for (int rb = 0; rb < 4; ++rb) red[(w * 4 + rb) * 64 + lane] = acc[rb];
    __syncthreads();
    if (w < 4) { const int rb = w; f32x4 s = red[rb * 64 + lane];
#pragma unroll
        for (int k = 1; k < 8; ++k) s = s + red[(k * 4 + rb) * 64 + lane];
        const int row = row0 + 16 * rb;
        if (MODE == 0) { u32x2 o; o.x = cvt_pk_bf16(s[0], s[1]); o.y = cvt_pk_bf16(s[2], s[3]); *(u32x2*)(OUTB + (size_t)row * DM + 16 * cb + 4 * fq) = o; }
        else { *(f32x4*)(OUTF + (size_t)(row - MP) * DM + 16 * cb + 4 * fq) = s;
            float q = (s[0] * s[0] + s[1] * s[1]) + (s[2] * s[2] + s[3] * s[3]);
            q += __shfl_xor(q, 16); q += __shfl_xor(q, 32);
            if (fq == 0) SSQS[(size_t)(row - MP) * 128 + cb] = q; }
    }
    __syncthreads();
}
}

namespace att {
typedef unsigned short u16;
#define GA __attribute__((address_space(1)))
using bf16x8 = __attribute__((ext_vector_type(8))) short;
using s16x4  = __attribute__((ext_vector_type(4))) short;
using f32x16 = __attribute__((ext_vector_type(16))) float;
using f32x4  = __attribute__((ext_vector_type(4))) float;
using u32x4  = __attribute__((ext_vector_type(4))) unsigned;
using u32x2  = __attribute__((ext_vector_type(2))) unsigned;
constexpr int SHM_V = 16384, SHM_K = 16384;
constexpr int NBUF = 3;
constexpr int OFF_V = 0, OFF_K = NBUF * SHM_V, OFF_BIAS = 2 * NBUF * SHM_V, OFF_FLAGS = OFF_BIAS + 2304, OFF_ITEM = OFF_FLAGS + 128, ATT_LDS = OFF_ITEM + 64;
constexpr float SB_DONE_LOG2 = -200.0f;
#define KSWZ(row, colB) ((row) * 256 + ((colB) ^ (((row) & 7) << 4)))
#define ATT_SBAR() __builtin_amdgcn_sched_barrier(0)
__device__ __forceinline__ int crow(int r, int hi) { return (r & 3) + 8 * (r >> 2) + 4 * hi; }
__device__ __forceinline__ unsigned cvtpk(float lo, float hi) { return pg8::cvt_pk_bf16(lo, hi); }
__device__ __forceinline__ int v_st(int k, int c) { const int kk = (k & ~0xC) | ((k & 4) << 1) | ((k & 8) >> 1); return ((kk >> 3) * 4 + (c >> 5)) * 512 + ((kk & 7) * 32 + (c & 31)) * 2; }
__device__ __forceinline__ int v_rd_base(int lane) { return ((lane & 3) << 3) | (((lane >> 2) & 3) << 6) | (((lane >> 4) & 1) << 5) | (((lane >> 5) & 1) << 8); }
constexpr int v_rd_off(int d0, int ks, int half) { return d0 * 512 + ks * 4096 + half * 2048; }
template <int OFF> __device__ __forceinline__ s16x4 tr_read(int vb) { s16x4 r; asm volatile("ds_read_b64_tr_b16 %0, %1 offset:%2" : "=&v"(r) : "v"(vb), "i"(OFF) : "memory"); return r; }

struct Item {
    int mode;
    int rule;
    const GA u16* Q; int ldq; int nq; int qpos0;
    const GA u16 *kb, *vb; int ldb; int pb_lo, pb_hi;
    const GA float *kf, *vf; int ldf; int pf_lo, pf_hi;
    int pv_lo, pv_hi;
    int kp_first, kp_step, ntiles;
    const GA float* bias;
    GA u16* O; int ldo; const GA u16* G; int ldg;
    int dma;
};

template <bool QPARK>
__device__ __forceinline__ void qkt(f32x16& p0, f32x16& p1, const char* Ks, const bf16x8* qr, const char* qpark, int r32, int hi) {
    p0 = f32x16{}; p1 = f32x16{};
#pragma unroll
    for (int d0 = 0; d0 < 8; ++d0) { const int cb = (d0 * 16 + hi * 8) * 2;
        const bf16x8 b0 = *reinterpret_cast<const bf16x8*>(Ks + KSWZ(r32, cb));
        const bf16x8 b1 = *reinterpret_cast<const bf16x8*>(Ks + KSWZ(32 + r32, cb));
        const bf16x8 q = QPARK ? *reinterpret_cast<const bf16x8*>(qpark + d0 * 1024) : qr[d0];
        p0 = __builtin_amdgcn_mfma_f32_32x32x16_bf16(b0, q, p0, 0, 0, 0);
        p1 = __builtin_amdgcn_mfma_f32_32x32x16_bf16(b1, q, p1, 0, 0, 0); }
}
template <int D0> __device__ __forceinline__ void pv_one(f32x16& od, int vb, bf16x8 pa0, bf16x8 pa1, bf16x8 pa2, bf16x8 pa3) {
    const s16x4 l0 = tr_read<v_rd_off(D0, 0, 0)>(vb), h0 = tr_read<v_rd_off(D0, 0, 1)>(vb), l1 = tr_read<v_rd_off(D0, 1, 0)>(vb), h1 = tr_read<v_rd_off(D0, 1, 1)>(vb);
    const s16x4 l2 = tr_read<v_rd_off(D0, 2, 0)>(vb), h2 = tr_read<v_rd_off(D0, 2, 1)>(vb), l3 = tr_read<v_rd_off(D0, 3, 0)>(vb), h3 = tr_read<v_rd_off(D0, 3, 1)>(vb);
    asm volatile("s_waitcnt lgkmcnt(0)" ::: "memory"); ATT_SBAR();
#define ATT_PK(L, H) (bf16x8){L[0], L[1], L[2], L[3], H[0], H[1], H[2], H[3]}
    od = __builtin_amdgcn_mfma_f32_32x32x16_bf16(ATT_PK(l0, h0), pa0, od, 0, 0, 0);
    od = __builtin_amdgcn_mfma_f32_32x32x16_bf16(ATT_PK(l1, h1), pa1, od, 0, 0, 0);
    od = __builtin_amdgcn_mfma_f32_32x32x16_bf16(ATT_PK(l2, h2), pa2, od, 0, 0, 0);
    od = __builtin_amdgcn_mfma_f32_32x32x16_bf16(ATT_PK(l3, h3), pa3, od, 0, 0, 0);
#undef ATT_PK
}
#define ATT_PK4(P, BASE, OUT) do { const unsigned a0_ = cvtpk(P[BASE + 0], P[BASE + 1]), a1_ = cvtpk(P[BASE + 2], P[BASE + 3]);   \
    const unsigned b0_ = cvtpk(P[BASE + 4], P[BASE + 5]), b1_ = cvtpk(P[BASE + 6], P[BASE + 7]);                              \
    auto r0_ = __builtin_amdgcn_permlane32_swap(a0_, b0_, false, false); auto r1_ = __builtin_amdgcn_permlane32_swap(a1_, b1_, false, false); \
    u32x4 w_ = {r0_[0], r1_[0], r0_[1], r1_[1]}; OUT = *reinterpret_cast<bf16x8*>(&w_); } while (0)

__device__ __forceinline__ void sb_half(f32x16& p, float& carry, bool need_mask, int kbase, int qpos, int pv_lo, int pv_hi, int hi) {
    float T[16];
#pragma unroll
    for (int r = 0; r < 16; ++r) {
        const float z = p[r];
        const float t = __builtin_amdgcn_exp2f(-__builtin_fabsf(z));
        const float l = __builtin_amdgcn_logf(1.0f + t);
        float lm = -(fmaxf(z, 0.f) + l);
        float lp = fminf(z, 0.f) - l;
        if (need_mask) { const int kp = kbase + crow(r, hi); const bool ok = (kp < qpos) && (kp >= pv_lo) && (kp < pv_hi); lm = ok ? lm : 0.f; lp = ok ? lp : -1e30f; }
        T[r] = lm; p[r] = lp;
    }
    float glo[4], ghi[4];
#pragma unroll
    for (int g = 0; g < 4; ++g) {
        T[4 * g + 2] += T[4 * g + 3]; T[4 * g + 1] += T[4 * g + 2]; T[4 * g] += T[4 * g + 1];
        const float gt = T[4 * g];
        auto rr = __builtin_amdgcn_permlane32_swap(__float_as_uint(gt), __float_as_uint(gt), false, false);
        glo[g] = __uint_as_float(rr[0]); ghi[g] = __uint_as_float(rr[1]);
    }
    float SG[4];
    SG[3] = 0.f; SG[2] = glo[3] + ghi[3]; SG[1] = SG[2] + (glo[2] + ghi[2]); SG[0] = SG[1] + (glo[1] + ghi[1]);
    const float tot = SG[0] + (glo[0] + ghi[0]);
#pragma unroll
    for (int g = 0; g < 4; ++g) SG[g] += carry + (hi == 0 ? ghi[g] : 0.f);
#pragma unroll
    for (int r = 0; r < 16; ++r) p[r] = __builtin_amdgcn_exp2f(p[r] + ((r & 3) == 3 ? SG[r >> 2] : SG[r >> 2] + T[r + 1]));
    carry += tot;
}

#define ATT_TILE(Kt, vb_) do { \
            f32x16 p0, p1; \
            qkt<!DMA>(p0, p1, (Kt), qr, qpark, r32, hi); \
            bool need_mask = (kp0 < it.pv_lo) || (kp0 + 64 > it.pv_hi); \
            if (MODE == 0) { \
                need_mask = need_mask || (kp0 + 63 >= it.qpos0 + 32 * wid); \
                sb_half(p1, carry, need_mask, kp0 + 32, qpos, it.pv_lo, it.pv_hi, hi); \
                sb_half(p0, carry, need_mask, kp0, qpos, it.pv_lo, it.pv_hi, hi); \
            } else { \
                if (has_bias) {       \
                    const int dlo_ = it.qpos0 + 32 * wid - kp0 - 63, dhi_ = it.qpos0 + 32 * wid + 31 - kp0;       \
                    if (dlo_ >= 256) { const float c_ = biasT[0]; \
                        _Pragma("unroll") for (int r = 0; r < 16; ++r) { p0[r] += c_; p1[r] += c_; } } \
                    else if (dlo_ > -256 && dhi_ < 256) { const float* rb_ = biasT + (256 - qpos + kp0 + 4 * hi);              \
                        _Pragma("unroll") for (int r = 0; r < 16; ++r) { p0[r] += rb_[(r & 3) + 8 * (r >> 2)]; p1[r] += rb_[32 + (r & 3) + 8 * (r >> 2)]; } } \
                    else { \
                        _Pragma("unroll") for (int r = 0; r < 16; ++r) { const int kp = kp0 + crow(r, hi); \
                            int i0_ = 256 - qpos + kp; i0_ = i0_ < 0 ? 0 : (i0_ > 512 ? 512 : i0_); \
                            int i1_ = 288 - qpos + kp; i1_ = i1_ < 0 ? 0 : (i1_ > 512 ? 512 : i1_); \
                            p0[r] += biasT[i0_]; p1[r] += biasT[i1_]; } } \
                } \
                if (need_mask) { \
                    _Pragma("unroll") for (int r = 0; r < 16; ++r) { const int kp = kp0 + crow(r, hi); \
                        if (!(kp >= it.pv_lo && kp < it.pv_hi)) p0[r] = -1e30f; \
                        if (!(kp + 32 >= it.pv_lo && kp + 32 < it.pv_hi)) p1[r] = -1e30f; } \
                } \
                float pmax = p0[0]; \
                _Pragma("unroll") for (int r = 1; r < 16; ++r) pmax = fmaxf(pmax, p0[r]); \
                _Pragma("unroll") for (int r = 0; r < 16; ++r) pmax = fmaxf(pmax, p1[r]); \
                { auto rr = __builtin_amdgcn_permlane32_swap(__float_as_uint(pmax), __float_as_uint(pmax), false, false); pmax = fmaxf(__uint_as_float(rr[0]), __uint_as_float(rr[1])); } \
                float mn = m_reg, alpha = 1.f;                  \
                if (!__all(pmax - m_reg <= 8.0f)) { mn = fmaxf(m_reg, pmax); alpha = __builtin_amdgcn_exp2f(m_reg - mn); m_reg = mn; } \
                float ps = 0.f; \
                _Pragma("unroll") for (int r = 0; r < 16; ++r) { p0[r] = __builtin_amdgcn_exp2f(p0[r] - mn); ps += p0[r]; } \
                _Pragma("unroll") for (int r = 0; r < 16; ++r) { p1[r] = __builtin_amdgcn_exp2f(p1[r] - mn); ps += p1[r]; } \
                { auto rr = __builtin_amdgcn_permlane32_swap(__float_as_uint(ps), __float_as_uint(ps), false, false); ps = __uint_as_float(rr[0]) + __uint_as_float(rr[1]); } \
                l_reg = l_reg * alpha + ps; \
                if (__any(alpha < 1.f)) { \
                    _Pragma("unroll") for (int d = 0; d < 4; ++d) \
                        _Pragma("unroll") for (int r = 0; r < 16; ++r) o[d][r] *= alpha; } \
            } \
            bf16x8 pa0, pa1, pa2, pa3; \
            ATT_PK4(p0, 0, pa0); ATT_PK4(p0, 8, pa1); ATT_PK4(p1, 0, pa2); ATT_PK4(p1, 8, pa3); \
            const int vbt_ = (vb_); \
            pv_one<0>(o[0], vbt_, pa0, pa1, pa2, pa3); pv_one<1>(o[1], vbt_, pa0, pa1, pa2, pa3); pv_one<2>(o[2], vbt_, pa0, pa1, pa2, pa3); pv_one<3>(o[3], vbt_, pa0, pa1, pa2, pa3); \
        } while (0)

template <int MODE, bool DMA>
__device__ __forceinline__ void run_item(const Item& it, char* lds, __attribute__((address_space(3))) unsigned char* ldsl) {
    typedef __attribute__((address_space(3))) unsigned las_u32;
    const int tid = threadIdx.x, lane = tid & 63, r32 = lane & 31, hi = lane >> 5;
    const int wid = __builtin_amdgcn_readfirstlane(tid >> 6);
    char* V_lds = lds + OFF_V; char* K_lds = lds + OFF_K;
    float* biasT = (float*)(lds + OFF_BIAS);
    volatile __attribute__((address_space(3))) int* flags = (volatile __attribute__((address_space(3))) int*)(ldsl + OFF_FLAGS);
    const bool has_bias = (MODE == 1) && (it.bias != nullptr);
    const bool wave_rows = (32 * wid < it.nq);
    int qrow = 32 * wid + r32; if (qrow >= it.nq) qrow = it.nq - 1;
    const int qpos = it.qpos0 + 32 * wid + r32;
    bf16x8 qr[8];
    char* const qpark = K_lds + 2 * SHM_K + (wid & 1) * 8192 + lane * 16;
#define ATT_ITEM_LOADS() do { \
    if (has_bias) for (int i = tid; i < 513; i += 512) biasT[i] = it.bias[512 - i] * LOG2E; \
    { const GA u16* Qw = it.Q + (size_t)qrow * it.ldq + hi * 8; \
      _Pragma("unroll") for (int d0 = 0; d0 < 8; ++d0) { const bf16x8 q = *reinterpret_cast<const GA bf16x8*>(Qw + d0 * 16); \
          if constexpr (DMA) qr[d0] = q; else { if (wid < 2) *reinterpret_cast<bf16x8*>(qpark + d0 * 1024) = q; } } } \
    } while (0)
    f32x16 o[4]; o[0] = f32x16{}; o[1] = f32x16{}; o[2] = f32x16{}; o[3] = f32x16{};
    float carry = 0.f, m_reg = -1e30f, l_reg = 0.f;
    const int vb0 = (int)(uintptr_t)V_lds + v_rd_base(lane);
    const int nt = it.ntiles;
    bool wdone = !wave_rows;
    if constexpr (!DMA) ATT_ITEM_LOADS();
    if constexpr (DMA) {
        unsigned koff[2], voff[2];
#pragma unroll
        for (int i = 0; i < 2; ++i) { const int p = wid + 8 * i;
            const int krow = 4 * p + (lane >> 4), kch = (lane & 15) ^ (krow & 7);
            koff[i] = (unsigned)(krow * it.ldb * 2 + kch * 16);
            const int s = 2 * p + (lane >> 5), kk = 8 * (s >> 2) + ((lane & 31) >> 2), k = (kk & ~0xC) | ((kk & 4) << 1) | ((kk & 8) >> 1), c = 32 * (s & 3) + 8 * (lane & 3);
            voff[i] = (unsigned)(k * it.ldb * 2 + c * 2); }
        const GA char* kbase = (const GA char*)it.kb; const GA char* vbase = (const GA char*)it.vb;
#define ATT_DMA(b, kp0_) do { const size_t to_ = (size_t)((kp0_) - it.pb_lo) * (size_t)it.ldb * 2; \
        _Pragma("unroll") for (int i_ = 0; i_ < 2; ++i_) { \
            __builtin_amdgcn_global_load_lds((const GA unsigned*)(kbase + to_ + koff[i_]), (las_u32*)(ldsl + OFF_K + (b) * SHM_K + (wid + 8 * i_) * 1024), 16, 0, 0); \
            __builtin_amdgcn_global_load_lds((const GA unsigned*)(vbase + to_ + voff[i_]), (las_u32*)(ldsl + OFF_V + (b) * SHM_V + (wid + 8 * i_) * 1024), 16, 0, 0); } } while (0)
        ATT_DMA(0, it.kp_first);
        if (nt > 1) ATT_DMA(1, it.kp_first + it.kp_step);
        ATT_ITEM_LOADS();
        int cur = 0;
        for (int j = 0; j < nt; ++j) {
            const int kp0 = it.kp_first + j * it.kp_step;
            if (j + 1 < nt) asm volatile("s_waitcnt vmcnt(4) lgkmcnt(0)\n\ts_barrier" ::: "memory");
            else            asm volatile("s_waitcnt vmcnt(0) lgkmcnt(0)\n\ts_barrier" ::: "memory");
            if (MODE == 0 && SB_EARLY_EXIT && j > 0) {
                int alld = 1;
#pragma unroll
                for (int w = 0; w < 8; ++w) alld &= flags[((j - 1) & 1) * 8 + w];
                if (alld) break;
            }
            if (j + 2 < nt) { const int b2 = (cur >= 1) ? cur - 1 : cur + 2; ATT_DMA(b2, kp0 + 2 * it.kp_step); }
            bool active = wave_rows;
            if (it.rule == 1) active = active && (kp0 <= it.qpos0 + 32 * wid + 30) && !wdone;
            if (it.rule == 2) { const int ct = kp0 >> 6, cw = (it.qpos0 + 32 * wid) >> 6; active = active && (ct >= cw - 8) && (ct <= cw); }
            if (active) ATT_TILE(K_lds + cur * SHM_K, vb0 + cur * SHM_V);
            if (MODE == 0 && SB_EARLY_EXIT) {
                if (wave_rows && !wdone) { const bool rowdone = (carry < SB_DONE_LOG2) || (32 * wid + r32 >= it.nq); wdone = __all(rowdone); }
                if (lane == 0) flags[(j & 1) * 8 + wid] = wdone ? 1 : 0;
            }
            cur = (cur == NBUF - 1) ? 0 : cur + 1;
        }
        asm volatile("s_waitcnt vmcnt(0) lgkmcnt(0)\n\ts_barrier" ::: "memory");
#undef ATT_DMA
    } else {
    const int sr = tid >> 4, sc = (tid & 15) * 8;
    const int vst0 = v_st(sr, sc), vst1 = v_st(32 + sr, sc), kst0 = KSWZ(sr, sc * 2), kst1 = KSWZ(32 + sr, sc * 2);
    f32x4 sK0a, sK0b, sK1a, sK1b, sV0a, sV0b, sV1a, sV1b;
#define ATT_LD(p, A, B, kbp, kfp) do { const int p_ = (p); const bool isb_ = (p_ >= it.pb_lo && p_ < it.pb_hi), isf_ = (p_ >= it.pf_lo && p_ < it.pf_hi); \
        const GA char* a0_ = isf_ ? (const GA char*)(kfp + (size_t)(p_ - it.pf_lo) * it.ldf + sc) : (const GA char*)(kbp + (size_t)(isb_ ? p_ - it.pb_lo : 0) * it.ldb + sc); \
        const f32x4 la_ = *reinterpret_cast<const GA f32x4*>(a0_); const f32x4 lb_ = *reinterpret_cast<const GA f32x4*>(a0_ + (isf_ ? 16 : 0)); \
        A = la_; B = lb_; } while (0)
#define ATT_CV(p, A, B, OUT) do { const int p_ = (p); const bool isb_ = (p_ >= it.pb_lo && p_ < it.pb_hi), isf_ = (p_ >= it.pf_lo && p_ < it.pf_hi); \
        u32x4 w_ = {cvtpk(A[0], A[1]), cvtpk(A[2], A[3]), cvtpk(B[0], B[1]), cvtpk(B[2], B[3])}; const u32x4 r_ = __builtin_bit_cast(u32x4, A); \
        w_.x = isf_ ? w_.x : (isb_ ? r_.x : 0u); w_.y = isf_ ? w_.y : (isb_ ? r_.y : 0u); w_.z = isf_ ? w_.z : (isb_ ? r_.z : 0u); w_.w = isf_ ? w_.w : (isb_ ? r_.w : 0u); \
        OUT = *reinterpret_cast<bf16x8*>(&w_); } while (0)
#define ATT_SLOAD(kp0) do { ATT_LD((kp0) + sr, sK0a, sK0b, it.kb, it.kf); ATT_LD((kp0) + 32 + sr, sK1a, sK1b, it.kb, it.kf); \
        ATT_LD((kp0) + sr, sV0a, sV0b, it.vb, it.vf); ATT_LD((kp0) + 32 + sr, sV1a, sV1b, it.vb, it.vf); } while (0)
#define ATT_SWRITE(b, kp0) do { bf16x8 t_; \
        ATT_CV((kp0) + sr, sK0a, sK0b, t_); *reinterpret_cast<bf16x8*>(K_lds + (b) * SHM_K + kst0) = t_; \
        ATT_CV((kp0) + 32 + sr, sK1a, sK1b, t_); *reinterpret_cast<bf16x8*>(K_lds + (b) * SHM_K + kst1) = t_; \
        ATT_CV((kp0) + sr, sV0a, sV0b, t_); *reinterpret_cast<bf16x8*>(V_lds + (b) * SHM_V + vst0) = t_; \
        ATT_CV((kp0) + 32 + sr, sV1a, sV1b, t_); *reinterpret_cast<bf16x8*>(V_lds + (b) * SHM_V + vst1) = t_; } while (0)
    sK0b = sK1b = sV0b = sV1b = (f32x4){0.f, 0.f, 0.f, 0.f};
    ATT_SLOAD(it.kp_first); ATT_SWRITE(0, it.kp_first);
    __syncthreads();
    for (int j = 0; j < nt; ++j) {
        const int kp0 = it.kp_first + j * it.kp_step, kpn = kp0 + it.kp_step, cur = j & 1;
        const bool more = (j + 1 < nt);
        if (more) ATT_SLOAD(kpn);
        bool active = wave_rows;
        if (it.rule == 1) active = active && (kp0 <= it.qpos0 + 32 * wid + 30) && !wdone;
        if (it.rule == 2) { const int ct = kp0 >> 6, cw = (it.qpos0 + 32 * wid) >> 6; active = active && (ct >= cw - 8) && (ct <= cw); }
        if (active) ATT_TILE(K_lds + cur * SHM_K, vb0 + cur * SHM_V);
        if (MODE == 0 && SB_EARLY_EXIT) {
            if (wave_rows && !wdone) { const bool rowdone = (carry < SB_DONE_LOG2) || (32 * wid + r32 >= it.nq); wdone = __all(rowdone); }
            if (lane == 0) flags[cur * 8 + wid] = wdone ? 1 : 0;
        }
        if (more) ATT_SWRITE(cur ^ 1, kpn);
        __syncthreads();
        if (MODE == 0 && SB_EARLY_EXIT) {
            int alld = 1;
#pragma unroll
            for (int w = 0; w < 8; ++w) alld &= flags[cur * 8 + w];
            if (alld) break;
        }
    }
#undef ATT_LD
#undef ATT_CV
#undef ATT_SLOAD
#undef ATT_SWRITE
    }
    if (wave_rows) {
        const int nrow = it.nq - 32 * wid;
        const int prow = lane >> 4, piece = lane & 15;
        u32x4 gq[8];
#pragma unroll
        for (int j = 0; j < 8; ++j) { int rl = 4 * j + prow; rl = rl < nrow ? rl : nrow - 1;
            gq[j] = *reinterpret_cast<const GA u32x4*>(it.G + (size_t)(32 * wid + rl) * it.ldg + 8 * piece); }
        const float inv = (MODE == 1) ? __builtin_amdgcn_rcpf(l_reg) : 1.0f;
        char* const stg = lds + wid * 8704 + r32 * 272 + hi * 8;
#pragma unroll
        for (int d0 = 0; d0 < 4; ++d0)
#pragma unroll
            for (int g = 0; g < 4; ++g) { u32x2 w; w.x = cvtpk(o[d0][4 * g] * inv, o[d0][4 * g + 1] * inv); w.y = cvtpk(o[d0][4 * g + 2] * inv, o[d0][4 * g + 3] * inv);
                *reinterpret_cast<u32x2*>(stg + d0 * 64 + g * 16) = w; }
        asm volatile("s_waitcnt lgkmcnt(0)" ::: "memory");
        const char* const rd = lds + wid * 8704 + prow * 272 + piece * 16;
#pragma unroll
        for (int j = 0; j < 8; ++j) { const int rl = 4 * j + prow;
            const u32x4 ov = *reinterpret_cast<const u32x4*>(rd + j * 4 * 272); const u32x4 gg = gq[j]; u32x4 w;
#pragma unroll
            for (int e = 0; e < 4; ++e) w[e] = cvtpk(__uint_as_float(ov[e] << 16) * __uint_as_float(gg[e] << 16), __uint_as_float(ov[e] & 0xffff0000u) * __uint_as_float(gg[e] & 0xffff0000u));
            if (rl < nrow) *reinterpret_cast<GA u32x4*>(it.O + (size_t)(32 * wid + rl) * it.ldo + 8 * piece) = w; }
    }
    __syncthreads();
}
#undef ATT_TILE
#undef ATT_ITEM_LOADS
#undef GA
}

constexpr int NWAVES = 8;
constexpr int N_LAUNCHES = MK_N_LAUNCHES;
constexpr int PER_PHASE = 6;

constexpr size_t al256(size_t x) { return (x + 255) & ~(size_t)255; }
constexpr size_t WS_CTL = 0, CTL_ZERO_BYTES = 65536, CTL_BYTES = 1u << 20;
constexpr size_t WS_WCAT = CTL_BYTES;
constexpr size_t WS_WUP  = WS_WCAT + (size_t)NCAT * DM * 2;
constexpr size_t WS_WOUT = WS_WUP + (size_t)DM * DM * 2;
constexpr size_t WS_ACAT = WS_WOUT + (size_t)DM * DM * 2;
constexpr size_t SZ768 = (size_t)MIN_ * 768 * 2, SZ512 = (size_t)MIN_ * 512 * 2;
constexpr size_t WS_QSB = WS_ACAT + (size_t)MA * DM * 2, WS_KSB = WS_QSB + SZ768, WS_VSB = WS_KSB + SZ768, WS_GSB = WS_VSB + SZ768;
constexpr size_t WS_QBD = WS_GSB + SZ768, WS_KBD = WS_QBD + SZ768, WS_VBD = WS_KBD + SZ768, WS_GBD = WS_VBD + SZ768;
constexpr size_t WS_QMM = WS_GBD + SZ768, WS_GMM = WS_QMM + SZ512;
constexpr size_t WS_MG  = WS_GMM + SZ512;
constexpr size_t WS_MK  = WS_MG + (size_t)MIN_ * 6144 * 2, WS_MV = WS_MK + (size_t)512 * 512 * 2;
constexpr size_t WS_AUP = WS_MV + (size_t)512 * 512 * 2;
constexpr size_t WS_SSQ = WS_AUP + (size_t)MIN_ * DM * 2;
constexpr size_t WS_SSQS = WS_SSQ + (size_t)MIN_ * 32 * 4;
constexpr size_t WS_XBUF = WS_SSQS + (size_t)MS * 128 * 4;
constexpr size_t WS_YB = WS_XBUF + (size_t)MP * 8 * 4;
constexpr size_t WS_KBC = WS_YB, WS_VBC = WS_KBC + (size_t)DB * 576 * 768 * 2, WS_MKC = WS_VBC + (size_t)DB * 576 * 768 * 2, WS_MVC = WS_MKC + (size_t)DB * NMEM * 512 * 2;
static_assert(WS_MVC + (size_t)DB * NMEM * 512 * 2 <= WS_YB + (size_t)MP * DM * 2, "decode caches inside the YB region");
constexpr size_t WS_END = WS_YB + (size_t)MP * DM * 2;
static_assert(WS_WCAT % 256 == 0 && WS_QSB % 256 == 0 && WS_MG % 256 == 0 && WS_AUP % 256 == 0 && WS_SSQ % 256 == 0, "alignment");
constexpr int CW_TMO = 0, CW_WORK = 64, CW_BAR = 4096, CW_PANEL = 8192;
constexpr int OUT_ELEMS = 32112640;

constexpr int RING_BYTES = 131072, LDSCTL_OFF = RING_BYTES, MISC_OFF = LDSCTL_OFF + 320, STG_OFF = 147456, LDS_BYTES = 163840;
static_assert(att::ATT_LDS <= RING_BYTES, "attention scratch inside the ring region");

#define GAS __attribute__((address_space(1)))
#define LAS __attribute__((address_space(3)))
typedef unsigned short bf16;
typedef unsigned v4u __attribute__((ext_vector_type(4)));
typedef float f32x4 __attribute__((ext_vector_type(4)));
typedef GAS unsigned gu32;
#define RLX_AGENT __ATOMIC_RELAXED, __HIP_MEMORY_SCOPE_AGENT
#define LDS_WAIT() asm volatile("s_waitcnt lgkmcnt(0)" ::: "memory")
__device__ __forceinline__ unsigned pk2(float lo, float hi) { return pg8::cvt_pk_bf16(lo, hi); }

#define XB_TMO      128
#define XB_XCNT(j)  (256  + 64 * (j))
#define XB_XSUB(j)  (1280 + 64 * (j))
#define XB_XGEN(j)  (2304 + 64 * (j))
#define XB_TOP      3328
#define XB_TOPGEN   3392
#define XCD_BAR_WORDS 3456
#define XB_SPIN_CAP (1u << 18)
__device__ __forceinline__ unsigned xb_ld(unsigned* p)              { return __hip_atomic_load(p, __ATOMIC_RELAXED, __HIP_MEMORY_SCOPE_AGENT); }
__device__ __forceinline__ unsigned xb_add(unsigned* p, unsigned v) { return __hip_atomic_fetch_add(p, v, __ATOMIC_RELAXED, __HIP_MEMORY_SCOPE_AGENT); }
__device__ __forceinline__ unsigned xb_xcc_id() { return (unsigned)__builtin_amdgcn_s_getreg((3 << 11) | 20) & 0xFu; }
#define XB_SPIN(cond, bar) do { unsigned _sp = 0; while (cond) { __builtin_amdgcn_s_sleep(1); \
    if ((++_sp & 255u) == 0u) { if (xb_ld(&(bar)[XB_TMO])) break; if (_sp > XB_SPIN_CAP) { atomicAdd(&(bar)[XB_TMO], 1u); break; } } } } while (0)
struct XcdBarrier { unsigned* bar; unsigned x; volatile LAS unsigned* st; };
__device__ __forceinline__ XcdBarrier xcd_barrier_post(unsigned* bar, volatile LAS unsigned* st) {
    XcdBarrier b; b.bar = bar; b.x = xb_xcc_id(); b.st = st;
    if (threadIdx.x == 0) (void)xb_add(&bar[XB_XCNT(b.x)], 1u);
    return b;
}
__device__ __forceinline__ void xcd_barrier_complete(unsigned* bar, unsigned x, unsigned& nloc, unsigned& nx) {
    const unsigned G = gridDim.x * gridDim.y * gridDim.z;
    unsigned sum, cnt, mine, sp = 0u;
    for (;;) {
        sum = 0u; cnt = 0u; mine = 0u;
#pragma unroll
        for (unsigned j = 0; j < 16; ++j) { const unsigned c = xb_ld(&bar[XB_XCNT(j)]); sum += c; cnt += (c > 0u) ? 1u : 0u; mine = (j == x) ? c : mine; }
        if (sum == G) break;
        __builtin_amdgcn_s_sleep(1);
        if ((++sp & 255u) == 0u) { if (xb_ld(&bar[XB_TMO])) break; if (sp > XB_SPIN_CAP) { atomicAdd(&bar[XB_TMO], 1u); break; } }
    }
    nloc = mine > 0u ? mine : 1u; nx = cnt > 0u ? cnt : 1u;
}
__device__ __forceinline__ void xcd_barrier(const XcdBarrier& b) {
    asm volatile("s_waitcnt vmcnt(0)" ::: "memory");
    __syncthreads();
    if (threadIdx.x == 0) {
        unsigned* bar = b.bar;
        __builtin_amdgcn_s_waitcnt(0);
        unsigned nloc = b.st[0], nx = b.st[1];
        if (nloc == 0u) { xcd_barrier_complete(bar, b.x, nloc, nx); b.st[0] = nloc; b.st[1] = nx; }
        const unsigned old = xb_add(&bar[XB_XSUB(b.x)], 1u);
        const unsigned gen = old / nloc;
        if (old + 1u == (gen + 1u) * nloc) {
            __builtin_amdgcn_fence(__ATOMIC_RELEASE, "agent");
            asm volatile("s_waitcnt vmcnt(0)" ::: "memory");
            const unsigned og = xb_add(&bar[XB_TOP], 1u);
            const unsigned tg = og / nx;
            if (og + 1u == (tg + 1u) * nx) xb_add(&bar[XB_TOPGEN], 1u);
            else XB_SPIN(xb_ld(&bar[XB_TOPGEN]) == tg, bar);
            __builtin_amdgcn_fence(__ATOMIC_ACQUIRE, "agent");
            xb_add(&bar[XB_XGEN(b.x)], 1u);
            asm volatile("s_waitcnt vmcnt(0)" ::: "memory");
        } else {
            XB_SPIN(xb_ld(&bar[XB_XGEN(b.x)]) == gen, bar);
            __builtin_amdgcn_fence(__ATOMIC_ACQUIRE, "agent");
            asm volatile("s_waitcnt vmcnt(0)" ::: "memory");
        }
    }
    __syncthreads();
}

struct Frame {
    LAS unsigned char* lds;
    volatile LAS unsigned* MISC;
    gu32* ctl;
    int vcu, G;
    const float *x_prompt, *x_sample, *c_sbk, *c_sbv, *c_bdk, *c_bdv, *c_mk, *c_mv, *mem_prompt, *g_pre, *w_in, *rel_bias, *g_mem, *w_mem_kv, *w_up_sb, *w_up_band, *w_up_mem, *w_out, *g_post;
    float* out;
    bf16 *WCAT, *WUP, *WOUT, *ACAT, *QSB, *KSB, *VSB, *GSB, *QBD, *KBD, *VBD, *GBD, *QMM, *GMM, *MG, *MK, *MV, *AUP, *MERGED;
    float* SSQ; float* SSQS; bf16* YB; bf16 *KBC, *VBC, *MKC, *MVC;
};

__device__ __forceinline__ int fresh_tid() { int t = threadIdx.x; asm volatile("" : "+v"(t)); return t; }
__device__ __forceinline__ float wave_sum(float v) {
#pragma unroll
    for (int o = 1; o < 64; o <<= 1) v += __shfl_xor(v, o);
    return v;
}
__device__ __forceinline__ void p0_decode(int item, int nblk, int& kb, int& nb) { kb = item / nblk; nb = item % nblk; }
__device__ __forceinline__ void p0_transpose_item(const float* W, int N, int nkb, bf16* WT, int ldt, int row_off, int col_off, int item, int lane) {
    int kb, nb; p0_decode(item, N / 32, kb, nb); const int k0 = 64 * kb + 8 * (lane >> 3), n0 = 32 * nb + 4 * (lane & 7);
    f32x4 wv[8];
#pragma unroll
    for (int i = 0; i < 8; ++i) wv[i] = __builtin_nontemporal_load((const GAS f32x4*)(W + (size_t)(k0 + i) * N + n0));
#pragma unroll
    for (int e = 0; e < 4; ++e) { v4u o; o.x = pk2(wv[0][e], wv[1][e]); o.y = pk2(wv[2][e], wv[3][e]); o.z = pk2(wv[4][e], wv[5][e]); o.w = pk2(wv[6][e], wv[7][e]);
        *(GAS v4u*)(WT + (size_t)(row_off + n0 + e) * ldt + col_off + k0) = o; }
}
__device__ __forceinline__ void rms_row_to_bf16(const float* xrow, const float* g, bf16* orow, int lane) {
    const GAS f32x4* xr = (const GAS f32x4*)xrow + lane; const GAS f32x4* gr = (const GAS f32x4*)g + lane;
    f32x4 v[8]; float s = 0.f;
#pragma unroll
    for (int j = 0; j < 8; ++j) { v[j] = xr[64 * j]; s += (v[j].x * v[j].x + v[j].y * v[j].y) + (v[j].z * v[j].z + v[j].w * v[j].w); }
    const float r = 1.0f / sqrtf(wave_sum(s) * (1.0f / DM) + RMS_EPS);
    GAS unsigned long long* o8 = (GAS unsigned long long*)orow + lane;
#pragma unroll
    for (int j = 0; j < 8; ++j) { const f32x4 gv = gr[64 * j];
        o8[64 * j] = (unsigned long long)pk2(v[j].x * r * gv.x, v[j].y * r * gv.y) | ((unsigned long long)pk2(v[j].z * r * gv.z, v[j].w * r * gv.w) << 32); }
}
__device__ __forceinline__ void p0_t_load(const float* W, int N, int item, int lane, f32x4 (&wv)[8]) {
    int kb, nb; p0_decode(item, N / 32, kb, nb); const int k0 = 64 * kb + 8 * (lane >> 3), n0 = 32 * nb + 4 * (lane & 7);
#pragma unroll
    for (int i = 0; i < 8; ++i) wv[i] = __builtin_nontemporal_load((const GAS f32x4*)(W + (size_t)(k0 + i) * N + n0));
}
__device__ __forceinline__ int wcat_row(int c) {
    int kind, idx;
    if (c >= 7168) { const int d = c - 7168; kind = d >> 11; idx = d & 2047; }
    else { const int p = c >> 8;
        if (p < 9) return c;
        if (p < 12) { kind = 3; idx = c - 2304; }
        else if (p < 21) return c - 768;
        else if (p < 24) { kind = 3; idx = 768 + (c - 5376); }
        else if (p < 26) return c - 1536;
        else { kind = 3; idx = 1536 + (c - 6656); } }
    const int t = idx >> 6, q = idx & 63;
    return (20 + t) * 256 + 128 * (kind >> 1) + 4 * (kind & 1) + 32 * (q >> 4) + 8 * ((q >> 2) & 3) + (q & 3);
}
__device__ __forceinline__ float wcat_scale(int c) { const int p = c >> 8; return (p < 3 || (p >= 12 && p < 15) || p == 24 || p == 25) ? QSCALE : ((p >= 9 && p < 12) || p >= 21) ? -LOG2E : 1.0f; }
template <bool MAP>
__device__ __forceinline__ void p0_t_finish(const f32x4 (&wv)[8], int N, bf16* WT, int ldt, int row_off, int col_off, int item, int lane) {
    int kb, nb; p0_decode(item, N / 32, kb, nb); const int k0 = 64 * kb + 8 * (lane >> 3), n0 = 32 * nb + 4 * (lane & 7);
#pragma unroll
    for (int e = 0; e < 4; ++e) { const float sc = MAP ? wcat_scale(n0 + e) : 1.0f;
        v4u o; o.x = pk2(wv[0][e] * sc, wv[1][e] * sc); o.y = pk2(wv[2][e] * sc, wv[3][e] * sc); o.z = pk2(wv[4][e] * sc, wv[5][e] * sc); o.w = pk2(wv[6][e] * sc, wv[7][e] * sc);
        *(GAS v4u*)(WT + (size_t)(MAP ? wcat_row(n0 + e) : row_off + n0 + e) * ldt + col_off + k0) = o; }
}
__device__ __forceinline__ void rms_load(const float* xrow, int lane, f32x4 (&v)[8]) {
    const GAS f32x4* xr = (const GAS f32x4*)xrow + lane;
#pragma unroll
    for (int j = 0; j < 8; ++j) v[j] = __builtin_nontemporal_load(&xr[64 * j]);
}
__device__ __forceinline__ void rms_finish(const f32x4 (&v)[8], const f32x4 (&gv)[8], bf16* orow, int lane) {
    float s = 0.f;
#pragma unroll
    for (int j = 0; j < 8; ++j) s += (v[j].x * v[j].x + v[j].y * v[j].y) + (v[j].z * v[j].z + v[j].w * v[j].w);
    const float r = 1.0f / sqrtf(wave_sum(s) * (1.0f / DM) + RMS_EPS);
    GAS unsigned long long* o8 = (GAS unsigned long long*)orow + lane;
#pragma unroll
    for (int j = 0; j < 8; ++j) o8[64 * j] = (unsigned long long)pk2(v[j].x * r * gv[j].x, v[j].y * r * gv[j].y) | ((unsigned long long)pk2(v[j].z * r * gv[j].z, v[j].w * r * gv[j].w) << 32);
}
__device__ __forceinline__ void p0_prologue(Frame& F) {
    const int tid_ = fresh_tid(), lane_ = tid_ & 63, wave_ = __builtin_amdgcn_readfirstlane(tid_ >> 6);
    const int gw = F.vcu * NWAVES + wave_, NGW = F.G * NWAVES;
    constexpr int I_IN = 32 * (INW / 32), I_MEM = 32 * (1024 / 32), I_USB = 12 * 64, I_UBD = 12 * 64, I_UMM = 8 * 64, I_OUT = 32 * 64;
    constexpr int NI = I_IN + I_MEM;
#define P0_TLOAD(buf, it_) do { if ((it_) < I_IN) p0_t_load(F.w_in, INW, (it_), lane_, buf); else p0_t_load(F.w_mem_kv, 1024, (it_) - I_IN, lane_, buf); } while (0)
#define P0_TFIN(buf, it_) do { if ((it_) < I_IN) p0_t_finish<true>(buf, INW, F.WCAT, DM, 0, 0, (it_), lane_); else p0_t_finish<false>(buf, 1024, F.WCAT, DM, INW, 0, (it_) - I_IN, lane_); } while (0)
    { f32x4 wa[8], wb[8]; int it = gw;
      if (it < NI) P0_TLOAD(wa, it);
      while (it < NI) {
          int it2 = it + NGW; if (it2 < NI) P0_TLOAD(wb, it2);
          P0_TFIN(wa, it); it = it2; if (it >= NI) break;
          it2 = it + NGW; if (it2 < NI) P0_TLOAD(wa, it2);
          P0_TFIN(wb, it); it = it2; } }
#undef P0_TLOAD
#undef P0_TFIN
    if (!LATE_WT) for (int it = gw; it < I_USB + I_UBD + I_UMM + I_OUT; it += NGW) {
        int r = it;
        if (r < I_USB) { p0_transpose_item(F.w_up_sb, DM, 12, F.WUP, DM, 0, 0, r, lane_); continue; } r -= I_USB;
        if (r < I_UBD) { p0_transpose_item(F.w_up_band, DM, 12, F.WUP, DM, 0, 768, r, lane_); continue; } r -= I_UBD;
        if (r < I_UMM) { p0_transpose_item(F.w_up_mem, DM, 8, F.WUP, DM, 0, 1536, r, lane_); continue; } r -= I_UMM;
        p0_transpose_item(F.w_out, DM, 32, F.WOUT, DM, 0, 0, r, lane_);
    }
    { f32x4 gv[8], va[8], vb[8]; const GAS f32x4* gr = (const GAS f32x4*)F.g_pre + lane_;
#pragma unroll
      for (int j = 0; j < 8; ++j) gv[j] = gr[64 * j];
      int m = gw;
      if (m < MP) rms_load(F.x_prompt + (size_t)m * DM, lane_, va);
      while (m < MP) {
          int m2 = m + NGW; if (m2 < MP) rms_load(F.x_prompt + (size_t)m2 * DM, lane_, vb);
          rms_finish(va, gv, F.ACAT + (size_t)m * DM, lane_); m = m2; if (m >= MP) break;
          m2 = m + NGW; if (m2 < MP) rms_load(F.x_prompt + (size_t)m2 * DM, lane_, va);
          rms_finish(vb, gv, F.ACAT + (size_t)m * DM, lane_); m = m2; } }
    for (int m = MP + gw; m < MA; m += NGW) {
        bf16* orow = F.ACAT + (size_t)m * DM;
        if (m < MREAL) rms_row_to_bf16(F.x_sample + (size_t)(m - MP) * DM, F.g_pre, orow, lane_);
        else if (m < MIN_) {
            GAS v4u* o = (GAS v4u*)orow + lane_; GAS v4u* o2 = (GAS v4u*)(F.AUP + (size_t)m * DM) + lane_;
#pragma unroll
            for (int j = 0; j < 4; ++j) { o[64 * j] = (v4u){0u, 0u, 0u, 0u}; o2[64 * j] = (v4u){0u, 0u, 0u, 0u}; }
        }
        else rms_row_to_bf16(F.mem_prompt + (size_t)(m - MMEM0) * DM, F.g_mem, orow, lane_);
    }
}
constexpr int LATE_ITEMS = 128;
__device__ __forceinline__ void late_transpose_item(Frame& F, int j) {
    const int tid_ = fresh_tid(), lane_ = tid_ & 63, wave_ = __builtin_amdgcn_readfirstlane(tid_ >> 6);
    constexpr int I_USB = 12 * 64, I_UBD = 12 * 64, I_UMM = 8 * 64;
#pragma unroll 1
    for (int q = 0; q < 4; ++q) {
        int r = (j * 8 + wave_) * 4 + q;
        if (r < I_USB) { p0_transpose_item(F.w_up_sb, DM, 12, F.WUP, DM, 0, 0, r, lane_); continue; } r -= I_USB;
        if (r < I_UBD) { p0_transpose_item(F.w_up_band, DM, 12, F.WUP, DM, 0, 768, r, lane_); continue; } r -= I_UBD;
        if (r < I_UMM) { p0_transpose_item(F.w_up_mem, DM, 8, F.WUP, DM, 0, 1536, r, lane_); continue; } r -= I_UMM;
        p0_transpose_item(F.w_out, DM, 32, F.WOUT, DM, 0, 0, r, lane_);
    }
}
constexpr int CV_BD = DB * 576 * 768 / 32768, CV_MM = DB * NMEM * 512 / 32768, SLACK_ITEMS = LATE_ITEMS + 2 * CV_BD + 2 * CV_MM;
static_assert(DB * 576 * 768 % 32768 == 0 && DB * NMEM * 512 % 32768 == 0, "conversion item size");
template <bool BAND>
__device__ __forceinline__ void slack_convert(const float* src, bf16* dst, int jj, int tid_) {
    constexpr int ld = BAND ? 768 : 512, rows_d = BAND ? 576 : NMEM, rows_s = BAND ? 512 : NMEM;
    f32x4 va[8], vb[8];
#pragma unroll
    for (int it = 0; it < 8; ++it) { const int e = (jj * 4096 + it * 512 + tid_) * 8;
        const int col = e % ld, rowd = e / ld, b = rowd / rows_d, row = rowd % rows_d;
        const float* s = src + ((size_t)(b * rows_s + (row < rows_s ? row : 0)) * ld + col);
        va[it] = *(const GAS f32x4*)s; vb[it] = *(const GAS f32x4*)(s + 4); }
#pragma unroll
    for (int it = 0; it < 8; ++it) { const int e = (jj * 4096 + it * 512 + tid_) * 8; const int row = (e / ld) % rows_d;
        v4u w; w.x = pk2(va[it].x, va[it].y); w.y = pk2(va[it].z, va[it].w); w.z = pk2(vb[it].x, vb[it].y); w.w = pk2(vb[it].z, vb[it].w);
        if (row >= rows_s + DS) w = (v4u){0u, 0u, 0u, 0u};
        if (row < rows_s || row >= rows_s + DS) *(GAS v4u*)(dst + e) = w; }
}
__device__ __forceinline__ void slack_item(Frame& F, int j) {
    if (j < LATE_ITEMS) { late_transpose_item(F, j); return; }
    j -= LATE_ITEMS;
    const int tid_ = fresh_tid();
    if (j < CV_BD) slack_convert<true>(F.c_bdk, F.KBC, j, tid_);
    else if (j < 2 * CV_BD) slack_convert<true>(F.c_bdv, F.VBC, j - CV_BD, tid_);
    else if (j < 2 * CV_BD + CV_MM) slack_convert<false>(F.c_mk, F.MKC, j - 2 * CV_BD, tid_);
    else slack_convert<false>(F.c_mv, F.MVC, j - 2 * CV_BD - CV_MM, tid_);
}
struct P5Row { float sq; unsigned long long yb[8]; f32x4 xv[8]; };
__device__ __forceinline__ void p5_load(Frame& F, int m, int lane, float& sq, unsigned long long (&yb)[8], f32x4 (&xv)[8]) {
    sq = (lane < 32) ? F.SSQ[(size_t)m * 32 + lane] : 0.f;
    const GAS unsigned long long* yb8 = (const GAS unsigned long long*)(F.YB + (size_t)m * DM) + lane; const GAS f32x4* x4 = (const GAS f32x4*)(F.x_prompt + (size_t)m * DM) + lane;
#pragma unroll
    for (int j = 0; j < 8; ++j) { yb[j] = yb8[64 * j]; xv[j] = x4[64 * j]; }
}
__device__ __forceinline__ void p5_finish(Frame& F, int m, int lane, float sq, const unsigned long long (&yb)[8], const f32x4 (&xv)[8], const f32x4 (&gv)[8]) {
    const float r = 1.0f / sqrtf(wave_sum(sq) * (1.0f / DM) + RMS_EPS);
    GAS f32x4* y4 = (GAS f32x4*)(F.out + (size_t)m * DM) + lane;
#pragma unroll
    for (int j = 0; j < 8; ++j) { const unsigned long long yq = yb[j];
        const f32x4 yv = {__uint_as_float((unsigned)yq << 16), __uint_as_float((unsigned)yq & 0xffff0000u), __uint_as_float((unsigned)(yq >> 32) << 16), __uint_as_float((unsigned)(yq >> 32) & 0xffff0000u)};
        __builtin_nontemporal_store(xv[j] + yv * r * gv[j], &y4[64 * j]); }
}
__device__ __forceinline__ void p5_final(Frame& F) {
    const int tid_ = fresh_tid(), lane_ = tid_ & 63, wave_ = __builtin_amdgcn_readfirstlane(tid_ >> 6);
    const int gw = F.vcu * NWAVES + wave_, NGW = F.G * NWAVES;
    f32x4 gv[8]; { const GAS f32x4* g4 = (const GAS f32x4*)F.g_post + lane_;
#pragma unroll
        for (int j = 0; j < 8; ++j) gv[j] = g4[64 * j]; }
    if (!FUSE_RMS) {
        float sa, sb; unsigned long long ya[8], yb[8]; f32x4 xa[8], xb[8]; int m = gw;
        if (m < MP) p5_load(F, m, lane_, sa, ya, xa);
        while (m < MP) {
            int m2 = m + NGW; if (m2 < MP) p5_load(F, m2, lane_, sb, yb, xb);
            p5_finish(F, m, lane_, sa, ya, xa, gv); m = m2; if (m >= MP) break;
            m2 = m + NGW; if (m2 < MP) p5_load(F, m2, lane_, sa, ya, xa);
            p5_finish(F, m, lane_, sb, yb, xb, gv); m = m2; }
    }
    for (int m = MP + gw; m < MREAL; m += NGW) {
        float s = F.SSQS[(size_t)(m - MP) * 128 + lane_] + F.SSQS[(size_t)(m - MP) * 128 + 64 + lane_];
        s = wave_sum(s);
        const float r = 1.0f / sqrtf(s * (1.0f / DM) + RMS_EPS);
        GAS f32x4* y4 = (GAS f32x4*)(F.out + (size_t)16777216 + (size_t)(m - MP) * DM) + lane_; const GAS f32x4* x4 = (const GAS f32x4*)(F.x_sample + (size_t)(m - MP) * DM) + lane_;
#pragma unroll
        for (int j = 0; j < 8; ++j) { const f32x4 yv = y4[64 * j], xv = x4[64 * j]; y4[64 * j] = xv + yv * r * gv[j]; }
    }
}

constexpr int IT_BDP = 192, IT_BDS = 48, IT_SBP = 192, IT_SBS = 48, IT_MMP = 128, IT_MMS = 32;
constexpr int IT_TOTAL = IT_BDP + IT_BDS + IT_SBP + IT_SBS + IT_MMP + IT_MMS;
struct ArgsK { const void* in[19]; float* out; unsigned char* ws; int ph_lo, ph_hi; };
struct ItemSrc {
    const ArgsK* ka; unsigned char* ws;
    __device__ __forceinline__ GAS bf16* W(size_t off) const { return (GAS bf16*)(ws + off); }
    __device__ __forceinline__ const GAS float* I(int k) const { return (const GAS float*)ka->in[k]; }
};
__device__ __forceinline__ att::Item make_item(const ItemSrc& S, int idx) {
    GAS bf16* const QSB = S.W(WS_QSB); GAS bf16* const KSB = S.W(WS_KSB); GAS bf16* const VSB = S.W(WS_VSB); GAS bf16* const GSB = S.W(WS_GSB);
    GAS bf16* const QBD = S.W(WS_QBD); GAS bf16* const KBD = S.W(WS_KBD); GAS bf16* const VBD = S.W(WS_VBD); GAS bf16* const GBD = S.W(WS_GBD);
    GAS bf16* const QMM = S.W(WS_QMM); GAS bf16* const GMM = S.W(WS_GMM); GAS bf16* const MK = S.W(WS_MK); GAS bf16* const MV = S.W(WS_MV); GAS bf16* const AUP = S.W(WS_AUP);
    att::Item it; it.dma = 0; it.bias = nullptr; it.kf = nullptr; it.vf = nullptr; it.ldf = 0; it.pf_lo = 0; it.pf_hi = 0; it.kb = nullptr; it.vb = nullptr; it.ldb = 0; it.pb_lo = 0; it.pb_hi = 0;
    if (idx < 48) idx += 192; else if (idx < 96) idx += 432 - 48; else if (idx < 128) idx += 608 - 96; else if (idx < 320) idx -= 128; else if (idx < 512) idx += 240 - 320; else idx += 480 - 512;
    if (idx < IT_BDP) {
        const int b = idx / 96, h = (idx / 16) % 6, cg = idx % 16; const size_t row0 = (size_t)b * SEQ + 256 * cg;
        it.mode = 1; it.rule = 2; it.Q = QBD + row0 * 768 + h * HD; it.ldq = 768; it.nq = 256; it.qpos0 = 256 * cg;
        it.kb = KBD + (size_t)b * SEQ * 768 + h * HD; it.vb = VBD + (size_t)b * SEQ * 768 + h * HD; it.ldb = 768; it.pb_lo = 0; it.pb_hi = SEQ;
        it.pv_lo = 0; it.pv_hi = SEQ; const int c_lo = (4 * cg - 8) > 0 ? (4 * cg - 8) : 0;
        it.kp_first = 64 * c_lo; it.kp_step = 64; it.ntiles = 4 * cg + 4 - c_lo; it.bias = S.I(11) + h * 513; it.dma = 1;
        it.O = AUP + row0 * DM + 768 + h * HD; it.ldo = DM; it.G = GBD + row0 * 768 + h * HD; it.ldg = 768; return it; }
    idx -= IT_BDP;
    if (idx < IT_BDS) {
        const int b = idx / 6, h = idx % 6; const size_t row0 = (size_t)MP + b * DS;
        it.mode = 1; it.rule = 0; it.Q = QBD + row0 * 768 + h * HD; it.ldq = 768; it.nq = DS; it.qpos0 = PAST;
        if (SLACK_P1) {
            it.kb = S.W(WS_KBC) + (size_t)b * 576 * 768 + h * HD; it.vb = S.W(WS_VBC) + (size_t)b * 576 * 768 + h * HD; it.ldb = 768; it.pb_lo = PAST - 512; it.pb_hi = PAST - 512 + 576; it.dma = 1;
        } else {
            it.kb = KBD + row0 * 768 + h * HD; it.vb = VBD + row0 * 768 + h * HD; it.ldb = 768; it.pb_lo = PAST; it.pb_hi = PAST + DS;
            it.kf = S.I(4) + (size_t)b * 512 * 768 + h * HD; it.vf = S.I(5) + (size_t)b * 512 * 768 + h * HD; it.ldf = 768; it.pf_lo = PAST - 512; it.pf_hi = PAST; }
        it.pv_lo = PAST - 512; it.pv_hi = PAST + DS; it.kp_first = PAST - 512; it.kp_step = 64; it.ntiles = 9; it.bias = S.I(11) + h * 513;
        it.O = AUP + row0 * DM + 768 + h * HD; it.ldo = DM; it.G = GBD + row0 * 768 + h * HD; it.ldg = 768; return it; }
    idx -= IT_BDS;
    if (idx < IT_SBP) {
        const int b = idx % 2, h = (idx / 2) % 6, qb = 15 - idx / 12; const size_t row0 = (size_t)b * SEQ + 256 * qb;
        it.mode = 0; it.rule = 1; it.Q = QSB + row0 * 768 + h * HD; it.ldq = 768; it.nq = 256; it.qpos0 = 256 * qb;
        it.kb = KSB + (size_t)b * SEQ * 768 + h * HD; it.vb = VSB + (size_t)b * SEQ * 768 + h * HD; it.ldb = 768; it.pb_lo = 0; it.pb_hi = SEQ;
        it.pv_lo = 0; it.pv_hi = SEQ; it.kp_first = 64 * (4 * qb + 3); it.kp_step = -64; it.ntiles = 4 * qb + 4; it.dma = 1;
        it.O = AUP + row0 * DM + h * HD; it.ldo = DM; it.G = GSB + row0 * 768 + h * HD; it.ldg = 768; return it; }
    idx -= IT_SBP;
    if (idx < IT_SBS) {
        const int b = idx / 6, h = idx % 6; const size_t row0 = (size_t)MP + b * DS;
        it.mode = 0; it.rule = 1; it.Q = QSB + row0 * 768 + h * HD; it.ldq = 768; it.nq = DS; it.qpos0 = PAST;
        it.kb = KSB + row0 * 768 + h * HD; it.vb = VSB + row0 * 768 + h * HD; it.ldb = 768; it.pb_lo = PAST; it.pb_hi = PAST + DS;
        it.kf = S.I(2) + (size_t)b * PAST * 768 + h * HD; it.vf = S.I(3) + (size_t)b * PAST * 768 + h * HD; it.ldf = 768; it.pf_lo = 0; it.pf_hi = PAST;
        it.pv_lo = 0; it.pv_hi = PAST + DS; it.kp_first = PAST + DS - 64; it.kp_step = -64; it.ntiles = (PAST + DS + 63) / 64;
        it.O = AUP + row0 * DM + h * HD; it.ldo = DM; it.G = GSB + row0 * 768 + h * HD; it.ldg = 768; return it; }
    idx -= IT_SBS;
    if (idx < IT_MMP) {
        const int b = idx / 64, h = (idx / 16) % 4, qb = idx % 16; const size_t row0 = (size_t)b * SEQ + 256 * qb;
        it.mode = 1; it.rule = 0; it.Q = QMM + row0 * 512 + h * HD; it.ldq = 512; it.nq = 256; it.qpos0 = 0;
        it.kb = MK + (size_t)b * NMEM * 512 + h * HD; it.vb = MV + (size_t)b * NMEM * 512 + h * HD; it.ldb = 512; it.pb_lo = 0; it.pb_hi = NMEM;
        it.pv_lo = 0; it.pv_hi = NMEM; it.kp_first = 0; it.kp_step = 64; it.ntiles = 4; it.dma = 1;
        it.O = AUP + row0 * DM + 1536 + h * HD; it.ldo = DM; it.G = GMM + row0 * 512 + h * HD; it.ldg = 512; return it; }
    idx -= IT_MMP;
    {
        const int b = idx / 4, h = idx % 4; const size_t row0 = (size_t)MP + b * DS;
        it.mode = 1; it.rule = 0; it.Q = QMM + row0 * 512 + h * HD; it.ldq = 512; it.nq = DS; it.qpos0 = 0;
        if (SLACK_P1) { it.kb = S.W(WS_MKC) + (size_t)b * NMEM * 512 + h * HD; it.vb = S.W(WS_MVC) + (size_t)b * NMEM * 512 + h * HD; it.ldb = 512; it.pb_lo = 0; it.pb_hi = NMEM; it.dma = 1; }
        else { it.kf = S.I(6) + (size_t)b * NMEM * 512 + h * HD; it.vf = S.I(7) + (size_t)b * NMEM * 512 + h * HD; it.ldf = 512; it.pf_lo = 0; it.pf_hi = NMEM; }
        it.pv_lo = 0; it.pv_hi = NMEM; it.kp_first = 0; it.kp_step = 64; it.ntiles = 4;
        it.O = AUP + row0 * DM + 1536 + h * HD; it.ldo = DM; it.G = GMM + row0 * 512 + h * HD; it.ldg = 512; return it; }
}

struct Args { const void* in[19]; float* out; unsigned char* ws; int ph_lo, ph_hi; };
__global__ void __launch_bounds__(NWAVES * 64, 2) fwd_megakernel(Args args) {
    extern __shared__ __attribute__((aligned(16))) unsigned char lds[];
    Frame F;
    F.lds = (LAS unsigned char*)lds;
    F.MISC = (volatile LAS unsigned*)(F.lds + MISC_OFF);
    F.G = gridDim.x; { const int bx = blockIdx.x; F.vcu = (F.G % 8 == 0) ? (bx % 8) * (F.G / 8) + bx / 8 : bx; }
    unsigned char* ws = args.ws;
    F.ctl = (gu32*)(ws + WS_CTL);
    F.x_prompt = (const float*)args.in[0]; F.x_sample = (const float*)args.in[1]; F.c_sbk = (const float*)args.in[2]; F.c_sbv = (const float*)args.in[3];
    F.c_bdk = (const float*)args.in[4]; F.c_bdv = (const float*)args.in[5]; F.c_mk = (const float*)args.in[6]; F.c_mv = (const float*)args.in[7];
    F.mem_prompt = (const float*)args.in[8]; F.g_pre = (const float*)args.in[9]; F.w_in = (const float*)args.in[10]; F.rel_bias = (const float*)args.in[11];
    F.g_mem = (const float*)args.in[12]; F.w_mem_kv = (const float*)args.in[13]; F.w_up_sb = (const float*)args.in[14]; F.w_up_band = (const float*)args.in[15];
    F.w_up_mem = (const float*)args.in[16]; F.w_out = (const float*)args.in[17]; F.g_post = (const float*)args.in[18];
    F.out = args.out;
    F.WCAT = (bf16*)(ws + WS_WCAT); F.WUP = (bf16*)(ws + WS_WUP); F.WOUT = (bf16*)(ws + WS_WOUT); F.ACAT = (bf16*)(ws + WS_ACAT); F.MERGED = (bf16*)(ws + WS_ACAT);
    F.QSB = (bf16*)(ws + WS_QSB); F.KSB = (bf16*)(ws + WS_KSB); F.VSB = (bf16*)(ws + WS_VSB); F.GSB = (bf16*)(ws + WS_GSB);
    F.QBD = (bf16*)(ws + WS_QBD); F.KBD = (bf16*)(ws + WS_KBD); F.VBD = (bf16*)(ws + WS_VBD); F.GBD = (bf16*)(ws + WS_GBD);
    F.QMM = (bf16*)(ws + WS_QMM); F.GMM = (bf16*)(ws + WS_GMM); F.MG = (bf16*)(ws + WS_MG); F.MK = (bf16*)(ws + WS_MK); F.MV = (bf16*)(ws + WS_MV);
    F.AUP = (bf16*)(ws + WS_AUP); F.SSQ = (float*)(ws + WS_SSQ); F.SSQS = (float*)(ws + WS_SSQS); F.YB = (bf16*)(ws + WS_YB); F.KBC = (bf16*)(ws + WS_KBC); F.VBC = (bf16*)(ws + WS_VBC); F.MKC = (bf16*)(ws + WS_MKC); F.MVC = (bf16*)(ws + WS_MVC);
    for (int u = threadIdx.x; u < (STG_OFF - LDSCTL_OFF) / 4; u += NWAVES * 64) ((LAS unsigned*)(F.lds + LDSCTL_OFF))[u] = 0u;
    __syncthreads();
    XcdBarrier bar; bar.bar = (unsigned*)(F.ctl + CW_BAR); bar.x = 0; bar.st = nullptr;
    if (N_LAUNCHES != PER_PHASE) bar = xcd_barrier_post((unsigned*)(F.ctl + CW_BAR), F.MISC + 8);
#define GRID_BAR() do { if (N_LAUNCHES != PER_PHASE) xcd_barrier(bar); } while (0)
    const int lo = args.ph_lo, hi = args.ph_hi;
#ifdef ONLY_PHASE
#define IN(k) ((k) == ONLY_PHASE && lo <= (k) && (k) < hi)
#else
#define IN(k) (lo <= (k) && (k) < hi)
#endif
#define BOTH(k) (IN(k) && IN((k) + 1))
#ifdef PROBE_PHASE
#define PROBE_T0(k) do { if ((k) == PROBE_PHASE && blockIdx.x == 0 && threadIdx.x == 0) { const unsigned long long t_ = __builtin_amdgcn_s_memrealtime(); F.MISC[20] = (unsigned)t_; F.MISC[21] = (unsigned)(t_ >> 32); } } while (0)
#define PROBE_T1(k) do { if ((k) == PROBE_PHASE) { if (blockIdx.x == 0 && threadIdx.x == 0) { const unsigned long long t1_ = __builtin_amdgcn_s_memrealtime(), t0_ = (unsigned long long)F.MISC[20] | ((unsigned long long)F.MISC[21] << 32); \
        const unsigned long long te_ = t1_ + (unsigned long long)(PROBE_K) * (t1_ - t0_); unsigned n_ = 0; while (__builtin_amdgcn_s_memrealtime() < te_ && ++n_ < (1u << 22)) __builtin_amdgcn_s_sleep(4); } \
        __syncthreads(); GRID_BAR(); } } while (0)
#else
#define PROBE_T0(k) do { } while (0)
#define PROBE_T1(k) do { } while (0)
#endif
    if (IN(0)) { PROBE_T0(0); p0_prologue(F); if (BOTH(0)) GRID_BAR(); PROBE_T1(0); }
    if (IN(1)) {
        PROBE_T0(1);
        pg8::Gemm g{F.ACAT, F.WCAT, MA, NCAT, DM}; ep::InOrder S; S.init(F.G, (int)blockIdx.x);
        ep::EpiIn E{F.QSB, F.KSB, F.VSB, F.GSB, F.QBD, F.KBD, F.VBD, F.GBD, F.QMM, F.GMM, F.MG, F.MK, F.MV, F.out, F.lds + STG_OFF, F.KBC, F.VBC};
        {
        pg8::gemm_phase<ep::EpiIn, ep::InOrder, true, true>(F.lds, g, S, E);
        if (SLACK_P1) {
            volatile LAS int* sl = (volatile LAS int*)(F.MISC + 12);
            for (;;) {
                if (threadIdx.x == 0) *sl = (int)__hip_atomic_fetch_add((unsigned*)(F.ctl + CW_WORK + 64), 1u, RLX_AGENT);
                __syncthreads();
                const int j = __builtin_amdgcn_readfirstlane(*sl);
                __syncthreads();
                if (j >= SLACK_ITEMS) break;
                slack_item(F, j);
            }
        }
        if (BOTH(1)) GRID_BAR(); }
        PROBE_T1(1);
    }
    if (IN(2)) {
        PROBE_T0(2);
        volatile LAS int* slot = (volatile LAS int*)(F.lds + att::OFF_ITEM);
        for (;;) {
            if (threadIdx.x == 0) *slot = (int)__hip_atomic_fetch_add((unsigned*)(F.ctl + CW_WORK), 1u, RLX_AGENT);
            __syncthreads();
            const int idx = __builtin_amdgcn_readfirstlane(*slot);
            __syncthreads();
            if (idx >= IT_TOTAL + ((LATE_WT && !SLACK_P1) ? LATE_ITEMS : 0)) break;
            if (idx >= IT_TOTAL) { late_transpose_item(F, idx - IT_TOTAL); __syncthreads(); continue; }
            const ArgsK* ka = (const ArgsK*)__builtin_amdgcn_kernarg_segment_ptr(); unsigned char* wsl = args.ws;
            asm volatile("" : "+s"(ka), "+s"(wsl));
            const ItemSrc isrc{ka, wsl};
            const att::Item it = make_item(isrc, idx);
            if (it.dma) { if (it.mode == 0) att::run_item<0, true>(it, (char*)lds, F.lds); else att::run_item<1, true>(it, (char*)lds, F.lds); }
            else { if (it.mode == 0) att::run_item<0, false>(it, (char*)lds, F.lds); else att::run_item<1, false>(it, (char*)lds, F.lds); }
        }
        if (BOTH(2)) GRID_BAR();
        PROBE_T1(2);
    }
    if (IN(3)) {
        PROBE_T0(3);
        pg8::Gemm g{F.AUP, F.WUP, MIN_, DM, DM}; ep::MergeOrder S; S.init(F.G, (int)blockIdx.x);
        ep::EpiMerge E{F.MG, F.MERGED};
        {
        pg8::gemm_phase<ep::EpiMerge, ep::MergeOrder, true, true>(F.lds, g, S, E);
        for (int sl = F.vcu; sl < 256; sl += F.G) ep::skinny_phase<0>(F.AUP, F.WUP, F.MG, F.MERGED, nullptr, nullptr, sl, F.lds);
        if (BOTH(3)) GRID_BAR(); }
        PROBE_T1(3);
    }
    if (IN(4)) {
        PROBE_T0(4);
        pg8::Gemm g{F.MERGED, F.WOUT, MP, DM, DM}; pg8::StaticOrder S; S.init(MP, DM, F.G, (int)blockIdx.x);
#if FUSE_RMS
        ep::EpiOutFused E{F.x_prompt, F.out, F.g_post, (float*)(ws + WS_XBUF), (unsigned*)(F.ctl + CW_PANEL), (unsigned*)(F.ctl + CW_TMO)};
        {
        pg8::gemm_phase<ep::EpiOutFused, pg8::StaticOrder, false, true>(F.lds, g, S, E);
#else
        ep::EpiOut E{F.YB, F.SSQ};
        {
        pg8::gemm_phase<ep::EpiOut, pg8::StaticOrder, true, true>(F.lds, g, S, E);
#endif
        for (int sl = F.vcu; sl < 256; sl += F.G) ep::skinny_phase<1>(F.MERGED, F.WOUT, nullptr, nullptr, F.out + 16777216, F.SSQS, sl, F.lds);
        if (BOTH(4)) GRID_BAR(); }
        PROBE_T1(4);
    }
    if (IN(5)) p5_final(F);
#undef IN
#undef BOTH
#undef GRID_BAR
#undef PROBE_T0
#undef PROBE_T1
}

extern "C" void kernel_launch(void* const* d_in, const int* in_sizes, int n_in, void* d_out, int out_size, void* d_ws, size_t ws_size, hipStream_t stream) {
    static int grid = 0;
    if (grid == 0) {
        if (n_in != 19 || in_sizes[0] != MP * DM || in_sizes[10] != DM * INW || out_size != OUT_ELEMS || ws_size < WS_END) {
            fprintf(stderr, "kernel_launch: built for 19 inputs, x_prompt %d, w_in %d, out %d floats, >= %zu bytes of workspace; got n_in %d, in0 %d, in10 %d, out %d, ws %zu; nothing launched\n",
                    MP * DM, DM * INW, OUT_ELEMS, (size_t)WS_END, n_in, n_in > 0 ? in_sizes[0] : -1, n_in > 10 ? in_sizes[10] : -1, out_size, ws_size);
            grid = -1; return; }
        int dev = 0, cus = 0, per_cu = 0;
        if (hipGetDevice(&dev) != hipSuccess || hipDeviceGetAttribute(&cus, hipDeviceAttributeMultiprocessorCount, dev) != hipSuccess) { fprintf(stderr, "kernel_launch: device query failed\n"); grid = -1; return; }
        if (hipFuncSetAttribute((const void*)fwd_megakernel, hipFuncAttributeMaxDynamicSharedMemorySize, LDS_BYTES) != hipSuccess) { fprintf(stderr, "kernel_launch: hipFuncSetAttribute(%d B LDS) failed\n", LDS_BYTES); grid = -1; return; }
        if (hipOccupancyMaxActiveBlocksPerMultiprocessor(&per_cu, (const void*)fwd_megakernel, NWAVES * 64, LDS_BYTES) != hipSuccess || per_cu < 1) {
            fprintf(stderr, "kernel_launch: occupancy query reports %d workgroups per CU; nothing launched\n", per_cu); (void)hipGetLastError(); grid = -1; return; }
        grid = cus;
    }
    if (grid < 0) return;
    if (hipMemsetAsync((char*)d_ws + WS_CTL, 0, CTL_ZERO_BYTES, stream) != hipSuccess) { fprintf(stderr, "kernel_launch: hipMemsetAsync failed\n"); return; }
    Args a{};
    for (int i = 0; i < 19; ++i) a.in[i] = d_in[i];
    a.out = (float*)d_out; a.ws = (unsigned char*)d_ws;
    if (N_LAUNCHES == 1) {
        a.ph_lo = 0; a.ph_hi = PER_PHASE;
        hipLaunchKernelGGL(fwd_megakernel, dim3(grid), dim3(NWAVES * 64), LDS_BYTES, stream, a);
    } else {
        for (int li = 0; li < PER_PHASE; ++li) { a.ph_lo = li; a.ph_hi = li + 1; hipLaunchKernelGGL(fwd_megakernel, dim3(grid), dim3(NWAVES * 64), LDS_BYTES, stream, a); }
    }
    const hipError_t le = hipPeekAtLastError();
    if (le != hipSuccess) fprintf(stderr, "kernel_launch: launch failed: %s (grid %d)\n", hipGetErrorName(le), grid);
}
```

```cpp
#include <hip/hip_runtime.h>
#include <hip/hip_bf16.h>
#include <cstdio>
#include <cstdint>

#ifndef MK_N_LAUNCHES
#define MK_N_LAUNCHES 1
#endif
#ifndef FUSE_RMS
#define FUSE_RMS 0
#endif
#ifndef LATE_WT
#define LATE_WT 1
#endif
#ifndef SLACK_P1
#define SLACK_P1 1
#endif
#ifndef SB_EARLY_EXIT
#define SB_EARLY_EXIT 1
#endif

constexpr int DM = 2048, SEQ = 4096, NB = 2, DB = 8, DS = 16, PAST = 4096, HD = 128;
constexpr int MP = NB * SEQ;
constexpr int MS = DB * DS;
constexpr int MIN_ = 8448;
constexpr int MREAL = MP + MS;
constexpr int MMEM0 = 8448;
constexpr int MA = 8960;
constexpr int INW = 13312, NCAT = 14336;
constexpr int NMEM = 256;
constexpr float RMS_EPS = 1e-6f;
constexpr float LOG2E = 1.4426950408889634f;
constexpr float QSCALE = 0.08838834764831845f * 1.4426950408889634f;

namespace pg8 {
#define PG8_LAS __attribute__((address_space(3)))
typedef unsigned short bf16_t;
typedef short bf16x8 __attribute__((ext_vector_type(8)));
typedef float f32x4 __attribute__((ext_vector_type(4)));
typedef unsigned u32x4 __attribute__((ext_vector_type(4)));
constexpr int BM = 256, BK = 64, HALF = 128, HTB = HALF * BK * 2  , STAGE_BYTES = 8 * HTB, NXCD = 8, WGM = 8;

__host__ __device__ __forceinline__ int lds_byte(int r, int c) { const int st = (r >> 4) * 2 + (c >> 5), rr = r & 15, cc = c & 31, ob = rr * 64 + cc * 2; return st * 1024 + (ob ^ (((ob >> 9) & 1) << 5)); }
__host__ __device__ __forceinline__ void stage_rc(int b, int& R, int& C) { const int st = b / 1024, sb = b % 1024, swz = sb ^ (((sb >> 9) & 1) << 5); R = (st >> 1) * 16 + swz / 64; C = (st & 1) * 32 + (swz % 64) / 2; }
__host__ __device__ __forceinline__ int perm32(int rho) { const int n = rho >> 4, i = rho & 15; return 8 * (i >> 2) + 4 * n + (i & 3); }

struct Unit { int pm, pn, k0, nt; };
struct Gemm { const bf16_t* A; const bf16_t* Bt; int M, N, K; };

struct StaticOrder {
    int nM, nN, nwg, G, c;
    __host__ __device__ void init(int M, int N, int G_, int c_) { nM = M / BM; nN = N / BM; nwg = nM * nN; G = G_; c = c_; }
    __host__ __device__ bool next(int i, Unit& u) const {
        const long L = (long)i * G + c; if (L >= nwg) return false;
        int wgid = (int)L; { const int q = nwg / NXCD, r = nwg % NXCD, xcd = wgid % NXCD, off = wgid / NXCD; wgid = (xcd < r ? xcd * (q + 1) : r * (q + 1) + (xcd - r) * q) + off; }
        const int nig = WGM * nN, gid = wgid / nig, fm = gid * WGM, gsz = (nM - fm) < WGM ? (nM - fm) : WGM;
        u.pm = fm + ((wgid % nig) % gsz); u.pn = (wgid % nig) / gsz; u.k0 = 0; u.nt = 0; return true;
    }
    __device__ __forceinline__ void a_ready(const Unit&) const {}
    __device__ __forceinline__ void done(const Unit&) const {}
};

typedef float f32x2_t __attribute__((ext_vector_type(2))); typedef __bf16 bf16x2_t __attribute__((ext_vector_type(2)));
__device__ __forceinline__ unsigned cvt_pk_bf16(float lo, float hi) { f32x2_t v = {lo, hi}; bf16x2_t b = __builtin_convertvector(v, bf16x2_t); return __builtin_bit_cast(unsigned, b); }

template <class Epi, class Sched, bool ALIGN_EPI = false, bool SP2 = false>
__device__ __forceinline__ void gemm_phase(PG8_LAS unsigned char* lds, const Gemm g, const Sched& S, const Epi& E) {
    int tid_ = threadIdx.x; asm volatile("" : "+v"(tid_));
    const int tid = tid_, wid = __builtin_amdgcn_readfirstlane(tid >> 6), lane = tid & 63, wr = wid >> 2, wc = wid & 3, fr = lane & 15, fq = lane >> 4;
    const int K = g.K, nt = K / BK;
    unsigned voffA[2], voffB[2];
#pragma unroll
    for (int i = 0; i < 2; ++i) { int R, C; stage_rc(tid * 16 + i * 8192, R, C); const int Rb = Epi::PERM ? ((R & ~31) + perm32(R & 31)) : R;
        voffA[i] = (unsigned)(R * K + C) * 2u; voffB[i] = (unsigned)(Rb * K + C) * 2u; }
    const size_t kstep = (size_t)(BK * 2);
    const size_t hstep = (size_t)HALF * K * 2;
    const size_t tstep = 2 * hstep;
    const unsigned ldsw = (unsigned)wid * 1024u;
    const int aoff = lds_byte(wr * 64 + fr, fq * 8), boff = lds_byte(wc * 32 + fr, fq * 8);
#define PG8_SA(b, h) (((b) * 2 + (h)) * HTB)
#define PG8_SB(b, h) ((4 + (b) * 2 + (h)) * HTB)
#define PG8_STAGE(bufoff, gbase, voff) do { _Pragma("unroll") for (int _i = 0; _i < 2; ++_i) \
        __builtin_amdgcn_global_load_lds((const unsigned*)((const char*)(gbase) + (voff)[_i]), (PG8_LAS unsigned*)(lds + (bufoff) + ldsw + _i * 8192), 16, 0, 0); } while (0)
#define PG8_LDA(dst, b, h) do { _Pragma("unroll") for (int m = 0; m < 4; ++m) _Pragma("unroll") for (int k = 0; k < 2; ++k) dst[m][k] = *(const PG8_LAS bf16x8*)(lds + PG8_SA(b, h) + aoff + m * 2048 + k * 1024); } while (0)
#define PG8_LDB(dst, b, h) do { _Pragma("unroll") for (int n = 0; n < 2; ++n) _Pragma("unroll") for (int k = 0; k < 2; ++k) dst[n][k] = *(const PG8_LAS bf16x8*)(lds + PG8_SB(b, h) + boff + n * 2048 + k * 1024); } while (0)
#define PG8_MMA(ai, bj, At, Bt) do { __builtin_amdgcn_s_setprio(1); _Pragma("unroll") for (int m = 0; m < 4; ++m) _Pragma("unroll") for (int n = 0; n < 2; ++n) _Pragma("unroll") for (int k = 0; k < 2; ++k) \
        acc[ai][bj][m][n] = __builtin_amdgcn_mfma_f32_16x16x32_bf16(Bt[n][k], At[m][k], acc[ai][bj][m][n], 0, 0, 0); __builtin_amdgcn_s_setprio(0); } while (0)
#define PG8_WAIT_V(n) asm volatile("s_waitcnt vmcnt(" #n ")" ::: "memory")
#define PG8_WAIT_L(n) asm volatile("s_waitcnt lgkmcnt(" #n ")" ::: "memory")
#define PG8_BAR __builtin_amdgcn_s_barrier()
#define PG8_SCHED __builtin_amdgcn_sched_barrier(0)
    Unit cur, nxt; int ui = 0;
    if (!S.next(0, cur)) return;
    f32x4 acc[2][2][4][2];
#pragma unroll
    for (int a = 0; a < 2; ++a)
#pragma unroll
        for (int b = 0; b < 2; ++b)
#pragma unroll
            for (int m = 0; m < 4; ++m)
#pragma unroll
                for (int n = 0; n < 2; ++n) acc[a][b][m][n] = (f32x4){0.f, 0.f, 0.f, 0.f};
    bf16x8 At[4][2], B0[2][2], B1[2][2];
    const char* cA = (const char*)g.A + (size_t)cur.pm * tstep + (size_t)cur.k0 * 2; const char* cB = (const char*)g.Bt + (size_t)cur.pn * tstep + (size_t)cur.k0 * 2;
    S.a_ready(cur);
    if constexpr (SP2) {
        PG8_STAGE(PG8_SB(0, 0), cB, voffB); PG8_STAGE(PG8_SB(0, 1), cB + hstep, voffB); PG8_STAGE(PG8_SA(0, 0), cA, voffA); PG8_STAGE(PG8_SA(0, 1), cA + hstep, voffA);
        if (wr == 1) PG8_BAR;
        PG8_WAIT_V(2); PG8_BAR;
        PG8_STAGE(PG8_SB(1, 0), cB + kstep, voffB); PG8_STAGE(PG8_SA(1, 0), cA + kstep, voffA); PG8_STAGE(PG8_SB(1, 1), cB + hstep + kstep, voffB);
        PG8_WAIT_V(6); PG8_BAR;
    } else {
        PG8_STAGE(PG8_SB(0, 0), cB, voffB); PG8_STAGE(PG8_SA(0, 0), cA, voffA); PG8_STAGE(PG8_SB(0, 1), cB + hstep, voffB); PG8_STAGE(PG8_SA(0, 1), cA + hstep, voffA);
        if (wr == 1) PG8_BAR;
        PG8_WAIT_V(4); PG8_BAR;
        PG8_STAGE(PG8_SB(1, 0), cB + kstep, voffB); PG8_STAGE(PG8_SA(1, 0), cA + kstep, voffA); PG8_STAGE(PG8_SB(1, 1), cB + hstep + kstep, voffB);
        PG8_WAIT_V(6); PG8_BAR;
    }
    for (;;) {
        const bool has_next = S.next(ui + 1, nxt);
        const char* nA = has_next ? (const char*)g.A + (size_t)nxt.pm * tstep + (size_t)nxt.k0 * 2 : cA; const char* nB = has_next ? (const char*)g.Bt + (size_t)nxt.pn * tstep + (size_t)nxt.k0 * 2 : cB;
        const int ntu = cur.nt ? cur.nt : nt;
        for (int t = 0; t < ntu; t += 2) {
            const bool last = (t == ntu - 2);
            const char* a1 = cA + (size_t)(t + 1) * kstep;
            const char* a2 = last ? nA : cA + (size_t)(t + 2) * kstep; const char* b2 = last ? nB : cB + (size_t)(t + 2) * kstep;
            const char* a3 = a2 + kstep; const char* b3 = b2 + kstep;
            if (last && has_next) S.a_ready(nxt);
            if constexpr (SP2) {
            PG8_LDB(B0, 0, 0); PG8_LDB(B1, 0, 1); PG8_SCHED; PG8_LDA(At, 0, 0); PG8_STAGE(PG8_SA(1, 1), a1 + hstep, voffA);
            PG8_WAIT_V(8); PG8_WAIT_L(0); PG8_BAR; PG8_MMA(0, 0, At, B0); PG8_MMA(0, 1, At, B1); PG8_BAR; PG8_SCHED;
            PG8_LDA(At, 0, 1); PG8_STAGE(PG8_SB(0, 0), b2, voffB); PG8_STAGE(PG8_SB(0, 1), b2 + hstep, voffB); PG8_STAGE(PG8_SA(0, 0), a2, voffA);
            PG8_WAIT_V(8); PG8_WAIT_L(0); PG8_BAR; PG8_MMA(1, 0, At, B0); PG8_MMA(1, 1, At, B1); PG8_BAR; PG8_SCHED;
            PG8_LDB(B0, 1, 0); PG8_LDB(B1, 1, 1); PG8_SCHED; PG8_LDA(At, 1, 0); PG8_STAGE(PG8_SA(0, 1), a2 + hstep, voffA);
            PG8_WAIT_V(8); PG8_WAIT_L(0); PG8_BAR; PG8_MMA(0, 0, At, B0); PG8_MMA(0, 1, At, B1); PG8_BAR; PG8_SCHED;
            PG8_LDA(At, 1, 1); PG8_STAGE(PG8_SB(1, 0), b3, voffB); PG8_STAGE(PG8_SB(1, 1), b3 + hstep, voffB); PG8_STAGE(PG8_SA(1, 0), a3, voffA);
            PG8_WAIT_V(8); PG8_WAIT_L(0); PG8_BAR; PG8_MMA(1, 0, At, B0); PG8_MMA(1, 1, At, B1); PG8_BAR; PG8_SCHED;
            } else {
            PG8_LDB(B0, 0, 0); PG8_SCHED; PG8_LDA(At, 0, 0); PG8_STAGE(PG8_SA(1, 1), a1 + hstep, voffA);
            PG8_WAIT_L(8); PG8_BAR; PG8_WAIT_L(0); PG8_MMA(0, 0, At, B0); PG8_BAR; PG8_SCHED;
            PG8_LDB(B1, 0, 1); PG8_STAGE(PG8_SB(0, 0), b2, voffB);
            PG8_BAR; PG8_WAIT_L(0); PG8_MMA(0, 1, At, B1); PG8_BAR;
            PG8_LDA(At, 0, 1); PG8_STAGE(PG8_SA(0, 0), a2, voffA);
            PG8_BAR; PG8_WAIT_L(0); PG8_MMA(1, 0, At, B0); PG8_BAR; PG8_SCHED;
            PG8_STAGE(PG8_SB(0, 1), b2 + hstep, voffB);
            PG8_WAIT_V(6); PG8_BAR; PG8_MMA(1, 1, At, B1); PG8_BAR;
            PG8_LDB(B0, 1, 0); PG8_SCHED; PG8_LDA(At, 1, 0); PG8_STAGE(PG8_SA(0, 1), a2 + hstep, voffA);
            PG8_WAIT_L(8); PG8_BAR; PG8_WAIT_L(0); PG8_MMA(0, 0, At, B0); PG8_BAR; PG8_SCHED;
            PG8_LDB(B1, 1, 1); PG8_STAGE(PG8_SB(1, 0), b3, voffB);
            PG8_BAR; PG8_WAIT_L(0); PG8_MMA(0, 1, At, B1); PG8_BAR;
            PG8_LDA(At, 1, 1); PG8_STAGE(PG8_SA(1, 0), a3, voffA);
            PG8_BAR; PG8_WAIT_L(0); PG8_MMA(1, 0, At, B0); PG8_BAR; PG8_SCHED;
            PG8_STAGE(PG8_SB(1, 1), b3 + hstep, voffB);
            PG8_WAIT_V(6); PG8_BAR; PG8_MMA(1, 1, At, B1); PG8_BAR;
            }
        }
        if constexpr (ALIGN_EPI) { if (wr == 0) PG8_BAR; }
        if constexpr (!Epi::AFTER_DRAIN) { E(acc, cur, wr, wc, fr, fq); S.done(cur); }
        if (!has_next) break;
        if (E.reset_after(cur))
#pragma unroll
        for (int a = 0; a < 2; ++a)
#pragma unroll
            for (int b = 0; b < 2; ++b)
#pragma unroll
                for (int m = 0; m < 4; ++m)
#pragma unroll
                    for (int n = 0; n < 2; ++n) acc[a][b][m][n] = (f32x4){0.f, 0.f, 0.f, 0.f};
        cur = nxt; cA = nA; cB = nB; ++ui;
        if constexpr (ALIGN_EPI) { if (wr == 1) PG8_BAR; }
    }
    PG8_WAIT_V(0);
    if constexpr (!ALIGN_EPI) { if (wr == 0) PG8_BAR; }
    PG8_BAR;
    if constexpr (Epi::AFTER_DRAIN) { E.fused(acc, cur, wr, wc, fr, fq, lds, wid, lane); S.done(cur); }
#undef PG8_SA
#undef PG8_SB
#undef PG8_STAGE
#undef PG8_LDA
#undef PG8_LDB
#undef PG8_MMA
#undef PG8_WAIT_V
#undef PG8_WAIT_L
#undef PG8_BAR
#undef PG8_SCHED
}
}

namespace ep {
using pg8::f32x4; using pg8::u32x4; using pg8::Unit; using pg8::bf16_t; using pg8::HALF; using pg8::BM; using pg8::cvt_pk_bf16;
typedef unsigned u32x2 __attribute__((ext_vector_type(2)));

struct InOrder {
    pg8::StaticOrder so; int G, c;
    __device__ void init(int G_, int c_) { so.init(MIN_, INW, G_, c_); G = G_; c = c_; }
    __device__ bool next(int i, Unit& u) const {
        const long L = (long)i * G + c;
        if (L < so.nwg) return so.next(i, u);
        const int j = (int)(L - so.nwg); if (j >= 8) return false;
        u.pm = 33 + (j & 1); u.pn = 52 + (j >> 1); u.k0 = 0; u.nt = 0; return true;
    }
    __device__ __forceinline__ void a_ready(const Unit&) const {}
    __device__ __forceinline__ void done(const Unit&) const {}
};

__device__ __forceinline__ float sigmoidf_fast(float x) { return __builtin_amdgcn_rcpf(1.0f + __builtin_amdgcn_exp2f(-x * LOG2E)); }
__device__ __forceinline__ float bf2f(unsigned short h) { return __uint_as_float((unsigned)h << 16); }

struct EpiIn {
    static constexpr bool PERM = true, AFTER_DRAIN = false;
    bf16_t *QSB, *KSB, *VSB, *GSB, *QBD, *KBD, *VBD, *GBD, *QMM, *GMM, *MG, *MK, *MV;
    float* out;
    __attribute__((address_space(3))) unsigned char* stg;
    bf16_t *KBC, *VBC;
    __device__ __forceinline__ bool reset_after(const Unit&) const { return true; }
    template <int ACT, int F32>
    __device__ __forceinline__ void store(const f32x4 (&acc)[2][2][4][2], bf16_t* dst, int ldc, int colt, int rowoff, int pm, float* f0, float* f1, int wr, int wc, int fr, int fq, bf16_t* bdc = nullptr) const {
        const int col0 = colt + wc * 32 + 8 * fq;
#pragma unroll
        for (int ai = 0; ai < 2; ++ai)
#pragma unroll
            for (int m = 0; m < 4; ++m) {
                const int r = pm * BM + ai * HALF + wr * 64 + m * 16 + fr;
                bf16_t* rowp = dst + (size_t)(r - rowoff) * ldc + col0;
                float* frow = nullptr;
                if (F32 == 1) { if (r < MP) frow = f0 + (size_t)r * 768; else if (r < MREAL) frow = f1 + (size_t)(r - MP) * 768; }
                if (F32 == 2) { if (r < MP) { const int t = r & (SEQ - 1); if (t >= SEQ - 512) frow = f0 + ((size_t)(r >> 12) * 512 + (t - (SEQ - 512))) * 768; } else if (r < MREAL) frow = f1 + (size_t)(r - MP) * 768; }
                if (F32 == 3) frow = f0 + (size_t)(r - MMEM0) * 512;
#pragma unroll
                for (int bj = 0; bj < 2; ++bj) {
                    f32x4 v0 = acc[ai][bj][m][0], v1 = acc[ai][bj][m][1];
                    if (F32 != 0) { if (frow) { __builtin_nontemporal_store(v0, (f32x4*)(frow + col0 + bj * HALF)); __builtin_nontemporal_store(v1, (f32x4*)(frow + col0 + bj * HALF + 4)); } }
                    if (ACT == 1) { v0 = v0 * QSCALE; v1 = v1 * QSCALE; }
                    if (ACT == 2) {
#pragma unroll
                        for (int e = 0; e < 4; ++e) { v0[e] = v0[e] * sigmoidf_fast(v0[e]); v1[e] = v1[e] * sigmoidf_fast(v1[e]); } }
                    if (ACT == 3) {
#pragma unroll
                        for (int e = 0; e < 4; ++e) { v0[e] = sigmoidf_fast(v0[e]); v1[e] = sigmoidf_fast(v1[e]); } }
                    u32x4 w; w.x = cvt_pk_bf16(v0[0], v0[1]); w.y = cvt_pk_bf16(v0[2], v0[3]); w.z = cvt_pk_bf16(v1[0], v1[1]); w.w = cvt_pk_bf16(v1[2], v1[3]);
                    *(u32x4*)(rowp + bj * HALF) = w;
                    if (F32 == 2 && SLACK_P1) { if (r >= MP && r < MREAL) *(u32x4*)(bdc + ((size_t)((r - MP) >> 4) * 576 + 512 + ((r - MP) & 15)) * 768 + col0 + bj * HALF) = w; } }
            }
    }
    __device__ __forceinline__ void store_gates(const f32x4 (&acc)[2][2][4][2], int t, int pm, int wr, int wc, int fr, int fq) const {
        typedef float f32x2 __attribute__((ext_vector_type(2)));
        typedef __attribute__((address_space(3))) u32x2 lu32x2; typedef __attribute__((address_space(3))) u32x4 lu32x4;
        const int sld = (t < 24) ? 768 : 512;
        bf16_t* const sdst = (t < 12) ? GSB + 64 * t : (t < 24 ? GBD + 64 * (t - 12) : GMM + 64 * (t - 24));
        constexpr float CAP = 1073741824.0f, NLN2 = -0.6931471805599453f;
        const int row32 = wr * 16 + fr;
        const int woff = row32 * 128 + ((wc ^ ((row32 >> 1) & 3)) << 5) + fq * 8;
        const int tid = threadIdx.x, rrow = (tid & 255) >> 3, part = tid & 7, kq = tid >> 8;
        const int roff = kq * 4096 + rrow * 128 + ((((part >> 1) ^ ((rrow >> 1) & 3)) << 5) | ((part & 1) << 4));
        const int grow = pm * BM + (rrow >> 4) * 64 + (rrow & 15);
#pragma unroll
        for (int ai = 0; ai < 2; ++ai)
#pragma unroll
            for (int m = 0; m < 4; ++m) {
                u32x2 w1, w2, w3, ws;
#pragma unroll
                for (int h = 0; h < 2; ++h) {
                    const f32x2 x1 = {acc[ai][0][m][0][2 * h], acc[ai][0][m][0][2 * h + 1]}, x2 = {acc[ai][0][m][1][2 * h], acc[ai][0][m][1][2 * h + 1]};
                    const f32x2 x3 = {acc[ai][1][m][0][2 * h], acc[ai][1][m][0][2 * h + 1]}, xs = {acc[ai][1][m][1][2 * h], acc[ai][1][m][1][2 * h + 1]};
                    const f32x2 one = {1.0f, 1.0f};
                    const f32x2 d1 = (f32x2){fminf(__builtin_amdgcn_exp2f(x1.x), CAP), fminf(__builtin_amdgcn_exp2f(x1.y), CAP)} + one, d2 = (f32x2){fminf(__builtin_amdgcn_exp2f(x2.x), CAP), fminf(__builtin_amdgcn_exp2f(x2.y), CAP)} + one;
                    const f32x2 d3 = (f32x2){fminf(__builtin_amdgcn_exp2f(x3.x), CAP), fminf(__builtin_amdgcn_exp2f(x3.y), CAP)} + one, ds = (f32x2){fminf(__builtin_amdgcn_exp2f(xs.x), CAP), fminf(__builtin_amdgcn_exp2f(xs.y), CAP)} + one;
                    const f32x2 p12 = d1 * d2, p3s = d3 * ds, q = p12 * p3s;
                    const f32x2 rq = {__builtin_amdgcn_rcpf(q.x), __builtin_amdgcn_rcpf(q.y)};
                    const f32x2 i12 = rq * p3s, i3s = rq * p12;
                    const f32x2 g3 = i3s * ds, sg = (xs * NLN2) * (i3s * d3);
                    const f32x2 r1 = (d2 * d2) * i12, r2 = (d3 * d1) * i12;
                    w1[h] = cvt_pk_bf16(r1.x, r1.y); w2[h] = cvt_pk_bf16(r2.x, r2.y); w3[h] = cvt_pk_bf16(g3.x, g3.y); ws[h] = cvt_pk_bf16(sg.x, sg.y);
                }
                if (ai + m > 0) { asm volatile("s_waitcnt lgkmcnt(0)" ::: "memory"); __builtin_amdgcn_s_barrier(); }
                *(lu32x2*)(stg + woff) = w1; *(lu32x2*)(stg + 4096 + woff) = w2; *(lu32x2*)(stg + 8192 + woff) = w3; *(lu32x2*)(stg + 12288 + woff) = ws;
                asm volatile("s_waitcnt lgkmcnt(0)" ::: "memory"); __builtin_amdgcn_s_barrier(); asm volatile("" ::: "memory");
                const u32x4 va = *(const lu32x4*)(stg + roff), vb = *(const lu32x4*)(stg + 8192 + roff);
                const int r = grow + ai * HALF + m * 16;
                *(u32x4*)(MG + (size_t)r * 6144 + kq * 2048 + 64 * t + part * 8) = va;
                if (kq == 0) *(u32x4*)(MG + (size_t)r * 6144 + 4096 + 64 * t + part * 8) = vb;
                else *(u32x4*)(sdst + (size_t)r * sld + part * 8) = vb;
            }
        asm volatile("s_waitcnt lgkmcnt(0)" ::: "memory");
    }
    __device__ __forceinline__ void operator()(const f32x4 (&acc)[2][2][4][2], const Unit& u, int wr, int wc, int fr, int fq) const {
        const int pn = u.pn, pm = u.pm;
        float* const o_sbk = out + 17039360, * const o_sbv = out + 23330816, * const o_bdk = out + 29622272, * const o_bdv = out + 30408704;
        float* const o_mk = out + 31195136, * const o_mv = out + 31457280;
        float* const s_sbk = out + 31719424, * const s_sbv = out + 31817728, * const s_bdk = out + 31916032, * const s_bdv = out + 32014336;
        if (pn < 3)        store<0, 0>(acc, QSB, 768, 256 * pn, 0, pm, nullptr, nullptr, wr, wc, fr, fq);
        else if (pn < 6)   store<0, 1>(acc, KSB, 768, 256 * (pn - 3), 0, pm, o_sbk, s_sbk, wr, wc, fr, fq);
        else if (pn < 9)   store<0, 1>(acc, VSB, 768, 256 * (pn - 6), 0, pm, o_sbv, s_sbv, wr, wc, fr, fq);
        else if (pn < 12)  store<0, 0>(acc, QBD, 768, 256 * (pn - 9), 0, pm, nullptr, nullptr, wr, wc, fr, fq);
        else if (pn < 15)  store<0, 2>(acc, KBD, 768, 256 * (pn - 12), 0, pm, o_bdk, s_bdk, wr, wc, fr, fq, KBC);
        else if (pn < 18)  store<0, 2>(acc, VBD, 768, 256 * (pn - 15), 0, pm, o_bdv, s_bdv, wr, wc, fr, fq, VBC);
        else if (pn < 20)  store<0, 0>(acc, QMM, 512, 256 * (pn - 18), 0, pm, nullptr, nullptr, wr, wc, fr, fq);
        else if (pn < 52)  store_gates(acc, pn - 20, pm, wr, wc, fr, fq);
        else if (pn < 54)  store<0, 3>(acc, MK, 512, 256 * (pn - 52), MMEM0, pm, o_mk, nullptr, wr, wc, fr, fq);
        else               store<0, 3>(acc, MV, 512, 256 * (pn - 54), MMEM0, pm, o_mv, nullptr, wr, wc, fr, fq);
    }
};

struct MergeOrder {
    pg8::StaticOrder so;
    __device__ void init(int G_, int c_) { so.init(MP, DM, G_, c_); }
    __device__ bool next(int i, Unit& u) const {
        const int ti = i / 3, seg = i - 3 * ti;
        if (!so.next(ti, u)) return false;
        u.k0 = 768 * seg; u.nt = (seg == 2) ? 8 : 12; return true;
    }
    __device__ __forceinline__ void a_ready(const Unit&) const {}
    __device__ __forceinline__ void done(const Unit&) const {}
};
struct EpiMerge {
    static constexpr bool PERM = true, AFTER_DRAIN = false;
    const bf16_t* MG; bf16_t* OUT;
    __device__ __forceinline__ bool reset_after(const Unit& u) const { return u.k0 == 1536; }
    __device__ __forceinline__ void operator()(f32x4 (&acc)[2][2][4][2], const Unit& u, int wr, int wc, int fr, int fq) const {
        const int col0 = u.pn * BM + wc * 32 + 8 * fq;
        const int seg = (u.k0 == 0) ? 0 : (u.k0 == 768 ? 1 : 2);
        const bool last = (seg == 2);
        u32x4 g[2][4][2];
#pragma unroll
        for (int ai = 0; ai < 2; ++ai)
#pragma unroll
            for (int m = 0; m < 4; ++m) { const bf16_t* g_ = MG + (size_t)(u.pm * BM + ai * HALF + wr * 64 + m * 16 + fr) * 6144 + seg * 2048 + col0;
#pragma unroll
                for (int bj = 0; bj < 2; ++bj) g[ai][m][bj] = __builtin_nontemporal_load((const u32x4*)(g_ + bj * HALF)); }
#pragma unroll
        for (int ai = 0; ai < 2; ++ai)
#pragma unroll
            for (int m = 0; m < 4; ++m) { bf16_t* rowp = OUT + (size_t)(u.pm * BM + ai * HALF + wr * 64 + m * 16 + fr) * DM + col0;
#pragma unroll
                for (int bj = 0; bj < 2; ++bj) {
#pragma unroll
                    for (int e = 0; e < 4; ++e) { acc[ai][bj][m][e >> 1][2 * (e & 1)] *= __uint_as_float(g[ai][m][bj][e] << 16); acc[ai][bj][m][e >> 1][2 * (e & 1) + 1] *= __uint_as_float(g[ai][m][bj][e] & 0xffff0000u); }
                    if (last) { u32x4 w; w.x = cvt_pk_bf16(acc[ai][bj][m][0][0], acc[ai][bj][m][0][1]); w.y = cvt_pk_bf16(acc[ai][bj][m][0][2], acc[ai][bj][m][0][3]);
                        w.z = cvt_pk_bf16(acc[ai][bj][m][1][0], acc[ai][bj][m][1][1]); w.w = cvt_pk_bf16(acc[ai][bj][m][1][2], acc[ai][bj][m][1][3]);
                        *(u32x4*)(rowp + bj * HALF) = w; } } }
    }
};

struct EpiOut {
    static constexpr bool PERM = true, AFTER_DRAIN = false;
    bf16_t* yb; float* ssq;
    __device__ __forceinline__ bool reset_after(const Unit&) const { return true; }
    __device__ __forceinline__ void operator()(const f32x4 (&acc)[2][2][4][2], const Unit& u, int wr, int wc, int fr, int fq) const {
        const int col0 = u.pn * BM + wc * 32 + 8 * fq;
#pragma unroll
        for (int ai = 0; ai < 2; ++ai)
#pragma unroll
            for (int m = 0; m < 4; ++m) {
                const int r = u.pm * BM + ai * HALF + wr * 64 + m * 16 + fr;
                bf16_t* yrow = yb + (size_t)r * DM + col0;
                float s = 0.f;
#pragma unroll
                for (int bj = 0; bj < 2; ++bj) { const f32x4 v0 = acc[ai][bj][m][0], v1 = acc[ai][bj][m][1];
                    s += ((v0[0] * v0[0] + v0[1] * v0[1]) + (v0[2] * v0[2] + v0[3] * v0[3])) + ((v1[0] * v1[0] + v1[1] * v1[1]) + (v1[2] * v1[2] + v1[3] * v1[3]));
                    u32x4 w; w.x = cvt_pk_bf16(v0[0], v0[1]); w.y = cvt_pk_bf16(v0[2], v0[3]); w.z = cvt_pk_bf16(v1[0], v1[1]); w.w = cvt_pk_bf16(v1[2], v1[3]);
                    *(u32x4*)(yrow + bj * HALF) = w; }
                s += __shfl_xor(s, 16); s += __shfl_xor(s, 32);
                if (fq == 0) ssq[(size_t)r * 32 + u.pn * 4 + wc] = s;
            }
    }
};

struct EpiOutFused {
    static constexpr bool PERM = false, AFTER_DRAIN = true;
    const float* x; float* out; const float* gpost; float* xbuf; unsigned* cnt; unsigned* tmo;
    __device__ __forceinline__ bool reset_after(const Unit&) const { return true; }
    __device__ __forceinline__ void operator()(const f32x4 (&)[2][2][4][2], const Unit&, int, int, int, int) const {}
    __device__ __forceinline__ void fused(f32x4 (&acc)[2][2][4][2], const Unit& u, int wr, int wc, int fr, int fq, __attribute__((address_space(3))) unsigned char* lds, int wid, int lane) const {
        typedef __attribute__((address_space(3))) float lfloat;
        lfloat* P = (lfloat*)lds;
        lfloat* S = (lfloat*)(lds + 4096);
        __attribute__((address_space(3))) unsigned* flag = (__attribute__((address_space(3))) unsigned*)(lds + 4096 + 1024);
        const int col0 = u.pn * BM + wc * 32 + 4 * fq;
        f32x4 pre[4][2][2];
#pragma unroll
        for (int m = 0; m < 4; ++m) { const size_t off = (size_t)(u.pm * BM + wr * 64 + m * 16 + fr) * DM + col0;
#pragma unroll
            for (int bj = 0; bj < 2; ++bj)
#pragma unroll
                for (int n = 0; n < 2; ++n) pre[m][bj][n] = *(const f32x4*)(x + off + bj * HALF + n * 16); }
#pragma unroll
        for (int ai = 0; ai < 2; ++ai)
#pragma unroll
            for (int m = 0; m < 4; ++m) { float s = 0.f;
#pragma unroll
                for (int bj = 0; bj < 2; ++bj)
#pragma unroll
                    for (int n = 0; n < 2; ++n) { const f32x4 v = acc[ai][bj][m][n]; s += (v[0] * v[0] + v[1] * v[1]) + (v[2] * v[2] + v[3] * v[3]); }
                s += __shfl_xor(s, 16); s += __shfl_xor(s, 32);
                if (fq == 0) P[(ai * HALF + wr * 64 + m * 16 + fr) * 4 + wc] = s; }
        asm volatile("s_waitcnt lgkmcnt(0)" ::: "memory"); __builtin_amdgcn_s_barrier(); asm volatile("" ::: "memory");
        const int row = wid * 32 + (lane & 31);
        if (lane < 32) { const float t = (P[row * 4 + 0] + P[row * 4 + 1]) + (P[row * 4 + 2] + P[row * 4 + 3]);
            __hip_atomic_store(xbuf + ((size_t)(u.pm * BM + row) * 8 + u.pn), t, __ATOMIC_RELAXED, __HIP_MEMORY_SCOPE_AGENT); }
        asm volatile("s_waitcnt vmcnt(0)" ::: "memory");
        if (lane == 0) __hip_atomic_fetch_add(cnt + 64 * u.pm, 1u, __ATOMIC_RELAXED, __HIP_MEMORY_SCOPE_AGENT);
        if (wid == 0) { bool dead = false; const unsigned long long t0 = __builtin_amdgcn_s_memrealtime();
            for (;;) {
                if ((unsigned)__builtin_amdgcn_readfirstlane(__hip_atomic_load(cnt + 64 * u.pm, __ATOMIC_RELAXED, __HIP_MEMORY_SCOPE_AGENT)) >= 64u) break;
                if (__builtin_amdgcn_s_memrealtime() - t0 > 2000000ull) { if (lane == 0) __hip_atomic_store(tmo, 1u, __ATOMIC_RELAXED, __HIP_MEMORY_SCOPE_AGENT); dead = true; break; }
                __builtin_amdgcn_s_sleep(2); }
            __builtin_amdgcn_fence(__ATOMIC_ACQUIRE, "agent");
            if (lane == 0) flag[0] = dead ? 1u : 0u; }
        asm volatile("s_waitcnt vmcnt(0) lgkmcnt(0)" ::: "memory"); __builtin_amdgcn_s_barrier(); asm volatile("" ::: "memory");
        const bool bad = flag[0] != 0u;
        if (lane < 32) { const float* slot = xbuf + (size_t)(u.pm * BM + row) * 8; float q = 0.f;
#pragma unroll
            for (int t = 0; t < 8; ++t) q += __hip_atomic_load(slot + t, __ATOMIC_RELAXED, __HIP_MEMORY_SCOPE_AGENT);
            S[row] = 1.0f / sqrtf(q * (1.0f / DM) + RMS_EPS); }
        asm volatile("s_waitcnt lgkmcnt(0)" ::: "memory"); __builtin_amdgcn_s_barrier(); asm volatile("" ::: "memory");
        f32x4 gv[2][2];
#pragma unroll
        for (int bj = 0; bj < 2; ++bj)
#pragma unroll
            for (int n = 0; n < 2; ++n) gv[bj][n] = *(const f32x4*)(gpost + col0 + bj * HALF + n * 16);
        const float qnan = __builtin_nanf("");
#pragma unroll
        for (int ai = 0; ai < 2; ++ai)
#pragma unroll
            for (int m = 0; m < 4; ++m) { const int r = ai * HALF + wr * 64 + m * 16 + fr; const float rs = S[r]; const size_t off = (size_t)(u.pm * BM + r) * DM + col0;
#pragma unroll
                for (int bj = 0; bj < 2; ++bj)
#pragma unroll
                    for (int n = 0; n < 2; ++n) { const f32x4 bs = ai == 0 ? pre[m][bj][n] : *(const f32x4*)(x + off + bj * HALF + n * 16);
                        f32x4 o = bs + acc[ai][bj][m][n] * rs * gv[bj][n];
                        if (bad) o = (f32x4){qnan, qnan, qnan, qnan};
                        *(f32x4*)(out + off + bj * HALF + n * 16) = o; }
                if (m & 1) asm volatile("" ::: "memory"); }
    }
};

template <int MODE>
__device__ __forceinline__ void skinny_phase(const bf16_t* A, const bf16_t* Bt, const bf16_t* MG, bf16_t* OUTB, float* OUTF, float* SSQS, int slice, __attribute__((address_space(3))) unsigned char* ldsl) {
    typedef short bf16x8 __attribute__((ext_vector_type(8)));
    int tid_ = threadIdx.x; asm volatile("" : "+v"(tid_));
    const int tid = tid_, lane = tid & 63, fr = lane & 15, fq = lane >> 4;
    const int w = __builtin_amdgcn_readfirstlane(tid >> 6);
    const int cb = slice >> 1, rh = slice & 1;
    const int row0 = MP + 64 * rh + fr;
    const bf16_t* ap = A + (size_t)row0 * DM + 256 * w + 8 * fq;
    const bf16_t* bp = Bt + (size_t)(16 * cb + fr) * DM + 256 * w + 8 * fq;
    bf16x8 bf[8], af[4][8];
#pragma unroll
    for (int j = 0; j < 8; ++j) bf[j] = *(const bf16x8*)(bp + 32 * j);
#pragma unroll
    for (int rb = 0; rb < 4; ++rb)
#pragma unroll
        for (int j = 0; j < 8; ++j) af[rb][j] = *(const bf16x8*)(ap + (size_t)rb * 16 * DM + 32 * j);
    f32x4 acc[4];
#pragma unroll
    for (int rb = 0; rb < 4; ++rb) { acc[rb] = (f32x4){0.f, 0.f, 0.f, 0.f};
#pragma unroll
        for (int j = 0; j < 8; ++j) acc[rb] = __builtin_amdgcn_mfma_f32_16x16x32_bf16(bf[j], af[rb][j], acc[rb], 0, 0, 0); }
    if (MODE == 0) { const int s = (w < 3) ? 0 : (w < 6 ? 1 : 2);
#pragma unroll
        for (int rb = 0; rb < 4; ++rb) { const bf16_t* gp = MG + (size_t)(row0 + 16 * rb) * 6144 + 16 * cb + 4 * fq;
            const u32x2 ra = *(const u32x2*)gp, rb2 = *(const u32x2*)(gp + 2048), gc = *(const u32x2*)(gp + 4096);
#pragma unroll
            for (int e = 0; e < 4; ++e) { const unsigned a_ = e < 2 ? ra.x : ra.y, b_ = e < 2 ? rb2.x : rb2.y, c_ = e < 2 ? gc.x : gc.y;
                const float f1 = (e & 1) ? __uint_as_float(a_ & 0xffff0000u) : __uint_as_float(a_ << 16), f2 = (e & 1) ? __uint_as_float(b_ & 0xffff0000u) : __uint_as_float(b_ << 16), f3 = (e & 1) ? __uint_as_float(c_ & 0xffff0000u) : __uint_as_float(c_ << 16);
                acc[rb][e] *= f3 * (s < 2 ? f2 : 1.0f) * (s < 1 ? f1 : 1.0f); } } }
    __attribute__((address_space(3))) f32x4* red = (__attribute__((address_space(3))) f32x4*)ldsl;
#pragma unroll
    for (int rb = 0; rb < 4; ++rb) red[(w * 4 + rb) * 64 + lane] = acc[rb];
    __syncthreads();
    if (w < 4) { const int rb = w; f32x4 s = red[rb * 64 + lane];
#pragma unroll
        for (int k = 1; k < 8; ++k) s = s + red[(k * 4 + rb) * 64 + lane];
        const int row = row0 + 16 * rb;
        if (MODE == 0) { u32x2 o; o.x = cvt_pk_bf16(s[0], s[1]); o.y = cvt_pk_bf16(s[2], s[3]); *(u32x2*)(OUTB + (size_t)row * DM + 16 * cb + 4 * fq) = o; }
        else { *(f32x4*)(OUTF + (size_t)(row - MP) * DM + 16 * cb + 4 * fq) = s;
            float q = (s[0] * s[0] + s[1] * s[1]) + (s[2] * s[2] + s[3] * s[3]);
            q += __shfl_xor(q, 16); q += __shfl_xor(q, 32);
            if (fq == 0) SSQS[(size_t)(row - MP) * 128 + cb] = q; }
    }
    __syncthreads();
}
}

namespace att {
typedef unsigned short u16;
#define GA __attribute__((address_space(1)))
using bf16x8 = __attribute__((ext_vector_type(8))) short;
using s16x4  = __attribute__((ext_vector_type(4))) short;
using f32x16 = __attribute__((ext_vector_type(16))) float;
using f32x4  = __attribute__((ext_vector_type(4))) float;
using u32x4  = __attribute__((ext_vector_type(4))) unsigned;
using u32x2  = __attribute__((ext_vector_type(2))) unsigned;
constexpr int SHM_V = 16384, SHM_K = 16384;
constexpr int NBUF = 3;
constexpr int OFF_V = 0, OFF_K = NBUF * SHM_V, OFF_BIAS = 2 * NBUF * SHM_V, OFF_FLAGS = OFF_BIAS + 2304, OFF_ITEM = OFF_FLAGS + 128, ATT_LDS = OFF_ITEM + 64;
constexpr float SB_DONE_LOG2 = -200.0f;
#define KSWZ(row, colB) ((row) * 256 + ((colB) ^ (((row) & 7) << 4)))
#define ATT_SBAR() __builtin_amdgcn_sched_barrier(0)
__device__ __forceinline__ int crow(int r, int hi) { return (r & 3) + 8 * (r >> 2) + 4 * hi; }
__device__ __forceinline__ unsigned cvtpk(float lo, float hi) { return pg8::cvt_pk_bf16(lo, hi); }
__device__ __forceinline__ int v_st(int k, int c) { const int kk = (k & ~0xC) | ((k & 4) << 1) | ((k & 8) >> 1); return ((kk >> 3) * 4 + (c >> 5)) * 512 + ((kk & 7) * 32 + (c & 31)) * 2; }
__device__ __forceinline__ int v_rd_base(int lane) { return ((lane & 3) << 3) | (((lane >> 2) & 3) << 6) | (((lane >> 4) & 1) << 5) | (((lane >> 5) & 1) << 8); }
constexpr int v_rd_off(int d0, int ks, int half) { return d0 * 512 + ks * 4096 + half * 2048; }
template <int OFF> __device__ __forceinline__ s16x4 tr_read(int vb) { s16x4 r; asm volatile("ds_read_b64_tr_b16 %0, %1 offset:%2" : "=&v"(r) : "v"(vb), "i"(OFF) : "memory"); return r; }

struct Item {
    int mode;
    int rule;
    const GA u16* Q; int ldq; int nq; int qpos0;
    const GA u16 *kb, *vb; int ldb; int pb_lo, pb_hi;
    const GA float *kf, *vf; int ldf; int pf_lo, pf_hi;
    int pv_lo, pv_hi;
    int kp_first, kp_step, ntiles;
    const GA float* bias;
    GA u16* O; int ldo; const GA u16* G; int ldg;
    int dma;
};

template <bool QPARK>
__device__ __forceinline__ void qkt(f32x16& p0, f32x16& p1, const char* Ks, const bf16x8* qr, const char* qpark, int r32, int hi) {
    p0 = f32x16{}; p1 = f32x16{};
#pragma unroll
    for (int d0 = 0; d0 < 8; ++d0) { const int cb = (d0 * 16 + hi * 8) * 2;
        const bf16x8 b0 = *reinterpret_cast<const bf16x8*>(Ks + KSWZ(r32, cb));
        const bf16x8 b1 = *reinterpret_cast<const bf16x8*>(Ks + KSWZ(32 + r32, cb));
        const bf16x8 q = QPARK ? *reinterpret_cast<const bf16x8*>(qpark + d0 * 1024) : qr[d0];
        p0 = __builtin_amdgcn_mfma_f32_32x32x16_bf16(b0, q, p0, 0, 0, 0);
        p1 = __builtin_amdgcn_mfma_f32_32x32x16_bf16(b1, q, p1, 0, 0, 0); }
}
template <int D0> __device__ __forceinline__ void pv_one(f32x16& od, int vb, bf16x8 pa0, bf16x8 pa1, bf16x8 pa2, bf16x8 pa3) {
    const s16x4 l0 = tr_read<v_rd_off(D0, 0, 0)>(vb), h0 = tr_read<v_rd_off(D0, 0, 1)>(vb), l1 = tr_read<v_rd_off(D0, 1, 0)>(vb), h1 = tr_read<v_rd_off(D0, 1, 1)>(vb);
    const s16x4 l2 = tr_read<v_rd_off(D0, 2, 0)>(vb), h2 = tr_read<v_rd_off(D0, 2, 1)>(vb), l3 = tr_read<v_rd_off(D0, 3, 0)>(vb), h3 = tr_read<v_rd_off(D0, 3, 1)>(vb);
    asm volatile("s_waitcnt lgkmcnt(0)" ::: "memory"); ATT_SBAR();
#define ATT_PK(L, H) (bf16x8){L[0], L[1], L[2], L[3], H[0], H[1], H[2], H[3]}
    od = __builtin_amdgcn_mfma_f32_32x32x16_bf16(ATT_PK(l0, h0), pa0, od, 0, 0, 0);
    od = __builtin_amdgcn_mfma_f32_32x32x16_bf16(ATT_PK(l1, h1), pa1, od, 0, 0, 0);
    od = __builtin_amdgcn_mfma_f32_32x32x16_bf16(ATT_PK(l2, h2), pa2, od, 0, 0, 0);
    od = __builtin_amdgcn_mfma_f32_32x32x16_bf16(ATT_PK(l3, h3), pa3, od, 0, 0, 0);
#undef ATT_PK
}
#define ATT_PK4(P, BASE, OUT) do { const unsigned a0_ = cvtpk(P[BASE + 0], P[BASE + 1]), a1_ = cvtpk(P[BASE + 2], P[BASE + 3]);   \
    const unsigned b0_ = cvtpk(P[BASE + 4], P[BASE + 5]), b1_ = cvtpk(P[BASE + 6], P[BASE + 7]);                              \
    auto r0_ = __builtin_amdgcn_permlane32_swap(a0_, b0_, false, false); auto r1_ = __builtin_amdgcn_permlane32_swap(a1_, b1_, false, false); \
    u32x4 w_ = {r0_[0], r1_[0], r0_[1], r1_[1]}; OUT = *reinterpret_cast<bf16x8*>(&w_); } while (0)

__device__ __forceinline__ void sb_half(f32x16& p, float& carry, bool need_mask, int kbase, int qpos, int pv_lo, int pv_hi, int hi) {
    float T[16];
#pragma unroll
    for (int r = 0; r < 16; ++r) {
        const float z = p[r];
        const float t = __builtin_amdgcn_exp2f(-__builtin_fabsf(z));
        const float l = __builtin_amdgcn_logf(1.0f + t);
        float lm = -(fmaxf(z, 0.f) + l);
        float lp = fminf(z, 0.f) - l;
        if (need_mask) { const int kp = kbase + crow(r, hi); const bool ok = (kp < qpos) && (kp >= pv_lo) && (kp < pv_hi); lm = ok ? lm : 0.f; lp = ok ? lp : -1e30f; }
        T[r] = lm; p[r] = lp;
    }
    float glo[4], ghi[4];
#pragma unroll
    for (int g = 0; g < 4; ++g) {
        T[4 * g + 2] += T[4 * g + 3]; T[4 * g + 1] += T[4 * g + 2]; T[4 * g] += T[4 * g + 1];
        const float gt = T[4 * g];
        auto rr = __builtin_amdgcn_permlane32_swap(__float_as_uint(gt), __float_as_uint(gt), false, false);
        glo[g] = __uint_as_float(rr[0]); ghi[g] = __uint_as_float(rr[1]);
    }
    float SG[4];
    SG[3] = 0.f; SG[2] = glo[3] + ghi[3]; SG[1] = SG[2] + (glo[2] + ghi[2]); SG[0] = SG[1] + (glo[1] + ghi[1]);
    const float tot = SG[0] + (glo[0] + ghi[0]);
#pragma unroll
    for (int g = 0; g < 4; ++g) SG[g] += carry + (hi == 0 ? ghi[g] : 0.f);
#pragma unroll
    for (int r = 0; r < 16; ++r) p[r] = __builtin_amdgcn_exp2f(p[r] + ((r & 3) == 3 ? SG[r >> 2] : SG[r >> 2] + T[r + 1]));
    carry += tot;
}

#define ATT_TILE(Kt, vb_) do { \
            f32x16 p0, p1; \
            qkt<!DMA>(p0, p1, (Kt), qr, qpark, r32, hi); \
            bool need_mask = (kp0 < it.pv_lo) || (kp0 + 64 > it.pv_hi); \
            if (MODE == 0) { \
                need_mask = need_mask || (kp0 + 63 >= it.qpos0 + 32 * wid); \
                sb_half(p1, carry, need_mask, kp0 + 32, qpos, it.pv_lo, it.pv_hi, hi); \
                sb_half(p0, carry, need_mask, kp0, qpos, it.pv_lo, it.pv_hi, hi); \
            } else { \
                if (has_bias) {       \
                    const int dlo_ = it.qpos0 + 32 * wid - kp0 - 63, dhi_ = it.qpos0 + 32 * wid + 31 - kp0;       \
                    if (dlo_ >= 256) { const float c_ = biasT[0]; \
                        _Pragma("unroll") for (int r = 0; r < 16; ++r) { p0[r] += c_; p1[r] += c_; } } \
                    else if (dlo_ > -256 && dhi_ < 256) { const float* rb_ = biasT + (256 - qpos + kp0 + 4 * hi);              \
                        _Pragma("unroll") for (int r = 0; r < 16; ++r) { p0[r] += rb_[(r & 3) + 8 * (r >> 2)]; p1[r] += rb_[32 + (r & 3) + 8 * (r >> 2)]; } } \
                    else { \
                        _Pragma("unroll") for (int r = 0; r < 16; ++r) { const int kp = kp0 + crow(r, hi); \
                            int i0_ = 256 - qpos + kp; i0_ = i0_ < 0 ? 0 : (i0_ > 512 ? 512 : i0_); \
                            int i1_ = 288 - qpos + kp; i1_ = i1_ < 0 ? 0 : (i1_ > 512 ? 512 : i1_); \
                            p0[r] += biasT[i0_]; p1[r] += biasT[i1_]; } } \
                } \
                if (need_mask) { \
                    _Pragma("unroll") for (int r = 0; r < 16; ++r) { const int kp = kp0 + crow(r, hi); \
                        if (!(kp >= it.pv_lo && kp < it.pv_hi)) p0[r] = -1e30f; \
                        if (!(kp + 32 >= it.pv_lo && kp + 32 < it.pv_hi)) p1[r] = -1e30f; } \
                } \
                float pmax = p0[0]; \
                _Pragma("unroll") for (int r = 1; r < 16; ++r) pmax = fmaxf(pmax, p0[r]); \
                _Pragma("unroll") for (int r = 0; r < 16; ++r) pmax = fmaxf(pmax, p1[r]); \
                { auto rr = __builtin_amdgcn_permlane32_swap(__float_as_uint(pmax), __float_as_uint(pmax), false, false); pmax = fmaxf(__uint_as_float(rr[0]), __uint_as_float(rr[1])); } \
                float mn = m_reg, alpha = 1.f;                  \
                if (!__all(pmax - m_reg <= 8.0f)) { mn = fmaxf(m_reg, pmax); alpha = __builtin_amdgcn_exp2f(m_reg - mn); m_reg = mn; } \
                float ps = 0.f; \
                _Pragma("unroll") for (int r = 0; r < 16; ++r) { p0[r] = __builtin_amdgcn_exp2f(p0[r] - mn); ps += p0[r]; } \
                _Pragma("unroll") for (int r = 0; r < 16; ++r) { p1[r] = __builtin_amdgcn_exp2f(p1[r] - mn); ps += p1[r]; } \
                { auto rr = __builtin_amdgcn_permlane32_swap(__float_as_uint(ps), __float_as_uint(ps), false, false); ps = __uint_as_float(rr[0]) + __uint_as_float(rr[1]); } \
                l_reg = l_reg * alpha + ps; \
                if (__any(alpha < 1.f)) { \
                    _Pragma("unroll") for (int d = 0; d < 4; ++d) \
                        _Pragma("unroll") for (int r = 0; r < 16; ++r) o[d][r] *= alpha; } \
            } \
            bf16x8 pa0, pa1, pa2, pa3; \
            ATT_PK4(p0, 0, pa0); ATT_PK4(p0, 8, pa1); ATT_PK4(p1, 0, pa2); ATT_PK4(p1, 8, pa3); \
            const int vbt_ = (vb_); \
            pv_one<0>(o[0], vbt_, pa0, pa1, pa2, pa3); pv_one<1>(o[1], vbt_, pa0, pa1, pa2, pa3); pv_one<2>(o[2], vbt_, pa0, pa1, pa2, pa3); pv_one<3>(o[3], vbt_, pa0, pa1, pa2, pa3); \
        } while (0)

template <int MODE, bool DMA>
__device__ __forceinline__ void run_item(const Item& it, char* lds, __attribute__((address_space(3))) unsigned char* ldsl) {
    typedef __attribute__((address_space(3))) unsigned las_u32;
    const int tid = threadIdx.x, lane = tid & 63, r32 = lane & 31, hi = lane >> 5;
    const int wid = __builtin_amdgcn_readfirstlane(tid >> 6);
    char* V_lds = lds + OFF_V; char* K_lds = lds + OFF_K;
    float* biasT = (float*)(lds + OFF_BIAS);
    volatile __attribute__((address_space(3))) int* flags = (volatile __attribute__((address_space(3))) int*)(ldsl + OFF_FLAGS);
    const bool has_bias = (MODE == 1) && (it.bias != nullptr);
    const bool wave_rows = (32 * wid < it.nq);
    int qrow = 32 * wid + r32; if (qrow >= it.nq) qrow = it.nq - 1;
    const int qpos = it.qpos0 + 32 * wid + r32;
    bf16x8 qr[8];
    char* const qpark = K_lds + 2 * SHM_K + (wid & 1) * 8192 + lane * 16;
#define ATT_ITEM_LOADS() do { \
    if (has_bias) for (int i = tid; i < 513; i += 512) biasT[i] = it.bias[512 - i] * LOG2E; \
    { const GA u16* Qw = it.Q + (size_t)qrow * it.ldq + hi * 8; \
      _Pragma("unroll") for (int d0 = 0; d0 < 8; ++d0) { const bf16x8 q = *reinterpret_cast<const GA bf16x8*>(Qw + d0 * 16); \
          if constexpr (DMA) qr[d0] = q; else { if (wid < 2) *reinterpret_cast<bf16x8*>(qpark + d0 * 1024) = q; } } } \
    } while (0)
    f32x16 o[4]; o[0] = f32x16{}; o[1] = f32x16{}; o[2] = f32x16{}; o[3] = f32x16{};
    float carry = 0.f, m_reg = -1e30f, l_reg = 0.f;
    const int vb0 = (int)(uintptr_t)V_lds + v_rd_base(lane);
    const int nt = it.ntiles;
    bool wdone = !wave_rows;
    if constexpr (!DMA) ATT_ITEM_LOADS();
    if constexpr (DMA) {
        unsigned koff[2], voff[2];
#pragma unroll
        for (int i = 0; i < 2; ++i) { const int p = wid + 8 * i;
            const int krow = 4 * p + (lane >> 4), kch = (lane & 15) ^ (krow & 7);
            koff[i] = (unsigned)(krow * it.ldb * 2 + kch * 16);
            const int s = 2 * p + (lane >> 5), kk = 8 * (s >> 2) + ((lane & 31) >> 2), k = (kk & ~0xC) | ((kk & 4) << 1) | ((kk & 8) >> 1), c = 32 * (s & 3) + 8 * (lane & 3);
            voff[i] = (unsigned)(k * it.ldb * 2 + c * 2); }
        const GA char* kbase = (const GA char*)it.kb; const GA char* vbase = (const GA char*)it.vb;
#define ATT_DMA(b, kp0_) do { const size_t to_ = (size_t)((kp0_) - it.pb_lo) * (size_t)it.ldb * 2; \
        _Pragma("unroll") for (int i_ = 0; i_ < 2; ++i_) { \
            __builtin_amdgcn_global_load_lds((const GA unsigned*)(kbase + to_ + koff[i_]), (las_u32*)(ldsl + OFF_K + (b) * SHM_K + (wid + 8 * i_) * 1024), 16, 0, 0); \
            __builtin_amdgcn_global_load_lds((const GA unsigned*)(vbase + to_ + voff[i_]), (las_u32*)(ldsl + OFF_V + (b) * SHM_V + (wid + 8 * i_) * 1024), 16, 0, 0); } } while (0)
        ATT_DMA(0, it.kp_first);
        if (nt > 1) ATT_DMA(1, it.kp_first + it.kp_step);
        ATT_ITEM_LOADS();
        int cur = 0;
        for (int j = 0; j < nt; ++j) {
            const int kp0 = it.kp_first + j * it.kp_step;
            if (j + 1 < nt) asm volatile("s_waitcnt vmcnt(4) lgkmcnt(0)\n\ts_barrier" ::: "memory");
            else            asm volatile("s_waitcnt vmcnt(0) lgkmcnt(0)\n\ts_barrier" ::: "memory");
            if (MODE == 0 && SB_EARLY_EXIT && j > 0) {
                int alld = 1;
#pragma unroll
                for (int w = 0; w < 8; ++w) alld &= flags[((j - 1) & 1) * 8 + w];
                if (alld) break;
            }
            if (j + 2 < nt) { const int b2 = (cur >= 1) ? cur - 1 : cur + 2; ATT_DMA(b2, kp0 + 2 * it.kp_step); }
            bool active = wave_rows;
            if (it.rule == 1) active = active && (kp0 <= it.qpos0 + 32 * wid + 30) && !wdone;
            if (it.rule == 2) { const int ct = kp0 >> 6, cw = (it.qpos0 + 32 * wid) >> 6; active = active && (ct >= cw - 8) && (ct <= cw); }
            if (active) ATT_TILE(K_lds + cur * SHM_K, vb0 + cur * SHM_V);
            if (MODE == 0 && SB_EARLY_EXIT) {
                if (wave_rows && !wdone) { const bool rowdone = (carry < SB_DONE_LOG2) || (32 * wid + r32 >= it.nq); wdone = __all(rowdone); }
                if (lane == 0) flags[(j & 1) * 8 + wid] = wdone ? 1 : 0;
            }
            cur = (cur == NBUF - 1) ? 0 : cur + 1;
        }
        asm volatile("s_waitcnt vmcnt(0) lgkmcnt(0)\n\ts_barrier" ::: "memory");
#undef ATT_DMA
    } else {
    const int sr = tid >> 4, sc = (tid & 15) * 8;
    const int vst0 = v_st(sr, sc), vst1 = v_st(32 + sr, sc), kst0 = KSWZ(sr, sc * 2), kst1 = KSWZ(32 + sr, sc * 2);
    f32x4 sK0a, sK0b, sK1a, sK1b, sV0a, sV0b, sV1a, sV1b;
#define ATT_LD(p, A, B, kbp, kfp) do { const int p_ = (p); const bool isb_ = (p_ >= it.pb_lo && p_ < it.pb_hi), isf_ = (p_ >= it.pf_lo && p_ < it.pf_hi); \
        const GA char* a0_ = isf_ ? (const GA char*)(kfp + (size_t)(p_ - it.pf_lo) * it.ldf + sc) : (const GA char*)(kbp + (size_t)(isb_ ? p_ - it.pb_lo : 0) * it.ldb + sc); \
        const f32x4 la_ = *reinterpret_cast<const GA f32x4*>(a0_); const f32x4 lb_ = *reinterpret_cast<const GA f32x4*>(a0_ + (isf_ ? 16 : 0)); \
        A = la_; B = lb_; } while (0)
#define ATT_CV(p, A, B, OUT) do { const int p_ = (p); const bool isb_ = (p_ >= it.pb_lo && p_ < it.pb_hi), isf_ = (p_ >= it.pf_lo && p_ < it.pf_hi); \
        u32x4 w_ = {cvtpk(A[0], A[1]), cvtpk(A[2], A[3]), cvtpk(B[0], B[1]), cvtpk(B[2], B[3])}; const u32x4 r_ = __builtin_bit_cast(u32x4, A); \
        w_.x = isf_ ? w_.x : (isb_ ? r_.x : 0u); w_.y = isf_ ? w_.y : (isb_ ? r_.y : 0u); w_.z = isf_ ? w_.z : (isb_ ? r_.z : 0u); w_.w = isf_ ? w_.w : (isb_ ? r_.w : 0u); \
        OUT = *reinterpret_cast<bf16x8*>(&w_); } while (0)
#define ATT_SLOAD(kp0) do { ATT_LD((kp0) + sr, sK0a, sK0b, it.kb, it.kf); ATT_LD((kp0) + 32 + sr, sK1a, sK1b, it.kb, it.kf); \
        ATT_LD((kp0) + sr, sV0a, sV0b, it.vb, it.vf); ATT_LD((kp0) + 32 + sr, sV1a, sV1b, it.vb, it.vf); } while (0)
#define ATT_SWRITE(b, kp0) do { bf16x8 t_; \
        ATT_CV((kp0) + sr, sK0a, sK0b, t_); *reinterpret_cast<bf16x8*>(K_lds + (b) * SHM_K + kst0) = t_; \
        ATT_CV((kp0) + 32 + sr, sK1a, sK1b, t_); *reinterpret_cast<bf16x8*>(K_lds + (b) * SHM_K + kst1) = t_; \
        ATT_CV((kp0) + sr, sV0a, sV0b, t_); *reinterpret_cast<bf16x8*>(V_lds + (b) * SHM_V + vst0) = t_; \
        ATT_CV((kp0) + 32 + sr, sV1a, sV1b, t_); *reinterpret_cast<bf16x8*>(V_lds + (b) * SHM_V + vst1) = t_; } while (0)
    sK0b = sK1b = sV0b = sV1b = (f32x4){0.f, 0.f, 0.f, 0.f};
    ATT_SLOAD(it.kp_first); ATT_SWRITE(0, it.kp_first);
    __syncthreads();
    for (int j = 0; j < nt; ++j) {
        const int kp0 = it.kp_first + j * it.kp_step, kpn = kp0 + it.kp_step, cur = j & 1;
        const bool more = (j + 1 < nt);
        if (more) ATT_SLOAD(kpn);
        bool active = wave_rows;
        if (it.rule == 1) active = active && (kp0 <= it.qpos0 + 32 * wid + 30) && !wdone;
        if (it.rule == 2) { const int ct = kp0 >> 6, cw = (it.qpos0 + 32 * wid) >> 6; active = active && (ct >= cw - 8) && (ct <= cw); }
        if (active) ATT_TILE(K_lds + cur * SHM_K, vb0 + cur * SHM_V);
        if (MODE == 0 && SB_EARLY_EXIT) {
            if (wave_rows && !wdone) { const bool rowdone = (carry < SB_DONE_LOG2) || (32 * wid + r32 >= it.nq); wdone = __all(rowdone); }
            if (lane == 0) flags[cur * 8 + wid] = wdone ? 1 : 0;
        }
        if (more) ATT_SWRITE(cur ^ 1, kpn);
        __syncthreads();
        if (MODE == 0 && SB_EARLY_EXIT) {
            int alld = 1;
#pragma unroll
            for (int w = 0; w < 8; ++w) alld &= flags[cur * 8 + w];
            if (alld) break;
        }
    }
#undef ATT_LD
#undef ATT_CV
#undef ATT_SLOAD
#undef ATT_SWRITE
    }
    if (wave_rows) {
        const int nrow = it.nq - 32 * wid;
        const int prow = lane >> 4, piece = lane & 15;
        u32x4 gq[8];
#pragma unroll
        for (int j = 0; j < 8; ++j) { int rl = 4 * j + prow; rl = rl < nrow ? rl : nrow - 1;
            gq[j] = *reinterpret_cast<const GA u32x4*>(it.G + (size_t)(32 * wid + rl) * it.ldg + 8 * piece); }
        const float inv = (MODE == 1) ? __builtin_amdgcn_rcpf(l_reg) : 1.0f;
        char* const stg = lds + wid * 8704 + r32 * 272 + hi * 8;
#pragma unroll
        for (int d0 = 0; d0 < 4; ++d0)
#pragma unroll
            for (int g = 0; g < 4; ++g) { u32x2 w; w.x = cvtpk(o[d0][4 * g] * inv, o[d0][4 * g + 1] * inv); w.y = cvtpk(o[d0][4 * g + 2] * inv, o[d0][4 * g + 3] * inv);
                *reinterpret_cast<u32x2*>(stg + d0 * 64 + g * 16) = w; }
        asm volatile("s_waitcnt lgkmcnt(0)" ::: "memory");
        const char* const rd = lds + wid * 8704 + prow * 272 + piece * 16;
#pragma unroll
        for (int j = 0; j < 8; ++j) { const int rl = 4 * j + prow;
            const u32x4 ov = *reinterpret_cast<const u32x4*>(rd + j * 4 * 272); const u32x4 gg = gq[j]; u32x4 w;
#pragma unroll
            for (int e = 0; e < 4; ++e) w[e] = cvtpk(__uint_as_float(ov[e] << 16) * __uint_as_float(gg[e] << 16), __uint_as_float(ov[e] & 0xffff0000u) * __uint_as_float(gg[e] & 0xffff0000u));
            if (rl < nrow) *reinterpret_cast<GA u32x4*>(it.O + (size_t)(32 * wid + rl) * it.ldo + 8 * piece) = w; }
    }
    __syncthreads();
}
#undef ATT_TILE
#undef ATT_ITEM_LOADS
#undef GA
}

constexpr int NWAVES = 8;
constexpr int N_LAUNCHES = MK_N_LAUNCHES;
constexpr int PER_PHASE = 6;

constexpr size_t al256(size_t x) { return (x + 255) & ~(size_t)255; }
constexpr size_t WS_CTL = 0, CTL_ZERO_BYTES = 65536, CTL_BYTES = 1u << 20;
constexpr size_t WS_WCAT = CTL_BYTES;
constexpr size_t WS_WUP  = WS_WCAT + (size_t)NCAT * DM * 2;
constexpr size_t WS_WOUT = WS_WUP + (size_t)DM * DM * 2;
constexpr size_t WS_ACAT = WS_WOUT + (size_t)DM * DM * 2;
constexpr size_t SZ768 = (size_t)MIN_ * 768 * 2, SZ512 = (size_t)MIN_ * 512 * 2;
constexpr size_t WS_QSB = WS_ACAT + (size_t)MA * DM * 2, WS_KSB = WS_QSB + SZ768, WS_VSB = WS_KSB + SZ768, WS_GSB = WS_VSB + SZ768;
constexpr size_t WS_QBD = WS_GSB + SZ768, WS_KBD = WS_QBD + SZ768, WS_VBD = WS_KBD + SZ768, WS_GBD = WS_VBD + SZ768;
constexpr size_t WS_QMM = WS_GBD + SZ768, WS_GMM = WS_QMM + SZ512;
constexpr size_t WS_MG  = WS_GMM + SZ512;
constexpr size_t WS_MK  = WS_MG + (size_t)MIN_ * 6144 * 2, WS_MV = WS_MK + (size_t)512 * 512 * 2;
constexpr size_t WS_AUP = WS_MV + (size_t)512 * 512 * 2;
constexpr size_t WS_SSQ = WS_AUP + (size_t)MIN_ * DM * 2;
constexpr size_t WS_SSQS = WS_SSQ + (size_t)MIN_ * 32 * 4;
constexpr size_t WS_XBUF = WS_SSQS + (size_t)MS * 128 * 4;
constexpr size_t WS_YB = WS_XBUF + (size_t)MP * 8 * 4;
constexpr size_t WS_KBC = WS_YB, WS_VBC = WS_KBC + (size_t)DB * 576 * 768 * 2, WS_MKC = WS_VBC + (size_t)DB * 576 * 768 * 2, WS_MVC = WS_MKC + (size_t)DB * NMEM * 512 * 2;
static_assert(WS_MVC + (size_t)DB * NMEM * 512 * 2 <= WS_YB + (size_t)MP * DM * 2, "decode caches inside the YB region");
constexpr size_t WS_END = WS_YB + (size_t)MP * DM * 2;
static_assert(WS_WCAT % 256 == 0 && WS_QSB % 256 == 0 && WS_MG % 256 == 0 && WS_AUP % 256 == 0 && WS_SSQ % 256 == 0, "alignment");
constexpr int CW_TMO = 0, CW_WORK = 64, CW_BAR = 4096, CW_PANEL = 8192;
constexpr int OUT_ELEMS = 32112640;

constexpr int RING_BYTES = 131072, LDSCTL_OFF = RING_BYTES, MISC_OFF = LDSCTL_OFF + 320, STG_OFF = 147456, LDS_BYTES = 163840;
static_assert(att::ATT_LDS <= RING_BYTES, "attention scratch inside the ring region");

#define GAS __attribute__((address_space(1)))
#define LAS __attribute__((address_space(3)))
typedef unsigned short bf16;
typedef unsigned v4u __attribute__((ext_vector_type(4)));
typedef float f32x4 __attribute__((ext_vector_type(4)));
typedef GAS unsigned gu32;
#define RLX_AGENT __ATOMIC_RELAXED, __HIP_MEMORY_SCOPE_AGENT
#define LDS_WAIT() asm volatile("s_waitcnt lgkmcnt(0)" ::: "memory")
__device__ __forceinline__ unsigned pk2(float lo, float hi) { return pg8::cvt_pk_bf16(lo, hi); }

#define XB_TMO      128
#define XB_XCNT(j)  (256  + 64 * (j))
#define XB_XSUB(j)  (1280 + 64 * (j))
#define XB_XGEN(j)  (2304 + 64 * (j))
#define XB_TOP      3328
#define XB_TOPGEN   3392
#define XCD_BAR_WORDS 3456
#define XB_SPIN_CAP (1u << 18)
__device__ __forceinline__ unsigned xb_ld(unsigned* p)              { return __hip_atomic_load(p, __ATOMIC_RELAXED, __HIP_MEMORY_SCOPE_AGENT); }
__device__ __forceinline__ unsigned xb_add(unsigned* p, unsigned v) { return __hip_atomic_fetch_add(p, v, __ATOMIC_RELAXED, __HIP_MEMORY_SCOPE_AGENT); }
__device__ __forceinline__ unsigned xb_xcc_id() { return (unsigned)__builtin_amdgcn_s_getreg((3 << 11) | 20) & 0xFu; }
#define XB_SPIN(cond, bar) do { unsigned _sp = 0; while (cond) { __builtin_amdgcn_s_sleep(1); \
    if ((++_sp & 255u) == 0u) { if (xb_ld(&(bar)[XB_TMO])) break; if (_sp > XB_SPIN_CAP) { atomicAdd(&(bar)[XB_TMO], 1u); break; } } } } while (0)
struct XcdBarrier { unsigned* bar; unsigned x; volatile LAS unsigned* st; };
__device__ __forceinline__ XcdBarrier xcd_barrier_post(unsigned* bar, volatile LAS unsigned* st) {
    XcdBarrier b; b.bar = bar; b.x = xb_xcc_id(); b.st = st;
    if (threadIdx.x == 0) (void)xb_add(&bar[XB_XCNT(b.x)], 1u);
    return b;
}
__device__ __forceinline__ void xcd_barrier_complete(unsigned* bar, unsigned x, unsigned& nloc, unsigned& nx) {
    const unsigned G = gridDim.x * gridDim.y * gridDim.z;
    unsigned sum, cnt, mine, sp = 0u;
    for (;;) {
        sum = 0u; cnt = 0u; mine = 0u;
#pragma unroll
        for (unsigned j = 0; j < 16; ++j) { const unsigned c = xb_ld(&bar[XB_XCNT(j)]); sum += c; cnt += (c > 0u) ? 1u : 0u; mine = (j == x) ? c : mine; }
        if (sum == G) break;
        __builtin_amdgcn_s_sleep(1);
        if ((++sp & 255u) == 0u) { if (xb_ld(&bar[XB_TMO])) break; if (sp > XB_SPIN_CAP) { atomicAdd(&bar[XB_TMO], 1u); break; } }
    }
    nloc = mine > 0u ? mine : 1u; nx = cnt > 0u ? cnt : 1u;
}
__device__ __forceinline__ void xcd_barrier(const XcdBarrier& b) {
    asm volatile("s_waitcnt vmcnt(0)" ::: "memory");
    __syncthreads();
    if (threadIdx.x == 0) {
        unsigned* bar = b.bar;
        __builtin_amdgcn_s_waitcnt(0);
        unsigned nloc = b.st[0], nx = b.st[1];
        if (nloc == 0u) { xcd_barrier_complete(bar, b.x, nloc, nx); b.st[0] = nloc; b.st[1] = nx; }
        const unsigned old = xb_add(&bar[XB_XSUB(b.x)], 1u);
        const unsigned gen = old / nloc;
        if (old + 1u == (gen + 1u) * nloc) {
            __builtin_amdgcn_fence(__ATOMIC_RELEASE, "agent");
            asm volatile("s_waitcnt vmcnt(0)" ::: "memory");
            const unsigned og = xb_add(&bar[XB_TOP], 1u);
            const unsigned tg = og / nx;
            if (og + 1u == (tg + 1u) * nx) xb_add(&bar[XB_TOPGEN], 1u);
            else XB_SPIN(xb_ld(&bar[XB_TOPGEN]) == tg, bar);
            __builtin_amdgcn_fence(__ATOMIC_ACQUIRE, "agent");
            xb_add(&bar[XB_XGEN(b.x)], 1u);
            asm volatile("s_waitcnt vmcnt(0)" ::: "memory");
        } else {
            XB_SPIN(xb_ld(&bar[XB_XGEN(b.x)]) == gen, bar);
            __builtin_amdgcn_fence(__ATOMIC_ACQUIRE, "agent");
            asm volatile("s_waitcnt vmcnt(0)" ::: "memory");
        }
    }
    __syncthreads();
}

struct Frame {
    LAS unsigned char* lds;
    volatile LAS unsigned* MISC;
    gu32* ctl;
    int vcu, G;
    const float *x_prompt, *x_sample, *c_sbk, *c_sbv, *c_bdk, *c_bdv, *c_mk, *c_mv, *mem_prompt, *g_pre, *w_in, *rel_bias, *g_mem, *w_mem_kv, *w_up_sb, *w_up_band, *w_up_mem, *w_out, *g_post;
    float* out;
    bf16 *WCAT, *WUP, *WOUT, *ACAT, *QSB, *KSB, *VSB, *GSB, *QBD, *KBD, *VBD, *GBD, *QMM, *GMM, *MG, *MK, *MV, *AUP, *MERGED;
    float* SSQ; float* SSQS; bf16* YB; bf16 *KBC, *VBC, *MKC, *MVC;
};

__device__ __forceinline__ int fresh_tid() { int t = threadIdx.x; asm volatile("" : "+v"(t)); return t; }
__device__ __forceinline__ float wave_sum(float v) {
#pragma unroll
    for (int o = 1; o < 64; o <<= 1) v += __shfl_xor(v, o);
    return v;
}
__device__ __forceinline__ void p0_decode(int item, int nblk, int& kb, int& nb) { kb = item / nblk; nb = item % nblk; }
__device__ __forceinline__ void p0_transpose_item(const float* W, int N, int nkb, bf16* WT, int ldt, int row_off, int col_off, int item, int lane) {
    int kb, nb; p0_decode(item, N / 32, kb, nb); const int k0 = 64 * kb + 8 * (lane >> 3), n0 = 32 * nb + 4 * (lane & 7);
    f32x4 wv[8];
#pragma unroll
    for (int i = 0; i < 8; ++i) wv[i] = __builtin_nontemporal_load((const GAS f32x4*)(W + (size_t)(k0 + i) * N + n0));
#pragma unroll
    for (int e = 0; e < 4; ++e) { v4u o; o.x = pk2(wv[0][e], wv[1][e]); o.y = pk2(wv[2][e], wv[3][e]); o.z = pk2(wv[4][e], wv[5][e]); o.w = pk2(wv[6][e], wv[7][e]);
        *(GAS v4u*)(WT + (size_t)(row_off + n0 + e) * ldt + col_off + k0) = o; }
}
__device__ __forceinline__ void rms_row_to_bf16(const float* xrow, const float* g, bf16* orow, int lane) {
    const GAS f32x4* xr = (const GAS f32x4*)xrow + lane; const GAS f32x4* gr = (const GAS f32x4*)g + lane;
    f32x4 v[8]; float s = 0.f;
#pragma unroll
    for (int j = 0; j < 8; ++j) { v[j] = xr[64 * j]; s += (v[j].x * v[j].x + v[j].y * v[j].y) + (v[j].z * v[j].z + v[j].w * v[j].w); }
    const float r = 1.0f / sqrtf(wave_sum(s) * (1.0f / DM) + RMS_EPS);
    GAS unsigned long long* o8 = (GAS unsigned long long*)orow + lane;
#pragma unroll
    for (int j = 0; j < 8; ++j) { const f32x4 gv = gr[64 * j];
        o8[64 * j] = (unsigned long long)pk2(v[j].x * r * gv.x, v[j].y * r * gv.y) | ((unsigned long long)pk2(v[j].z * r * gv.z, v[j].w * r * gv.w) << 32); }
}
__device__ __forceinline__ void p0_t_load(const float* W, int N, int item, int lane, f32x4 (&wv)[8]) {
    int kb, nb; p0_decode(item, N / 32, kb, nb); const int k0 = 64 * kb + 8 * (lane >> 3), n0 = 32 * nb + 4 * (lane & 7);
#pragma unroll
    for (int i = 0; i < 8; ++i) wv[i] = __builtin_nontemporal_load((const GAS f32x4*)(W + (size_t)(k0 + i) * N + n0));
}
__device__ __forceinline__ int wcat_row(int c) {
    int kind, idx;
    if (c >= 7168) { const int d = c - 7168; kind = d >> 11; idx = d & 2047; }
    else { const int p = c >> 8;
        if (p < 9) return c;
        if (p < 12) { kind = 3; idx = c - 2304; }
        else if (p < 21) return c - 768;
        else if (p < 24) { kind = 3; idx = 768 + (c - 5376); }
        else if (p < 26) return c - 1536;
        else { kind = 3; idx = 1536 + (c - 6656); } }
    const int t = idx >> 6, q = idx & 63;
    return (20 + t) * 256 + 128 * (kind >> 1) + 4 * (kind & 1) + 32 * (q >> 4) + 8 * ((q >> 2) & 3) + (q & 3);
}
__device__ __forceinline__ float wcat_scale(int c) { const int p = c >> 8; return (p < 3 || (p >= 12 && p < 15) || p == 24 || p == 25) ? QSCALE : ((p >= 9 && p < 12) || p >= 21) ? -LOG2E : 1.0f; }
template <bool MAP>
__device__ __forceinline__ void p0_t_finish(const f32x4 (&wv)[8], int N, bf16* WT, int ldt, int row_off, int col_off, int item, int lane) {
    int kb, nb; p0_decode(item, N / 32, kb, nb); const int k0 = 64 * kb + 8 * (lane >> 3), n0 = 32 * nb + 4 * (lane & 7);
#pragma unroll
    for (int e = 0; e < 4; ++e) { const float sc = MAP ? wcat_scale(n0 + e) : 1.0f;
        v4u o; o.x = pk2(wv[0][e] * sc, wv[1][e] * sc); o.y = pk2(wv[2][e] * sc, wv[3][e] * sc); o.z = pk2(wv[4][e] * sc, wv[5][e] * sc); o.w = pk2(wv[6][e] * sc, wv[7][e] * sc);
        *(GAS v4u*)(WT + (size_t)(MAP ? wcat_row(n0 + e) : row_off + n0 + e) * ldt + col_off + k0) = o; }
}
__device__ __forceinline__ void rms_load(const float* xrow, int lane, f32x4 (&v)[8]) {
    const GAS f32x4* xr = (const GAS f32x4*)xrow + lane;
#pragma unroll
    for (int j = 0; j < 8; ++j) v[j] = __builtin_nontemporal_load(&xr[64 * j]);
}
__device__ __forceinline__ void rms_finish(const f32x4 (&v)[8], const f32x4 (&gv)[8], bf16* orow, int lane) {
    float s = 0.f;
#pragma unroll
    for (int j = 0; j < 8; ++j) s += (v[j].x * v[j].x + v[j].y * v[j].y) + (v[j].z * v[j].z + v[j].w * v[j].w);
    const float r = 1.0f / sqrtf(wave_sum(s) * (1.0f / DM) + RMS_EPS);
    GAS unsigned long long* o8 = (GAS unsigned long long*)orow + lane;
#pragma unroll
    for (int j = 0; j < 8; ++j) o8[64 * j] = (unsigned long long)pk2(v[j].x * r * gv[j].x, v[j].y * r * gv[j].y) | ((unsigned long long)pk2(v[j].z * r * gv[j].z, v[j].w * r * gv[j].w) << 32);
}
__device__ __forceinline__ void p0_prologue(Frame& F) {
    const int tid_ = fresh_tid(), lane_ = tid_ & 63, wave_ = __builtin_amdgcn_readfirstlane(tid_ >> 6);
    const int gw = F.vcu * NWAVES + wave_, NGW = F.G * NWAVES;
    constexpr int I_IN = 32 * (INW / 32), I_MEM = 32 * (1024 / 32), I_USB = 12 * 64, I_UBD = 12 * 64, I_UMM = 8 * 64, I_OUT = 32 * 64;
    constexpr int NI = I_IN + I_MEM;
#define P0_TLOAD(buf, it_) do { if ((it_) < I_IN) p0_t_load(F.w_in, INW, (it_), lane_, buf); else p0_t_load(F.w_mem_kv, 1024, (it_) - I_IN, lane_, buf); } while (0)
#define P0_TFIN(buf, it_) do { if ((it_) < I_IN) p0_t_finish<true>(buf, INW, F.WCAT, DM, 0, 0, (it_), lane_); else p0_t_finish<false>(buf, 1024, F.WCAT, DM, INW, 0, (it_) - I_IN, lane_); } while (0)
    { f32x4 wa[8], wb[8]; int it = gw;
      if (it < NI) P0_TLOAD(wa, it);
      while (it < NI) {
          int it2 = it + NGW; if (it2 < NI) P0_TLOAD(wb, it2);
          P0_TFIN(wa, it); it = it2; if (it >= NI) break;
          it2 = it + NGW; if (it2 < NI) P0_TLOAD(wa, it2);
          P0_TFIN(wb, it); it = it2; } }
#undef P0_TLOAD
#undef P0_TFIN
    if (!LATE_WT) for (int it = gw; it < I_USB + I_UBD + I_UMM + I_OUT; it += NGW) {
        int r = it;
        if (r < I_USB) { p0_transpose_item(F.w_up_sb, DM, 12, F.WUP, DM, 0, 0, r, lane_); continue; } r -= I_USB;
        if (r < I_UBD) { p0_transpose_item(F.w_up_band, DM, 12, F.WUP, DM, 0, 768, r, lane_); continue; } r -= I_UBD;
        if (r < I_UMM) { p0_transpose_item(F.w_up_mem, DM, 8, F.WUP, DM, 0, 1536, r, lane_); continue; } r -= I_UMM;
        p0_transpose_item(F.w_out, DM, 32, F.WOUT, DM, 0, 0, r, lane_);
    }
    { f32x4 gv[8], va[8], vb[8]; const GAS f32x4* gr = (const GAS f32x4*)F.g_pre + lane_;
#pragma unroll
      for (int j = 0; j < 8; ++j) gv[j] = gr[64 * j];
      int m = gw;
      if (m < MP) rms_load(F.x_prompt + (size_t)m * DM, lane_, va);
      while (m < MP) {
          int m2 = m + NGW; if (m2 < MP) rms_load(F.x_prompt + (size_t)m2 * DM, lane_, vb);
          rms_finish(va, gv, F.ACAT + (size_t)m * DM, lane_); m = m2; if (m >= MP) break;
          m2 = m + NGW; if (m2 < MP) rms_load(F.x_prompt + (size_t)m2 * DM, lane_, va);
          rms_finish(vb, gv, F.ACAT + (size_t)m * DM, lane_); m = m2; } }
    for (int m = MP + gw; m < MA; m += NGW) {
        bf16* orow = F.ACAT + (size_t)m * DM;
        if (m < MREAL) rms_row_to_bf16(F.x_sample + (size_t)(m - MP) * DM, F.g_pre, orow, lane_);
        else if (m < MIN_) {
            GAS v4u* o = (GAS v4u*)orow + lane_; GAS v4u* o2 = (GAS v4u*)(F.AUP + (size_t)m * DM) + lane_;
#pragma unroll
            for (int j = 0; j < 4; ++j) { o[64 * j] = (v4u){0u, 0u, 0u, 0u}; o2[64 * j] = (v4u){0u, 0u, 0u, 0u}; }
        }
        else rms_row_to_bf16(F.mem_prompt + (size_t)(m - MMEM0) * DM, F.g_mem, orow, lane_);
    }
}
constexpr int LATE_ITEMS = 128;
__device__ __forceinline__ void late_transpose_item(Frame& F, int j) {
    const int tid_ = fresh_tid(), lane_ = tid_ & 63, wave_ = __builtin_amdgcn_readfirstlane(tid_ >> 6);
    constexpr int I_USB = 12 * 64, I_UBD = 12 * 64, I_UMM = 8 * 64;
#pragma unroll 1
    for (int q = 0; q < 4; ++q) {
        int r = (j * 8 + wave_) * 4 + q;
        if (r < I_USB) { p0_transpose_item(F.w_up_sb, DM, 12, F.WUP, DM, 0, 0, r, lane_); continue; } r -= I_USB;
        if (r < I_UBD) { p0_transpose_item(F.w_up_band, DM, 12, F.WUP, DM, 0, 768, r, lane_); continue; } r -= I_UBD;
        if (r < I_UMM) { p0_transpose_item(F.w_up_mem, DM, 8, F.WUP, DM, 0, 1536, r, lane_); continue; } r -= I_UMM;
        p0_transpose_item(F.w_out, DM, 32, F.WOUT, DM, 0, 0, r, lane_);
    }
}
constexpr int CV_BD = DB * 576 * 768 / 32768, CV_MM = DB * NMEM * 512 / 32768, SLACK_ITEMS = LATE_ITEMS + 2 * CV_BD + 2 * CV_MM;
static_assert(DB * 576 * 768 % 32768 == 0 && DB * NMEM * 512 % 32768 == 0, "conversion item size");
template <bool BAND>
__device__ __forceinline__ void slack_convert(const float* src, bf16* dst, int jj, int tid_) {
    constexpr int ld = BAND ? 768 : 512, rows_d = BAND ? 576 : NMEM, rows_s = BAND ? 512 : NMEM;
    f32x4 va[8], vb[8];
#pragma unroll
    for (int it = 0; it < 8; ++it) { const int e = (jj * 4096 + it * 512 + tid_) * 8;
        const int col = e % ld, rowd = e / ld, b = rowd / rows_d, row = rowd % rows_d;
        const float* s = src + ((size_t)(b * rows_s + (row < rows_s ? row : 0)) * ld + col);
        va[it] = __builtin_nontemporal_load((const GAS f32x4*)s); vb[it] = __builtin_nontemporal_load((const GAS f32x4*)(s + 4)); }
#pragma unroll
    for (int it = 0; it < 8; ++it) { const int e = (jj * 4096 + it * 512 + tid_) * 8; const int row = (e / ld) % rows_d;
        v4u w; w.x = pk2(va[it].x, va[it].y); w.y = pk2(va[it].z, va[it].w); w.z = pk2(vb[it].x, vb[it].y); w.w = pk2(vb[it].z, vb[it].w);
        if (row >= rows_s + DS) w = (v4u){0u, 0u, 0u, 0u};
        if (row < rows_s || row >= rows_s + DS) *(GAS v4u*)(dst + e) = w; }
}
__device__ __forceinline__ void slack_item(Frame& F, int j) {
    if (j < LATE_ITEMS) { late_transpose_item(F, j); return; }
    j -= LATE_ITEMS;
    const int tid_ = fresh_tid();
    if (j < CV_BD) slack_convert<true>(F.c_bdk, F.KBC, j, tid_);
    else if (j < 2 * CV_BD) slack_convert<true>(F.c_bdv, F.VBC, j - CV_BD, tid_);
    else if (j < 2 * CV_BD + CV_MM) slack_convert<false>(F.c_mk, F.MKC, j - 2 * CV_BD, tid_);
    else slack_convert<false>(F.c_mv, F.MVC, j - 2 * CV_BD - CV_MM, tid_);
}
struct P5Row { float sq; unsigned long long yb[8]; f32x4 xv[8]; };
__device__ __forceinline__ void p5_load(Frame& F, int m, int lane, float& sq, unsigned long long (&yb)[8], f32x4 (&xv)[8]) {
    sq = (lane < 32) ? F.SSQ[(size_t)m * 32 + lane] : 0.f;
    const GAS unsigned long long* yb8 = (const GAS unsigned long long*)(F.YB + (size_t)m * DM) + lane; const GAS f32x4* x4 = (const GAS f32x4*)(F.x_prompt + (size_t)m * DM) + lane;
#pragma unroll
    for (int j = 0; j < 8; ++j) { yb[j] = __builtin_nontemporal_load(&yb8[64 * j]); xv[j] = __builtin_nontemporal_load(&x4[64 * j]); }
}
__device__ __forceinline__ void p5_finish(Frame& F, int m, int lane, float sq, const unsigned long long (&yb)[8], const f32x4 (&xv)[8], const f32x4 (&gv)[8]) {
    const float r = 1.0f / sqrtf(wave_sum(sq) * (1.0f / DM) + RMS_EPS);
    GAS f32x4* y4 = (GAS f32x4*)(F.out + (size_t)m * DM) + lane;
#pragma unroll
    for (int j = 0; j < 8; ++j) { const unsigned long long yq = yb[j];
        const f32x4 yv = {__uint_as_float((unsigned)yq << 16), __uint_as_float((unsigned)yq & 0xffff0000u), __uint_as_float((unsigned)(yq >> 32) << 16), __uint_as_float((unsigned)(yq >> 32) & 0xffff0000u)};
        __builtin_nontemporal_store(xv[j] + yv * r * gv[j], &y4[64 * j]); }
}
__device__ __forceinline__ void p5_final(Frame& F) {
    const int tid_ = fresh_tid(), lane_ = tid_ & 63, wave_ = __builtin_amdgcn_readfirstlane(tid_ >> 6);
    const int gw = F.vcu * NWAVES + wave_, NGW = F.G * NWAVES;
    f32x4 gv[8]; { const GAS f32x4* g4 = (const GAS f32x4*)F.g_post + lane_;
#pragma unroll
        for (int j = 0; j < 8; ++j) gv[j] = g4[64 * j]; }
    if (!FUSE_RMS) {
        float sa, sb; unsigned long long ya[8], yb[8]; f32x4 xa[8], xb[8]; int m = gw;
        if (m < MP) p5_load(F, m, lane_, sa, ya, xa);
        while (m < MP) {
            int m2 = m + NGW; if (m2 < MP) p5_load(F, m2, lane_, sb, yb, xb);
            p5_finish(F, m, lane_, sa, ya, xa, gv); m = m2; if (m >= MP) break;
            m2 = m + NGW; if (m2 < MP) p5_load(F, m2, lane_, sa, ya, xa);
            p5_finish(F, m, lane_, sb, yb, xb, gv); m = m2; }
    }
    for (int m = MP + gw; m < MREAL; m += NGW) {
        float s = F.SSQS[(size_t)(m - MP) * 128 + lane_] + F.SSQS[(size_t)(m - MP) * 128 + 64 + lane_];
        s = wave_sum(s);
        const float r = 1.0f / sqrtf(s * (1.0f / DM) + RMS_EPS);
        GAS f32x4* y4 = (GAS f32x4*)(F.out + (size_t)16777216 + (size_t)(m - MP) * DM) + lane_; const GAS f32x4* x4 = (const GAS f32x4*)(F.x_sample + (size_t)(m - MP) * DM) + lane_;
#pragma unroll
        for (int j = 0; j < 8; ++j) { const f32x4 yv = y4[64 * j], xv = x4[64 * j]; y4[64 * j] = xv + yv * r * gv[j]; }
    }
}

constexpr int IT_BDP = 192, IT_BDS = 48, IT_SBP = 192, IT_SBS = 48, IT_MMP = 128, IT_MMS = 32;
constexpr int IT_TOTAL = IT_BDP + IT_BDS + IT_SBP + IT_SBS + IT_MMP + IT_MMS;
struct ArgsK { const void* in[19]; float* out; unsigned char* ws; int ph_lo, ph_hi; };
struct ItemSrc {
    const ArgsK* ka; unsigned char* ws;
    __device__ __forceinline__ GAS bf16* W(size_t off) const { return (GAS bf16*)(ws + off); }
    __device__ __forceinline__ const GAS float* I(int k) const { return (const GAS float*)ka->in[k]; }
};
__device__ __forceinline__ att::Item make_item(const ItemSrc& S, int idx) {
    GAS bf16* const QSB = S.W(WS_QSB); GAS bf16* const KSB = S.W(WS_KSB); GAS bf16* const VSB = S.W(WS_VSB); GAS bf16* const GSB = S.W(WS_GSB);
    GAS bf16* const QBD = S.W(WS_QBD); GAS bf16* const KBD = S.W(WS_KBD); GAS bf16* const VBD = S.W(WS_VBD); GAS bf16* const GBD = S.W(WS_GBD);
    GAS bf16* const QMM = S.W(WS_QMM); GAS bf16* const GMM = S.W(WS_GMM); GAS bf16* const MK = S.W(WS_MK); GAS bf16* const MV = S.W(WS_MV); GAS bf16* const AUP = S.W(WS_AUP);
    att::Item it; it.dma = 0; it.bias = nullptr; it.kf = nullptr; it.vf = nullptr; it.ldf = 0; it.pf_lo = 0; it.pf_hi = 0; it.kb = nullptr; it.vb = nullptr; it.ldb = 0; it.pb_lo = 0; it.pb_hi = 0;
    if (idx < 48) idx += 192; else if (idx < 96) idx += 432 - 48; else if (idx < 128) idx += 608 - 96; else if (idx < 320) idx -= 128; else if (idx < 512) idx += 240 - 320; else idx += 480 - 512;
    if (idx < IT_BDP) {
        const int b = idx / 96, h = (idx / 16) % 6, cg = idx % 16; const size_t row0 = (size_t)b * SEQ + 256 * cg;
        it.mode = 1; it.rule = 2; it.Q = QBD + row0 * 768 + h * HD; it.ldq = 768; it.nq = 256; it.qpos0 = 256 * cg;
        it.kb = KBD + (size_t)b * SEQ * 768 + h * HD; it.vb = VBD + (size_t)b * SEQ * 768 + h * HD; it.ldb = 768; it.pb_lo = 0; it.pb_hi = SEQ;
        it.pv_lo = 0; it.pv_hi = SEQ; const int c_lo = (4 * cg - 8) > 0 ? (4 * cg - 8) : 0;
        it.kp_first = 64 * c_lo; it.kp_step = 64; it.ntiles = 4 * cg + 4 - c_lo; it.bias = S.I(11) + h * 513; it.dma = 1;
        it.O = AUP + row0 * DM + 768 + h * HD; it.ldo = DM; it.G = GBD + row0 * 768 + h * HD; it.ldg = 768; return it; }
    idx -= IT_BDP;
    if (idx < IT_BDS) {
        const int b = idx / 6, h = idx % 6; const size_t row0 = (size_t)MP + b * DS;
        it.mode = 1; it.rule = 0; it.Q = QBD + row0 * 768 + h * HD; it.ldq = 768; it.nq = DS; it.qpos0 = PAST;
        if (SLACK_P1) {
            it.kb = S.W(WS_KBC) + (size_t)b * 576 * 768 + h * HD; it.vb = S.W(WS_VBC) + (size_t)b * 576 * 768 + h * HD; it.ldb = 768; it.pb_lo = PAST - 512; it.pb_hi = PAST - 512 + 576; it.dma = 1;
        } else {
            it.kb = KBD + row0 * 768 + h * HD; it.vb = VBD + row0 * 768 + h * HD; it.ldb = 768; it.pb_lo = PAST; it.pb_hi = PAST + DS;
            it.kf = S.I(4) + (size_t)b * 512 * 768 + h * HD; it.vf = S.I(5) + (size_t)b * 512 * 768 + h * HD; it.ldf = 768; it.pf_lo = PAST - 512; it.pf_hi = PAST; }
        it.pv_lo = PAST - 512; it.pv_hi = PAST + DS; it.kp_first = PAST - 512; it.kp_step = 64; it.ntiles = 9; it.bias = S.I(11) + h * 513;
        it.O = AUP + row0 * DM + 768 + h * HD; it.ldo = DM; it.G = GBD + row0 * 768 + h * HD; it.ldg = 768; return it; }
    idx -= IT_BDS;
    if (idx < IT_SBP) {
        const int b = idx % 2, h = (idx / 2) % 6, qb = 15 - idx / 12; const size_t row0 = (size_t)b * SEQ + 256 * qb;
        it.mode = 0; it.rule = 1; it.Q = QSB + row0 * 768 + h * HD; it.ldq = 768; it.nq = 256; it.qpos0 = 256 * qb;
        it.kb = KSB + (size_t)b * SEQ * 768 + h * HD; it.vb = VSB + (size_t)b * SEQ * 768 + h * HD; it.ldb = 768; it.pb_lo = 0; it.pb_hi = SEQ;
        it.pv_lo = 0; it.pv_hi = SEQ; it.kp_first = 64 * (4 * qb + 3); it.kp_step = -64; it.ntiles = 4 * qb + 4; it.dma = 1;
        it.O = AUP + row0 * DM + h * HD; it.ldo = DM; it.G = GSB + row0 * 768 + h * HD; it.ldg = 768; return it; }
    idx -= IT_SBP;
    if (idx < IT_SBS) {
        const int b = idx / 6, h = idx % 6; const size_t row0 = (size_t)MP + b * DS;
        it.mode = 0; it.rule = 1; it.Q = QSB + row0 * 768 + h * HD; it.ldq = 768; it.nq = DS; it.qpos0 = PAST;
        it.kb = KSB + row0 * 768 + h * HD; it.vb = VSB + row0 * 768 + h * HD; it.ldb = 768; it.pb_lo = PAST; it.pb_hi = PAST + DS;
        it.kf = S.I(2) + (size_t)b * PAST * 768 + h * HD; it.vf = S.I(3) + (size_t)b * PAST * 768 + h * HD; it.ldf = 768; it.pf_lo = 0; it.pf_hi = PAST;
        it.pv_lo = 0; it.pv_hi = PAST + DS; it.kp_first = PAST + DS - 64; it.kp_step = -64; it.ntiles = (PAST + DS + 63) / 64;
        it.O = AUP + row0 * DM + h * HD; it.ldo = DM; it.G = GSB + row0 * 768 + h * HD; it.ldg = 768; return it; }
    idx -= IT_SBS;
    if (idx < IT_MMP) {
        const int b = idx / 64, h = (idx / 16) % 4, qb = idx % 16; const size_t row0 = (size_t)b * SEQ + 256 * qb;
        it.mode = 1; it.rule = 0; it.Q = QMM + row0 * 512 + h * HD; it.ldq = 512; it.nq = 256; it.qpos0 = 0;
        it.kb = MK + (size_t)b * NMEM * 512 + h * HD; it.vb = MV + (size_t)b * NMEM * 512 + h * HD; it.ldb = 512; it.pb_lo = 0; it.pb_hi = NMEM;
        it.pv_lo = 0; it.pv_hi = NMEM; it.kp_first = 0; it.kp_step = 64; it.ntiles = 4; it.dma = 1;
        it.O = AUP + row0 * DM + 1536 + h * HD; it.ldo = DM; it.G = GMM + row0 * 512 + h * HD; it.ldg = 512; return it; }
    idx -= IT_MMP;
    {
        const int b = idx / 4, h = idx % 4; const size_t row0 = (size_t)MP + b * DS;
        it.mode = 1; it.rule = 0; it.Q = QMM + row0 * 512 + h * HD; it.ldq = 512; it.nq = DS; it.qpos0 = 0;
        if (SLACK_P1) { it.kb = S.W(WS_MKC) + (size_t)b * NMEM * 512 + h * HD; it.vb = S.W(WS_MVC) + (size_t)b * NMEM * 512 + h * HD; it.ldb = 512; it.pb_lo = 0; it.pb_hi = NMEM; it.dma = 1; }
        else { it.kf = S.I(6) + (size_t)b * NMEM * 512 + h * HD; it.vf = S.I(7) + (size_t)b * NMEM * 512 + h * HD; it.ldf = 512; it.pf_lo = 0; it.pf_hi = NMEM; }
        it.pv_lo = 0; it.pv_hi = NMEM; it.kp_first = 0; it.kp_step = 64; it.ntiles = 4;
        it.O = AUP + row0 * DM + 1536 + h * HD; it.ldo = DM; it.G = GMM + row0 * 512 + h * HD; it.ldg = 512; return it; }
}

struct Args { const void* in[19]; float* out; unsigned char* ws; int ph_lo, ph_hi; };
__global__ void __launch_bounds__(NWAVES * 64, 2) fwd_megakernel(Args args) {
    extern __shared__ __attribute__((aligned(16))) unsigned char lds[];
    Frame F;
    F.lds = (LAS unsigned char*)lds;
    F.MISC = (volatile LAS unsigned*)(F.lds + MISC_OFF);
    F.G = gridDim.x; { const int bx = blockIdx.x; F.vcu = (F.G % 8 == 0) ? (bx % 8) * (F.G / 8) + bx / 8 : bx; }
    unsigned char* ws = args.ws;
    F.ctl = (gu32*)(ws + WS_CTL);
    F.x_prompt = (const float*)args.in[0]; F.x_sample = (const float*)args.in[1]; F.c_sbk = (const float*)args.in[2]; F.c_sbv = (const float*)args.in[3];
    F.c_bdk = (const float*)args.in[4]; F.c_bdv = (const float*)args.in[5]; F.c_mk = (const float*)args.in[6]; F.c_mv = (const float*)args.in[7];
    F.mem_prompt = (const float*)args.in[8]; F.g_pre = (const float*)args.in[9]; F.w_in = (const float*)args.in[10]; F.rel_bias = (const float*)args.in[11];
    F.g_mem = (const float*)args.in[12]; F.w_mem_kv = (const float*)args.in[13]; F.w_up_sb = (const float*)args.in[14]; F.w_up_band = (const float*)args.in[15];
    F.w_up_mem = (const float*)args.in[16]; F.w_out = (const float*)args.in[17]; F.g_post = (const float*)args.in[18];
    F.out = args.out;
    F.WCAT = (bf16*)(ws + WS_WCAT); F.WUP = (bf16*)(ws + WS_WUP); F.WOUT = (bf16*)(ws + WS_WOUT); F.ACAT = (bf16*)(ws + WS_ACAT); F.MERGED = (bf16*)(ws + WS_ACAT);
    F.QSB = (bf16*)(ws + WS_QSB); F.KSB = (bf16*)(ws + WS_KSB); F.VSB = (bf16*)(ws + WS_VSB); F.GSB = (bf16*)(ws + WS_GSB);
    F.QBD = (bf16*)(ws + WS_QBD); F.KBD = (bf16*)(ws + WS_KBD); F.VBD = (bf16*)(ws + WS_VBD); F.GBD = (bf16*)(ws + WS_GBD);
    F.QMM = (bf16*)(ws + WS_QMM); F.GMM = (bf16*)(ws + WS_GMM); F.MG = (bf16*)(ws + WS_MG); F.MK = (bf16*)(ws + WS_MK); F.MV = (bf16*)(ws + WS_MV);
    F.AUP = (bf16*)(ws + WS_AUP); F.SSQ = (float*)(ws + WS_SSQ); F.SSQS = (float*)(ws + WS_SSQS); F.YB = (bf16*)(ws + WS_YB); F.KBC = (bf16*)(ws + WS_KBC); F.VBC = (bf16*)(ws + WS_VBC); F.MKC = (bf16*)(ws + WS_MKC); F.MVC = (bf16*)(ws + WS_MVC);
    for (int u = threadIdx.x; u < (STG_OFF - LDSCTL_OFF) / 4; u += NWAVES * 64) ((LAS unsigned*)(F.lds + LDSCTL_OFF))[u] = 0u;
    __syncthreads();
    XcdBarrier bar; bar.bar = (unsigned*)(F.ctl + CW_BAR); bar.x = 0; bar.st = nullptr;
    if (N_LAUNCHES != PER_PHASE) bar = xcd_barrier_post((unsigned*)(F.ctl + CW_BAR), F.MISC + 8);
#define GRID_BAR() do { if (N_LAUNCHES != PER_PHASE) xcd_barrier(bar); } while (0)
    const int lo = args.ph_lo, hi = args.ph_hi;
#ifdef ONLY_PHASE
#define IN(k) ((k) == ONLY_PHASE && lo <= (k) && (k) < hi)
#else
#define IN(k) (lo <= (k) && (k) < hi)
#endif
#define BOTH(k) (IN(k) && IN((k) + 1))
#ifdef PROBE_PHASE
#define PROBE_T0(k) do { if ((k) == PROBE_PHASE && blockIdx.x == 0 && threadIdx.x == 0) { const unsigned long long t_ = __builtin_amdgcn_s_memrealtime(); F.MISC[20] = (unsigned)t_; F.MISC[21] = (unsigned)(t_ >> 32); } } while (0)
#define PROBE_T1(k) do { if ((k) == PROBE_PHASE) { if (blockIdx.x == 0 && threadIdx.x == 0) { const unsigned long long t1_ = __builtin_amdgcn_s_memrealtime(), t0_ = (unsigned long long)F.MISC[20] | ((unsigned long long)F.MISC[21] << 32); \
        const unsigned long long te_ = t1_ + (unsigned long long)(PROBE_K) * (t1_ - t0_); unsigned n_ = 0; while (__builtin_amdgcn_s_memrealtime() < te_ && ++n_ < (1u << 22)) __builtin_amdgcn_s_sleep(4); } \
        __syncthreads(); GRID_BAR(); } } while (0)
#else
#define PROBE_T0(k) do { } while (0)
#define PROBE_T1(k) do { } while (0)
#endif
    if (IN(0)) { PROBE_T0(0); p0_prologue(F); if (BOTH(0)) GRID_BAR(); PROBE_T1(0); }
    if (IN(1)) {
        PROBE_T0(1);
        pg8::Gemm g{F.ACAT, F.WCAT, MA, NCAT, DM}; ep::InOrder S; S.init(F.G, (int)blockIdx.x);
        ep::EpiIn E{F.QSB, F.KSB, F.VSB, F.GSB, F.QBD, F.KBD, F.VBD, F.GBD, F.QMM, F.GMM, F.MG, F.MK, F.MV, F.out, F.lds + STG_OFF, F.KBC, F.VBC};
        {
        pg8::gemm_phase<ep::EpiIn, ep::InOrder, true, true>(F.lds, g, S, E);
        if (SLACK_P1) {
            volatile LAS int* sl = (volatile LAS int*)(F.MISC + 12);
            for (;;) {
                if (threadIdx.x == 0) *sl = (int)__hip_atomic_fetch_add((unsigned*)(F.ctl + CW_WORK + 64), 1u, RLX_AGENT);
                __syncthreads();
                const int j = __builtin_amdgcn_readfirstlane(*sl);
                __syncthreads();
                if (j >= SLACK_ITEMS) break;
                slack_item(F, j);
            }
        }
        if (BOTH(1)) GRID_BAR(); }
        PROBE_T1(1);
    }
    if (IN(2)) {
        static_assert(SLACK_P1 || !LATE_WT, "the late transposes run in P1's slack");
        PROBE_T0(2);
        volatile LAS int* slot = (volatile LAS int*)(F.lds + att::OFF_ITEM);
        for (;;) {
            if (threadIdx.x == 0) *slot = (int)__hip_atomic_fetch_add((unsigned*)(F.ctl + CW_WORK), 1u, RLX_AGENT);
            __syncthreads();
            const int idx = __builtin_amdgcn_readfirstlane(*slot);
            __syncthreads();
#ifdef PROBE_P2_N
            if (idx >= IT_TOTAL + PROBE_P2_N) break;
            const int qidx = idx < PROBE_P2_N ? PROBE_P2_BASE + idx : idx - PROBE_P2_N;
#else
            if (idx >= IT_TOTAL) break;
            const int qidx = idx;
#endif
            const ArgsK* ka = (const ArgsK*)__builtin_amdgcn_kernarg_segment_ptr(); unsigned char* wsl = args.ws;
            asm volatile("" : "+s"(ka), "+s"(wsl));
            const ItemSrc isrc{ka, wsl};
            const att::Item it = make_item(isrc, qidx);
            if (it.dma) { if (it.mode == 0) att::run_item<0, true>(it, (char*)lds, F.lds); else att::run_item<1, true>(it, (char*)lds, F.lds); }
            else { if (it.mode == 0) att::run_item<0, false>(it, (char*)lds, F.lds); else att::run_item<1, false>(it, (char*)lds, F.lds); }
        }
        if (BOTH(2)) GRID_BAR();
        PROBE_T1(2);
    }
    if (IN(3)) {
        PROBE_T0(3);
        pg8::Gemm g{F.AUP, F.WUP, MIN_, DM, DM}; ep::MergeOrder S; S.init(F.G, (int)blockIdx.x);
        ep::EpiMerge E{F.MG, F.MERGED};
        const bool skf = (F.vcu & 1) != 0;
        int two = 2; asm volatile("" : "+s"(two));
#pragma unroll 1
        for (int pass = 0; pass < two; ++pass) {
            if (skf == (pass == 0)) for (int sl = F.vcu; sl < 256; sl += F.G) ep::skinny_phase<0>(F.AUP, F.WUP, F.MG, F.MERGED, nullptr, nullptr, sl, F.lds);
            if (pass == 0) pg8::gemm_phase<ep::EpiMerge, ep::MergeOrder, true, true>(F.lds, g, S, E);
        }
        if (BOTH(3)) GRID_BAR();
        PROBE_T1(3);
    }
    if (IN(4)) {
        PROBE_T0(4);
        pg8::Gemm g{F.MERGED, F.WOUT, MP, DM, DM}; pg8::StaticOrder S; S.init(MP, DM, F.G, (int)blockIdx.x);
#if FUSE_RMS
        ep::EpiOutFused E{F.x_prompt, F.out, F.g_post, (float*)(ws + WS_XBUF), (unsigned*)(F.ctl + CW_PANEL), (unsigned*)(F.ctl + CW_TMO)};
        {
        pg8::gemm_phase<ep::EpiOutFused, pg8::StaticOrder, false, true>(F.lds, g, S, E);
        for (int sl = F.vcu; sl < 256; sl += F.G) ep::skinny_phase<1>(F.MERGED, F.WOUT, nullptr, nullptr, F.out + 16777216, F.SSQS, sl, F.lds);
#else
        ep::EpiOut E{F.YB, F.SSQ};
        {
        const bool skf = (F.vcu & 1) != 0;
        int two = 2; asm volatile("" : "+s"(two));
#pragma unroll 1
        for (int pass = 0; pass < two; ++pass) {
            if (skf == (pass == 0)) for (int sl = F.vcu; sl < 256; sl += F.G) ep::skinny_phase<1>(F.MERGED, F.WOUT, nullptr, nullptr, F.out + 16777216, F.SSQS, sl, F.lds);
            if (pass == 0) pg8::gemm_phase<ep::EpiOut, pg8::StaticOrder, true, true>(F.lds, g, S, E);
        }
#endif
        if (BOTH(4)) GRID_BAR(); }
        PROBE_T1(4);
    }
    if (IN(5)) p5_final(F);
#undef IN
#undef BOTH
#undef GRID_BAR
#undef PROBE_T0
#undef PROBE_T1
}

extern "C" void kernel_launch(void* const* d_in, const int* in_sizes, int n_in, void* d_out, int out_size, void* d_ws, size_t ws_size, hipStream_t stream) {
    static int grid = 0;
    if (grid == 0) {
        if (n_in != 19 || in_sizes[0] != MP * DM || in_sizes[10] != DM * INW || out_size != OUT_ELEMS || ws_size < WS_END) {
            fprintf(stderr, "kernel_launch: built for 19 inputs, x_prompt %d, w_in %d, out %d floats, >= %zu bytes of workspace; got n_in %d, in0 %d, in10 %d, out %d, ws %zu; nothing launched\n",
                    MP * DM, DM * INW, OUT_ELEMS, (size_t)WS_END, n_in, n_in > 0 ? in_sizes[0] : -1, n_in > 10 ? in_sizes[10] : -1, out_size, ws_size);
            grid = -1; return; }
        int dev = 0, cus = 0, per_cu = 0;
        if (hipGetDevice(&dev) != hipSuccess || hipDeviceGetAttribute(&cus, hipDeviceAttributeMultiprocessorCount, dev) != hipSuccess) { fprintf(stderr, "kernel_launch: device query failed\n"); grid = -1; return; }
        if (hipFuncSetAttribute((const void*)fwd_megakernel, hipFuncAttributeMaxDynamicSharedMemorySize, LDS_BYTES) != hipSuccess) { fprintf(stderr, "kernel_launch: hipFuncSetAttribute(%d B LDS) failed\n", LDS_BYTES); grid = -1; return; }
        if (hipOccupancyMaxActiveBlocksPerMultiprocessor(&per_cu, (const void*)fwd_megakernel, NWAVES * 64, LDS_BYTES) != hipSuccess || per_cu < 1) {
            fprintf(stderr, "kernel_launch: occupancy query reports %d workgroups per CU; nothing launched\n", per_cu); (void)hipGetLastError(); grid = -1; return; }
        grid = cus;
    }
    if (grid < 0) return;
    if (hipMemsetAsync((char*)d_ws + WS_CTL, 0, CTL_ZERO_BYTES, stream) != hipSuccess) { fprintf(stderr, "kernel_launch: hipMemsetAsync failed\n"); return; }
    Args a{};
    for (int i = 0; i < 19; ++i) a.in[i] = d_in[i];
    a.out = (float*)d_out; a.ws = (unsigned char*)d_ws;
    if (N_LAUNCHES == 1) {
        a.ph_lo = 0; a.ph_hi = PER_PHASE;
        hipLaunchKernelGGL(fwd_megakernel, dim3(grid), dim3(NWAVES * 64), LDS_BYTES, stream, a);
    } else {
        for (int li = 0; li < PER_PHASE; ++li) { a.ph_lo = li; a.ph_hi = li + 1; hipLaunchKernelGGL(fwd_megakernel, dim3(grid), dim3(NWAVES * 64), LDS_BYTES, stream, a); }
    }
    const hipError_t le = hipPeekAtLastError();
    if (le != hipSuccess) fprintf(stderr, "kernel_launch: launch failed: %s (grid %d)\n", hipGetErrorName(le), grid);
}
```

```cpp
#include <hip/hip_runtime.h>
#include <hip/hip_bf16.h>
#include <cstdio>
#include <cstdint>

#ifndef MK_N_LAUNCHES
#define MK_N_LAUNCHES 1
#endif
#ifndef FUSE_RMS
#define FUSE_RMS 0
#endif
#ifndef LATE_WT
#define LATE_WT 1
#endif
#ifndef SLACK_P1
#define SLACK_P1 1
#endif
#ifndef SB_EARLY_EXIT
#define SB_EARLY_EXIT 1
#endif

constexpr int DM = 2048, SEQ = 4096, NB = 2, DB = 8, DS = 16, PAST = 4096, HD = 128;
constexpr int MP = NB * SEQ;
constexpr int MS = DB * DS;
constexpr int MIN_ = 8448;
constexpr int MREAL = MP + MS;
constexpr int MMEM0 = 8448;
constexpr int MA = 8960;
constexpr int INW = 13312, NCAT = 14336;
constexpr int NMEM = 256;
constexpr float RMS_EPS = 1e-6f;
constexpr float LOG2E = 1.4426950408889634f;
constexpr float QSCALE = 0.08838834764831845f * 1.4426950408889634f;

namespace pg8 {
#define PG8_LAS __attribute__((address_space(3)))
typedef unsigned short bf16_t;
typedef short bf16x8 __attribute__((ext_vector_type(8)));
typedef float f32x4 __attribute__((ext_vector_type(4)));
typedef unsigned u32x4 __attribute__((ext_vector_type(4)));
constexpr int BM = 256, BK = 64, HALF = 128, HTB = HALF * BK * 2  , STAGE_BYTES = 8 * HTB, NXCD = 8, WGM = 8;

__host__ __device__ __forceinline__ int lds_byte(int r, int c) { const int st = (r >> 4) * 2 + (c >> 5), rr = r & 15, cc = c & 31, ob = rr * 64 + cc * 2; return st * 1024 + (ob ^ (((ob >> 9) & 1) << 5)); }
__host__ __device__ __forceinline__ void stage_rc(int b, int& R, int& C) { const int st = b / 1024, sb = b % 1024, swz = sb ^ (((sb >> 9) & 1) << 5); R = (st >> 1) * 16 + swz / 64; C = (st & 1) * 32 + (swz % 64) / 2; }
__host__ __device__ __forceinline__ int perm32(int rho) { const int n = rho >> 4, i = rho & 15; return 8 * (i >> 2) + 4 * n + (i & 3); }

struct Unit { int pm, pn, k0, nt; };
struct Gemm { const bf16_t* A; const bf16_t* Bt; int M, N, K; };

struct StaticOrder {
    int nM, nN, nwg, G, c;
    __host__ __device__ void init(int M, int N, int G_, int c_) { nM = M / BM; nN = N / BM; nwg = nM * nN; G = G_; c = c_; }
    __host__ __device__ bool next(int i, Unit& u) const {
        const long L = (long)i * G + c; if (L >= nwg) return false;
        int wgid = (int)L; { const int q = nwg / NXCD, r = nwg % NXCD, xcd = wgid % NXCD, off = wgid / NXCD; wgid = (xcd < r ? xcd * (q + 1) : r * (q + 1) + (xcd - r) * q) + off; }
        const int nig = WGM * nN, gid = wgid / nig, fm = gid * WGM, gsz = (nM - fm) < WGM ? (nM - fm) : WGM;
        u.pm = fm + ((wgid % nig) % gsz); u.pn = (wgid % nig) / gsz; u.k0 = 0; u.nt = 0; return true;
    }
    __device__ __forceinline__ void a_ready(const Unit&) const {}
    __device__ __forceinline__ void done(const Unit&) const {}
};

typedef float f32x2_t __attribute__((ext_vector_type(2))); typedef __bf16 bf16x2_t __attribute__((ext_vector_type(2)));
__device__ __forceinline__ unsigned cvt_pk_bf16(float lo, float hi) { f32x2_t v = {lo, hi}; bf16x2_t b = __builtin_convertvector(v, bf16x2_t); return __builtin_bit_cast(unsigned, b); }

template <class Epi, class Sched, bool ALIGN_EPI = false, bool SP2 = false>
__device__ __forceinline__ void gemm_phase(PG8_LAS unsigned char* lds, const Gemm g, const Sched& S, const Epi& E) {
    int tid_ = threadIdx.x; asm volatile("" : "+v"(tid_));
    const int tid = tid_, wid = __builtin_amdgcn_readfirstlane(tid >> 6), lane = tid & 63, wr = wid >> 2, wc = wid & 3, fr = lane & 15, fq = lane >> 4;
    const int K = g.K, nt = K / BK;
    unsigned voffA[2], voffB[2];
#pragma unroll
    for (int i = 0; i < 2; ++i) { int R, C; stage_rc(tid * 16 + i * 8192, R, C); const int Rb = Epi::PERM ? ((R & ~31) + perm32(R & 31)) : R;
        voffA[i] = (unsigned)(R * K + C) * 2u; voffB[i] = (unsigned)(Rb * K + C) * 2u; }
    const size_t kstep = (size_t)(BK * 2);
    const size_t hstep = (size_t)HALF * K * 2;
    const size_t tstep = 2 * hstep;
    const unsigned ldsw = (unsigned)wid * 1024u;
    const int aoff = lds_byte(wr * 64 + fr, fq * 8), boff = lds_byte(wc * 32 + fr, fq * 8);
#define PG8_SA(b, h) (((b) * 2 + (h)) * HTB)
#define PG8_SB(b, h) ((4 + (b) * 2 + (h)) * HTB)
#define PG8_STAGE(bufoff, gbase, voff) do { _Pragma("unroll") for (int _i = 0; _i < 2; ++_i) \
        __builtin_amdgcn_global_load_lds((const unsigned*)((const char*)(gbase) + (voff)[_i]), (PG8_LAS unsigned*)(lds + (bufoff) + ldsw + _i * 8192), 16, 0, 0); } while (0)
#define PG8_LDA(dst, b, h) do { _Pragma("unroll") for (int m = 0; m < 4; ++m) _Pragma("unroll") for (int k = 0; k < 2; ++k) dst[m][k] = *(const PG8_LAS bf16x8*)(lds + PG8_SA(b, h) + aoff + m * 2048 + k * 1024); } while (0)
#define PG8_LDB(dst, b, h) do { _Pragma("unroll") for (int n = 0; n < 2; ++n) _Pragma("unroll") for (int k = 0; k < 2; ++k) dst[n][k] = *(const PG8_LAS bf16x8*)(lds + PG8_SB(b, h) + boff + n * 2048 + k * 1024); } while (0)
#define PG8_MMA(ai, bj, At, Bt) do { __builtin_amdgcn_s_setprio(1); _Pragma("unroll") for (int m = 0; m < 4; ++m) _Pragma("unroll") for (int n = 0; n < 2; ++n) _Pragma("unroll") for (int k = 0; k < 2; ++k) \
        acc[ai][bj][m][n] = __builtin_amdgcn_mfma_f32_16x16x32_bf16(Bt[n][k], At[m][k], acc[ai][bj][m][n], 0, 0, 0); __builtin_amdgcn_s_setprio(0); } while (0)
#define PG8_WAIT_V(n) asm volatile("s_waitcnt vmcnt(" #n ")" ::: "memory")
#define PG8_WAIT_L(n) asm volatile("s_waitcnt lgkmcnt(" #n ")" ::: "memory")
#define PG8_BAR __builtin_amdgcn_s_barrier()
#define PG8_SCHED __builtin_amdgcn_sched_barrier(0)
    Unit cur, nxt; int ui = 0;
    if (!S.next(0, cur)) return;
    f32x4 acc[2][2][4][2];
#pragma unroll
    for (int a = 0; a < 2; ++a)
#pragma unroll
        for (int b = 0; b < 2; ++b)
#pragma unroll
            for (int m = 0; m < 4; ++m)
#pragma unroll
                for (int n = 0; n < 2; ++n) acc[a][b][m][n] = (f32x4){0.f, 0.f, 0.f, 0.f};
    bf16x8 At[4][2], B0[2][2], B1[2][2];
    const char* cA = (const char*)g.A + (size_t)cur.pm * tstep + (size_t)cur.k0 * 2; const char* cB = (const char*)g.Bt + (size_t)cur.pn * tstep + (size_t)cur.k0 * 2;
    S.a_ready(cur);
    if constexpr (SP2) {
        PG8_STAGE(PG8_SB(0, 0), cB, voffB); PG8_STAGE(PG8_SB(0, 1), cB + hstep, voffB); PG8_STAGE(PG8_SA(0, 0), cA, voffA); PG8_STAGE(PG8_SA(0, 1), cA + hstep, voffA);
        if (wr == 1) PG8_BAR;
        PG8_WAIT_V(2); PG8_BAR;
        PG8_STAGE(PG8_SB(1, 0), cB + kstep, voffB); PG8_STAGE(PG8_SA(1, 0), cA + kstep, voffA); PG8_STAGE(PG8_SB(1, 1), cB + hstep + kstep, voffB);
        PG8_WAIT_V(6); PG8_BAR;
    } else {
        PG8_STAGE(PG8_SB(0, 0), cB, voffB); PG8_STAGE(PG8_SA(0, 0), cA, voffA); PG8_STAGE(PG8_SB(0, 1), cB + hstep, voffB); PG8_STAGE(PG8_SA(0, 1), cA + hstep, voffA);
        if (wr == 1) PG8_BAR;
        PG8_WAIT_V(4); PG8_BAR;
        PG8_STAGE(PG8_SB(1, 0), cB + kstep, voffB); PG8_STAGE(PG8_SA(1, 0), cA + kstep, voffA); PG8_STAGE(PG8_SB(1, 1), cB + hstep + kstep, voffB);
        PG8_WAIT_V(6); PG8_BAR;
    }
    for (;;) {
        const bool has_next = S.next(ui + 1, nxt);
        const char* nA = has_next ? (const char*)g.A + (size_t)nxt.pm * tstep + (size_t)nxt.k0 * 2 : cA; const char* nB = has_next ? (const char*)g.Bt + (size_t)nxt.pn * tstep + (size_t)nxt.k0 * 2 : cB;
        const int ntu = cur.nt ? cur.nt : nt;
        for (int t = 0; t < ntu; t += 2) {
            const bool last = (t == ntu - 2);
            const char* a1 = cA + (size_t)(t + 1) * kstep;
            const char* a2 = last ? nA : cA + (size_t)(t + 2) * kstep; const char* b2 = last ? nB : cB + (size_t)(t + 2) * kstep;
            const char* a3 = a2 + kstep; const char* b3 = b2 + kstep;
            if (last && has_next) S.a_ready(nxt);
            if constexpr (SP2) {
            PG8_LDB(B0, 0, 0); PG8_LDB(B1, 0, 1); PG8_SCHED; PG8_LDA(At, 0, 0); PG8_STAGE(PG8_SA(1, 1), a1 + hstep, voffA);
            PG8_WAIT_V(8); PG8_WAIT_L(0); PG8_BAR; PG8_MMA(0, 0, At, B0); PG8_MMA(0, 1, At, B1); PG8_BAR; PG8_SCHED;
            PG8_LDA(At, 0, 1); PG8_STAGE(PG8_SB(0, 0), b2, voffB); PG8_STAGE(PG8_SB(0, 1), b2 + hstep, voffB); PG8_STAGE(PG8_SA(0, 0), a2, voffA);
            PG8_WAIT_V(8); PG8_WAIT_L(0); PG8_BAR; PG8_MMA(1, 0, At, B0); PG8_MMA(1, 1, At, B1); PG8_BAR; PG8_SCHED;
            PG8_LDB(B0, 1, 0); PG8_LDB(B1, 1, 1); PG8_SCHED; PG8_LDA(At, 1, 0); PG8_STAGE(PG8_SA(0, 1), a2 + hstep, voffA);
            PG8_WAIT_V(8); PG8_WAIT_L(0); PG8_BAR; PG8_MMA(0, 0, At, B0); PG8_MMA(0, 1, At, B1); PG8_BAR; PG8_SCHED;
            PG8_LDA(At, 1, 1); PG8_STAGE(PG8_SB(1, 0), b3, voffB); PG8_STAGE(PG8_SB(1, 1), b3 + hstep, voffB); PG8_STAGE(PG8_SA(1, 0), a3, voffA);
            PG8_WAIT_V(8); PG8_WAIT_L(0); PG8_BAR; PG8_MMA(1, 0, At, B0); PG8_MMA(1, 1, At, B1); PG8_BAR; PG8_SCHED;
            } else {
            PG8_LDB(B0, 0, 0); PG8_SCHED; PG8_LDA(At, 0, 0); PG8_STAGE(PG8_SA(1, 1), a1 + hstep, voffA);
            PG8_WAIT_L(8); PG8_BAR; PG8_WAIT_L(0); PG8_MMA(0, 0, At, B0); PG8_BAR; PG8_SCHED;
            PG8_LDB(B1, 0, 1); PG8_STAGE(PG8_SB(0, 0), b2, voffB);
            PG8_BAR; PG8_WAIT_L(0); PG8_MMA(0, 1, At, B1); PG8_BAR;
            PG8_LDA(At, 0, 1); PG8_STAGE(PG8_SA(0, 0), a2, voffA);
            PG8_BAR; PG8_WAIT_L(0); PG8_MMA(1, 0, At, B0); PG8_BAR; PG8_SCHED;
            PG8_STAGE(PG8_SB(0, 1), b2 + hstep, voffB);
            PG8_WAIT_V(6); PG8_BAR; PG8_MMA(1, 1, At, B1); PG8_BAR;
            PG8_LDB(B0, 1, 0); PG8_SCHED; PG8_LDA(At, 1, 0); PG8_STAGE(PG8_SA(0, 1), a2 + hstep, voffA);
            PG8_WAIT_L(8); PG8_BAR; PG8_WAIT_L(0); PG8_MMA(0, 0, At, B0); PG8_BAR; PG8_SCHED;
            PG8_LDB(B1, 1, 1); PG8_STAGE(PG8_SB(1, 0), b3, voffB);
            PG8_BAR; PG8_WAIT_L(0); PG8_MMA(0, 1, At, B1); PG8_BAR;
            PG8_LDA(At, 1, 1); PG8_STAGE(PG8_SA(1, 0), a3, voffA);
            PG8_BAR; PG8_WAIT_L(0); PG8_MMA(1, 0, At, B0); PG8_BAR; PG8_SCHED;
            PG8_STAGE(PG8_SB(1, 1), b3 + hstep, voffB);
            PG8_WAIT_V(6); PG8_BAR; PG8_MMA(1, 1, At, B1); PG8_BAR;
            }
        }
        if constexpr (ALIGN_EPI) { if (wr == 0) PG8_BAR; }
        if constexpr (!Epi::AFTER_DRAIN) { E(acc, cur, wr, wc, fr, fq); S.done(cur); }
        if (!has_next) break;
        if (E.reset_after(cur))
#pragma unroll
        for (int a = 0; a < 2; ++a)
#pragma unroll
            for (int b = 0; b < 2; ++b)
#pragma unroll
                for (int m = 0; m < 4; ++m)
#pragma unroll
                    for (int n = 0; n < 2; ++n) acc[a][b][m][n] = (f32x4){0.f, 0.f, 0.f, 0.f};
        cur = nxt; cA = nA; cB = nB; ++ui;
        if constexpr (ALIGN_EPI) { if (wr == 1) PG8_BAR; }
    }
    PG8_WAIT_V(0);
    if constexpr (!ALIGN_EPI) { if (wr == 0) PG8_BAR; }
    PG8_BAR;
    if constexpr (Epi::AFTER_DRAIN) { E.fused(acc, cur, wr, wc, fr, fq, lds, wid, lane); S.done(cur); }
#undef PG8_SA
#undef PG8_SB
#undef PG8_STAGE
#undef PG8_LDA
#undef PG8_LDB
#undef PG8_MMA
#undef PG8_WAIT_V
#undef PG8_WAIT_L
#undef PG8_BAR
#undef PG8_SCHED
}
}

namespace ep {
using pg8::f32x4; using pg8::u32x4; using pg8::Unit; using pg8::bf16_t; using pg8::HALF; using pg8::BM; using pg8::cvt_pk_bf16;
typedef unsigned u32x2 __attribute__((ext_vector_type(2)));

struct InOrder {
    pg8::StaticOrder so; int G, c;
    __device__ void init(int G_, int c_) { so.init(MIN_, INW, G_, c_); G = G_; c = c_; }
    __device__ bool next(int i, Unit& u) const {
        const long L = (long)i * G + c;
        if (L < so.nwg) return so.next(i, u);
        const int j = (int)(L - so.nwg); if (j >= 8) return false;
        u.pm = 33 + (j & 1); u.pn = 52 + (j >> 1); u.k0 = 0; u.nt = 0; return true;
    }
    __device__ __forceinline__ void a_ready(const Unit&) const {}
    __device__ __forceinline__ void done(const Unit&) const {}
};

__device__ __forceinline__ size_t mg_off(int pm, int pn, int seg, int wave, int ai, int m, int bj, int lane) { return ((size_t)((pm * 8 + pn) * 3 + seg) << 16) + wave * 8192 + ((ai * 4 + m) * 2 + bj) * 512 + lane * 8; }
__device__ __forceinline__ float sigmoidf_fast(float x) { return __builtin_amdgcn_rcpf(1.0f + __builtin_amdgcn_exp2f(-x * LOG2E)); }
__device__ __forceinline__ float bf2f(unsigned short h) { return __uint_as_float((unsigned)h << 16); }

struct EpiIn {
    static constexpr bool PERM = true, AFTER_DRAIN = false;
    bf16_t *QSB, *KSB, *VSB, *GSB, *QBD, *KBD, *VBD, *GBD, *QMM, *GMM, *MG, *MK, *MV;
    float* out;
    __attribute__((address_space(3))) unsigned char* stg;
    bf16_t *KBC, *VBC;
    __device__ __forceinline__ bool reset_after(const Unit&) const { return true; }
    template <int ACT, int F32>
    __device__ __forceinline__ void store(const f32x4 (&acc)[2][2][4][2], bf16_t* dst, int ldc, int colt, int rowoff, int pm, float* f0, float* f1, int wr, int wc, int fr, int fq, bf16_t* bdc = nullptr) const {
        const int col0 = colt + wc * 32 + 8 * fq;
#pragma unroll
        for (int ai = 0; ai < 2; ++ai)
#pragma unroll
            for (int m = 0; m < 4; ++m) {
                const int r = pm * BM + ai * HALF + wr * 64 + m * 16 + fr;
                bf16_t* rowp = dst + (size_t)(r - rowoff) * ldc + col0;
                float* frow = nullptr;
                if (F32 == 1) { if (r < MP) frow = f0 + (size_t)r * 768; else if (r < MREAL) frow = f1 + (size_t)(r - MP) * 768; }
                if (F32 == 2) { if (r < MP) { const int t = r & (SEQ - 1); if (t >= SEQ - 512) frow = f0 + ((size_t)(r >> 12) * 512 + (t - (SEQ - 512))) * 768; } else if (r < MREAL) frow = f1 + (size_t)(r - MP) * 768; }
                if (F32 == 3) frow = f0 + (size_t)(r - MMEM0) * 512;
#pragma unroll
                for (int bj = 0; bj < 2; ++bj) {
                    f32x4 v0 = acc[ai][bj][m][0], v1 = acc[ai][bj][m][1];
                    if (F32 != 0) { if (frow) { __builtin_nontemporal_store(v0, (f32x4*)(frow + col0 + bj * HALF)); __builtin_nontemporal_store(v1, (f32x4*)(frow + col0 + bj * HALF + 4)); } }
                    if (ACT == 1) { v0 = v0 * QSCALE; v1 = v1 * QSCALE; }
                    if (ACT == 2) {
#pragma unroll
                        for (int e = 0; e < 4; ++e) { v0[e] = v0[e] * sigmoidf_fast(v0[e]); v1[e] = v1[e] * sigmoidf_fast(v1[e]); } }
                    if (ACT == 3) {
#pragma unroll
                        for (int e = 0; e < 4; ++e) { v0[e] = sigmoidf_fast(v0[e]); v1[e] = sigmoidf_fast(v1[e]); } }
                    u32x4 w; w.x = cvt_pk_bf16(v0[0], v0[1]); w.y = cvt_pk_bf16(v0[2], v0[3]); w.z = cvt_pk_bf16(v1[0], v1[1]); w.w = cvt_pk_bf16(v1[2], v1[3]);
                    *(u32x4*)(rowp + bj * HALF) = w;
                    if (F32 == 2 && SLACK_P1) { if (r >= MP && r < MREAL) *(u32x4*)(bdc + ((size_t)((r - MP) >> 4) * 576 + 512 + ((r - MP) & 15)) * 768 + col0 + bj * HALF) = w; } }
            }
    }
    __device__ __forceinline__ void store_gates(const f32x4 (&acc)[2][2][4][2], int t, int pm, int wr, int wc, int fr, int fq) const {
        typedef float f32x2 __attribute__((ext_vector_type(2)));
        typedef __attribute__((address_space(3))) u32x2 lu32x2; typedef __attribute__((address_space(3))) u32x4 lu32x4;
        const int sld = (t < 24) ? 768 : 512;
        bf16_t* const sdst = (t < 12) ? GSB + 64 * t : (t < 24 ? GBD + 64 * (t - 12) : GMM + 64 * (t - 24));
        constexpr float CAP = 1073741824.0f, NLN2 = -0.6931471805599453f;
        const int row32 = wr * 16 + fr;
        const int woff = row32 * 128 + ((wc ^ ((row32 >> 1) & 3)) << 5) + fq * 8;
        const int tid = threadIdx.x, kq = tid >> 8;
        const int mfr = tid & 15, mpart = (tid >> 4) & 7, mwr = (tid >> 7) & 1, mrow = mwr * 16 + mfr;
        const int moff = mrow * 128 + ((((mpart >> 1) ^ ((mrow >> 1) & 3)) << 5) | ((mpart & 1) << 4));
        const int mpn = t >> 2, mbj = (t & 3) >> 1, mwave = mwr * 4 + (t & 1) * 2 + (mpart >> 2), mlane = (mpart & 3) * 16 + mfr;
        const int rrow = (tid & 255) >> 3, part = tid & 7;
        const int roff = 12288 + rrow * 128 + ((((part >> 1) ^ ((rrow >> 1) & 3)) << 5) | ((part & 1) << 4));
        const int grow = pm * BM + (rrow >> 4) * 64 + (rrow & 15);
#pragma unroll
        for (int ai = 0; ai < 2; ++ai)
#pragma unroll
            for (int m = 0; m < 4; ++m) {
                u32x2 w1, w2, w3, ws;
#pragma unroll
                for (int h = 0; h < 2; ++h) {
                    const f32x2 x1 = {acc[ai][0][m][0][2 * h], acc[ai][0][m][0][2 * h + 1]}, x2 = {acc[ai][0][m][1][2 * h], acc[ai][0][m][1][2 * h + 1]};
                    const f32x2 x3 = {acc[ai][1][m][0][2 * h], acc[ai][1][m][0][2 * h + 1]}, xs = {acc[ai][1][m][1][2 * h], acc[ai][1][m][1][2 * h + 1]};
                    const f32x2 one = {1.0f, 1.0f};
                    const f32x2 d1 = (f32x2){fminf(__builtin_amdgcn_exp2f(x1.x), CAP), fminf(__builtin_amdgcn_exp2f(x1.y), CAP)} + one, d2 = (f32x2){fminf(__builtin_amdgcn_exp2f(x2.x), CAP), fminf(__builtin_amdgcn_exp2f(x2.y), CAP)} + one;
                    const f32x2 d3 = (f32x2){fminf(__builtin_amdgcn_exp2f(x3.x), CAP), fminf(__builtin_amdgcn_exp2f(x3.y), CAP)} + one, ds = (f32x2){fminf(__builtin_amdgcn_exp2f(xs.x), CAP), fminf(__builtin_amdgcn_exp2f(xs.y), CAP)} + one;
                    const f32x2 p12 = d1 * d2, p3s = d3 * ds, q = p12 * p3s;
                    const f32x2 rq = {__builtin_amdgcn_rcpf(q.x), __builtin_amdgcn_rcpf(q.y)};
                    const f32x2 i12 = rq * p3s, i3s = rq * p12;
                    const f32x2 g3 = i3s * ds, sg = (xs * NLN2) * (i3s * d3);
                    const f32x2 r1 = (d2 * d2) * i12, r2 = (d3 * d1) * i12;
                    w1[h] = cvt_pk_bf16(r1.x, r1.y); w2[h] = cvt_pk_bf16(r2.x, r2.y); w3[h] = cvt_pk_bf16(g3.x, g3.y); ws[h] = cvt_pk_bf16(sg.x, sg.y);
                }
                if (ai + m > 0) { asm volatile("s_waitcnt lgkmcnt(0)" ::: "memory"); __builtin_amdgcn_s_barrier(); }
                *(lu32x2*)(stg + woff) = w1; *(lu32x2*)(stg + 4096 + woff) = w2; *(lu32x2*)(stg + 8192 + woff) = w3; *(lu32x2*)(stg + 12288 + woff) = ws;
                asm volatile("s_waitcnt lgkmcnt(0)" ::: "memory"); __builtin_amdgcn_s_barrier(); asm volatile("" ::: "memory");
                const u32x4 va = *(const lu32x4*)(stg + kq * 4096 + moff), vb = *(const lu32x4*)(stg + (kq == 0 ? 8192 + moff : roff));
                *(u32x4*)(MG + mg_off(pm, mpn, kq, mwave, ai, m, mbj, mlane)) = va;
                if (kq == 0) *(u32x4*)(MG + mg_off(pm, mpn, 2, mwave, ai, m, mbj, mlane)) = vb;
                else *(u32x4*)(sdst + (size_t)(grow + ai * HALF + m * 16) * sld + part * 8) = vb;
            }
        asm volatile("s_waitcnt lgkmcnt(0)" ::: "memory");
    }
    __device__ __forceinline__ void operator()(const f32x4 (&acc)[2][2][4][2], const Unit& u, int wr, int wc, int fr, int fq) const {
        const int pn = u.pn, pm = u.pm;
        float* const o_sbk = out + 17039360, * const o_sbv = out + 23330816, * const o_bdk = out + 29622272, * const o_bdv = out + 30408704;
        float* const o_mk = out + 31195136, * const o_mv = out + 31457280;
        float* const s_sbk = out + 31719424, * const s_sbv = out + 31817728, * const s_bdk = out + 31916032, * const s_bdv = out + 32014336;
        if (pn < 3)        store<0, 0>(acc, QSB, 768, 256 * pn, 0, pm, nullptr, nullptr, wr, wc, fr, fq);
        else if (pn < 6)   store<0, 1>(acc, KSB, 768, 256 * (pn - 3), 0, pm, o_sbk, s_sbk, wr, wc, fr, fq);
        else if (pn < 9)   store<0, 1>(acc, VSB, 768, 256 * (pn - 6), 0, pm, o_sbv, s_sbv, wr, wc, fr, fq);
        else if (pn < 12)  store<0, 0>(acc, QBD, 768, 256 * (pn - 9), 0, pm, nullptr, nullptr, wr, wc, fr, fq);
        else if (pn < 15)  store<0, 2>(acc, KBD, 768, 256 * (pn - 12), 0, pm, o_bdk, s_bdk, wr, wc, fr, fq, KBC);
        else if (pn < 18)  store<0, 2>(acc, VBD, 768, 256 * (pn - 15), 0, pm, o_bdv, s_bdv, wr, wc, fr, fq, VBC);
        else if (pn < 20)  store<0, 0>(acc, QMM, 512, 256 * (pn - 18), 0, pm, nullptr, nullptr, wr, wc, fr, fq);
        else if (pn < 52)  store_gates(acc, pn - 20, pm, wr, wc, fr, fq);
        else if (pn < 54)  store<0, 3>(acc, MK, 512, 256 * (pn - 52), MMEM0, pm, o_mk, nullptr, wr, wc, fr, fq);
        else               store<0, 3>(acc, MV, 512, 256 * (pn - 54), MMEM0, pm, o_mv, nullptr, wr, wc, fr, fq);
    }
};

struct MergeOrder {
    pg8::StaticOrder so;
    __device__ void init(int G_, int c_) { so.init(MP, DM, G_, c_); }
    __device__ bool next(int i, Unit& u) const {
        const int ti = i / 3, seg = i - 3 * ti;
        if (!so.next(ti, u)) return false;
        u.k0 = 768 * seg; u.nt = (seg == 2) ? 8 : 12; return true;
    }
    __device__ __forceinline__ void a_ready(const Unit&) const {}
    __device__ __forceinline__ void done(const Unit&) const {}
};
struct EpiMerge {
    static constexpr bool PERM = true, AFTER_DRAIN = false;
    const bf16_t* MG; bf16_t* OUT;
    __device__ __forceinline__ bool reset_after(const Unit& u) const { return u.k0 == 1536; }
    __device__ __forceinline__ void operator()(f32x4 (&acc)[2][2][4][2], const Unit& u, int wr, int wc, int fr, int fq) const {
        const int col0 = u.pn * BM + wc * 32 + 8 * fq;
        const int seg = (u.k0 == 0) ? 0 : (u.k0 == 768 ? 1 : 2);
        const bool last = (seg == 2);
        u32x4 g[2][4][2];
#pragma unroll
        for (int ai = 0; ai < 2; ++ai)
#pragma unroll
            for (int m = 0; m < 4; ++m)
#pragma unroll
                for (int bj = 0; bj < 2; ++bj) g[ai][m][bj] = __builtin_nontemporal_load((const u32x4*)(MG + mg_off(u.pm, u.pn, seg, wr * 4 + wc, ai, m, bj, fq * 16 + fr)));
#pragma unroll
        for (int ai = 0; ai < 2; ++ai)
#pragma unroll
            for (int m = 0; m < 4; ++m) { bf16_t* rowp = OUT + (size_t)(u.pm * BM + ai * HALF + wr * 64 + m * 16 + fr) * DM + col0;
#pragma unroll
                for (int bj = 0; bj < 2; ++bj) {
#pragma unroll
                    for (int e = 0; e < 4; ++e) { acc[ai][bj][m][e >> 1][2 * (e & 1)] *= __uint_as_float(g[ai][m][bj][e] << 16); acc[ai][bj][m][e >> 1][2 * (e & 1) + 1] *= __uint_as_float(g[ai][m][bj][e] & 0xffff0000u); }
                    if (last) { u32x4 w; w.x = cvt_pk_bf16(acc[ai][bj][m][0][0], acc[ai][bj][m][0][1]); w.y = cvt_pk_bf16(acc[ai][bj][m][0][2], acc[ai][bj][m][0][3]);
                        w.z = cvt_pk_bf16(acc[ai][bj][m][1][0], acc[ai][bj][m][1][1]); w.w = cvt_pk_bf16(acc[ai][bj][m][1][2], acc[ai][bj][m][1][3]);
                        *(u32x4*)(rowp + bj * HALF) = w; } } }
    }
};

struct EpiOut {
    static constexpr bool PERM = true, AFTER_DRAIN = false;
    bf16_t* yb; float* ssq;
    __device__ __forceinline__ bool reset_after(const Unit&) const { return true; }
    __device__ __forceinline__ void operator()(const f32x4 (&acc)[2][2][4][2], const Unit& u, int wr, int wc, int fr, int fq) const {
        const int col0 = u.pn * BM + wc * 32 + 8 * fq;
#pragma unroll
        for (int ai = 0; ai < 2; ++ai)
#pragma unroll
            for (int m = 0; m < 4; ++m) {
                const int r = u.pm * BM + ai * HALF + wr * 64 + m * 16 + fr;
                bf16_t* yrow = yb + (size_t)r * DM + col0;
                float s = 0.f;
#pragma unroll
                for (int bj = 0; bj < 2; ++bj) { const f32x4 v0 = acc[ai][bj][m][0], v1 = acc[ai][bj][m][1];
                    s += ((v0[0] * v0[0] + v0[1] * v0[1]) + (v0[2] * v0[2] + v0[3] * v0[3])) + ((v1[0] * v1[0] + v1[1] * v1[1]) + (v1[2] * v1[2] + v1[3] * v1[3]));
                    u32x4 w; w.x = cvt_pk_bf16(v0[0], v0[1]); w.y = cvt_pk_bf16(v0[2], v0[3]); w.z = cvt_pk_bf16(v1[0], v1[1]); w.w = cvt_pk_bf16(v1[2], v1[3]);
                    *(u32x4*)(yrow + bj * HALF) = w; }
                s += __shfl_xor(s, 16); s += __shfl_xor(s, 32);
                if (fq == 0) ssq[(size_t)r * 32 + u.pn * 4 + wc] = s;
            }
    }
};

struct EpiOutFused {
    static constexpr bool PERM = false, AFTER_DRAIN = true;
    const float* x; float* out; const float* gpost; float* xbuf; unsigned* cnt; unsigned* tmo;
    __device__ __forceinline__ bool reset_after(const Unit&) const { return true; }
    __device__ __forceinline__ void operator()(const f32x4 (&)[2][2][4][2], const Unit&, int, int, int, int) const {}
    __device__ __forceinline__ void fused(f32x4 (&acc)[2][2][4][2], const Unit& u, int wr, int wc, int fr, int fq, __attribute__((address_space(3))) unsigned char* lds, int wid, int lane) const {
        typedef __attribute__((address_space(3))) float lfloat;
        lfloat* P = (lfloat*)lds;
        lfloat* S = (lfloat*)(lds + 4096);
        __attribute__((address_space(3))) unsigned* flag = (__attribute__((address_space(3))) unsigned*)(lds + 4096 + 1024);
        const int col0 = u.pn * BM + wc * 32 + 4 * fq;
        f32x4 pre[4][2][2];
#pragma unroll
        for (int m = 0; m < 4; ++m) { const size_t off = (size_t)(u.pm * BM + wr * 64 + m * 16 + fr) * DM + col0;
#pragma unroll
            for (int bj = 0; bj < 2; ++bj)
#pragma unroll
                for (int n = 0; n < 2; ++n) pre[m][bj][n] = *(const f32x4*)(x + off + bj * HALF + n * 16); }
#pragma unroll
        for (int ai = 0; ai < 2; ++ai)
#pragma unroll
            for (int m = 0; m < 4; ++m) { float s = 0.f;
#pragma unroll
                for (int bj = 0; bj < 2; ++bj)
#pragma unroll
                    for (int n = 0; n < 2; ++n) { const f32x4 v = acc[ai][bj][m][n]; s += (v[0] * v[0] + v[1] * v[1]) + (v[2] * v[2] + v[3] * v[3]); }
                s += __shfl_xor(s, 16); s += __shfl_xor(s, 32);
                if (fq == 0) P[(ai * HALF + wr * 64 + m * 16 + fr) * 4 + wc] = s; }
        asm volatile("s_waitcnt lgkmcnt(0)" ::: "memory"); __builtin_amdgcn_s_barrier(); asm volatile("" ::: "memory");
        const int row = wid * 32 + (lane & 31);
        if (lane < 32) { const float t = (P[row * 4 + 0] + P[row * 4 + 1]) + (P[row * 4 + 2] + P[row * 4 + 3]);
            __hip_atomic_store(xbuf + ((size_t)(u.pm * BM + row) * 8 + u.pn), t, __ATOMIC_RELAXED, __HIP_MEMORY_SCOPE_AGENT); }
        asm volatile("s_waitcnt vmcnt(0)" ::: "memory");
        if (lane == 0) __hip_atomic_fetch_add(cnt + 64 * u.pm, 1u, __ATOMIC_RELAXED, __HIP_MEMORY_SCOPE_AGENT);
        if (wid == 0) { bool dead = false; const unsigned long long t0 = __builtin_amdgcn_s_memrealtime();
            for (;;) {
                if ((unsigned)__builtin_amdgcn_readfirstlane(__hip_atomic_load(cnt + 64 * u.pm, __ATOMIC_RELAXED, __HIP_MEMORY_SCOPE_AGENT)) >= 64u) break;
                if (__builtin_amdgcn_s_memrealtime() - t0 > 2000000ull) { if (lane == 0) __hip_atomic_store(tmo, 1u, __ATOMIC_RELAXED, __HIP_MEMORY_SCOPE_AGENT); dead = true; break; }
                __builtin_amdgcn_s_sleep(2); }
            __builtin_amdgcn_fence(__ATOMIC_ACQUIRE, "agent");
            if (lane == 0) flag[0] = dead ? 1u : 0u; }
        asm volatile("s_waitcnt vmcnt(0) lgkmcnt(0)" ::: "memory"); __builtin_amdgcn_s_barrier(); asm volatile("" ::: "memory");
        const bool bad = flag[0] != 0u;
        if (lane < 32) { const float* slot = xbuf + (size_t)(u.pm * BM + row) * 8; float q = 0.f;
#pragma unroll
            for (int t = 0; t < 8; ++t) q += __hip_atomic_load(slot + t, __ATOMIC_RELAXED, __HIP_MEMORY_SCOPE_AGENT);
            S[row] = 1.0f / sqrtf(q * (1.0f / DM) + RMS_EPS); }
        asm volatile("s_waitcnt lgkmcnt(0)" ::: "memory"); __builtin_amdgcn_s_barrier(); asm volatile("" ::: "memory");
        f32x4 gv[2][2];
#pragma unroll
        for (int bj = 0; bj < 2; ++bj)
#pragma unroll
            for (int n = 0; n < 2; ++n) gv[bj][n] = *(const f32x4*)(gpost + col0 + bj * HALF + n * 16);
        const float qnan = __builtin_nanf("");
#pragma unroll
        for (int ai = 0; ai < 2; ++ai)
#pragma unroll
            for (int m = 0; m < 4; ++m) { const int r = ai * HALF + wr * 64 + m * 16 + fr; const float rs = S[r]; const size_t off = (size_t)(u.pm * BM + r) * DM + col0;
#pragma unroll
                for (int bj = 0; bj < 2; ++bj)
#pragma unroll
                    for (int n = 0; n < 2; ++n) { const f32x4 bs = ai == 0 ? pre[m][bj][n] : *(const f32x4*)(x + off + bj * HALF + n * 16);
                        f32x4 o = bs + acc[ai][bj][m][n] * rs * gv[bj][n];
                        if (bad) o = (f32x4){qnan, qnan, qnan, qnan};
                        *(f32x4*)(out + off + bj * HALF + n * 16) = o; }
                if (m & 1) asm volatile("" ::: "memory"); }
    }
};

template <int MODE>
__device__ __forceinline__ void skinny_phase(const bf16_t* A, const bf16_t* Bt, const bf16_t* MG, bf16_t* OUTB, float* OUTF, float* SSQS, int slice, __attribute__((address_space(3))) unsigned char* ldsl) {
    typedef short bf16x8 __attribute__((ext_vector_type(8)));
    int tid_ = threadIdx.x; asm volatile("" : "+v"(tid_));
    const int tid = tid_, lane = tid & 63, fr = lane & 15, fq = lane >> 4;
    const int w = __builtin_amdgcn_readfirstlane(tid >> 6);
    const int cb = slice >> 1, rh = slice & 1;
    const int row0 = MP + 64 * rh + fr;
    const bf16_t* ap = A + (size_t)row0 * DM + 256 * w + 8 * fq;
    const bf16_t* bp = Bt + (size_t)(16 * cb + fr) * DM + 256 * w + 8 * fq;
    bf16x8 bf[8], af[4][8];
#pragma unroll
    for (int j = 0; j < 8; ++j) bf[j] = *(const bf16x8*)(bp + 32 * j);
#pragma unroll
    for (int rb = 0; rb < 4; ++rb)
#pragma unroll
        for (int j = 0; j < 8; ++j) af[rb][j] = *(const bf16x8*)(ap + (size_t)rb * 16 * DM + 32 * j);
    f32x4 acc[4];
#pragma unroll
    for (int rb = 0; rb < 4; ++rb) { acc[rb] = (f32x4){0.f, 0.f, 0.f, 0.f};
#pragma unroll
        for (int j = 0; j < 8; ++j) acc[rb] = __builtin_amdgcn_mfma_f32_16x16x32_bf16(bf[j], af[rb][j], acc[rb], 0, 0, 0); }
    if (MODE == 0) { const int s = (w < 3) ? 0 : (w < 6 ? 1 : 2);
#pragma unroll
        for (int rb = 0; rb < 4; ++rb) {
            const bf16_t* gp = MG + mg_off(32, cb >> 4, 0, rh * 4 + ((cb & 7) >> 1), 0, rb, (cb & 15) >> 3, ((cb & 1) * 2 + (fq >> 1)) * 16 + fr) + 4 * (fq & 1);
            const u32x2 ra = *(const u32x2*)gp, rb2 = *(const u32x2*)(gp + 65536), gc = *(const u32x2*)(gp + 131072);
#pragma unroll
            for (int e = 0; e < 4; ++e) { const unsigned a_ = e < 2 ? ra.x : ra.y, b_ = e < 2 ? rb2.x : rb2.y, c_ = e < 2 ? gc.x : gc.y;
                const float f1 = (e & 1) ? __uint_as_float(a_ & 0xffff0000u) : __uint_as_float(a_ << 16), f2 = (e & 1) ? __uint_as_float(b_ & 0xffff0000u) : __uint_as_float(b_ << 16), f3 = (e & 1) ? __uint_as_float(c_ & 0xffff0000u) : __uint_as_float(c_ << 16);
                acc[rb][e] *= f3 * (s < 2 ? f2 : 1.0f) * (s < 1 ? f1 : 1.0f); } } }
    __attribute__((address_space(3))) f32x4* red = (__attribute__((address_space(3))) f32x4*)ldsl;
#pragma unroll
    for (int rb = 0; rb < 4; ++rb) red[(w * 4 + rb) * 64 + lane] = acc[rb];
    __syncthreads();
    if (w < 4) { const int rb = w; f32x4 s = red[rb * 64 + lane];
#pragma unroll
        for (int k = 1; k < 8; ++k) s = s + red[(k * 4 + rb) * 64 + lane];
        const int row = row0 + 16 * rb;
        if (MODE == 0) { u32x2 o; o.x = cvt_pk_bf16(s[0], s[1]); o.y = cvt_pk_bf16(s[2], s[3]); *(u32x2*)(OUTB + (size_t)row * DM + 16 * cb + 4 * fq) = o; }
        else { *(f32x4*)(OUTF + (size_t)(row - MP) * DM + 16 * cb + 4 * fq) = s;
            float q = (s[0] * s[0] + s[1] * s[1]) + (s[2] * s[2] + s[3] * s[3]);
            q += __shfl_xor(q, 16); q += __shfl_xor(q, 32);
            if (fq == 0) SSQS[(size_t)(row - MP) * 128 + cb] = q; }
    }
    __syncthreads();
}
}

namespace att {
typedef unsigned short u16;
#define GA __attribute__((address_space(1)))
using bf16x8 = __attribute__((ext_vector_type(8))) short;
using s16x4  = __attribute__((ext_vector_type(4))) short;
using f32x16 = __attribute__((ext_vector_type(16))) float;
using f32x4  = __attribute__((ext_vector_type(4))) float;
using u32x4  = __attribute__((ext_vector_type(4))) unsigned;
using u32x2  = __attribute__((ext_vector_type(2))) unsigned;
constexpr int SHM_V = 16384, SHM_K = 16384;
constexpr int NBUF = 3;
constexpr int OFF_V = 0, OFF_K = NBUF * SHM_V, OFF_BIAS = 2 * NBUF * SHM_V, OFF_FLAGS = OFF_BIAS + 2304, OFF_ITEM = OFF_FLAGS + 128, ATT_LDS = OFF_ITEM + 64;
constexpr float SB_DONE_LOG2 = -200.0f;
#define KSWZ(row, colB) ((row) * 256 + ((colB) ^ (((row) & 7) << 4)))
#define ATT_SBAR() __builtin_amdgcn_sched_barrier(0)
__device__ __forceinline__ int crow(int r, int hi) { return (r & 3) + 8 * (r >> 2) + 4 * hi; }
__device__ __forceinline__ unsigned cvtpk(float lo, float hi) { return pg8::cvt_pk_bf16(lo, hi); }
__device__ __forceinline__ int v_st(int k, int c) { const int kk = (k & ~0xC) | ((k & 4) << 1) | ((k & 8) >> 1); return ((kk >> 3) * 4 + (c >> 5)) * 512 + ((kk & 7) * 32 + (c & 31)) * 2; }
__device__ __forceinline__ int v_rd_base(int lane) { return ((lane & 3) << 3) | (((lane >> 2) & 3) << 6) | (((lane >> 4) & 1) << 5) | (((lane >> 5) & 1) << 8); }
constexpr int v_rd_off(int d0, int ks, int half) { return d0 * 512 + ks * 4096 + half * 2048; }
template <int OFF> __device__ __forceinline__ s16x4 tr_read(int vb) { s16x4 r; asm volatile("ds_read_b64_tr_b16 %0, %1 offset:%2" : "=&v"(r) : "v"(vb), "i"(OFF) : "memory"); return r; }

struct Item {
    int mode;
    int rule;
    const GA u16* Q; int ldq; int nq; int qpos0;
    const GA u16 *kb, *vb; int ldb; int pb_lo, pb_hi;
    const GA float *kf, *vf; int ldf; int pf_lo, pf_hi;
    int pv_lo, pv_hi;
    int kp_first, kp_step, ntiles;
    const GA float* bias;
    GA u16* O; int ldo; const GA u16* G; int ldg;
    int dma;
};

template <bool QPARK>
__device__ __forceinline__ void qkt(f32x16& p0, f32x16& p1, const char* Ks, const bf16x8* qr, const char* qpark, int r32, int hi) {
    p0 = f32x16{}; p1 = f32x16{};
#pragma unroll
    for (int d0 = 0; d0 < 8; ++d0) { const int cb = (d0 * 16 + hi * 8) * 2;
        const bf16x8 b0 = *reinterpret_cast<const bf16x8*>(Ks + KSWZ(r32, cb));
        const bf16x8 b1 = *reinterpret_cast<const bf16x8*>(Ks + KSWZ(32 + r32, cb));
        const bf16x8 q = QPARK ? *reinterpret_cast<const bf16x8*>(qpark + d0 * 1024) : qr[d0];
        p0 = __builtin_amdgcn_mfma_f32_32x32x16_bf16(b0, q, p0, 0, 0, 0);
        p1 = __builtin_amdgcn_mfma_f32_32x32x16_bf16(b1, q, p1, 0, 0, 0); }
}
template <int D0> __device__ __forceinline__ void pv_one(f32x16& od, int vb, bf16x8 pa0, bf16x8 pa1, bf16x8 pa2, bf16x8 pa3) {
    const s16x4 l0 = tr_read<v_rd_off(D0, 0, 0)>(vb), h0 = tr_read<v_rd_off(D0, 0, 1)>(vb), l1 = tr_read<v_rd_off(D0, 1, 0)>(vb), h1 = tr_read<v_rd_off(D0, 1, 1)>(vb);
    const s16x4 l2 = tr_read<v_rd_off(D0, 2, 0)>(vb), h2 = tr_read<v_rd_off(D0, 2, 1)>(vb), l3 = tr_read<v_rd_off(D0, 3, 0)>(vb), h3 = tr_read<v_rd_off(D0, 3, 1)>(vb);
    asm volatile("s_waitcnt lgkmcnt(0)" ::: "memory"); ATT_SBAR();
#define ATT_PK(L, H) (bf16x8){L[0], L[1], L[2], L[3], H[0], H[1], H[2], H[3]}
    od = __builtin_amdgcn_mfma_f32_32x32x16_bf16(ATT_PK(l0, h0), pa0, od, 0, 0, 0);
    od = __builtin_amdgcn_mfma_f32_32x32x16_bf16(ATT_PK(l1, h1), pa1, od, 0, 0, 0);
    od = __builtin_amdgcn_mfma_f32_32x32x16_bf16(ATT_PK(l2, h2), pa2, od, 0, 0, 0);
    od = __builtin_amdgcn_mfma_f32_32x32x16_bf16(ATT_PK(l3, h3), pa3, od, 0, 0, 0);
#undef ATT_PK
}
#define ATT_PK4(P, BASE, OUT) do { const unsigned a0_ = cvtpk(P[BASE + 0], P[BASE + 1]), a1_ = cvtpk(P[BASE + 2], P[BASE + 3]);   \
    const unsigned b0_ = cvtpk(P[BASE + 4], P[BASE + 5]), b1_ = cvtpk(P[BASE + 6], P[BASE + 7]);                              \
    auto r0_ = __builtin_amdgcn_permlane32_swap(a0_, b0_, false, false); auto r1_ = __builtin_amdgcn_permlane32_swap(a1_, b1_, false, false); \
    u32x4 w_ = {r0_[0], r1_[0], r0_[1], r1_[1]}; OUT = *reinterpret_cast<bf16x8*>(&w_); } while (0)

__device__ __forceinline__ void sb_half(f32x16& p, float& carry, bool need_mask, int kbase, int qpos, int pv_lo, int pv_hi, int hi) {
    float T[16];
#pragma unroll
    for (int r = 0; r < 16; ++r) {
        const float z = p[r];
        const float t = __builtin_amdgcn_exp2f(-__builtin_fabsf(z));
        const float l = __builtin_amdgcn_logf(1.0f + t);
        float lm = -(fmaxf(z, 0.f) + l);
        float lp = fminf(z, 0.f) - l;
        if (need_mask) { const int kp = kbase + crow(r, hi); const bool ok = (kp < qpos) && (kp >= pv_lo) && (kp < pv_hi); lm = ok ? lm : 0.f; lp = ok ? lp : -1e30f; }
        T[r] = lm; p[r] = lp;
    }
    float glo[4], ghi[4];
#pragma unroll
    for (int g = 0; g < 4; ++g) {
        T[4 * g + 2] += T[4 * g + 3]; T[4 * g + 1] += T[4 * g + 2]; T[4 * g] += T[4 * g + 1];
        const float gt = T[4 * g];
        auto rr = __builtin_amdgcn_permlane32_swap(__float_as_uint(gt), __float_as_uint(gt), false, false);
        glo[g] = __uint_as_float(rr[0]); ghi[g] = __uint_as_float(rr[1]);
    }
    float SG[4];
    SG[3] = 0.f; SG[2] = glo[3] + ghi[3]; SG[1] = SG[2] + (glo[2] + ghi[2]); SG[0] = SG[1] + (glo[1] + ghi[1]);
    const float tot = SG[0] + (glo[0] + ghi[0]);
#pragma unroll
    for (int g = 0; g < 4; ++g) SG[g] += carry + (hi == 0 ? ghi[g] : 0.f);
#pragma unroll
    for (int r = 0; r < 16; ++r) p[r] = __builtin_amdgcn_exp2f(p[r] + ((r & 3) == 3 ? SG[r >> 2] : SG[r >> 2] + T[r + 1]));
    carry += tot;
}

#define ATT_TILE(Kt, vb_) do { \
            f32x16 p0, p1; \
            qkt<!DMA>(p0, p1, (Kt), qr, qpark, r32, hi); \
            bool need_mask = (kp0 < it.pv_lo) || (kp0 + 64 > it.pv_hi); \
            if (MODE == 0) { \
                need_mask = need_mask || (kp0 + 63 >= it.qpos0 + 32 * wid); \
                sb_half(p1, carry, need_mask, kp0 + 32, qpos, it.pv_lo, it.pv_hi, hi); \
                sb_half(p0, carry, need_mask, kp0, qpos, it.pv_lo, it.pv_hi, hi); \
            } else { \
                if (has_bias) {       \
                    const int dlo_ = it.qpos0 + 32 * wid - kp0 - 63, dhi_ = it.qpos0 + 32 * wid + 31 - kp0;       \
                    if (dlo_ >= 256) { const float c_ = biasT[0]; \
                        _Pragma("unroll") for (int r = 0; r < 16; ++r) { p0[r] += c_; p1[r] += c_; } } \
                    else if (dlo_ > -256 && dhi_ < 256) { const float* rb_ = biasT + (256 - qpos + kp0 + 4 * hi);              \
                        _Pragma("unroll") for (int r = 0; r < 16; ++r) { p0[r] += rb_[(r & 3) + 8 * (r >> 2)]; p1[r] += rb_[32 + (r & 3) + 8 * (r >> 2)]; } } \
                    else { \
                        _Pragma("unroll") for (int r = 0; r < 16; ++r) { const int kp = kp0 + crow(r, hi); \
                            int i0_ = 256 - qpos + kp; i0_ = i0_ < 0 ? 0 : (i0_ > 512 ? 512 : i0_); \
                            int i1_ = 288 - qpos + kp; i1_ = i1_ < 0 ? 0 : (i1_ > 512 ? 512 : i1_); \
                            p0[r] += biasT[i0_]; p1[r] += biasT[i1_]; } } \
                } \
                if (need_mask) { \
                    _Pragma("unroll") for (int r = 0; r < 16; ++r) { const int kp = kp0 + crow(r, hi); \
                        if (!(kp >= it.pv_lo && kp < it.pv_hi)) p0[r] = -1e30f; \
                        if (!(kp + 32 >= it.pv_lo && kp + 32 < it.pv_hi)) p1[r] = -1e30f; } \
                } \
                float pmax = p0[0]; \
                _Pragma("unroll") for (int r = 1; r < 16; ++r) pmax = fmaxf(pmax, p0[r]); \
                _Pragma("unroll") for (int r = 0; r < 16; ++r) pmax = fmaxf(pmax, p1[r]); \
                { auto rr = __builtin_amdgcn_permlane32_swap(__float_as_uint(pmax), __float_as_uint(pmax), false, false); pmax = fmaxf(__uint_as_float(rr[0]), __uint_as_float(rr[1])); } \
                float mn = m_reg, alpha = 1.f;                  \
                if (!__all(pmax - m_reg <= 8.0f)) { mn = fmaxf(m_reg, pmax); alpha = __builtin_amdgcn_exp2f(m_reg - mn); m_reg = mn; } \
                float ps = 0.f; \
                _Pragma("unroll") for (int r = 0; r < 16; ++r) { p0[r] = __builtin_amdgcn_exp2f(p0[r] - mn); ps += p0[r]; } \
                _Pragma("unroll") for (int r = 0; r < 16; ++r) { p1[r] = __builtin_amdgcn_exp2f(p1[r] - mn); ps += p1[r]; } \
                { auto rr = __builtin_amdgcn_permlane32_swap(__float_as_uint(ps), __float_as_uint(ps), false, false); ps = __uint_as_float(rr[0]) + __uint_as_float(rr[1]); } \
                l_reg = l_reg * alpha + ps; \
                if (__any(alpha < 1.f)) { \
                    _Pragma("unroll") for (int d = 0; d < 4; ++d) \
                        _Pragma("unroll") for (int r = 0; r < 16; ++r) o[d][r] *= alpha; } \
            } \
            bf16x8 pa0, pa1, pa2, pa3; \
            ATT_PK4(p0, 0, pa0); ATT_PK4(p0, 8, pa1); ATT_PK4(p1, 0, pa2); ATT_PK4(p1, 8, pa3); \
            const int vbt_ = (vb_); \
            pv_one<0>(o[0], vbt_, pa0, pa1, pa2, pa3); pv_one<1>(o[1], vbt_, pa0, pa1, pa2, pa3); pv_one<2>(o[2], vbt_, pa0, pa1, pa2, pa3); pv_one<3>(o[3], vbt_, pa0, pa1, pa2, pa3); \
        } while (0)

template <int MODE, bool DMA>
__device__ __forceinline__ void run_item(const Item& it, char* lds, __attribute__((address_space(3))) unsigned char* ldsl) {
    typedef __attribute__((address_space(3))) unsigned las_u32;
    const int tid = threadIdx.x, lane = tid & 63, r32 = lane & 31, hi = lane >> 5;
    const int wid = __builtin_amdgcn_readfirstlane(tid >> 6);
    char* V_lds = lds + OFF_V; char* K_lds = lds + OFF_K;
    float* biasT = (float*)(lds + OFF_BIAS);
    volatile __attribute__((address_space(3))) int* flags = (volatile __attribute__((address_space(3))) int*)(ldsl + OFF_FLAGS);
    const bool has_bias = (MODE == 1) && (it.bias != nullptr);
    const bool wave_rows = (32 * wid < it.nq);
    int qrow = 32 * wid + r32; if (qrow >= it.nq) qrow = it.nq - 1;
    const int qpos = it.qpos0 + 32 * wid + r32;
    bf16x8 qr[8];
    char* const qpark = K_lds + 2 * SHM_K + (wid & 1) * 8192 + lane * 16;
#define ATT_ITEM_LOADS() do { \
    if (has_bias) for (int i = tid; i < 513; i += 512) biasT[i] = it.bias[512 - i] * LOG2E; \
    { const GA u16* Qw = it.Q + (size_t)qrow * it.ldq + hi * 8; \
      _Pragma("unroll") for (int d0 = 0; d0 < 8; ++d0) { const bf16x8 q = *reinterpret_cast<const GA bf16x8*>(Qw + d0 * 16); \
          if constexpr (DMA) qr[d0] = q; else { if (wid < 2) *reinterpret_cast<bf16x8*>(qpark + d0 * 1024) = q; } } } \
    } while (0)
    f32x16 o[4]; o[0] = f32x16{}; o[1] = f32x16{}; o[2] = f32x16{}; o[3] = f32x16{};
    float carry = 0.f, m_reg = -1e30f, l_reg = 0.f;
    const int vb0 = (int)(uintptr_t)V_lds + v_rd_base(lane);
    const int nt = it.ntiles;
    bool wdone = !wave_rows;
    if constexpr (!DMA) ATT_ITEM_LOADS();
    if constexpr (DMA) {
        unsigned koff[2], voff[2];
#pragma unroll
        for (int i = 0; i < 2; ++i) { const int p = wid + 8 * i;
            const int krow = 4 * p + (lane >> 4), kch = (lane & 15) ^ (krow & 7);
            koff[i] = (unsigned)(krow * it.ldb * 2 + kch * 16);
            const int s = 2 * p + (lane >> 5), kk = 8 * (s >> 2) + ((lane & 31) >> 2), k = (kk & ~0xC) | ((kk & 4) << 1) | ((kk & 8) >> 1), c = 32 * (s & 3) + 8 * (lane & 3);
            voff[i] = (unsigned)(k * it.ldb * 2 + c * 2); }
        const GA char* kbase = (const GA char*)it.kb; const GA char* vbase = (const GA char*)it.vb;
#define ATT_DMA(b, kp0_) do { const size_t to_ = (size_t)((kp0_) - it.pb_lo) * (size_t)it.ldb * 2; \
        _Pragma("unroll") for (int i_ = 0; i_ < 2; ++i_) { \
            __builtin_amdgcn_global_load_lds((const GA unsigned*)(kbase + to_ + koff[i_]), (las_u32*)(ldsl + OFF_K + (b) * SHM_K + (wid + 8 * i_) * 1024), 16, 0, 0); \
            __builtin_amdgcn_global_load_lds((const GA unsigned*)(vbase + to_ + voff[i_]), (las_u32*)(ldsl + OFF_V + (b) * SHM_V + (wid + 8 * i_) * 1024), 16, 0, 0); } } while (0)
        ATT_DMA(0, it.kp_first);
        if (nt > 1) ATT_DMA(1, it.kp_first + it.kp_step);
        ATT_ITEM_LOADS();
        int cur = 0;
        for (int j = 0; j < nt; ++j) {
            const int kp0 = it.kp_first + j * it.kp_step;
            if (j + 1 < nt) asm volatile("s_waitcnt vmcnt(4) lgkmcnt(0)\n\ts_barrier" ::: "memory");
            else            asm volatile("s_waitcnt vmcnt(0) lgkmcnt(0)\n\ts_barrier" ::: "memory");
            if (MODE == 0 && SB_EARLY_EXIT && j > 0) {
                int alld = 1;
#pragma unroll
                for (int w = 0; w < 8; ++w) alld &= flags[((j - 1) & 1) * 8 + w];
                if (alld) break;
            }
            if (j + 2 < nt) { const int b2 = (cur >= 1) ? cur - 1 : cur + 2; ATT_DMA(b2, kp0 + 2 * it.kp_step); }
            bool active = wave_rows;
            if (it.rule == 1) active = active && (kp0 <= it.qpos0 + 32 * wid + 30) && !wdone;
            if (it.rule == 2) { const int ct = kp0 >> 6, cw = (it.qpos0 + 32 * wid) >> 6; active = active && (ct >= cw - 8) && (ct <= cw); }
            if (active) ATT_TILE(K_lds + cur * SHM_K, vb0 + cur * SHM_V);
            if (MODE == 0 && SB_EARLY_EXIT) {
                if (wave_rows && !wdone) { const bool rowdone = (carry < SB_DONE_LOG2) || (32 * wid + r32 >= it.nq); wdone = __all(rowdone); }
                if (lane == 0) flags[(j & 1) * 8 + wid] = wdone ? 1 : 0;
            }
            cur = (cur == NBUF - 1) ? 0 : cur + 1;
        }
        asm volatile("s_waitcnt vmcnt(0) lgkmcnt(0)\n\ts_barrier" ::: "memory");
#undef ATT_DMA
    } else {
    const int sr = tid >> 4, sc = (tid & 15) * 8;
    const int vst0 = v_st(sr, sc), vst1 = v_st(32 + sr, sc), kst0 = KSWZ(sr, sc * 2), kst1 = KSWZ(32 + sr, sc * 2);
    f32x4 sK0a, sK0b, sK1a, sK1b, sV0a, sV0b, sV1a, sV1b;
#define ATT_LD(p, A, B, kbp, kfp) do { const int p_ = (p); const bool isb_ = (p_ >= it.pb_lo && p_ < it.pb_hi), isf_ = (p_ >= it.pf_lo && p_ < it.pf_hi); \
        const GA char* a0_ = isf_ ? (const GA char*)(kfp + (size_t)(p_ - it.pf_lo) * it.ldf + sc) : (const GA char*)(kbp + (size_t)(isb_ ? p_ - it.pb_lo : 0) * it.ldb + sc); \
        const f32x4 la_ = *reinterpret_cast<const GA f32x4*>(a0_); const f32x4 lb_ = *reinterpret_cast<const GA f32x4*>(a0_ + (isf_ ? 16 : 0)); \
        A = la_; B = lb_; } while (0)
#define ATT_CV(p, A, B, OUT) do { const int p_ = (p); const bool isb_ = (p_ >= it.pb_lo && p_ < it.pb_hi), isf_ = (p_ >= it.pf_lo && p_ < it.pf_hi); \
        u32x4 w_ = {cvtpk(A[0], A[1]), cvtpk(A[2], A[3]), cvtpk(B[0], B[1]), cvtpk(B[2], B[3])}; const u32x4 r_ = __builtin_bit_cast(u32x4, A); \
        w_.x = isf_ ? w_.x : (isb_ ? r_.x : 0u); w_.y = isf_ ? w_.y : (isb_ ? r_.y : 0u); w_.z = isf_ ? w_.z : (isb_ ? r_.z : 0u); w_.w = isf_ ? w_.w : (isb_ ? r_.w : 0u); \
        OUT = *reinterpret_cast<bf16x8*>(&w_); } while (0)
#define ATT_SLOAD(kp0) do { ATT_LD((kp0) + sr, sK0a, sK0b, it.kb, it.kf); ATT_LD((kp0) + 32 + sr, sK1a, sK1b, it.kb, it.kf); \
        ATT_LD((kp0) + sr, sV0a, sV0b, it.vb, it.vf); ATT_LD((kp0) + 32 + sr, sV1a, sV1b, it.vb, it.vf); } while (0)
#define ATT_SWRITE(b, kp0) do { bf16x8 t_; \
        ATT_CV((kp0) + sr, sK0a, sK0b, t_); *reinterpret_cast<bf16x8*>(K_lds + (b) * SHM_K + kst0) = t_; \
        ATT_CV((kp0) + 32 + sr, sK1a, sK1b, t_); *reinterpret_cast<bf16x8*>(K_lds + (b) * SHM_K + kst1) = t_; \
        ATT_CV((kp0) + sr, sV0a, sV0b, t_); *reinterpret_cast<bf16x8*>(V_lds + (b) * SHM_V + vst0) = t_; \
        ATT_CV((kp0) + 32 + sr, sV1a, sV1b, t_); *reinterpret_cast<bf16x8*>(V_lds + (b) * SHM_V + vst1) = t_; } while (0)
    sK0b = sK1b = sV0b = sV1b = (f32x4){0.f, 0.f, 0.f, 0.f};
    ATT_SLOAD(it.kp_first); ATT_SWRITE(0, it.kp_first);
    __syncthreads();
    for (int j = 0; j < nt; ++j) {
        const int kp0 = it.kp_first + j * it.kp_step, kpn = kp0 + it.kp_step, cur = j & 1;
        const bool more = (j + 1 < nt);
        if (more) ATT_SLOAD(kpn);
        bool active = wave_rows;
        if (it.rule == 1) active = active && (kp0 <= it.qpos0 + 32 * wid + 30) && !wdone;
        if (it.rule == 2) { const int ct = kp0 >> 6, cw = (it.qpos0 + 32 * wid) >> 6; active = active && (ct >= cw - 8) && (ct <= cw); }
        if (active) ATT_TILE(K_lds + cur * SHM_K, vb0 + cur * SHM_V);
        if (MODE == 0 && SB_EARLY_EXIT) {
            if (wave_rows && !wdone) { const bool rowdone = (carry < SB_DONE_LOG2) || (32 * wid + r32 >= it.nq); wdone = __all(rowdone); }
            if (lane == 0) flags[cur * 8 + wid] = wdone ? 1 : 0;
        }
        if (more) ATT_SWRITE(cur ^ 1, kpn);
        __syncthreads();
        if (MODE == 0 && SB_EARLY_EXIT) {
            int alld = 1;
#pragma unroll
            for (int w = 0; w < 8; ++w) alld &= flags[cur * 8 + w];
            if (alld) break;
        }
    }
#undef ATT_LD
#undef ATT_CV
#undef ATT_SLOAD
#undef ATT_SWRITE
    }
    if (wave_rows) {
        const int nrow = it.nq - 32 * wid;
        const int prow = lane >> 4, piece = lane & 15;
        u32x4 gq[8];
#pragma unroll
        for (int j = 0; j < 8; ++j) { int rl = 4 * j + prow; rl = rl < nrow ? rl : nrow - 1;
            gq[j] = *reinterpret_cast<const GA u32x4*>(it.G + (size_t)(32 * wid + rl) * it.ldg + 8 * piece); }
        const float inv = (MODE == 1) ? __builtin_amdgcn_rcpf(l_reg) : 1.0f;
        char* const stg = lds + wid * 8704 + r32 * 272 + hi * 8;
#pragma unroll
        for (int d0 = 0; d0 < 4; ++d0)
#pragma unroll
            for (int g = 0; g < 4; ++g) { u32x2 w; w.x = cvtpk(o[d0][4 * g] * inv, o[d0][4 * g + 1] * inv); w.y = cvtpk(o[d0][4 * g + 2] * inv, o[d0][4 * g + 3] * inv);
                *reinterpret_cast<u32x2*>(stg + d0 * 64 + g * 16) = w; }
        asm volatile("s_waitcnt lgkmcnt(0)" ::: "memory");
        const char* const rd = lds + wid * 8704 + prow * 272 + piece * 16;
#pragma unroll
        for (int j = 0; j < 8; ++j) { const int rl = 4 * j + prow;
            const u32x4 ov = *reinterpret_cast<const u32x4*>(rd + j * 4 * 272); const u32x4 gg = gq[j]; u32x4 w;
#pragma unroll
            for (int e = 0; e < 4; ++e) w[e] = cvtpk(__uint_as_float(ov[e] << 16) * __uint_as_float(gg[e] << 16), __uint_as_float(ov[e] & 0xffff0000u) * __uint_as_float(gg[e] & 0xffff0000u));
            if (rl < nrow) *reinterpret_cast<GA u32x4*>(it.O + (size_t)(32 * wid + rl) * it.ldo + 8 * piece) = w; }
    }
    __syncthreads();
}
#undef ATT_TILE
#undef ATT_ITEM_LOADS
#undef GA
}

constexpr int NWAVES = 8;
constexpr int N_LAUNCHES = MK_N_LAUNCHES;
constexpr int PER_PHASE = 6;

constexpr size_t al256(size_t x) { return (x + 255) & ~(size_t)255; }
constexpr size_t WS_CTL = 0, CTL_ZERO_BYTES = 65536, CTL_BYTES = 1u << 20;
constexpr size_t WS_WCAT = CTL_BYTES;
constexpr size_t WS_WUP  = WS_WCAT + (size_t)NCAT * DM * 2;
constexpr size_t WS_WOUT = WS_WUP + (size_t)DM * DM * 2;
constexpr size_t WS_ACAT = WS_WOUT + (size_t)DM * DM * 2;
constexpr size_t SZ768 = (size_t)MIN_ * 768 * 2, SZ512 = (size_t)MIN_ * 512 * 2;
constexpr size_t WS_QSB = WS_ACAT + (size_t)MA * DM * 2, WS_KSB = WS_QSB + SZ768, WS_VSB = WS_KSB + SZ768, WS_GSB = WS_VSB + SZ768;
constexpr size_t WS_QBD = WS_GSB + SZ768, WS_KBD = WS_QBD + SZ768, WS_VBD = WS_KBD + SZ768, WS_GBD = WS_VBD + SZ768;
constexpr size_t WS_QMM = WS_GBD + SZ768, WS_GMM = WS_QMM + SZ512;
constexpr size_t WS_MG  = WS_GMM + SZ512;
constexpr size_t WS_MK  = WS_MG + (size_t)MIN_ * 6144 * 2, WS_MV = WS_MK + (size_t)512 * 512 * 2;
constexpr size_t WS_AUP = WS_MV + (size_t)512 * 512 * 2;
constexpr size_t WS_SSQ = WS_AUP + (size_t)MIN_ * DM * 2;
constexpr size_t WS_SSQS = WS_SSQ + (size_t)MIN_ * 32 * 4;
constexpr size_t WS_XBUF = WS_SSQS + (size_t)MS * 128 * 4;
constexpr size_t WS_YB = WS_XBUF + (size_t)MP * 8 * 4;
constexpr size_t WS_KBC = WS_YB, WS_VBC = WS_KBC + (size_t)DB * 576 * 768 * 2, WS_MKC = WS_VBC + (size_t)DB * 576 * 768 * 2, WS_MVC = WS_MKC + (size_t)DB * NMEM * 512 * 2;
static_assert(WS_MVC + (size_t)DB * NMEM * 512 * 2 <= WS_YB + (size_t)MP * DM * 2, "decode caches inside the YB region");
constexpr size_t WS_END = WS_YB + (size_t)MP * DM * 2;
static_assert(WS_WCAT % 256 == 0 && WS_QSB % 256 == 0 && WS_MG % 256 == 0 && WS_AUP % 256 == 0 && WS_SSQ % 256 == 0, "alignment");
constexpr int CW_TMO = 0, CW_WORK = 64, CW_BAR = 4096, CW_PANEL = 8192;
constexpr int OUT_ELEMS = 32112640;

constexpr int RING_BYTES = 131072, LDSCTL_OFF = RING_BYTES, MISC_OFF = LDSCTL_OFF + 320, STG_OFF = 147456, LDS_BYTES = 163840;
static_assert(att::ATT_LDS <= RING_BYTES, "attention scratch inside the ring region");

#define GAS __attribute__((address_space(1)))
#define LAS __attribute__((address_space(3)))
typedef unsigned short bf16;
typedef unsigned v4u __attribute__((ext_vector_type(4)));
typedef float f32x4 __attribute__((ext_vector_type(4)));
typedef GAS unsigned gu32;
#define RLX_AGENT __ATOMIC_RELAXED, __HIP_MEMORY_SCOPE_AGENT
#define LDS_WAIT() asm volatile("s_waitcnt lgkmcnt(0)" ::: "memory")
__device__ __forceinline__ unsigned pk2(float lo, float hi) { return pg8::cvt_pk_bf16(lo, hi); }

#define XB_TMO      128
#define XB_XCNT(j)  (256  + 64 * (j))
#define XB_XSUB(j)  (1280 + 64 * (j))
#define XB_XGEN(j)  (2304 + 64 * (j))
#define XB_TOP      3328
#define XB_TOPGEN   3392
#define XCD_BAR_WORDS 3456
#define XB_SPIN_CAP (1u << 18)
__device__ __forceinline__ unsigned xb_ld(unsigned* p)              { return __hip_atomic_load(p, __ATOMIC_RELAXED, __HIP_MEMORY_SCOPE_AGENT); }
__device__ __forceinline__ unsigned xb_add(unsigned* p, unsigned v) { return __hip_atomic_fetch_add(p, v, __ATOMIC_RELAXED, __HIP_MEMORY_SCOPE_AGENT); }
__device__ __forceinline__ unsigned xb_xcc_id() { return (unsigned)__builtin_amdgcn_s_getreg((3 << 11) | 20) & 0xFu; }
#define XB_SPIN(cond, bar) do { unsigned _sp = 0; while (cond) { __builtin_amdgcn_s_sleep(1); \
    if ((++_sp & 255u) == 0u) { if (xb_ld(&(bar)[XB_TMO])) break; if (_sp > XB_SPIN_CAP) { atomicAdd(&(bar)[XB_TMO], 1u); break; } } } } while (0)
struct XcdBarrier { unsigned* bar; unsigned x; volatile LAS unsigned* st; };
__device__ __forceinline__ XcdBarrier xcd_barrier_post(unsigned* bar, volatile LAS unsigned* st) {
    XcdBarrier b; b.bar = bar; b.x = xb_xcc_id(); b.st = st;
    if (threadIdx.x == 0) (void)xb_add(&bar[XB_XCNT(b.x)], 1u);
    return b;
}
__device__ __forceinline__ void xcd_barrier_complete(unsigned* bar, unsigned x, unsigned& nloc, unsigned& nx) {
    const unsigned G = gridDim.x * gridDim.y * gridDim.z;
    unsigned sum, cnt, mine, sp = 0u;
    for (;;) {
        sum = 0u; cnt = 0u; mine = 0u;
#pragma unroll
        for (unsigned j = 0; j < 16; ++j) { const unsigned c = xb_ld(&bar[XB_XCNT(j)]); sum += c; cnt += (c > 0u) ? 1u : 0u; mine = (j == x) ? c : mine; }
        if (sum == G) break;
        __builtin_amdgcn_s_sleep(1);
        if ((++sp & 255u) == 0u) { if (xb_ld(&bar[XB_TMO])) break; if (sp > XB_SPIN_CAP) { atomicAdd(&bar[XB_TMO], 1u); break; } }
    }
    nloc = mine > 0u ? mine : 1u; nx = cnt > 0u ? cnt : 1u;
}
__device__ __forceinline__ void xcd_barrier(const XcdBarrier& b) {
    asm volatile("s_waitcnt vmcnt(0)" ::: "memory");
    __syncthreads();
    if (threadIdx.x == 0) {
        unsigned* bar = b.bar;
        __builtin_amdgcn_s_waitcnt(0);
        unsigned nloc = b.st[0], nx = b.st[1];
        if (nloc == 0u) { xcd_barrier_complete(bar, b.x, nloc, nx); b.st[0] = nloc; b.st[1] = nx; }
        const unsigned old = xb_add(&bar[XB_XSUB(b.x)], 1u);
        const unsigned gen = old / nloc;
        if (old + 1u == (gen + 1u) * nloc) {
            __builtin_amdgcn_fence(__ATOMIC_RELEASE, "agent");
            asm volatile("s_waitcnt vmcnt(0)" ::: "memory");
            const unsigned og = xb_add(&bar[XB_TOP], 1u);
            const unsigned tg = og / nx;
            if (og + 1u == (tg + 1u) * nx) xb_add(&bar[XB_TOPGEN], 1u);
            else XB_SPIN(xb_ld(&bar[XB_TOPGEN]) == tg, bar);
            __builtin_amdgcn_fence(__ATOMIC_ACQUIRE, "agent");
            xb_add(&bar[XB_XGEN(b.x)], 1u);
            asm volatile("s_waitcnt vmcnt(0)" ::: "memory");
        } else {
            XB_SPIN(xb_ld(&bar[XB_XGEN(b.x)]) == gen, bar);
            __builtin_amdgcn_fence(__ATOMIC_ACQUIRE, "agent");
            asm volatile("s_waitcnt vmcnt(0)" ::: "memory");
        }
    }
    __syncthreads();
}

struct Frame {
    LAS unsigned char* lds;
    volatile LAS unsigned* MISC;
    gu32* ctl;
    int vcu, G;
    const float *x_prompt, *x_sample, *c_sbk, *c_sbv, *c_bdk, *c_bdv, *c_mk, *c_mv, *mem_prompt, *g_pre, *w_in, *rel_bias, *g_mem, *w_mem_kv, *w_up_sb, *w_up_band, *w_up_mem, *w_out, *g_post;
    float* out;
    bf16 *WCAT, *WUP, *WOUT, *ACAT, *QSB, *KSB, *VSB, *GSB, *QBD, *KBD, *VBD, *GBD, *QMM, *GMM, *MG, *MK, *MV, *AUP, *MERGED;
    float* SSQ; float* SSQS; bf16* YB; bf16 *KBC, *VBC, *MKC, *MVC;
};

__device__ __forceinline__ int fresh_tid() { int t = threadIdx.x; asm volatile("" : "+v"(t)); return t; }
__device__ __forceinline__ float wave_sum(float v) {
#pragma unroll
    for (int o = 1; o < 64; o <<= 1) v += __shfl_xor(v, o);
    return v;
}
__device__ __forceinline__ void p0_decode(int item, int nblk, int& kb, int& nb) { kb = item / nblk; nb = item % nblk; }
__device__ __forceinline__ void p0_transpose_item(const float* W, int N, int nkb, bf16* WT, int ldt, int row_off, int col_off, int item, int lane) {
    int kb, nb; p0_decode(item, N / 32, kb, nb); const int k0 = 64 * kb + 8 * (lane >> 3), n0 = 32 * nb + 4 * (lane & 7);
    f32x4 wv[8];
#pragma unroll
    for (int i = 0; i < 8; ++i) wv[i] = __builtin_nontemporal_load((const GAS f32x4*)(W + (size_t)(k0 + i) * N + n0));
#pragma unroll
    for (int e = 0; e < 4; ++e) { v4u o; o.x = pk2(wv[0][e], wv[1][e]); o.y = pk2(wv[2][e], wv[3][e]); o.z = pk2(wv[4][e], wv[5][e]); o.w = pk2(wv[6][e], wv[7][e]);
        *(GAS v4u*)(WT + (size_t)(row_off + n0 + e) * ldt + col_off + k0) = o; }
}
__device__ __forceinline__ void rms_row_to_bf16(const float* xrow, const float* g, bf16* orow, int lane) {
    const GAS f32x4* xr = (const GAS f32x4*)xrow + lane; const GAS f32x4* gr = (const GAS f32x4*)g + lane;
    f32x4 v[8]; float s = 0.f;
#pragma unroll
    for (int j = 0; j < 8; ++j) { v[j] = xr[64 * j]; s += (v[j].x * v[j].x + v[j].y * v[j].y) + (v[j].z * v[j].z + v[j].w * v[j].w); }
    const float r = 1.0f / sqrtf(wave_sum(s) * (1.0f / DM) + RMS_EPS);
    GAS unsigned long long* o8 = (GAS unsigned long long*)orow + lane;
#pragma unroll
    for (int j = 0; j < 8; ++j) { const f32x4 gv = gr[64 * j];
        o8[64 * j] = (unsigned long long)pk2(v[j].x * r * gv.x, v[j].y * r * gv.y) | ((unsigned long long)pk2(v[j].z * r * gv.z, v[j].w * r * gv.w) << 32); }
}
__device__ __forceinline__ void p0_t_load(const float* W, int N, int item, int lane, f32x4 (&wv)[8]) {
    int kb, nb; p0_decode(item, N / 32, kb, nb); const int k0 = 64 * kb + 8 * (lane >> 3), n0 = 32 * nb + 4 * (lane & 7);
#pragma unroll
    for (int i = 0; i < 8; ++i) wv[i] = __builtin_nontemporal_load((const GAS f32x4*)(W + (size_t)(k0 + i) * N + n0));
}
__device__ __forceinline__ int wcat_row(int c) {
    int kind, idx;
    if (c >= 7168) { const int d = c - 7168; kind = d >> 11; idx = d & 2047; }
    else { const int p = c >> 8;
        if (p < 9) return c;
        if (p < 12) { kind = 3; idx = c - 2304; }
        else if (p < 21) return c - 768;
        else if (p < 24) { kind = 3; idx = 768 + (c - 5376); }
        else if (p < 26) return c - 1536;
        else { kind = 3; idx = 1536 + (c - 6656); } }
    const int t = idx >> 6, q = idx & 63;
    return (20 + t) * 256 + 128 * (kind >> 1) + 4 * (kind & 1) + 32 * (q >> 4) + 8 * ((q >> 2) & 3) + (q & 3);
}
__device__ __forceinline__ float wcat_scale(int c) { const int p = c >> 8; return (p < 3 || (p >= 12 && p < 15) || p == 24 || p == 25) ? QSCALE : ((p >= 9 && p < 12) || p >= 21) ? -LOG2E : 1.0f; }
template <bool MAP>
__device__ __forceinline__ void p0_t_finish(const f32x4 (&wv)[8], int N, bf16* WT, int ldt, int row_off, int col_off, int item, int lane) {
    int kb, nb; p0_decode(item, N / 32, kb, nb); const int k0 = 64 * kb + 8 * (lane >> 3), n0 = 32 * nb + 4 * (lane & 7);
#pragma unroll
    for (int e = 0; e < 4; ++e) { const float sc = MAP ? wcat_scale(n0 + e) : 1.0f;
        v4u o; o.x = pk2(wv[0][e] * sc, wv[1][e] * sc); o.y = pk2(wv[2][e] * sc, wv[3][e] * sc); o.z = pk2(wv[4][e] * sc, wv[5][e] * sc); o.w = pk2(wv[6][e] * sc, wv[7][e] * sc);
        *(GAS v4u*)(WT + (size_t)(MAP ? wcat_row(n0 + e) : row_off + n0 + e) * ldt + col_off + k0) = o; }
}
__device__ __forceinline__ void rms_load(const float* xrow, int lane, f32x4 (&v)[8]) {
    const GAS f32x4* xr = (const GAS f32x4*)xrow + lane;
#pragma unroll
    for (int j = 0; j < 8; ++j) v[j] = __builtin_nontemporal_load(&xr[64 * j]);
}
__device__ __forceinline__ void rms_finish(const f32x4 (&v)[8], const f32x4 (&gv)[8], bf16* orow, int lane) {
    float s = 0.f;
#pragma unroll
    for (int j = 0; j < 8; ++j) s += (v[j].x * v[j].x + v[j].y * v[j].y) + (v[j].z * v[j].z + v[j].w * v[j].w);
    const float r = 1.0f / sqrtf(wave_sum(s) * (1.0f / DM) + RMS_EPS);
    GAS unsigned long long* o8 = (GAS unsigned long long*)orow + lane;
#pragma unroll
    for (int j = 0; j < 8; ++j) o8[64 * j] = (unsigned long long)pk2(v[j].x * r * gv[j].x, v[j].y * r * gv[j].y) | ((unsigned long long)pk2(v[j].z * r * gv[j].z, v[j].w * r * gv[j].w) << 32);
}
__device__ __forceinline__ void p0_prologue(Frame& F) {
    const int tid_ = fresh_tid(), lane_ = tid_ & 63, wave_ = __builtin_amdgcn_readfirstlane(tid_ >> 6);
    const int gw = F.vcu * NWAVES + wave_, NGW = F.G * NWAVES;
    constexpr int I_IN = 32 * (INW / 32), I_MEM = 32 * (1024 / 32), I_USB = 12 * 64, I_UBD = 12 * 64, I_UMM = 8 * 64, I_OUT = 32 * 64;
    constexpr int NI = I_IN + I_MEM;
#define P0_TLOAD(buf, it_) do { if ((it_) < I_IN) p0_t_load(F.w_in, INW, (it_), lane_, buf); else p0_t_load(F.w_mem_kv, 1024, (it_) - I_IN, lane_, buf); } while (0)
#define P0_TFIN(buf, it_) do { if ((it_) < I_IN) p0_t_finish<true>(buf, INW, F.WCAT, DM, 0, 0, (it_), lane_); else p0_t_finish<false>(buf, 1024, F.WCAT, DM, INW, 0, (it_) - I_IN, lane_); } while (0)
    { f32x4 wa[8], wb[8]; int it = gw;
      if (it < NI) P0_TLOAD(wa, it);
      while (it < NI) {
          int it2 = it + NGW; if (it2 < NI) P0_TLOAD(wb, it2);
          P0_TFIN(wa, it); it = it2; if (it >= NI) break;
          it2 = it + NGW; if (it2 < NI) P0_TLOAD(wa, it2);
          P0_TFIN(wb, it); it = it2; } }
#undef P0_TLOAD
#undef P0_TFIN
    if (!LATE_WT) for (int it = gw; it < I_USB + I_UBD + I_UMM + I_OUT; it += NGW) {
        int r = it;
        if (r < I_USB) { p0_transpose_item(F.w_up_sb, DM, 12, F.WUP, DM, 0, 0, r, lane_); continue; } r -= I_USB;
        if (r < I_UBD) { p0_transpose_item(F.w_up_band, DM, 12, F.WUP, DM, 0, 768, r, lane_); continue; } r -= I_UBD;
        if (r < I_UMM) { p0_transpose_item(F.w_up_mem, DM, 8, F.WUP, DM, 0, 1536, r, lane_); continue; } r -= I_UMM;
        p0_transpose_item(F.w_out, DM, 32, F.WOUT, DM, 0, 0, r, lane_);
    }
    { f32x4 gv[8], va[8], vb[8]; const GAS f32x4* gr = (const GAS f32x4*)F.g_pre + lane_;
#pragma unroll
      for (int j = 0; j < 8; ++j) gv[j] = gr[64 * j];
      int m = gw;
      if (m < MP) rms_load(F.x_prompt + (size_t)m * DM, lane_, va);
      while (m < MP) {
          int m2 = m + NGW; if (m2 < MP) rms_load(F.x_prompt + (size_t)m2 * DM, lane_, vb);
          rms_finish(va, gv, F.ACAT + (size_t)m * DM, lane_); m = m2; if (m >= MP) break;
          m2 = m + NGW; if (m2 < MP) rms_load(F.x_prompt + (size_t)m2 * DM, lane_, va);
          rms_finish(vb, gv, F.ACAT + (size_t)m * DM, lane_); m = m2; } }
    for (int m = MP + gw; m < MA; m += NGW) {
        bf16* orow = F.ACAT + (size_t)m * DM;
        if (m < MREAL) rms_row_to_bf16(F.x_sample + (size_t)(m - MP) * DM, F.g_pre, orow, lane_);
        else if (m < MIN_) {
            GAS v4u* o = (GAS v4u*)orow + lane_; GAS v4u* o2 = (GAS v4u*)(F.AUP + (size_t)m * DM) + lane_;
#pragma unroll
            for (int j = 0; j < 4; ++j) { o[64 * j] = (v4u){0u, 0u, 0u, 0u}; o2[64 * j] = (v4u){0u, 0u, 0u, 0u}; }
        }
        else rms_row_to_bf16(F.mem_prompt + (size_t)(m - MMEM0) * DM, F.g_mem, orow, lane_);
    }
}
constexpr int LATE_ITEMS = 128;
__device__ __forceinline__ void late_transpose_item(Frame& F, int j) {
    const int tid_ = fresh_tid(), lane_ = tid_ & 63, wave_ = __builtin_amdgcn_readfirstlane(tid_ >> 6);
    constexpr int I_USB = 12 * 64, I_UBD = 12 * 64, I_UMM = 8 * 64;
#pragma unroll 1
    for (int q = 0; q < 4; ++q) {
        int r = (j * 8 + wave_) * 4 + q;
        if (r < I_USB) { p0_transpose_item(F.w_up_sb, DM, 12, F.WUP, DM, 0, 0, r, lane_); continue; } r -= I_USB;
        if (r < I_UBD) { p0_transpose_item(F.w_up_band, DM, 12, F.WUP, DM, 0, 768, r, lane_); continue; } r -= I_UBD;
        if (r < I_UMM) { p0_transpose_item(F.w_up_mem, DM, 8, F.WUP, DM, 0, 1536, r, lane_); continue; } r -= I_UMM;
        p0_transpose_item(F.w_out, DM, 32, F.WOUT, DM, 0, 0, r, lane_);
    }
}
constexpr int CV_BD = DB * 576 * 768 / 32768, CV_MM = DB * NMEM * 512 / 32768, SLACK_ITEMS = LATE_ITEMS + 2 * CV_BD + 2 * CV_MM;
static_assert(DB * 576 * 768 % 32768 == 0 && DB * NMEM * 512 % 32768 == 0, "conversion item size");
template <bool BAND>
__device__ __forceinline__ void slack_convert(const float* src, bf16* dst, int jj, int tid_) {
    constexpr int ld = BAND ? 768 : 512, rows_d = BAND ? 576 : NMEM, rows_s = BAND ? 512 : NMEM;
    f32x4 va[8], vb[8];
#pragma unroll
    for (int it = 0; it < 8; ++it) { const int e = (jj * 4096 + it * 512 + tid_) * 8;
        const int col = e % ld, rowd = e / ld, b = rowd / rows_d, row = rowd % rows_d;
        const float* s = src + ((size_t)(b * rows_s + (row < rows_s ? row : 0)) * ld + col);
        va[it] = __builtin_nontemporal_load((const GAS f32x4*)s); vb[it] = __builtin_nontemporal_load((const GAS f32x4*)(s + 4)); }
#pragma unroll
    for (int it = 0; it < 8; ++it) { const int e = (jj * 4096 + it * 512 + tid_) * 8; const int row = (e / ld) % rows_d;
        v4u w; w.x = pk2(va[it].x, va[it].y); w.y = pk2(va[it].z, va[it].w); w.z = pk2(vb[it].x, vb[it].y); w.w = pk2(vb[it].z, vb[it].w);
        if (row >= rows_s + DS) w = (v4u){0u, 0u, 0u, 0u};
        if (row < rows_s || row >= rows_s + DS) *(GAS v4u*)(dst + e) = w; }
}
__device__ __forceinline__ void slack_item(Frame& F, int j) {
    if (j < LATE_ITEMS) { late_transpose_item(F, j); return; }
    j -= LATE_ITEMS;
    const int tid_ = fresh_tid();
    if (j < CV_BD) slack_convert<true>(F.c_bdk, F.KBC, j, tid_);
    else if (j < 2 * CV_BD) slack_convert<true>(F.c_bdv, F.VBC, j - CV_BD, tid_);
    else if (j < 2 * CV_BD + CV_MM) slack_convert<false>(F.c_mk, F.MKC, j - 2 * CV_BD, tid_);
    else slack_convert<false>(F.c_mv, F.MVC, j - 2 * CV_BD - CV_MM, tid_);
}
struct P5Row { float sq; unsigned long long yb[8]; f32x4 xv[8]; };
__device__ __forceinline__ void p5_load(Frame& F, int m, int lane, float& sq, unsigned long long (&yb)[8], f32x4 (&xv)[8]) {
    sq = (lane < 32) ? F.SSQ[(size_t)m * 32 + lane] : 0.f;
    const GAS unsigned long long* yb8 = (const GAS unsigned long long*)(F.YB + (size_t)m * DM) + lane; const GAS f32x4* x4 = (const GAS f32x4*)(F.x_prompt + (size_t)m * DM) + lane;
#pragma unroll
    for (int j = 0; j < 8; ++j) { yb[j] = __builtin_nontemporal_load(&yb8[64 * j]); xv[j] = __builtin_nontemporal_load(&x4[64 * j]); }
}
__device__ __forceinline__ void p5_finish(Frame& F, int m, int lane, float sq, const unsigned long long (&yb)[8], const f32x4 (&xv)[8], const f32x4 (&gv)[8]) {
    const float r = 1.0f / sqrtf(wave_sum(sq) * (1.0f / DM) + RMS_EPS);
    GAS f32x4* y4 = (GAS f32x4*)(F.out + (size_t)m * DM) + lane;
#pragma unroll
    for (int j = 0; j < 8; ++j) { const unsigned long long yq = yb[j];
        const f32x4 yv = {__uint_as_float((unsigned)yq << 16), __uint_as_float((unsigned)yq & 0xffff0000u), __uint_as_float((unsigned)(yq >> 32) << 16), __uint_as_float((unsigned)(yq >> 32) & 0xffff0000u)};
        __builtin_nontemporal_store(xv[j] + yv * r * gv[j], &y4[64 * j]); }
}
__device__ __forceinline__ void p5_final(Frame& F) {
    const int tid_ = fresh_tid(), lane_ = tid_ & 63, wave_ = __builtin_amdgcn_readfirstlane(tid_ >> 6);
    const int gw = F.vcu * NWAVES + wave_, NGW = F.G * NWAVES;
    f32x4 gv[8]; { const GAS f32x4* g4 = (const GAS f32x4*)F.g_post + lane_;
#pragma unroll
        for (int j = 0; j < 8; ++j) gv[j] = g4[64 * j]; }
    if (!FUSE_RMS) {
        float sa, sb; unsigned long long ya[8], yb[8]; f32x4 xa[8], xb[8]; int m = gw;
        if (m < MP) p5_load(F, m, lane_, sa, ya, xa);
        while (m < MP) {
            int m2 = m + NGW; if (m2 < MP) p5_load(F, m2, lane_, sb, yb, xb);
            p5_finish(F, m, lane_, sa, ya, xa, gv); m = m2; if (m >= MP) break;
            m2 = m + NGW; if (m2 < MP) p5_load(F, m2, lane_, sa, ya, xa);
            p5_finish(F, m, lane_, sb, yb, xb, gv); m = m2; }
    }
    for (int m = MP + gw; m < MREAL; m += NGW) {
        float s = F.SSQS[(size_t)(m - MP) * 128 + lane_] + F.SSQS[(size_t)(m - MP) * 128 + 64 + lane_];
        s = wave_sum(s);
        const float r = 1.0f / sqrtf(s * (1.0f / DM) + RMS_EPS);
        GAS f32x4* y4 = (GAS f32x4*)(F.out + (size_t)16777216 + (size_t)(m - MP) * DM) + lane_; const GAS f32x4* x4 = (const GAS f32x4*)(F.x_sample + (size_t)(m - MP) * DM) + lane_;
#pragma unroll
        for (int j = 0; j < 8; ++j) { const f32x4 yv = y4[64 * j], xv = x4[64 * j]; y4[64 * j] = xv + yv * r * gv[j]; }
    }
}

constexpr int IT_BDP = 192, IT_BDS = 48, IT_SBP = 192, IT_SBS = 48, IT_MMP = 128, IT_MMS = 32;
constexpr int IT_TOTAL = IT_BDP + IT_BDS + IT_SBP + IT_SBS + IT_MMP + IT_MMS;
struct ArgsK { const void* in[19]; float* out; unsigned char* ws; int ph_lo, ph_hi; };
struct ItemSrc {
    const ArgsK* ka; unsigned char* ws;
    __device__ __forceinline__ GAS bf16* W(size_t off) const { return (GAS bf16*)(ws + off); }
    __device__ __forceinline__ const GAS float* I(int k) const { return (const GAS float*)ka->in[k]; }
};
__device__ __forceinline__ att::Item make_item(const ItemSrc& S, int idx) {
    GAS bf16* const QSB = S.W(WS_QSB); GAS bf16* const KSB = S.W(WS_KSB); GAS bf16* const VSB = S.W(WS_VSB); GAS bf16* const GSB = S.W(WS_GSB);
    GAS bf16* const QBD = S.W(WS_QBD); GAS bf16* const KBD = S.W(WS_KBD); GAS bf16* const VBD = S.W(WS_VBD); GAS bf16* const GBD = S.W(WS_GBD);
    GAS bf16* const QMM = S.W(WS_QMM); GAS bf16* const GMM = S.W(WS_GMM); GAS bf16* const MK = S.W(WS_MK); GAS bf16* const MV = S.W(WS_MV); GAS bf16* const AUP = S.W(WS_AUP);
    att::Item it; it.dma = 0; it.bias = nullptr; it.kf = nullptr; it.vf = nullptr; it.ldf = 0; it.pf_lo = 0; it.pf_hi = 0; it.kb = nullptr; it.vb = nullptr; it.ldb = 0; it.pb_lo = 0; it.pb_hi = 0;
    if (idx < 48) idx += 192; else if (idx < 96) idx += 432 - 48; else if (idx < 128) idx += 608 - 96; else if (idx < 320) idx -= 128; else if (idx < 512) idx += 240 - 320; else idx += 480 - 512;
    if (idx < IT_BDP) {
        const int b = idx / 96, h = (idx / 16) % 6, cg = idx % 16; const size_t row0 = (size_t)b * SEQ + 256 * cg;
        it.mode = 1; it.rule = 2; it.Q = QBD + row0 * 768 + h * HD; it.ldq = 768; it.nq = 256; it.qpos0 = 256 * cg;
        it.kb = KBD + (size_t)b * SEQ * 768 + h * HD; it.vb = VBD + (size_t)b * SEQ * 768 + h * HD; it.ldb = 768; it.pb_lo = 0; it.pb_hi = SEQ;
        it.pv_lo = 0; it.pv_hi = SEQ; const int c_lo = (4 * cg - 8) > 0 ? (4 * cg - 8) : 0;
        it.kp_first = 64 * c_lo; it.kp_step = 64; it.ntiles = 4 * cg + 4 - c_lo; it.bias = S.I(11) + h * 513; it.dma = 1;
        it.O = AUP + row0 * DM + 768 + h * HD; it.ldo = DM; it.G = GBD + row0 * 768 + h * HD; it.ldg = 768; return it; }
    idx -= IT_BDP;
    if (idx < IT_BDS) {
        const int b = idx / 6, h = idx % 6; const size_t row0 = (size_t)MP + b * DS;
        it.mode = 1; it.rule = 0; it.Q = QBD + row0 * 768 + h * HD; it.ldq = 768; it.nq = DS; it.qpos0 = PAST;
        if (SLACK_P1) {
            it.kb = S.W(WS_KBC) + (size_t)b * 576 * 768 + h * HD; it.vb = S.W(WS_VBC) + (size_t)b * 576 * 768 + h * HD; it.ldb = 768; it.pb_lo = PAST - 512; it.pb_hi = PAST - 512 + 576; it.dma = 1;
        } else {
            it.kb = KBD + row0 * 768 + h * HD; it.vb = VBD + row0 * 768 + h * HD; it.ldb = 768; it.pb_lo = PAST; it.pb_hi = PAST + DS;
            it.kf = S.I(4) + (size_t)b * 512 * 768 + h * HD; it.vf = S.I(5) + (size_t)b * 512 * 768 + h * HD; it.ldf = 768; it.pf_lo = PAST - 512; it.pf_hi = PAST; }
        it.pv_lo = PAST - 512; it.pv_hi = PAST + DS; it.kp_first = PAST - 512; it.kp_step = 64; it.ntiles = 9; it.bias = S.I(11) + h * 513;
        it.O = AUP + row0 * DM + 768 + h * HD; it.ldo = DM; it.G = GBD + row0 * 768 + h * HD; it.ldg = 768; return it; }
    idx -= IT_BDS;
    if (idx < IT_SBP) {
        const int b = idx % 2, h = (idx / 2) % 6, qb = 15 - idx / 12; const size_t row0 = (size_t)b * SEQ + 256 * qb;
        it.mode = 0; it.rule = 1; it.Q = QSB + row0 * 768 + h * HD; it.ldq = 768; it.nq = 256; it.qpos0 = 256 * qb;
        it.kb = KSB + (size_t)b * SEQ * 768 + h * HD; it.vb = VSB + (size_t)b * SEQ * 768 + h * HD; it.ldb = 768; it.pb_lo = 0; it.pb_hi = SEQ;
        it.pv_lo = 0; it.pv_hi = SEQ; it.kp_first = 64 * (4 * qb + 3); it.kp_step = -64; it.ntiles = 4 * qb + 4; it.dma = 1;
        it.O = AUP + row0 * DM + h * HD; it.ldo = DM; it.G = GSB + row0 * 768 + h * HD; it.ldg = 768; return it; }
    idx -= IT_SBP;
    if (idx < IT_SBS) {
        const int b = idx / 6, h = idx % 6; const size_t row0 = (size_t)MP + b * DS;
        it.mode = 0; it.rule = 1; it.Q = QSB + row0 * 768 + h * HD; it.ldq = 768; it.nq = DS; it.qpos0 = PAST;
        it.kb = KSB + row0 * 768 + h * HD; it.vb = VSB + row0 * 768 + h * HD; it.ldb = 768; it.pb_lo = PAST; it.pb_hi = PAST + DS;
        it.kf = S.I(2) + (size_t)b * PAST * 768 + h * HD; it.vf = S.I(3) + (size_t)b * PAST * 768 + h * HD; it.ldf = 768; it.pf_lo = 0; it.pf_hi = PAST;
        it.pv_lo = 0; it.pv_hi = PAST + DS; it.kp_first = PAST + DS - 64; it.kp_step = -64; it.ntiles = (PAST + DS + 63) / 64;
        it.O = AUP + row0 * DM + h * HD; it.ldo = DM; it.G = GSB + row0 * 768 + h * HD; it.ldg = 768; return it; }
    idx -= IT_SBS;
    if (idx < IT_MMP) {
        const int b = idx / 64, h = (idx / 16) % 4, qb = idx % 16; const size_t row0 = (size_t)b * SEQ + 256 * qb;
        it.mode = 1; it.rule = 0; it.Q = QMM + row0 * 512 + h * HD; it.ldq = 512; it.nq = 256; it.qpos0 = 0;
        it.kb = MK + (size_t)b * NMEM * 512 + h * HD; it.vb = MV + (size_t)b * NMEM * 512 + h * HD; it.ldb = 512; it.pb_lo = 0; it.pb_hi = NMEM;
        it.pv_lo = 0; it.pv_hi = NMEM; it.kp_first = 0; it.kp_step = 64; it.ntiles = 4; it.dma = 1;
        it.O = AUP + row0 * DM + 1536 + h * HD; it.ldo = DM; it.G = GMM + row0 * 512 + h * HD; it.ldg = 512; return it; }
    idx -= IT_MMP;
    {
        const int b = idx / 4, h = idx % 4; const size_t row0 = (size_t)MP + b * DS;
        it.mode = 1; it.rule = 0; it.Q = QMM + row0 * 512 + h * HD; it.ldq = 512; it.nq = DS; it.qpos0 = 0;
        if (SLACK_P1) { it.kb = S.W(WS_MKC) + (size_t)b * NMEM * 512 + h * HD; it.vb = S.W(WS_MVC) + (size_t)b * NMEM * 512 + h * HD; it.ldb = 512; it.pb_lo = 0; it.pb_hi = NMEM; it.dma = 1; }
        else { it.kf = S.I(6) + (size_t)b * NMEM * 512 + h * HD; it.vf = S.I(7) + (size_t)b * NMEM * 512 + h * HD; it.ldf = 512; it.pf_lo = 0; it.pf_hi = NMEM; }
        it.pv_lo = 0; it.pv_hi = NMEM; it.kp_first = 0; it.kp_step = 64; it.ntiles = 4;
        it.O = AUP + row0 * DM + 1536 + h * HD; it.ldo = DM; it.G = GMM + row0 * 512 + h * HD; it.ldg = 512; return it; }
}

struct Args { const void* in[19]; float* out; unsigned char* ws; int ph_lo, ph_hi; };
__global__ void __launch_bounds__(NWAVES * 64, 2) fwd_megakernel(Args args) {
    extern __shared__ __attribute__((aligned(16))) unsigned char lds[];
    Frame F;
    F.lds = (LAS unsigned char*)lds;
    F.MISC = (volatile LAS unsigned*)(F.lds + MISC_OFF);
    F.G = gridDim.x; { const int bx = blockIdx.x; F.vcu = (F.G % 8 == 0) ? (bx % 8) * (F.G / 8) + bx / 8 : bx; }
    unsigned char* ws = args.ws;
    F.ctl = (gu32*)(ws + WS_CTL);
    F.x_prompt = (const float*)args.in[0]; F.x_sample = (const float*)args.in[1]; F.c_sbk = (const float*)args.in[2]; F.c_sbv = (const float*)args.in[3];
    F.c_bdk = (const float*)args.in[4]; F.c_bdv = (const float*)args.in[5]; F.c_mk = (const float*)args.in[6]; F.c_mv = (const float*)args.in[7];
    F.mem_prompt = (const float*)args.in[8]; F.g_pre = (const float*)args.in[9]; F.w_in = (const float*)args.in[10]; F.rel_bias = (const float*)args.in[11];
    F.g_mem = (const float*)args.in[12]; F.w_mem_kv = (const float*)args.in[13]; F.w_up_sb = (const float*)args.in[14]; F.w_up_band = (const float*)args.in[15];
    F.w_up_mem = (const float*)args.in[16]; F.w_out = (const float*)args.in[17]; F.g_post = (const float*)args.in[18];
    F.out = args.out;
    F.WCAT = (bf16*)(ws + WS_WCAT); F.WUP = (bf16*)(ws + WS_WUP); F.WOUT = (bf16*)(ws + WS_WOUT); F.ACAT = (bf16*)(ws + WS_ACAT); F.MERGED = (bf16*)(ws + WS_ACAT);
    F.QSB = (bf16*)(ws + WS_QSB); F.KSB = (bf16*)(ws + WS_KSB); F.VSB = (bf16*)(ws + WS_VSB); F.GSB = (bf16*)(ws + WS_GSB);
    F.QBD = (bf16*)(ws + WS_QBD); F.KBD = (bf16*)(ws + WS_KBD); F.VBD = (bf16*)(ws + WS_VBD); F.GBD = (bf16*)(ws + WS_GBD);
    F.QMM = (bf16*)(ws + WS_QMM); F.GMM = (bf16*)(ws + WS_GMM); F.MG = (bf16*)(ws + WS_MG); F.MK = (bf16*)(ws + WS_MK); F.MV = (bf16*)(ws + WS_MV);
    F.AUP = (bf16*)(ws + WS_AUP); F.SSQ = (float*)(ws + WS_SSQ); F.SSQS = (float*)(ws + WS_SSQS); F.YB = (bf16*)(ws + WS_YB); F.KBC = (bf16*)(ws + WS_KBC); F.VBC = (bf16*)(ws + WS_VBC); F.MKC = (bf16*)(ws + WS_MKC); F.MVC = (bf16*)(ws + WS_MVC);
    for (int u = threadIdx.x; u < (STG_OFF - LDSCTL_OFF) / 4; u += NWAVES * 64) ((LAS unsigned*)(F.lds + LDSCTL_OFF))[u] = 0u;
    __syncthreads();
    XcdBarrier bar; bar.bar = (unsigned*)(F.ctl + CW_BAR); bar.x = 0; bar.st = nullptr;
    if (N_LAUNCHES != PER_PHASE) bar = xcd_barrier_post((unsigned*)(F.ctl + CW_BAR), F.MISC + 8);
#define GRID_BAR() do { if (N_LAUNCHES != PER_PHASE) xcd_barrier(bar); } while (0)
    const int lo = args.ph_lo, hi = args.ph_hi;
#ifdef ONLY_PHASE
#define IN(k) ((k) == ONLY_PHASE && lo <= (k) && (k) < hi)
#else
#define IN(k) (lo <= (k) && (k) < hi)
#endif
#define BOTH(k) (IN(k) && IN((k) + 1))
#ifdef PROBE_PHASE
#define PROBE_T0(k) do { if ((k) == PROBE_PHASE && blockIdx.x == 0 && threadIdx.x == 0) { const unsigned long long t_ = __builtin_amdgcn_s_memrealtime(); F.MISC[20] = (unsigned)t_; F.MISC[21] = (unsigned)(t_ >> 32); } } while (0)
#define PROBE_T1(k) do { if ((k) == PROBE_PHASE) { if (blockIdx.x == 0 && threadIdx.x == 0) { const unsigned long long t1_ = __builtin_amdgcn_s_memrealtime(), t0_ = (unsigned long long)F.MISC[20] | ((unsigned long long)F.MISC[21] << 32); \
        const unsigned long long te_ = t1_ + (unsigned long long)(PROBE_K) * (t1_ - t0_); unsigned n_ = 0; while (__builtin_amdgcn_s_memrealtime() < te_ && ++n_ < (1u << 22)) __builtin_amdgcn_s_sleep(4); } \
        __syncthreads(); GRID_BAR(); } } while (0)
#else
#define PROBE_T0(k) do { } while (0)
#define PROBE_T1(k) do { } while (0)
#endif
    if (IN(0)) { PROBE_T0(0); p0_prologue(F); if (BOTH(0)) GRID_BAR(); PROBE_T1(0); }
    if (IN(1)) {
        PROBE_T0(1);
        pg8::Gemm g{F.ACAT, F.WCAT, MA, NCAT, DM}; ep::InOrder S; S.init(F.G, (int)blockIdx.x);
        ep::EpiIn E{F.QSB, F.KSB, F.VSB, F.GSB, F.QBD, F.KBD, F.VBD, F.GBD, F.QMM, F.GMM, F.MG, F.MK, F.MV, F.out, F.lds + STG_OFF, F.KBC, F.VBC};
        {
        pg8::gemm_phase<ep::EpiIn, ep::InOrder, true, true>(F.lds, g, S, E);
        if (SLACK_P1) {
            volatile LAS int* sl = (volatile LAS int*)(F.MISC + 12);
            for (;;) {
                if (threadIdx.x == 0) *sl = (int)__hip_atomic_fetch_add((unsigned*)(F.ctl + CW_WORK + 64), 1u, RLX_AGENT);
                __syncthreads();
                const int j = __builtin_amdgcn_readfirstlane(*sl);
                __syncthreads();
                if (j >= SLACK_ITEMS) break;
                slack_item(F, j);
            }
        }
        if (BOTH(1)) GRID_BAR(); }
        PROBE_T1(1);
    }
    if (IN(2)) {
        static_assert(SLACK_P1 || !LATE_WT, "the late transposes run in P1's slack");
        PROBE_T0(2);
        volatile LAS int* slot = (volatile LAS int*)(F.lds + att::OFF_ITEM);
        for (;;) {
            if (threadIdx.x == 0) *slot = (int)__hip_atomic_fetch_add((unsigned*)(F.ctl + CW_WORK), 1u, RLX_AGENT);
            __syncthreads();
            const int idx = __builtin_amdgcn_readfirstlane(*slot);
            __syncthreads();
#ifdef PROBE_P2_N
            if (idx >= IT_TOTAL + PROBE_P2_N) break;
            const int qidx = idx < PROBE_P2_N ? PROBE_P2_BASE + idx : idx - PROBE_P2_N;
#else
            if (idx >= IT_TOTAL) break;
            const int qidx = idx;
#endif
            const ArgsK* ka = (const ArgsK*)__builtin_amdgcn_kernarg_segment_ptr(); unsigned char* wsl = args.ws;
            asm volatile("" : "+s"(ka), "+s"(wsl));
            const ItemSrc isrc{ka, wsl};
            const att::Item it = make_item(isrc, qidx);
            if (it.dma) { if (it.mode == 0) att::run_item<0, true>(it, (char*)lds, F.lds); else att::run_item<1, true>(it, (char*)lds, F.lds); }
            else { if (it.mode == 0) att::run_item<0, false>(it, (char*)lds, F.lds); else att::run_item<1, false>(it, (char*)lds, F.lds); }
        }
        if (BOTH(2)) GRID_BAR();
        PROBE_T1(2);
    }
    if (IN(3)) {
        PROBE_T0(3);
        pg8::Gemm g{F.AUP, F.WUP, MIN_, DM, DM}; ep::MergeOrder S; S.init(F.G, (int)blockIdx.x);
        ep::EpiMerge E{F.MG, F.MERGED};
        const bool skf = (F.vcu & 1) != 0;
        int two = 2; asm volatile("" : "+s"(two));
#pragma unroll 1
        for (int pass = 0; pass < two; ++pass) {
            if (skf == (pass == 0)) for (int sl = F.vcu; sl < 256; sl += F.G) ep::skinny_phase<0>(F.AUP, F.WUP, F.MG, F.MERGED, nullptr, nullptr, sl, F.lds);
            if (pass == 0) pg8::gemm_phase<ep::EpiMerge, ep::MergeOrder, true, true>(F.lds, g, S, E);
        }
        if (BOTH(3)) GRID_BAR();
        PROBE_T1(3);
    }
    if (IN(4)) {
        PROBE_T0(4);
        pg8::Gemm g{F.MERGED, F.WOUT, MP, DM, DM}; pg8::StaticOrder S; S.init(MP, DM, F.G, (int)blockIdx.x);
#if FUSE_RMS
        ep::EpiOutFused E{F.x_prompt, F.out, F.g_post, (float*)(ws + WS_XBUF), (unsigned*)(F.ctl + CW_PANEL), (unsigned*)(F.ctl + CW_TMO)};
        {
        pg8::gemm_phase<ep::EpiOutFused, pg8::StaticOrder, false, true>(F.lds, g, S, E);
        for (int sl = F.vcu; sl < 256; sl += F.G) ep::skinny_phase<1>(F.MERGED, F.WOUT, nullptr, nullptr, F.out + 16777216, F.SSQS, sl, F.lds);
#else
        ep::EpiOut E{F.YB, F.SSQ};
        {
        const bool skf = (F.vcu & 1) != 0;
        int two = 2; asm volatile("" : "+s"(two));
#pragma unroll 1
        for (int pass = 0; pass < two; ++pass) {
            if (skf == (pass == 0)) for (int sl = F.vcu; sl < 256; sl += F.G) ep::skinny_phase<1>(F.MERGED, F.WOUT, nullptr, nullptr, F.out + 16777216, F.SSQS, sl, F.lds);
            if (pass == 0) pg8::gemm_phase<ep::EpiOut, pg8::StaticOrder, true, true>(F.lds, g, S, E);
        }
#endif
        if (BOTH(4)) GRID_BAR(); }
        PROBE_T1(4);
    }
    if (IN(5)) p5_final(F);
#undef IN
#undef BOTH
#undef GRID_BAR
#undef PROBE_T0
#undef PROBE_T1
}

extern "C" void kernel_launch(void* const* d_in, const int* in_sizes, int n_in, void* d_out, int out_size, void* d_ws, size_t ws_size, hipStream_t stream) {
    static int grid = 0;
    if (grid == 0) {
        if (n_in != 19 || in_sizes[0] != MP * DM || in_sizes[10] != DM * INW || out_size != OUT_ELEMS || ws_size < WS_END) {
            fprintf(stderr, "kernel_launch: built for 19 inputs, x_prompt %d, w_in %d, out %d floats, >= %zu bytes of workspace; got n_in %d, in0 %d, in10 %d, out %d, ws %zu; nothing launched\n",
                    MP * DM, DM * INW, OUT_ELEMS, (size_t)WS_END, n_in, n_in > 0 ? in_sizes[0] : -1, n_in > 10 ? in_sizes[10] : -1, out_size, ws_size);
            grid = -1; return; }
        int dev = 0, cus = 0, per_cu = 0;
        if (hipGetDevice(&dev) != hipSuccess || hipDeviceGetAttribute(&cus, hipDeviceAttributeMultiprocessorCount, dev) != hipSuccess) { fprintf(stderr, "kernel_launch: device query failed\n"); grid = -1; return; }
        if (hipFuncSetAttribute((const void*)fwd_megakernel, hipFuncAttributeMaxDynamicSharedMemorySize, LDS_BYTES) != hipSuccess) { fprintf(stderr, "kernel_launch: hipFuncSetAttribute(%d B LDS) failed\n", LDS_BYTES); grid = -1; return; }
        if (hipOccupancyMaxActiveBlocksPerMultiprocessor(&per_cu, (const void*)fwd_megakernel, NWAVES * 64, LDS_BYTES) != hipSuccess || per_cu < 1) {
            fprintf(stderr, "kernel_launch: occupancy query reports %d workgroups per CU; nothing launched\n", per_cu); (void)hipGetLastError(); grid = -1; return; }
        grid = cus;
    }
    if (grid < 0) return;
    if (hipMemsetAsync((char*)d_ws + WS_CTL, 0, CTL_ZERO_BYTES, stream) != hipSuccess) { fprintf(stderr, "kernel_launch: hipMemsetAsync failed\n"); return; }
    Args a{};
    for (int i = 0; i < 19; ++i) a.in[i] = d_in[i];
    a.out = (float*)d_out; a.ws = (unsigned char*)d_ws;
    if (N_LAUNCHES == 1) {
        a.ph_lo = 0; a.ph_hi = PER_PHASE;
        hipLaunchKernelGGL(fwd_megakernel, dim3(grid), dim3(NWAVES * 64), LDS_BYTES, stream, a);
    } else {
        for (int li = 0; li < PER_PHASE; ++li) { a.ph_lo = li; a.ph_hi = li + 1; hipLaunchKernelGGL(fwd_megakernel, dim3(grid), dim3(NWAVES * 64), LDS_BYTES, stream, a); }
    }
    const hipError_t le = hipPeekAtLastError();
    if (le != hipSuccess) fprintf(stderr, "kernel_launch: launch failed: %s (grid %d)\n", hipGetErrorName(le), grid);
}
```

```cpp
#include <hip/hip_runtime.h>
#include <hip/hip_bf16.h>
#include <cstdio>
#include <cstdint>

#ifndef MK_N_LAUNCHES
#define MK_N_LAUNCHES 1
#endif
#ifndef FUSE_RMS
#define FUSE_RMS 0
#endif
#ifndef LATE_WT
#define LATE_WT 1
#endif
#ifndef SLACK_P1
#define SLACK_P1 1
#endif
#ifndef SB_EARLY_EXIT
#define SB_EARLY_EXIT 1
#endif

constexpr int DM = 2048, SEQ = 4096, NB = 2, DB = 8, DS = 16, PAST = 4096, HD = 128;
constexpr int MP = NB * SEQ;
constexpr int MS = DB * DS;
constexpr int MIN_ = 8448;
constexpr int MREAL = MP + MS;
constexpr int MMEM0 = 8448;
constexpr int MA = 8960;
constexpr int INW = 13312, NCAT = 14336;
constexpr int NMEM = 256;
constexpr float RMS_EPS = 1e-6f;
constexpr float LOG2E = 1.4426950408889634f;
constexpr float QSCALE = 0.08838834764831845f * 1.4426950408889634f;

namespace pg8 {
#define PG8_LAS __attribute__((address_space(3)))
typedef unsigned short bf16_t;
typedef short bf16x8 __attribute__((ext_vector_type(8)));
typedef float f32x4 __attribute__((ext_vector_type(4)));
typedef unsigned u32x4 __attribute__((ext_vector_type(4)));
constexpr int BM = 256, BK = 64, HALF = 128, HTB = HALF * BK * 2  , STAGE_BYTES = 8 * HTB, NXCD = 8, WGM = 8;

__host__ __device__ __forceinline__ int lds_byte(int r, int c) { const int st = (r >> 4) * 2 + (c >> 5), rr = r & 15, cc = c & 31, ob = rr * 64 + cc * 2; return st * 1024 + (ob ^ (((ob >> 9) & 1) << 5)); }
__host__ __device__ __forceinline__ void stage_rc(int b, int& R, int& C) { const int st = b / 1024, sb = b % 1024, swz = sb ^ (((sb >> 9) & 1) << 5); R = (st >> 1) * 16 + swz / 64; C = (st & 1) * 32 + (swz % 64) / 2; }
__host__ __device__ __forceinline__ int perm32(int rho) { const int n = rho >> 4, i = rho & 15; return 8 * (i >> 2) + 4 * n + (i & 3); }

struct Unit { int pm, pn, k0, nt; };
struct Gemm { const bf16_t* A; const bf16_t* Bt; int M, N, K; };

struct StaticOrder {
    int nM, nN, nwg, G, c;
    __host__ __device__ void init(int M, int N, int G_, int c_) { nM = M / BM; nN = N / BM; nwg = nM * nN; G = G_; c = c_; }
    __host__ __device__ bool next(int i, Unit& u) const {
        const long L = (long)i * G + c; if (L >= nwg) return false;
        int wgid = (int)L; { const int q = nwg / NXCD, r = nwg % NXCD, xcd = wgid % NXCD, off = wgid / NXCD; wgid = (xcd < r ? xcd * (q + 1) : r * (q + 1) + (xcd - r) * q) + off; }
        const int nig = WGM * nN, gid = wgid / nig, fm = gid * WGM, gsz = (nM - fm) < WGM ? (nM - fm) : WGM;
        u.pm = fm + ((wgid % nig) % gsz); u.pn = (wgid % nig) / gsz; u.k0 = 0; u.nt = 0; return true;
    }
    __device__ __forceinline__ void a_ready(const Unit&) const {}
    __device__ __forceinline__ void done(const Unit&) const {}
};

typedef float f32x2_t __attribute__((ext_vector_type(2))); typedef __bf16 bf16x2_t __attribute__((ext_vector_type(2)));
__device__ __forceinline__ unsigned cvt_pk_bf16(float lo, float hi) { f32x2_t v = {lo, hi}; bf16x2_t b = __builtin_convertvector(v, bf16x2_t); return __builtin_bit_cast(unsigned, b); }

template <class Epi, class Sched, bool ALIGN_EPI = false, bool SP2 = false>
__device__ __forceinline__ void gemm_phase(PG8_LAS unsigned char* lds, const Gemm g, const Sched& S, const Epi& E) {
    int tid_ = threadIdx.x; asm volatile("" : "+v"(tid_));
    const int tid = tid_, wid = __builtin_amdgcn_readfirstlane(tid >> 6), lane = tid & 63, wr = wid >> 2, wc = wid & 3, fr = lane & 15, fq = lane >> 4;
    const int K = g.K, nt = K / BK;
    unsigned voffA[2], voffB[2];
#pragma unroll
    for (int i = 0; i < 2; ++i) { int R, C; stage_rc(tid * 16 + i * 8192, R, C); const int Rb = Epi::PERM ? ((R & ~31) + perm32(R & 31)) : R;
        voffA[i] = (unsigned)(R * K + C) * 2u; voffB[i] = (unsigned)(Rb * K + C) * 2u; }
    const size_t kstep = (size_t)(BK * 2);
    const size_t hstep = (size_t)HALF * K * 2;
    const size_t tstep = 2 * hstep;
    const unsigned ldsw = (unsigned)wid * 1024u;
    const int aoff = lds_byte(wr * 64 + fr, fq * 8), boff = lds_byte(wc * 32 + fr, fq * 8);
#define PG8_SA(b, h) (((b) * 2 + (h)) * HTB)
#define PG8_SB(b, h) ((4 + (b) * 2 + (h)) * HTB)
#define PG8_STAGE(bufoff, gbase, voff) do { _Pragma("unroll") for (int _i = 0; _i < 2; ++_i) \
        __builtin_amdgcn_global_load_lds((const unsigned*)((const char*)(gbase) + (voff)[_i]), (PG8_LAS unsigned*)(lds + (bufoff) + ldsw + _i * 8192), 16, 0, 0); } while (0)
#define PG8_LDA(dst, b, h) do { _Pragma("unroll") for (int m = 0; m < 4; ++m) _Pragma("unroll") for (int k = 0; k < 2; ++k) dst[m][k] = *(const PG8_LAS bf16x8*)(lds + PG8_SA(b, h) + aoff + m * 2048 + k * 1024); } while (0)
#define PG8_LDB(dst, b, h) do { _Pragma("unroll") for (int n = 0; n < 2; ++n) _Pragma("unroll") for (int k = 0; k < 2; ++k) dst[n][k] = *(const PG8_LAS bf16x8*)(lds + PG8_SB(b, h) + boff + n * 2048 + k * 1024); } while (0)
#define PG8_MMA(ai, bj, At, Bt) do { __builtin_amdgcn_s_setprio(1); _Pragma("unroll") for (int m = 0; m < 4; ++m) _Pragma("unroll") for (int n = 0; n < 2; ++n) _Pragma("unroll") for (int k = 0; k < 2; ++k) \
        acc[ai][bj][m][n] = __builtin_amdgcn_mfma_f32_16x16x32_bf16(Bt[n][k], At[m][k], acc[ai][bj][m][n], 0, 0, 0); __builtin_amdgcn_s_setprio(0); } while (0)
#define PG8_WAIT_V(n) asm volatile("s_waitcnt vmcnt(" #n ")" ::: "memory")
#define PG8_WAIT_L(n) asm volatile("s_waitcnt lgkmcnt(" #n ")" ::: "memory")
#define PG8_BAR __builtin_amdgcn_s_barrier()
#define PG8_SCHED __builtin_amdgcn_sched_barrier(0)
    Unit cur, nxt; int ui = 0;
    if (!S.next(0, cur)) return;
    f32x4 acc[2][2][4][2];
#pragma unroll
    for (int a = 0; a < 2; ++a)
#pragma unroll
        for (int b = 0; b < 2; ++b)
#pragma unroll
            for (int m = 0; m < 4; ++m)
#pragma unroll
                for (int n = 0; n < 2; ++n) acc[a][b][m][n] = (f32x4){0.f, 0.f, 0.f, 0.f};
    bf16x8 At[4][2], B0[2][2], B1[2][2];
    const char* cA = (const char*)g.A + (size_t)cur.pm * tstep + (size_t)cur.k0 * 2; const char* cB = (const char*)g.Bt + (size_t)cur.pn * tstep + (size_t)cur.k0 * 2;
    S.a_ready(cur);
    if constexpr (SP2) {
        PG8_STAGE(PG8_SB(0, 0), cB, voffB); PG8_STAGE(PG8_SB(0, 1), cB + hstep, voffB); PG8_STAGE(PG8_SA(0, 0), cA, voffA); PG8_STAGE(PG8_SA(0, 1), cA + hstep, voffA);
        if (wr == 1) PG8_BAR;
        PG8_WAIT_V(2); PG8_BAR;
        PG8_STAGE(PG8_SB(1, 0), cB + kstep, voffB); PG8_STAGE(PG8_SA(1, 0), cA + kstep, voffA); PG8_STAGE(PG8_SB(1, 1), cB + hstep + kstep, voffB);
        PG8_WAIT_V(6); PG8_BAR;
    } else {
        PG8_STAGE(PG8_SB(0, 0), cB, voffB); PG8_STAGE(PG8_SA(0, 0), cA, voffA); PG8_STAGE(PG8_SB(0, 1), cB + hstep, voffB); PG8_STAGE(PG8_SA(0, 1), cA + hstep, voffA);
        if (wr == 1) PG8_BAR;
        PG8_WAIT_V(4); PG8_BAR;
        PG8_STAGE(PG8_SB(1, 0), cB + kstep, voffB); PG8_STAGE(PG8_SA(1, 0), cA + kstep, voffA); PG8_STAGE(PG8_SB(1, 1), cB + hstep + kstep, voffB);
        PG8_WAIT_V(6); PG8_BAR;
    }
    for (;;) {
        const bool has_next = S.next(ui + 1, nxt);
        const char* nA = has_next ? (const char*)g.A + (size_t)nxt.pm * tstep + (size_t)nxt.k0 * 2 : cA; const char* nB = has_next ? (const char*)g.Bt + (size_t)nxt.pn * tstep + (size_t)nxt.k0 * 2 : cB;
        const int ntu = cur.nt ? cur.nt : nt;
        for (int t = 0; t < ntu; t += 2) {
            const bool last = (t == ntu - 2);
            const char* a1 = cA + (size_t)(t + 1) * kstep;
            const char* a2 = last ? nA : cA + (size_t)(t + 2) * kstep; const char* b2 = last ? nB : cB + (size_t)(t + 2) * kstep;
            const char* a3 = a2 + kstep; const char* b3 = b2 + kstep;
            if (last && has_next) S.a_ready(nxt);
            if constexpr (SP2) {
            PG8_LDB(B0, 0, 0); PG8_LDB(B1, 0, 1); PG8_SCHED; PG8_LDA(At, 0, 0); PG8_STAGE(PG8_SA(1, 1), a1 + hstep, voffA);
            PG8_WAIT_V(8); PG8_WAIT_L(0); PG8_BAR; PG8_MMA(0, 0, At, B0); PG8_MMA(0, 1, At, B1); PG8_BAR; PG8_SCHED;
            PG8_LDA(At, 0, 1); PG8_STAGE(PG8_SB(0, 0), b2, voffB); PG8_STAGE(PG8_SB(0, 1), b2 + hstep, voffB); PG8_STAGE(PG8_SA(0, 0), a2, voffA);
            PG8_WAIT_V(8); PG8_WAIT_L(0); PG8_BAR; PG8_MMA(1, 0, At, B0); PG8_MMA(1, 1, At, B1); PG8_BAR; PG8_SCHED;
            PG8_LDB(B0, 1, 0); PG8_LDB(B1, 1, 1); PG8_SCHED; PG8_LDA(At, 1, 0); PG8_STAGE(PG8_SA(0, 1), a2 + hstep, voffA);
            PG8_WAIT_V(8); PG8_WAIT_L(0); PG8_BAR; PG8_MMA(0, 0, At, B0); PG8_MMA(0, 1, At, B1); PG8_BAR; PG8_SCHED;
            PG8_LDA(At, 1, 1); PG8_STAGE(PG8_SB(1, 0), b3, voffB); PG8_STAGE(PG8_SB(1, 1), b3 + hstep, voffB); PG8_STAGE(PG8_SA(1, 0), a3, voffA);
            PG8_WAIT_V(8); PG8_WAIT_L(0); PG8_BAR; PG8_MMA(1, 0, At, B0); PG8_MMA(1, 1, At, B1); PG8_BAR; PG8_SCHED;
            } else {
            PG8_LDB(B0, 0, 0); PG8_SCHED; PG8_LDA(At, 0, 0); PG8_STAGE(PG8_SA(1, 1), a1 + hstep, voffA);
            PG8_WAIT_L(8); PG8_BAR; PG8_WAIT_L(0); PG8_MMA(0, 0, At, B0); PG8_BAR; PG8_SCHED;
            PG8_LDB(B1, 0, 1); PG8_STAGE(PG8_SB(0, 0), b2, voffB);
            PG8_BAR; PG8_WAIT_L(0); PG8_MMA(0, 1, At, B1); PG8_BAR;
            PG8_LDA(At, 0, 1); PG8_STAGE(PG8_SA(0, 0), a2, voffA);
            PG8_BAR; PG8_WAIT_L(0); PG8_MMA(1, 0, At, B0); PG8_BAR; PG8_SCHED;
            PG8_STAGE(PG8_SB(0, 1), b2 + hstep, voffB);
            PG8_WAIT_V(6); PG8_BAR; PG8_MMA(1, 1, At, B1); PG8_BAR;
            PG8_LDB(B0, 1, 0); PG8_SCHED; PG8_LDA(At, 1, 0); PG8_STAGE(PG8_SA(0, 1), a2 + hstep, voffA);
            PG8_WAIT_L(8); PG8_BAR; PG8_WAIT_L(0); PG8_MMA(0, 0, At, B0); PG8_BAR; PG8_SCHED;
            PG8_LDB(B1, 1, 1); PG8_STAGE(PG8_SB(1, 0), b3, voffB);
            PG8_BAR; PG8_WAIT_L(0); PG8_MMA(0, 1, At, B1); PG8_BAR;
            PG8_LDA(At, 1, 1); PG8_STAGE(PG8_SA(1, 0), a3, voffA);
            PG8_BAR; PG8_WAIT_L(0); PG8_MMA(1, 0, At, B0); PG8_BAR; PG8_SCHED;
            PG8_STAGE(PG8_SB(1, 1), b3 + hstep, voffB);
            PG8_WAIT_V(6); PG8_BAR; PG8_MMA(1, 1, At, B1); PG8_BAR;
            }
        }
        if constexpr (ALIGN_EPI) { if (wr == 0) PG8_BAR; }
        if constexpr (!Epi::AFTER_DRAIN) { E(acc, cur, wr, wc, fr, fq); S.done(cur); }
        if (!has_next) break;
        if (E.reset_after(cur))
#pragma unroll
        for (int a = 0; a < 2; ++a)
#pragma unroll
            for (int b = 0; b < 2; ++b)
#pragma unroll
                for (int m = 0; m < 4; ++m)
#pragma unroll
                    for (int n = 0; n < 2; ++n) acc[a][b][m][n] = (f32x4){0.f, 0.f, 0.f, 0.f};
        cur = nxt; cA = nA; cB = nB; ++ui;
        if constexpr (ALIGN_EPI) { if (wr == 1) PG8_BAR; }
    }
    PG8_WAIT_V(0);
    if constexpr (!ALIGN_EPI) { if (wr == 0) PG8_BAR; }
    PG8_BAR;
    if constexpr (Epi::AFTER_DRAIN) { E.fused(acc, cur, wr, wc, fr, fq, lds, wid, lane); S.done(cur); }
#undef PG8_SA
#undef PG8_SB
#undef PG8_STAGE
#undef PG8_LDA
#undef PG8_LDB
#undef PG8_MMA
#undef PG8_WAIT_V
#undef PG8_WAIT_L
#undef PG8_BAR
#undef PG8_SCHED
}
}

namespace ep {
using pg8::f32x4; using pg8::u32x4; using pg8::Unit; using pg8::bf16_t; using pg8::HALF; using pg8::BM; using pg8::cvt_pk_bf16;
typedef unsigned u32x2 __attribute__((ext_vector_type(2)));

struct InOrder {
    pg8::StaticOrder so; int G, c;
    __device__ void init(int G_, int c_) { so.init(MIN_, INW, G_, c_); G = G_; c = c_; }
    __device__ bool next(int i, Unit& u) const {
        const long L = (long)i * G + c;
        if (L < so.nwg) return so.next(i, u);
        const int j = (int)(L - so.nwg); if (j >= 8) return false;
        u.pm = 33 + (j & 1); u.pn = 52 + (j >> 1); u.k0 = 0; u.nt = 0; return true;
    }
    __device__ __forceinline__ void a_ready(const Unit&) const {}
    __device__ __forceinline__ void done(const Unit&) const {}
};

__device__ __forceinline__ size_t mg_off(int pm, int pn, int seg, int wave, int ai, int m, int bj, int lane) { return ((size_t)((pm * 8 + pn) * 3 + seg) << 16) + wave * 8192 + ((ai * 4 + m) * 2 + bj) * 512 + lane * 8; }
__device__ __forceinline__ float sigmoidf_fast(float x) { return __builtin_amdgcn_rcpf(1.0f + __builtin_amdgcn_exp2f(-x * LOG2E)); }
__device__ __forceinline__ float bf2f(unsigned short h) { return __uint_as_float((unsigned)h << 16); }

struct EpiIn {
    static constexpr bool PERM = true, AFTER_DRAIN = false;
    bf16_t *QSB, *KSB, *VSB, *GSB, *QBD, *KBD, *VBD, *GBD, *QMM, *GMM, *MG, *MK, *MV;
    float* out;
    __attribute__((address_space(3))) unsigned char* stg;
    bf16_t *KBC, *VBC;
    __device__ __forceinline__ bool reset_after(const Unit&) const { return true; }
    template <int ACT, int F32>
    __device__ __forceinline__ void store(const f32x4 (&acc)[2][2][4][2], bf16_t* dst, int ldc, int colt, int rowoff, int pm, float* f0, float* f1, int wr, int wc, int fr, int fq, bf16_t* bdc = nullptr) const {
        const int col0 = colt + wc * 32 + 8 * fq;
#pragma unroll
        for (int ai = 0; ai < 2; ++ai)
#pragma unroll
            for (int m = 0; m < 4; ++m) {
                const int r = pm * BM + ai * HALF + wr * 64 + m * 16 + fr;
                bf16_t* rowp = dst + (size_t)(r - rowoff) * ldc + col0;
                float* frow = nullptr;
                if (F32 == 1) { if (r < MP) frow = f0 + (size_t)r * 768; else if (r < MREAL) frow = f1 + (size_t)(r - MP) * 768; }
                if (F32 == 2) { if (r < MP) { const int t = r & (SEQ - 1); if (t >= SEQ - 512) frow = f0 + ((size_t)(r >> 12) * 512 + (t - (SEQ - 512))) * 768; } else if (r < MREAL) frow = f1 + (size_t)(r - MP) * 768; }
                if (F32 == 3) frow = f0 + (size_t)(r - MMEM0) * 512;
#pragma unroll
                for (int bj = 0; bj < 2; ++bj) {
                    f32x4 v0 = acc[ai][bj][m][0], v1 = acc[ai][bj][m][1];
                    if (F32 != 0) { if (frow) { __builtin_nontemporal_store(v0, (f32x4*)(frow + col0 + bj * HALF)); __builtin_nontemporal_store(v1, (f32x4*)(frow + col0 + bj * HALF + 4)); } }
                    if (ACT == 1) { v0 = v0 * QSCALE; v1 = v1 * QSCALE; }
                    if (ACT == 2) {
#pragma unroll
                        for (int e = 0; e < 4; ++e) { v0[e] = v0[e] * sigmoidf_fast(v0[e]); v1[e] = v1[e] * sigmoidf_fast(v1[e]); } }
                    if (ACT == 3) {
#pragma unroll
                        for (int e = 0; e < 4; ++e) { v0[e] = sigmoidf_fast(v0[e]); v1[e] = sigmoidf_fast(v1[e]); } }
                    u32x4 w; w.x = cvt_pk_bf16(v0[0], v0[1]); w.y = cvt_pk_bf16(v0[2], v0[3]); w.z = cvt_pk_bf16(v1[0], v1[1]); w.w = cvt_pk_bf16(v1[2], v1[3]);
                    *(u32x4*)(rowp + bj * HALF) = w;
                    if (F32 == 2 && SLACK_P1) { if (r >= MP && r < MREAL) *(u32x4*)(bdc + ((size_t)((r - MP) >> 4) * 576 + 512 + ((r - MP) & 15)) * 768 + col0 + bj * HALF) = w; } }
            }
    }
    __device__ __forceinline__ void store_gates(const f32x4 (&acc)[2][2][4][2], int t, int pm, int wr, int wc, int fr, int fq) const {
        typedef float f32x2 __attribute__((ext_vector_type(2)));
        typedef __attribute__((address_space(3))) u32x2 lu32x2; typedef __attribute__((address_space(3))) u32x4 lu32x4;
        const int sld = (t < 24) ? 768 : 512;
        bf16_t* const sdst = (t < 12) ? GSB + 64 * t : (t < 24 ? GBD + 64 * (t - 12) : GMM + 64 * (t - 24));
        constexpr float CAP = 1073741824.0f, NLN2 = -0.6931471805599453f;
        const int row32 = wr * 16 + fr;
        const int woff = row32 * 128 + ((wc ^ ((row32 >> 1) & 3)) << 5) + fq * 8;
        const int tid = threadIdx.x, kq = tid >> 8;
        const int mfr = tid & 15, mpart = (tid >> 4) & 7, mwr = (tid >> 7) & 1, mrow = mwr * 16 + mfr;
        const int moff = mrow * 128 + ((((mpart >> 1) ^ ((mrow >> 1) & 3)) << 5) | ((mpart & 1) << 4));
        const int mpn = t >> 2, mbj = (t & 3) >> 1, mwave = mwr * 4 + (t & 1) * 2 + (mpart >> 2), mlane = (mpart & 3) * 16 + mfr;
        const int rrow = (tid & 255) >> 3, part = tid & 7;
        const int roff = 12288 + rrow * 128 + ((((part >> 1) ^ ((rrow >> 1) & 3)) << 5) | ((part & 1) << 4));
        const int grow = pm * BM + (rrow >> 4) * 64 + (rrow & 15);
#pragma unroll
        for (int ai = 0; ai < 2; ++ai)
#pragma unroll
            for (int m = 0; m < 4; ++m) {
                u32x2 w1, w2, w3, ws;
#pragma unroll
                for (int h = 0; h < 2; ++h) {
                    const f32x2 x1 = {acc[ai][0][m][0][2 * h], acc[ai][0][m][0][2 * h + 1]}, x2 = {acc[ai][0][m][1][2 * h], acc[ai][0][m][1][2 * h + 1]};
                    const f32x2 x3 = {acc[ai][1][m][0][2 * h], acc[ai][1][m][0][2 * h + 1]}, xs = {acc[ai][1][m][1][2 * h], acc[ai][1][m][1][2 * h + 1]};
                    const f32x2 one = {1.0f, 1.0f};
                    const f32x2 d1 = (f32x2){fminf(__builtin_amdgcn_exp2f(x1.x), CAP), fminf(__builtin_amdgcn_exp2f(x1.y), CAP)} + one, d2 = (f32x2){fminf(__builtin_amdgcn_exp2f(x2.x), CAP), fminf(__builtin_amdgcn_exp2f(x2.y), CAP)} + one;
                    const f32x2 d3 = (f32x2){fminf(__builtin_amdgcn_exp2f(x3.x), CAP), fminf(__builtin_amdgcn_exp2f(x3.y), CAP)} + one, ds = (f32x2){fminf(__builtin_amdgcn_exp2f(xs.x), CAP), fminf(__builtin_amdgcn_exp2f(xs.y), CAP)} + one;
                    const f32x2 p12 = d1 * d2, p3s = d3 * ds, q = p12 * p3s;
                    const f32x2 rq = {__builtin_amdgcn_rcpf(q.x), __builtin_amdgcn_rcpf(q.y)};
                    const f32x2 i12 = rq * p3s, i3s = rq * p12;
                    const f32x2 g3 = i3s * ds, sg = (xs * NLN2) * (i3s * d3);
                    const f32x2 r1 = (d2 * d2) * i12, r2 = (d3 * d1) * i12;
                    w1[h] = cvt_pk_bf16(r1.x, r1.y); w2[h] = cvt_pk_bf16(r2.x, r2.y); w3[h] = cvt_pk_bf16(g3.x, g3.y); ws[h] = cvt_pk_bf16(sg.x, sg.y);
                }
                if (ai + m > 0) { asm volatile("s_waitcnt lgkmcnt(0)" ::: "memory"); __builtin_amdgcn_s_barrier(); }
                *(lu32x2*)(stg + woff) = w1; *(lu32x2*)(stg + 4096 + woff) = w2; *(lu32x2*)(stg + 8192 + woff) = w3; *(lu32x2*)(stg + 12288 + woff) = ws;
                asm volatile("s_waitcnt lgkmcnt(0)" ::: "memory"); __builtin_amdgcn_s_barrier(); asm volatile("" ::: "memory");
                const u32x4 va = *(const lu32x4*)(stg + kq * 4096 + moff), vb = *(const lu32x4*)(stg + (kq == 0 ? 8192 + moff : roff));
                *(u32x4*)(MG + mg_off(pm, mpn, kq, mwave, ai, m, mbj, mlane)) = va;
                if (kq == 0) *(u32x4*)(MG + mg_off(pm, mpn, 2, mwave, ai, m, mbj, mlane)) = vb;
                else *(u32x4*)(sdst + (size_t)(grow + ai * HALF + m * 16) * sld + part * 8) = vb;
            }
        asm volatile("s_waitcnt lgkmcnt(0)" ::: "memory");
    }
    __device__ __forceinline__ void operator()(const f32x4 (&acc)[2][2][4][2], const Unit& u, int wr, int wc, int fr, int fq) const {
        const int pn = u.pn, pm = u.pm;
        float* const o_sbk = out + 17039360, * const o_sbv = out + 23330816, * const o_bdk = out + 29622272, * const o_bdv = out + 30408704;
        float* const o_mk = out + 31195136, * const o_mv = out + 31457280;
        float* const s_sbk = out + 31719424, * const s_sbv = out + 31817728, * const s_bdk = out + 31916032, * const s_bdv = out + 32014336;
        if (pn < 3)        store<0, 0>(acc, QSB, 768, 256 * pn, 0, pm, nullptr, nullptr, wr, wc, fr, fq);
        else if (pn < 6)   store<0, 1>(acc, KSB, 768, 256 * (pn - 3), 0, pm, o_sbk, s_sbk, wr, wc, fr, fq);
        else if (pn < 9)   store<0, 1>(acc, VSB, 768, 256 * (pn - 6), 0, pm, o_sbv, s_sbv, wr, wc, fr, fq);
        else if (pn < 12)  store<0, 0>(acc, QBD, 768, 256 * (pn - 9), 0, pm, nullptr, nullptr, wr, wc, fr, fq);
        else if (pn < 15)  store<0, 2>(acc, KBD, 768, 256 * (pn - 12), 0, pm, o_bdk, s_bdk, wr, wc, fr, fq, KBC);
        else if (pn < 18)  store<0, 2>(acc, VBD, 768, 256 * (pn - 15), 0, pm, o_bdv, s_bdv, wr, wc, fr, fq, VBC);
        else if (pn < 20)  store<0, 0>(acc, QMM, 512, 256 * (pn - 18), 0, pm, nullptr, nullptr, wr, wc, fr, fq);
        else if (pn < 52)  store_gates(acc, pn - 20, pm, wr, wc, fr, fq);
        else if (pn < 54)  store<0, 3>(acc, MK, 512, 256 * (pn - 52), MMEM0, pm, o_mk, nullptr, wr, wc, fr, fq);
        else               store<0, 3>(acc, MV, 512, 256 * (pn - 54), MMEM0, pm, o_mv, nullptr, wr, wc, fr, fq);
    }
};

struct MergeOrder {
    pg8::StaticOrder so;
    __device__ void init(int G_, int c_) { so.init(MP, DM, G_, c_); }
    __device__ bool next(int i, Unit& u) const {
        const int ti = i / 3, seg = i - 3 * ti;
        if (!so.next(ti, u)) return false;
        u.k0 = 768 * seg; u.nt = (seg == 2) ? 8 : 12; return true;
    }
    __device__ __forceinline__ void a_ready(const Unit&) const {}
    __device__ __forceinline__ void done(const Unit&) const {}
};
struct EpiMerge {
    static constexpr bool PERM = true, AFTER_DRAIN = false;
    const bf16_t* MG; bf16_t* OUT;
    __device__ __forceinline__ bool reset_after(const Unit& u) const { return u.k0 == 1536; }
    __device__ __forceinline__ void operator()(f32x4 (&acc)[2][2][4][2], const Unit& u, int wr, int wc, int fr, int fq) const {
        const int col0 = u.pn * BM + wc * 32 + 8 * fq;
        const int seg = (u.k0 == 0) ? 0 : (u.k0 == 768 ? 1 : 2);
        const bool last = (seg == 2);
        u32x4 g[2][4][2];
#pragma unroll
        for (int ai = 0; ai < 2; ++ai)
#pragma unroll
            for (int m = 0; m < 4; ++m)
#pragma unroll
                for (int bj = 0; bj < 2; ++bj) g[ai][m][bj] = __builtin_nontemporal_load((const u32x4*)(MG + mg_off(u.pm, u.pn, seg, wr * 4 + wc, ai, m, bj, fq * 16 + fr)));
#pragma unroll
        for (int ai = 0; ai < 2; ++ai)
#pragma unroll
            for (int m = 0; m < 4; ++m) { bf16_t* rowp = OUT + (size_t)(u.pm * BM + ai * HALF + wr * 64 + m * 16 + fr) * DM + col0;
#pragma unroll
                for (int bj = 0; bj < 2; ++bj) {
#pragma unroll
                    for (int e = 0; e < 4; ++e) { acc[ai][bj][m][e >> 1][2 * (e & 1)] *= __uint_as_float(g[ai][m][bj][e] << 16); acc[ai][bj][m][e >> 1][2 * (e & 1) + 1] *= __uint_as_float(g[ai][m][bj][e] & 0xffff0000u); }
                    if (last) { u32x4 w; w.x = cvt_pk_bf16(acc[ai][bj][m][0][0], acc[ai][bj][m][0][1]); w.y = cvt_pk_bf16(acc[ai][bj][m][0][2], acc[ai][bj][m][0][3]);
                        w.z = cvt_pk_bf16(acc[ai][bj][m][1][0], acc[ai][bj][m][1][1]); w.w = cvt_pk_bf16(acc[ai][bj][m][1][2], acc[ai][bj][m][1][3]);
                        *(u32x4*)(rowp + bj * HALF) = w; } } }
    }
};

struct EpiOut {
    static constexpr bool PERM = true, AFTER_DRAIN = false;
    bf16_t* yb; float* ssq;
    __device__ __forceinline__ bool reset_after(const Unit&) const { return true; }
    __device__ __forceinline__ void operator()(const f32x4 (&acc)[2][2][4][2], const Unit& u, int wr, int wc, int fr, int fq) const {
        const int col0 = u.pn * BM + wc * 32 + 8 * fq;
#pragma unroll
        for (int ai = 0; ai < 2; ++ai)
#pragma unroll
            for (int m = 0; m < 4; ++m) {
                const int r = u.pm * BM + ai * HALF + wr * 64 + m * 16 + fr;
                bf16_t* yrow = yb + (size_t)r * DM + col0;
                float s = 0.f;
#pragma unroll
                for (int bj = 0; bj < 2; ++bj) { const f32x4 v0 = acc[ai][bj][m][0], v1 = acc[ai][bj][m][1];
                    s += ((v0[0] * v0[0] + v0[1] * v0[1]) + (v0[2] * v0[2] + v0[3] * v0[3])) + ((v1[0] * v1[0] + v1[1] * v1[1]) + (v1[2] * v1[2] + v1[3] * v1[3]));
                    u32x4 w; w.x = cvt_pk_bf16(v0[0], v0[1]); w.y = cvt_pk_bf16(v0[2], v0[3]); w.z = cvt_pk_bf16(v1[0], v1[1]); w.w = cvt_pk_bf16(v1[2], v1[3]);
                    *(u32x4*)(yrow + bj * HALF) = w; }
                s += __shfl_xor(s, 16); s += __shfl_xor(s, 32);
                if (fq == 0) ssq[(size_t)r * 32 + u.pn * 4 + wc] = s;
            }
    }
};

struct EpiOutFused {
    static constexpr bool PERM = false, AFTER_DRAIN = true;
    const float* x; float* out; const float* gpost; float* xbuf; unsigned* cnt; unsigned* tmo;
    __device__ __forceinline__ bool reset_after(const Unit&) const { return true; }
    __device__ __forceinline__ void operator()(const f32x4 (&)[2][2][4][2], const Unit&, int, int, int, int) const {}
    __device__ __forceinline__ void fused(f32x4 (&acc)[2][2][4][2], const Unit& u, int wr, int wc, int fr, int fq, __attribute__((address_space(3))) unsigned char* lds, int wid, int lane) const {
        typedef __attribute__((address_space(3))) float lfloat;
        lfloat* P = (lfloat*)lds;
        lfloat* S = (lfloat*)(lds + 4096);
        __attribute__((address_space(3))) unsigned* flag = (__attribute__((address_space(3))) unsigned*)(lds + 4096 + 1024);
        const int col0 = u.pn * BM + wc * 32 + 4 * fq;
        f32x4 pre[4][2][2];
#pragma unroll
        for (int m = 0; m < 4; ++m) { const size_t off = (size_t)(u.pm * BM + wr * 64 + m * 16 + fr) * DM + col0;
#pragma unroll
            for (int bj = 0; bj < 2; ++bj)
#pragma unroll
                for (int n = 0; n < 2; ++n) pre[m][bj][n] = *(const f32x4*)(x + off + bj * HALF + n * 16); }
#pragma unroll
        for (int ai = 0; ai < 2; ++ai)
#pragma unroll
            for (int m = 0; m < 4; ++m) { float s = 0.f;
#pragma unroll
                for (int bj = 0; bj < 2; ++bj)
#pragma unroll
                    for (int n = 0; n < 2; ++n) { const f32x4 v = acc[ai][bj][m][n]; s += (v[0] * v[0] + v[1] * v[1]) + (v[2] * v[2] + v[3] * v[3]); }
                s += __shfl_xor(s, 16); s += __shfl_xor(s, 32);
                if (fq == 0) P[(ai * HALF + wr * 64 + m * 16 + fr) * 4 + wc] = s; }
        asm volatile("s_waitcnt lgkmcnt(0)" ::: "memory"); __builtin_amdgcn_s_barrier(); asm volatile("" ::: "memory");
        const int row = wid * 32 + (lane & 31);
        if (lane < 32) { const float t = (P[row * 4 + 0] + P[row * 4 + 1]) + (P[row * 4 + 2] + P[row * 4 + 3]);
            __hip_atomic_store(xbuf + ((size_t)(u.pm * BM + row) * 8 + u.pn), t, __ATOMIC_RELAXED, __HIP_MEMORY_SCOPE_AGENT); }
        asm volatile("s_waitcnt vmcnt(0)" ::: "memory");
        if (lane == 0) __hip_atomic_fetch_add(cnt + 64 * u.pm, 1u, __ATOMIC_RELAXED, __HIP_MEMORY_SCOPE_AGENT);
        if (wid == 0) { bool dead = false; const unsigned long long t0 = __builtin_amdgcn_s_memrealtime();
            for (;;) {
                if ((unsigned)__builtin_amdgcn_readfirstlane(__hip_atomic_load(cnt + 64 * u.pm, __ATOMIC_RELAXED, __HIP_MEMORY_SCOPE_AGENT)) >= 64u) break;
                if (__builtin_amdgcn_s_memrealtime() - t0 > 2000000ull) { if (lane == 0) __hip_atomic_store(tmo, 1u, __ATOMIC_RELAXED, __HIP_MEMORY_SCOPE_AGENT); dead = true; break; }
                __builtin_amdgcn_s_sleep(2); }
            __builtin_amdgcn_fence(__ATOMIC_ACQUIRE, "agent");
            if (lane == 0) flag[0] = dead ? 1u : 0u; }
        asm volatile("s_waitcnt vmcnt(0) lgkmcnt(0)" ::: "memory"); __builtin_amdgcn_s_barrier(); asm volatile("" ::: "memory");
        const bool bad = flag[0] != 0u;
        if (lane < 32) { const float* slot = xbuf + (size_t)(u.pm * BM + row) * 8; float q = 0.f;
#pragma unroll
            for (int t = 0; t < 8; ++t) q += __hip_atomic_load(slot + t, __ATOMIC_RELAXED, __HIP_MEMORY_SCOPE_AGENT);
            S[row] = 1.0f / sqrtf(q * (1.0f / DM) + RMS_EPS); }
        asm volatile("s_waitcnt lgkmcnt(0)" ::: "memory"); __builtin_amdgcn_s_barrier(); asm volatile("" ::: "memory");
        f32x4 gv[2][2];
#pragma unroll
        for (int bj = 0; bj < 2; ++bj)
#pragma unroll
            for (int n = 0; n < 2; ++n) gv[bj][n] = *(const f32x4*)(gpost + col0 + bj * HALF + n * 16);
        const float qnan = __builtin_nanf("");
#pragma unroll
        for (int ai = 0; ai < 2; ++ai)
#pragma unroll
            for (int m = 0; m < 4; ++m) { const int r = ai * HALF + wr * 64 + m * 16 + fr; const float rs = S[r]; const size_t off = (size_t)(u.pm * BM + r) * DM + col0;
#pragma unroll
                for (int bj = 0; bj < 2; ++bj)
#pragma unroll
                    for (int n = 0; n < 2; ++n) { const f32x4 bs = ai == 0 ? pre[m][bj][n] : *(const f32x4*)(x + off + bj * HALF + n * 16);
                        f32x4 o = bs + acc[ai][bj][m][n] * rs * gv[bj][n];
                        if (bad) o = (f32x4){qnan, qnan, qnan, qnan};
                        *(f32x4*)(out + off + bj * HALF + n * 16) = o; }
                if (m & 1) asm volatile("" ::: "memory"); }
    }
};

template <int MODE>
__device__ __forceinline__ void skinny_phase(const bf16_t* A, const bf16_t* Bt, const bf16_t* MG, bf16_t* OUTB, float* OUTF, float* SSQS, int slice, __attribute__((address_space(3))) unsigned char* ldsl) {
    typedef short bf16x8 __attribute__((ext_vector_type(8)));
    int tid_ = threadIdx.x; asm volatile("" : "+v"(tid_));
    const int tid = tid_, lane = tid & 63, fr = lane & 15, fq = lane >> 4;
    const int w = __builtin_amdgcn_readfirstlane(tid >> 6);
    const int cb = slice >> 1, rh = slice & 1;
    const int row0 = MP + 64 * rh + fr;
    const bf16_t* ap = A + (size_t)row0 * DM + 256 * w + 8 * fq;
    const bf16_t* bp = Bt + (size_t)(16 * cb + fr) * DM + 256 * w + 8 * fq;
    bf16x8 bf[8], af[4][8];
#pragma unroll
    for (int j = 0; j < 8; ++j) bf[j] = *(const bf16x8*)(bp + 32 * j);
#pragma unroll
    for (int rb = 0; rb < 4; ++rb)
#pragma unroll
        for (int j = 0; j < 8; ++j) af[rb][j] = *(const bf16x8*)(ap + (size_t)rb * 16 * DM + 32 * j);
    f32x4 acc[4];
#pragma unroll
    for (int rb = 0; rb < 4; ++rb) { acc[rb] = (f32x4){0.f, 0.f, 0.f, 0.f};
#pragma unroll
        for (int j = 0; j < 8; ++j) acc[rb] = __builtin_amdgcn_mfma_f32_16x16x32_bf16(bf[j], af[rb][j], acc[rb], 0, 0, 0); }
    if (MODE == 0) { const int s = (w < 3) ? 0 : (w < 6 ? 1 : 2);
#pragma unroll
        for (int rb = 0; rb < 4; ++rb) {
            const bf16_t* gp = MG + mg_off(32, cb >> 4, 0, rh * 4 + ((cb & 7) >> 1), 0, rb, (cb & 15) >> 3, ((cb & 1) * 2 + (fq >> 1)) * 16 + fr) + 4 * (fq & 1);
            const u32x2 ra = *(const u32x2*)gp, rb2 = *(const u32x2*)(gp + 65536), gc = *(const u32x2*)(gp + 131072);
#pragma unroll
            for (int e = 0; e < 4; ++e) { const unsigned a_ = e < 2 ? ra.x : ra.y, b_ = e < 2 ? rb2.x : rb2.y, c_ = e < 2 ? gc.x : gc.y;
                const float f1 = (e & 1) ? __uint_as_float(a_ & 0xffff0000u) : __uint_as_float(a_ << 16), f2 = (e & 1) ? __uint_as_float(b_ & 0xffff0000u) : __uint_as_float(b_ << 16), f3 = (e & 1) ? __uint_as_float(c_ & 0xffff0000u) : __uint_as_float(c_ << 16);
                acc[rb][e] *= f3 * (s < 2 ? f2 : 1.0f) * (s < 1 ? f1 : 1.0f); } } }
    __attribute__((address_space(3))) f32x4* red = (__attribute__((address_space(3))) f32x4*)ldsl;
#pragma unroll
    for (int rb = 0; rb < 4; ++rb) red[(w * 4 + rb) * 64 + lane] = acc[rb];
    __syncthreads();
    if (w < 4) { const int rb = w; f32x4 s = red[rb * 64 + lane];
#pragma unroll
        for (int k = 1; k < 8; ++k) s = s + red[(k * 4 + rb) * 64 + lane];
        const int row = row0 + 16 * rb;
        if (MODE == 0) { u32x2 o; o.x = cvt_pk_bf16(s[0], s[1]); o.y = cvt_pk_bf16(s[2], s[3]); *(u32x2*)(OUTB + (size_t)row * DM + 16 * cb + 4 * fq) = o; }
        else { *(f32x4*)(OUTF + (size_t)(row - MP) * DM + 16 * cb + 4 * fq) = s;
            float q = (s[0] * s[0] + s[1] * s[1]) + (s[2] * s[2] + s[3] * s[3]);
            q += __shfl_xor(q, 16); q += __shfl_xor(q, 32);
            if (fq == 0) SSQS[(size_t)(row - MP) * 128 + cb] = q; }
    }
    __syncthreads();
}
}

namespace att {
typedef unsigned short u16;
#define GA __attribute__((address_space(1)))
using bf16x8 = __attribute__((ext_vector_type(8))) short;
using s16x4  = __attribute__((ext_vector_type(4))) short;
using f32x16 = __attribute__((ext_vector_type(16))) float;
using f32x4  = __attribute__((ext_vector_type(4))) float;
using u32x4  = __attribute__((ext_vector_type(4))) unsigned;
using u32x2  = __attribute__((ext_vector_type(2))) unsigned;
constexpr int SHM_V = 16384, SHM_K = 16384;
constexpr int NBUF = 3;
constexpr int OFF_V = 0, OFF_K = NBUF * SHM_V, OFF_BIAS = 2 * NBUF * SHM_V, OFF_FLAGS = OFF_BIAS + 2304, OFF_ITEM = OFF_FLAGS + 128, ATT_LDS = OFF_ITEM + 64;
constexpr float SB_DONE_LOG2 = -152.0f;
#define KSWZ(row, colB) ((row) * 256 + ((colB) ^ (((row) & 7) << 4)))
#define ATT_SBAR() __builtin_amdgcn_sched_barrier(0)
__device__ __forceinline__ int crow(int r, int hi) { return (r & 3) + 8 * (r >> 2) + 4 * hi; }
__device__ __forceinline__ unsigned cvtpk(float lo, float hi) { return pg8::cvt_pk_bf16(lo, hi); }
__device__ __forceinline__ int v_st(int k, int c) { const int kk = (k & ~0xC) | ((k & 4) << 1) | ((k & 8) >> 1); return ((kk >> 3) * 4 + (c >> 5)) * 512 + ((kk & 7) * 32 + (c & 31)) * 2; }
__device__ __forceinline__ int v_rd_base(int lane) { return ((lane & 3) << 3) | (((lane >> 2) & 3) << 6) | (((lane >> 4) & 1) << 5) | (((lane >> 5) & 1) << 8); }
constexpr int v_rd_off(int d0, int ks, int half) { return d0 * 512 + ks * 4096 + half * 2048; }
template <int OFF> __device__ __forceinline__ s16x4 tr_read(int vb) { s16x4 r; asm volatile("ds_read_b64_tr_b16 %0, %1 offset:%2" : "=&v"(r) : "v"(vb), "i"(OFF) : "memory"); return r; }

struct Item {
    int mode;
    int rule;
    const GA u16* Q; int ldq; int nq; int qpos0;
    const GA u16 *kb, *vb; int ldb; int pb_lo, pb_hi;
    const GA float *kf, *vf; int ldf; int pf_lo, pf_hi;
    int pv_lo, pv_hi;
    int kp_first, kp_step, ntiles;
    const GA float* bias;
    GA u16* O; int ldo; const GA u16* G; int ldg;
    int dma;
};

template <bool QPARK>
__device__ __forceinline__ void qkt(f32x16& p0, f32x16& p1, const char* Ks, const bf16x8* qr, const char* qpark, int r32, int hi) {
    p0 = f32x16{}; p1 = f32x16{};
#pragma unroll
    for (int d0 = 0; d0 < 8; ++d0) { const int cb = (d0 * 16 + hi * 8) * 2;
        const bf16x8 b0 = *reinterpret_cast<const bf16x8*>(Ks + KSWZ(r32, cb));
        const bf16x8 b1 = *reinterpret_cast<const bf16x8*>(Ks + KSWZ(32 + r32, cb));
        const bf16x8 q = QPARK ? *reinterpret_cast<const bf16x8*>(qpark + d0 * 1024) : qr[d0];
        p0 = __builtin_amdgcn_mfma_f32_32x32x16_bf16(b0, q, p0, 0, 0, 0);
        p1 = __builtin_amdgcn_mfma_f32_32x32x16_bf16(b1, q, p1, 0, 0, 0); }
}
template <int D0> __device__ __forceinline__ void pv_one(f32x16& od, int vb, bf16x8 pa0, bf16x8 pa1, bf16x8 pa2, bf16x8 pa3) {
    const s16x4 l0 = tr_read<v_rd_off(D0, 0, 0)>(vb), h0 = tr_read<v_rd_off(D0, 0, 1)>(vb), l1 = tr_read<v_rd_off(D0, 1, 0)>(vb), h1 = tr_read<v_rd_off(D0, 1, 1)>(vb);
    const s16x4 l2 = tr_read<v_rd_off(D0, 2, 0)>(vb), h2 = tr_read<v_rd_off(D0, 2, 1)>(vb), l3 = tr_read<v_rd_off(D0, 3, 0)>(vb), h3 = tr_read<v_rd_off(D0, 3, 1)>(vb);
    asm volatile("s_waitcnt lgkmcnt(0)" ::: "memory"); ATT_SBAR();
#define ATT_PK(L, H) (bf16x8){L[0], L[1], L[2], L[3], H[0], H[1], H[2], H[3]}
    od = __builtin_amdgcn_mfma_f32_32x32x16_bf16(ATT_PK(l0, h0), pa0, od, 0, 0, 0);
    od = __builtin_amdgcn_mfma_f32_32x32x16_bf16(ATT_PK(l1, h1), pa1, od, 0, 0, 0);
    od = __builtin_amdgcn_mfma_f32_32x32x16_bf16(ATT_PK(l2, h2), pa2, od, 0, 0, 0);
    od = __builtin_amdgcn_mfma_f32_32x32x16_bf16(ATT_PK(l3, h3), pa3, od, 0, 0, 0);
#undef ATT_PK
}
#define ATT_PK4(P, BASE, OUT) do { const unsigned a0_ = cvtpk(P[BASE + 0], P[BASE + 1]), a1_ = cvtpk(P[BASE + 2], P[BASE + 3]);   \
    const unsigned b0_ = cvtpk(P[BASE + 4], P[BASE + 5]), b1_ = cvtpk(P[BASE + 6], P[BASE + 7]);                              \
    auto r0_ = __builtin_amdgcn_permlane32_swap(a0_, b0_, false, false); auto r1_ = __builtin_amdgcn_permlane32_swap(a1_, b1_, false, false); \
    u32x4 w_ = {r0_[0], r1_[0], r0_[1], r1_[1]}; OUT = *reinterpret_cast<bf16x8*>(&w_); } while (0)

__device__ __forceinline__ void sb_half(f32x16& p, float& carry, bool need_mask, int kbase, int qpos, int pv_lo, int pv_hi, int hi) {
    float T[16];
#pragma unroll
    for (int r = 0; r < 16; ++r) {
        const float z = p[r];
        const float t = __builtin_amdgcn_exp2f(-__builtin_fabsf(z));
        const float l = __builtin_amdgcn_logf(1.0f + t);
        float lm = -(fmaxf(z, 0.f) + l);
        float lp = fminf(z, 0.f) - l;
        if (need_mask) { const int kp = kbase + crow(r, hi); const bool ok = (kp < qpos) && (kp >= pv_lo) && (kp < pv_hi); lm = ok ? lm : 0.f; lp = ok ? lp : -1e30f; }
        T[r] = lm; p[r] = lp;
    }
    float glo[4], ghi[4];
#pragma unroll
    for (int g = 0; g < 4; ++g) {
        T[4 * g + 2] += T[4 * g + 3]; T[4 * g + 1] += T[4 * g + 2]; T[4 * g] += T[4 * g + 1];
        const float gt = T[4 * g];
        auto rr = __builtin_amdgcn_permlane32_swap(__float_as_uint(gt), __float_as_uint(gt), false, false);
        glo[g] = __uint_as_float(rr[0]); ghi[g] = __uint_as_float(rr[1]);
    }
    float SG[4];
    SG[3] = 0.f; SG[2] = glo[3] + ghi[3]; SG[1] = SG[2] + (glo[2] + ghi[2]); SG[0] = SG[1] + (glo[1] + ghi[1]);
    const float tot = SG[0] + (glo[0] + ghi[0]);
#pragma unroll
    for (int g = 0; g < 4; ++g) SG[g] += carry + (hi == 0 ? ghi[g] : 0.f);
#pragma unroll
    for (int r = 0; r < 16; ++r) p[r] = __builtin_amdgcn_exp2f(p[r] + ((r & 3) == 3 ? SG[r >> 2] : SG[r >> 2] + T[r + 1]));
    carry += tot;
}

#define ATT_TILE(Kt, vb_) do { \
            f32x16 p0, p1; \
            qkt<!DMA>(p0, p1, (Kt), qr, qpark, r32, hi); \
            bool need_mask = (kp0 < it.pv_lo) || (kp0 + 64 > it.pv_hi); \
            if (MODE == 0) { \
                need_mask = need_mask || (kp0 + 63 >= it.qpos0 + 32 * wid); \
                sb_half(p1, carry, need_mask, kp0 + 32, qpos, it.pv_lo, it.pv_hi, hi); \
                sb_half(p0, carry, need_mask, kp0, qpos, it.pv_lo, it.pv_hi, hi); \
            } else { \
                if (has_bias) {       \
                    const int dlo_ = it.qpos0 + 32 * wid - kp0 - 63, dhi_ = it.qpos0 + 32 * wid + 31 - kp0;       \
                    if (dlo_ >= 256) { const float c_ = biasT[0]; \
                        _Pragma("unroll") for (int r = 0; r < 16; ++r) { p0[r] += c_; p1[r] += c_; } } \
                    else if (dlo_ > -256 && dhi_ < 256) { const float* rb_ = biasT + (256 - qpos + kp0 + 4 * hi);              \
                        _Pragma("unroll") for (int r = 0; r < 16; ++r) { p0[r] += rb_[(r & 3) + 8 * (r >> 2)]; p1[r] += rb_[32 + (r & 3) + 8 * (r >> 2)]; } } \
                    else { \
                        _Pragma("unroll") for (int r = 0; r < 16; ++r) { const int kp = kp0 + crow(r, hi); \
                            int i0_ = 256 - qpos + kp; i0_ = i0_ < 0 ? 0 : (i0_ > 512 ? 512 : i0_); \
                            int i1_ = 288 - qpos + kp; i1_ = i1_ < 0 ? 0 : (i1_ > 512 ? 512 : i1_); \
                            p0[r] += biasT[i0_]; p1[r] += biasT[i1_]; } } \
                } \
                if (need_mask) { \
                    _Pragma("unroll") for (int r = 0; r < 16; ++r) { const int kp = kp0 + crow(r, hi); \
                        if (!(kp >= it.pv_lo && kp < it.pv_hi)) p0[r] = -1e30f; \
                        if (!(kp + 32 >= it.pv_lo && kp + 32 < it.pv_hi)) p1[r] = -1e30f; } \
                } \
                float pmax = p0[0]; \
                _Pragma("unroll") for (int r = 1; r < 16; ++r) pmax = fmaxf(pmax, p0[r]); \
                _Pragma("unroll") for (int r = 0; r < 16; ++r) pmax = fmaxf(pmax, p1[r]); \
                { auto rr = __builtin_amdgcn_permlane32_swap(__float_as_uint(pmax), __float_as_uint(pmax), false, false); pmax = fmaxf(__uint_as_float(rr[0]), __uint_as_float(rr[1])); } \
                float mn = m_reg, alpha = 1.f;                  \
                if (!__all(pmax - m_reg <= 8.0f)) { mn = fmaxf(m_reg, pmax); alpha = __builtin_amdgcn_exp2f(m_reg - mn); m_reg = mn; } \
                float ps = 0.f; \
                _Pragma("unroll") for (int r = 0; r < 16; ++r) { p0[r] = __builtin_amdgcn_exp2f(p0[r] - mn); ps += p0[r]; } \
                _Pragma("unroll") for (int r = 0; r < 16; ++r) { p1[r] = __builtin_amdgcn_exp2f(p1[r] - mn); ps += p1[r]; } \
                { auto rr = __builtin_amdgcn_permlane32_swap(__float_as_uint(ps), __float_as_uint(ps), false, false); ps = __uint_as_float(rr[0]) + __uint_as_float(rr[1]); } \
                l_reg = l_reg * alpha + ps; \
                if (__any(alpha < 1.f)) { \
                    _Pragma("unroll") for (int d = 0; d < 4; ++d) \
                        _Pragma("unroll") for (int r = 0; r < 16; ++r) o[d][r] *= alpha; } \
            } \
            bf16x8 pa0, pa1, pa2, pa3; \
            ATT_PK4(p0, 0, pa0); ATT_PK4(p0, 8, pa1); ATT_PK4(p1, 0, pa2); ATT_PK4(p1, 8, pa3); \
            const int vbt_ = (vb_); \
            pv_one<0>(o[0], vbt_, pa0, pa1, pa2, pa3); pv_one<1>(o[1], vbt_, pa0, pa1, pa2, pa3); pv_one<2>(o[2], vbt_, pa0, pa1, pa2, pa3); pv_one<3>(o[3], vbt_, pa0, pa1, pa2, pa3); \
        } while (0)

template <int MODE, bool DMA>
__device__ __forceinline__ void run_item(const Item& it, char* lds, __attribute__((address_space(3))) unsigned char* ldsl) {
    typedef __attribute__((address_space(3))) unsigned las_u32;
    const int tid = threadIdx.x, lane = tid & 63, r32 = lane & 31, hi = lane >> 5;
    const int wid = __builtin_amdgcn_readfirstlane(tid >> 6);
    char* V_lds = lds + OFF_V; char* K_lds = lds + OFF_K;
    float* biasT = (float*)(lds + OFF_BIAS);
    volatile __attribute__((address_space(3))) int* flags = (volatile __attribute__((address_space(3))) int*)(ldsl + OFF_FLAGS);
    const bool has_bias = (MODE == 1) && (it.bias != nullptr);
    const bool wave_rows = (32 * wid < it.nq);
    int qrow = 32 * wid + r32; if (qrow >= it.nq) qrow = it.nq - 1;
    const int qpos = it.qpos0 + 32 * wid + r32;
    bf16x8 qr[8];
    char* const qpark = K_lds + 2 * SHM_K + (wid & 1) * 8192 + lane * 16;
#define ATT_ITEM_LOADS() do { \
    if (has_bias) for (int i = tid; i < 513; i += 512) biasT[i] = it.bias[512 - i] * LOG2E; \
    { const GA u16* Qw = it.Q + (size_t)qrow * it.ldq + hi * 8; \
      _Pragma("unroll") for (int d0 = 0; d0 < 8; ++d0) { const bf16x8 q = *reinterpret_cast<const GA bf16x8*>(Qw + d0 * 16); \
          if constexpr (DMA) qr[d0] = q; else { if (wid < 2) *reinterpret_cast<bf16x8*>(qpark + d0 * 1024) = q; } } } \
    } while (0)
    f32x16 o[4]; o[0] = f32x16{}; o[1] = f32x16{}; o[2] = f32x16{}; o[3] = f32x16{};
    float carry = 0.f, m_reg = -1e30f, l_reg = 0.f;
    const int vb0 = (int)(uintptr_t)V_lds + v_rd_base(lane);
    const int nt = it.ntiles;
    bool wdone = !wave_rows;
    if constexpr (!DMA) ATT_ITEM_LOADS();
    if constexpr (DMA) {
        unsigned koff[2], voff[2];
#pragma unroll
        for (int i = 0; i < 2; ++i) { const int p = wid + 8 * i;
            const int krow = 4 * p + (lane >> 4), kch = (lane & 15) ^ (krow & 7);
            koff[i] = (unsigned)(krow * it.ldb * 2 + kch * 16);
            const int s = 2 * p + (lane >> 5), kk = 8 * (s >> 2) + ((lane & 31) >> 2), k = (kk & ~0xC) | ((kk & 4) << 1) | ((kk & 8) >> 1), c = 32 * (s & 3) + 8 * (lane & 3);
            voff[i] = (unsigned)(k * it.ldb * 2 + c * 2); }
        const GA char* kbase = (const GA char*)it.kb; const GA char* vbase = (const GA char*)it.vb;
#define ATT_DMA(b, kp0_) do { const size_t to_ = (size_t)((kp0_) - it.pb_lo) * (size_t)it.ldb * 2; \
        _Pragma("unroll") for (int i_ = 0; i_ < 2; ++i_) { \
            __builtin_amdgcn_global_load_lds((const GA unsigned*)(kbase + to_ + koff[i_]), (las_u32*)(ldsl + OFF_K + (b) * SHM_K + (wid + 8 * i_) * 1024), 16, 0, 0); \
            __builtin_amdgcn_global_load_lds((const GA unsigned*)(vbase + to_ + voff[i_]), (las_u32*)(ldsl + OFF_V + (b) * SHM_V + (wid + 8 * i_) * 1024), 16, 0, 0); } } while (0)
        ATT_DMA(0, it.kp_first);
        if (nt > 1) ATT_DMA(1, it.kp_first + it.kp_step);
        ATT_ITEM_LOADS();
        int cur = 0;
        for (int j = 0; j < nt; ++j) {
            const int kp0 = it.kp_first + j * it.kp_step;
            if (j + 1 < nt) asm volatile("s_waitcnt vmcnt(4) lgkmcnt(0)\n\ts_barrier" ::: "memory");
            else            asm volatile("s_waitcnt vmcnt(0) lgkmcnt(0)\n\ts_barrier" ::: "memory");
            if (MODE == 0 && SB_EARLY_EXIT && j > 0) {
                int alld = 1;
#pragma unroll
                for (int w = 0; w < 8; ++w) alld &= flags[((j - 1) & 1) * 8 + w];
                if (alld) break;
            }
            if (j + 2 < nt) { const int b2 = (cur >= 1) ? cur - 1 : cur + 2; ATT_DMA(b2, kp0 + 2 * it.kp_step); }
            bool active = wave_rows;
            if (it.rule == 1) active = active && (kp0 <= it.qpos0 + 32 * wid + 30) && !wdone;
            if (it.rule == 2) { const int ct = kp0 >> 6, cw = (it.qpos0 + 32 * wid) >> 6; active = active && (ct >= cw - 8) && (ct <= cw); }
            if (active) ATT_TILE(K_lds + cur * SHM_K, vb0 + cur * SHM_V);
            if (MODE == 0 && SB_EARLY_EXIT) {
                if (wave_rows && !wdone) { const bool rowdone = (carry < SB_DONE_LOG2) || (32 * wid + r32 >= it.nq); wdone = __all(rowdone); }
                if (lane == 0) flags[(j & 1) * 8 + wid] = wdone ? 1 : 0;
            }
            cur = (cur == NBUF - 1) ? 0 : cur + 1;
        }
        asm volatile("s_waitcnt vmcnt(0) lgkmcnt(0)\n\ts_barrier" ::: "memory");
#undef ATT_DMA
    } else {
    const int sr = tid >> 4, sc = (tid & 15) * 8;
    const int vst0 = v_st(sr, sc), vst1 = v_st(32 + sr, sc), kst0 = KSWZ(sr, sc * 2), kst1 = KSWZ(32 + sr, sc * 2);
    f32x4 sK0a, sK0b, sK1a, sK1b, sV0a, sV0b, sV1a, sV1b;
#define ATT_LD(p, A, B, kbp, kfp) do { const int p_ = (p); const bool isb_ = (p_ >= it.pb_lo && p_ < it.pb_hi), isf_ = (p_ >= it.pf_lo && p_ < it.pf_hi); \
        const GA char* a0_ = isf_ ? (const GA char*)(kfp + (size_t)(p_ - it.pf_lo) * it.ldf + sc) : (const GA char*)(kbp + (size_t)(isb_ ? p_ - it.pb_lo : 0) * it.ldb + sc); \
        const f32x4 la_ = *reinterpret_cast<const GA f32x4*>(a0_); const f32x4 lb_ = *reinterpret_cast<const GA f32x4*>(a0_ + (isf_ ? 16 : 0)); \
        A = la_; B = lb_; } while (0)
#define ATT_CV(p, A, B, OUT) do { const int p_ = (p); const bool isb_ = (p_ >= it.pb_lo && p_ < it.pb_hi), isf_ = (p_ >= it.pf_lo && p_ < it.pf_hi); \
        u32x4 w_ = {cvtpk(A[0], A[1]), cvtpk(A[2], A[3]), cvtpk(B[0], B[1]), cvtpk(B[2], B[3])}; const u32x4 r_ = __builtin_bit_cast(u32x4, A); \
        w_.x = isf_ ? w_.x : (isb_ ? r_.x : 0u); w_.y = isf_ ? w_.y : (isb_ ? r_.y : 0u); w_.z = isf_ ? w_.z : (isb_ ? r_.z : 0u); w_.w = isf_ ? w_.w : (isb_ ? r_.w : 0u); \
        OUT = *reinterpret_cast<bf16x8*>(&w_); } while (0)
#define ATT_SLOAD(kp0) do { ATT_LD((kp0) + sr, sK0a, sK0b, it.kb, it.kf); ATT_LD((kp0) + 32 + sr, sK1a, sK1b, it.kb, it.kf); \
        ATT_LD((kp0) + sr, sV0a, sV0b, it.vb, it.vf); ATT_LD((kp0) + 32 + sr, sV1a, sV1b, it.vb, it.vf); } while (0)
#define ATT_SWRITE(b, kp0) do { bf16x8 t_; \
        ATT_CV((kp0) + sr, sK0a, sK0b, t_); *reinterpret_cast<bf16x8*>(K_lds + (b) * SHM_K + kst0) = t_; \
        ATT_CV((kp0) + 32 + sr, sK1a, sK1b, t_); *reinterpret_cast<bf16x8*>(K_lds + (b) * SHM_K + kst1) = t_; \
        ATT_CV((kp0) + sr, sV0a, sV0b, t_); *reinterpret_cast<bf16x8*>(V_lds + (b) * SHM_V + vst0) = t_; \
        ATT_CV((kp0) + 32 + sr, sV1a, sV1b, t_); *reinterpret_cast<bf16x8*>(V_lds + (b) * SHM_V + vst1) = t_; } while (0)
    sK0b = sK1b = sV0b = sV1b = (f32x4){0.f, 0.f, 0.f, 0.f};
    ATT_SLOAD(it.kp_first); ATT_SWRITE(0, it.kp_first);
    __syncthreads();
    for (int j = 0; j < nt; ++j) {
        const int kp0 = it.kp_first + j * it.kp_step, kpn = kp0 + it.kp_step, cur = j & 1;
        const bool more = (j + 1 < nt);
        if (more) ATT_SLOAD(kpn);
        bool active = wave_rows;
        if (it.rule == 1) active = active && (kp0 <= it.qpos0 + 32 * wid + 30) && !wdone;
        if (it.rule == 2) { const int ct = kp0 >> 6, cw = (it.qpos0 + 32 * wid) >> 6; active = active && (ct >= cw - 8) && (ct <= cw); }
        if (active) ATT_TILE(K_lds + cur * SHM_K, vb0 + cur * SHM_V);
        if (MODE == 0 && SB_EARLY_EXIT) {
            if (wave_rows && !wdone) { const bool rowdone = (carry < SB_DONE_LOG2) || (32 * wid + r32 >= it.nq); wdone = __all(rowdone); }
            if (lane == 0) flags[cur * 8 + wid] = wdone ? 1 : 0;
        }
        if (more) ATT_SWRITE(cur ^ 1, kpn);
        __syncthreads();
        if (MODE == 0 && SB_EARLY_EXIT) {
            int alld = 1;
#pragma unroll
            for (int w = 0; w < 8; ++w) alld &= flags[cur * 8 + w];
            if (alld) break;
        }
    }
#undef ATT_LD
#undef ATT_CV
#undef ATT_SLOAD
#undef ATT_SWRITE
    }
    if (wave_rows) {
        const int nrow = it.nq - 32 * wid;
        const int prow = lane >> 4, piece = lane & 15;
        u32x4 gq[8];
#pragma unroll
        for (int j = 0; j < 8; ++j) { int rl = 4 * j + prow; rl = rl < nrow ? rl : nrow - 1;
            gq[j] = *reinterpret_cast<const GA u32x4*>(it.G + (size_t)(32 * wid + rl) * it.ldg + 8 * piece); }
        const float inv = (MODE == 1) ? __builtin_amdgcn_rcpf(l_reg) : 1.0f;
        char* const stg = lds + wid * 8704 + r32 * 272 + hi * 8;
#pragma unroll
        for (int d0 = 0; d0 < 4; ++d0)
#pragma unroll
            for (int g = 0; g < 4; ++g) { u32x2 w; w.x = cvtpk(o[d0][4 * g] * inv, o[d0][4 * g + 1] * inv); w.y = cvtpk(o[d0][4 * g + 2] * inv, o[d0][4 * g + 3] * inv);
                *reinterpret_cast<u32x2*>(stg + d0 * 64 + g * 16) = w; }
        asm volatile("s_waitcnt lgkmcnt(0)" ::: "memory");
        const char* const rd = lds + wid * 8704 + piece * 16;
#pragma unroll
        for (int j = 0; j < 8; ++j) { int rl = 4 * j + prow; rl = rl < nrow ? rl : nrow - 1;
            const u32x4 ov = *reinterpret_cast<const u32x4*>(rd + rl * 272); const u32x4 gg = gq[j]; u32x4 w;
#pragma unroll
            for (int e = 0; e < 4; ++e) w[e] = cvtpk(__uint_as_float(ov[e] << 16) * __uint_as_float(gg[e] << 16), __uint_as_float(ov[e] & 0xffff0000u) * __uint_as_float(gg[e] & 0xffff0000u));
            *reinterpret_cast<GA u32x4*>(it.O + (size_t)(32 * wid + rl) * it.ldo + 8 * piece) = w; }
    }
    __syncthreads();
}
#undef ATT_TILE
#undef ATT_ITEM_LOADS
#undef GA
}

constexpr int NWAVES = 8;
constexpr int N_LAUNCHES = MK_N_LAUNCHES;
constexpr int PER_PHASE = 6;

constexpr size_t al256(size_t x) { return (x + 255) & ~(size_t)255; }
constexpr size_t WS_CTL = 0, CTL_ZERO_BYTES = 65536, CTL_BYTES = 1u << 20;
constexpr size_t WS_WCAT = CTL_BYTES;
constexpr size_t WS_WUP  = WS_WCAT + (size_t)NCAT * DM * 2;
constexpr size_t WS_WOUT = WS_WUP + (size_t)DM * DM * 2;
constexpr size_t WS_ACAT = WS_WOUT + (size_t)DM * DM * 2;
constexpr size_t SZ768 = (size_t)MIN_ * 768 * 2, SZ512 = (size_t)MIN_ * 512 * 2;
constexpr size_t WS_QSB = WS_ACAT + (size_t)MA * DM * 2, WS_KSB = WS_QSB + SZ768, WS_VSB = WS_KSB + SZ768, WS_GSB = WS_VSB + SZ768;
constexpr size_t WS_QBD = WS_GSB + SZ768, WS_KBD = WS_QBD + SZ768, WS_VBD = WS_KBD + SZ768, WS_GBD = WS_VBD + SZ768;
constexpr size_t WS_QMM = WS_GBD + SZ768, WS_GMM = WS_QMM + SZ512;
constexpr size_t WS_MG  = WS_GMM + SZ512;
constexpr size_t WS_MK  = WS_MG + (size_t)MIN_ * 6144 * 2, WS_MV = WS_MK + (size_t)512 * 512 * 2;
constexpr size_t WS_AUP = WS_MV + (size_t)512 * 512 * 2;
constexpr size_t WS_SSQ = WS_AUP + (size_t)MIN_ * DM * 2;
constexpr size_t WS_SSQS = WS_SSQ + (size_t)MIN_ * 32 * 4;
constexpr size_t WS_XBUF = WS_SSQS + (size_t)MS * 128 * 4;
constexpr size_t WS_YB = WS_XBUF + (size_t)MP * 8 * 4;
constexpr size_t WS_KBC = WS_YB, WS_VBC = WS_KBC + (size_t)DB * 576 * 768 * 2, WS_MKC = WS_VBC + (size_t)DB * 576 * 768 * 2, WS_MVC = WS_MKC + (size_t)DB * NMEM * 512 * 2;
static_assert(WS_MVC + (size_t)DB * NMEM * 512 * 2 <= WS_YB + (size_t)MP * DM * 2, "decode caches inside the YB region");
constexpr size_t WS_END = WS_YB + (size_t)MP * DM * 2;
static_assert(WS_WCAT % 256 == 0 && WS_QSB % 256 == 0 && WS_MG % 256 == 0 && WS_AUP % 256 == 0 && WS_SSQ % 256 == 0, "alignment");
constexpr int CW_TMO = 0, CW_WORK = 64, CW_BAR = 4096, CW_PANEL = 8192;
constexpr int OUT_ELEMS = 32112640;

constexpr int RING_BYTES = 131072, LDSCTL_OFF = RING_BYTES, MISC_OFF = LDSCTL_OFF + 320, STG_OFF = 147456, LDS_BYTES = 163840;
static_assert(att::ATT_LDS <= RING_BYTES, "attention scratch inside the ring region");

#define GAS __attribute__((address_space(1)))
#define LAS __attribute__((address_space(3)))
typedef unsigned short bf16;
typedef unsigned v4u __attribute__((ext_vector_type(4)));
typedef float f32x4 __attribute__((ext_vector_type(4)));
typedef GAS unsigned gu32;
#define RLX_AGENT __ATOMIC_RELAXED, __HIP_MEMORY_SCOPE_AGENT
#define LDS_WAIT() asm volatile("s_waitcnt lgkmcnt(0)" ::: "memory")
__device__ __forceinline__ unsigned pk2(float lo, float hi) { return pg8::cvt_pk_bf16(lo, hi); }

#define XB_TMO      128
#define XB_XCNT(j)  (256  + 64 * (j))
#define XB_XSUB(j)  (1280 + 64 * (j))
#define XB_XGEN(j)  (2304 + 64 * (j))
#define XB_TOP      3328
#define XB_TOPGEN   3392
#define XCD_BAR_WORDS 3456
#define XB_SPIN_CAP (1u << 18)
__device__ __forceinline__ unsigned xb_ld(unsigned* p)              { return __hip_atomic_load(p, __ATOMIC_RELAXED, __HIP_MEMORY_SCOPE_AGENT); }
__device__ __forceinline__ unsigned xb_add(unsigned* p, unsigned v) { return __hip_atomic_fetch_add(p, v, __ATOMIC_RELAXED, __HIP_MEMORY_SCOPE_AGENT); }
__device__ __forceinline__ unsigned xb_xcc_id() { return (unsigned)__builtin_amdgcn_s_getreg((3 << 11) | 20) & 0xFu; }
#define XB_SPIN(cond, bar) do { unsigned _sp = 0; while (cond) { __builtin_amdgcn_s_sleep(1); \
    if ((++_sp & 255u) == 0u) { if (xb_ld(&(bar)[XB_TMO])) break; if (_sp > XB_SPIN_CAP) { atomicAdd(&(bar)[XB_TMO], 1u); break; } } } } while (0)
struct XcdBarrier { unsigned* bar; unsigned x; volatile LAS unsigned* st; };
__device__ __forceinline__ XcdBarrier xcd_barrier_post(unsigned* bar, volatile LAS unsigned* st) {
    XcdBarrier b; b.bar = bar; b.x = xb_xcc_id(); b.st = st;
    if (threadIdx.x == 0) (void)xb_add(&bar[XB_XCNT(b.x)], 1u);
    return b;
}
__device__ __forceinline__ void xcd_barrier_complete(unsigned* bar, unsigned x, unsigned& nloc, unsigned& nx) {
    const unsigned G = gridDim.x * gridDim.y * gridDim.z;
    unsigned sum, cnt, mine, sp = 0u;
    for (;;) {
        sum = 0u; cnt = 0u; mine = 0u;
#pragma unroll
        for (unsigned j = 0; j < 16; ++j) { const unsigned c = xb_ld(&bar[XB_XCNT(j)]); sum += c; cnt += (c > 0u) ? 1u : 0u; mine = (j == x) ? c : mine; }
        if (sum == G) break;
        __builtin_amdgcn_s_sleep(1);
        if ((++sp & 255u) == 0u) { if (xb_ld(&bar[XB_TMO])) break; if (sp > XB_SPIN_CAP) { atomicAdd(&bar[XB_TMO], 1u); break; } }
    }
    nloc = mine > 0u ? mine : 1u; nx = cnt > 0u ? cnt : 1u;
}
__device__ __forceinline__ void xcd_barrier(const XcdBarrier& b) {
    asm volatile("s_waitcnt vmcnt(0)" ::: "memory");
    __syncthreads();
    if (threadIdx.x == 0) {
        unsigned* bar = b.bar;
        __builtin_amdgcn_s_waitcnt(0);
        unsigned nloc = b.st[0], nx = b.st[1];
        if (nloc == 0u) { xcd_barrier_complete(bar, b.x, nloc, nx); b.st[0] = nloc; b.st[1] = nx; }
        const unsigned old = xb_add(&bar[XB_XSUB(b.x)], 1u);
        const unsigned gen = old / nloc;
        if (old + 1u == (gen + 1u) * nloc) {
            __builtin_amdgcn_fence(__ATOMIC_RELEASE, "agent");
            asm volatile("s_waitcnt vmcnt(0)" ::: "memory");
            const unsigned og = xb_add(&bar[XB_TOP], 1u);
            const unsigned tg = og / nx;
            if (og + 1u == (tg + 1u) * nx) xb_add(&bar[XB_TOPGEN], 1u);
            else XB_SPIN(xb_ld(&bar[XB_TOPGEN]) == tg, bar);
            __builtin_amdgcn_fence(__ATOMIC_ACQUIRE, "agent");
            xb_add(&bar[XB_XGEN(b.x)], 1u);
            asm volatile("s_waitcnt vmcnt(0)" ::: "memory");
        } else {
            XB_SPIN(xb_ld(&bar[XB_XGEN(b.x)]) == gen, bar);
            __builtin_amdgcn_fence(__ATOMIC_ACQUIRE, "agent");
            asm volatile("s_waitcnt vmcnt(0)" ::: "memory");
        }
    }
    __syncthreads();
}

struct Frame {
    LAS unsigned char* lds;
    volatile LAS unsigned* MISC;
    gu32* ctl;
    int vcu, G;
    const float *x_prompt, *x_sample, *c_sbk, *c_sbv, *c_bdk, *c_bdv, *c_mk, *c_mv, *mem_prompt, *g_pre, *w_in, *rel_bias, *g_mem, *w_mem_kv, *w_up_sb, *w_up_band, *w_up_mem, *w_out, *g_post;
    float* out;
    bf16 *WCAT, *WUP, *WOUT, *ACAT, *QSB, *KSB, *VSB, *GSB, *QBD, *KBD, *VBD, *GBD, *QMM, *GMM, *MG, *MK, *MV, *AUP, *MERGED;
    float* SSQ; float* SSQS; bf16* YB; bf16 *KBC, *VBC, *MKC, *MVC;
};

__device__ __forceinline__ int fresh_tid() { int t = threadIdx.x; asm volatile("" : "+v"(t)); return t; }
__device__ __forceinline__ float wave_sum(float v) {
#pragma unroll
    for (int o = 1; o < 64; o <<= 1) v += __shfl_xor(v, o);
    return v;
}
__device__ __forceinline__ void p0_decode(int item, int nblk, int& kb, int& nb) { kb = item / nblk; nb = item % nblk; }
__device__ __forceinline__ void p0_transpose_item(const float* W, int N, int nkb, bf16* WT, int ldt, int row_off, int col_off, int item, int lane) {
    int kb, nb; p0_decode(item, N / 32, kb, nb); const int k0 = 64 * kb + 8 * (lane >> 3), n0 = 32 * nb + 4 * (lane & 7);
    f32x4 wv[8];
#pragma unroll
    for (int i = 0; i < 8; ++i) wv[i] = __builtin_nontemporal_load((const GAS f32x4*)(W + (size_t)(k0 + i) * N + n0));
#pragma unroll
    for (int e = 0; e < 4; ++e) { v4u o; o.x = pk2(wv[0][e], wv[1][e]); o.y = pk2(wv[2][e], wv[3][e]); o.z = pk2(wv[4][e], wv[5][e]); o.w = pk2(wv[6][e], wv[7][e]);
        *(GAS v4u*)(WT + (size_t)(row_off + n0 + e) * ldt + col_off + k0) = o; }
}
__device__ __forceinline__ void rms_row_to_bf16(const float* xrow, const float* g, bf16* orow, int lane) {
    const GAS f32x4* xr = (const GAS f32x4*)xrow + lane; const GAS f32x4* gr = (const GAS f32x4*)g + lane;
    f32x4 v[8]; float s = 0.f;
#pragma unroll
    for (int j = 0; j < 8; ++j) { v[j] = xr[64 * j]; s += (v[j].x * v[j].x + v[j].y * v[j].y) + (v[j].z * v[j].z + v[j].w * v[j].w); }
    const float r = 1.0f / sqrtf(wave_sum(s) * (1.0f / DM) + RMS_EPS);
    GAS unsigned long long* o8 = (GAS unsigned long long*)orow + lane;
#pragma unroll
    for (int j = 0; j < 8; ++j) { const f32x4 gv = gr[64 * j];
        o8[64 * j] = (unsigned long long)pk2(v[j].x * r * gv.x, v[j].y * r * gv.y) | ((unsigned long long)pk2(v[j].z * r * gv.z, v[j].w * r * gv.w) << 32); }
}
__device__ __forceinline__ void p0_t_load(const float* W, int N, int item, int lane, f32x4 (&wv)[8]) {
    int kb, nb; p0_decode(item, N / 32, kb, nb); const int k0 = 64 * kb + 8 * (lane >> 3), n0 = 32 * nb + 4 * (lane & 7);
#pragma unroll
    for (int i = 0; i < 8; ++i) wv[i] = __builtin_nontemporal_load((const GAS f32x4*)(W + (size_t)(k0 + i) * N + n0));
}
__device__ __forceinline__ int wcat_row(int c) {
    int kind, idx;
    if (c >= 7168) { const int d = c - 7168; kind = d >> 11; idx = d & 2047; }
    else { const int p = c >> 8;
        if (p < 9) return c;
        if (p < 12) { kind = 3; idx = c - 2304; }
        else if (p < 21) return c - 768;
        else if (p < 24) { kind = 3; idx = 768 + (c - 5376); }
        else if (p < 26) return c - 1536;
        else { kind = 3; idx = 1536 + (c - 6656); } }
    const int t = idx >> 6, q = idx & 63;
    return (20 + t) * 256 + 128 * (kind >> 1) + 4 * (kind & 1) + 32 * (q >> 4) + 8 * ((q >> 2) & 3) + (q & 3);
}
__device__ __forceinline__ float wcat_scale(int c) { const int p = c >> 8; return (p < 3 || (p >= 12 && p < 15) || p == 24 || p == 25) ? QSCALE : ((p >= 9 && p < 12) || p >= 21) ? -LOG2E : 1.0f; }
template <bool MAP>
__device__ __forceinline__ void p0_t_finish(const f32x4 (&wv)[8], int N, bf16* WT, int ldt, int row_off, int col_off, int item, int lane) {
    int kb, nb; p0_decode(item, N / 32, kb, nb); const int k0 = 64 * kb + 8 * (lane >> 3), n0 = 32 * nb + 4 * (lane & 7);
#pragma unroll
    for (int e = 0; e < 4; ++e) { const float sc = MAP ? wcat_scale(n0 + e) : 1.0f;
        v4u o; o.x = pk2(wv[0][e] * sc, wv[1][e] * sc); o.y = pk2(wv[2][e] * sc, wv[3][e] * sc); o.z = pk2(wv[4][e] * sc, wv[5][e] * sc); o.w = pk2(wv[6][e] * sc, wv[7][e] * sc);
        *(GAS v4u*)(WT + (size_t)(MAP ? wcat_row(n0 + e) : row_off + n0 + e) * ldt + col_off + k0) = o; }
}
__device__ __forceinline__ void rms_load(const float* xrow, int lane, f32x4 (&v)[8]) {
    const GAS f32x4* xr = (const GAS f32x4*)xrow + lane;
#pragma unroll
    for (int j = 0; j < 8; ++j) v[j] = __builtin_nontemporal_load(&xr[64 * j]);
}
__device__ __forceinline__ void rms_finish(const f32x4 (&v)[8], const f32x4 (&gv)[8], bf16* orow, int lane) {
    float s = 0.f;
#pragma unroll
    for (int j = 0; j < 8; ++j) s += (v[j].x * v[j].x + v[j].y * v[j].y) + (v[j].z * v[j].z + v[j].w * v[j].w);
    const float r = 1.0f / sqrtf(wave_sum(s) * (1.0f / DM) + RMS_EPS);
    GAS unsigned long long* o8 = (GAS unsigned long long*)orow + lane;
#pragma unroll
    for (int j = 0; j < 8; ++j) o8[64 * j] = (unsigned long long)pk2(v[j].x * r * gv[j].x, v[j].y * r * gv[j].y) | ((unsigned long long)pk2(v[j].z * r * gv[j].z, v[j].w * r * gv[j].w) << 32);
}
__device__ __forceinline__ void p0_prologue(Frame& F) {
    const int tid_ = fresh_tid(), lane_ = tid_ & 63, wave_ = __builtin_amdgcn_readfirstlane(tid_ >> 6);
    const int gw = F.vcu * NWAVES + wave_, NGW = F.G * NWAVES;
    constexpr int I_IN = 32 * (INW / 32), I_MEM = 32 * (1024 / 32), I_USB = 12 * 64, I_UBD = 12 * 64, I_UMM = 8 * 64, I_OUT = 32 * 64;
    constexpr int NI = I_IN + I_MEM;
#define P0_TLOAD(buf, it_) do { if ((it_) < I_IN) p0_t_load(F.w_in, INW, (it_), lane_, buf); else p0_t_load(F.w_mem_kv, 1024, (it_) - I_IN, lane_, buf); } while (0)
#define P0_TFIN(buf, it_) do { if ((it_) < I_IN) p0_t_finish<true>(buf, INW, F.WCAT, DM, 0, 0, (it_), lane_); else p0_t_finish<false>(buf, 1024, F.WCAT, DM, INW, 0, (it_) - I_IN, lane_); } while (0)
    { f32x4 wa[8], wb[8]; int it = gw;
      if (it < NI) P0_TLOAD(wa, it);
      while (it < NI) {
          int it2 = it + NGW; if (it2 < NI) P0_TLOAD(wb, it2);
          P0_TFIN(wa, it); it = it2; if (it >= NI) break;
          it2 = it + NGW; if (it2 < NI) P0_TLOAD(wa, it2);
          P0_TFIN(wb, it); it = it2; } }
#undef P0_TLOAD
#undef P0_TFIN
    if (!LATE_WT) for (int it = gw; it < I_USB + I_UBD + I_UMM + I_OUT; it += NGW) {
        int r = it;
        if (r < I_USB) { p0_transpose_item(F.w_up_sb, DM, 12, F.WUP, DM, 0, 0, r, lane_); continue; } r -= I_USB;
        if (r < I_UBD) { p0_transpose_item(F.w_up_band, DM, 12, F.WUP, DM, 0, 768, r, lane_); continue; } r -= I_UBD;
        if (r < I_UMM) { p0_transpose_item(F.w_up_mem, DM, 8, F.WUP, DM, 0, 1536, r, lane_); continue; } r -= I_UMM;
        p0_transpose_item(F.w_out, DM, 32, F.WOUT, DM, 0, 0, r, lane_);
    }
    { f32x4 gv[8], va[8], vb[8]; const GAS f32x4* gr = (const GAS f32x4*)F.g_pre + lane_;
#pragma unroll
      for (int j = 0; j < 8; ++j) gv[j] = gr[64 * j];
      int m = gw;
      if (m < MP) rms_load(F.x_prompt + (size_t)m * DM, lane_, va);
      while (m < MP) {
          int m2 = m + NGW; if (m2 < MP) rms_load(F.x_prompt + (size_t)m2 * DM, lane_, vb);
          rms_finish(va, gv, F.ACAT + (size_t)m * DM, lane_); m = m2; if (m >= MP) break;
          m2 = m + NGW; if (m2 < MP) rms_load(F.x_prompt + (size_t)m2 * DM, lane_, va);
          rms_finish(vb, gv, F.ACAT + (size_t)m * DM, lane_); m = m2; } }
    for (int m = MP + gw; m < MA; m += NGW) {
        bf16* orow = F.ACAT + (size_t)m * DM;
        if (m < MREAL) rms_row_to_bf16(F.x_sample + (size_t)(m - MP) * DM, F.g_pre, orow, lane_);
        else if (m < MIN_) {
            GAS v4u* o = (GAS v4u*)orow + lane_; GAS v4u* o2 = (GAS v4u*)(F.AUP + (size_t)m * DM) + lane_;
#pragma unroll
            for (int j = 0; j < 4; ++j) { o[64 * j] = (v4u){0u, 0u, 0u, 0u}; o2[64 * j] = (v4u){0u, 0u, 0u, 0u}; }
        }
        else rms_row_to_bf16(F.mem_prompt + (size_t)(m - MMEM0) * DM, F.g_mem, orow, lane_);
    }
}
constexpr int LATE_ITEMS = 128;
__device__ __forceinline__ void late_transpose_item(Frame& F, int j) {
    const int tid_ = fresh_tid(), lane_ = tid_ & 63, wave_ = __builtin_amdgcn_readfirstlane(tid_ >> 6);
    constexpr int I_USB = 12 * 64, I_UBD = 12 * 64, I_UMM = 8 * 64;
#pragma unroll 1
    for (int q = 0; q < 4; ++q) {
        int r = (j * 8 + wave_) * 4 + q;
        if (r < I_USB) { p0_transpose_item(F.w_up_sb, DM, 12, F.WUP, DM, 0, 0, r, lane_); continue; } r -= I_USB;
        if (r < I_UBD) { p0_transpose_item(F.w_up_band, DM, 12, F.WUP, DM, 0, 768, r, lane_); continue; } r -= I_UBD;
        if (r < I_UMM) { p0_transpose_item(F.w_up_mem, DM, 8, F.WUP, DM, 0, 1536, r, lane_); continue; } r -= I_UMM;
        p0_transpose_item(F.w_out, DM, 32, F.WOUT, DM, 0, 0, r, lane_);
    }
}
constexpr int CV_BD = DB * 576 * 768 / 32768, CV_MM = DB * NMEM * 512 / 32768, SLACK_ITEMS = LATE_ITEMS + 2 * CV_BD + 2 * CV_MM;
static_assert(DB * 576 * 768 % 32768 == 0 && DB * NMEM * 512 % 32768 == 0, "conversion item size");
template <bool BAND>
__device__ __forceinline__ void slack_convert(const float* src, bf16* dst, int jj, int tid_) {
    constexpr int ld = BAND ? 768 : 512, rows_d = BAND ? 576 : NMEM, rows_s = BAND ? 512 : NMEM;
    f32x4 va[8], vb[8];
#pragma unroll
    for (int it = 0; it < 8; ++it) { const int e = (jj * 4096 + it * 512 + tid_) * 8;
        const int col = e % ld, rowd = e / ld, b = rowd / rows_d, row = rowd % rows_d;
        const float* s = src + ((size_t)(b * rows_s + (row < rows_s ? row : 0)) * ld + col);
        va[it] = __builtin_nontemporal_load((const GAS f32x4*)s); vb[it] = __builtin_nontemporal_load((const GAS f32x4*)(s + 4)); }
#pragma unroll
    for (int it = 0; it < 8; ++it) { const int e = (jj * 4096 + it * 512 + tid_) * 8; const int row = (e / ld) % rows_d;
        v4u w; w.x = pk2(va[it].x, va[it].y); w.y = pk2(va[it].z, va[it].w); w.z = pk2(vb[it].x, vb[it].y); w.w = pk2(vb[it].z, vb[it].w);
        if (row >= rows_s + DS) w = (v4u){0u, 0u, 0u, 0u};
        if (row < rows_s || row >= rows_s + DS) *(GAS v4u*)(dst + e) = w; }
}
__device__ __forceinline__ void slack_item(Frame& F, int j) {
    if (j < LATE_ITEMS) { late_transpose_item(F, j); return; }
    j -= LATE_ITEMS;
    const int tid_ = fresh_tid();
    if (j < CV_BD) slack_convert<true>(F.c_bdk, F.KBC, j, tid_);
    else if (j < 2 * CV_BD) slack_convert<true>(F.c_bdv, F.VBC, j - CV_BD, tid_);
    else if (j < 2 * CV_BD + CV_MM) slack_convert<false>(F.c_mk, F.MKC, j - 2 * CV_BD, tid_);
    else slack_convert<false>(F.c_mv, F.MVC, j - 2 * CV_BD - CV_MM, tid_);
}
struct P5Row { float sq; unsigned long long yb[8]; f32x4 xv[8]; };
__device__ __forceinline__ void p5_load(Frame& F, int m, int lane, float& sq, unsigned long long (&yb)[8], f32x4 (&xv)[8]) {
    sq = (lane < 32) ? F.SSQ[(size_t)m * 32 + lane] : 0.f;
    const GAS unsigned long long* yb8 = (const GAS unsigned long long*)(F.YB + (size_t)m * DM) + lane; const GAS f32x4* x4 = (const GAS f32x4*)(F.x_prompt + (size_t)m * DM) + lane;
#pragma unroll
    for (int j = 0; j < 8; ++j) { yb[j] = __builtin_nontemporal_load(&yb8[64 * j]); xv[j] = __builtin_nontemporal_load(&x4[64 * j]); }
}
__device__ __forceinline__ void p5_finish(Frame& F, int m, int lane, float sq, const unsigned long long (&yb)[8], const f32x4 (&xv)[8], const f32x4 (&gv)[8]) {
    const float r = 1.0f / sqrtf(wave_sum(sq) * (1.0f / DM) + RMS_EPS);
    GAS f32x4* y4 = (GAS f32x4*)(F.out + (size_t)m * DM) + lane;
#pragma unroll
    for (int j = 0; j < 8; ++j) { const unsigned long long yq = yb[j];
        const f32x4 yv = {__uint_as_float((unsigned)yq << 16), __uint_as_float((unsigned)yq & 0xffff0000u), __uint_as_float((unsigned)(yq >> 32) << 16), __uint_as_float((unsigned)(yq >> 32) & 0xffff0000u)};
        __builtin_nontemporal_store(xv[j] + yv * r * gv[j], &y4[64 * j]); }
}
__device__ __forceinline__ void p5_final(Frame& F) {
    const int tid_ = fresh_tid(), lane_ = tid_ & 63, wave_ = __builtin_amdgcn_readfirstlane(tid_ >> 6);
    const int gw = F.vcu * NWAVES + wave_, NGW = F.G * NWAVES;
    f32x4 gv[8]; { const GAS f32x4* g4 = (const GAS f32x4*)F.g_post + lane_;
#pragma unroll
        for (int j = 0; j < 8; ++j) gv[j] = g4[64 * j]; }
    if (!FUSE_RMS) {
        float sa, sb; unsigned long long ya[8], yb[8]; f32x4 xa[8], xb[8]; int m = gw;
        if (m < MP) p5_load(F, m, lane_, sa, ya, xa);
        while (m < MP) {
            int m2 = m + NGW; if (m2 < MP) p5_load(F, m2, lane_, sb, yb, xb);
            p5_finish(F, m, lane_, sa, ya, xa, gv); m = m2; if (m >= MP) break;
            m2 = m + NGW; if (m2 < MP) p5_load(F, m2, lane_, sa, ya, xa);
            p5_finish(F, m, lane_, sb, yb, xb, gv); m = m2; }
    }
    for (int m = MP + gw; m < MREAL; m += NGW) {
        float s = F.SSQS[(size_t)(m - MP) * 128 + lane_] + F.SSQS[(size_t)(m - MP) * 128 + 64 + lane_];
        s = wave_sum(s);
        const float r = 1.0f / sqrtf(s * (1.0f / DM) + RMS_EPS);
        GAS f32x4* y4 = (GAS f32x4*)(F.out + (size_t)16777216 + (size_t)(m - MP) * DM) + lane_; const GAS f32x4* x4 = (const GAS f32x4*)(F.x_sample + (size_t)(m - MP) * DM) + lane_;
#pragma unroll
        for (int j = 0; j < 8; ++j) { const f32x4 yv = y4[64 * j], xv = x4[64 * j]; y4[64 * j] = xv + yv * r * gv[j]; }
    }
}

constexpr int IT_BDP = 192, IT_BDS = 48, IT_SBP = 192, IT_SBS = 48, IT_MMP = 128, IT_MMS = 32;
constexpr int IT_TOTAL = IT_BDP + IT_BDS + IT_SBP + IT_SBS + IT_MMP + IT_MMS;
struct ArgsK { const void* in[19]; float* out; unsigned char* ws; int ph_lo, ph_hi; };
struct ItemSrc {
    const ArgsK* ka; unsigned char* ws;
    __device__ __forceinline__ GAS bf16* W(size_t off) const { return (GAS bf16*)(ws + off); }
    __device__ __forceinline__ const GAS float* I(int k) const { return (const GAS float*)ka->in[k]; }
};
__device__ __forceinline__ att::Item make_item(const ItemSrc& S, int idx) {
    GAS bf16* const QSB = S.W(WS_QSB); GAS bf16* const KSB = S.W(WS_KSB); GAS bf16* const VSB = S.W(WS_VSB); GAS bf16* const GSB = S.W(WS_GSB);
    GAS bf16* const QBD = S.W(WS_QBD); GAS bf16* const KBD = S.W(WS_KBD); GAS bf16* const VBD = S.W(WS_VBD); GAS bf16* const GBD = S.W(WS_GBD);
    GAS bf16* const QMM = S.W(WS_QMM); GAS bf16* const GMM = S.W(WS_GMM); GAS bf16* const MK = S.W(WS_MK); GAS bf16* const MV = S.W(WS_MV); GAS bf16* const AUP = S.W(WS_AUP);
    att::Item it; it.dma = 0; it.bias = nullptr; it.kf = nullptr; it.vf = nullptr; it.ldf = 0; it.pf_lo = 0; it.pf_hi = 0; it.kb = nullptr; it.vb = nullptr; it.ldb = 0; it.pb_lo = 0; it.pb_hi = 0;
    if (idx < 48) idx += 192; else if (idx < 96) idx += 432 - 48; else if (idx < 128) idx += 608 - 96; else if (idx < 320) idx -= 128; else if (idx < 512) idx += 240 - 320; else idx += 480 - 512;
    if (idx < IT_BDP) {
        const int b = idx / 96, h = (idx / 16) % 6, cg = idx % 16; const size_t row0 = (size_t)b * SEQ + 256 * cg;
        it.mode = 1; it.rule = 2; it.Q = QBD + row0 * 768 + h * HD; it.ldq = 768; it.nq = 256; it.qpos0 = 256 * cg;
        it.kb = KBD + (size_t)b * SEQ * 768 + h * HD; it.vb = VBD + (size_t)b * SEQ * 768 + h * HD; it.ldb = 768; it.pb_lo = 0; it.pb_hi = SEQ;
        it.pv_lo = 0; it.pv_hi = SEQ; const int c_lo = (4 * cg - 8) > 0 ? (4 * cg - 8) : 0;
        it.kp_first = 64 * c_lo; it.kp_step = 64; it.ntiles = 4 * cg + 4 - c_lo; it.bias = S.I(11) + h * 513; it.dma = 1;
        it.O = AUP + row0 * DM + 768 + h * HD; it.ldo = DM; it.G = GBD + row0 * 768 + h * HD; it.ldg = 768; return it; }
    idx -= IT_BDP;
    if (idx < IT_BDS) {
        const int b = idx / 6, h = idx % 6; const size_t row0 = (size_t)MP + b * DS;
        it.mode = 1; it.rule = 0; it.Q = QBD + row0 * 768 + h * HD; it.ldq = 768; it.nq = DS; it.qpos0 = PAST;
        if (SLACK_P1) {
            it.kb = S.W(WS_KBC) + (size_t)b * 576 * 768 + h * HD; it.vb = S.W(WS_VBC) + (size_t)b * 576 * 768 + h * HD; it.ldb = 768; it.pb_lo = PAST - 512; it.pb_hi = PAST - 512 + 576; it.dma = 1;
        } else {
            it.kb = KBD + row0 * 768 + h * HD; it.vb = VBD + row0 * 768 + h * HD; it.ldb = 768; it.pb_lo = PAST; it.pb_hi = PAST + DS;
            it.kf = S.I(4) + (size_t)b * 512 * 768 + h * HD; it.vf = S.I(5) + (size_t)b * 512 * 768 + h * HD; it.ldf = 768; it.pf_lo = PAST - 512; it.pf_hi = PAST; }
        it.pv_lo = PAST - 512; it.pv_hi = PAST + DS; it.kp_first = PAST - 512; it.kp_step = 64; it.ntiles = 9; it.bias = S.I(11) + h * 513;
        it.O = AUP + row0 * DM + 768 + h * HD; it.ldo = DM; it.G = GBD + row0 * 768 + h * HD; it.ldg = 768; return it; }
    idx -= IT_BDS;
    if (idx < IT_SBP) {
        const int b = idx % 2, h = (idx / 2) % 6, qb = 15 - idx / 12; const size_t row0 = (size_t)b * SEQ + 256 * qb;
        it.mode = 0; it.rule = 1; it.Q = QSB + row0 * 768 + h * HD; it.ldq = 768; it.nq = 256; it.qpos0 = 256 * qb;
        it.kb = KSB + (size_t)b * SEQ * 768 + h * HD; it.vb = VSB + (size_t)b * SEQ * 768 + h * HD; it.ldb = 768; it.pb_lo = 0; it.pb_hi = SEQ;
        it.pv_lo = 0; it.pv_hi = SEQ; it.kp_first = 64 * (4 * qb + 3); it.kp_step = -64; it.ntiles = 4 * qb + 4; it.dma = 1;
        it.O = AUP + row0 * DM + h * HD; it.ldo = DM; it.G = GSB + row0 * 768 + h * HD; it.ldg = 768; return it; }
    idx -= IT_SBP;
    if (idx < IT_SBS) {
        const int b = idx / 6, h = idx % 6; const size_t row0 = (size_t)MP + b * DS;
        it.mode = 0; it.rule = 1; it.Q = QSB + row0 * 768 + h * HD; it.ldq = 768; it.nq = DS; it.qpos0 = PAST;
        it.kb = KSB + row0 * 768 + h * HD; it.vb = VSB + row0 * 768 + h * HD; it.ldb = 768; it.pb_lo = PAST; it.pb_hi = PAST + DS;
        it.kf = S.I(2) + (size_t)b * PAST * 768 + h * HD; it.vf = S.I(3) + (size_t)b * PAST * 768 + h * HD; it.ldf = 768; it.pf_lo = 0; it.pf_hi = PAST;
        it.pv_lo = 0; it.pv_hi = PAST + DS; it.kp_first = PAST + DS - 64; it.kp_step = -64; it.ntiles = (PAST + DS + 63) / 64;
        it.O = AUP + row0 * DM + h * HD; it.ldo = DM; it.G = GSB + row0 * 768 + h * HD; it.ldg = 768; return it; }
    idx -= IT_SBS;
    if (idx < IT_MMP) {
        const int b = idx / 64, h = (idx / 16) % 4, qb = idx % 16; const size_t row0 = (size_t)b * SEQ + 256 * qb;
        it.mode = 1; it.rule = 0; it.Q = QMM + row0 * 512 + h * HD; it.ldq = 512; it.nq = 256; it.qpos0 = 0;
        it.kb = MK + (size_t)b * NMEM * 512 + h * HD; it.vb = MV + (size_t)b * NMEM * 512 + h * HD; it.ldb = 512; it.pb_lo = 0; it.pb_hi = NMEM;
        it.pv_lo = 0; it.pv_hi = NMEM; it.kp_first = 0; it.kp_step = 64; it.ntiles = 4; it.dma = 1;
        it.O = AUP + row0 * DM + 1536 + h * HD; it.ldo = DM; it.G = GMM + row0 * 512 + h * HD; it.ldg = 512; return it; }
    idx -= IT_MMP;
    {
        const int b = idx / 4, h = idx % 4; const size_t row0 = (size_t)MP + b * DS;
        it.mode = 1; it.rule = 0; it.Q = QMM + row0 * 512 + h * HD; it.ldq = 512; it.nq = DS; it.qpos0 = 0;
        if (SLACK_P1) { it.kb = S.W(WS_MKC) + (size_t)b * NMEM * 512 + h * HD; it.vb = S.W(WS_MVC) + (size_t)b * NMEM * 512 + h * HD; it.ldb = 512; it.pb_lo = 0; it.pb_hi = NMEM; it.dma = 1; }
        else { it.kf = S.I(6) + (size_t)b * NMEM * 512 + h * HD; it.vf = S.I(7) + (size_t)b * NMEM * 512 + h * HD; it.ldf = 512; it.pf_lo = 0; it.pf_hi = NMEM; }
        it.pv_lo = 0; it.pv_hi = NMEM; it.kp_first = 0; it.kp_step = 64; it.ntiles = 4;
        it.O = AUP + row0 * DM + 1536 + h * HD; it.ldo = DM; it.G = GMM + row0 * 512 + h * HD; it.ldg = 512; return it; }
}

struct Args { const void* in[19]; float* out; unsigned char* ws; int ph_lo, ph_hi; };
__global__ void __launch_bounds__(NWAVES * 64, 2) fwd_megakernel(Args args) {
    extern __shared__ __attribute__((aligned(16))) unsigned char lds[];
    Frame F;
    F.lds = (LAS unsigned char*)lds;
    F.MISC = (volatile LAS unsigned*)(F.lds + MISC_OFF);
    F.G = gridDim.x; { const int bx = blockIdx.x; F.vcu = (F.G % 8 == 0) ? (bx % 8) * (F.G / 8) + bx / 8 : bx; }
    unsigned char* ws = args.ws;
    F.ctl = (gu32*)(ws + WS_CTL);
    F.x_prompt = (const float*)args.in[0]; F.x_sample = (const float*)args.in[1]; F.c_sbk = (const float*)args.in[2]; F.c_sbv = (const float*)args.in[3];
    F.c_bdk = (const float*)args.in[4]; F.c_bdv = (const float*)args.in[5]; F.c_mk = (const float*)args.in[6]; F.c_mv = (const float*)args.in[7];
    F.mem_prompt = (const float*)args.in[8]; F.g_pre = (const float*)args.in[9]; F.w_in = (const float*)args.in[10]; F.rel_bias = (const float*)args.in[11];
    F.g_mem = (const float*)args.in[12]; F.w_mem_kv = (const float*)args.in[13]; F.w_up_sb = (const float*)args.in[14]; F.w_up_band = (const float*)args.in[15];
    F.w_up_mem = (const float*)args.in[16]; F.w_out = (const float*)args.in[17]; F.g_post = (const float*)args.in[18];
    F.out = args.out;
    F.WCAT = (bf16*)(ws + WS_WCAT); F.WUP = (bf16*)(ws + WS_WUP); F.WOUT = (bf16*)(ws + WS_WOUT); F.ACAT = (bf16*)(ws + WS_ACAT); F.MERGED = (bf16*)(ws + WS_ACAT);
    F.QSB = (bf16*)(ws + WS_QSB); F.KSB = (bf16*)(ws + WS_KSB); F.VSB = (bf16*)(ws + WS_VSB); F.GSB = (bf16*)(ws + WS_GSB);
    F.QBD = (bf16*)(ws + WS_QBD); F.KBD = (bf16*)(ws + WS_KBD); F.VBD = (bf16*)(ws + WS_VBD); F.GBD = (bf16*)(ws + WS_GBD);
    F.QMM = (bf16*)(ws + WS_QMM); F.GMM = (bf16*)(ws + WS_GMM); F.MG = (bf16*)(ws + WS_MG); F.MK = (bf16*)(ws + WS_MK); F.MV = (bf16*)(ws + WS_MV);
    F.AUP = (bf16*)(ws + WS_AUP); F.SSQ = (float*)(ws + WS_SSQ); F.SSQS = (float*)(ws + WS_SSQS); F.YB = (bf16*)(ws + WS_YB); F.KBC = (bf16*)(ws + WS_KBC); F.VBC = (bf16*)(ws + WS_VBC); F.MKC = (bf16*)(ws + WS_MKC); F.MVC = (bf16*)(ws + WS_MVC);
    for (int u = threadIdx.x; u < (STG_OFF - LDSCTL_OFF) / 4; u += NWAVES * 64) ((LAS unsigned*)(F.lds + LDSCTL_OFF))[u] = 0u;
    __syncthreads();
    XcdBarrier bar; bar.bar = (unsigned*)(F.ctl + CW_BAR); bar.x = 0; bar.st = nullptr;
    if (N_LAUNCHES != PER_PHASE) bar = xcd_barrier_post((unsigned*)(F.ctl + CW_BAR), F.MISC + 8);
#define GRID_BAR() do { if (N_LAUNCHES != PER_PHASE) xcd_barrier(bar); } while (0)
    const int lo = args.ph_lo, hi = args.ph_hi;
#ifdef ONLY_PHASE
#define IN(k) ((k) == ONLY_PHASE && lo <= (k) && (k) < hi)
#else
#define IN(k) (lo <= (k) && (k) < hi)
#endif
#define BOTH(k) (IN(k) && IN((k) + 1))
#ifdef PROBE_PHASE
#define PROBE_T0(k) do { if ((k) == PROBE_PHASE && blockIdx.x == 0 && threadIdx.x == 0) { const unsigned long long t_ = __builtin_amdgcn_s_memrealtime(); F.MISC[20] = (unsigned)t_; F.MISC[21] = (unsigned)(t_ >> 32); } } while (0)
#define PROBE_T1(k) do { if ((k) == PROBE_PHASE) { if (blockIdx.x == 0 && threadIdx.x == 0) { const unsigned long long t1_ = __builtin_amdgcn_s_memrealtime(), t0_ = (unsigned long long)F.MISC[20] | ((unsigned long long)F.MISC[21] << 32); \
        const unsigned long long te_ = t1_ + (unsigned long long)(PROBE_K) * (t1_ - t0_); unsigned n_ = 0; while (__builtin_amdgcn_s_memrealtime() < te_ && ++n_ < (1u << 22)) __builtin_amdgcn_s_sleep(4); } \
        __syncthreads(); GRID_BAR(); } } while (0)
#else
#define PROBE_T0(k) do { } while (0)
#define PROBE_T1(k) do { } while (0)
#endif
    if (IN(0)) { PROBE_T0(0); p0_prologue(F); if (BOTH(0)) GRID_BAR(); PROBE_T1(0); }
    if (IN(1)) {
        PROBE_T0(1);
        pg8::Gemm g{F.ACAT, F.WCAT, MA, NCAT, DM}; ep::InOrder S; S.init(F.G, (int)blockIdx.x);
        ep::EpiIn E{F.QSB, F.KSB, F.VSB, F.GSB, F.QBD, F.KBD, F.VBD, F.GBD, F.QMM, F.GMM, F.MG, F.MK, F.MV, F.out, F.lds + STG_OFF, F.KBC, F.VBC};
        {
        pg8::gemm_phase<ep::EpiIn, ep::InOrder, true, true>(F.lds, g, S, E);
        if (SLACK_P1) {
            volatile LAS int* sl = (volatile LAS int*)(F.MISC + 12);
            for (;;) {
                if (threadIdx.x == 0) *sl = (int)__hip_atomic_fetch_add((unsigned*)(F.ctl + CW_WORK + 64), 1u, RLX_AGENT);
                __syncthreads();
                const int j = __builtin_amdgcn_readfirstlane(*sl);
                __syncthreads();
                if (j >= SLACK_ITEMS) break;
                slack_item(F, j);
            }
        }
        if (BOTH(1)) GRID_BAR(); }
        PROBE_T1(1);
    }
    if (IN(2)) {
        static_assert(SLACK_P1 || !LATE_WT, "the late transposes run in P1's slack");
        PROBE_T0(2);
        volatile LAS int* slot = (volatile LAS int*)(F.lds + att::OFF_ITEM);
        for (;;) {
            if (threadIdx.x == 0) *slot = (int)__hip_atomic_fetch_add((unsigned*)(F.ctl + CW_WORK), 1u, RLX_AGENT);
            __syncthreads();
            const int idx = __builtin_amdgcn_readfirstlane(*slot);
            __syncthreads();
#ifdef PROBE_P2_N
            if (idx >= IT_TOTAL + PROBE_P2_N) break;
            const int qidx = idx < PROBE_P2_N ? PROBE_P2_BASE + idx : idx - PROBE_P2_N;
#else
            if (idx >= IT_TOTAL) break;
            const int qidx = idx;
#endif
            const ArgsK* ka = (const ArgsK*)__builtin_amdgcn_kernarg_segment_ptr(); unsigned char* wsl = args.ws;
            asm volatile("" : "+s"(ka), "+s"(wsl));
            const ItemSrc isrc{ka, wsl};
            const att::Item it = make_item(isrc, qidx);
            if (it.dma) { if (it.mode == 0) att::run_item<0, true>(it, (char*)lds, F.lds); else att::run_item<1, true>(it, (char*)lds, F.lds); }
            else { if (it.mode == 0) att::run_item<0, false>(it, (char*)lds, F.lds); else att::run_item<1, false>(it, (char*)lds, F.lds); }
        }
        if (BOTH(2)) GRID_BAR();
        PROBE_T1(2);
    }
    if (IN(3)) {
        PROBE_T0(3);
        pg8::Gemm g{F.AUP, F.WUP, MIN_, DM, DM}; ep::MergeOrder S; S.init(F.G, (int)blockIdx.x);
        ep::EpiMerge E{F.MG, F.MERGED};
        const bool skf = (F.vcu & 1) != 0;
        int two = 2; asm volatile("" : "+s"(two));
#pragma unroll 1
        for (int pass = 0; pass < two; ++pass) {
            if (skf == (pass == 0)) for (int sl = F.vcu; sl < 256; sl += F.G) ep::skinny_phase<0>(F.AUP, F.WUP, F.MG, F.MERGED, nullptr, nullptr, sl, F.lds);
            if (pass == 0) pg8::gemm_phase<ep::EpiMerge, ep::MergeOrder, true, true>(F.lds, g, S, E);
        }
        if (BOTH(3)) GRID_BAR();
        PROBE_T1(3);
    }
    if (IN(4)) {
        PROBE_T0(4);
        pg8::Gemm g{F.MERGED, F.WOUT, MP, DM, DM}; pg8::StaticOrder S; S.init(MP, DM, F.G, (int)blockIdx.x);
#if FUSE_RMS
        ep::EpiOutFused E{F.x_prompt, F.out, F.g_post, (float*)(ws + WS_XBUF), (unsigned*)(F.ctl + CW_PANEL), (unsigned*)(F.ctl + CW_TMO)};
        {
        pg8::gemm_phase<ep::EpiOutFused, pg8::StaticOrder, false, true>(F.lds, g, S, E);
        for (int sl = F.vcu; sl < 256; sl += F.G) ep::skinny_phase<1>(F.MERGED, F.WOUT, nullptr, nullptr, F.out + 16777216, F.SSQS, sl, F.lds);
#else
        ep::EpiOut E{F.YB, F.SSQ};
        {
        const bool skf = (F.vcu & 1) != 0;
        int two = 2; asm volatile("" : "+s"(two));
#pragma unroll 1
        for (int pass = 0; pass < two; ++pass) {
            if (skf == (pass == 0)) for (int sl = F.vcu; sl < 256; sl += F.G) ep::skinny_phase<1>(F.MERGED, F.WOUT, nullptr, nullptr, F.out + 16777216, F.SSQS, sl, F.lds);
            if (pass == 0) pg8::gemm_phase<ep::EpiOut, pg8::StaticOrder, true, true>(F.lds, g, S, E);
        }
#endif
        if (BOTH(4)) GRID_BAR(); }
        PROBE_T1(4);
    }
#ifdef PROBE_PHASE
    if (IN(5)) { PROBE_T0(5); p5_final(F); if (PROBE_PHASE == 5) GRID_BAR(); PROBE_T1(5); }
#else
    if (IN(5)) p5_final(F);
#endif
#undef IN
#undef BOTH
#undef GRID_BAR
#undef PROBE_T0
#undef PROBE_T1
}

extern "C" void kernel_launch(void* const* d_in, const int* in_sizes, int n_in, void* d_out, int out_size, void* d_ws, size_t ws_size, hipStream_t stream) {
    static int grid = 0;
    if (grid == 0) {
        if (n_in != 19 || in_sizes[0] != MP * DM || in_sizes[10] != DM * INW || out_size != OUT_ELEMS || ws_size < WS_END) {
            fprintf(stderr, "kernel_launch: built for 19 inputs, x_prompt %d, w_in %d, out %d floats, >= %zu bytes of workspace; got n_in %d, in0 %d, in10 %d, out %d, ws %zu; nothing launched\n",
                    MP * DM, DM * INW, OUT_ELEMS, (size_t)WS_END, n_in, n_in > 0 ? in_sizes[0] : -1, n_in > 10 ? in_sizes[10] : -1, out_size, ws_size);
            grid = -1; return; }
        int dev = 0, cus = 0, per_cu = 0;
        if (hipGetDevice(&dev) != hipSuccess || hipDeviceGetAttribute(&cus, hipDeviceAttributeMultiprocessorCount, dev) != hipSuccess) { fprintf(stderr, "kernel_launch: device query failed\n"); grid = -1; return; }
        if (hipFuncSetAttribute((const void*)fwd_megakernel, hipFuncAttributeMaxDynamicSharedMemorySize, LDS_BYTES) != hipSuccess) { fprintf(stderr, "kernel_launch: hipFuncSetAttribute(%d B LDS) failed\n", LDS_BYTES); grid = -1; return; }
        if (hipOccupancyMaxActiveBlocksPerMultiprocessor(&per_cu, (const void*)fwd_megakernel, NWAVES * 64, LDS_BYTES) != hipSuccess || per_cu < 1) {
            fprintf(stderr, "kernel_launch: occupancy query reports %d workgroups per CU; nothing launched\n", per_cu); (void)hipGetLastError(); grid = -1; return; }
        grid = cus;
    }
    if (grid < 0) return;
    if (hipMemsetAsync((char*)d_ws + WS_CTL, 0, CTL_ZERO_BYTES, stream) != hipSuccess) { fprintf(stderr, "kernel_launch: hipMemsetAsync failed\n"); return; }
    Args a{};
    for (int i = 0; i < 19; ++i) a.in[i] = d_in[i];
    a.out = (float*)d_out; a.ws = (unsigned char*)d_ws;
    if (N_LAUNCHES == 1) {
        a.ph_lo = 0; a.ph_hi = PER_PHASE;
        hipLaunchKernelGGL(fwd_megakernel, dim3(grid), dim3(NWAVES * 64), LDS_BYTES, stream, a);
    } else {
        for (int li = 0; li < PER_PHASE; ++li) { a.ph_lo = li; a.ph_hi = li + 1; hipLaunchKernelGGL(fwd_megakernel, dim3(grid), dim3(NWAVES * 64), LDS_BYTES, stream, a); }
    }
    const hipError_t le = hipPeekAtLastError();
    if (le != hipSuccess) fprintf(stderr, "kernel_launch: launch failed: %s (grid %d)\n", hipGetErrorName(le), grid);
}
```

```cpp
#include <hip/hip_runtime.h>
#include <hip/hip_bf16.h>
#include <cstdio>
#include <cstdint>

#ifndef MK_N_LAUNCHES
#define MK_N_LAUNCHES 1
#endif
#ifndef FUSE_RMS
#define FUSE_RMS 0
#endif
#ifndef LATE_WT
#define LATE_WT 1
#endif
#ifndef SLACK_P1
#define SLACK_P1 1
#endif
#ifndef SB_EARLY_EXIT
#define SB_EARLY_EXIT 1
#endif

constexpr int DM = 2048, SEQ = 4096, NB = 2, DB = 8, DS = 16, PAST = 4096, HD = 128;
constexpr int MP = NB * SEQ;
constexpr int MS = DB * DS;
constexpr int MIN_ = 8448;
constexpr int MREAL = MP + MS;
constexpr int MMEM0 = 8448;
constexpr int MA = 8960;
constexpr int INW = 13312, NCAT = 14336;
constexpr int NMEM = 256;
constexpr float RMS_EPS = 1e-6f;
constexpr float LOG2E = 1.4426950408889634f;
constexpr float QSCALE = 0.08838834764831845f * 1.4426950408889634f;

namespace pg8 {
#define PG8_LAS __attribute__((address_space(3)))
typedef unsigned short bf16_t;
typedef short bf16x8 __attribute__((ext_vector_type(8)));
typedef float f32x4 __attribute__((ext_vector_type(4)));
typedef unsigned u32x4 __attribute__((ext_vector_type(4)));
constexpr int BM = 256, BK = 64, HALF = 128, HTB = HALF * BK * 2  , STAGE_BYTES = 8 * HTB, NXCD = 8, WGM = 8;

__host__ __device__ __forceinline__ int lds_byte(int r, int c) { const int st = (r >> 4) * 2 + (c >> 5), rr = r & 15, cc = c & 31, ob = rr * 64 + cc * 2; return st * 1024 + (ob ^ (((ob >> 9) & 1) << 5)); }
__host__ __device__ __forceinline__ void stage_rc(int b, int& R, int& C) { const int st = b / 1024, sb = b % 1024, swz = sb ^ (((sb >> 9) & 1) << 5); R = (st >> 1) * 16 + swz / 64; C = (st & 1) * 32 + (swz % 64) / 2; }
__host__ __device__ __forceinline__ int perm32(int rho) { const int n = rho >> 4, i = rho & 15; return 8 * (i >> 2) + 4 * n + (i & 3); }

struct Unit { int pm, pn, k0, nt; };
struct Gemm { const bf16_t* A; const bf16_t* Bt; int M, N, K; };

struct StaticOrder {
    int nM, nN, nwg, G, c;
    __host__ __device__ void init(int M, int N, int G_, int c_) { nM = M / BM; nN = N / BM; nwg = nM * nN; G = G_; c = c_; }
    __host__ __device__ bool next(int i, Unit& u) const {
        const long L = (long)i * G + c; if (L >= nwg) return false;
        int wgid = (int)L; { const int q = nwg / NXCD, r = nwg % NXCD, xcd = wgid % NXCD, off = wgid / NXCD; wgid = (xcd < r ? xcd * (q + 1) : r * (q + 1) + (xcd - r) * q) + off; }
        const int nig = WGM * nN, gid = wgid / nig, fm = gid * WGM, gsz = (nM - fm) < WGM ? (nM - fm) : WGM;
        u.pm = fm + ((wgid % nig) % gsz); u.pn = (wgid % nig) / gsz; u.k0 = 0; u.nt = 0; return true;
    }
    __device__ __forceinline__ void a_ready(const Unit&) const {}
    __device__ __forceinline__ void done(const Unit&) const {}
};

typedef float f32x2_t __attribute__((ext_vector_type(2))); typedef __bf16 bf16x2_t __attribute__((ext_vector_type(2)));
__device__ __forceinline__ unsigned cvt_pk_bf16(float lo, float hi) { f32x2_t v = {lo, hi}; bf16x2_t b = __builtin_convertvector(v, bf16x2_t); return __builtin_bit_cast(unsigned, b); }

template <class Epi, class Sched, bool ALIGN_EPI = false, bool SP2 = false>
__device__ __forceinline__ void gemm_phase(PG8_LAS unsigned char* lds, const Gemm g, const Sched& S, const Epi& E) {
    int tid_ = threadIdx.x; asm volatile("" : "+v"(tid_));
    const int tid = tid_, wid = __builtin_amdgcn_readfirstlane(tid >> 6), lane = tid & 63, wr = wid >> 2, wc = wid & 3, fr = lane & 15, fq = lane >> 4;
    const int K = g.K, nt = K / BK;
    unsigned voffA[2], voffB[2];
#pragma unroll
    for (int i = 0; i < 2; ++i) { int R, C; stage_rc(tid * 16 + i * 8192, R, C); const int Rb = Epi::PERM ? ((R & ~31) + perm32(R & 31)) : R;
        voffA[i] = (unsigned)(R * K + C) * 2u; voffB[i] = (unsigned)(Rb * K + C) * 2u; }
    const size_t kstep = (size_t)(BK * 2);
    const size_t hstep = (size_t)HALF * K * 2;
    const size_t tstep = 2 * hstep;
    const unsigned ldsw = (unsigned)wid * 1024u;
    const int aoff = lds_byte(wr * 64 + fr, fq * 8), boff = lds_byte(wc * 32 + fr, fq * 8);
#define PG8_SA(b, h) (((b) * 2 + (h)) * HTB)
#define PG8_SB(b, h) ((4 + (b) * 2 + (h)) * HTB)
#define PG8_STAGE(bufoff, gbase, voff) do { _Pragma("unroll") for (int _i = 0; _i < 2; ++_i) \
        __builtin_amdgcn_global_load_lds((const unsigned*)((const char*)(gbase) + (voff)[_i]), (PG8_LAS unsigned*)(lds + (bufoff) + ldsw + _i * 8192), 16, 0, 0); } while (0)
#define PG8_LDA(dst, b, h) do { _Pragma("unroll") for (int m = 0; m < 4; ++m) _Pragma("unroll") for (int k = 0; k < 2; ++k) dst[m][k] = *(const PG8_LAS bf16x8*)(lds + PG8_SA(b, h) + aoff + m * 2048 + k * 1024); } while (0)
#define PG8_LDB(dst, b, h) do { _Pragma("unroll") for (int n = 0; n < 2; ++n) _Pragma("unroll") for (int k = 0; k < 2; ++k) dst[n][k] = *(const PG8_LAS bf16x8*)(lds + PG8_SB(b, h) + boff + n * 2048 + k * 1024); } while (0)
#define PG8_MMA(ai, bj, At, Bt) do { __builtin_amdgcn_s_setprio(1); _Pragma("unroll") for (int m = 0; m < 4; ++m) _Pragma("unroll") for (int n = 0; n < 2; ++n) _Pragma("unroll") for (int k = 0; k < 2; ++k) \
        acc[ai][bj][m][n] = __builtin_amdgcn_mfma_f32_16x16x32_bf16(Bt[n][k], At[m][k], acc[ai][bj][m][n], 0, 0, 0); __builtin_amdgcn_s_setprio(0); } while (0)
#define PG8_WAIT_V(n) asm volatile("s_waitcnt vmcnt(" #n ")" ::: "memory")
#define PG8_WAIT_L(n) asm volatile("s_waitcnt lgkmcnt(" #n ")" ::: "memory")
#define PG8_BAR __builtin_amdgcn_s_barrier()
#define PG8_SCHED __builtin_amdgcn_sched_barrier(0)
    Unit cur, nxt; int ui = 0;
    if (!S.next(0, cur)) return;
    f32x4 acc[2][2][4][2];
#pragma unroll
    for (int a = 0; a < 2; ++a)
#pragma unroll
        for (int b = 0; b < 2; ++b)
#pragma unroll
            for (int m = 0; m < 4; ++m)
#pragma unroll
                for (int n = 0; n < 2; ++n) acc[a][b][m][n] = (f32x4){0.f, 0.f, 0.f, 0.f};
    bf16x8 At[4][2], B0[2][2], B1[2][2];
    const char* cA = (const char*)g.A + (size_t)cur.pm * tstep + (size_t)cur.k0 * 2; const char* cB = (const char*)g.Bt + (size_t)cur.pn * tstep + (size_t)cur.k0 * 2;
    S.a_ready(cur);
    if constexpr (SP2) {
        PG8_STAGE(PG8_SB(0, 0), cB, voffB); PG8_STAGE(PG8_SB(0, 1), cB + hstep, voffB); PG8_STAGE(PG8_SA(0, 0), cA, voffA); PG8_STAGE(PG8_SA(0, 1), cA + hstep, voffA);
        if (wr == 1) PG8_BAR;
        PG8_WAIT_V(2); PG8_BAR;
        PG8_STAGE(PG8_SB(1, 0), cB + kstep, voffB); PG8_STAGE(PG8_SA(1, 0), cA + kstep, voffA); PG8_STAGE(PG8_SB(1, 1), cB + hstep + kstep, voffB);
        PG8_WAIT_V(6); PG8_BAR;
    } else {
        PG8_STAGE(PG8_SB(0, 0), cB, voffB); PG8_STAGE(PG8_SA(0, 0), cA, voffA); PG8_STAGE(PG8_SB(0, 1), cB + hstep, voffB); PG8_STAGE(PG8_SA(0, 1), cA + hstep, voffA);
        if (wr == 1) PG8_BAR;
        PG8_WAIT_V(4); PG8_BAR;
        PG8_STAGE(PG8_SB(1, 0), cB + kstep, voffB); PG8_STAGE(PG8_SA(1, 0), cA + kstep, voffA); PG8_STAGE(PG8_SB(1, 1), cB + hstep + kstep, voffB);
        PG8_WAIT_V(6); PG8_BAR;
    }
    for (;;) {
        const bool has_next = S.next(ui + 1, nxt);
        const char* nA = has_next ? (const char*)g.A + (size_t)nxt.pm * tstep + (size_t)nxt.k0 * 2 : cA; const char* nB = has_next ? (const char*)g.Bt + (size_t)nxt.pn * tstep + (size_t)nxt.k0 * 2 : cB;
        const int ntu = cur.nt ? cur.nt : nt;
        for (int t = 0; t < ntu; t += 2) {
            const bool last = (t == ntu - 2);
            const char* a1 = cA + (size_t)(t + 1) * kstep;
            const char* a2 = last ? nA : cA + (size_t)(t + 2) * kstep; const char* b2 = last ? nB : cB + (size_t)(t + 2) * kstep;
            const char* a3 = a2 + kstep; const char* b3 = b2 + kstep;
            if (last && has_next) S.a_ready(nxt);
            if constexpr (SP2) {
            PG8_LDB(B0, 0, 0); PG8_LDB(B1, 0, 1); PG8_SCHED; PG8_LDA(At, 0, 0); PG8_STAGE(PG8_SA(1, 1), a1 + hstep, voffA);
            PG8_WAIT_V(8); PG8_WAIT_L(0); PG8_BAR; PG8_MMA(0, 0, At, B0); PG8_MMA(0, 1, At, B1); PG8_BAR; PG8_SCHED;
            PG8_LDA(At, 0, 1); PG8_STAGE(PG8_SB(0, 0), b2, voffB); PG8_STAGE(PG8_SB(0, 1), b2 + hstep, voffB); PG8_STAGE(PG8_SA(0, 0), a2, voffA);
            PG8_WAIT_V(8); PG8_WAIT_L(0); PG8_BAR; PG8_MMA(1, 0, At, B0); PG8_MMA(1, 1, At, B1); PG8_BAR; PG8_SCHED;
            PG8_LDB(B0, 1, 0); PG8_LDB(B1, 1, 1); PG8_SCHED; PG8_LDA(At, 1, 0); PG8_STAGE(PG8_SA(0, 1), a2 + hstep, voffA);
            PG8_WAIT_V(8); PG8_WAIT_L(0); PG8_BAR; PG8_MMA(0, 0, At, B0); PG8_MMA(0, 1, At, B1); PG8_BAR; PG8_SCHED;
            PG8_LDA(At, 1, 1); PG8_STAGE(PG8_SB(1, 0), b3, voffB); PG8_STAGE(PG8_SB(1, 1), b3 + hstep, voffB); PG8_STAGE(PG8_SA(1, 0), a3, voffA);
            PG8_WAIT_V(8); PG8_WAIT_L(0); PG8_BAR; PG8_MMA(1, 0, At, B0); PG8_MMA(1, 1, At, B1); PG8_BAR; PG8_SCHED;
            } else {
            PG8_LDB(B0, 0, 0); PG8_SCHED; PG8_LDA(At, 0, 0); PG8_STAGE(PG8_SA(1, 1), a1 + hstep, voffA);
            PG8_WAIT_L(8); PG8_BAR; PG8_WAIT_L(0); PG8_MMA(0, 0, At, B0); PG8_BAR; PG8_SCHED;
            PG8_LDB(B1, 0, 1); PG8_STAGE(PG8_SB(0, 0), b2, voffB);
            PG8_BAR; PG8_WAIT_L(0); PG8_MMA(0, 1, At, B1); PG8_BAR;
            PG8_LDA(At, 0, 1); PG8_STAGE(PG8_SA(0, 0), a2, voffA);
            PG8_BAR; PG8_WAIT_L(0); PG8_MMA(1, 0, At, B0); PG8_BAR; PG8_SCHED;
            PG8_STAGE(PG8_SB(0, 1), b2 + hstep, voffB);
            PG8_WAIT_V(6); PG8_BAR; PG8_MMA(1, 1, At, B1); PG8_BAR;
            PG8_LDB(B0, 1, 0); PG8_SCHED; PG8_LDA(At, 1, 0); PG8_STAGE(PG8_SA(0, 1), a2 + hstep, voffA);
            PG8_WAIT_L(8); PG8_BAR; PG8_WAIT_L(0); PG8_MMA(0, 0, At, B0); PG8_BAR; PG8_SCHED;
            PG8_LDB(B1, 1, 1); PG8_STAGE(PG8_SB(1, 0), b3, voffB);
            PG8_BAR; PG8_WAIT_L(0); PG8_MMA(0, 1, At, B1); PG8_BAR;
            PG8_LDA(At, 1, 1); PG8_STAGE(PG8_SA(1, 0), a3, voffA);
            PG8_BAR; PG8_WAIT_L(0); PG8_MMA(1, 0, At, B0); PG8_BAR; PG8_SCHED;
            PG8_STAGE(PG8_SB(1, 1), b3 + hstep, voffB);
            PG8_WAIT_V(6); PG8_BAR; PG8_MMA(1, 1, At, B1); PG8_BAR;
            }
        }
        if constexpr (ALIGN_EPI) { if (wr == 0) PG8_BAR; }
        if constexpr (!Epi::AFTER_DRAIN) { E(acc, cur, wr, wc, fr, fq); S.done(cur); }
        if (!has_next) break;
        if (E.reset_after(cur))
#pragma unroll
        for (int a = 0; a < 2; ++a)
#pragma unroll
            for (int b = 0; b < 2; ++b)
#pragma unroll
                for (int m = 0; m < 4; ++m)
#pragma unroll
                    for (int n = 0; n < 2; ++n) acc[a][b][m][n] = (f32x4){0.f, 0.f, 0.f, 0.f};
        cur = nxt; cA = nA; cB = nB; ++ui;
        if constexpr (ALIGN_EPI) { if (wr == 1) PG8_BAR; }
    }
    PG8_WAIT_V(0);
    if constexpr (!ALIGN_EPI) { if (wr == 0) PG8_BAR; }
    PG8_BAR;
    if constexpr (Epi::AFTER_DRAIN) { E.fused(acc, cur, wr, wc, fr, fq, lds, wid, lane); S.done(cur); }
#undef PG8_SA
#undef PG8_SB
#undef PG8_STAGE
#undef PG8_LDA
#undef PG8_LDB
#undef PG8_MMA
#undef PG8_WAIT_V
#undef PG8_WAIT_L
#undef PG8_BAR
#undef PG8_SCHED
}
}

namespace ep {
using pg8::f32x4; using pg8::u32x4; using pg8::Unit; using pg8::bf16_t; using pg8::HALF; using pg8::BM; using pg8::cvt_pk_bf16;
typedef unsigned u32x2 __attribute__((ext_vector_type(2)));

struct InOrder {
    pg8::StaticOrder so; int G, c;
    __device__ void init(int G_, int c_) { so.init(MIN_, INW, G_, c_); G = G_; c = c_; }
    __device__ bool next(int i, Unit& u) const {
        const long L = (long)i * G + c;
        if (L < so.nwg) return so.next(i, u);
        const int j = (int)(L - so.nwg); if (j >= 8) return false;
        u.pm = 33 + (j & 1); u.pn = 52 + (j >> 1); u.k0 = 0; u.nt = 0; return true;
    }
    __device__ __forceinline__ void a_ready(const Unit&) const {}
    __device__ __forceinline__ void done(const Unit&) const {}
};

__device__ __forceinline__ size_t mg_off(int pm, int pn, int seg, int wave, int ai, int m, int bj, int lane) { return ((size_t)((pm * 8 + pn) * 3 + seg) << 16) + wave * 8192 + ((ai * 4 + m) * 2 + bj) * 512 + lane * 8; }
__device__ __forceinline__ float sigmoidf_fast(float x) { return __builtin_amdgcn_rcpf(1.0f + __builtin_amdgcn_exp2f(-x * LOG2E)); }
__device__ __forceinline__ float bf2f(unsigned short h) { return __uint_as_float((unsigned)h << 16); }

struct EpiIn {
    static constexpr bool PERM = true, AFTER_DRAIN = false;
    bf16_t *QSB, *KSB, *VSB, *GSB, *QBD, *KBD, *VBD, *GBD, *QMM, *GMM, *MG, *MK, *MV;
    float* out;
    __attribute__((address_space(3))) unsigned char* stg;
    bf16_t *KBC, *VBC;
    __device__ __forceinline__ bool reset_after(const Unit&) const { return true; }
    template <int ACT, int F32>
    __device__ __forceinline__ void store(const f32x4 (&acc)[2][2][4][2], bf16_t* dst, int ldc, int colt, int rowoff, int pm, float* f0, float* f1, int wr, int wc, int fr, int fq, bf16_t* bdc = nullptr) const {
        const int col0 = colt + wc * 32 + 8 * fq;
#pragma unroll
        for (int ai = 0; ai < 2; ++ai)
#pragma unroll
            for (int m = 0; m < 4; ++m) {
                const int r = pm * BM + ai * HALF + wr * 64 + m * 16 + fr;
                bf16_t* rowp = dst + (size_t)(r - rowoff) * ldc + col0;
                float* frow = nullptr;
                if (F32 == 1) { if (r < MP) frow = f0 + (size_t)r * 768; else if (r < MREAL) frow = f1 + (size_t)(r - MP) * 768; }
                if (F32 == 2) { if (r < MP) { const int t = r & (SEQ - 1); if (t >= SEQ - 512) frow = f0 + ((size_t)(r >> 12) * 512 + (t - (SEQ - 512))) * 768; } else if (r < MREAL) frow = f1 + (size_t)(r - MP) * 768; }
                if (F32 == 3) frow = f0 + (size_t)(r - MMEM0) * 512;
#pragma unroll
                for (int bj = 0; bj < 2; ++bj) {
                    f32x4 v0 = acc[ai][bj][m][0], v1 = acc[ai][bj][m][1];
                    if (F32 != 0) { if (frow) { __builtin_nontemporal_store(v0, (f32x4*)(frow + col0 + bj * HALF)); __builtin_nontemporal_store(v1, (f32x4*)(frow + col0 + bj * HALF + 4)); } }
                    if (ACT == 1) { v0 = v0 * QSCALE; v1 = v1 * QSCALE; }
                    if (ACT == 2) {
#pragma unroll
                        for (int e = 0; e < 4; ++e) { v0[e] = v0[e] * sigmoidf_fast(v0[e]); v1[e] = v1[e] * sigmoidf_fast(v1[e]); } }
                    if (ACT == 3) {
#pragma unroll
                        for (int e = 0; e < 4; ++e) { v0[e] = sigmoidf_fast(v0[e]); v1[e] = sigmoidf_fast(v1[e]); } }
                    u32x4 w; w.x = cvt_pk_bf16(v0[0], v0[1]); w.y = cvt_pk_bf16(v0[2], v0[3]); w.z = cvt_pk_bf16(v1[0], v1[1]); w.w = cvt_pk_bf16(v1[2], v1[3]);
                    *(u32x4*)(rowp + bj * HALF) = w;
                    if (F32 == 2 && SLACK_P1) { if (r >= MP && r < MREAL) *(u32x4*)(bdc + ((size_t)((r - MP) >> 4) * 576 + 512 + ((r - MP) & 15)) * 768 + col0 + bj * HALF) = w; } }
            }
    }
    __device__ __forceinline__ void store_gates(const f32x4 (&acc)[2][2][4][2], int t, int pm, int wr, int wc, int fr, int fq) const {
        typedef float f32x2 __attribute__((ext_vector_type(2)));
        typedef __attribute__((address_space(3))) u32x2 lu32x2; typedef __attribute__((address_space(3))) u32x4 lu32x4;
        const int sld = (t < 24) ? 768 : 512;
        bf16_t* const sdst = (t < 12) ? GSB + 64 * t : (t < 24 ? GBD + 64 * (t - 12) : GMM + 64 * (t - 24));
        constexpr float CAP = 1073741824.0f, NLN2 = -0.6931471805599453f;
        const int row32 = wr * 16 + fr;
        const int woff = row32 * 128 + ((wc ^ ((row32 >> 1) & 3)) << 5) + fq * 8;
        const int tid = threadIdx.x, kq = tid >> 8;
        const int mfr = tid & 15, mpart = (tid >> 4) & 7, mwr = (tid >> 7) & 1, mrow = mwr * 16 + mfr;
        const int moff = mrow * 128 + ((((mpart >> 1) ^ ((mrow >> 1) & 3)) << 5) | ((mpart & 1) << 4));
        const int mpn = t >> 2, mbj = (t & 3) >> 1, mwave = mwr * 4 + (t & 1) * 2 + (mpart >> 2), mlane = (mpart & 3) * 16 + mfr;
        const int rrow = (tid & 255) >> 3, part = tid & 7;
        const int roff = 12288 + rrow * 128 + ((((part >> 1) ^ ((rrow >> 1) & 3)) << 5) | ((part & 1) << 4));
        const int grow = pm * BM + (rrow >> 4) * 64 + (rrow & 15);
#pragma unroll
        for (int ai = 0; ai < 2; ++ai)
#pragma unroll
            for (int m = 0; m < 4; ++m) {
                u32x2 w1, w2, w3, ws;
#pragma unroll
                for (int h = 0; h < 2; ++h) {
                    const f32x2 x1 = {acc[ai][0][m][0][2 * h], acc[ai][0][m][0][2 * h + 1]}, x2 = {acc[ai][0][m][1][2 * h], acc[ai][0][m][1][2 * h + 1]};
                    const f32x2 x3 = {acc[ai][1][m][0][2 * h], acc[ai][1][m][0][2 * h + 1]}, xs = {acc[ai][1][m][1][2 * h], acc[ai][1][m][1][2 * h + 1]};
                    const f32x2 one = {1.0f, 1.0f};
                    const f32x2 d1 = (f32x2){fminf(__builtin_amdgcn_exp2f(x1.x), CAP), fminf(__builtin_amdgcn_exp2f(x1.y), CAP)} + one, d2 = (f32x2){fminf(__builtin_amdgcn_exp2f(x2.x), CAP), fminf(__builtin_amdgcn_exp2f(x2.y), CAP)} + one;
                    const f32x2 d3 = (f32x2){fminf(__builtin_amdgcn_exp2f(x3.x), CAP), fminf(__builtin_amdgcn_exp2f(x3.y), CAP)} + one, ds = (f32x2){fminf(__builtin_amdgcn_exp2f(xs.x), CAP), fminf(__builtin_amdgcn_exp2f(xs.y), CAP)} + one;
                    const f32x2 p12 = d1 * d2, p3s = d3 * ds, q = p12 * p3s;
                    const f32x2 rq = {__builtin_amdgcn_rcpf(q.x), __builtin_amdgcn_rcpf(q.y)};
                    const f32x2 i12 = rq * p3s, i3s = rq * p12;
                    const f32x2 g3 = i3s * ds, sg = (xs * NLN2) * (i3s * d3);
                    const f32x2 r1 = (d2 * d2) * i12, r2 = (d3 * d1) * i12;
                    w1[h] = cvt_pk_bf16(r1.x, r1.y); w2[h] = cvt_pk_bf16(r2.x, r2.y); w3[h] = cvt_pk_bf16(g3.x, g3.y); ws[h] = cvt_pk_bf16(sg.x, sg.y);
                }
                if (ai + m > 0) { asm volatile("s_waitcnt lgkmcnt(0)" ::: "memory"); __builtin_amdgcn_s_barrier(); }
                *(lu32x2*)(stg + woff) = w1; *(lu32x2*)(stg + 4096 + woff) = w2; *(lu32x2*)(stg + 8192 + woff) = w3; *(lu32x2*)(stg + 12288 + woff) = ws;
                asm volatile("s_waitcnt lgkmcnt(0)" ::: "memory"); __builtin_amdgcn_s_barrier(); asm volatile("" ::: "memory");
                const u32x4 va = *(const lu32x4*)(stg + kq * 4096 + moff), vb = *(const lu32x4*)(stg + (kq == 0 ? 8192 + moff : roff));
                __builtin_nontemporal_store(va, (u32x4*)(MG + mg_off(pm, mpn, kq, mwave, ai, m, mbj, mlane)));
                if (kq == 0) __builtin_nontemporal_store(vb, (u32x4*)(MG + mg_off(pm, mpn, 2, mwave, ai, m, mbj, mlane)));
                else *(u32x4*)(sdst + (size_t)(grow + ai * HALF + m * 16) * sld + part * 8) = vb;
            }
        asm volatile("s_waitcnt lgkmcnt(0)" ::: "memory");
    }
    __device__ __forceinline__ void operator()(const f32x4 (&acc)[2][2][4][2], const Unit& u, int wr, int wc, int fr, int fq) const {
        const int pn = u.pn, pm = u.pm;
        float* const o_sbk = out + 17039360, * const o_sbv = out + 23330816, * const o_bdk = out + 29622272, * const o_bdv = out + 30408704;
        float* const o_mk = out + 31195136, * const o_mv = out + 31457280;
        float* const s_sbk = out + 31719424, * const s_sbv = out + 31817728, * const s_bdk = out + 31916032, * const s_bdv = out + 32014336;
        if (pn < 3)        store<0, 0>(acc, QSB, 768, 256 * pn, 0, pm, nullptr, nullptr, wr, wc, fr, fq);
        else if (pn < 6)   store<0, 1>(acc, KSB, 768, 256 * (pn - 3), 0, pm, o_sbk, s_sbk, wr, wc, fr, fq);
        else if (pn < 9)   store<0, 1>(acc, VSB, 768, 256 * (pn - 6), 0, pm, o_sbv, s_sbv, wr, wc, fr, fq);
        else if (pn < 12)  store<0, 0>(acc, QBD, 768, 256 * (pn - 9), 0, pm, nullptr, nullptr, wr, wc, fr, fq);
        else if (pn < 15)  store<0, 2>(acc, KBD, 768, 256 * (pn - 12), 0, pm, o_bdk, s_bdk, wr, wc, fr, fq, KBC);
        else if (pn < 18)  store<0, 2>(acc, VBD, 768, 256 * (pn - 15), 0, pm, o_bdv, s_bdv, wr, wc, fr, fq, VBC);
        else if (pn < 20)  store<0, 0>(acc, QMM, 512, 256 * (pn - 18), 0, pm, nullptr, nullptr, wr, wc, fr, fq);
        else if (pn < 52)  store_gates(acc, pn - 20, pm, wr, wc, fr, fq);
        else if (pn < 54)  store<0, 3>(acc, MK, 512, 256 * (pn - 52), MMEM0, pm, o_mk, nullptr, wr, wc, fr, fq);
        else               store<0, 3>(acc, MV, 512, 256 * (pn - 54), MMEM0, pm, o_mv, nullptr, wr, wc, fr, fq);
    }
};

struct MergeOrder {
    pg8::StaticOrder so;
    __device__ void init(int G_, int c_) { so.init(MP, DM, G_, c_); }
    __device__ bool next(int i, Unit& u) const {
        const int ti = i / 3, seg = i - 3 * ti;
        if (!so.next(ti, u)) return false;
        u.k0 = 768 * seg; u.nt = (seg == 2) ? 8 : 12; return true;
    }
    __device__ __forceinline__ void a_ready(const Unit&) const {}
    __device__ __forceinline__ void done(const Unit&) const {}
};
struct EpiMerge {
    static constexpr bool PERM = true, AFTER_DRAIN = false;
    const bf16_t* MG; bf16_t* OUT;
    __device__ __forceinline__ bool reset_after(const Unit& u) const { return u.k0 == 1536; }
    __device__ __forceinline__ void operator()(f32x4 (&acc)[2][2][4][2], const Unit& u, int wr, int wc, int fr, int fq) const {
        const int col0 = u.pn * BM + wc * 32 + 8 * fq;
        const int seg = (u.k0 == 0) ? 0 : (u.k0 == 768 ? 1 : 2);
        const bool last = (seg == 2);
        u32x4 g[2][4][2];
#pragma unroll
        for (int ai = 0; ai < 2; ++ai)
#pragma unroll
            for (int m = 0; m < 4; ++m)
#pragma unroll
                for (int bj = 0; bj < 2; ++bj) g[ai][m][bj] = __builtin_nontemporal_load((const u32x4*)(MG + mg_off(u.pm, u.pn, seg, wr * 4 + wc, ai, m, bj, fq * 16 + fr)));
#pragma unroll
        for (int ai = 0; ai < 2; ++ai)
#pragma unroll
            for (int m = 0; m < 4; ++m) { bf16_t* rowp = OUT + (size_t)(u.pm * BM + ai * HALF + wr * 64 + m * 16 + fr) * DM + col0;
#pragma unroll
                for (int bj = 0; bj < 2; ++bj) {
#pragma unroll
                    for (int e = 0; e < 4; ++e) { acc[ai][bj][m][e >> 1][2 * (e & 1)] *= __uint_as_float(g[ai][m][bj][e] << 16); acc[ai][bj][m][e >> 1][2 * (e & 1) + 1] *= __uint_as_float(g[ai][m][bj][e] & 0xffff0000u); }
                    if (last) { u32x4 w; w.x = cvt_pk_bf16(acc[ai][bj][m][0][0], acc[ai][bj][m][0][1]); w.y = cvt_pk_bf16(acc[ai][bj][m][0][2], acc[ai][bj][m][0][3]);
                        w.z = cvt_pk_bf16(acc[ai][bj][m][1][0], acc[ai][bj][m][1][1]); w.w = cvt_pk_bf16(acc[ai][bj][m][1][2], acc[ai][bj][m][1][3]);
                        *(u32x4*)(rowp + bj * HALF) = w; } } }
    }
};

struct EpiOut {
    static constexpr bool PERM = true, AFTER_DRAIN = false;
    bf16_t* yb; float* ssq;
    __device__ __forceinline__ bool reset_after(const Unit&) const { return true; }
    __device__ __forceinline__ void operator()(const f32x4 (&acc)[2][2][4][2], const Unit& u, int wr, int wc, int fr, int fq) const {
        const int col0 = u.pn * BM + wc * 32 + 8 * fq;
#pragma unroll
        for (int ai = 0; ai < 2; ++ai)
#pragma unroll
            for (int m = 0; m < 4; ++m) {
                const int r = u.pm * BM + ai * HALF + wr * 64 + m * 16 + fr;
                bf16_t* yrow = yb + (size_t)r * DM + col0;
                float s = 0.f;
#pragma unroll
                for (int bj = 0; bj < 2; ++bj) { const f32x4 v0 = acc[ai][bj][m][0], v1 = acc[ai][bj][m][1];
                    s += ((v0[0] * v0[0] + v0[1] * v0[1]) + (v0[2] * v0[2] + v0[3] * v0[3])) + ((v1[0] * v1[0] + v1[1] * v1[1]) + (v1[2] * v1[2] + v1[3] * v1[3]));
                    u32x4 w; w.x = cvt_pk_bf16(v0[0], v0[1]); w.y = cvt_pk_bf16(v0[2], v0[3]); w.z = cvt_pk_bf16(v1[0], v1[1]); w.w = cvt_pk_bf16(v1[2], v1[3]);
                    *(u32x4*)(yrow + bj * HALF) = w; }
                s += __shfl_xor(s, 16); s += __shfl_xor(s, 32);
                if (fq == 0) ssq[(size_t)r * 32 + u.pn * 4 + wc] = s;
            }
    }
};

struct EpiOutFused {
    static constexpr bool PERM = false, AFTER_DRAIN = true;
    const float* x; float* out; const float* gpost; float* xbuf; unsigned* cnt; unsigned* tmo;
    __device__ __forceinline__ bool reset_after(const Unit&) const { return true; }
    __device__ __forceinline__ void operator()(const f32x4 (&)[2][2][4][2], const Unit&, int, int, int, int) const {}
    __device__ __forceinline__ void fused(f32x4 (&acc)[2][2][4][2], const Unit& u, int wr, int wc, int fr, int fq, __attribute__((address_space(3))) unsigned char* lds, int wid, int lane) const {
        typedef __attribute__((address_space(3))) float lfloat;
        lfloat* P = (lfloat*)lds;
        lfloat* S = (lfloat*)(lds + 4096);
        __attribute__((address_space(3))) unsigned* flag = (__attribute__((address_space(3))) unsigned*)(lds + 4096 + 1024);
        const int col0 = u.pn * BM + wc * 32 + 4 * fq;
        f32x4 pre[4][2][2];
#pragma unroll
        for (int m = 0; m < 4; ++m) { const size_t off = (size_t)(u.pm * BM + wr * 64 + m * 16 + fr) * DM + col0;
#pragma unroll
            for (int bj = 0; bj < 2; ++bj)
#pragma unroll
                for (int n = 0; n < 2; ++n) pre[m][bj][n] = *(const f32x4*)(x + off + bj * HALF + n * 16); }
#pragma unroll
        for (int ai = 0; ai < 2; ++ai)
#pragma unroll
            for (int m = 0; m < 4; ++m) { float s = 0.f;
#pragma unroll
                for (int bj = 0; bj < 2; ++bj)
#pragma unroll
                    for (int n = 0; n < 2; ++n) { const f32x4 v = acc[ai][bj][m][n]; s += (v[0] * v[0] + v[1] * v[1]) + (v[2] * v[2] + v[3] * v[3]); }
                s += __shfl_xor(s, 16); s += __shfl_xor(s, 32);
                if (fq == 0) P[(ai * HALF + wr * 64 + m * 16 + fr) * 4 + wc] = s; }
        asm volatile("s_waitcnt lgkmcnt(0)" ::: "memory"); __builtin_amdgcn_s_barrier(); asm volatile("" ::: "memory");
        const int row = wid * 32 + (lane & 31);
        if (lane < 32) { const float t = (P[row * 4 + 0] + P[row * 4 + 1]) + (P[row * 4 + 2] + P[row * 4 + 3]);
            __hip_atomic_store(xbuf + ((size_t)(u.pm * BM + row) * 8 + u.pn), t, __ATOMIC_RELAXED, __HIP_MEMORY_SCOPE_AGENT); }
        asm volatile("s_waitcnt vmcnt(0)" ::: "memory");
        if (lane == 0) __hip_atomic_fetch_add(cnt + 64 * u.pm, 1u, __ATOMIC_RELAXED, __HIP_MEMORY_SCOPE_AGENT);
        if (wid == 0) { bool dead = false; const unsigned long long t0 = __builtin_amdgcn_s_memrealtime();
            for (;;) {
                if ((unsigned)__builtin_amdgcn_readfirstlane(__hip_atomic_load(cnt + 64 * u.pm, __ATOMIC_RELAXED, __HIP_MEMORY_SCOPE_AGENT)) >= 64u) break;
                if (__builtin_amdgcn_s_memrealtime() - t0 > 2000000ull) { if (lane == 0) __hip_atomic_store(tmo, 1u, __ATOMIC_RELAXED, __HIP_MEMORY_SCOPE_AGENT); dead = true; break; }
                __builtin_amdgcn_s_sleep(2); }
            __builtin_amdgcn_fence(__ATOMIC_ACQUIRE, "agent");
            if (lane == 0) flag[0] = dead ? 1u : 0u; }
        asm volatile("s_waitcnt vmcnt(0) lgkmcnt(0)" ::: "memory"); __builtin_amdgcn_s_barrier(); asm volatile("" ::: "memory");
        const bool bad = flag[0] != 0u;
        if (lane < 32) { const float* slot = xbuf + (size_t)(u.pm * BM + row) * 8; float q = 0.f;
#pragma unroll
            for (int t = 0; t < 8; ++t) q += __hip_atomic_load(slot + t, __ATOMIC_RELAXED, __HIP_MEMORY_SCOPE_AGENT);
            S[row] = 1.0f / sqrtf(q * (1.0f / DM) + RMS_EPS); }
        asm volatile("s_waitcnt lgkmcnt(0)" ::: "memory"); __builtin_amdgcn_s_barrier(); asm volatile("" ::: "memory");
        f32x4 gv[2][2];
#pragma unroll
        for (int bj = 0; bj < 2; ++bj)
#pragma unroll
            for (int n = 0; n < 2; ++n) gv[bj][n] = *(const f32x4*)(gpost + col0 + bj * HALF + n * 16);
        const float qnan = __builtin_nanf("");
#pragma unroll
        for (int ai = 0; ai < 2; ++ai)
#pragma unroll
            for (int m = 0; m < 4; ++m) { const int r = ai * HALF + wr * 64 + m * 16 + fr; const float rs = S[r]; const size_t off = (size_t)(u.pm * BM + r) * DM + col0;
#pragma unroll
                for (int bj = 0; bj < 2; ++bj)
#pragma unroll
                    for (int n = 0; n < 2; ++n) { const f32x4 bs = ai == 0 ? pre[m][bj][n] : *(const f32x4*)(x + off + bj * HALF + n * 16);
                        f32x4 o = bs + acc[ai][bj][m][n] * rs * gv[bj][n];
                        if (bad) o = (f32x4){qnan, qnan, qnan, qnan};
                        *(f32x4*)(out + off + bj * HALF + n * 16) = o; }
                if (m & 1) asm volatile("" ::: "memory"); }
    }
};

template <int MODE>
__device__ __forceinline__ void skinny_phase(const bf16_t* A, const bf16_t* Bt, const bf16_t* MG, bf16_t* OUTB, float* OUTF, float* SSQS, int slice, __attribute__((address_space(3))) unsigned char* ldsl) {
    typedef short bf16x8 __attribute__((ext_vector_type(8)));
    int tid_ = threadIdx.x; asm volatile("" : "+v"(tid_));
    const int tid = tid_, lane = tid & 63, fr = lane & 15, fq = lane >> 4;
    const int w = __builtin_amdgcn_readfirstlane(tid >> 6);
    const int cb = slice >> 1, rh = slice & 1;
    const int row0 = MP + 64 * rh + fr;
    const bf16_t* ap = A + (size_t)row0 * DM + 256 * w + 8 * fq;
    const bf16_t* bp = Bt + (size_t)(16 * cb + fr) * DM + 256 * w + 8 * fq;
    bf16x8 bf[8], af[4][8];
#pragma unroll
    for (int j = 0; j < 8; ++j) bf[j] = *(const bf16x8*)(bp + 32 * j);
#pragma unroll
    for (int rb = 0; rb < 4; ++rb)
#pragma unroll
        for (int j = 0; j < 8; ++j) af[rb][j] = *(const bf16x8*)(ap + (size_t)rb * 16 * DM + 32 * j);
    f32x4 acc[4];
#pragma unroll
    for (int rb = 0; rb < 4; ++rb) { acc[rb] = (f32x4){0.f, 0.f, 0.f, 0.f};
#pragma unroll
        for (int j = 0; j < 8; ++j) acc[rb] = __builtin_amdgcn_mfma_f32_16x16x32_bf16(bf[j], af[rb][j], acc[rb], 0, 0, 0); }
    if (MODE == 0) { const int s = (w < 3) ? 0 : (w < 6 ? 1 : 2);
#pragma unroll
        for (int rb = 0; rb < 4; ++rb) {
            const bf16_t* gp = MG + mg_off(32, cb >> 4, 0, rh * 4 + ((cb & 7) >> 1), 0, rb, (cb & 15) >> 3, ((cb & 1) * 2 + (fq >> 1)) * 16 + fr) + 4 * (fq & 1);
            const u32x2 ra = *(const u32x2*)gp, rb2 = *(const u32x2*)(gp + 65536), gc = *(const u32x2*)(gp + 131072);
#pragma unroll
            for (int e = 0; e < 4; ++e) { const unsigned a_ = e < 2 ? ra.x : ra.y, b_ = e < 2 ? rb2.x : rb2.y, c_ = e < 2 ? gc.x : gc.y;
                const float f1 = (e & 1) ? __uint_as_float(a_ & 0xffff0000u) : __uint_as_float(a_ << 16), f2 = (e & 1) ? __uint_as_float(b_ & 0xffff0000u) : __uint_as_float(b_ << 16), f3 = (e & 1) ? __uint_as_float(c_ & 0xffff0000u) : __uint_as_float(c_ << 16);
                acc[rb][e] *= f3 * (s < 2 ? f2 : 1.0f) * (s < 1 ? f1 : 1.0f); } } }
    __attribute__((address_space(3))) f32x4* red = (__attribute__((address_space(3))) f32x4*)ldsl;
#pragma unroll
    for (int rb = 0; rb < 4; ++rb) red[(w * 4 + rb) * 64 + lane] = acc[rb];
    __syncthreads();
    if (w < 4) { const int rb = w; f32x4 s = red[rb * 64 + lane];
#pragma unroll
        for (int k = 1; k < 8; ++k) s = s + red[(k * 4 + rb) * 64 + lane];
        const int row = row0 + 16 * rb;
        if (MODE == 0) { u32x2 o; o.x = cvt_pk_bf16(s[0], s[1]); o.y = cvt_pk_bf16(s[2], s[3]); *(u32x2*)(OUTB + (size_t)row * DM + 16 * cb + 4 * fq) = o; }
        else { *(f32x4*)(OUTF + (size_t)(row - MP) * DM + 16 * cb + 4 * fq) = s;
            float q = (s[0] * s[0] + s[1] * s[1]) + (s[2] * s[2] + s[3] * s[3]);
            q += __shfl_xor(q, 16); q += __shfl_xor(q, 32);
            if (fq == 0) SSQS[(size_t)(row - MP) * 128 + cb] = q; }
    }
    __syncthreads();
}
}

namespace att {
typedef unsigned short u16;
#define GA __attribute__((address_space(1)))
using bf16x8 = __attribute__((ext_vector_type(8))) short;
using s16x4  = __attribute__((ext_vector_type(4))) short;
using f32x16 = __attribute__((ext_vector_type(16))) float;
using f32x4  = __attribute__((ext_vector_type(4))) float;
using u32x4  = __attribute__((ext_vector_type(4))) unsigned;
using u32x2  = __attribute__((ext_vector_type(2))) unsigned;
constexpr int SHM_V = 16384, SHM_K = 16384;
constexpr int NBUF = 3;
constexpr int OFF_V = 0, OFF_K = NBUF * SHM_V, OFF_BIAS = 2 * NBUF * SHM_V, OFF_FLAGS = OFF_BIAS + 2304, OFF_ITEM = OFF_FLAGS + 128, ATT_LDS = OFF_ITEM + 64;
constexpr float SB_DONE_LOG2 = -152.0f;
#define KSWZ(row, colB) ((row) * 256 + ((colB) ^ (((row) & 7) << 4)))
#define ATT_SBAR() __builtin_amdgcn_sched_barrier(0)
__device__ __forceinline__ int crow(int r, int hi) { return (r & 3) + 8 * (r >> 2) + 4 * hi; }
__device__ __forceinline__ unsigned cvtpk(float lo, float hi) { return pg8::cvt_pk_bf16(lo, hi); }
__device__ __forceinline__ int v_st(int k, int c) { const int kk = (k & ~0xC) | ((k & 4) << 1) | ((k & 8) >> 1); return ((kk >> 3) * 4 + (c >> 5)) * 512 + ((kk & 7) * 32 + (c & 31)) * 2; }
__device__ __forceinline__ int v_rd_base(int lane) { return ((lane & 3) << 3) | (((lane >> 2) & 3) << 6) | (((lane >> 4) & 1) << 5) | (((lane >> 5) & 1) << 8); }
constexpr int v_rd_off(int d0, int ks, int half) { return d0 * 512 + ks * 4096 + half * 2048; }
template <int OFF> __device__ __forceinline__ s16x4 tr_read(int vb) { s16x4 r; asm volatile("ds_read_b64_tr_b16 %0, %1 offset:%2" : "=&v"(r) : "v"(vb), "i"(OFF) : "memory"); return r; }

struct Item {
    int mode;
    int rule;
    const GA u16* Q; int ldq; int nq; int qpos0;
    const GA u16 *kb, *vb; int ldb; int pb_lo, pb_hi;
    const GA float *kf, *vf; int ldf; int pf_lo, pf_hi;
    int pv_lo, pv_hi;
    int kp_first, kp_step, ntiles;
    const GA float* bias;
    GA u16* O; int ldo; const GA u16* G; int ldg;
    int dma;
};

template <bool QPARK>
__device__ __forceinline__ void qkt(f32x16& p0, f32x16& p1, const char* Ks, const bf16x8* qr, const char* qpark, int r32, int hi) {
    p0 = f32x16{}; p1 = f32x16{};
#pragma unroll
    for (int d0 = 0; d0 < 8; ++d0) { const int cb = (d0 * 16 + hi * 8) * 2;
        const bf16x8 b0 = *reinterpret_cast<const bf16x8*>(Ks + KSWZ(r32, cb));
        const bf16x8 b1 = *reinterpret_cast<const bf16x8*>(Ks + KSWZ(32 + r32, cb));
        const bf16x8 q = QPARK ? *reinterpret_cast<const bf16x8*>(qpark + d0 * 1024) : qr[d0];
        p0 = __builtin_amdgcn_mfma_f32_32x32x16_bf16(b0, q, p0, 0, 0, 0);
        p1 = __builtin_amdgcn_mfma_f32_32x32x16_bf16(b1, q, p1, 0, 0, 0); }
}
template <int D0> __device__ __forceinline__ void pv_one(f32x16& od, int vb, bf16x8 pa0, bf16x8 pa1, bf16x8 pa2, bf16x8 pa3) {
    const s16x4 l0 = tr_read<v_rd_off(D0, 0, 0)>(vb), h0 = tr_read<v_rd_off(D0, 0, 1)>(vb), l1 = tr_read<v_rd_off(D0, 1, 0)>(vb), h1 = tr_read<v_rd_off(D0, 1, 1)>(vb);
    const s16x4 l2 = tr_read<v_rd_off(D0, 2, 0)>(vb), h2 = tr_read<v_rd_off(D0, 2, 1)>(vb), l3 = tr_read<v_rd_off(D0, 3, 0)>(vb), h3 = tr_read<v_rd_off(D0, 3, 1)>(vb);
    asm volatile("s_waitcnt lgkmcnt(0)" ::: "memory"); ATT_SBAR();
#define ATT_PK(L, H) (bf16x8){L[0], L[1], L[2], L[3], H[0], H[1], H[2], H[3]}
    od = __builtin_amdgcn_mfma_f32_32x32x16_bf16(ATT_PK(l0, h0), pa0, od, 0, 0, 0);
    od = __builtin_amdgcn_mfma_f32_32x32x16_bf16(ATT_PK(l1, h1), pa1, od, 0, 0, 0);
    od = __builtin_amdgcn_mfma_f32_32x32x16_bf16(ATT_PK(l2, h2), pa2, od, 0, 0, 0);
    od = __builtin_amdgcn_mfma_f32_32x32x16_bf16(ATT_PK(l3, h3), pa3, od, 0, 0, 0);
#undef ATT_PK
}
#define ATT_PK4(P, BASE, OUT) do { const unsigned a0_ = cvtpk(P[BASE + 0], P[BASE + 1]), a1_ = cvtpk(P[BASE + 2], P[BASE + 3]);   \
    const unsigned b0_ = cvtpk(P[BASE + 4], P[BASE + 5]), b1_ = cvtpk(P[BASE + 6], P[BASE + 7]);                              \
    auto r0_ = __builtin_amdgcn_permlane32_swap(a0_, b0_, false, false); auto r1_ = __builtin_amdgcn_permlane32_swap(a1_, b1_, false, false); \
    u32x4 w_ = {r0_[0], r1_[0], r0_[1], r1_[1]}; OUT = *reinterpret_cast<bf16x8*>(&w_); } while (0)

__device__ __forceinline__ void sb_half(f32x16& p, float& carry, bool need_mask, int kbase, int qpos, int pv_lo, int pv_hi, int hi) {
    float T[16];
#pragma unroll
    for (int r = 0; r < 16; ++r) {
        const float z = p[r];
        const float t = __builtin_amdgcn_exp2f(-__builtin_fabsf(z));
        const float l = __builtin_amdgcn_logf(1.0f + t);
        float lm = -(fmaxf(z, 0.f) + l);
        float lp = fminf(z, 0.f) - l;
        if (need_mask) { const int kp = kbase + crow(r, hi); const bool ok = (kp < qpos) && (kp >= pv_lo) && (kp < pv_hi); lm = ok ? lm : 0.f; lp = ok ? lp : -1e30f; }
        T[r] = lm; p[r] = lp;
    }
    float glo[4], ghi[4];
#pragma unroll
    for (int g = 0; g < 4; ++g) {
        T[4 * g + 2] += T[4 * g + 3]; T[4 * g + 1] += T[4 * g + 2]; T[4 * g] += T[4 * g + 1];
        const float gt = T[4 * g];
        auto rr = __builtin_amdgcn_permlane32_swap(__float_as_uint(gt), __float_as_uint(gt), false, false);
        glo[g] = __uint_as_float(rr[0]); ghi[g] = __uint_as_float(rr[1]);
    }
    float SG[4];
    SG[3] = 0.f; SG[2] = glo[3] + ghi[3]; SG[1] = SG[2] + (glo[2] + ghi[2]); SG[0] = SG[1] + (glo[1] + ghi[1]);
    const float tot = SG[0] + (glo[0] + ghi[0]);
#pragma unroll
    for (int g = 0; g < 4; ++g) SG[g] += carry + (hi == 0 ? ghi[g] : 0.f);
#pragma unroll
    for (int r = 0; r < 16; ++r) p[r] = __builtin_amdgcn_exp2f(p[r] + ((r & 3) == 3 ? SG[r >> 2] : SG[r >> 2] + T[r + 1]));
    carry += tot;
}

#define ATT_TILE(Kt, vb_) do { \
            f32x16 p0, p1; \
            qkt<!DMA>(p0, p1, (Kt), qr, qpark, r32, hi); \
            bool need_mask = (kp0 < it.pv_lo) || (kp0 + 64 > it.pv_hi); \
            if (MODE == 0) { \
                need_mask = need_mask || (kp0 + 63 >= it.qpos0 + 32 * wid); \
                sb_half(p1, carry, need_mask, kp0 + 32, qpos, it.pv_lo, it.pv_hi, hi); \
                sb_half(p0, carry, need_mask, kp0, qpos, it.pv_lo, it.pv_hi, hi); \
            } else { \
                if (has_bias) {       \
                    const int dlo_ = it.qpos0 + 32 * wid - kp0 - 63, dhi_ = it.qpos0 + 32 * wid + 31 - kp0;       \
                    if (dlo_ >= 256) { const float c_ = biasT[0]; \
                        _Pragma("unroll") for (int r = 0; r < 16; ++r) { p0[r] += c_; p1[r] += c_; } } \
                    else if (dlo_ > -256 && dhi_ < 256) { const float* rb_ = biasT + (256 - qpos + kp0 + 4 * hi);              \
                        _Pragma("unroll") for (int r = 0; r < 16; ++r) { p0[r] += rb_[(r & 3) + 8 * (r >> 2)]; p1[r] += rb_[32 + (r & 3) + 8 * (r >> 2)]; } } \
                    else { \
                        _Pragma("unroll") for (int r = 0; r < 16; ++r) { const int kp = kp0 + crow(r, hi); \
                            int i0_ = 256 - qpos + kp; i0_ = i0_ < 0 ? 0 : (i0_ > 512 ? 512 : i0_); \
                            int i1_ = 288 - qpos + kp; i1_ = i1_ < 0 ? 0 : (i1_ > 512 ? 512 : i1_); \
                            p0[r] += biasT[i0_]; p1[r] += biasT[i1_]; } } \
                } \
                if (need_mask) { \
                    _Pragma("unroll") for (int r = 0; r < 16; ++r) { const int kp = kp0 + crow(r, hi); \
                        if (!(kp >= it.pv_lo && kp < it.pv_hi)) p0[r] = -1e30f; \
                        if (!(kp + 32 >= it.pv_lo && kp + 32 < it.pv_hi)) p1[r] = -1e30f; } \
                } \
                float pmax = p0[0]; \
                _Pragma("unroll") for (int r = 1; r < 16; ++r) pmax = fmaxf(pmax, p0[r]); \
                _Pragma("unroll") for (int r = 0; r < 16; ++r) pmax = fmaxf(pmax, p1[r]); \
                { auto rr = __builtin_amdgcn_permlane32_swap(__float_as_uint(pmax), __float_as_uint(pmax), false, false); pmax = fmaxf(__uint_as_float(rr[0]), __uint_as_float(rr[1])); } \
                float mn = m_reg, alpha = 1.f;                  \
                if (!__all(pmax - m_reg <= 8.0f)) { mn = fmaxf(m_reg, pmax); alpha = __builtin_amdgcn_exp2f(m_reg - mn); m_reg = mn; } \
                float ps = 0.f; \
                _Pragma("unroll") for (int r = 0; r < 16; ++r) { p0[r] = __builtin_amdgcn_exp2f(p0[r] - mn); ps += p0[r]; } \
                _Pragma("unroll") for (int r = 0; r < 16; ++r) { p1[r] = __builtin_amdgcn_exp2f(p1[r] - mn); ps += p1[r]; } \
                { auto rr = __builtin_amdgcn_permlane32_swap(__float_as_uint(ps), __float_as_uint(ps), false, false); ps = __uint_as_float(rr[0]) + __uint_as_float(rr[1]); } \
                l_reg = l_reg * alpha + ps; \
                if (__any(alpha < 1.f)) { \
                    _Pragma("unroll") for (int d = 0; d < 4; ++d) \
                        _Pragma("unroll") for (int r = 0; r < 16; ++r) o[d][r] *= alpha; } \
            } \
            bf16x8 pa0, pa1, pa2, pa3; \
            ATT_PK4(p0, 0, pa0); ATT_PK4(p0, 8, pa1); ATT_PK4(p1, 0, pa2); ATT_PK4(p1, 8, pa3); \
            const int vbt_ = (vb_); \
            pv_one<0>(o[0], vbt_, pa0, pa1, pa2, pa3); pv_one<1>(o[1], vbt_, pa0, pa1, pa2, pa3); pv_one<2>(o[2], vbt_, pa0, pa1, pa2, pa3); pv_one<3>(o[3], vbt_, pa0, pa1, pa2, pa3); \
        } while (0)

template <int MODE, bool DMA>
__device__ __forceinline__ void run_item(const Item& it, char* lds, __attribute__((address_space(3))) unsigned char* ldsl) {
    typedef __attribute__((address_space(3))) unsigned las_u32;
    const int tid = threadIdx.x, lane = tid & 63, r32 = lane & 31, hi = lane >> 5;
    const int wid = __builtin_amdgcn_readfirstlane(tid >> 6);
    char* V_lds = lds + OFF_V; char* K_lds = lds + OFF_K;
    float* biasT = (float*)(lds + OFF_BIAS);
    volatile __attribute__((address_space(3))) int* flags = (volatile __attribute__((address_space(3))) int*)(ldsl + OFF_FLAGS);
    const bool has_bias = (MODE == 1) && (it.bias != nullptr);
    const bool wave_rows = (32 * wid < it.nq);
    int qrow = 32 * wid + r32; if (qrow >= it.nq) qrow = it.nq - 1;
    const int qpos = it.qpos0 + 32 * wid + r32;
    bf16x8 qr[8];
    char* const qpark = K_lds + 2 * SHM_K + (wid & 1) * 8192 + lane * 16;
#define ATT_ITEM_LOADS() do { \
    if (has_bias) for (int i = tid; i < 513; i += 512) biasT[i] = it.bias[512 - i] * LOG2E; \
    { const GA u16* Qw = it.Q + (size_t)qrow * it.ldq + hi * 8; \
      _Pragma("unroll") for (int d0 = 0; d0 < 8; ++d0) { const bf16x8 q = *reinterpret_cast<const GA bf16x8*>(Qw + d0 * 16); \
          if constexpr (DMA) qr[d0] = q; else { if (wid < 2) *reinterpret_cast<bf16x8*>(qpark + d0 * 1024) = q; } } } \
    } while (0)
    f32x16 o[4]; o[0] = f32x16{}; o[1] = f32x16{}; o[2] = f32x16{}; o[3] = f32x16{};
    float carry = 0.f, m_reg = -1e30f, l_reg = 0.f;
    const int vb0 = (int)(uintptr_t)V_lds + v_rd_base(lane);
    const int nt = it.ntiles;
    bool wdone = !wave_rows;
    if constexpr (!DMA) ATT_ITEM_LOADS();
    if constexpr (DMA) {
        unsigned koff[2], voff[2];
#pragma unroll
        for (int i = 0; i < 2; ++i) { const int p = wid + 8 * i;
            const int krow = 4 * p + (lane >> 4), kch = (lane & 15) ^ (krow & 7);
            koff[i] = (unsigned)(krow * it.ldb * 2 + kch * 16);
            const int s = 2 * p + (lane >> 5), kk = 8 * (s >> 2) + ((lane & 31) >> 2), k = (kk & ~0xC) | ((kk & 4) << 1) | ((kk & 8) >> 1), c = 32 * (s & 3) + 8 * (lane & 3);
            voff[i] = (unsigned)(k * it.ldb * 2 + c * 2); }
        const GA char* kbase = (const GA char*)it.kb; const GA char* vbase = (const GA char*)it.vb;
#define ATT_DMA(b, kp0_) do { const size_t to_ = (size_t)((kp0_) - it.pb_lo) * (size_t)it.ldb * 2; \
        _Pragma("unroll") for (int i_ = 0; i_ < 2; ++i_) { \
            __builtin_amdgcn_global_load_lds((const GA unsigned*)(kbase + to_ + koff[i_]), (las_u32*)(ldsl + OFF_K + (b) * SHM_K + (wid + 8 * i_) * 1024), 16, 0, 0); \
            __builtin_amdgcn_global_load_lds((const GA unsigned*)(vbase + to_ + voff[i_]), (las_u32*)(ldsl + OFF_V + (b) * SHM_V + (wid + 8 * i_) * 1024), 16, 0, 0); } } while (0)
        ATT_DMA(0, it.kp_first);
        if (nt > 1) ATT_DMA(1, it.kp_first + it.kp_step);
        ATT_ITEM_LOADS();
        int cur = 0;
        for (int j = 0; j < nt; ++j) {
            const int kp0 = it.kp_first + j * it.kp_step;
            if (j + 1 < nt) asm volatile("s_waitcnt vmcnt(4) lgkmcnt(0)\n\ts_barrier" ::: "memory");
            else            asm volatile("s_waitcnt vmcnt(0) lgkmcnt(0)\n\ts_barrier" ::: "memory");
            if (MODE == 0 && SB_EARLY_EXIT && j > 0) {
                int alld = 1;
#pragma unroll
                for (int w = 0; w < 8; ++w) alld &= flags[((j - 1) & 1) * 8 + w];
                if (alld) break;
            }
            if (j + 2 < nt) { const int b2 = (cur >= 1) ? cur - 1 : cur + 2; ATT_DMA(b2, kp0 + 2 * it.kp_step); }
            bool active = wave_rows;
            if (it.rule == 1) active = active && (kp0 <= it.qpos0 + 32 * wid + 30) && !wdone;
            if (it.rule == 2) { const int ct = kp0 >> 6, cw = (it.qpos0 + 32 * wid) >> 6; active = active && (ct >= cw - 8) && (ct <= cw); }
            if (active) ATT_TILE(K_lds + cur * SHM_K, vb0 + cur * SHM_V);
            if (MODE == 0 && SB_EARLY_EXIT) {
                if (wave_rows && !wdone) { const bool rowdone = (carry < SB_DONE_LOG2) || (32 * wid + r32 >= it.nq); wdone = __all(rowdone); }
                if (lane == 0) flags[(j & 1) * 8 + wid] = wdone ? 1 : 0;
            }
            cur = (cur == NBUF - 1) ? 0 : cur + 1;
        }
        asm volatile("s_waitcnt vmcnt(0) lgkmcnt(0)\n\ts_barrier" ::: "memory");
#undef ATT_DMA
    } else {
    const int sr = tid >> 4, sc = (tid & 15) * 8;
    const int vst0 = v_st(sr, sc), vst1 = v_st(32 + sr, sc), kst0 = KSWZ(sr, sc * 2), kst1 = KSWZ(32 + sr, sc * 2);
    f32x4 sK0a, sK0b, sK1a, sK1b, sV0a, sV0b, sV1a, sV1b;
#define ATT_LD(p, A, B, kbp, kfp) do { const int p_ = (p); const bool isb_ = (p_ >= it.pb_lo && p_ < it.pb_hi), isf_ = (p_ >= it.pf_lo && p_ < it.pf_hi); \
        const GA char* a0_ = isf_ ? (const GA char*)(kfp + (size_t)(p_ - it.pf_lo) * it.ldf + sc) : (const GA char*)(kbp + (size_t)(isb_ ? p_ - it.pb_lo : 0) * it.ldb + sc); \
        const f32x4 la_ = *reinterpret_cast<const GA f32x4*>(a0_); const f32x4 lb_ = *reinterpret_cast<const GA f32x4*>(a0_ + (isf_ ? 16 : 0)); \
        A = la_; B = lb_; } while (0)
#define ATT_CV(p, A, B, OUT) do { const int p_ = (p); const bool isb_ = (p_ >= it.pb_lo && p_ < it.pb_hi), isf_ = (p_ >= it.pf_lo && p_ < it.pf_hi); \
        u32x4 w_ = {cvtpk(A[0], A[1]), cvtpk(A[2], A[3]), cvtpk(B[0], B[1]), cvtpk(B[2], B[3])}; const u32x4 r_ = __builtin_bit_cast(u32x4, A); \
        w_.x = isf_ ? w_.x : (isb_ ? r_.x : 0u); w_.y = isf_ ? w_.y : (isb_ ? r_.y : 0u); w_.z = isf_ ? w_.z : (isb_ ? r_.z : 0u); w_.w = isf_ ? w_.w : (isb_ ? r_.w : 0u); \
        OUT = *reinterpret_cast<bf16x8*>(&w_); } while (0)
#define ATT_SLOAD(kp0) do { ATT_LD((kp0) + sr, sK0a, sK0b, it.kb, it.kf); ATT_LD((kp0) + 32 + sr, sK1a, sK1b, it.kb, it.kf); \
        ATT_LD((kp0) + sr, sV0a, sV0b, it.vb, it.vf); ATT_LD((kp0) + 32 + sr, sV1a, sV1b, it.vb, it.vf); } while (0)
#define ATT_SWRITE(b, kp0) do { bf16x8 t_; \
        ATT_CV((kp0) + sr, sK0a, sK0b, t_); *reinterpret_cast<bf16x8*>(K_lds + (b) * SHM_K + kst0) = t_; \
        ATT_CV((kp0) + 32 + sr, sK1a, sK1b, t_); *reinterpret_cast<bf16x8*>(K_lds + (b) * SHM_K + kst1) = t_; \
        ATT_CV((kp0) + sr, sV0a, sV0b, t_); *reinterpret_cast<bf16x8*>(V_lds + (b) * SHM_V + vst0) = t_; \
        ATT_CV((kp0) + 32 + sr, sV1a, sV1b, t_); *reinterpret_cast<bf16x8*>(V_lds + (b) * SHM_V + vst1) = t_; } while (0)
    sK0b = sK1b = sV0b = sV1b = (f32x4){0.f, 0.f, 0.f, 0.f};
    ATT_SLOAD(it.kp_first); ATT_SWRITE(0, it.kp_first);
    __syncthreads();
    for (int j = 0; j < nt; ++j) {
        const int kp0 = it.kp_first + j * it.kp_step, kpn = kp0 + it.kp_step, cur = j & 1;
        const bool more = (j + 1 < nt);
        if (more) ATT_SLOAD(kpn);
        bool active = wave_rows;
        if (it.rule == 1) active = active && (kp0 <= it.qpos0 + 32 * wid + 30) && !wdone;
        if (it.rule == 2) { const int ct = kp0 >> 6, cw = (it.qpos0 + 32 * wid) >> 6; active = active && (ct >= cw - 8) && (ct <= cw); }
        if (active) ATT_TILE(K_lds + cur * SHM_K, vb0 + cur * SHM_V);
        if (MODE == 0 && SB_EARLY_EXIT) {
            if (wave_rows && !wdone) { const bool rowdone = (carry < SB_DONE_LOG2) || (32 * wid + r32 >= it.nq); wdone = __all(rowdone); }
            if (lane == 0) flags[cur * 8 + wid] = wdone ? 1 : 0;
        }
        if (more) ATT_SWRITE(cur ^ 1, kpn);
        __syncthreads();
        if (MODE == 0 && SB_EARLY_EXIT) {
            int alld = 1;
#pragma unroll
            for (int w = 0; w < 8; ++w) alld &= flags[cur * 8 + w];
            if (alld) break;
        }
    }
#undef ATT_LD
#undef ATT_CV
#undef ATT_SLOAD
#undef ATT_SWRITE
    }
    if (wave_rows) {
        const int nrow = it.nq - 32 * wid;
        const int prow = lane >> 4, piece = lane & 15;
        u32x4 gq[8];
#pragma unroll
        for (int j = 0; j < 8; ++j) { int rl = 4 * j + prow; rl = rl < nrow ? rl : nrow - 1;
            gq[j] = *reinterpret_cast<const GA u32x4*>(it.G + (size_t)(32 * wid + rl) * it.ldg + 8 * piece); }
        const float inv = (MODE == 1) ? __builtin_amdgcn_rcpf(l_reg) : 1.0f;
        char* const stg = lds + wid * 8704 + r32 * 272 + hi * 8;
#pragma unroll
        for (int d0 = 0; d0 < 4; ++d0)
#pragma unroll
            for (int g = 0; g < 4; ++g) { u32x2 w; w.x = cvtpk(o[d0][4 * g] * inv, o[d0][4 * g + 1] * inv); w.y = cvtpk(o[d0][4 * g + 2] * inv, o[d0][4 * g + 3] * inv);
                *reinterpret_cast<u32x2*>(stg + d0 * 64 + g * 16) = w; }
        asm volatile("s_waitcnt lgkmcnt(0)" ::: "memory");
        const char* const rd = lds + wid * 8704 + piece * 16;
#pragma unroll
        for (int j = 0; j < 8; ++j) { int rl = 4 * j + prow; rl = rl < nrow ? rl : nrow - 1;
            const u32x4 ov = *reinterpret_cast<const u32x4*>(rd + rl * 272); const u32x4 gg = gq[j]; u32x4 w;
#pragma unroll
            for (int e = 0; e < 4; ++e) w[e] = cvtpk(__uint_as_float(ov[e] << 16) * __uint_as_float(gg[e] << 16), __uint_as_float(ov[e] & 0xffff0000u) * __uint_as_float(gg[e] & 0xffff0000u));
            *reinterpret_cast<GA u32x4*>(it.O + (size_t)(32 * wid + rl) * it.ldo + 8 * piece) = w; }
    }
    __syncthreads();
}
#undef ATT_TILE
#undef ATT_ITEM_LOADS
#undef GA
}

constexpr int NWAVES = 8;
constexpr int N_LAUNCHES = MK_N_LAUNCHES;
constexpr int PER_PHASE = 6;

constexpr size_t al256(size_t x) { return (x + 255) & ~(size_t)255; }
constexpr size_t WS_CTL = 0, CTL_ZERO_BYTES = 65536, CTL_BYTES = 1u << 20;
constexpr size_t WS_WCAT = CTL_BYTES;
constexpr size_t WS_WUP  = WS_WCAT + (size_t)NCAT * DM * 2;
constexpr size_t WS_WOUT = WS_WUP + (size_t)DM * DM * 2;
constexpr size_t WS_ACAT = WS_WOUT + (size_t)DM * DM * 2;
constexpr size_t SZ768 = (size_t)MIN_ * 768 * 2, SZ512 = (size_t)MIN_ * 512 * 2;
constexpr size_t WS_QSB = WS_ACAT + (size_t)MA * DM * 2, WS_KSB = WS_QSB + SZ768, WS_VSB = WS_KSB + SZ768, WS_GSB = WS_VSB + SZ768;
constexpr size_t WS_QBD = WS_GSB + SZ768, WS_KBD = WS_QBD + SZ768, WS_VBD = WS_KBD + SZ768, WS_GBD = WS_VBD + SZ768;
constexpr size_t WS_QMM = WS_GBD + SZ768, WS_GMM = WS_QMM + SZ512;
constexpr size_t WS_MG  = WS_GMM + SZ512;
constexpr size_t WS_MK  = WS_MG + (size_t)MIN_ * 6144 * 2, WS_MV = WS_MK + (size_t)512 * 512 * 2;
constexpr size_t WS_AUP = WS_MV + (size_t)512 * 512 * 2;
constexpr size_t WS_SSQ = WS_AUP + (size_t)MIN_ * DM * 2;
constexpr size_t WS_SSQS = WS_SSQ + (size_t)MIN_ * 32 * 4;
constexpr size_t WS_XBUF = WS_SSQS + (size_t)MS * 128 * 4;
constexpr size_t WS_YB = WS_XBUF + (size_t)MP * 8 * 4;
constexpr size_t WS_KBC = WS_YB, WS_VBC = WS_KBC + (size_t)DB * 576 * 768 * 2, WS_MKC = WS_VBC + (size_t)DB * 576 * 768 * 2, WS_MVC = WS_MKC + (size_t)DB * NMEM * 512 * 2;
static_assert(WS_MVC + (size_t)DB * NMEM * 512 * 2 <= WS_YB + (size_t)MP * DM * 2, "decode caches inside the YB region");
constexpr size_t WS_END = WS_YB + (size_t)MP * DM * 2;
static_assert(WS_WCAT % 256 == 0 && WS_QSB % 256 == 0 && WS_MG % 256 == 0 && WS_AUP % 256 == 0 && WS_SSQ % 256 == 0, "alignment");
constexpr int CW_TMO = 0, CW_WORK = 64, CW_BAR = 4096, CW_PANEL = 8192;
constexpr int OUT_ELEMS = 32112640;

constexpr int RING_BYTES = 131072, LDSCTL_OFF = RING_BYTES, MISC_OFF = LDSCTL_OFF + 320, STG_OFF = 147456, LDS_BYTES = 163840;
static_assert(att::ATT_LDS <= RING_BYTES, "attention scratch inside the ring region");

#define GAS __attribute__((address_space(1)))
#define LAS __attribute__((address_space(3)))
typedef unsigned short bf16;
typedef unsigned v4u __attribute__((ext_vector_type(4)));
typedef float f32x4 __attribute__((ext_vector_type(4)));
typedef GAS unsigned gu32;
#define RLX_AGENT __ATOMIC_RELAXED, __HIP_MEMORY_SCOPE_AGENT
#define LDS_WAIT() asm volatile("s_waitcnt lgkmcnt(0)" ::: "memory")
__device__ __forceinline__ unsigned pk2(float lo, float hi) { return pg8::cvt_pk_bf16(lo, hi); }

#define XB_TMO      128
#define XB_XCNT(j)  (256  + 64 * (j))
#define XB_XSUB(j)  (1280 + 64 * (j))
#define XB_XGEN(j)  (2304 + 64 * (j))
#define XB_TOP      3328
#define XB_TOPGEN   3392
#define XCD_BAR_WORDS 3456
#define XB_SPIN_CAP (1u << 18)
__device__ __forceinline__ unsigned xb_ld(unsigned* p)              { return __hip_atomic_load(p, __ATOMIC_RELAXED, __HIP_MEMORY_SCOPE_AGENT); }
__device__ __forceinline__ unsigned xb_add(unsigned* p, unsigned v) { return __hip_atomic_fetch_add(p, v, __ATOMIC_RELAXED, __HIP_MEMORY_SCOPE_AGENT); }
__device__ __forceinline__ unsigned xb_xcc_id() { return (unsigned)__builtin_amdgcn_s_getreg((3 << 11) | 20) & 0xFu; }
#define XB_SPIN(cond, bar) do { unsigned _sp = 0; while (cond) { __builtin_amdgcn_s_sleep(1); \
    if ((++_sp & 255u) == 0u) { if (xb_ld(&(bar)[XB_TMO])) break; if (_sp > XB_SPIN_CAP) { atomicAdd(&(bar)[XB_TMO], 1u); break; } } } } while (0)
struct XcdBarrier { unsigned* bar; unsigned x; volatile LAS unsigned* st; };
__device__ __forceinline__ XcdBarrier xcd_barrier_post(unsigned* bar, volatile LAS unsigned* st) {
    XcdBarrier b; b.bar = bar; b.x = xb_xcc_id(); b.st = st;
    if (threadIdx.x == 0) (void)xb_add(&bar[XB_XCNT(b.x)], 1u);
    return b;
}
__device__ __forceinline__ void xcd_barrier_complete(unsigned* bar, unsigned x, unsigned& nloc, unsigned& nx) {
    const unsigned G = gridDim.x * gridDim.y * gridDim.z;
    unsigned sum, cnt, mine, sp = 0u;
    for (;;) {
        sum = 0u; cnt = 0u; mine = 0u;
#pragma unroll
        for (unsigned j = 0; j < 16; ++j) { const unsigned c = xb_ld(&bar[XB_XCNT(j)]); sum += c; cnt += (c > 0u) ? 1u : 0u; mine = (j == x) ? c : mine; }
        if (sum == G) break;
        __builtin_amdgcn_s_sleep(1);
        if ((++sp & 255u) == 0u) { if (xb_ld(&bar[XB_TMO])) break; if (sp > XB_SPIN_CAP) { atomicAdd(&bar[XB_TMO], 1u); break; } }
    }
    nloc = mine > 0u ? mine : 1u; nx = cnt > 0u ? cnt : 1u;
}
__device__ __forceinline__ void xcd_barrier(const XcdBarrier& b) {
    asm volatile("s_waitcnt vmcnt(0)" ::: "memory");
    __syncthreads();
    if (threadIdx.x == 0) {
        unsigned* bar = b.bar;
        __builtin_amdgcn_s_waitcnt(0);
        unsigned nloc = b.st[0], nx = b.st[1];
        if (nloc == 0u) { xcd_barrier_complete(bar, b.x, nloc, nx); b.st[0] = nloc; b.st[1] = nx; }
        const unsigned old = xb_add(&bar[XB_XSUB(b.x)], 1u);
        const unsigned gen = old / nloc;
        if (old + 1u == (gen + 1u) * nloc) {
            __builtin_amdgcn_fence(__ATOMIC_RELEASE, "agent");
            asm volatile("s_waitcnt vmcnt(0)" ::: "memory");
            const unsigned og = xb_add(&bar[XB_TOP], 1u);
            const unsigned tg = og / nx;
            if (og + 1u == (tg + 1u) * nx) xb_add(&bar[XB_TOPGEN], 1u);
            else XB_SPIN(xb_ld(&bar[XB_TOPGEN]) == tg, bar);
            __builtin_amdgcn_fence(__ATOMIC_ACQUIRE, "agent");
            xb_add(&bar[XB_XGEN(b.x)], 1u);
            asm volatile("s_waitcnt vmcnt(0)" ::: "memory");
        } else {
            XB_SPIN(xb_ld(&bar[XB_XGEN(b.x)]) == gen, bar);
            __builtin_amdgcn_fence(__ATOMIC_ACQUIRE, "agent");
            asm volatile("s_waitcnt vmcnt(0)" ::: "memory");
        }
    }
    __syncthreads();
}

struct Frame {
    LAS unsigned char* lds;
    volatile LAS unsigned* MISC;
    gu32* ctl;
    int vcu, G;
    const float *x_prompt, *x_sample, *c_sbk, *c_sbv, *c_bdk, *c_bdv, *c_mk, *c_mv, *mem_prompt, *g_pre, *w_in, *rel_bias, *g_mem, *w_mem_kv, *w_up_sb, *w_up_band, *w_up_mem, *w_out, *g_post;
    float* out;
    bf16 *WCAT, *WUP, *WOUT, *ACAT, *QSB, *KSB, *VSB, *GSB, *QBD, *KBD, *VBD, *GBD, *QMM, *GMM, *MG, *MK, *MV, *AUP, *MERGED;
    float* SSQ; float* SSQS; bf16* YB; bf16 *KBC, *VBC, *MKC, *MVC;
};

__device__ __forceinline__ int fresh_tid() { int t = threadIdx.x; asm volatile("" : "+v"(t)); return t; }
__device__ __forceinline__ float wave_sum(float v) {
#pragma unroll
    for (int o = 1; o < 64; o <<= 1) v += __shfl_xor(v, o);
    return v;
}
__device__ __forceinline__ void p0_decode(int item, int nblk, int& kb, int& nb) { kb = item / nblk; nb = item % nblk; }
__device__ __forceinline__ void p0_transpose_item(const float* W, int N, int nkb, bf16* WT, int ldt, int row_off, int col_off, int item, int lane) {
    int kb, nb; p0_decode(item, N / 32, kb, nb); const int k0 = 64 * kb + 8 * (lane >> 3), n0 = 32 * nb + 4 * (lane & 7);
    f32x4 wv[8];
#pragma unroll
    for (int i = 0; i < 8; ++i) wv[i] = __builtin_nontemporal_load((const GAS f32x4*)(W + (size_t)(k0 + i) * N + n0));
#pragma unroll
    for (int e = 0; e < 4; ++e) { v4u o; o.x = pk2(wv[0][e], wv[1][e]); o.y = pk2(wv[2][e], wv[3][e]); o.z = pk2(wv[4][e], wv[5][e]); o.w = pk2(wv[6][e], wv[7][e]);
        *(GAS v4u*)(WT + (size_t)(row_off + n0 + e) * ldt + col_off + k0) = o; }
}
__device__ __forceinline__ void rms_row_to_bf16(const float* xrow, const float* g, bf16* orow, int lane) {
    const GAS f32x4* xr = (const GAS f32x4*)xrow + lane; const GAS f32x4* gr = (const GAS f32x4*)g + lane;
    f32x4 v[8]; float s = 0.f;
#pragma unroll
    for (int j = 0; j < 8; ++j) { v[j] = xr[64 * j]; s += (v[j].x * v[j].x + v[j].y * v[j].y) + (v[j].z * v[j].z + v[j].w * v[j].w); }
    const float r = 1.0f / sqrtf(wave_sum(s) * (1.0f / DM) + RMS_EPS);
    GAS unsigned long long* o8 = (GAS unsigned long long*)orow + lane;
#pragma unroll
    for (int j = 0; j < 8; ++j) { const f32x4 gv = gr[64 * j];
        o8[64 * j] = (unsigned long long)pk2(v[j].x * r * gv.x, v[j].y * r * gv.y) | ((unsigned long long)pk2(v[j].z * r * gv.z, v[j].w * r * gv.w) << 32); }
}
__device__ __forceinline__ void p0_t_load(const float* W, int N, int item, int lane, f32x4 (&wv)[8]) {
    int kb, nb; p0_decode(item, N / 32, kb, nb); const int k0 = 64 * kb + 8 * (lane >> 3), n0 = 32 * nb + 4 * (lane & 7);
#pragma unroll
    for (int i = 0; i < 8; ++i) wv[i] = __builtin_nontemporal_load((const GAS f32x4*)(W + (size_t)(k0 + i) * N + n0));
}
__device__ __forceinline__ int wcat_row(int c) {
    int kind, idx;
    if (c >= 7168) { const int d = c - 7168; kind = d >> 11; idx = d & 2047; }
    else { const int p = c >> 8;
        if (p < 9) return c;
        if (p < 12) { kind = 3; idx = c - 2304; }
        else if (p < 21) return c - 768;
        else if (p < 24) { kind = 3; idx = 768 + (c - 5376); }
        else if (p < 26) return c - 1536;
        else { kind = 3; idx = 1536 + (c - 6656); } }
    const int t = idx >> 6, q = idx & 63;
    return (20 + t) * 256 + 128 * (kind >> 1) + 4 * (kind & 1) + 32 * (q >> 4) + 8 * ((q >> 2) & 3) + (q & 3);
}
__device__ __forceinline__ float wcat_scale(int c) { const int p = c >> 8; return (p < 3 || (p >= 12 && p < 15) || p == 24 || p == 25) ? QSCALE : ((p >= 9 && p < 12) || p >= 21) ? -LOG2E : 1.0f; }
template <bool MAP>
__device__ __forceinline__ void p0_t_finish(const f32x4 (&wv)[8], int N, bf16* WT, int ldt, int row_off, int col_off, int item, int lane) {
    int kb, nb; p0_decode(item, N / 32, kb, nb); const int k0 = 64 * kb + 8 * (lane >> 3), n0 = 32 * nb + 4 * (lane & 7);
#pragma unroll
    for (int e = 0; e < 4; ++e) { const float sc = MAP ? wcat_scale(n0 + e) : 1.0f;
        v4u o; o.x = pk2(wv[0][e] * sc, wv[1][e] * sc); o.y = pk2(wv[2][e] * sc, wv[3][e] * sc); o.z = pk2(wv[4][e] * sc, wv[5][e] * sc); o.w = pk2(wv[6][e] * sc, wv[7][e] * sc);
        *(GAS v4u*)(WT + (size_t)(MAP ? wcat_row(n0 + e) : row_off + n0 + e) * ldt + col_off + k0) = o; }
}
__device__ __forceinline__ void rms_load(const float* xrow, int lane, f32x4 (&v)[8]) {
    const GAS f32x4* xr = (const GAS f32x4*)xrow + lane;
#pragma unroll
    for (int j = 0; j < 8; ++j) v[j] = __builtin_nontemporal_load(&xr[64 * j]);
}
__device__ __forceinline__ void rms_finish(const f32x4 (&v)[8], const f32x4 (&gv)[8], bf16* orow, int lane) {
    float s = 0.f;
#pragma unroll
    for (int j = 0; j < 8; ++j) s += (v[j].x * v[j].x + v[j].y * v[j].y) + (v[j].z * v[j].z + v[j].w * v[j].w);
    const float r = 1.0f / sqrtf(wave_sum(s) * (1.0f / DM) + RMS_EPS);
    GAS unsigned long long* o8 = (GAS unsigned long long*)orow + lane;
#pragma unroll
    for (int j = 0; j < 8; ++j) o8[64 * j] = (unsigned long long)pk2(v[j].x * r * gv[j].x, v[j].y * r * gv[j].y) | ((unsigned long long)pk2(v[j].z * r * gv[j].z, v[j].w * r * gv[j].w) << 32);
}
__device__ __forceinline__ void p0_prologue(Frame& F) {
    const int tid_ = fresh_tid(), lane_ = tid_ & 63, wave_ = __builtin_amdgcn_readfirstlane(tid_ >> 6);
    const int gw = F.vcu * NWAVES + wave_, NGW = F.G * NWAVES;
    constexpr int I_IN = 32 * (INW / 32), I_MEM = 32 * (1024 / 32), I_USB = 12 * 64, I_UBD = 12 * 64, I_UMM = 8 * 64, I_OUT = 32 * 64;
    constexpr int NI = I_IN + I_MEM;
#define P0_TLOAD(buf, it_) do { if ((it_) < I_IN) p0_t_load(F.w_in, INW, (it_), lane_, buf); else p0_t_load(F.w_mem_kv, 1024, (it_) - I_IN, lane_, buf); } while (0)
#define P0_TFIN(buf, it_) do { if ((it_) < I_IN) p0_t_finish<true>(buf, INW, F.WCAT, DM, 0, 0, (it_), lane_); else p0_t_finish<false>(buf, 1024, F.WCAT, DM, INW, 0, (it_) - I_IN, lane_); } while (0)
    { f32x4 wa[8], wb[8]; int it = gw;
      if (it < NI) P0_TLOAD(wa, it);
      while (it < NI) {
          int it2 = it + NGW; if (it2 < NI) P0_TLOAD(wb, it2);
          P0_TFIN(wa, it); it = it2; if (it >= NI) break;
          it2 = it + NGW; if (it2 < NI) P0_TLOAD(wa, it2);
          P0_TFIN(wb, it); it = it2; } }
#undef P0_TLOAD
#undef P0_TFIN
    if (!LATE_WT) for (int it = gw; it < I_USB + I_UBD + I_UMM + I_OUT; it += NGW) {
        int r = it;
        if (r < I_USB) { p0_transpose_item(F.w_up_sb, DM, 12, F.WUP, DM, 0, 0, r, lane_); continue; } r -= I_USB;
        if (r < I_UBD) { p0_transpose_item(F.w_up_band, DM, 12, F.WUP, DM, 0, 768, r, lane_); continue; } r -= I_UBD;
        if (r < I_UMM) { p0_transpose_item(F.w_up_mem, DM, 8, F.WUP, DM, 0, 1536, r, lane_); continue; } r -= I_UMM;
        p0_transpose_item(F.w_out, DM, 32, F.WOUT, DM, 0, 0, r, lane_);
    }
    { f32x4 gv[8], va[8], vb[8]; const GAS f32x4* gr = (const GAS f32x4*)F.g_pre + lane_;
#pragma unroll
      for (int j = 0; j < 8; ++j) gv[j] = gr[64 * j];
      int m = gw;
      if (m < MP) rms_load(F.x_prompt + (size_t)m * DM, lane_, va);
      while (m < MP) {
          int m2 = m + NGW; if (m2 < MP) rms_load(F.x_prompt + (size_t)m2 * DM, lane_, vb);
          rms_finish(va, gv, F.ACAT + (size_t)m * DM, lane_); m = m2; if (m >= MP) break;
          m2 = m + NGW; if (m2 < MP) rms_load(F.x_prompt + (size_t)m2 * DM, lane_, va);
          rms_finish(vb, gv, F.ACAT + (size_t)m * DM, lane_); m = m2; } }
    for (int m = MP + gw; m < MA; m += NGW) {
        bf16* orow = F.ACAT + (size_t)m * DM;
        if (m < MREAL) rms_row_to_bf16(F.x_sample + (size_t)(m - MP) * DM, F.g_pre, orow, lane_);
        else if (m < MIN_) {
            GAS v4u* o = (GAS v4u*)orow + lane_; GAS v4u* o2 = (GAS v4u*)(F.AUP + (size_t)m * DM) + lane_;
#pragma unroll
            for (int j = 0; j < 4; ++j) { o[64 * j] = (v4u){0u, 0u, 0u, 0u}; o2[64 * j] = (v4u){0u, 0u, 0u, 0u}; }
        }
        else rms_row_to_bf16(F.mem_prompt + (size_t)(m - MMEM0) * DM, F.g_mem, orow, lane_);
    }
}
constexpr int LATE_ITEMS = 128;
__device__ __forceinline__ void late_transpose_item(Frame& F, int j) {
    const int tid_ = fresh_tid(), lane_ = tid_ & 63, wave_ = __builtin_amdgcn_readfirstlane(tid_ >> 6);
    constexpr int I_USB = 12 * 64, I_UBD = 12 * 64, I_UMM = 8 * 64;
#pragma unroll 1
    for (int q = 0; q < 4; ++q) {
        int r = (j * 8 + wave_) * 4 + q;
        if (r < I_USB) { p0_transpose_item(F.w_up_sb, DM, 12, F.WUP, DM, 0, 0, r, lane_); continue; } r -= I_USB;
        if (r < I_UBD) { p0_transpose_item(F.w_up_band, DM, 12, F.WUP, DM, 0, 768, r, lane_); continue; } r -= I_UBD;
        if (r < I_UMM) { p0_transpose_item(F.w_up_mem, DM, 8, F.WUP, DM, 0, 1536, r, lane_); continue; } r -= I_UMM;
        p0_transpose_item(F.w_out, DM, 32, F.WOUT, DM, 0, 0, r, lane_);
    }
}
constexpr int CV_BD = DB * 576 * 768 / 32768, CV_MM = DB * NMEM * 512 / 32768, SLACK_ITEMS = LATE_ITEMS + 2 * CV_BD + 2 * CV_MM;
static_assert(DB * 576 * 768 % 32768 == 0 && DB * NMEM * 512 % 32768 == 0, "conversion item size");
template <bool BAND>
__device__ __forceinline__ void slack_convert(const float* src, bf16* dst, int jj, int tid_) {
    constexpr int ld = BAND ? 768 : 512, rows_d = BAND ? 576 : NMEM, rows_s = BAND ? 512 : NMEM;
    f32x4 va[8], vb[8];
#pragma unroll
    for (int it = 0; it < 8; ++it) { const int e = (jj * 4096 + it * 512 + tid_) * 8;
        const int col = e % ld, rowd = e / ld, b = rowd / rows_d, row = rowd % rows_d;
        const float* s = src + ((size_t)(b * rows_s + (row < rows_s ? row : 0)) * ld + col);
        va[it] = __builtin_nontemporal_load((const GAS f32x4*)s); vb[it] = __builtin_nontemporal_load((const GAS f32x4*)(s + 4)); }
#pragma unroll
    for (int it = 0; it < 8; ++it) { const int e = (jj * 4096 + it * 512 + tid_) * 8; const int row = (e / ld) % rows_d;
        v4u w; w.x = pk2(va[it].x, va[it].y); w.y = pk2(va[it].z, va[it].w); w.z = pk2(vb[it].x, vb[it].y); w.w = pk2(vb[it].z, vb[it].w);
        if (row >= rows_s + DS) w = (v4u){0u, 0u, 0u, 0u};
        if (row < rows_s || row >= rows_s + DS) *(GAS v4u*)(dst + e) = w; }
}
__device__ __forceinline__ void slack_item(Frame& F, int j) {
    if (j < LATE_ITEMS) { late_transpose_item(F, j); return; }
    j -= LATE_ITEMS;
    const int tid_ = fresh_tid();
    if (j < CV_BD) slack_convert<true>(F.c_bdk, F.KBC, j, tid_);
    else if (j < 2 * CV_BD) slack_convert<true>(F.c_bdv, F.VBC, j - CV_BD, tid_);
    else if (j < 2 * CV_BD + CV_MM) slack_convert<false>(F.c_mk, F.MKC, j - 2 * CV_BD, tid_);
    else slack_convert<false>(F.c_mv, F.MVC, j - 2 * CV_BD - CV_MM, tid_);
}
struct P5Row { float sq; unsigned long long yb[8]; f32x4 xv[8]; };
__device__ __forceinline__ void p5_load(Frame& F, int m, int lane, float& sq, unsigned long long (&yb)[8], f32x4 (&xv)[8]) {
    sq = (lane < 32) ? F.SSQ[(size_t)m * 32 + lane] : 0.f;
    const GAS unsigned long long* yb8 = (const GAS unsigned long long*)(F.YB + (size_t)m * DM) + lane; const GAS f32x4* x4 = (const GAS f32x4*)(F.x_prompt + (size_t)m * DM) + lane;
#pragma unroll
    for (int j = 0; j < 8; ++j) { yb[j] = __builtin_nontemporal_load(&yb8[64 * j]); xv[j] = __builtin_nontemporal_load(&x4[64 * j]); }
}
__device__ __forceinline__ void p5_finish(Frame& F, int m, int lane, float sq, const unsigned long long (&yb)[8], const f32x4 (&xv)[8], const f32x4 (&gv)[8]) {
    const float r = 1.0f / sqrtf(wave_sum(sq) * (1.0f / DM) + RMS_EPS);
    GAS f32x4* y4 = (GAS f32x4*)(F.out + (size_t)m * DM) + lane;
#pragma unroll
    for (int j = 0; j < 8; ++j) { const unsigned long long yq = yb[j];
        const f32x4 yv = {__uint_as_float((unsigned)yq << 16), __uint_as_float((unsigned)yq & 0xffff0000u), __uint_as_float((unsigned)(yq >> 32) << 16), __uint_as_float((unsigned)(yq >> 32) & 0xffff0000u)};
        __builtin_nontemporal_store(xv[j] + yv * r * gv[j], &y4[64 * j]); }
}
__device__ __forceinline__ void p5_final(Frame& F) {
    const int tid_ = fresh_tid(), lane_ = tid_ & 63, wave_ = __builtin_amdgcn_readfirstlane(tid_ >> 6);
    const int gw = F.vcu * NWAVES + wave_, NGW = F.G * NWAVES;
    f32x4 gv[8]; { const GAS f32x4* g4 = (const GAS f32x4*)F.g_post + lane_;
#pragma unroll
        for (int j = 0; j < 8; ++j) gv[j] = g4[64 * j]; }
    if (!FUSE_RMS) {
        float sa, sb; unsigned long long ya[8], yb[8]; f32x4 xa[8], xb[8]; int m = gw;
        if (m < MP) p5_load(F, m, lane_, sa, ya, xa);
        while (m < MP) {
            int m2 = m + NGW; if (m2 < MP) p5_load(F, m2, lane_, sb, yb, xb);
            p5_finish(F, m, lane_, sa, ya, xa, gv); m = m2; if (m >= MP) break;
            m2 = m + NGW; if (m2 < MP) p5_load(F, m2, lane_, sa, ya, xa);
            p5_finish(F, m, lane_, sb, yb, xb, gv); m = m2; }
    }
    for (int m = MP + gw; m < MREAL; m += NGW) {
        float s = F.SSQS[(size_t)(m - MP) * 128 + lane_] + F.SSQS[(size_t)(m - MP) * 128 + 64 + lane_];
        s = wave_sum(s);
        const float r = 1.0f / sqrtf(s * (1.0f / DM) + RMS_EPS);
        GAS f32x4* y4 = (GAS f32x4*)(F.out + (size_t)16777216 + (size_t)(m - MP) * DM) + lane_; const GAS f32x4* x4 = (const GAS f32x4*)(F.x_sample + (size_t)(m - MP) * DM) + lane_;
#pragma unroll
        for (int j = 0; j < 8; ++j) { const f32x4 yv = y4[64 * j], xv = x4[64 * j]; y4[64 * j] = xv + yv * r * gv[j]; }
    }
}

constexpr int IT_BDP = 192, IT_BDS = 48, IT_SBP = 192, IT_SBS = 48, IT_MMP = 128, IT_MMS = 32;
constexpr int IT_TOTAL = IT_BDP + IT_BDS + IT_SBP + IT_SBS + IT_MMP + IT_MMS;
struct ArgsK { const void* in[19]; float* out; unsigned char* ws; int ph_lo, ph_hi; };
struct ItemSrc {
    const ArgsK* ka; unsigned char* ws;
    __device__ __forceinline__ GAS bf16* W(size_t off) const { return (GAS bf16*)(ws + off); }
    __device__ __forceinline__ const GAS float* I(int k) const { return (const GAS float*)ka->in[k]; }
};
__device__ __forceinline__ att::Item make_item(const ItemSrc& S, int idx) {
    GAS bf16* const QSB = S.W(WS_QSB); GAS bf16* const KSB = S.W(WS_KSB); GAS bf16* const VSB = S.W(WS_VSB); GAS bf16* const GSB = S.W(WS_GSB);
    GAS bf16* const QBD = S.W(WS_QBD); GAS bf16* const KBD = S.W(WS_KBD); GAS bf16* const VBD = S.W(WS_VBD); GAS bf16* const GBD = S.W(WS_GBD);
    GAS bf16* const QMM = S.W(WS_QMM); GAS bf16* const GMM = S.W(WS_GMM); GAS bf16* const MK = S.W(WS_MK); GAS bf16* const MV = S.W(WS_MV); GAS bf16* const AUP = S.W(WS_AUP);
    att::Item it; it.dma = 0; it.bias = nullptr; it.kf = nullptr; it.vf = nullptr; it.ldf = 0; it.pf_lo = 0; it.pf_hi = 0; it.kb = nullptr; it.vb = nullptr; it.ldb = 0; it.pb_lo = 0; it.pb_hi = 0;
    if (idx < 48) idx += 192; else if (idx < 96) idx += 432 - 48; else if (idx < 128) idx += 608 - 96; else if (idx < 320) idx -= 128; else if (idx < 512) idx += 240 - 320; else idx += 480 - 512;
    if (idx < IT_BDP) {
        const int b = idx / 96, h = (idx / 16) % 6, cg = idx % 16; const size_t row0 = (size_t)b * SEQ + 256 * cg;
        it.mode = 1; it.rule = 2; it.Q = QBD + row0 * 768 + h * HD; it.ldq = 768; it.nq = 256; it.qpos0 = 256 * cg;
        it.kb = KBD + (size_t)b * SEQ * 768 + h * HD; it.vb = VBD + (size_t)b * SEQ * 768 + h * HD; it.ldb = 768; it.pb_lo = 0; it.pb_hi = SEQ;
        it.pv_lo = 0; it.pv_hi = SEQ; const int c_lo = (4 * cg - 8) > 0 ? (4 * cg - 8) : 0;
        it.kp_first = 64 * c_lo; it.kp_step = 64; it.ntiles = 4 * cg + 4 - c_lo; it.bias = S.I(11) + h * 513; it.dma = 1;
        it.O = AUP + row0 * DM + 768 + h * HD; it.ldo = DM; it.G = GBD + row0 * 768 + h * HD; it.ldg = 768; return it; }
    idx -= IT_BDP;
    if (idx < IT_BDS) {
        const int b = idx / 6, h = idx % 6; const size_t row0 = (size_t)MP + b * DS;
        it.mode = 1; it.rule = 0; it.Q = QBD + row0 * 768 + h * HD; it.ldq = 768; it.nq = DS; it.qpos0 = PAST;
        if (SLACK_P1) {
            it.kb = S.W(WS_KBC) + (size_t)b * 576 * 768 + h * HD; it.vb = S.W(WS_VBC) + (size_t)b * 576 * 768 + h * HD; it.ldb = 768; it.pb_lo = PAST - 512; it.pb_hi = PAST - 512 + 576; it.dma = 1;
        } else {
            it.kb = KBD + row0 * 768 + h * HD; it.vb = VBD + row0 * 768 + h * HD; it.ldb = 768; it.pb_lo = PAST; it.pb_hi = PAST + DS;
            it.kf = S.I(4) + (size_t)b * 512 * 768 + h * HD; it.vf = S.I(5) + (size_t)b * 512 * 768 + h * HD; it.ldf = 768; it.pf_lo = PAST - 512; it.pf_hi = PAST; }
        it.pv_lo = PAST - 512; it.pv_hi = PAST + DS; it.kp_first = PAST - 512; it.kp_step = 64; it.ntiles = 9; it.bias = S.I(11) + h * 513;
        it.O = AUP + row0 * DM + 768 + h * HD; it.ldo = DM; it.G = GBD + row0 * 768 + h * HD; it.ldg = 768; return it; }
    idx -= IT_BDS;
    if (idx < IT_SBP) {
        const int b = idx % 2, h = (idx / 2) % 6, qb = 15 - idx / 12; const size_t row0 = (size_t)b * SEQ + 256 * qb;
        it.mode = 0; it.rule = 1; it.Q = QSB + row0 * 768 + h * HD; it.ldq = 768; it.nq = 256; it.qpos0 = 256 * qb;
        it.kb = KSB + (size_t)b * SEQ * 768 + h * HD; it.vb = VSB + (size_t)b * SEQ * 768 + h * HD; it.ldb = 768; it.pb_lo = 0; it.pb_hi = SEQ;
        it.pv_lo = 0; it.pv_hi = SEQ; it.kp_first = 64 * (4 * qb + 3); it.kp_step = -64; it.ntiles = 4 * qb + 4; it.dma = 1;
        it.O = AUP + row0 * DM + h * HD; it.ldo = DM; it.G = GSB + row0 * 768 + h * HD; it.ldg = 768; return it; }
    idx -= IT_SBP;
    if (idx < IT_SBS) {
        const int b = idx / 6, h = idx % 6; const size_t row0 = (size_t)MP + b * DS;
        it.mode = 0; it.rule = 1; it.Q = QSB + row0 * 768 + h * HD; it.ldq = 768; it.nq = DS; it.qpos0 = PAST;
        it.kb = KSB + row0 * 768 + h * HD; it.vb = VSB + row0 * 768 + h * HD; it.ldb = 768; it.pb_lo = PAST; it.pb_hi = PAST + DS;
        it.kf = S.I(2) + (size_t)b * PAST * 768 + h * HD; it.vf = S.I(3) + (size_t)b * PAST * 768 + h * HD; it.ldf = 768; it.pf_lo = 0; it.pf_hi = PAST;
        it.pv_lo = 0; it.pv_hi = PAST + DS; it.kp_first = PAST + DS - 64; it.kp_step = -64; it.ntiles = (PAST + DS + 63) / 64;
        it.O = AUP + row0 * DM + h * HD; it.ldo = DM; it.G = GSB + row0 * 768 + h * HD; it.ldg = 768; return it; }
    idx -= IT_SBS;
    if (idx < IT_MMP) {
        const int b = idx / 64, h = (idx / 16) % 4, qb = idx % 16; const size_t row0 = (size_t)b * SEQ + 256 * qb;
        it.mode = 1; it.rule = 0; it.Q = QMM + row0 * 512 + h * HD; it.ldq = 512; it.nq = 256; it.qpos0 = 0;
        it.kb = MK + (size_t)b * NMEM * 512 + h * HD; it.vb = MV + (size_t)b * NMEM * 512 + h * HD; it.ldb = 512; it.pb_lo = 0; it.pb_hi = NMEM;
        it.pv_lo = 0; it.pv_hi = NMEM; it.kp_first = 0; it.kp_step = 64; it.ntiles = 4; it.dma = 1;
        it.O = AUP + row0 * DM + 1536 + h * HD; it.ldo = DM; it.G = GMM + row0 * 512 + h * HD; it.ldg = 512; return it; }
    idx -= IT_MMP;
    {
        const int b = idx / 4, h = idx % 4; const size_t row0 = (size_t)MP + b * DS;
        it.mode = 1; it.rule = 0; it.Q = QMM + row0 * 512 + h * HD; it.ldq = 512; it.nq = DS; it.qpos0 = 0;
        if (SLACK_P1) { it.kb = S.W(WS_MKC) + (size_t)b * NMEM * 512 + h * HD; it.vb = S.W(WS_MVC) + (size_t)b * NMEM * 512 + h * HD; it.ldb = 512; it.pb_lo = 0; it.pb_hi = NMEM; it.dma = 1; }
        else { it.kf = S.I(6) + (size_t)b * NMEM * 512 + h * HD; it.vf = S.I(7) + (size_t)b * NMEM * 512 + h * HD; it.ldf = 512; it.pf_lo = 0; it.pf_hi = NMEM; }
        it.pv_lo = 0; it.pv_hi = NMEM; it.kp_first = 0; it.kp_step = 64; it.ntiles = 4;
        it.O = AUP + row0 * DM + 1536 + h * HD; it.ldo = DM; it.G = GMM + row0 * 512 + h * HD; it.ldg = 512; return it; }
}

struct Args { const void* in[19]; float* out; unsigned char* ws; int ph_lo, ph_hi; };
__global__ void __launch_bounds__(NWAVES * 64, 2) fwd_megakernel(Args args) {
    extern __shared__ __attribute__((aligned(16))) unsigned char lds[];
    Frame F;
    F.lds = (LAS unsigned char*)lds;
    F.MISC = (volatile LAS unsigned*)(F.lds + MISC_OFF);
    F.G = gridDim.x; { const int bx = blockIdx.x; F.vcu = (F.G % 8 == 0) ? (bx % 8) * (F.G / 8) + bx / 8 : bx; }
    unsigned char* ws = args.ws;
    F.ctl = (gu32*)(ws + WS_CTL);
    F.x_prompt = (const float*)args.in[0]; F.x_sample = (const float*)args.in[1]; F.c_sbk = (const float*)args.in[2]; F.c_sbv = (const float*)args.in[3];
    F.c_bdk = (const float*)args.in[4]; F.c_bdv = (const float*)args.in[5]; F.c_mk = (const float*)args.in[6]; F.c_mv = (const float*)args.in[7];
    F.mem_prompt = (const float*)args.in[8]; F.g_pre = (const float*)args.in[9]; F.w_in = (const float*)args.in[10]; F.rel_bias = (const float*)args.in[11];
    F.g_mem = (const float*)args.in[12]; F.w_mem_kv = (const float*)args.in[13]; F.w_up_sb = (const float*)args.in[14]; F.w_up_band = (const float*)args.in[15];
    F.w_up_mem = (const float*)args.in[16]; F.w_out = (const float*)args.in[17]; F.g_post = (const float*)args.in[18];
    F.out = args.out;
    F.WCAT = (bf16*)(ws + WS_WCAT); F.WUP = (bf16*)(ws + WS_WUP); F.WOUT = (bf16*)(ws + WS_WOUT); F.ACAT = (bf16*)(ws + WS_ACAT); F.MERGED = (bf16*)(ws + WS_ACAT);
    F.QSB = (bf16*)(ws + WS_QSB); F.KSB = (bf16*)(ws + WS_KSB); F.VSB = (bf16*)(ws + WS_VSB); F.GSB = (bf16*)(ws + WS_GSB);
    F.QBD = (bf16*)(ws + WS_QBD); F.KBD = (bf16*)(ws + WS_KBD); F.VBD = (bf16*)(ws + WS_VBD); F.GBD = (bf16*)(ws + WS_GBD);
    F.QMM = (bf16*)(ws + WS_QMM); F.GMM = (bf16*)(ws + WS_GMM); F.MG = (bf16*)(ws + WS_MG); F.MK = (bf16*)(ws + WS_MK); F.MV = (bf16*)(ws + WS_MV);
    F.AUP = (bf16*)(ws + WS_AUP); F.SSQ = (float*)(ws + WS_SSQ); F.SSQS = (float*)(ws + WS_SSQS); F.YB = (bf16*)(ws + WS_YB); F.KBC = (bf16*)(ws + WS_KBC); F.VBC = (bf16*)(ws + WS_VBC); F.MKC = (bf16*)(ws + WS_MKC); F.MVC = (bf16*)(ws + WS_MVC);
    for (int u = threadIdx.x; u < (STG_OFF - LDSCTL_OFF) / 4; u += NWAVES * 64) ((LAS unsigned*)(F.lds + LDSCTL_OFF))[u] = 0u;
    __syncthreads();
    XcdBarrier bar; bar.bar = (unsigned*)(F.ctl + CW_BAR); bar.x = 0; bar.st = nullptr;
    if (N_LAUNCHES != PER_PHASE) bar = xcd_barrier_post((unsigned*)(F.ctl + CW_BAR), F.MISC + 8);
#define GRID_BAR() do { if (N_LAUNCHES != PER_PHASE) xcd_barrier(bar); } while (0)
    const int lo = args.ph_lo, hi = args.ph_hi;
#ifdef ONLY_PHASE
#define IN(k) ((k) == ONLY_PHASE && lo <= (k) && (k) < hi)
#else
#define IN(k) (lo <= (k) && (k) < hi)
#endif
#define BOTH(k) (IN(k) && IN((k) + 1))
#ifdef PROBE_PHASE
#define PROBE_T0(k) do { if ((k) == PROBE_PHASE && blockIdx.x == 0 && threadIdx.x == 0) { const unsigned long long t_ = __builtin_amdgcn_s_memrealtime(); F.MISC[20] = (unsigned)t_; F.MISC[21] = (unsigned)(t_ >> 32); } } while (0)
#define PROBE_T1(k) do { if ((k) == PROBE_PHASE) { if (blockIdx.x == 0 && threadIdx.x == 0) { const unsigned long long t1_ = __builtin_amdgcn_s_memrealtime(), t0_ = (unsigned long long)F.MISC[20] | ((unsigned long long)F.MISC[21] << 32); \
        const unsigned long long te_ = t1_ + (unsigned long long)(PROBE_K) * (t1_ - t0_); unsigned n_ = 0; while (__builtin_amdgcn_s_memrealtime() < te_ && ++n_ < (1u << 22)) __builtin_amdgcn_s_sleep(4); } \
        __syncthreads(); GRID_BAR(); } } while (0)
#else
#define PROBE_T0(k) do { } while (0)
#define PROBE_T1(k) do { } while (0)
#endif
    if (IN(0)) { PROBE_T0(0); p0_prologue(F); if (BOTH(0)) GRID_BAR(); PROBE_T1(0); }
    if (IN(1)) {
        PROBE_T0(1);
        pg8::Gemm g{F.ACAT, F.WCAT, MA, NCAT, DM}; ep::InOrder S; S.init(F.G, (int)blockIdx.x);
        ep::EpiIn E{F.QSB, F.KSB, F.VSB, F.GSB, F.QBD, F.KBD, F.VBD, F.GBD, F.QMM, F.GMM, F.MG, F.MK, F.MV, F.out, F.lds + STG_OFF, F.KBC, F.VBC};
        {
        pg8::gemm_phase<ep::EpiIn, ep::InOrder, true, true>(F.lds, g, S, E);
        if (SLACK_P1) {
            volatile LAS int* sl = (volatile LAS int*)(F.MISC + 12);
            for (;;) {
                if (threadIdx.x == 0) *sl = (int)__hip_atomic_fetch_add((unsigned*)(F.ctl + CW_WORK + 64), 1u, RLX_AGENT);
                __syncthreads();
                const int j = __builtin_amdgcn_readfirstlane(*sl);
                __syncthreads();
                if (j >= SLACK_ITEMS) break;
                slack_item(F, j);
            }
        }
        if (BOTH(1)) GRID_BAR(); }
        PROBE_T1(1);
    }
    if (IN(2)) {
        static_assert(SLACK_P1 || !LATE_WT, "the late transposes run in P1's slack");
        PROBE_T0(2);
        volatile LAS int* slot = (volatile LAS int*)(F.lds + att::OFF_ITEM);
        for (;;) {
            if (threadIdx.x == 0) *slot = (int)__hip_atomic_fetch_add((unsigned*)(F.ctl + CW_WORK), 1u, RLX_AGENT);
            __syncthreads();
            const int idx = __builtin_amdgcn_readfirstlane(*slot);
            __syncthreads();
#ifdef PROBE_P2_N
            if (idx >= IT_TOTAL + PROBE_P2_N) break;
            const int qidx = idx < PROBE_P2_N ? PROBE_P2_BASE + idx : idx - PROBE_P2_N;
#else
            if (idx >= IT_TOTAL) break;
            const int qidx = idx;
#endif
            const ArgsK* ka = (const ArgsK*)__builtin_amdgcn_kernarg_segment_ptr(); unsigned char* wsl = args.ws;
            asm volatile("" : "+s"(ka), "+s"(wsl));
            const ItemSrc isrc{ka, wsl};
            const att::Item it = make_item(isrc, qidx);
            if (it.dma) { if (it.mode == 0) att::run_item<0, true>(it, (char*)lds, F.lds); else att::run_item<1, true>(it, (char*)lds, F.lds); }
            else { if (it.mode == 0) att::run_item<0, false>(it, (char*)lds, F.lds); else att::run_item<1, false>(it, (char*)lds, F.lds); }
        }
        if (BOTH(2)) GRID_BAR();
        PROBE_T1(2);
    }
    if (IN(3)) {
        PROBE_T0(3);
        pg8::Gemm g{F.AUP, F.WUP, MIN_, DM, DM}; ep::MergeOrder S; S.init(F.G, (int)blockIdx.x);
        ep::EpiMerge E{F.MG, F.MERGED};
        const bool skf = (F.vcu & 1) != 0;
        int two = 2; asm volatile("" : "+s"(two));
#pragma unroll 1
        for (int pass = 0; pass < two; ++pass) {
            if (skf == (pass == 0)) for (int sl = F.vcu; sl < 256; sl += F.G) ep::skinny_phase<0>(F.AUP, F.WUP, F.MG, F.MERGED, nullptr, nullptr, sl, F.lds);
            if (pass == 0) pg8::gemm_phase<ep::EpiMerge, ep::MergeOrder, true, true>(F.lds, g, S, E);
        }
        if (BOTH(3)) GRID_BAR();
        PROBE_T1(3);
    }
    if (IN(4)) {
        PROBE_T0(4);
        pg8::Gemm g{F.MERGED, F.WOUT, MP, DM, DM}; pg8::StaticOrder S; S.init(MP, DM, F.G, (int)blockIdx.x);
#if FUSE_RMS
        ep::EpiOutFused E{F.x_prompt, F.out, F.g_post, (float*)(ws + WS_XBUF), (unsigned*)(F.ctl + CW_PANEL), (unsigned*)(F.ctl + CW_TMO)};
        {
        pg8::gemm_phase<ep::EpiOutFused, pg8::StaticOrder, false, true>(F.lds, g, S, E);
        for (int sl = F.vcu; sl < 256; sl += F.G) ep::skinny_phase<1>(F.MERGED, F.WOUT, nullptr, nullptr, F.out + 16777216, F.SSQS, sl, F.lds);
#else
        ep::EpiOut E{F.YB, F.SSQ};
        {
        const bool skf = (F.vcu & 1) != 0;
        int two = 2; asm volatile("" : "+s"(two));
#pragma unroll 1
        for (int pass = 0; pass < two; ++pass) {
            if (skf == (pass == 0)) for (int sl = F.vcu; sl < 256; sl += F.G) ep::skinny_phase<1>(F.MERGED, F.WOUT, nullptr, nullptr, F.out + 16777216, F.SSQS, sl, F.lds);
            if (pass == 0) pg8::gemm_phase<ep::EpiOut, pg8::StaticOrder, true, true>(F.lds, g, S, E);
        }
#endif
        if (BOTH(4)) GRID_BAR(); }
        PROBE_T1(4);
    }
#ifdef PROBE_PHASE
    if (IN(5)) { PROBE_T0(5); p5_final(F); if (PROBE_PHASE == 5) GRID_BAR(); PROBE_T1(5); }
#else
    if (IN(5)) p5_final(F);
#endif
#undef IN
#undef BOTH
#undef GRID_BAR
#undef PROBE_T0
#undef PROBE_T1
}

extern "C" void kernel_launch(void* const* d_in, const int* in_sizes, int n_in, void* d_out, int out_size, void* d_ws, size_t ws_size, hipStream_t stream) {
    static int grid = 0;
    if (grid == 0) {
        if (n_in != 19 || in_sizes[0] != MP * DM || in_sizes[10] != DM * INW || out_size != OUT_ELEMS || ws_size < WS_END) {
            fprintf(stderr, "kernel_launch: built for 19 inputs, x_prompt %d, w_in %d, out %d floats, >= %zu bytes of workspace; got n_in %d, in0 %d, in10 %d, out %d, ws %zu; nothing launched\n",
                    MP * DM, DM * INW, OUT_ELEMS, (size_t)WS_END, n_in, n_in > 0 ? in_sizes[0] : -1, n_in > 10 ? in_sizes[10] : -1, out_size, ws_size);
            grid = -1; return; }
        int dev = 0, cus = 0, per_cu = 0;
        if (hipGetDevice(&dev) != hipSuccess || hipDeviceGetAttribute(&cus, hipDeviceAttributeMultiprocessorCount, dev) != hipSuccess) { fprintf(stderr, "kernel_launch: device query failed\n"); grid = -1; return; }
        if (hipFuncSetAttribute((const void*)fwd_megakernel, hipFuncAttributeMaxDynamicSharedMemorySize, LDS_BYTES) != hipSuccess) { fprintf(stderr, "kernel_launch: hipFuncSetAttribute(%d B LDS) failed\n", LDS_BYTES); grid = -1; return; }
        if (hipOccupancyMaxActiveBlocksPerMultiprocessor(&per_cu, (const void*)fwd_megakernel, NWAVES * 64, LDS_BYTES) != hipSuccess || per_cu < 1) {
            fprintf(stderr, "kernel_launch: occupancy query reports %d workgroups per CU; nothing launched\n", per_cu); (void)hipGetLastError(); grid = -1; return; }
        grid = cus;
    }
    if (grid < 0) return;
    if (hipMemsetAsync((char*)d_ws + WS_CTL, 0, CTL_ZERO_BYTES, stream) != hipSuccess) { fprintf(stderr, "kernel_launch: hipMemsetAsync failed\n"); return; }
    Args a{};
    for (int i = 0; i < 19; ++i) a.in[i] = d_in[i];
    a.out = (float*)d_out; a.ws = (unsigned char*)d_ws;
    if (N_LAUNCHES == 1) {
        a.ph_lo = 0; a.ph_hi = PER_PHASE;
        hipLaunchKernelGGL(fwd_megakernel, dim3(grid), dim3(NWAVES * 64), LDS_BYTES, stream, a);
    } else {
        for (int li = 0; li < PER_PHASE; ++li) { a.ph_lo = li; a.ph_hi = li + 1; hipLaunchKernelGGL(fwd_megakernel, dim3(grid), dim3(NWAVES * 64), LDS_BYTES, stream, a); }
    }
    const hipError_t le = hipPeekAtLastError();
    if (le != hipSuccess) fprintf(stderr, "kernel_launch: launch failed: %s (grid %d)\n", hipGetErrorName(le), grid);
}
```
